# Optimizing an MI355X kernel written in HIP

```python
import jax
import jax.numpy as jnp
from jax import lax
import numpy as np

D_MODEL = 2048
BATCH = 1
SEQ = 8192
DEPTH = 4

ATT_HEADS = 8
ATT_HEAD_DIM = 128
IDX_HEADS = 8
IDX_DIM = 64
INDEX_TOPK = 256
Q_BLOCK = 128
MLSTM_HEADS = 4
MLSTM_QK_DIM = 128
MLSTM_V_DIM = 256
MLSTM_CHUNK = 64
CONV_WIDTH = 4
RET_HEADS = 8
RET_QK_DIM = 128
RET_V_DIM = 128
RET_CHUNK = 128
ROPE_THETA = 10000.0
NORM_EPS = 1e-6
FFN_DIM = -(-8 * D_MODEL // (3 * 256)) * 256
N_BRANCHES = 3

SPLIT_SIZES = (
    ATT_HEADS * ATT_HEAD_DIM,
    ATT_HEADS * ATT_HEAD_DIM,
    ATT_HEADS * ATT_HEAD_DIM,
    IDX_HEADS * IDX_DIM,
    IDX_DIM,
    IDX_HEADS,
    MLSTM_HEADS * MLSTM_QK_DIM,
    MLSTM_HEADS * MLSTM_QK_DIM,
    MLSTM_HEADS * MLSTM_V_DIM,
    MLSTM_HEADS,
    MLSTM_HEADS,
    MLSTM_HEADS * MLSTM_V_DIM,
    RET_HEADS * RET_QK_DIM,
    RET_HEADS * RET_QK_DIM,
    RET_HEADS * RET_V_DIM,
    RET_HEADS * RET_V_DIM,
    N_BRANCHES * D_MODEL,
)
PROJ_DIM = sum(SPLIT_SIZES)

kernel_name = 'hybrid_dsa_mlstm_retention_trunk'


def rms_norm(x, g):
    xf = x.astype(jnp.float32)
    y = xf * lax.rsqrt(jnp.mean(xf * xf, axis=-1, keepdims=True) + NORM_EPS)
    return (y * g).astype(x.dtype)


def head_layer_norm(x, g):
    xf = x.astype(jnp.float32)
    mu = jnp.mean(xf, axis=-1, keepdims=True)
    xc = xf - mu
    y = xc * lax.rsqrt(jnp.mean(xc * xc, axis=-1, keepdims=True) + NORM_EPS)
    return (y * g).astype(x.dtype)


def split_heads(t, n):
    return t.reshape(t.shape[:-1] + (n, -1))


def rope(x, pos):
    d = x.shape[-1]
    half = d // 2
    inv_freq = ROPE_THETA ** (-jnp.arange(half, dtype=jnp.float32) * 2.0 / d)
    ang = pos.astype(jnp.float32)[:, None] * inv_freq[None, :]
    cos = jnp.cos(ang)[:, None, :]
    sin = jnp.sin(ang)[:, None, :]
    xf = x.astype(jnp.float32)
    x1, x2 = xf[..., :half], xf[..., half:]
    return jnp.concatenate([x1 * cos - x2 * sin, x2 * cos + x1 * sin], axis=-1).astype(x.dtype)


def causal_depthwise_conv(x, w):
    c = x.shape[-1]
    return lax.conv_general_dilated(
        x, w[:, None, :].astype(x.dtype), window_strides=(1,),
        padding=[(w.shape[0] - 1, 0)], dimension_numbers=('NWC', 'WIO', 'NWC'),
        feature_group_count=c)


def to_chunks(a, size):
    b, s, h, d = a.shape
    return jnp.moveaxis(a.astype(jnp.float32).reshape(b, s // size, size, h, d), (1, 3), (0, 2))


def from_chunks(a):
    nc, b, h, size, d = a.shape
    return jnp.moveaxis(a, (0, 2), (1, 3)).reshape(b, nc * size, h, d)


def dsa_sparse_attention(q, k, v, iq, ik, iw):
    b, s, h, dh = q.shape
    n_sel = min(INDEX_TOPK, s // 4)
    nb = s // Q_BLOCK
    key_pos = jnp.arange(s, dtype=jnp.int32)

    def to_blocks(a):
        return jnp.moveaxis(a.reshape((b, nb, Q_BLOCK) + a.shape[2:]), 1, 0)

    def block(args):
        qb, iqb, iwb, start = args
        q_pos = start + jnp.arange(Q_BLOCK, dtype=jnp.int32)
        causal = key_pos[None, :] <= q_pos[:, None]
        idx_logits = jnp.einsum('bqjd,bsd->bqjs', iqb, ik).astype(jnp.float32) * IDX_DIM ** -0.5
        w = iwb.astype(jnp.float32) * IDX_HEADS ** -0.5
        score = jnp.einsum('bqj,bqjs->bqs', w, jax.nn.relu(idx_logits))
        score = jnp.where(causal[None], score, -jnp.inf)
        _, sel = lax.top_k(score, n_sel)
        valid = sel <= q_pos[None, :, None]
        k_sel = jax.vmap(lambda kk, ii: kk[ii])(k, sel)
        v_sel = jax.vmap(lambda vv, ii: vv[ii])(v, sel)
        logits = jnp.einsum('bqhd,bqnhd->bhqn', qb, k_sel).astype(jnp.float32) * dh ** -0.5
        logits = jnp.where(valid[:, None], logits, -jnp.inf)
        p = jax.nn.softmax(logits, axis=-1)
        return jnp.einsum('bhqn,bqnhd->bqhd', p.astype(v.dtype), v_sel)

    starts = jnp.arange(nb, dtype=jnp.int32) * Q_BLOCK
    out = lax.map(block, (to_blocks(q), to_blocks(iq), to_blocks(iw), starts))
    return jnp.moveaxis(out, 0, 1).reshape(b, s, h * dh)


def mlstm_chunkwise(q, k, v, i_pre, f_pre):
    b, s, h, dk = q.shape
    dv = v.shape[-1]
    size = MLSTM_CHUNK
    qc = to_chunks(q, size)
    kc = to_chunks(k, size) * dk ** -0.5
    vc = to_chunks(v, size)
    ic = to_chunks(i_pre[..., None], size)[..., 0]
    logf = to_chunks(jax.nn.log_sigmoid(f_pre.astype(jnp.float32))[..., None], size)[..., 0]
    bc = jnp.cumsum(logf, axis=-1)
    tril = jnp.tril(jnp.ones((size, size), dtype=bool))

    def step(carry, xs):
        c_state, n_state, m_state = carry
        q_, k_, v_, b_, i_ = xs
        log_intra = jnp.where(tril, b_[..., :, None] - b_[..., None, :] + i_[..., None, :], -jnp.inf)
        m_inter = b_ + m_state[..., None]
        m_t = jnp.maximum(m_inter, jnp.max(log_intra, axis=-1))
        w_inter = jnp.exp(m_inter - m_t)
        p = jnp.exp(log_intra - m_t[..., None]) * jnp.einsum('bhld,bhsd->bhls', q_, k_)
        num = w_inter[..., None] * jnp.einsum('bhld,bhde->bhle', q_, c_state) + jnp.einsum('bhls,bhse->bhle', p, v_)
        den = w_inter * jnp.einsum('bhld,bhd->bhl', q_, n_state) + jnp.sum(p, axis=-1)
        h_out = num / jnp.maximum(jnp.abs(den), jnp.exp(-m_t))[..., None]
        b_end = b_[..., -1]
        log_to_end = b_end[..., None] - b_ + i_
        m_new = jnp.maximum(b_end + m_state, jnp.max(log_to_end, axis=-1))
        decay = jnp.exp(b_end + m_state - m_new)
        ka = k_ * jnp.exp(log_to_end - m_new[..., None])[..., None]
        c_new = decay[..., None, None] * c_state + jnp.einsum('bhsd,bhse->bhde', ka, v_)
        n_new = decay[..., None] * n_state + jnp.sum(ka, axis=-2)
        return (c_new, n_new, m_new), h_out

    init = (jnp.zeros((b, h, dk, dv), jnp.float32), jnp.zeros((b, h, dk), jnp.float32),
            jnp.zeros((b, h), jnp.float32))
    _, hs = lax.scan(step, init, (qc, kc, vc, bc, ic))
    return from_chunks(hs)


def retention_chunkwise(q, k, v):
    b, s, h, dk = q.shape
    size = RET_CHUNK
    log_gamma = jnp.log(1.0 - 2.0 ** (-5.0 - jnp.arange(h, dtype=jnp.float32)))
    pos = jnp.arange(size, dtype=jnp.float32)
    rel = pos[:, None] - pos[None, :]
    decay_intra = jnp.where(rel >= 0, jnp.exp(log_gamma[:, None, None] * jnp.maximum(rel, 0.0)), 0.0)
    q_decay = jnp.exp(log_gamma[:, None] * (pos + 1.0))[:, :, None]
    k_decay = jnp.exp(log_gamma[:, None] * (size - 1.0 - pos))[:, :, None]
    chunk_decay = jnp.exp(log_gamma * size)[:, None, None]
    qc = to_chunks(q, size)
    kc = to_chunks(k, size) * dk ** -0.5
    vc = to_chunks(v, size)

    def step(r_state, xs):
        q_, k_, v_ = xs
        inner = jnp.einsum('bhls,bhse->bhle', jnp.einsum('bhld,bhsd->bhls', q_, k_) * decay_intra, v_)
        cross = jnp.einsum('bhld,bhde->bhle', q_ * q_decay, r_state)
        r_new = chunk_decay * r_state + jnp.einsum('bhsd,bhse->bhde', k_ * k_decay, v_)
        return r_new, inner + cross

    init = jnp.zeros((b, h, dk, v.shape[-1]), jnp.float32)
    _, outs = lax.scan(step, init, (qc, kc, vc))
    return from_chunks(outs)


def setup_inputs(seed: int = 0) -> dict:
    key = jax.random.key(seed)
    ks = jax.random.split(key, 17)
    f32 = jnp.float32

    def normal(k, shape, scale):
        return jax.random.normal(k, shape, f32) * scale

    def gain(k, shape):
        return 1.0 + 0.05 * jax.random.normal(k, shape, f32)

    att_w = ATT_HEADS * ATT_HEAD_DIM
    mlstm_w = MLSTM_HEADS * MLSTM_V_DIM
    ret_w = RET_HEADS * RET_V_DIM
    i_bias = normal(ks[7], (DEPTH, MLSTM_HEADS), 0.1)
    f_bias = jnp.linspace(3.0, 6.0, MLSTM_HEADS, dtype=f32)[None, :] + normal(ks[8], (DEPTH, MLSTM_HEADS), 0.1)
    return {
        'x': normal(ks[0], (BATCH, SEQ, D_MODEL), 1.0),
        'norm_mix': gain(ks[1], (DEPTH, D_MODEL)),
        'norm_ffn': gain(ks[2], (DEPTH, D_MODEL)),
        'w_in': normal(ks[3], (DEPTH, D_MODEL, PROJ_DIM), D_MODEL ** -0.5),
        'att_q_norm': gain(ks[4], (DEPTH, ATT_HEAD_DIM)),
        'att_k_norm': gain(ks[5], (DEPTH, ATT_HEAD_DIM)),
        'mlstm_conv': normal(ks[6], (DEPTH, CONV_WIDTH, 2 * MLSTM_HEADS * MLSTM_QK_DIM), CONV_WIDTH ** -0.5),
        'mlstm_gate_bias': jnp.concatenate([i_bias, f_bias], axis=-1),
        'mlstm_out_norm': gain(ks[9], (DEPTH, MLSTM_HEADS, MLSTM_V_DIM)),
        'ret_out_norm': gain(ks[10], (DEPTH, RET_HEADS, RET_V_DIM)),
        'w_branch_att': normal(ks[11], (DEPTH, att_w, D_MODEL), att_w ** -0.5),
        'w_branch_mlstm': normal(ks[12], (DEPTH, mlstm_w, D_MODEL), mlstm_w ** -0.5),
        'w_branch_ret': normal(ks[13], (DEPTH, ret_w, D_MODEL), ret_w ** -0.5),
        'w_out': normal(ks[14], (DEPTH, D_MODEL, D_MODEL), D_MODEL ** -0.5),
        'w_ffn_in': normal(ks[15], (DEPTH, D_MODEL, 2 * FFN_DIM), D_MODEL ** -0.5),
        'w_ffn_out': normal(ks[16], (DEPTH, FFN_DIM, D_MODEL), FFN_DIM ** -0.5),
    }


def reference(x, norm_mix, norm_ffn, w_in, att_q_norm, att_k_norm, mlstm_conv, mlstm_gate_bias,
              mlstm_out_norm, ret_out_norm, w_branch_att, w_branch_mlstm, w_branch_ret, w_out,
              w_ffn_in, w_ffn_out):
    b, s, _ = x.shape
    pos = jnp.arange(s, dtype=jnp.int32)
    split_points = np.cumsum(SPLIT_SIZES)[:-1]
    for layer in range(DEPTH):
        h = rms_norm(x, norm_mix[layer])
        (aq, ak, av, iq, ik, iw, mq, mk, mv, mi, mf, mo,
         rq, rk, rv, rg, gates) = jnp.split(h @ w_in[layer], split_points, axis=-1)

        aq = rope(rms_norm(split_heads(aq, ATT_HEADS), att_q_norm[layer]), pos)
        ak = rope(rms_norm(split_heads(ak, ATT_HEADS), att_k_norm[layer]), pos)
        iq = rope(split_heads(iq, IDX_HEADS), pos)
        ik = rope(ik[:, :, None, :], pos)[:, :, 0, :]
        y_att = dsa_sparse_attention(aq, ak, split_heads(av, ATT_HEADS), iq, ik, iw)

        mqk = causal_depthwise_conv(jnp.concatenate([mq, mk], axis=-1), mlstm_conv[layer])
        mq, mk = jnp.split(mqk, 2, axis=-1)
        gate_bias = mlstm_gate_bias[layer]
        hm = mlstm_chunkwise(split_heads(mq, MLSTM_HEADS), split_heads(mk, MLSTM_HEADS),
                             split_heads(mv, MLSTM_HEADS),
                             mi.astype(jnp.float32) + gate_bias[:MLSTM_HEADS],
                             mf.astype(jnp.float32) + gate_bias[MLSTM_HEADS:])
        y_mlstm = (rms_norm(hm, mlstm_out_norm[layer]).reshape(b, s, -1)
                   * jax.nn.sigmoid(mo.astype(jnp.float32))).astype(x.dtype)

        hr = retention_chunkwise(rope(split_heads(rq, RET_HEADS), pos), rope(split_heads(rk, RET_HEADS), pos),
                                 split_heads(rv, RET_HEADS))
        y_ret = (head_layer_norm(hr, ret_out_norm[layer]).reshape(b, s, -1)
                 * jax.nn.silu(rg.astype(jnp.float32))).astype(x.dtype)

        g_att, g_mlstm, g_ret = jnp.split(jax.nn.sigmoid(gates), N_BRANCHES, axis=-1)
        merged = (g_att * (y_att @ w_branch_att[layer])
                  + g_mlstm * (y_mlstm @ w_branch_mlstm[layer])
                  + g_ret * (y_ret @ w_branch_ret[layer]))
        x = x + merged @ w_out[layer]

        h = rms_norm(x, norm_ffn[layer])
        ff_gate, ff_up = jnp.split(h @ w_ffn_in[layer], 2, axis=-1)
        x = x + (jax.nn.silu(ff_gate) * ff_up) @ w_ffn_out[layer]
    return x
```

```cpp
#include <hip/hip_runtime.h>
#include <cstdio>
#include <cstdint>
namespace pg8 {
#define PG8_LAS __attribute__((address_space(3)))
typedef unsigned short bf16_t;
typedef short bf16x8 __attribute__((ext_vector_type(8)));
typedef float f32x4 __attribute__((ext_vector_type(4)));
typedef unsigned u32x4 __attribute__((ext_vector_type(4)));
constexpr int BM = 256, BK = 64, HALF = 128, HTB = HALF * BK * 2  , STAGE_BYTES = 8 * HTB, NXCD = 8, WGM = 8;

__host__ __device__ __forceinline__ int lds_byte(int r, int c) { const int st = (r >> 4) * 2 + (c >> 5), rr = r & 15, cc = c & 31, ob = rr * 64 + cc * 2; return st * 1024 + (ob ^ (((ob >> 9) & 1) << 5)); }
__host__ __device__ __forceinline__ void stage_rc(int b, int& R, int& C) { const int st = b / 1024, sb = b % 1024, swz = sb ^ (((sb >> 9) & 1) << 5); R = (st >> 1) * 16 + swz / 64; C = (st & 1) * 32 + (swz % 64) / 2; }
__host__ __device__ __forceinline__ int perm32(int rho) { const int n = rho >> 4, i = rho & 15; return 8 * (i >> 2) + 4 * n + (i & 3); }

struct Unit { int pm, pn; };
struct Gemm { const bf16_t* A; const bf16_t* Bt; int M, N, K; };

struct StaticOrder {
    int nM, nN, nwg, G, c;
    __host__ __device__ void init(int M, int N, int G_, int c_) { nM = M / BM; nN = N / BM; nwg = nM * nN; G = G_; c = c_; }
    __host__ __device__ bool next(int i, Unit& u) const {
        const long L = (long)i * G + c; if (L >= nwg) return false;
        int wgid = (int)L; { const int q = nwg / NXCD, r = nwg % NXCD, xcd = wgid % NXCD, off = wgid / NXCD; wgid = (xcd < r ? xcd * (q + 1) : r * (q + 1) + (xcd - r) * q) + off; }
        const int nig = WGM * nN, gid = wgid / nig, fm = gid * WGM, gsz = (nM - fm) < WGM ? (nM - fm) : WGM;
        u.pm = fm + ((wgid % nig) % gsz); u.pn = (wgid % nig) / gsz; return true;
    }
    __device__ __forceinline__ void a_ready(const Unit&) const {}
    __device__ __forceinline__ void done(const Unit&) const {}
};

__device__ __forceinline__ unsigned cvt_pk_bf16(float lo, float hi) { unsigned r; asm volatile("v_cvt_pk_bf16_f32 %0, %1, %2" : "=v"(r) : "v"(lo), "v"(hi)); return r; }
typedef float f32x2 __attribute__((ext_vector_type(2)));
__device__ __forceinline__ float sigmoid_f(float x) { return __builtin_amdgcn_rcpf(1.0f + __builtin_amdgcn_exp2f(-1.4426950408889634f * x)); }
struct EpiProj {
    static constexpr bool PERM = true, AFTER_DRAIN = false;
    bf16_t* P; int ldp; float* Sm; int ngate0, nbf;
    __device__ __forceinline__ void operator()(const f32x4 (&acc)[2][2][4][2], const Unit& u, int wr, int wc, int fr, int fq) const {
        const int row0 = u.pm * BM + wr * 64 + fr, col0 = u.pn * BM + wc * 32 + 8 * fq;
        if (u.pn >= nbf) {
            const int c0 = wc * 32 + 8 * fq;
#pragma unroll
            for (int ai = 0; ai < 2; ++ai)
#pragma unroll
                for (int m = 0; m < 4; ++m) { float* rowp = Sm + (size_t)(row0 + ai * HALF + m * 16) * 256 + c0;
#pragma unroll
                    for (int bj = 0; bj < 2; ++bj) { *(f32x4*)(rowp + bj * HALF) = acc[ai][bj][m][0]; *(f32x4*)(rowp + bj * HALF + 4) = acc[ai][bj][m][1]; } }
            return;
        }
        const bool sg = u.pn >= ngate0;
#pragma unroll
        for (int ai = 0; ai < 2; ++ai)
#pragma unroll
            for (int m = 0; m < 4; ++m) { bf16_t* rowp = P + (size_t)(row0 + ai * HALF + m * 16) * ldp + col0;
#pragma unroll
                for (int bj = 0; bj < 2; ++bj) { f32x4 v0 = acc[ai][bj][m][0], v1 = acc[ai][bj][m][1];
                    if (sg) {
#pragma unroll
                        for (int j = 0; j < 4; ++j) { v0[j] = sigmoid_f(v0[j]); v1[j] = sigmoid_f(v1[j]); } }
                    u32x4 w; w.x = cvt_pk_bf16(v0[0], v0[1]); w.y = cvt_pk_bf16(v0[2], v0[3]); w.z = cvt_pk_bf16(v1[0], v1[1]); w.w = cvt_pk_bf16(v1[2], v1[3]);
                    *(u32x4*)(rowp + bj * HALF) = w; } }
    }
};
__device__ __forceinline__ f32x4 bf4_lo(u32x4 w) { return (f32x4){__uint_as_float(w.x << 16), __uint_as_float(w.x & 0xffff0000u), __uint_as_float(w.y << 16), __uint_as_float(w.y & 0xffff0000u)}; }
__device__ __forceinline__ f32x4 bf4_hi(u32x4 w) { return (f32x4){__uint_as_float(w.z << 16), __uint_as_float(w.z & 0xffff0000u), __uint_as_float(w.w << 16), __uint_as_float(w.w & 0xffff0000u)}; }
template <int MODE> struct EpiBranch {
    static constexpr bool PERM = true, AFTER_DRAIN = false;
    const bf16_t* G; int ldg; float* T; bf16_t* O; int ldt;
    __device__ __forceinline__ void operator()(const f32x4 (&acc)[2][2][4][2], const Unit& u, int wr, int wc, int fr, int fq) const {
        const int row0 = u.pm * BM + wr * 64 + fr, col0 = u.pn * BM + wc * 32 + 8 * fq;
#pragma unroll
        for (int ai = 0; ai < 2; ++ai)
#pragma unroll
            for (int m = 0; m < 4; ++m) { const size_t r = (size_t)(row0 + ai * HALF + m * 16);
#pragma unroll
                for (int bj = 0; bj < 2; ++bj) { const u32x4 g = *(const u32x4*)(G + r * ldg + col0 + bj * HALF);
                    f32x4 v0 = acc[ai][bj][m][0] * bf4_lo(g), v1 = acc[ai][bj][m][1] * bf4_hi(g);
                    float* tp = T + r * ldt + col0 + bj * HALF;
                    if (MODE >= 1) { v0 = v0 + *(const f32x4*)tp; v1 = v1 + *(const f32x4*)(tp + 4); }
                    if (MODE <= 1) { *(f32x4*)tp = v0; *(f32x4*)(tp + 4) = v1; }
                    else { u32x4 w; w.x = cvt_pk_bf16(v0[0], v0[1]); w.y = cvt_pk_bf16(v0[2], v0[3]); w.z = cvt_pk_bf16(v1[0], v1[1]); w.w = cvt_pk_bf16(v1[2], v1[3]);
                        *(u32x4*)(O + r * ldt + col0 + bj * HALF) = w; } } }
    }
};
struct EpiResid {
    static constexpr bool PERM = false, AFTER_DRAIN = false;
    const float* base; float* out; int ldc;
    __device__ __forceinline__ void operator()(const f32x4 (&acc)[2][2][4][2], const Unit& u, int wr, int wc, int fr, int fq) const {
        const int row0 = u.pm * BM + wr * 64 + fr, col0 = u.pn * BM + wc * 32 + 4 * fq;
#pragma unroll
        for (int ai = 0; ai < 2; ++ai)
#pragma unroll
            for (int m = 0; m < 4; ++m) { const size_t off = (size_t)(row0 + ai * HALF + m * 16) * ldc + col0;
#pragma unroll
                for (int bj = 0; bj < 2; ++bj)
#pragma unroll
                    for (int n = 0; n < 2; ++n) *(f32x4*)(out + off + bj * HALF + n * 16) = *(const f32x4*)(base + off + bj * HALF + n * 16) + acc[ai][bj][m][n]; }
    }
};
struct EpiSwiGLU {
    static constexpr bool PERM = true, AFTER_DRAIN = false;
    bf16_t* O; int ldc;
    __device__ __forceinline__ void operator()(const f32x4 (&acc)[2][2][4][2], const Unit& u, int wr, int wc, int fr, int fq) const {
        const int row0 = u.pm * BM + wr * 64 + fr, col0 = u.pn * HALF + wc * 32 + 8 * fq;
#pragma unroll
        for (int ai = 0; ai < 2; ++ai)
#pragma unroll
            for (int m = 0; m < 4; ++m) { f32x4 v0, v1;
#pragma unroll
                for (int j = 0; j < 4; ++j) { const float g0 = acc[ai][0][m][0][j], g1 = acc[ai][0][m][1][j];
                    v0[j] = g0 * sigmoid_f(g0) * acc[ai][1][m][0][j]; v1[j] = g1 * sigmoid_f(g1) * acc[ai][1][m][1][j]; }
                u32x4 w; w.x = cvt_pk_bf16(v0[0], v0[1]); w.y = cvt_pk_bf16(v0[2], v0[3]); w.z = cvt_pk_bf16(v1[0], v1[1]); w.w = cvt_pk_bf16(v1[2], v1[3]);
                *(u32x4*)(O + (size_t)(row0 + ai * HALF + m * 16) * ldc + col0) = w; }
    }
};
template <class Epi, class Sched, bool ALIGN_EPI = false, bool SP2 = false>
__device__ __forceinline__ void gemm_phase(PG8_LAS unsigned char* lds, const Gemm g, const Sched& S, const Epi& E) {
    const int tid = threadIdx.x, wid = __builtin_amdgcn_readfirstlane(tid >> 6), lane = tid & 63, wr = wid >> 2, wc = wid & 3, fr = lane & 15, fq = lane >> 4;
    const int K = g.K, nt = K / BK;
    unsigned voffA[2], voffB[2];
#pragma unroll
    for (int i = 0; i < 2; ++i) { int R, C; stage_rc(tid * 16 + i * 8192, R, C); const int Rb = Epi::PERM ? ((R & ~31) + perm32(R & 31)) : R;
        voffA[i] = (unsigned)(R * K + C) * 2u; voffB[i] = (unsigned)(Rb * K + C) * 2u; }
    const size_t kstep = (size_t)(BK * 2);
    const size_t hstep = (size_t)HALF * K * 2;
    const size_t tstep = 2 * hstep;
    const unsigned ldsw = (unsigned)wid * 1024u;
    const int aoff = lds_byte(wr * 64 + fr, fq * 8), boff = lds_byte(wc * 32 + fr, fq * 8);
#define PG8_SA(b, h) (((b) * 2 + (h)) * HTB)
#define PG8_SB(b, h) ((4 + (b) * 2 + (h)) * HTB)
#define PG8_STAGE(bufoff, gbase, voff) do { _Pragma("unroll") for (int _i = 0; _i < 2; ++_i) \
        __builtin_amdgcn_global_load_lds((const unsigned*)((const char*)(gbase) + (voff)[_i]), (PG8_LAS unsigned*)(lds + (bufoff) + ldsw + _i * 8192), 16, 0, 0); } while (0)
#define PG8_LDA(dst, b, h) do { _Pragma("unroll") for (int m = 0; m < 4; ++m) _Pragma("unroll") for (int k = 0; k < 2; ++k) dst[m][k] = *(const PG8_LAS bf16x8*)(lds + PG8_SA(b, h) + aoff + m * 2048 + k * 1024); } while (0)
#define PG8_LDB(dst, b, h) do { _Pragma("unroll") for (int n = 0; n < 2; ++n) _Pragma("unroll") for (int k = 0; k < 2; ++k) dst[n][k] = *(const PG8_LAS bf16x8*)(lds + PG8_SB(b, h) + boff + n * 2048 + k * 1024); } while (0)
#define PG8_MMA(ai, bj, At, Bt) do { __builtin_amdgcn_s_setprio(1); _Pragma("unroll") for (int m = 0; m < 4; ++m) _Pragma("unroll") for (int n = 0; n < 2; ++n) _Pragma("unroll") for (int k = 0; k < 2; ++k) \
        acc[ai][bj][m][n] = __builtin_amdgcn_mfma_f32_16x16x32_bf16(Bt[n][k], At[m][k], acc[ai][bj][m][n], 0, 0, 0); __builtin_amdgcn_s_setprio(0); } while (0)
#define PG8_WAIT_V(n) asm volatile("s_waitcnt vmcnt(" #n ")" ::: "memory")
#define PG8_WAIT_L(n) asm volatile("s_waitcnt lgkmcnt(" #n ")" ::: "memory")
#define PG8_BAR __builtin_amdgcn_s_barrier()
#define PG8_SCHED __builtin_amdgcn_sched_barrier(0)
    Unit cur, nxt; int ui = 0;
    if (!S.next(0, cur)) return;
    f32x4 acc[2][2][4][2];
#pragma unroll
    for (int a = 0; a < 2; ++a)
#pragma unroll
        for (int b = 0; b < 2; ++b)
#pragma unroll
            for (int m = 0; m < 4; ++m)
#pragma unroll
                for (int n = 0; n < 2; ++n) acc[a][b][m][n] = (f32x4){0.f, 0.f, 0.f, 0.f};
    bf16x8 At[4][2], B0[2][2], B1[2][2];
    const char* cA = (const char*)g.A + (size_t)cur.pm * tstep; const char* cB = (const char*)g.Bt + (size_t)cur.pn * tstep;
    S.a_ready(cur);
    if constexpr (SP2) {
        PG8_STAGE(PG8_SB(0, 0), cB, voffB); PG8_STAGE(PG8_SB(0, 1), cB + hstep, voffB); PG8_STAGE(PG8_SA(0, 0), cA, voffA); PG8_STAGE(PG8_SA(0, 1), cA + hstep, voffA);
        if (wr == 1) PG8_BAR;
        PG8_WAIT_V(2); PG8_BAR;
        PG8_STAGE(PG8_SB(1, 0), cB + kstep, voffB); PG8_STAGE(PG8_SA(1, 0), cA + kstep, voffA); PG8_STAGE(PG8_SB(1, 1), cB + hstep + kstep, voffB);
        PG8_WAIT_V(6); PG8_BAR;
    } else {
        PG8_STAGE(PG8_SB(0, 0), cB, voffB); PG8_STAGE(PG8_SA(0, 0), cA, voffA); PG8_STAGE(PG8_SB(0, 1), cB + hstep, voffB); PG8_STAGE(PG8_SA(0, 1), cA + hstep, voffA);
        if (wr == 1) PG8_BAR;
        PG8_WAIT_V(4); PG8_BAR;
        PG8_STAGE(PG8_SB(1, 0), cB + kstep, voffB); PG8_STAGE(PG8_SA(1, 0), cA + kstep, voffA); PG8_STAGE(PG8_SB(1, 1), cB + hstep + kstep, voffB);
        PG8_WAIT_V(6); PG8_BAR;
    }
    for (;;) {
        const bool has_next = S.next(ui + 1, nxt);
        const char* nA = has_next ? (const char*)g.A + (size_t)nxt.pm * tstep : cA; const char* nB = has_next ? (const char*)g.Bt + (size_t)nxt.pn * tstep : cB;
        for (int t = 0; t < nt; t += 2) {
            const bool last = (t == nt - 2);
            const char* a1 = cA + (size_t)(t + 1) * kstep;
            const char* a2 = last ? nA : cA + (size_t)(t + 2) * kstep; const char* b2 = last ? nB : cB + (size_t)(t + 2) * kstep;
            const char* a3 = a2 + kstep; const char* b3 = b2 + kstep;
            if (last && has_next) S.a_ready(nxt);
            if constexpr (SP2) {
            PG8_LDB(B0, 0, 0); PG8_LDB(B1, 0, 1); PG8_SCHED; PG8_LDA(At, 0, 0); PG8_STAGE(PG8_SA(1, 1), a1 + hstep, voffA);
            PG8_WAIT_V(8); PG8_WAIT_L(0); PG8_BAR; PG8_MMA(0, 0, At, B0); PG8_MMA(0, 1, At, B1); PG8_BAR; PG8_SCHED;
            PG8_LDA(At, 0, 1); PG8_STAGE(PG8_SB(0, 0), b2, voffB); PG8_STAGE(PG8_SB(0, 1), b2 + hstep, voffB); PG8_STAGE(PG8_SA(0, 0), a2, voffA);
            PG8_WAIT_V(8); PG8_WAIT_L(0); PG8_BAR; PG8_MMA(1, 0, At, B0); PG8_MMA(1, 1, At, B1); PG8_BAR; PG8_SCHED;
            PG8_LDB(B0, 1, 0); PG8_LDB(B1, 1, 1); PG8_SCHED; PG8_LDA(At, 1, 0); PG8_STAGE(PG8_SA(0, 1), a2 + hstep, voffA);
            PG8_WAIT_V(8); PG8_WAIT_L(0); PG8_BAR; PG8_MMA(0, 0, At, B0); PG8_MMA(0, 1, At, B1); PG8_BAR; PG8_SCHED;
            PG8_LDA(At, 1, 1); PG8_STAGE(PG8_SB(1, 0), b3, voffB); PG8_STAGE(PG8_SB(1, 1), b3 + hstep, voffB); PG8_STAGE(PG8_SA(1, 0), a3, voffA);
            PG8_WAIT_V(8); PG8_WAIT_L(0); PG8_BAR; PG8_MMA(1, 0, At, B0); PG8_MMA(1, 1, At, B1); PG8_BAR; PG8_SCHED;
            } else {
            PG8_LDB(B0, 0, 0); PG8_SCHED; PG8_LDA(At, 0, 0); PG8_STAGE(PG8_SA(1, 1), a1 + hstep, voffA);
            PG8_WAIT_L(8); PG8_BAR; PG8_WAIT_L(0); PG8_MMA(0, 0, At, B0); PG8_BAR; PG8_SCHED;
            PG8_LDB(B1, 0, 1); PG8_STAGE(PG8_SB(0, 0), b2, voffB);
            PG8_BAR; PG8_WAIT_L(0); PG8_MMA(0, 1, At, B1); PG8_BAR;
            PG8_LDA(At, 0, 1); PG8_STAGE(PG8_SA(0, 0), a2, voffA);
            PG8_BAR; PG8_WAIT_L(0); PG8_MMA(1, 0, At, B0); PG8_BAR; PG8_SCHED;
            PG8_STAGE(PG8_SB(0, 1), b2 + hstep, voffB);
            PG8_WAIT_V(6); PG8_BAR; PG8_MMA(1, 1, At, B1); PG8_BAR;
            PG8_LDB(B0, 1, 0); PG8_SCHED; PG8_LDA(At, 1, 0); PG8_STAGE(PG8_SA(0, 1), a2 + hstep, voffA);
            PG8_WAIT_L(8); PG8_BAR; PG8_WAIT_L(0); PG8_MMA(0, 0, At, B0); PG8_BAR; PG8_SCHED;
            PG8_LDB(B1, 1, 1); PG8_STAGE(PG8_SB(1, 0), b3, voffB);
            PG8_BAR; PG8_WAIT_L(0); PG8_MMA(0, 1, At, B1); PG8_BAR;
            PG8_LDA(At, 1, 1); PG8_STAGE(PG8_SA(1, 0), a3, voffA);
            PG8_BAR; PG8_WAIT_L(0); PG8_MMA(1, 0, At, B0); PG8_BAR; PG8_SCHED;
            PG8_STAGE(PG8_SB(1, 1), b3 + hstep, voffB);
            PG8_WAIT_V(6); PG8_BAR; PG8_MMA(1, 1, At, B1); PG8_BAR;
            }
        }
        if constexpr (ALIGN_EPI) { if (wr == 0) PG8_BAR; }
        if constexpr (!Epi::AFTER_DRAIN) { E(acc, cur, wr, wc, fr, fq); S.done(cur); }
        if (!has_next) break;
#pragma unroll
        for (int a = 0; a < 2; ++a)
#pragma unroll
            for (int b = 0; b < 2; ++b)
#pragma unroll
                for (int m = 0; m < 4; ++m)
#pragma unroll
                    for (int n = 0; n < 2; ++n) acc[a][b][m][n] = (f32x4){0.f, 0.f, 0.f, 0.f};
        cur = nxt; cA = nA; cB = nB; ++ui;
        if constexpr (ALIGN_EPI) { if (wr == 1) PG8_BAR; }
    }
    PG8_WAIT_V(0);
    if constexpr (!ALIGN_EPI) { if (wr == 0) PG8_BAR; }
    PG8_BAR;
    if constexpr (Epi::AFTER_DRAIN) { E.fused(acc, cur, wr, wc, fr, fq, lds, wid, lane); S.done(cur); }
#undef PG8_SA
#undef PG8_SB
#undef PG8_STAGE
#undef PG8_LDA
#undef PG8_LDB
#undef PG8_MMA
#undef PG8_WAIT_V
#undef PG8_WAIT_L
#undef PG8_BAR
#undef PG8_SCHED
}
}

using pg8::sigmoid_f;
constexpr int NWAVES = 8, NTHR = 512;
constexpr int S = 8192, DM = 2048, DEPTH = 4, FF = 5632;
constexpr int NPROJ = 16896, NPROJ_PAD = 17152, LPROJ = 16976;
constexpr int PC_AQ = 0, PC_AK = 1024, PC_AV = 2048, PC_IQ = 3072, PC_MQ = 3584, PC_MK = 4096, PC_MV = 4608, PC_MO = 5632, PC_RQ = 6656, PC_RK = 7680, PC_RV = 8704, PC_RG = 9728, PC_G = 10752;
constexpr int LC_IK = 3584, LC_IW = 3648, LC_MI = 5704, LC_MF = 5708;
constexpr float NORM_EPS = 1e-6f;
constexpr size_t MiB = 1u << 20;
constexpr size_t WS_CTL = 0, CTL_ZERO_BYTES = 1 * MiB;
constexpr size_t WS_ROPE128 = 2 * MiB, WS_ROPE64 = 6 * MiB;
constexpr size_t WS_W = 16 * MiB, W_LAYER = 153 * MiB;
constexpr size_t WO_IN = 0, WO_B = 67 * MiB, WO_OUT = 79 * MiB, WO_FIN = 87 * MiB, WO_FOUT = 131 * MiB;
constexpr size_t WS_H = 640 * MiB, WS_PROJ = 672 * MiB, WS_SMALL = 936 * MiB, WS_MQK = 944 * MiB, WS_IKB = 960 * MiB, WS_IWF = 961 * MiB, WS_GIF = WS_IWF + 512 * 1024;
constexpr size_t WS_SC = 964 * MiB, WS_MB = 1220 * MiB, WS_DCM = 1228 * MiB, WS_CPM = 1260 * MiB, WS_MISC = 1292 * MiB, WS_DRR = 1294 * MiB, WS_RPR = 1310 * MiB;
constexpr size_t WS_YA = 1328 * MiB, WS_YM = 1344 * MiB, WS_YR = 1360 * MiB, WS_MERGEDF = 1376 * MiB, WS_MERGED = 1440 * MiB, WS_ACT = 1472 * MiB, WS_END = 1560 * MiB;
constexpr size_t MISC_DN = 0, MISC_NPREV = 256 * 1024, MISC_AB = 512 * 1024, MISC_MPREV = 520 * 1024;
constexpr int CW_BAR = 4096;
constexpr int LDS_BYTES = 147456, MISC_OFF = 147456 - 256;

#define GAS __attribute__((address_space(1)))
#define LAS __attribute__((address_space(3)))
typedef unsigned short bf16;
typedef unsigned v4u __attribute__((ext_vector_type(4)));
typedef unsigned v2u __attribute__((ext_vector_type(2)));
typedef float f32x4 __attribute__((ext_vector_type(4)));
typedef float f32x16 __attribute__((ext_vector_type(16)));
typedef short bf16x8 __attribute__((ext_vector_type(8)));
typedef short s16x4 __attribute__((ext_vector_type(4)));
#define LDS_WAIT() asm volatile("s_waitcnt lgkmcnt(0)" ::: "memory")
#define VM_WAIT() asm volatile("s_waitcnt vmcnt(0)" ::: "memory")
__device__ __forceinline__ unsigned f2bf(float f) { unsigned u = __builtin_bit_cast(unsigned, f); return (u + 0x7fffu + ((u >> 16) & 1u)) >> 16; }
__device__ __forceinline__ unsigned pk2(float lo, float hi) { return f2bf(lo) | (f2bf(hi) << 16); }
__device__ __forceinline__ float bf2f(bf16 b) { return __uint_as_float(((unsigned)b) << 16); }
__device__ __forceinline__ float wave_sum(float v) {
#pragma unroll
    for (int o = 1; o < 64; o <<= 1) v += __shfl_xor(v, o);
    return v;
}
__device__ __forceinline__ float wave_max(float v) {
#pragma unroll
    for (int o = 1; o < 64; o <<= 1) v = fmaxf(v, __shfl_xor(v, o));
    return v;
}
#define XB_TMO      128
#define XB_XCNT(j)  (256  + 64 * (j))
#define XB_XSUB(j)  (1280 + 64 * (j))
#define XB_XGEN(j)  (2304 + 64 * (j))
#define XB_TOP      3328
#define XB_TOPGEN   3392
#define XCD_BAR_WORDS 3456
#define XB_SPIN_CAP (1u << 18)

__device__ __forceinline__ unsigned xb_ld(unsigned* p)              { return __hip_atomic_load(p, __ATOMIC_RELAXED, __HIP_MEMORY_SCOPE_AGENT); }
__device__ __forceinline__ unsigned xb_add(unsigned* p, unsigned v) { return __hip_atomic_fetch_add(p, v, __ATOMIC_RELAXED, __HIP_MEMORY_SCOPE_AGENT); }
__device__ __forceinline__ unsigned xb_xcc_id() { return (unsigned)__builtin_amdgcn_s_getreg((3 << 11) | 20) & 0xFu; }
#define XB_SPIN(cond, bar) do { unsigned _sp = 0; while (cond) { __builtin_amdgcn_s_sleep(1); \
    if ((++_sp & 255u) == 0u) { if (xb_ld(&(bar)[XB_TMO])) break; if (_sp > XB_SPIN_CAP) { atomicAdd(&(bar)[XB_TMO], 1u); break; } } } } while (0)

struct XcdBarrier {
    unsigned* bar; unsigned x;
    volatile LAS unsigned* st;
};

__device__ __forceinline__ XcdBarrier xcd_barrier_post(unsigned* bar, volatile LAS unsigned* st) {
    XcdBarrier b; b.bar = bar; b.x = xb_xcc_id(); b.st = st;
    if (threadIdx.x == 0) (void)xb_add(&bar[XB_XCNT(b.x)], 1u);
    return b;
}
__device__ __forceinline__ void xcd_barrier_complete(unsigned* bar, unsigned x, unsigned& nloc, unsigned& nx) {
    const unsigned G = gridDim.x * gridDim.y * gridDim.z;
    unsigned sum, cnt, mine, sp = 0u;
    for (;;) {
        sum = 0u; cnt = 0u; mine = 0u;
#pragma unroll
        for (unsigned j = 0; j < 16; ++j) { const unsigned c = xb_ld(&bar[XB_XCNT(j)]); sum += c; cnt += (c > 0u) ? 1u : 0u; mine = (j == x) ? c : mine; }
        if (sum == G) break;
        __builtin_amdgcn_s_sleep(1);
        if ((++sp & 255u) == 0u) { if (xb_ld(&bar[XB_TMO])) break; if (sp > XB_SPIN_CAP) { atomicAdd(&bar[XB_TMO], 1u); break; } }
    }
    nloc = mine > 0u ? mine : 1u; nx = cnt > 0u ? cnt : 1u;
}

__device__ __forceinline__ void xcd_barrier(const XcdBarrier& b) {
    asm volatile("s_waitcnt vmcnt(0)" ::: "memory");
    __syncthreads();
    if (threadIdx.x == 0) {
        unsigned* bar = b.bar;
        __builtin_amdgcn_s_waitcnt(0);
        unsigned nloc = b.st[0], nx = b.st[1];
        if (nloc == 0u) { xcd_barrier_complete(bar, b.x, nloc, nx); b.st[0] = nloc; b.st[1] = nx; }
        const unsigned old = xb_add(&bar[XB_XSUB(b.x)], 1u);
        const unsigned gen = old / nloc;
        if (old + 1u == (gen + 1u) * nloc) {
            __builtin_amdgcn_fence(__ATOMIC_RELEASE, "agent");
            asm volatile("s_waitcnt vmcnt(0)" ::: "memory");
            const unsigned og = xb_add(&bar[XB_TOP], 1u);
            const unsigned tg = og / nx;
            if (og + 1u == (tg + 1u) * nx) xb_add(&bar[XB_TOPGEN], 1u);
            else XB_SPIN(xb_ld(&bar[XB_TOPGEN]) == tg, bar);
            __builtin_amdgcn_fence(__ATOMIC_ACQUIRE, "agent");
            xb_add(&bar[XB_XGEN(b.x)], 1u);
            asm volatile("s_waitcnt vmcnt(0)" ::: "memory");
        } else {
            XB_SPIN(xb_ld(&bar[XB_XGEN(b.x)]) == gen, bar);
            __builtin_amdgcn_fence(__ATOMIC_ACQUIRE, "agent");
            asm volatile("s_waitcnt vmcnt(0)" ::: "memory");
        }
    }
    __syncthreads();
}

struct MapIdent { __device__ __forceinline__ int operator()(int p) const { return p; } };
struct MapWin { __device__ __forceinline__ int operator()(int p) const {
    if (p < 3584) return p; if (p < 5632) return p + 72; if (p < NPROJ) return p + 80;
    const int r = p - NPROJ; if (r < 64) return LC_IK + r; if (r < 72) return LC_IW + (r - 64); if (r < 76) return LC_MI + (r - 72); if (r < 80) return LC_MF + (r - 76); return -1; } };
struct MapFfn { __device__ __forceinline__ int operator()(int p) const { const int t = p >> 8, r = p & 255; return r < 128 ? 128 * t + r : FF + 128 * t + (r - 128); } };
template <class Map> __device__ __forceinline__ void transpose_item(const float* W, int K, int N, bf16* WT, LAS float* scr, int item, int nblk, int lane, const Map& map) {
    const int kb = item / nblk, nb = item % nblk, k0 = 64 * kb, p0 = 32 * nb;
    const int nl = map(p0 + (lane & 31));
#pragma unroll 8
    for (int i = 0; i < 32; ++i) { const int kk = 2 * i + (lane >> 5); scr[kk * 33 + (lane & 31)] = nl >= 0 ? W[(size_t)(k0 + kk) * N + nl] : 0.f; }
    LDS_WAIT(); asm volatile("" ::: "memory");
    const int c = lane & 7;
#pragma unroll
    for (int j = 0; j < 4; ++j) { const int n = (lane >> 3) + 8 * j; const LAS float* s = scr + (8 * c) * 33 + n;
        v4u o; o.x = pk2(s[0 * 33], s[1 * 33]); o.y = pk2(s[2 * 33], s[3 * 33]); o.z = pk2(s[4 * 33], s[5 * 33]); o.w = pk2(s[6 * 33], s[7 * 33]);
        *(GAS v4u*)(WT + (size_t)(p0 + n) * K + k0 + 8 * c) = o; }
    LDS_WAIT(); asm volatile("" ::: "memory");
}
template <class Map> __device__ __forceinline__ void transpose_matrix(const float* W, int K, int N, int Nphys, bf16* WT, LAS float* scr, int gw, int ngw, int lane, const Map& map) {
    const int nblk = Nphys / 32, nit = (K / 64) * nblk;
    for (int it = gw; it < nit; it += ngw) transpose_item(W, K, N, WT, scr, it, nblk, lane, map);
}

__device__ __forceinline__ void rms_row_to_bf16(const float* xrow, const float* gain, bf16* orow, int lane) {
    const GAS f32x4* xr = (const GAS f32x4*)xrow + lane; const GAS f32x4* gr = (const GAS f32x4*)gain + lane;
    f32x4 v[8]; float s = 0.f;
#pragma unroll
    for (int j = 0; j < 8; ++j) { v[j] = xr[64 * j]; s += (v[j].x * v[j].x + v[j].y * v[j].y) + (v[j].z * v[j].z + v[j].w * v[j].w); }
    const float rstd = 1.0f / sqrtf(wave_sum(s) * (1.f / DM) + NORM_EPS);
    GAS unsigned long long* o8 = (GAS unsigned long long*)orow + lane;
#pragma unroll
    for (int j = 0; j < 8; ++j) { const f32x4 g = gr[64 * j]; o8[64 * j] = (unsigned long long)pk2(v[j].x * rstd * g.x, v[j].y * rstd * g.y) | ((unsigned long long)pk2(v[j].z * rstd * g.z, v[j].w * rstd * g.w) << 32); }
}

struct PPArgs { bf16* proj; const float* small; bf16* mqk; bf16* ikb; float* iwf; float* gif; const float* rope128; const float* rope64; const float* gq; const float* gk; const float* convw; const float* gbias; };
__device__ __forceinline__ void pp_row(const PPArgs& a, int t, int lane) {
    bf16* pr = a.proj + (size_t)t * NPROJ;
    const float2 cs = ((const float2*)a.rope128)[t * 64 + lane];
    const float2 c6 = ((const float2*)a.rope64)[t * 32 + (lane & 31)];
#pragma unroll 1
    for (int which = 0; which < 2; ++which) {
        const float* gn = which ? a.gk : a.gq; const float g1 = gn[lane], g2 = gn[64 + lane];
#pragma unroll 2
        for (int hh = 0; hh < 8; ++hh) { bf16* p = pr + (which ? PC_AK : PC_AQ) + hh * 128;
            const float x1 = bf2f(p[lane]), x2 = bf2f(p[64 + lane]);
            const float rstd = 1.0f / sqrtf(wave_sum(x1 * x1 + x2 * x2) * (1.f / 128.f) + NORM_EPS);
            const float y1 = x1 * rstd * g1, y2 = x2 * rstd * g2;
            p[lane] = (bf16)f2bf(y1 * cs.x - y2 * cs.y); p[64 + lane] = (bf16)f2bf(y2 * cs.x + y1 * cs.y); }
    }
#pragma unroll 1
    for (int which = 0; which < 2; ++which) {
#pragma unroll 2
        for (int hh = 0; hh < 8; ++hh) { bf16* p = pr + (which ? PC_RK : PC_RQ) + hh * 128;
            const float y1 = bf2f(p[lane]), y2 = bf2f(p[64 + lane]);
            p[lane] = (bf16)f2bf(y1 * cs.x - y2 * cs.y); p[64 + lane] = (bf16)f2bf(y2 * cs.x + y1 * cs.y); }
    }
#pragma unroll
    for (int p4 = 0; p4 < 4; ++p4) { bf16* p = pr + PC_IQ + (2 * p4 + (lane >> 5)) * 64; const int i = lane & 31;
        const float y1 = bf2f(p[i]), y2 = bf2f(p[32 + i]);
        p[i] = (bf16)f2bf(y1 * c6.x - y2 * c6.y); p[32 + i] = (bf16)f2bf(y2 * c6.x + y1 * c6.y); }
    const float* sm = a.small + (size_t)t * 256;
    if (lane < 32) { const float y1 = sm[lane], y2 = sm[32 + lane];
        a.ikb[(size_t)t * 64 + lane] = (bf16)f2bf(y1 * c6.x - y2 * c6.y); a.ikb[(size_t)t * 64 + 32 + lane] = (bf16)f2bf(y2 * c6.x + y1 * c6.y); }
    if (lane < 8) { a.iwf[(size_t)t * 8 + lane] = sm[64 + lane] * (0.35355339059327373f * 0.125f);
        a.gif[(size_t)t * 8 + lane] = sm[72 + lane] + a.gbias[lane]; }
#pragma unroll 4
    for (int i = 0; i < 16; ++i) { const int c = lane + 64 * i; float acc = 0.f;
#pragma unroll
        for (int j = 0; j < 4; ++j) { const int tt = t - 3 + j; if (tt >= 0) acc += a.convw[j * 1024 + c] * bf2f(a.proj[(size_t)tt * NPROJ + PC_MQ + c]); }
        a.mqk[(size_t)t * 1024 + c] = (bf16)f2bf(acc); }
}

__device__ __forceinline__ void score_wave_unit(const bf16* proj, const bf16* ikb, const float* iwf, float* sc, int qb, int kb, int lane) {
    const int r = lane & 31, h = lane >> 5, q = qb * 32 + r, s0 = kb * 128;
    bf16x8 ka[4][4];
#pragma unroll
    for (int b = 0; b < 4; ++b)
#pragma unroll
        for (int kk = 0; kk < 4; ++kk) ka[b][kk] = *(const bf16x8*)(ikb + (size_t)(s0 + 32 * b + r) * 64 + 16 * kk + 8 * h);
    f32x16 scv[4];
#pragma unroll
    for (int b = 0; b < 4; ++b)
#pragma unroll
        for (int e = 0; e < 16; ++e) scv[b][e] = 0.f;
#pragma unroll 1
    for (int j = 0; j < 8; ++j) {
        bf16x8 qf[4];
#pragma unroll
        for (int kk = 0; kk < 4; ++kk) qf[kk] = *(const bf16x8*)(proj + (size_t)q * NPROJ + PC_IQ + j * 64 + 16 * kk + 8 * h);
        const float wj = iwf[(size_t)q * 8 + j];
#pragma unroll
        for (int b = 0; b < 4; ++b) { f32x16 acc;
#pragma unroll
            for (int e = 0; e < 16; ++e) acc[e] = 0.f;
#pragma unroll
            for (int kk = 0; kk < 4; ++kk) acc = __builtin_amdgcn_mfma_f32_32x32x16_bf16(ka[b][kk], qf[kk], acc, 0, 0, 0);
#pragma unroll
            for (int e = 0; e < 16; ++e) scv[b][e] += wj * fmaxf(acc[e], 0.f); }
    }
#pragma unroll
    for (int b = 0; b < 4; ++b)
#pragma unroll
        for (int g = 0; g < 4; ++g) *(f32x4*)(sc + (size_t)q * S + s0 + 32 * b + 8 * g + 4 * h) = (f32x4){scv[b][4 * g], scv[b][4 * g + 1], scv[b][4 * g + 2], scv[b][4 * g + 3]};
}

template <int NREG> __device__ __forceinline__ void select_row(const float* scr, unsigned long long* mbr, int t, int lane) {
    unsigned u[NREG];
#pragma unroll
    for (int i = 0; i < NREG; ++i) { const int s = i * 64 + lane; unsigned k = 0u;
        if (s <= t) { const float v = scr[s] + 0.0f; const unsigned b = __float_as_uint(v); k = (b & 0x80000000u) ? ~b : (b | 0x80000000u); }
        u[i] = k; }
    unsigned prefix = 0u; bool exact = false;
#pragma unroll 1
    for (int bit = 31; bit >= 0; --bit) {
        const unsigned cand = prefix | (1u << bit); int c = 0;
#pragma unroll
        for (int i = 0; i < NREG; ++i) c += __builtin_popcountll(__builtin_amdgcn_ballot_w64(u[i] >= cand));
        if (c >= 256) prefix = cand;
        if (c == 256) { exact = true; break; }
    }
    int need = 0;
    if (!exact) { int cg = 0;
#pragma unroll
        for (int i = 0; i < NREG; ++i) cg += __builtin_popcountll(__builtin_amdgcn_ballot_w64(u[i] > prefix));
        need = 256 - cg; }
    unsigned long long w0 = 0ull, w1 = 0ull;
#pragma unroll
    for (int i = 0; i < NREG; ++i) {
        bool sel;
        if (exact) sel = u[i] >= prefix;
        else { const bool eq = u[i] == prefix; const unsigned long long em = __builtin_amdgcn_ballot_w64(eq);
            const int rank = __builtin_amdgcn_mbcnt_hi((unsigned)(em >> 32), __builtin_amdgcn_mbcnt_lo((unsigned)em, 0u));
            sel = (u[i] > prefix) || (eq && rank < need); need -= __builtin_popcountll(em); if (need < 0) need = 0; }
        const unsigned long long m = __builtin_amdgcn_ballot_w64(sel);
        if (lane == (i & 63)) { if (i < 64) w0 = m; else w1 = m; }
    }
    mbr[lane] = w0; mbr[64 + lane] = w1;
}
__device__ __forceinline__ void select_dispatch(const float* sc, unsigned long long* mb, int t, int lane) {
    const float* scr = sc + (size_t)t * S; unsigned long long* mbr = mb + (size_t)t * 128;
    if (t < 256) {
        const int j0 = lane, j1 = 64 + lane; unsigned long long w0 = 0ull, w1 = 0ull;
        const int full = (t + 1) >> 6, rem = (t + 1) & 63;
        if (j0 < full) w0 = ~0ull; else if (j0 == full && rem) w0 = (1ull << rem) - 1ull;
        (void)j1; mbr[lane] = w0; mbr[64 + lane] = w1; return; }
    if (t < 2048) select_row<32>(scr, mbr, t, lane);
    else if (t < 4096) select_row<64>(scr, mbr, t, lane);
    else if (t < 6144) select_row<96>(scr, mbr, t, lane);
    else select_row<128>(scr, mbr, t, lane);
}

template <int RS> __device__ __forceinline__ bf16x8 frag_row(const LAS unsigned char* base, int r0, int k0, int lane) {
    return *(const LAS bf16x8*)(base + (r0 + (lane & 15)) * RS + (k0 + 8 * (lane >> 4)) * 2);
}
template <int RS> __device__ __forceinline__ bf16x8 frag_tr(const LAS unsigned char* base, int k0, int c0, int lane) {
    const int g = lane >> 4, q = (lane & 15) >> 2, p = lane & 3;
    const unsigned a = (unsigned)(size_t)(base + (k0 + 8 * g + q) * RS + (c0 + 4 * p) * 2);
    s16x4 lo, hi;
    asm volatile("ds_read_b64_tr_b16 %0, %2\n\tds_read_b64_tr_b16 %1, %2 offset:%3\n\ts_waitcnt lgkmcnt(0)" : "=&v"(lo), "=&v"(hi) : "v"(a), "i"(4 * RS) : "memory");
    return (bf16x8){lo[0], lo[1], lo[2], lo[3], hi[0], hi[1], hi[2], hi[3]};
}
#define MFMA16(a, b, c) __builtin_amdgcn_mfma_f32_16x16x32_bf16((a), (b), (c), 0, 0, 0)
constexpr int SCR_OFF = 114688;
constexpr float DK_SCALE = 0.08838834764831845f;
__device__ __forceinline__ float log_sigmoid_f(float x) { return fminf(x, 0.f) - log1pf(expf(-fabsf(x))); }

template <int L, int DV> __device__ __forceinline__ void chunk_delta(LAS unsigned char* lds, const bf16* ksrc, int ldk, const bf16* vsrc, int ldv, const LAS float* wcol, bf16* outT, float* dn, int tid) {
    constexpr int RSK = (128 + 8) * 2, RSV = (DV + 8) * 2, NCB = DV / 128;
    LAS unsigned char* KA = lds; LAS unsigned char* V = lds + L * RSK;
    const int lane = tid & 63, w = tid >> 6;
    for (int idx = tid; idx < L * 16; idx += NTHR) { const int s = idx >> 4, c8 = idx & 15;
        const v4u x = *(const GAS v4u*)(ksrc + (size_t)s * ldk + c8 * 8); const float sc = DK_SCALE * wcol[s]; v4u o;
        o.x = pk2(__uint_as_float(x.x << 16) * sc, __uint_as_float(x.x & 0xffff0000u) * sc); o.y = pk2(__uint_as_float(x.y << 16) * sc, __uint_as_float(x.y & 0xffff0000u) * sc);
        o.z = pk2(__uint_as_float(x.z << 16) * sc, __uint_as_float(x.z & 0xffff0000u) * sc); o.w = pk2(__uint_as_float(x.w << 16) * sc, __uint_as_float(x.w & 0xffff0000u) * sc);
        *(LAS v4u*)(KA + s * RSK + c8 * 16) = o; }
    for (int idx = tid; idx < L * (DV / 8); idx += NTHR) { const int s = idx / (DV / 8), c8 = idx % (DV / 8);
        *(LAS v4u*)(V + s * RSV + c8 * 16) = *(const GAS v4u*)(vsrc + (size_t)s * ldv + c8 * 8); }
    __syncthreads();
    f32x4 acc[8][NCB];
#pragma unroll
    for (int db = 0; db < 8; ++db)
#pragma unroll
        for (int i = 0; i < NCB; ++i) acc[db][i] = (f32x4){0.f, 0.f, 0.f, 0.f};
#pragma unroll
    for (int kk = 0; kk < L / 32; ++kk) {
        bf16x8 bfr[NCB];
#pragma unroll
        for (int i = 0; i < NCB; ++i) bfr[i] = frag_tr<RSV>(V, 32 * kk, 16 * (w * NCB + i), lane);
#pragma unroll
        for (int db = 0; db < 8; ++db) { const bf16x8 a = frag_tr<RSK>(KA, 32 * kk, 16 * db, lane);
#pragma unroll
            for (int i = 0; i < NCB; ++i) acc[db][i] = MFMA16(a, bfr[i], acc[db][i]); }
    }
#pragma unroll
    for (int db = 0; db < 8; ++db)
#pragma unroll
        for (int i = 0; i < NCB; ++i) { const int e = 16 * (w * NCB + i) + (lane & 15), d0 = 16 * db + 4 * (lane >> 4);
            v2u o; o.x = pk2(acc[db][i][0], acc[db][i][1]); o.y = pk2(acc[db][i][2], acc[db][i][3]);
            *(GAS v2u*)(outT + (size_t)e * 128 + d0) = o; }
    if (dn != nullptr && tid < 128) { float s_ = 0.f;
        for (int s = 0; s < L; ++s) s_ += bf2f(*(const LAS bf16*)(KA + s * RSK + tid * 2));
        dn[tid] = s_; }
    __syncthreads();
}

template <int L, int DV, int MODE> __device__ __forceinline__ void chunk_out(LAS unsigned char* lds, LAS float* sf, const bf16* qsrc, int ldq, const bf16* ksrc, int ldk, const bf16* vsrc, int ldv,
                                                                              const bf16* stT, const float* gain, const bf16* gate, int ldg, bf16* y, int ldy, int tid) {
    constexpr int RSQ = (128 + 8) * 2, RSV = (DV + 8) * 2, RSP = (L + 8) * 2, NCB = DV / 128, NT = L / 16, TPW = NT * NT / 8;
    LAS unsigned char* Q = lds; LAS unsigned char* K = lds + L * RSQ; LAS unsigned char* V = lds + 2 * L * RSQ;
    LAS unsigned char* P = (MODE == 0) ? (lds + 2 * L * RSQ + L * RSV) : K;
    LAS float* H = (LAS float*)lds;
    LAS float* lrow = sf; LAS float* lcol = sf + 128; LAS float* qs = sf + 256; LAS float* flo = sf + 384; LAS float* rowsum = sf + 512; LAS float* npv = sf + 640; LAS float* part = sf + 768; LAS float* dpart = sf + 768 + L * NT;
    const int lane = tid & 63, w = tid >> 6, g4 = lane >> 4, c16 = lane & 15;
    for (int idx = tid; idx < L * 16; idx += NTHR) { const int s = idx >> 4, c8 = idx & 15;
        *(LAS v4u*)(Q + s * RSQ + c8 * 16) = *(const GAS v4u*)(qsrc + (size_t)s * ldq + c8 * 8);
        *(LAS v4u*)(K + s * RSQ + c8 * 16) = *(const GAS v4u*)(ksrc + (size_t)s * ldk + c8 * 8); }
    for (int idx = tid; idx < L * (DV / 8); idx += NTHR) { const int s = idx / (DV / 8), c8 = idx % (DV / 8);
        *(LAS v4u*)(V + s * RSV + c8 * 16) = *(const GAS v4u*)(vsrc + (size_t)s * ldv + c8 * 8); }
    __syncthreads();
    f32x4 pv[TPW];
#pragma unroll
    for (int i = 0; i < TPW; ++i) { const int ti = w * TPW + i, rb = ti / NT, cb = ti % NT; f32x4 a = (f32x4){0.f, 0.f, 0.f, 0.f};
        if (cb <= rb) {
#pragma unroll
            for (int kk = 0; kk < 4; ++kk) a = MFMA16(frag_row<RSQ>(Q, 16 * rb, 32 * kk, lane), frag_row<RSQ>(K, 16 * cb, 32 * kk, lane), a);
            const int s = 16 * cb + c16; const float lc = lcol[s]; float rs[4];
#pragma unroll
            for (int r = 0; r < 4; ++r) { const int t = 16 * rb + 4 * g4 + r; const float pw = (s <= t) ? __expf(lrow[t] + lc) * a[r] * DK_SCALE : 0.f; a[r] = pw; rs[r] = pw; }
            if (MODE == 0) {
#pragma unroll
                for (int r = 0; r < 4; ++r) { float v = rs[r]; v += __shfl_xor(v, 1); v += __shfl_xor(v, 2); v += __shfl_xor(v, 4); v += __shfl_xor(v, 8);
                    if (c16 == 0) part[(16 * rb + 4 * g4 + r) * NT + cb] = v; } }
        } else if (MODE == 0) { if (c16 == 0) {
#pragma unroll
                for (int r = 0; r < 4; ++r) part[(16 * rb + 4 * g4 + r) * NT + cb] = 0.f; } }
        pv[i] = a; }
    __syncthreads();
#pragma unroll
    for (int i = 0; i < TPW; ++i) { const int ti = w * TPW + i, rb = ti / NT, cb = ti % NT;
#pragma unroll
        for (int r = 0; r < 4; ++r) *(LAS bf16*)(P + (16 * rb + 4 * g4 + r) * RSP + (16 * cb + c16) * 2) = (bf16)f2bf(pv[i][r]); }
    for (int idx = tid; idx < L * 16; idx += NTHR) { const int s = idx >> 4, c8 = idx & 15; const float sc = qs[s];
        const v4u x = *(const LAS v4u*)(Q + s * RSQ + c8 * 16); float f[8];
        f[0] = __uint_as_float(x.x << 16) * sc; f[1] = __uint_as_float(x.x & 0xffff0000u) * sc; f[2] = __uint_as_float(x.y << 16) * sc; f[3] = __uint_as_float(x.y & 0xffff0000u) * sc;
        f[4] = __uint_as_float(x.z << 16) * sc; f[5] = __uint_as_float(x.z & 0xffff0000u) * sc; f[6] = __uint_as_float(x.w << 16) * sc; f[7] = __uint_as_float(x.w & 0xffff0000u) * sc;
        v4u o; o.x = pk2(f[0], f[1]); o.y = pk2(f[2], f[3]); o.z = pk2(f[4], f[5]); o.w = pk2(f[6], f[7]);
        *(LAS v4u*)(Q + s * RSQ + c8 * 16) = o;
        if (MODE == 0) { float dsum = 0.f;
#pragma unroll
            for (int j = 0; j < 8; ++j) dsum += f[j] * npv[8 * c8 + j];
            dpart[s * 16 + c8] = dsum; } }
    __syncthreads();
    if (MODE == 0 && tid < L) { float a = 0.f;
#pragma unroll
        for (int j = 0; j < NT; ++j) a += part[tid * NT + j];
#pragma unroll
        for (int j = 0; j < 16; ++j) a += dpart[tid * 16 + j];
        rowsum[tid] = a; }
    f32x4 acc[NT][NCB];
#pragma unroll
    for (int rb = 0; rb < NT; ++rb)
#pragma unroll
        for (int i = 0; i < NCB; ++i) acc[rb][i] = (f32x4){0.f, 0.f, 0.f, 0.f};
#pragma unroll
    for (int kk = 0; kk < 4; ++kk) { bf16x8 bfr[NCB];
#pragma unroll
        for (int i = 0; i < NCB; ++i) bfr[i] = *(const GAS bf16x8*)(stT + (size_t)(16 * (w * NCB + i) + c16) * 128 + 32 * kk + 8 * g4);
#pragma unroll
        for (int rb = 0; rb < NT; ++rb) { const bf16x8 a = frag_row<RSQ>(Q, 16 * rb, 32 * kk, lane);
#pragma unroll
            for (int i = 0; i < NCB; ++i) acc[rb][i] = MFMA16(a, bfr[i], acc[rb][i]); } }
#pragma unroll
    for (int kk = 0; kk < L / 32; ++kk) { bf16x8 bfr[NCB];
#pragma unroll
        for (int i = 0; i < NCB; ++i) bfr[i] = frag_tr<RSV>(V, 32 * kk, 16 * (w * NCB + i), lane);
#pragma unroll
        for (int rb = 0; rb < NT; ++rb) { const bf16x8 a = frag_row<RSP>(P, 16 * rb, 32 * kk, lane);
#pragma unroll
            for (int i = 0; i < NCB; ++i) acc[rb][i] = MFMA16(a, bfr[i], acc[rb][i]); } }
    __syncthreads();
#pragma unroll
    for (int rb = 0; rb < NT; ++rb)
#pragma unroll
        for (int i = 0; i < NCB; ++i)
#pragma unroll
            for (int r = 0; r < 4; ++r) { const int t = 16 * rb + 4 * g4 + r, e = 16 * (w * NCB + i) + c16; float hv = acc[rb][i][r];
                if (MODE == 0) hv = hv / fmaxf(fabsf(rowsum[t]), flo[t]);
                H[t * DV + e] = hv; }
    __syncthreads();
    for (int t = w; t < L; t += NWAVES) { float hv[DV / 64]; float s1 = 0.f;
#pragma unroll
        for (int i = 0; i < DV / 64; ++i) { hv[i] = H[t * DV + lane + 64 * i]; s1 += hv[i]; }
        float mu = 0.f; if (MODE == 1) { mu = wave_sum(s1) * (1.f / DV); }
        float s2 = 0.f;
#pragma unroll
        for (int i = 0; i < DV / 64; ++i) { hv[i] -= mu; s2 += hv[i] * hv[i]; }
        const float rstd = 1.0f / sqrtf(wave_sum(s2) * (1.f / DV) + NORM_EPS);
#pragma unroll
        for (int i = 0; i < DV / 64; ++i) { const int e = lane + 64 * i; const float gt = bf2f(gate[(size_t)t * ldg + e]);
            const float act = (MODE == 0) ? sigmoid_f(gt) : gt * sigmoid_f(gt);
            y[(size_t)t * ldy + e] = (bf16)f2bf(hv[i] * rstd * gain[e] * act); } }
    __syncthreads();
}
namespace att {
constexpr int D = 128, LDQKV = NPROJ, LDO = 1024;
constexpr float THR = 8.f; constexpr bool WSKIP = false;
constexpr float SCALE = 0.08838834764831845f;
constexpr int NW = 8, QBLK = 32, KVBLK = 64, QB = NW * QBLK;
constexpr int SHM_V = KVBLK * D * 2, SHM_K = KVBLK * D * 2;
constexpr int LDS_BYTES = 2 * SHM_V + 2 * SHM_K + NW * 64 * 4;

using bf16 = unsigned short;
typedef short bf16x8 __attribute__((ext_vector_type(8)));
typedef short s16x4 __attribute__((ext_vector_type(4)));
typedef float f32x16 __attribute__((ext_vector_type(16)));
typedef float f32x4 __attribute__((ext_vector_type(4)));
typedef unsigned u32x4 __attribute__((ext_vector_type(4)));
template <class A, class Bt> struct same_t { static constexpr bool v = false; };
template <class A> struct same_t<A, A> { static constexpr bool v = true; };

#define KSWZ(row, colB) ((row) * 256 + ((colB) ^ (((row) & 7) << 4)))
#define SBAR() __builtin_amdgcn_sched_barrier(0)
__device__ __forceinline__ int v_st(int k, int c) { const int kk = (k & ~0xC) | ((k & 4) << 1) | ((k & 8) >> 1); return ((kk >> 3) * 4 + (c >> 5)) * 512 + ((kk & 7) * 32 + (c & 31)) * 2; }
__device__ __forceinline__ int v_rd_base(int lane) { return ((lane & 3) << 3) | (((lane >> 2) & 3) << 6) | (((lane >> 4) & 1) << 5) | (((lane >> 5) & 1) << 8); }
constexpr int v_rd_off(int d0, int ks, int half) { return d0 * 512 + ks * 4096 + half * 2048; }
__device__ __forceinline__ int crow(int r, int hi) { return (r & 3) + 8 * (r >> 2) + 4 * hi; }
__device__ __forceinline__ unsigned cvtpk(float lo, float hi) {
    unsigned r; asm volatile("v_cvt_pk_bf16_f32 %0, %1, %2" : "=v"(r) : "v"(lo), "v"(hi)); return r;
}
__device__ __forceinline__ bf16x8 pack8(f32x4 a, f32x4 b) {
    u32x4 w = {cvtpk(a[0], a[1]), cvtpk(a[2], a[3]), cvtpk(b[0], b[1]), cvtpk(b[2], b[3])};
    return *reinterpret_cast<bf16x8*>(&w);
}
template <class T> __device__ __forceinline__ bf16x8 load8(const T* p) {
    if constexpr (same_t<T, float>::v) { return pack8(*(const f32x4*)p, *(const f32x4*)(p + 4)); }
    else { return *reinterpret_cast<const bf16x8*>(p); }
}
__device__ __forceinline__ void mask_bits(f32x16& p0, f32x16& p1, unsigned long long mw, int hi) {
    const unsigned a = (unsigned)mw >> (4 * hi), b = (unsigned)(mw >> 32) >> (4 * hi);
#pragma unroll
    for (int r = 0; r < 16; ++r) {
        const int c = (r & 3) + 8 * (r >> 2);
        const unsigned ma = (unsigned)(((int)(a << (31 - c))) >> 31), mb = (unsigned)(((int)(b << (31 - c))) >> 31);
        p0[r] = __uint_as_float((__float_as_uint(p0[r]) & ma) | (0xff800000u & ~ma));
        p1[r] = __uint_as_float((__float_as_uint(p1[r]) & mb) | (0xff800000u & ~mb));
    }
}
__device__ __forceinline__ void partialSM(f32x16& p0, f32x16& p1, float& m_reg, float& mn, float& alpha) {
    float pmax = p0[0]; for (int r = 1; r < 16; ++r) pmax = fmaxf(pmax, p0[r]); for (int r = 0; r < 16; ++r) pmax = fmaxf(pmax, p1[r]);
    { auto rr = __builtin_amdgcn_permlane32_swap(__float_as_uint(pmax), __float_as_uint(pmax), false, false);
      pmax = fmaxf(__uint_as_float(rr[0]), __uint_as_float(rr[1])); }
    constexpr float C2 = 1.4426950408889634f * SCALE;
    if (__builtin_expect(__all((pmax - m_reg) * SCALE <= THR), 1)) { mn = m_reg; alpha = 1.f; }
    else { mn = fmaxf(m_reg, pmax); alpha = __builtin_amdgcn_exp2f((m_reg - mn) * C2); m_reg = mn; }
    const float mnL = -mn * C2;
    for (int r = 0; r < 16; ++r) p0[r] = fmaf(p0[r], C2, mnL); for (int r = 0; r < 16; ++r) p1[r] = fmaf(p1[r], C2, mnL);
    for (int r = 0; r < 16; ++r) p0[r] = __builtin_amdgcn_exp2f(p0[r]);
}
__device__ __forceinline__ void finishSM(f32x16& p0, f32x16& p1, float alpha, float& l_reg, bf16x8& pa0, bf16x8& pa1, bf16x8& pa2, bf16x8& pa3) {
    for (int r = 0; r < 16; ++r) p1[r] = __builtin_amdgcn_exp2f(p1[r]);
    float ps = 0; for (int r = 0; r < 16; ++r) ps += p0[r]; for (int r = 0; r < 16; ++r) ps += p1[r];
    { auto rr = __builtin_amdgcn_permlane32_swap(__float_as_uint(ps), __float_as_uint(ps), false, false);
      ps = __uint_as_float(rr[0]) + __uint_as_float(rr[1]); }
    l_reg = l_reg * alpha + ps;
#define PK4(P, B_, OUT) do { unsigned a0 = cvtpk(P[B_+0], P[B_+1]), a1 = cvtpk(P[B_+2], P[B_+3]);                          \
        unsigned b0 = cvtpk(P[B_+4], P[B_+5]), b1 = cvtpk(P[B_+6], P[B_+7]);                                             \
        auto r0 = __builtin_amdgcn_permlane32_swap(a0, b0, false, false); auto r1 = __builtin_amdgcn_permlane32_swap(a1, b1, false, false); \
        u32x4 w = {r0[0], r1[0], r0[1], r1[1]}; OUT = *reinterpret_cast<bf16x8*>(&w); } while (0)
    PK4(p0, 0, pa0); PK4(p0, 8, pa1); PK4(p1, 0, pa2); PK4(p1, 8, pa3);
#undef PK4
}
template <int KB, bool SK>
__device__ __forceinline__ void qkt(f32x16& p0, f32x16& p1, const char* K_lds, int r32, int hi, const bf16x8* qr, bool act) {
    if (SK && !act) { const float NEG = -__builtin_inff();
#pragma unroll
        for (int r = 0; r < 16; ++r) { p0[r] = NEG; p1[r] = NEG; } return; }
    p0 = f32x16{}; p1 = f32x16{};
    const char* kb[4];
#pragma unroll
    for (int dd = 0; dd < 4; ++dd) kb[dd] = K_lds + KB * SHM_K + KSWZ(r32, (dd * 16 + hi * 8) * 2);
#pragma unroll
    for (int d0 = 0; d0 < 8; ++d0) { const char* a = kb[d0 & 3] + (d0 >> 2) * 128;
        bf16x8 b0 = *reinterpret_cast<const bf16x8*>(a);
        bf16x8 b1 = *reinterpret_cast<const bf16x8*>(a + 32 * 256);
        p0 = __builtin_amdgcn_mfma_f32_32x32x16_bf16(b0, qr[d0], p0, 0, 0, 0);
        p1 = __builtin_amdgcn_mfma_f32_32x32x16_bf16(b1, qr[d0], p1, 0, 0, 0); }
}
template <int VB, bool SK>
__device__ __forceinline__ void pv_tile(f32x16* o, int vb0, bf16x8 pa0, bf16x8 pa1, bf16x8 pa2, bf16x8 pa3, bool act) {
    if (SK && !act) return;
#define TRRD(dst, off) asm volatile("ds_read_b64_tr_b16 %0, %1 offset:%2" : "=&v"(dst) : "v"(vb0), "i"(off) : "memory")
#define PV_D0(d0) do { s16x4 l0, l1, l2, l3, h0, h1, h2, h3; constexpr int b_ = VB * SHM_V + v_rd_off(d0, 0, 0);     \
        TRRD(l0, b_); TRRD(h0, b_ + 2048); TRRD(l1, b_ + 4096); TRRD(h1, b_ + 6144); TRRD(l2, b_ + 8192); TRRD(h2, b_ + 10240); TRRD(l3, b_ + 12288); TRRD(h3, b_ + 14336); \
        asm volatile("s_waitcnt lgkmcnt(0)" ::: "memory"); SBAR();                 \
        o[d0] = __builtin_amdgcn_mfma_f32_32x32x16_bf16(pa0, (bf16x8){l0[0], l0[1], l0[2], l0[3], h0[0], h0[1], h0[2], h0[3]}, o[d0], 0, 0, 0);   \
        o[d0] = __builtin_amdgcn_mfma_f32_32x32x16_bf16(pa1, (bf16x8){l1[0], l1[1], l1[2], l1[3], h1[0], h1[1], h1[2], h1[3]}, o[d0], 0, 0, 0);   \
        o[d0] = __builtin_amdgcn_mfma_f32_32x32x16_bf16(pa2, (bf16x8){l2[0], l2[1], l2[2], l2[3], h2[0], h2[1], h2[2], h2[3]}, o[d0], 0, 0, 0);   \
        o[d0] = __builtin_amdgcn_mfma_f32_32x32x16_bf16(pa3, (bf16x8){l3[0], l3[1], l3[2], l3[3], h3[0], h3[1], h3[2], h3[3]}, o[d0], 0, 0, 0); } while (0)
    PV_D0(0); PV_D0(1); PV_D0(2); PV_D0(3);
#undef PV_D0
#undef TRRD
}

template <class TIn, class TOut> struct BlockRef { const TIn* Q; const TIn* K; const TIn* V; TOut* O; const unsigned long long* M; int P0; };
template <class TIn> struct Seam {
    bf16x8 qr[8];
    bf16x8 st_v0, st_v1, st_k0, st_k1; f32x4 sf0, sf1, sf2, sf3;
    f32x4 tq[16];
};
__device__ __forceinline__ int swa_jlo(int P0, int W) { const int lowk = P0 - W + 1; return lowk > 0 ? lowk / KVBLK : 0; }
#define ROW(p, k0, rr) ((p) + (size_t)((k0) + (rr)) * LDQKV + sc)
#define VMW() asm volatile("s_waitcnt vmcnt(0)" ::: "memory")
#define VMWN(n) asm volatile("s_waitcnt vmcnt(%0)" :: "i"(n) : "memory")
#define LD16U(base, off) (*reinterpret_cast<const bf16x8*>((const char*)(base) + (off)))
#define SLOAD_H(Kp, Vp, k0) do { const char* kb_ = (const char*)((Kp) + (size_t)(k0) * LDQKV); const char* vb_ = (const char*)((Vp) + (size_t)(k0) * LDQKV);                 \
                         S.st_v0 = LD16U(vb_, soff); S.st_v1 = LD16U(vb_ + (size_t)32 * LDQKV * 2, soff);                                  \
                         S.st_k0 = LD16U(kb_, soff); S.st_k1 = LD16U(kb_ + (size_t)32 * LDQKV * 2, soff); } while (0)
#define SWRITE_HK(bf) do { *(bf16x8*)(K_lds + (bf) * SHM_K + kws) = S.st_k0; *(bf16x8*)(K_lds + (bf) * SHM_K + kws + 32 * 256) = S.st_k1; } while (0)
#define SWRITE_HV(bf) do { *(bf16x8*)(V_lds + (bf) * SHM_V + vst0) = S.st_v0; *(bf16x8*)(V_lds + (bf) * SHM_V + vst1) = S.st_v1; } while (0)
#define SWRITE_H(bf) do { SWRITE_HV(bf); SWRITE_HK(bf); } while (0)
#define SLOAD_F(p, k0) do { S.sf0 = *(const f32x4*)ROW(p, k0, sr); S.sf1 = *(const f32x4*)(ROW(p, k0, sr) + 4);                \
                            S.sf2 = *(const f32x4*)ROW(p, k0, 32 + sr); S.sf3 = *(const f32x4*)(ROW(p, k0, 32 + sr) + 4); } while (0)
#define SWRITE_KF(bf) do { *(bf16x8*)(K_lds + (bf) * SHM_K + kws) = pack8(S.sf0, S.sf1); *(bf16x8*)(K_lds + (bf) * SHM_K + kws + 32 * 256) = pack8(S.sf2, S.sf3); } while (0)
#define SWRITE_VF(bf) do { *(bf16x8*)(V_lds + (bf) * SHM_V + vst0) = pack8(S.sf0, S.sf1); *(bf16x8*)(V_lds + (bf) * SHM_V + vst1) = pack8(S.sf2, S.sf3); } while (0)
template <class TIn, class TOut>
__device__ __forceinline__ void causal_swa_prime(const BlockRef<TIn, TOut>& cur, int W, char* lds, Seam<TIn>& S) {
    constexpr bool F32 = same_t<TIn, float>::v;
    const int tid = threadIdx.x, wid = __builtin_amdgcn_readfirstlane(tid >> 6), lane = tid & 63, r32 = lane & 31, hi = lane >> 5;
    const int sr = tid >> 4, sc = (tid & 15) * 8, kws = KSWZ(sr, sc * 2); char* K_lds = lds + 2 * SHM_V; const unsigned soff = (unsigned)(sr * LDQKV + sc) * 2u;
    const int kb0 = swa_jlo(cur.P0, W) * KVBLK;
    for (int d0 = 0; d0 < 8; ++d0) S.qr[d0] = load8<TIn>(cur.Q + (size_t)(wid * QBLK + r32) * LDQKV + d0 * 16 + hi * 8);
    if constexpr (F32) { SLOAD_F((const float*)cur.K, kb0); VMW(); SWRITE_KF(0); SBAR(); SLOAD_F((const float*)cur.V, kb0); }
    else { SLOAD_H(cur.K, cur.V, kb0); VMW(); SWRITE_HK(0); }
    __syncthreads();
}
template <class TIn, class TOut>
__device__ __forceinline__ void causal_swa_block(const BlockRef<TIn, TOut>& cur, const BlockRef<TIn, TOut>& nxt, int skv, int W, char* lds, Seam<TIn>& S) {
    constexpr bool F32 = same_t<TIn, float>::v;
    const int tid = threadIdx.x, wid = __builtin_amdgcn_readfirstlane(tid >> 6), lane = tid & 63, r32 = lane & 31, hi = lane >> 5;
    const int j_lo = swa_jlo(cur.P0, W);
    int j_hi = (cur.P0 + QB - 1) / KVBLK + 1; if (j_hi > skv / KVBLK) j_hi = skv / KVBLK;
    const int NT = j_hi - j_lo;
    const int kbn = swa_jlo(nxt.P0, W) * KVBLK;
    const int qlo = cur.P0 + wid * QBLK, qm = qlo + r32 - 4 * hi;
    char* V_lds = lds; char* K_lds = lds + 2 * SHM_V;
    const unsigned mlane = (unsigned)(wid * QBLK + r32) * 1024u;
    float* ws = (float*)(lds + 2 * SHM_V + 2 * SHM_K) + wid * 64; float* li_l = ws, * al_l = ws + 32;
    float m_reg = -1e30f, l_reg = 0; f32x16 o[4] = {};
    const unsigned soff = (unsigned)((tid >> 4) * LDQKV + (tid & 15) * 8) * 2u;
    const int sr = tid >> 4, sc = (tid & 15) * 8, vst0 = v_st(sr, sc), vst1 = v_st(32 + sr, sc), kws = KSWZ(sr, sc * 2);
    const int vb0 = (int)(uintptr_t)V_lds + v_rd_base(lane);
    const TIn* Kh = cur.K; const TIn* Vh = cur.V;
#define RESC(a) do { if (__any((a) < 1.f)) { if (hi == 0) al_l[r32] = (a); asm volatile("s_waitcnt lgkmcnt(0)" ::: "memory");              \
                     for (int d_ = 0; d_ < 4; ++d_) for (int r = 0; r < 16; ++r) o[d_][r] *= al_l[crow(r, hi)]; } } while (0)
#define KBASE(t) ((j_lo + (t)) * KVBLK)
#define ACT(t) (KBASE(t) <= qlo + QBLK - 1 && KBASE(t) + KVBLK - 1 >= qlo - W + 1)
#define MASKT(P0_, P1_, mw_) mask_bits(P0_, P1_, mw_, hi)
#define MLOAD(t) (*(const unsigned long long*)((const char*)cur.M + (size_t)((j_lo + (t)) * 8) + mlane))
    constexpr int NQL = F32 ? 16 : 8;
    constexpr bool SK = WSKIP && !F32;
#define SEAM_K0() do { VMWN(NQL); if constexpr (F32) { SWRITE_KF(0); SBAR(); SLOAD_F((const float*)nxt.V, kbn); } else { SWRITE_HK(0); } SBAR(); } while (0)
    f32x16 pA0, pA1, pB0, pB1; float mnA, mnB, alA, alB; bf16x8 pa0, pa1, pa2, pa3;
    if constexpr (F32) { VMW(); SWRITE_VF(0); SBAR(); } else { SWRITE_HV(0); SBAR(); }
    if (NT > 1) { if constexpr (F32) SLOAD_F((const float*)Kh, KBASE(1)); else SLOAD_H(Kh, Vh, KBASE(1)); }
    SBAR(); qkt<0, SK>(pA0, pA1, K_lds, r32, hi, S.qr, ACT(0));
    if constexpr (F32) { if (NT > 1) { VMW(); SWRITE_KF(1); SBAR(); SLOAD_F((const float*)Vh, KBASE(1)); } }
    MASKT(pA0, pA1, MLOAD(0)); partialSM(pA0, pA1, m_reg, mnA, alA);
    if (NT > 1) { VMW(); if constexpr (F32) { SWRITE_VF(1); SBAR(); if (NT > 2) SLOAD_F((const float*)Kh, KBASE(2)); } else SWRITE_H(1); }
    __syncthreads();
#define HALF_STEP(PX0, PX1, mnX, alX, PY0, PY1, alY, t, KB, VB, SB) do {                                                      \
        SBAR(); qkt<KB, SK>(PX0, PX1, K_lds, r32, hi, S.qr, ACT(t));                                             \
        finishSM(PY0, PY1, alY, l_reg, pa0, pa1, pa2, pa3); SBAR();                                                           \
        if ((t) + 1 < NT) { if constexpr (F32) { VMW(); SWRITE_KF(SB); SBAR(); SLOAD_F((const float*)Vh, KBASE((t) + 1)); }  \
                            else { SLOAD_H(Kh, Vh, KBASE((t) + 1)); } SBAR(); }                                               \
        pv_tile<VB, SK>(o, vb0, pa0, pa1, pa2, pa3, ACT((t) - 1)); MASKT(PX0, PX1, MLOAD(t)); partialSM(PX0, PX1, m_reg, mnX, alX);                                        \
        __syncthreads();                                                                                                      \
        if ((t) + 1 < NT) { VMW(); if constexpr (F32) { SWRITE_VF(SB); SBAR(); if ((t) + 2 < NT) SLOAD_F((const float*)Kh, KBASE((t) + 2)); } \
                            else { SWRITE_H(SB); } }                                                                          \
        RESC(alX); __syncthreads(); } while (0)
    for (int t = 1; t + 1 < NT; t += 2) {
        HALF_STEP(pB0, pB1, mnB, alB, pA0, pA1, alA, t, 1, 0, 0);
        HALF_STEP(pA0, pA1, mnA, alA, pB0, pB1, alB, t + 1, 0, 1, 1);
    }
    const bool even = (NT & 1) == 0;
    if (even) { SBAR(); qkt<1, SK>(pB0, pB1, K_lds, r32, hi, S.qr, ACT(NT - 1)); SBAR(); }
#define QROW(e) (nxt.Q + (size_t)(wid * QBLK + r32) * LDQKV + ((e) >> 1) * 16 + hi * 8 + ((e) & 1) * 4)
    if constexpr (F32) { SLOAD_F((const float*)nxt.K, kbn); SBAR();
#pragma unroll
        for (int e = 0; e < 8; ++e) S.tq[e] = *(const f32x4*)QROW(e); }
    else { SLOAD_H(nxt.K, nxt.V, kbn); SBAR();
#pragma unroll
        for (int d0 = 0; d0 < 8; ++d0) S.qr[d0] = load8<TIn>(nxt.Q + (size_t)(wid * QBLK + r32) * LDQKV + d0 * 16 + hi * 8); }
    SBAR();
    finishSM(pA0, pA1, alA, l_reg, pa0, pa1, pa2, pa3); SBAR();
    if constexpr (F32) {
#pragma unroll
        for (int e = 8; e < 16; ++e) S.tq[e] = *(const f32x4*)QROW(e); SBAR(); }
#undef QROW
    pv_tile<0, SK>(o, vb0, pa0, pa1, pa2, pa3, ACT(even ? NT - 2 : NT - 1));
    if (even) { MASKT(pB0, pB1, MLOAD(NT - 1)); partialSM(pB0, pB1, m_reg, mnB, alB); __syncthreads(); RESC(alB);
        finishSM(pB0, pB1, alB, l_reg, pa0, pa1, pa2, pa3); SBAR(); pv_tile<1, SK>(o, vb0, pa0, pa1, pa2, pa3, ACT(NT - 1)); }
    SBAR(); SEAM_K0();
    if (hi == 0) li_l[r32] = l_reg; asm volatile("s_waitcnt lgkmcnt(0)" ::: "memory");
    float rli[16];
#pragma unroll
    for (int r = 0; r < 16; ++r) rli[r] = __builtin_amdgcn_rcpf(li_l[crow(r, hi)]);
    TOut* Ow = cur.O + (size_t)(wid * QBLK) * LDO;
#pragma unroll
    for (int r = 0; r < 16; ++r) { const int orow = crow(r, hi);
#pragma unroll
        for (int d0 = 0; d0 < 4; ++d0) { const float v = o[d0][r] * rli[r];
            if constexpr (same_t<TOut, float>::v) { Ow[(size_t)orow * LDO + d0 * 32 + r32] = v; }
            else { const float vn = __shfl_xor(v, 1);
                   if ((r32 & 1) == 0) *(unsigned*)(Ow + (size_t)orow * LDO + d0 * 32 + r32) = cvtpk(v, vn); } } }
    if constexpr (F32) {
#pragma unroll
        for (int d0 = 0; d0 < 8; ++d0) S.qr[d0] = pack8(S.tq[2 * d0], S.tq[2 * d0 + 1]); }
    __syncthreads();
#undef RESC
#undef KBASE
#undef ACT
#undef MASKT
#undef MLOAD
#undef SEAM_K0
#undef HALF_STEP
}
#undef ROW
#undef VMW
#undef VMWN
#undef SLOAD_H
#undef LD16U
#undef SWRITE_HK
#undef SWRITE_HV
#undef SWRITE_H
#undef SLOAD_F
#undef SWRITE_KF
#undef SWRITE_VF

}


template <int NC> __device__ __forceinline__ void scan_elems(const bf16* __restrict__ delta, bf16* __restrict__ prev, size_t cstride, const LAS float* dec, const LAS float* inj) {
    f32x4 st = (f32x4){0.f, 0.f, 0.f, 0.f};
#pragma unroll 8
    for (int c = 0; c < NC; ++c) { const v2u x = *(const GAS v2u*)(delta + (size_t)c * cstride);
        v2u o; o.x = pk2(st[0], st[1]); o.y = pk2(st[2], st[3]); *(GAS v2u*)(prev + (size_t)c * cstride) = o;
        const float d = dec[c], j = inj[c];
        st[0] = d * st[0] + j * __uint_as_float(x.x << 16); st[1] = d * st[1] + j * __uint_as_float(x.x & 0xffff0000u);
        st[2] = d * st[2] + j * __uint_as_float(x.y << 16); st[3] = d * st[3] + j * __uint_as_float(x.y & 0xffff0000u); }
}

struct Args {
    const float* x; const float* norm_mix; const float* norm_ffn; const float* w_in; const float* att_q_norm; const float* att_k_norm; const float* mlstm_conv; const float* mlstm_gate_bias;
    const float* mlstm_out_norm; const float* ret_out_norm; const float* w_b_att; const float* w_b_mlstm; const float* w_b_ret; const float* w_out; const float* w_ffn_in; const float* w_ffn_out;
    float* out; unsigned char* ws; int layer_lo, layer_hi, ph_lo, ph_hi;
};
constexpr int PH_PER_LAYER = 16;
__device__ __forceinline__ float ret_lngamma(int hd) { return log1pf(-exp2f(-5.0f - (float)hd)); }

template <int PLO, int PHI> __global__ void __launch_bounds__(NTHR, 2) fwd(Args args) {
    extern __shared__ __attribute__((aligned(16))) unsigned char lds_raw[];
    LAS unsigned char* lds = (LAS unsigned char*)lds_raw;
    volatile LAS unsigned* MISC = (volatile LAS unsigned*)(lds + MISC_OFF);
    const int tid = threadIdx.x, lane = tid & 63, wave = __builtin_amdgcn_readfirstlane(tid >> 6);
    const int G = gridDim.x, bx = blockIdx.x;
    const int gw = bx * NWAVES + wave, NGW = G * NWAVES;
    unsigned char* ws = args.ws;
    if (tid < 64) MISC[tid] = 0u;
    __syncthreads();
    constexpr bool one_launch = (PHI - PLO > 1);
    XcdBarrier bar; bar.bar = (unsigned*)(ws + WS_CTL) + CW_BAR; bar.x = 0; bar.st = nullptr;
    if constexpr (one_launch) bar = xcd_barrier_post((unsigned*)(ws + WS_CTL) + CW_BAR, MISC);
#define SEAM() do { if constexpr (one_launch) xcd_barrier(bar); } while (0)
    bf16* const H = (bf16*)(ws + WS_H); bf16* const PROJ = (bf16*)(ws + WS_PROJ); float* const SMALL = (float*)(ws + WS_SMALL); bf16* const MQK = (bf16*)(ws + WS_MQK);
    bf16* const IKB = (bf16*)(ws + WS_IKB); float* const IWF = (float*)(ws + WS_IWF); float* const GIF = (float*)(ws + WS_GIF); float* const SC = (float*)(ws + WS_SC);
    unsigned long long* const MB = (unsigned long long*)(ws + WS_MB); bf16* const DCM = (bf16*)(ws + WS_DCM); bf16* const CPM = (bf16*)(ws + WS_CPM);
    float* const DN = (float*)(ws + WS_MISC + MISC_DN); float* const NPREV = (float*)(ws + WS_MISC + MISC_NPREV); float* const AB = (float*)(ws + WS_MISC + MISC_AB); float* const MPREV = (float*)(ws + WS_MISC + MISC_MPREV);
    bf16* const DRR = (bf16*)(ws + WS_DRR); bf16* const RPR = (bf16*)(ws + WS_RPR); bf16* const YA = (bf16*)(ws + WS_YA); bf16* const YM = (bf16*)(ws + WS_YM); bf16* const YR = (bf16*)(ws + WS_YR);
    float* const MERGEDF = (float*)(ws + WS_MERGEDF); bf16* const MERGED = (bf16*)(ws + WS_MERGED); bf16* const ACT = (bf16*)(ws + WS_ACT);
    float* const ROPE128 = (float*)(ws + WS_ROPE128); float* const ROPE64 = (float*)(ws + WS_ROPE64);
    LAS float* const sf = (LAS float*)(lds + SCR_OFF);

    if constexpr (PLO == 0) {
        LAS float* scr = (LAS float*)(lds + wave * 16384);
        for (int l = 0; l < DEPTH; ++l) { unsigned char* wl = ws + WS_W + (size_t)l * W_LAYER;
            transpose_matrix(args.w_in + (size_t)l * DM * LPROJ, DM, LPROJ, NPROJ_PAD, (bf16*)(wl + WO_IN), scr, gw, NGW, lane, MapWin());
            transpose_matrix(args.w_b_att + (size_t)l * 1024 * DM, 1024, DM, DM, (bf16*)(wl + WO_B), scr, gw, NGW, lane, MapIdent());
            transpose_matrix(args.w_b_mlstm + (size_t)l * 1024 * DM, 1024, DM, DM, (bf16*)(wl + WO_B + 4 * MiB), scr, gw, NGW, lane, MapIdent());
            transpose_matrix(args.w_b_ret + (size_t)l * 1024 * DM, 1024, DM, DM, (bf16*)(wl + WO_B + 8 * MiB), scr, gw, NGW, lane, MapIdent());
            transpose_matrix(args.w_out + (size_t)l * DM * DM, DM, DM, DM, (bf16*)(wl + WO_OUT), scr, gw, NGW, lane, MapIdent());
            transpose_matrix(args.w_ffn_in + (size_t)l * DM * 2 * FF, DM, 2 * FF, 2 * FF, (bf16*)(wl + WO_FIN), scr, gw, NGW, lane, MapFfn());
            transpose_matrix(args.w_ffn_out + (size_t)l * FF * DM, FF, DM, DM, (bf16*)(wl + WO_FOUT), scr, gw, NGW, lane, MapIdent()); }
        for (int i = gw * 64 + lane; i < S * 96; i += NGW * 64) {
            if (i < S * 64) { const int t = i >> 6, f = i & 63; const float inv = (float)pow(10000.0, -(double)f * 2.0 / 128.0); const float ang = (float)t * inv;
                ROPE128[2 * i] = (float)cos((double)ang); ROPE128[2 * i + 1] = (float)sin((double)ang); }
            else { const int k = i - S * 64, t = k >> 5, f = k & 31; const float inv = (float)pow(10000.0, -(double)f * 2.0 / 64.0); const float ang = (float)t * inv;
                ROPE64[2 * k] = (float)cos((double)ang); ROPE64[2 * k + 1] = (float)sin((double)ang); } }
        if (PHI > 1) SEAM();
    }
#define IN(k) (PLO <= (k) && (k) < PHI)
#pragma unroll 1
    for (int layer = args.layer_lo; layer < args.layer_hi; ++layer) {
        unsigned char* wl = ws + WS_W + (size_t)layer * W_LAYER;
        const float* xin = layer == 0 ? args.x : args.out;
        if constexpr (IN(1)) { for (int m = gw; m < S; m += NGW) rms_row_to_bf16(xin + (size_t)m * DM, args.norm_mix + layer * DM, H + (size_t)m * DM, lane); SEAM(); }
        if constexpr (IN(2)) { pg8::Gemm g{H, (const bf16*)(wl + WO_IN), S, NPROJ_PAD, DM}; pg8::StaticOrder so; so.init(S, NPROJ_PAD, G, bx);
            pg8::EpiProj E{PROJ, NPROJ, SMALL, PC_G / 256, NPROJ / 256};
            pg8::gemm_phase<pg8::EpiProj, pg8::StaticOrder, true, true>(lds, g, so, E); SEAM(); }
        if constexpr (IN(3)) { PPArgs a{PROJ, SMALL, MQK, IKB, IWF, GIF, ROPE128, ROPE64, args.att_q_norm + layer * 128, args.att_k_norm + layer * 128, args.mlstm_conv + layer * 4096, args.mlstm_gate_bias + layer * 8};
            for (int m = gw; m < S; m += NGW) pp_row(a, m, lane); SEAM(); }
        if constexpr (IN(4)) {
            for (int u = gw; u < 8320; u += NGW) { int g = (int)((sqrtf(1.0f + 2.0f * (float)u) - 1.0f) * 0.5f); while (2 * (g + 1) * (g + 2) <= u) ++g; while (2 * g * (g + 1) > u) --g;
                const int r = u - 2 * g * (g + 1); score_wave_unit(PROJ, IKB, IWF, SC, 4 * g + r / (g + 1), r % (g + 1), lane); } }
        if constexpr (IN(5)) {
            for (int u = bx; u < 1024; u += G) {
                if (u < 512) { const int hd = u >> 7, c = u & 127, t0 = c * 64;
                    if (wave == 0) { const float iv = GIF[(size_t)(t0 + lane) * 8 + hd], fv = GIF[(size_t)(t0 + lane) * 8 + 4 + hd]; float b = log_sigmoid_f(fv);
#pragma unroll
                        for (int o = 1; o < 64; o <<= 1) { const float y = __shfl_up(b, o); if (lane >= o) b += y; }
                        const float bend = __shfl(b, 63), gl = bend - b + iv, A = wave_max(gl);
                        sf[lane] = __expf(gl - A); if (lane == 0) { AB[(hd * 128 + c) * 2] = A; AB[(hd * 128 + c) * 2 + 1] = bend; } }
                    __syncthreads();
                    chunk_delta<64, 256>(lds, MQK + (size_t)t0 * 1024 + 512 + hd * 128, 1024, PROJ + (size_t)t0 * NPROJ + PC_MV + hd * 256, NPROJ, sf, DCM + (size_t)(hd * 128 + c) * 32768, DN + (hd * 128 + c) * 128, tid);
                } else { const int v = u - 512, hd = v >> 6, c = v & 63, t0 = c * 128; const float lg = ret_lngamma(hd);
                    if (tid < 128) sf[tid] = __expf(lg * (float)(127 - tid));
                    __syncthreads();
                    chunk_delta<128, 128>(lds, PROJ + (size_t)t0 * NPROJ + PC_RK + hd * 128, NPROJ, PROJ + (size_t)t0 * NPROJ + PC_RV + hd * 128, NPROJ, sf, DRR + (size_t)(hd * 64 + c) * 16384, nullptr, tid); }
            }
            SEAM(); }
        if constexpr (IN(6)) {
            for (int i = gw; i < S; i += NGW) { const int k = i >> 1, t = (i & 1) ? (S - 1 - k) : k; select_dispatch(SC, MB, t, lane); } }
        if constexpr (IN(7)) {
            for (int u = bx; u < 128; u += G) {
                LAS float* dec = sf; LAS float* inj = sf + 128; LAS float* av = sf + 256; LAS float* bv = sf + 384;
                if (u < 64) { const int hd = u >> 4, p = u & 15;
                    if (tid < 128) { av[tid] = AB[(hd * 128 + tid) * 2]; bv[tid] = AB[(hd * 128 + tid) * 2 + 1]; }
                    __syncthreads();
                    if (tid == 0) { float m = 0.f; for (int c = 0; c < 128; ++c) { const float mn = fmaxf(bv[c] + m, av[c]); dec[c] = __expf(bv[c] + m - mn); inj[c] = __expf(av[c] - mn); if (p == 0) MPREV[hd * 128 + c] = m; m = mn; } }
                    __syncthreads();
                    const size_t e4 = (size_t)hd * 128 * 32768 + p * 2048 + tid * 4;
                    scan_elems<128>(DCM + e4, CPM + e4, 32768, dec, inj);
                    if (p == 0 && tid < 128) { float st = 0.f; for (int c = 0; c < 128; ++c) { NPREV[(hd * 128 + c) * 128 + tid] = st; st = dec[c] * st + inj[c] * DN[(hd * 128 + c) * 128 + tid]; } }
                } else { const int v = u - 64, hd = v >> 3, p = v & 7; const float dg = __expf(128.0f * ret_lngamma(hd));
                    if (tid < 64) { dec[tid] = dg; inj[tid] = 1.0f; }
                    __syncthreads();
                    const size_t e4 = (size_t)hd * 64 * 16384 + p * 2048 + tid * 4;
                    scan_elems<64>(DRR + e4, RPR + e4, 16384, dec, inj); }
                __syncthreads(); }
            SEAM(); }
        if constexpr (IN(8)) {
            {   typedef att::BlockRef<bf16, bf16> BR; att::Seam<bf16> seam; char* alds = (char*)lds_raw;
#define ATT_REF(r, item_, pass_) do { const int hd_ = (item_) >> 4, y_ = (item_) & 15, qb_ = (pass_) ? 31 - y_ : y_; \
                    (r).Q = PROJ + (size_t)qb_ * 256 * NPROJ + PC_AQ + hd_ * 128; (r).K = PROJ + PC_AK + hd_ * 128; (r).V = PROJ + PC_AV + hd_ * 128; (r).O = YA + (size_t)qb_ * 256 * 1024 + hd_ * 128; \
                    (r).M = MB + (size_t)qb_ * 256 * 128; (r).P0 = qb_ * 256; } while (0)
                if (bx < 128) { int item = bx, pass = 0; BR cur; ATT_REF(cur, item, 0); att::causal_swa_prime<bf16, bf16>(cur, 1 << 30, alds, seam);
                    for (;;) { const bool more_pass = pass == 0, more_item = item + G < 128, last = !more_pass && !more_item;
                        int itn = item, pn = pass + 1; if (!more_pass) { pn = 0; itn = more_item ? item + G : item; }
                        BR nxt = cur; if (!last) ATT_REF(nxt, itn, pn);
                        att::causal_swa_block<bf16, bf16>(cur, nxt, S, 1 << 30, alds, seam);
                        if (last) break; cur = nxt; item = itn; pass = pn; } }
                __syncthreads(); } }
        if constexpr (IN(9)) {
            for (int u = bx; u < 1024; u += G) {
                if (u < 512) { const int hd = u >> 7, c = u & 127, t0 = c * 64;
                    if (wave == 0) { const float iv = GIF[(size_t)(t0 + lane) * 8 + hd], fv = GIF[(size_t)(t0 + lane) * 8 + 4 + hd]; float b = log_sigmoid_f(fv);
#pragma unroll
                        for (int o = 1; o < 64; o <<= 1) { const float y = __shfl_up(b, o); if (lane >= o) b += y; }
                        const float mp = MPREV[hd * 128 + c]; float pm = iv - b;
#pragma unroll
                        for (int o = 1; o < 64; o <<= 1) { const float y = __shfl_up(pm, o); if (lane >= o) pm = fmaxf(pm, y); }
                        const float mt = fmaxf(b + mp, b + pm);
                        sf[lane] = b - mt; sf[128 + lane] = iv - b; sf[256 + lane] = __expf(b + mp - mt); sf[384 + lane] = __expf(-mt); sf[512 + lane] = 0.f; }
                    if (wave == 1) { sf[640 + lane] = NPREV[(hd * 128 + c) * 128 + lane]; sf[640 + 64 + lane] = NPREV[(hd * 128 + c) * 128 + 64 + lane]; }
                    __syncthreads();
                    chunk_out<64, 256, 0>(lds, sf, MQK + (size_t)t0 * 1024 + hd * 128, 1024, MQK + (size_t)t0 * 1024 + 512 + hd * 128, 1024, PROJ + (size_t)t0 * NPROJ + PC_MV + hd * 256, NPROJ,
                                          CPM + (size_t)(hd * 128 + c) * 32768, args.mlstm_out_norm + layer * 1024 + hd * 256, PROJ + (size_t)t0 * NPROJ + PC_MO + hd * 256, NPROJ, YM + (size_t)t0 * 1024 + hd * 256, 1024, tid);
                } else { const int v = u - 512, hd = v >> 6, c = v & 63, t0 = c * 128; const float lg = ret_lngamma(hd);
                    if (tid < 128) { sf[tid] = lg * (float)tid; sf[128 + tid] = -lg * (float)tid; sf[256 + tid] = __expf(lg * (float)(tid + 1)); }
                    __syncthreads();
                    chunk_out<128, 128, 1>(lds, sf, PROJ + (size_t)t0 * NPROJ + PC_RQ + hd * 128, NPROJ, PROJ + (size_t)t0 * NPROJ + PC_RK + hd * 128, NPROJ, PROJ + (size_t)t0 * NPROJ + PC_RV + hd * 128, NPROJ,
                                           RPR + (size_t)(hd * 64 + c) * 16384, args.ret_out_norm + layer * 1024 + hd * 128, PROJ + (size_t)t0 * NPROJ + PC_RG + hd * 128, NPROJ, YR + (size_t)t0 * 1024 + hd * 128, 1024, tid); }
            }
            SEAM(); }
        if constexpr (IN(10)) { pg8::Gemm g{YA, (const bf16*)(wl + WO_B), S, DM, 1024}; pg8::StaticOrder so; so.init(S, DM, G, bx); pg8::EpiBranch<0> E{PROJ + PC_G, NPROJ, MERGEDF, MERGED, DM};
            pg8::gemm_phase<pg8::EpiBranch<0>, pg8::StaticOrder, true, true>(lds, g, so, E); }
        if constexpr (IN(11)) { pg8::Gemm g{YM, (const bf16*)(wl + WO_B + 4 * MiB), S, DM, 1024}; pg8::StaticOrder so; so.init(S, DM, G, bx); pg8::EpiBranch<1> E{PROJ + PC_G + DM, NPROJ, MERGEDF, MERGED, DM};
            pg8::gemm_phase<pg8::EpiBranch<1>, pg8::StaticOrder, true, true>(lds, g, so, E); }
        if constexpr (IN(12)) { pg8::Gemm g{YR, (const bf16*)(wl + WO_B + 8 * MiB), S, DM, 1024}; pg8::StaticOrder so; so.init(S, DM, G, bx); pg8::EpiBranch<2> E{PROJ + PC_G + 2 * DM, NPROJ, MERGEDF, MERGED, DM};
            pg8::gemm_phase<pg8::EpiBranch<2>, pg8::StaticOrder, true, true>(lds, g, so, E); SEAM(); }
        if constexpr (IN(13)) { pg8::Gemm g{MERGED, (const bf16*)(wl + WO_OUT), S, DM, DM}; pg8::StaticOrder so; so.init(S, DM, G, bx); pg8::EpiResid E{xin, args.out, DM};
            pg8::gemm_phase<pg8::EpiResid, pg8::StaticOrder, true, true>(lds, g, so, E); SEAM(); }
        if constexpr (IN(14)) { for (int m = gw; m < S; m += NGW) rms_row_to_bf16(args.out + (size_t)m * DM, args.norm_ffn + layer * DM, H + (size_t)m * DM, lane); SEAM(); }
        if constexpr (IN(15)) { pg8::Gemm g{H, (const bf16*)(wl + WO_FIN), S, 2 * FF, DM}; pg8::StaticOrder so; so.init(S, 2 * FF, G, bx); pg8::EpiSwiGLU E{ACT, FF};
            pg8::gemm_phase<pg8::EpiSwiGLU, pg8::StaticOrder, true, true>(lds, g, so, E); SEAM(); }
        if constexpr (IN(16)) { pg8::Gemm g{ACT, (const bf16*)(wl + WO_FOUT), S, DM, FF}; pg8::StaticOrder so; so.init(S, DM, G, bx); pg8::EpiResid E{args.out, args.out, DM};
            pg8::gemm_phase<pg8::EpiResid, pg8::StaticOrder, true, true>(lds, g, so, E); if (layer + 1 < args.layer_hi) SEAM(); }
    }
#undef IN
#undef SEAM
}

#ifndef ONE_LAUNCH
#define ONE_LAUNCH 0
#endif
typedef void (*kern_t)(Args);
template <int P> static kern_t phase_kernel(int p) { if (p == P) return fwd<P, P + 1>; if constexpr (P < PH_PER_LAYER) return phase_kernel<P + 1>(p); else return nullptr; }
extern "C" void kernel_launch(void* const* d_in, const int* in_sizes, int n_in, void* d_out, int out_size, void* d_ws, size_t ws_size, hipStream_t stream) {
    static int grid = 0;
    if (grid == 0) {
        if (n_in != 16 || in_sizes[0] != S * DM || out_size != S * DM || ws_size < WS_END) { fprintf(stderr, "kernel_launch: unexpected shapes (n_in %d, in0 %d, out %d, ws %zu < %zu); nothing launched\n", n_in, n_in > 0 ? in_sizes[0] : -1, out_size, ws_size, (size_t)WS_END); grid = -1; return; }
        int dev = 0, cus = 0;
        if (hipGetDevice(&dev) != hipSuccess || hipDeviceGetAttribute(&cus, hipDeviceAttributeMultiprocessorCount, dev) != hipSuccess) { grid = -1; return; }
#if ONE_LAUNCH
        if (hipFuncSetAttribute((const void*)fwd<0, PH_PER_LAYER + 1>, hipFuncAttributeMaxDynamicSharedMemorySize, LDS_BYTES) != hipSuccess) { grid = -1; return; }
#else
        for (int p = 0; p <= PH_PER_LAYER; ++p) if (hipFuncSetAttribute((const void*)phase_kernel<0>(p), hipFuncAttributeMaxDynamicSharedMemorySize, LDS_BYTES) != hipSuccess) { fprintf(stderr, "kernel_launch: hipFuncSetAttribute failed\n"); grid = -1; return; }
#endif
        (void)hipGetLastError();
        grid = cus;
    }
    if (grid < 0) return;
    (void)hipMemsetAsync((char*)d_ws + WS_CTL, 0, CTL_ZERO_BYTES, stream);
    Args a{};
    a.x = (const float*)d_in[0]; a.norm_mix = (const float*)d_in[1]; a.norm_ffn = (const float*)d_in[2]; a.w_in = (const float*)d_in[3]; a.att_q_norm = (const float*)d_in[4]; a.att_k_norm = (const float*)d_in[5];
    a.mlstm_conv = (const float*)d_in[6]; a.mlstm_gate_bias = (const float*)d_in[7]; a.mlstm_out_norm = (const float*)d_in[8]; a.ret_out_norm = (const float*)d_in[9];
    a.w_b_att = (const float*)d_in[10]; a.w_b_mlstm = (const float*)d_in[11]; a.w_b_ret = (const float*)d_in[12]; a.w_out = (const float*)d_in[13]; a.w_ffn_in = (const float*)d_in[14]; a.w_ffn_out = (const float*)d_in[15];
    a.out = (float*)d_out; a.ws = (unsigned char*)d_ws;
#if ONE_LAUNCH
    a.layer_lo = 0; a.layer_hi = DEPTH; a.ph_lo = 0; a.ph_hi = PH_PER_LAYER + 1; hipLaunchKernelGGL((fwd<0, PH_PER_LAYER + 1>), dim3(grid), dim3(NTHR), LDS_BYTES, stream, a);
#else
    a.layer_lo = 0; a.layer_hi = 0; a.ph_lo = 0; a.ph_hi = 1; hipLaunchKernelGGL((fwd<0, 1>), dim3(grid), dim3(NTHR), LDS_BYTES, stream, a);
    for (int l = 0; l < DEPTH; ++l) for (int p = 1; p <= PH_PER_LAYER; ++p) { a.layer_lo = l; a.layer_hi = l + 1; a.ph_lo = p; a.ph_hi = p + 1; hipLaunchKernelGGL(phase_kernel<0>(p), dim3(grid), dim3(NTHR), LDS_BYTES, stream, a); }
#endif
}
```

```cpp
#include <hip/hip_runtime.h>
#include <cstdio>
#include <cstdint>
namespace pg8 {
#define PG8_LAS __attribute__((address_space(3)))
typedef unsigned short bf16_t;
typedef short bf16x8 __attribute__((ext_vector_type(8)));
typedef float f32x4 __attribute__((ext_vector_type(4)));
typedef unsigned u32x4 __attribute__((ext_vector_type(4)));
constexpr int BM = 256, BK = 64, HALF = 128, HTB = HALF * BK * 2  , STAGE_BYTES = 8 * HTB, NXCD = 8, WGM = 8;

__host__ __device__ __forceinline__ int lds_byte(int r, int c) { const int st = (r >> 4) * 2 + (c >> 5), rr = r & 15, cc = c & 31, ob = rr * 64 + cc * 2; return st * 1024 + (ob ^ (((ob >> 9) & 1) << 5)); }
__host__ __device__ __forceinline__ void stage_rc(int b, int& R, int& C) { const int st = b / 1024, sb = b % 1024, swz = sb ^ (((sb >> 9) & 1) << 5); R = (st >> 1) * 16 + swz / 64; C = (st & 1) * 32 + (swz % 64) / 2; }
__host__ __device__ __forceinline__ int perm32(int rho) { const int n = rho >> 4, i = rho & 15; return 8 * (i >> 2) + 4 * n + (i & 3); }

struct Unit { int pm, pn; };
struct Gemm { const bf16_t* A; const bf16_t* Bt; int M, N, K; };

struct StaticOrder {
    int nM, nN, nwg, G, c;
    __host__ __device__ void init(int M, int N, int G_, int c_) { nM = M / BM; nN = N / BM; nwg = nM * nN; G = G_; c = c_; }
    __host__ __device__ bool next(int i, Unit& u) const {
        const long L = (long)i * G + c; if (L >= nwg) return false;
        int wgid = (int)L; { const int q = nwg / NXCD, r = nwg % NXCD, xcd = wgid % NXCD, off = wgid / NXCD; wgid = (xcd < r ? xcd * (q + 1) : r * (q + 1) + (xcd - r) * q) + off; }
        const int nig = WGM * nN, gid = wgid / nig, fm = gid * WGM, gsz = (nM - fm) < WGM ? (nM - fm) : WGM;
        u.pm = fm + ((wgid % nig) % gsz); u.pn = (wgid % nig) / gsz; return true;
    }
    __device__ __forceinline__ void a_ready(const Unit&) const {}
    __device__ __forceinline__ void done(const Unit&) const {}
};

__device__ __forceinline__ unsigned cvt_pk_bf16(float lo, float hi) { unsigned r; asm volatile("v_cvt_pk_bf16_f32 %0, %1, %2" : "=v"(r) : "v"(lo), "v"(hi)); return r; }
typedef float f32x2 __attribute__((ext_vector_type(2)));
__device__ __forceinline__ float sigmoid_f(float x) { return __builtin_amdgcn_rcpf(1.0f + __builtin_amdgcn_exp2f(-1.4426950408889634f * x)); }
struct EpiProj {
    static constexpr bool PERM = true, AFTER_DRAIN = false;
    bf16_t* P; int ldp; float* Sm; int ngate0, nbf;
    __device__ __forceinline__ void operator()(const f32x4 (&acc)[2][2][4][2], const Unit& u, int wr, int wc, int fr, int fq) const {
        const int row0 = u.pm * BM + wr * 64 + fr, col0 = u.pn * BM + wc * 32 + 8 * fq;
        if (u.pn >= nbf) {
            const int c0 = wc * 32 + 8 * fq;
#pragma unroll
            for (int ai = 0; ai < 2; ++ai)
#pragma unroll
                for (int m = 0; m < 4; ++m) { float* rowp = Sm + (size_t)(row0 + ai * HALF + m * 16) * 256 + c0;
#pragma unroll
                    for (int bj = 0; bj < 2; ++bj) { *(f32x4*)(rowp + bj * HALF) = acc[ai][bj][m][0]; *(f32x4*)(rowp + bj * HALF + 4) = acc[ai][bj][m][1]; } }
            return;
        }
        const bool sg = u.pn >= ngate0;
#pragma unroll
        for (int ai = 0; ai < 2; ++ai)
#pragma unroll
            for (int m = 0; m < 4; ++m) { bf16_t* rowp = P + (size_t)(row0 + ai * HALF + m * 16) * ldp + col0;
#pragma unroll
                for (int bj = 0; bj < 2; ++bj) { f32x4 v0 = acc[ai][bj][m][0], v1 = acc[ai][bj][m][1];
                    if (sg) {
#pragma unroll
                        for (int j = 0; j < 4; ++j) { v0[j] = sigmoid_f(v0[j]); v1[j] = sigmoid_f(v1[j]); } }
                    u32x4 w; w.x = cvt_pk_bf16(v0[0], v0[1]); w.y = cvt_pk_bf16(v0[2], v0[3]); w.z = cvt_pk_bf16(v1[0], v1[1]); w.w = cvt_pk_bf16(v1[2], v1[3]);
                    *(u32x4*)(rowp + bj * HALF) = w; } }
    }
};
__device__ __forceinline__ f32x4 bf4_lo(u32x4 w) { return (f32x4){__uint_as_float(w.x << 16), __uint_as_float(w.x & 0xffff0000u), __uint_as_float(w.y << 16), __uint_as_float(w.y & 0xffff0000u)}; }
__device__ __forceinline__ f32x4 bf4_hi(u32x4 w) { return (f32x4){__uint_as_float(w.z << 16), __uint_as_float(w.z & 0xffff0000u), __uint_as_float(w.w << 16), __uint_as_float(w.w & 0xffff0000u)}; }
template <int MODE> struct EpiBranch {
    static constexpr bool PERM = true, AFTER_DRAIN = false;
    const bf16_t* G; int ldg; float* T; bf16_t* O; int ldt;
    __device__ __forceinline__ void operator()(const f32x4 (&acc)[2][2][4][2], const Unit& u, int wr, int wc, int fr, int fq) const {
        const int row0 = u.pm * BM + wr * 64 + fr, col0 = u.pn * BM + wc * 32 + 8 * fq;
#pragma unroll
        for (int ai = 0; ai < 2; ++ai)
#pragma unroll
            for (int m = 0; m < 4; ++m) { const size_t r = (size_t)(row0 + ai * HALF + m * 16);
#pragma unroll
                for (int bj = 0; bj < 2; ++bj) { const u32x4 g = *(const u32x4*)(G + r * ldg + col0 + bj * HALF);
                    f32x4 v0 = acc[ai][bj][m][0] * bf4_lo(g), v1 = acc[ai][bj][m][1] * bf4_hi(g);
                    float* tp = T + r * ldt + col0 + bj * HALF;
                    if (MODE >= 1) { v0 = v0 + *(const f32x4*)tp; v1 = v1 + *(const f32x4*)(tp + 4); }
                    if (MODE <= 1) { *(f32x4*)tp = v0; *(f32x4*)(tp + 4) = v1; }
                    else { u32x4 w; w.x = cvt_pk_bf16(v0[0], v0[1]); w.y = cvt_pk_bf16(v0[2], v0[3]); w.z = cvt_pk_bf16(v1[0], v1[1]); w.w = cvt_pk_bf16(v1[2], v1[3]);
                        *(u32x4*)(O + r * ldt + col0 + bj * HALF) = w; } } }
    }
};
struct EpiResid {
    static constexpr bool PERM = false, AFTER_DRAIN = false;
    const float* base; float* out; int ldc;
    __device__ __forceinline__ void operator()(const f32x4 (&acc)[2][2][4][2], const Unit& u, int wr, int wc, int fr, int fq) const {
        const int row0 = u.pm * BM + wr * 64 + fr, col0 = u.pn * BM + wc * 32 + 4 * fq;
#pragma unroll
        for (int ai = 0; ai < 2; ++ai)
#pragma unroll
            for (int m = 0; m < 4; ++m) { const size_t off = (size_t)(row0 + ai * HALF + m * 16) * ldc + col0;
#pragma unroll
                for (int bj = 0; bj < 2; ++bj)
#pragma unroll
                    for (int n = 0; n < 2; ++n) *(f32x4*)(out + off + bj * HALF + n * 16) = *(const f32x4*)(base + off + bj * HALF + n * 16) + acc[ai][bj][m][n]; }
    }
};
struct EpiSwiGLU {
    static constexpr bool PERM = true, AFTER_DRAIN = false;
    bf16_t* O; int ldc;
    __device__ __forceinline__ void operator()(const f32x4 (&acc)[2][2][4][2], const Unit& u, int wr, int wc, int fr, int fq) const {
        const int row0 = u.pm * BM + wr * 64 + fr, col0 = u.pn * HALF + wc * 32 + 8 * fq;
#pragma unroll
        for (int ai = 0; ai < 2; ++ai)
#pragma unroll
            for (int m = 0; m < 4; ++m) { f32x4 v0, v1;
#pragma unroll
                for (int j = 0; j < 4; ++j) { const float g0 = acc[ai][0][m][0][j], g1 = acc[ai][0][m][1][j];
                    v0[j] = g0 * sigmoid_f(g0) * acc[ai][1][m][0][j]; v1[j] = g1 * sigmoid_f(g1) * acc[ai][1][m][1][j]; }
                u32x4 w; w.x = cvt_pk_bf16(v0[0], v0[1]); w.y = cvt_pk_bf16(v0[2], v0[3]); w.z = cvt_pk_bf16(v1[0], v1[1]); w.w = cvt_pk_bf16(v1[2], v1[3]);
                *(u32x4*)(O + (size_t)(row0 + ai * HALF + m * 16) * ldc + col0) = w; }
    }
};
template <class Epi, class Sched, bool ALIGN_EPI = false, bool SP2 = false>
__device__ __forceinline__ void gemm_phase(PG8_LAS unsigned char* lds, const Gemm g, const Sched& S, const Epi& E) {
    int tid_o = threadIdx.x; asm volatile("" : "+v"(tid_o));
    const int tid = tid_o, wid = __builtin_amdgcn_readfirstlane(tid >> 6), lane = tid & 63, wr = wid >> 2, wc = wid & 3, fr = lane & 15, fq = lane >> 4;
    const int K = g.K, nt = K / BK;
    unsigned voffA[2], voffB[2];
#pragma unroll
    for (int i = 0; i < 2; ++i) { int R, C; stage_rc(tid * 16 + i * 8192, R, C); const int Rb = Epi::PERM ? ((R & ~31) + perm32(R & 31)) : R;
        voffA[i] = (unsigned)(R * K + C) * 2u; voffB[i] = (unsigned)(Rb * K + C) * 2u; }
    const size_t kstep = (size_t)(BK * 2);
    const size_t hstep = (size_t)HALF * K * 2;
    const size_t tstep = 2 * hstep;
    const unsigned ldsw = (unsigned)wid * 1024u;
    const int aoff = lds_byte(wr * 64 + fr, fq * 8), boff = lds_byte(wc * 32 + fr, fq * 8);
#define PG8_SA(b, h) (((b) * 2 + (h)) * HTB)
#define PG8_SB(b, h) ((4 + (b) * 2 + (h)) * HTB)
#define PG8_STAGE(bufoff, gbase, voff) do { _Pragma("unroll") for (int _i = 0; _i < 2; ++_i) \
        __builtin_amdgcn_global_load_lds((const unsigned*)((const char*)(gbase) + (voff)[_i]), (PG8_LAS unsigned*)(lds + (bufoff) + ldsw + _i * 8192), 16, 0, 0); } while (0)
#define PG8_LDA(dst, b, h) do { _Pragma("unroll") for (int m = 0; m < 4; ++m) _Pragma("unroll") for (int k = 0; k < 2; ++k) dst[m][k] = *(const PG8_LAS bf16x8*)(lds + PG8_SA(b, h) + aoff + m * 2048 + k * 1024); } while (0)
#define PG8_LDB(dst, b, h) do { _Pragma("unroll") for (int n = 0; n < 2; ++n) _Pragma("unroll") for (int k = 0; k < 2; ++k) dst[n][k] = *(const PG8_LAS bf16x8*)(lds + PG8_SB(b, h) + boff + n * 2048 + k * 1024); } while (0)
#define PG8_MMA(ai, bj, At, Bt) do { __builtin_amdgcn_s_setprio(1); _Pragma("unroll") for (int m = 0; m < 4; ++m) _Pragma("unroll") for (int n = 0; n < 2; ++n) _Pragma("unroll") for (int k = 0; k < 2; ++k) \
        acc[ai][bj][m][n] = __builtin_amdgcn_mfma_f32_16x16x32_bf16(Bt[n][k], At[m][k], acc[ai][bj][m][n], 0, 0, 0); __builtin_amdgcn_s_setprio(0); } while (0)
#define PG8_WAIT_V(n) asm volatile("s_waitcnt vmcnt(" #n ")" ::: "memory")
#define PG8_WAIT_L(n) asm volatile("s_waitcnt lgkmcnt(" #n ")" ::: "memory")
#define PG8_BAR __builtin_amdgcn_s_barrier()
#define PG8_SCHED __builtin_amdgcn_sched_barrier(0)
    Unit cur, nxt; int ui = 0;
    if (!S.next(0, cur)) return;
    f32x4 acc[2][2][4][2];
#pragma unroll
    for (int a = 0; a < 2; ++a)
#pragma unroll
        for (int b = 0; b < 2; ++b)
#pragma unroll
            for (int m = 0; m < 4; ++m)
#pragma unroll
                for (int n = 0; n < 2; ++n) acc[a][b][m][n] = (f32x4){0.f, 0.f, 0.f, 0.f};
    bf16x8 At[4][2], B0[2][2], B1[2][2];
    const char* cA = (const char*)g.A + (size_t)cur.pm * tstep; const char* cB = (const char*)g.Bt + (size_t)cur.pn * tstep;
    S.a_ready(cur);
    if constexpr (SP2) {
        PG8_STAGE(PG8_SB(0, 0), cB, voffB); PG8_STAGE(PG8_SB(0, 1), cB + hstep, voffB); PG8_STAGE(PG8_SA(0, 0), cA, voffA); PG8_STAGE(PG8_SA(0, 1), cA + hstep, voffA);
        if (wr == 1) PG8_BAR;
        PG8_WAIT_V(2); PG8_BAR;
        PG8_STAGE(PG8_SB(1, 0), cB + kstep, voffB); PG8_STAGE(PG8_SA(1, 0), cA + kstep, voffA); PG8_STAGE(PG8_SB(1, 1), cB + hstep + kstep, voffB);
        PG8_WAIT_V(6); PG8_BAR;
    } else {
        PG8_STAGE(PG8_SB(0, 0), cB, voffB); PG8_STAGE(PG8_SA(0, 0), cA, voffA); PG8_STAGE(PG8_SB(0, 1), cB + hstep, voffB); PG8_STAGE(PG8_SA(0, 1), cA + hstep, voffA);
        if (wr == 1) PG8_BAR;
        PG8_WAIT_V(4); PG8_BAR;
        PG8_STAGE(PG8_SB(1, 0), cB + kstep, voffB); PG8_STAGE(PG8_SA(1, 0), cA + kstep, voffA); PG8_STAGE(PG8_SB(1, 1), cB + hstep + kstep, voffB);
        PG8_WAIT_V(6); PG8_BAR;
    }
    for (;;) {
        const bool has_next = S.next(ui + 1, nxt);
        const char* nA = has_next ? (const char*)g.A + (size_t)nxt.pm * tstep : cA; const char* nB = has_next ? (const char*)g.Bt + (size_t)nxt.pn * tstep : cB;
        for (int t = 0; t < nt; t += 2) {
            const bool last = (t == nt - 2);
            const char* a1 = cA + (size_t)(t + 1) * kstep;
            const char* a2 = last ? nA : cA + (size_t)(t + 2) * kstep; const char* b2 = last ? nB : cB + (size_t)(t + 2) * kstep;
            const char* a3 = a2 + kstep; const char* b3 = b2 + kstep;
            if (last && has_next) S.a_ready(nxt);
            if constexpr (SP2) {
            PG8_LDB(B0, 0, 0); PG8_LDB(B1, 0, 1); PG8_SCHED; PG8_LDA(At, 0, 0); PG8_STAGE(PG8_SA(1, 1), a1 + hstep, voffA);
            PG8_WAIT_V(8); PG8_WAIT_L(0); PG8_BAR; PG8_MMA(0, 0, At, B0); PG8_MMA(0, 1, At, B1); PG8_BAR; PG8_SCHED;
            PG8_LDA(At, 0, 1); PG8_STAGE(PG8_SB(0, 0), b2, voffB); PG8_STAGE(PG8_SB(0, 1), b2 + hstep, voffB); PG8_STAGE(PG8_SA(0, 0), a2, voffA);
            PG8_WAIT_V(8); PG8_WAIT_L(0); PG8_BAR; PG8_MMA(1, 0, At, B0); PG8_MMA(1, 1, At, B1); PG8_BAR; PG8_SCHED;
            PG8_LDB(B0, 1, 0); PG8_LDB(B1, 1, 1); PG8_SCHED; PG8_LDA(At, 1, 0); PG8_STAGE(PG8_SA(0, 1), a2 + hstep, voffA);
            PG8_WAIT_V(8); PG8_WAIT_L(0); PG8_BAR; PG8_MMA(0, 0, At, B0); PG8_MMA(0, 1, At, B1); PG8_BAR; PG8_SCHED;
            PG8_LDA(At, 1, 1); PG8_STAGE(PG8_SB(1, 0), b3, voffB); PG8_STAGE(PG8_SB(1, 1), b3 + hstep, voffB); PG8_STAGE(PG8_SA(1, 0), a3, voffA);
            PG8_WAIT_V(8); PG8_WAIT_L(0); PG8_BAR; PG8_MMA(1, 0, At, B0); PG8_MMA(1, 1, At, B1); PG8_BAR; PG8_SCHED;
            } else {
            PG8_LDB(B0, 0, 0); PG8_SCHED; PG8_LDA(At, 0, 0); PG8_STAGE(PG8_SA(1, 1), a1 + hstep, voffA);
            PG8_WAIT_L(8); PG8_BAR; PG8_WAIT_L(0); PG8_MMA(0, 0, At, B0); PG8_BAR; PG8_SCHED;
            PG8_LDB(B1, 0, 1); PG8_STAGE(PG8_SB(0, 0), b2, voffB);
            PG8_BAR; PG8_WAIT_L(0); PG8_MMA(0, 1, At, B1); PG8_BAR;
            PG8_LDA(At, 0, 1); PG8_STAGE(PG8_SA(0, 0), a2, voffA);
            PG8_BAR; PG8_WAIT_L(0); PG8_MMA(1, 0, At, B0); PG8_BAR; PG8_SCHED;
            PG8_STAGE(PG8_SB(0, 1), b2 + hstep, voffB);
            PG8_WAIT_V(6); PG8_BAR; PG8_MMA(1, 1, At, B1); PG8_BAR;
            PG8_LDB(B0, 1, 0); PG8_SCHED; PG8_LDA(At, 1, 0); PG8_STAGE(PG8_SA(0, 1), a2 + hstep, voffA);
            PG8_WAIT_L(8); PG8_BAR; PG8_WAIT_L(0); PG8_MMA(0, 0, At, B0); PG8_BAR; PG8_SCHED;
            PG8_LDB(B1, 1, 1); PG8_STAGE(PG8_SB(1, 0), b3, voffB);
            PG8_BAR; PG8_WAIT_L(0); PG8_MMA(0, 1, At, B1); PG8_BAR;
            PG8_LDA(At, 1, 1); PG8_STAGE(PG8_SA(1, 0), a3, voffA);
            PG8_BAR; PG8_WAIT_L(0); PG8_MMA(1, 0, At, B0); PG8_BAR; PG8_SCHED;
            PG8_STAGE(PG8_SB(1, 1), b3 + hstep, voffB);
            PG8_WAIT_V(6); PG8_BAR; PG8_MMA(1, 1, At, B1); PG8_BAR;
            }
        }
        if constexpr (ALIGN_EPI) { if (wr == 0) PG8_BAR; }
        if constexpr (!Epi::AFTER_DRAIN) { E(acc, cur, wr, wc, fr, fq); S.done(cur); }
        if (!has_next) break;
#pragma unroll
        for (int a = 0; a < 2; ++a)
#pragma unroll
            for (int b = 0; b < 2; ++b)
#pragma unroll
                for (int m = 0; m < 4; ++m)
#pragma unroll
                    for (int n = 0; n < 2; ++n) acc[a][b][m][n] = (f32x4){0.f, 0.f, 0.f, 0.f};
        cur = nxt; cA = nA; cB = nB; ++ui;
        if constexpr (ALIGN_EPI) { if (wr == 1) PG8_BAR; }
    }
    PG8_WAIT_V(0);
    if constexpr (!ALIGN_EPI) { if (wr == 0) PG8_BAR; }
    PG8_BAR;
    if constexpr (Epi::AFTER_DRAIN) { E.fused(acc, cur, wr, wc, fr, fq, lds, wid, lane); S.done(cur); }
#undef PG8_SA
#undef PG8_SB
#undef PG8_STAGE
#undef PG8_LDA
#undef PG8_LDB
#undef PG8_MMA
#undef PG8_WAIT_V
#undef PG8_WAIT_L
#undef PG8_BAR
#undef PG8_SCHED
}
}

using pg8::sigmoid_f;
constexpr int NWAVES = 8, NTHR = 512;
constexpr int S = 8192, DM = 2048, DEPTH = 4, FF = 5632;
constexpr int NPROJ = 16896, NPROJ_PAD = 17152, LPROJ = 16976;
constexpr int PC_AQ = 0, PC_AK = 1024, PC_AV = 2048, PC_IQ = 3072, PC_MQ = 3584, PC_MK = 4096, PC_MV = 4608, PC_MO = 5632, PC_RQ = 6656, PC_RK = 7680, PC_RV = 8704, PC_RG = 9728, PC_G = 10752;
constexpr int LC_IK = 3584, LC_IW = 3648, LC_MI = 5704, LC_MF = 5708;
constexpr float NORM_EPS = 1e-6f;
constexpr size_t MiB = 1u << 20;
constexpr size_t WS_CTL = 0, CTL_ZERO_BYTES = 1 * MiB;
constexpr size_t WS_ROPE128 = 2 * MiB, WS_ROPE64 = 6 * MiB;
constexpr size_t WS_W = 16 * MiB, W_LAYER = 153 * MiB;
constexpr size_t WO_IN = 0, WO_B = 67 * MiB, WO_OUT = 79 * MiB, WO_FIN = 87 * MiB, WO_FOUT = 131 * MiB;
constexpr size_t WS_H = 640 * MiB, WS_PROJ = 672 * MiB, WS_SMALL = 936 * MiB, WS_MQK = 944 * MiB, WS_IKB = 960 * MiB, WS_IWF = 961 * MiB, WS_GIF = WS_IWF + 512 * 1024;
constexpr size_t WS_SC = 964 * MiB, WS_MB = 1220 * MiB, WS_DCM = 1228 * MiB, WS_CPM = 1260 * MiB, WS_MISC = 1292 * MiB, WS_DRR = 1294 * MiB, WS_RPR = 1310 * MiB;
constexpr size_t WS_YA = 1328 * MiB, WS_YM = 1344 * MiB, WS_YR = 1360 * MiB, WS_MERGEDF = 1376 * MiB, WS_MERGED = 1440 * MiB, WS_ACT = 1472 * MiB, WS_END = 1560 * MiB;
constexpr size_t MISC_DN = 0, MISC_NPREV = 256 * 1024, MISC_AB = 512 * 1024, MISC_MPREV = 520 * 1024;
constexpr int CW_BAR = 4096;
constexpr int LDS_BYTES = 147456, MISC_OFF = 147456 - 256;

#define GAS __attribute__((address_space(1)))
#define LAS __attribute__((address_space(3)))
typedef unsigned short bf16;
typedef unsigned v4u __attribute__((ext_vector_type(4)));
typedef unsigned v2u __attribute__((ext_vector_type(2)));
typedef float f32x4 __attribute__((ext_vector_type(4)));
typedef float f32x16 __attribute__((ext_vector_type(16)));
typedef short bf16x8 __attribute__((ext_vector_type(8)));
typedef short s16x4 __attribute__((ext_vector_type(4)));
#define LDS_WAIT() asm volatile("s_waitcnt lgkmcnt(0)" ::: "memory")
#define VM_WAIT() asm volatile("s_waitcnt vmcnt(0)" ::: "memory")
__device__ __forceinline__ unsigned f2bf(float f) { unsigned u = __builtin_bit_cast(unsigned, f); return (u + 0x7fffu + ((u >> 16) & 1u)) >> 16; }
__device__ __forceinline__ unsigned pk2(float lo, float hi) { return f2bf(lo) | (f2bf(hi) << 16); }
__device__ __forceinline__ float bf2f(bf16 b) { return __uint_as_float(((unsigned)b) << 16); }
__device__ __forceinline__ float wave_sum(float v) {
#pragma unroll
    for (int o = 1; o < 64; o <<= 1) v += __shfl_xor(v, o);
    return v;
}
__device__ __forceinline__ float wave_max(float v) {
#pragma unroll
    for (int o = 1; o < 64; o <<= 1) v = fmaxf(v, __shfl_xor(v, o));
    return v;
}
#define XB_TMO      128
#define XB_XCNT(j)  (256  + 64 * (j))
#define XB_XSUB(j)  (1280 + 64 * (j))
#define XB_XGEN(j)  (2304 + 64 * (j))
#define XB_TOP      3328
#define XB_TOPGEN   3392
#define XCD_BAR_WORDS 3456
#define XB_SPIN_CAP (1u << 18)

__device__ __forceinline__ unsigned xb_ld(unsigned* p)              { return __hip_atomic_load(p, __ATOMIC_RELAXED, __HIP_MEMORY_SCOPE_AGENT); }
__device__ __forceinline__ unsigned xb_add(unsigned* p, unsigned v) { return __hip_atomic_fetch_add(p, v, __ATOMIC_RELAXED, __HIP_MEMORY_SCOPE_AGENT); }
__device__ __forceinline__ unsigned xb_xcc_id() { return (unsigned)__builtin_amdgcn_s_getreg((3 << 11) | 20) & 0xFu; }
#define XB_SPIN(cond, bar) do { unsigned _sp = 0; while (cond) { __builtin_amdgcn_s_sleep(1); \
    if ((++_sp & 255u) == 0u) { if (xb_ld(&(bar)[XB_TMO])) break; if (_sp > XB_SPIN_CAP) { atomicAdd(&(bar)[XB_TMO], 1u); break; } } } } while (0)

struct XcdBarrier {
    unsigned* bar; unsigned x;
    volatile LAS unsigned* st;
};

__device__ __forceinline__ XcdBarrier xcd_barrier_post(unsigned* bar, volatile LAS unsigned* st) {
    XcdBarrier b; b.bar = bar; b.x = xb_xcc_id(); b.st = st;
    if (threadIdx.x == 0) (void)xb_add(&bar[XB_XCNT(b.x)], 1u);
    return b;
}
__device__ __forceinline__ void xcd_barrier_complete(unsigned* bar, unsigned x, unsigned& nloc, unsigned& nx) {
    const unsigned G = gridDim.x * gridDim.y * gridDim.z;
    unsigned sum, cnt, mine, sp = 0u;
    for (;;) {
        sum = 0u; cnt = 0u; mine = 0u;
#pragma unroll
        for (unsigned j = 0; j < 16; ++j) { const unsigned c = xb_ld(&bar[XB_XCNT(j)]); sum += c; cnt += (c > 0u) ? 1u : 0u; mine = (j == x) ? c : mine; }
        if (sum == G) break;
        __builtin_amdgcn_s_sleep(1);
        if ((++sp & 255u) == 0u) { if (xb_ld(&bar[XB_TMO])) break; if (sp > XB_SPIN_CAP) { atomicAdd(&bar[XB_TMO], 1u); break; } }
    }
    nloc = mine > 0u ? mine : 1u; nx = cnt > 0u ? cnt : 1u;
}

__device__ __forceinline__ void xcd_barrier(const XcdBarrier& b) {
    asm volatile("s_waitcnt vmcnt(0)" ::: "memory");
    __syncthreads();
    if (threadIdx.x == 0) {
        unsigned* bar = b.bar;
        __builtin_amdgcn_s_waitcnt(0);
        unsigned nloc = b.st[0], nx = b.st[1];
        if (nloc == 0u) { xcd_barrier_complete(bar, b.x, nloc, nx); b.st[0] = nloc; b.st[1] = nx; }
        const unsigned old = xb_add(&bar[XB_XSUB(b.x)], 1u);
        const unsigned gen = old / nloc;
        if (old + 1u == (gen + 1u) * nloc) {
            __builtin_amdgcn_fence(__ATOMIC_RELEASE, "agent");
            asm volatile("s_waitcnt vmcnt(0)" ::: "memory");
            const unsigned og = xb_add(&bar[XB_TOP], 1u);
            const unsigned tg = og / nx;
            if (og + 1u == (tg + 1u) * nx) xb_add(&bar[XB_TOPGEN], 1u);
            else XB_SPIN(xb_ld(&bar[XB_TOPGEN]) == tg, bar);
            __builtin_amdgcn_fence(__ATOMIC_ACQUIRE, "agent");
            xb_add(&bar[XB_XGEN(b.x)], 1u);
            asm volatile("s_waitcnt vmcnt(0)" ::: "memory");
        } else {
            XB_SPIN(xb_ld(&bar[XB_XGEN(b.x)]) == gen, bar);
            __builtin_amdgcn_fence(__ATOMIC_ACQUIRE, "agent");
            asm volatile("s_waitcnt vmcnt(0)" ::: "memory");
        }
    }
    __syncthreads();
}

struct MapIdent { __device__ __forceinline__ int operator()(int p) const { return p; } };
struct MapWin { __device__ __forceinline__ int operator()(int p) const {
    if (p < 3584) return p; if (p < 5632) return p + 72; if (p < NPROJ) return p + 80;
    const int r = p - NPROJ; if (r < 64) return LC_IK + r; if (r < 72) return LC_IW + (r - 64); if (r < 76) return LC_MI + (r - 72); if (r < 80) return LC_MF + (r - 76); return -1; } };
struct MapFfn { __device__ __forceinline__ int operator()(int p) const { const int t = p >> 8, r = p & 255; return r < 128 ? 128 * t + r : FF + 128 * t + (r - 128); } };
template <class Map> __device__ __forceinline__ void transpose_item(const float* W, int K, int N, bf16* WT, LAS float* scr, int item, int nblk, int lane, const Map& map) {
    const int kb = item / nblk, nb = item % nblk, k0 = 64 * kb, p0 = 32 * nb;
    const int nl = map(p0 + (lane & 31));
#pragma unroll 8
    for (int i = 0; i < 32; ++i) { const int kk = 2 * i + (lane >> 5); scr[kk * 33 + (lane & 31)] = nl >= 0 ? W[(size_t)(k0 + kk) * N + nl] : 0.f; }
    LDS_WAIT(); asm volatile("" ::: "memory");
    const int c = lane & 7;
#pragma unroll
    for (int j = 0; j < 4; ++j) { const int n = (lane >> 3) + 8 * j; const LAS float* s = scr + (8 * c) * 33 + n;
        v4u o; o.x = pk2(s[0 * 33], s[1 * 33]); o.y = pk2(s[2 * 33], s[3 * 33]); o.z = pk2(s[4 * 33], s[5 * 33]); o.w = pk2(s[6 * 33], s[7 * 33]);
        *(GAS v4u*)(WT + (size_t)(p0 + n) * K + k0 + 8 * c) = o; }
    LDS_WAIT(); asm volatile("" ::: "memory");
}
template <class Map> __device__ __forceinline__ void transpose_matrix(const float* W, int K, int N, int Nphys, bf16* WT, LAS float* scr, int gw, int ngw, int lane, const Map& map) {
    const int nblk = Nphys / 32, nit = (K / 64) * nblk;
    for (int it = gw; it < nit; it += ngw) transpose_item(W, K, N, WT, scr, it, nblk, lane, map);
}

__device__ __forceinline__ void rms_row_to_bf16(const float* xrow, const float* gain, bf16* orow, int lane) {
    const GAS f32x4* xr = (const GAS f32x4*)xrow + lane; const GAS f32x4* gr = (const GAS f32x4*)gain + lane;
    f32x4 v[8]; float s = 0.f;
#pragma unroll
    for (int j = 0; j < 8; ++j) { v[j] = xr[64 * j]; s += (v[j].x * v[j].x + v[j].y * v[j].y) + (v[j].z * v[j].z + v[j].w * v[j].w); }
    const float rstd = 1.0f / sqrtf(wave_sum(s) * (1.f / DM) + NORM_EPS);
    GAS unsigned long long* o8 = (GAS unsigned long long*)orow + lane;
#pragma unroll
    for (int j = 0; j < 8; ++j) { const f32x4 g = gr[64 * j]; o8[64 * j] = (unsigned long long)pk2(v[j].x * rstd * g.x, v[j].y * rstd * g.y) | ((unsigned long long)pk2(v[j].z * rstd * g.z, v[j].w * rstd * g.w) << 32); }
}

struct PPArgs { bf16* proj; const float* small; bf16* mqk; bf16* ikb; float* iwf; float* gif; const float* rope128; const float* rope64; const float* gq; const float* gk; const float* convw; const float* gbias; };
__device__ __forceinline__ void pp_row(const PPArgs& a, int t, int lane) {
    bf16* pr = a.proj + (size_t)t * NPROJ;
    const float2 cs = ((const float2*)a.rope128)[t * 64 + lane];
    const float2 c6 = ((const float2*)a.rope64)[t * 32 + (lane & 31)];
#pragma unroll 1
    for (int which = 0; which < 2; ++which) {
        const float* gn = which ? a.gk : a.gq; const float g1 = gn[lane], g2 = gn[64 + lane];
#pragma unroll 2
        for (int hh = 0; hh < 8; ++hh) { bf16* p = pr + (which ? PC_AK : PC_AQ) + hh * 128;
            const float x1 = bf2f(p[lane]), x2 = bf2f(p[64 + lane]);
            const float rstd = 1.0f / sqrtf(wave_sum(x1 * x1 + x2 * x2) * (1.f / 128.f) + NORM_EPS);
            const float y1 = x1 * rstd * g1, y2 = x2 * rstd * g2;
            p[lane] = (bf16)f2bf(y1 * cs.x - y2 * cs.y); p[64 + lane] = (bf16)f2bf(y2 * cs.x + y1 * cs.y); }
    }
#pragma unroll 1
    for (int which = 0; which < 2; ++which) {
#pragma unroll 2
        for (int hh = 0; hh < 8; ++hh) { bf16* p = pr + (which ? PC_RK : PC_RQ) + hh * 128;
            const float y1 = bf2f(p[lane]), y2 = bf2f(p[64 + lane]);
            p[lane] = (bf16)f2bf(y1 * cs.x - y2 * cs.y); p[64 + lane] = (bf16)f2bf(y2 * cs.x + y1 * cs.y); }
    }
#pragma unroll
    for (int p4 = 0; p4 < 4; ++p4) { bf16* p = pr + PC_IQ + (2 * p4 + (lane >> 5)) * 64; const int i = lane & 31;
        const float y1 = bf2f(p[i]), y2 = bf2f(p[32 + i]);
        p[i] = (bf16)f2bf(y1 * c6.x - y2 * c6.y); p[32 + i] = (bf16)f2bf(y2 * c6.x + y1 * c6.y); }
    const float* sm = a.small + (size_t)t * 256;
    if (lane < 32) { const float y1 = sm[lane], y2 = sm[32 + lane];
        a.ikb[(size_t)t * 64 + lane] = (bf16)f2bf(y1 * c6.x - y2 * c6.y); a.ikb[(size_t)t * 64 + 32 + lane] = (bf16)f2bf(y2 * c6.x + y1 * c6.y); }
    if (lane < 8) { a.iwf[(size_t)t * 8 + lane] = sm[64 + lane] * (0.35355339059327373f * 0.125f);
        a.gif[(size_t)t * 8 + lane] = sm[72 + lane] + a.gbias[lane]; }
#pragma unroll 4
    for (int i = 0; i < 16; ++i) { const int c = lane + 64 * i; float acc = 0.f;
#pragma unroll
        for (int j = 0; j < 4; ++j) { const int tt = t - 3 + j; if (tt >= 0) acc += a.convw[j * 1024 + c] * bf2f(a.proj[(size_t)tt * NPROJ + PC_MQ + c]); }
        a.mqk[(size_t)t * 1024 + c] = (bf16)f2bf(acc); }
}

__device__ __forceinline__ void score_wave_unit(const bf16* proj, const bf16* ikb, const float* iwf, float* sc, int qb, int kb, int lane) {
    const int r = lane & 31, h = lane >> 5, q = qb * 32 + r, s0 = kb * 128;
    bf16x8 ka[4][4];
#pragma unroll
    for (int b = 0; b < 4; ++b)
#pragma unroll
        for (int kk = 0; kk < 4; ++kk) ka[b][kk] = *(const bf16x8*)(ikb + (size_t)(s0 + 32 * b + r) * 64 + 16 * kk + 8 * h);
    f32x16 scv[4];
#pragma unroll
    for (int b = 0; b < 4; ++b)
#pragma unroll
        for (int e = 0; e < 16; ++e) scv[b][e] = 0.f;
#pragma unroll 1
    for (int j = 0; j < 8; ++j) {
        bf16x8 qf[4];
#pragma unroll
        for (int kk = 0; kk < 4; ++kk) qf[kk] = *(const bf16x8*)(proj + (size_t)q * NPROJ + PC_IQ + j * 64 + 16 * kk + 8 * h);
        const float wj = iwf[(size_t)q * 8 + j];
#pragma unroll
        for (int b = 0; b < 4; ++b) { f32x16 acc;
#pragma unroll
            for (int e = 0; e < 16; ++e) acc[e] = 0.f;
#pragma unroll
            for (int kk = 0; kk < 4; ++kk) acc = __builtin_amdgcn_mfma_f32_32x32x16_bf16(ka[b][kk], qf[kk], acc, 0, 0, 0);
#pragma unroll
            for (int e = 0; e < 16; ++e) scv[b][e] += wj * fmaxf(acc[e], 0.f); }
    }
#pragma unroll
    for (int b = 0; b < 4; ++b)
#pragma unroll
        for (int g = 0; g < 4; ++g) *(f32x4*)(sc + (size_t)q * S + s0 + 32 * b + 8 * g + 4 * h) = (f32x4){scv[b][4 * g], scv[b][4 * g + 1], scv[b][4 * g + 2], scv[b][4 * g + 3]};
}

__device__ __forceinline__ unsigned sel_key(float v) { v += 0.0f; const unsigned b = __float_as_uint(v); return (b & 0x80000000u) ? ~b : (b | 0x80000000u); }
__device__ __forceinline__ void select_rows_wg(LAS unsigned char* lds, const float* sc, unsigned long long* mb, int row0, int rstep, int tid) {
    LAS unsigned* hist = (LAS unsigned*)lds; LAS unsigned* wsum = hist + 2048; LAS unsigned* res = hist + 2064; LAS unsigned* cnt = hist + 2080;
    const int lane = tid & 63, w = tid >> 6;
    float nx[16];
#define SEL_LOAD(t_) do { const float* scr_ = sc + (size_t)(t_) * S; _Pragma("unroll") for (int i = 0; i < 16; ++i) { const int s_ = i * 512 + tid; nx[i] = (s_ <= (t_)) ? scr_[s_] : 0.f; } } while (0)
    if (row0 < S) SEL_LOAD(row0);
    for (int t = row0; t < S; t += rstep) {
        unsigned u[16];
#pragma unroll
        for (int i = 0; i < 16; ++i) u[i] = sel_key(nx[i]);
        if (t + rstep < S) SEL_LOAD(t + rstep);
        unsigned long long* mbr = mb + (size_t)t * 128;
        const int nround = (t >> 9) + 1;
        unsigned T = 0u, need = 256u, hsel = 0u;
        if (t >= 256) {
#pragma unroll 1
            for (int lvl = 0; lvl < 3; ++lvl) {
                const int shift = lvl == 0 ? 21 : (lvl == 1 ? 10 : 0), nb = lvl == 2 ? 10 : 11;
                const unsigned hmask = lvl == 0 ? 0u : (lvl == 1 ? 0xffe00000u : 0xfffffc00u);
#pragma unroll
                for (int j = 0; j < 4; ++j) hist[4 * tid + j] = 0u;
                __syncthreads();
#pragma unroll
                for (int i = 0; i < 16; ++i) if (i < nround) { const int s = i * 512 + tid;
                    if (s <= t && ((u[i] ^ T) & hmask) == 0u) (void)__hip_atomic_fetch_add(hist + ((u[i] >> shift) & ((1u << nb) - 1u)), 1u, __ATOMIC_RELAXED, __HIP_MEMORY_SCOPE_WORKGROUP); }
                __syncthreads();
                const unsigned h0 = hist[4 * tid], h1 = hist[4 * tid + 1], h2 = hist[4 * tid + 2], h3 = hist[4 * tid + 3], ts = h0 + h1 + h2 + h3;
                unsigned suf = ts;
#pragma unroll
                for (int o = 1; o < 64; o <<= 1) { const unsigned y = __shfl_down(suf, o); if (lane + o < 64) suf += y; }
                if (lane == 0) wsum[w] = suf;
                __syncthreads();
                unsigned above = suf - ts;
#pragma unroll
                for (int ww = 1; ww < 8; ++ww) if (ww > w) above += wsum[ww];
                if (above < need && above + h3 >= need) { res[0] = 4 * tid + 3; res[1] = above; res[2] = h3; } above += h3;
                if (above < need && above + h2 >= need) { res[0] = 4 * tid + 2; res[1] = above; res[2] = h2; } above += h2;
                if (above < need && above + h1 >= need) { res[0] = 4 * tid + 1; res[1] = above; res[2] = h1; } above += h1;
                if (above < need && above + h0 >= need) { res[0] = 4 * tid; res[1] = above; res[2] = h0; }
                __syncthreads();
                T |= res[0] << shift; need -= res[1]; hsel = res[2];
            }
        }
        const bool all_ties = (hsel == need);
        if (t >= 256 && !all_ties) {
#pragma unroll
            for (int i = 0; i < 16; ++i) { const int s = i * 512 + tid; const unsigned long long em = __builtin_amdgcn_ballot_w64(s <= t && u[i] == T); if (lane == 0) cnt[i * 8 + w] = (unsigned)__builtin_popcountll(em); }
            __syncthreads();
        }
#pragma unroll
        for (int i = 0; i < 16; ++i) { const int s = i * 512 + tid; bool sel = s <= t;
            if (t >= 256) { const bool eq = u[i] == T; bool take = true;
                if (!all_ties) { const unsigned long long em = __builtin_amdgcn_ballot_w64(sel && eq); unsigned rank = __builtin_amdgcn_mbcnt_hi((unsigned)(em >> 32), __builtin_amdgcn_mbcnt_lo((unsigned)em, 0u));
                    for (int k = 0; k < i * 8 + w; ++k) rank += cnt[k];
                    take = rank < need; }
                sel = sel && (u[i] > T || (eq && take)); }
            const unsigned long long m = __builtin_amdgcn_ballot_w64(sel);
            if (lane == 0) mbr[i * 8 + w] = m; }
        __syncthreads();
    }
#undef SEL_LOAD
}

template <int RS> __device__ __forceinline__ bf16x8 frag_row(const LAS unsigned char* base, int r0, int k0, int lane) {
    return *(const LAS bf16x8*)(base + (r0 + (lane & 15)) * RS + (k0 + 8 * (lane >> 4)) * 2);
}
template <int RS> __device__ __forceinline__ bf16x8 frag_tr(const LAS unsigned char* base, int k0, int c0, int lane) {
    const int g = lane >> 4, q = (lane & 15) >> 2, p = lane & 3;
    const unsigned a = (unsigned)(size_t)(base + (k0 + 8 * g + q) * RS + (c0 + 4 * p) * 2);
    s16x4 lo, hi;
    asm volatile("ds_read_b64_tr_b16 %0, %2\n\tds_read_b64_tr_b16 %1, %2 offset:%3\n\ts_waitcnt lgkmcnt(0)" : "=&v"(lo), "=&v"(hi) : "v"(a), "i"(4 * RS) : "memory");
    return (bf16x8){lo[0], lo[1], lo[2], lo[3], hi[0], hi[1], hi[2], hi[3]};
}
#define MFMA16(a, b, c) __builtin_amdgcn_mfma_f32_16x16x32_bf16((a), (b), (c), 0, 0, 0)
constexpr int SCR_OFF = 114688;
constexpr float DK_SCALE = 0.08838834764831845f;
__device__ __forceinline__ float log_sigmoid_f(float x) { return fminf(x, 0.f) - log1pf(expf(-fabsf(x))); }

template <int L, int DV> __device__ __forceinline__ void chunk_delta(LAS unsigned char* lds, const bf16* ksrc, int ldk, const bf16* vsrc, int ldv, const LAS float* wcol, bf16* outT, float* dn, int tid) {
    constexpr int RSK = (128 + 8) * 2, RSV = (DV + 8) * 2, NCB = DV / 128;
    LAS unsigned char* KA = lds; LAS unsigned char* V = lds + L * RSK;
    const int lane = tid & 63, w = tid >> 6;
    for (int idx = tid; idx < L * 16; idx += NTHR) { const int s = idx >> 4, c8 = idx & 15;
        const v4u x = *(const GAS v4u*)(ksrc + (size_t)s * ldk + c8 * 8); const float sc = DK_SCALE * wcol[s]; v4u o;
        o.x = pk2(__uint_as_float(x.x << 16) * sc, __uint_as_float(x.x & 0xffff0000u) * sc); o.y = pk2(__uint_as_float(x.y << 16) * sc, __uint_as_float(x.y & 0xffff0000u) * sc);
        o.z = pk2(__uint_as_float(x.z << 16) * sc, __uint_as_float(x.z & 0xffff0000u) * sc); o.w = pk2(__uint_as_float(x.w << 16) * sc, __uint_as_float(x.w & 0xffff0000u) * sc);
        *(LAS v4u*)(KA + s * RSK + c8 * 16) = o; }
    for (int idx = tid; idx < L * (DV / 8); idx += NTHR) { const int s = idx / (DV / 8), c8 = idx % (DV / 8);
        *(LAS v4u*)(V + s * RSV + c8 * 16) = *(const GAS v4u*)(vsrc + (size_t)s * ldv + c8 * 8); }
    __syncthreads();
    f32x4 acc[8][NCB];
#pragma unroll
    for (int db = 0; db < 8; ++db)
#pragma unroll
        for (int i = 0; i < NCB; ++i) acc[db][i] = (f32x4){0.f, 0.f, 0.f, 0.f};
#pragma unroll
    for (int kk = 0; kk < L / 32; ++kk) {
        bf16x8 bfr[NCB];
#pragma unroll
        for (int i = 0; i < NCB; ++i) bfr[i] = frag_tr<RSV>(V, 32 * kk, 16 * (w * NCB + i), lane);
#pragma unroll
        for (int db = 0; db < 8; ++db) { const bf16x8 a = frag_tr<RSK>(KA, 32 * kk, 16 * db, lane);
#pragma unroll
            for (int i = 0; i < NCB; ++i) acc[db][i] = MFMA16(a, bfr[i], acc[db][i]); }
    }
#pragma unroll
    for (int db = 0; db < 8; ++db)
#pragma unroll
        for (int i = 0; i < NCB; ++i) { const int e = 16 * (w * NCB + i) + (lane & 15), d0 = 16 * db + 4 * (lane >> 4);
            v2u o; o.x = pk2(acc[db][i][0], acc[db][i][1]); o.y = pk2(acc[db][i][2], acc[db][i][3]);
            *(GAS v2u*)(outT + (size_t)e * 128 + d0) = o; }
    if (dn != nullptr && tid < 128) { float s_ = 0.f;
        for (int s = 0; s < L; ++s) s_ += bf2f(*(const LAS bf16*)(KA + s * RSK + tid * 2));
        dn[tid] = s_; }
    __syncthreads();
}

template <int L, int DV, int MODE> __device__ __forceinline__ void chunk_out(LAS unsigned char* lds, LAS float* sf, const bf16* qsrc, int ldq, const bf16* ksrc, int ldk, const bf16* vsrc, int ldv,
                                                                              const bf16* stT, const float* gain, const bf16* gate, int ldg, bf16* y, int ldy, int tid) {
    constexpr int RSQ = (128 + 8) * 2, RSV = (DV + 8) * 2, RSP = (L + 8) * 2, NCB = DV / 128, NT = L / 16, TPW = NT * NT / 8;
    LAS unsigned char* Q = lds; LAS unsigned char* K = lds + L * RSQ; LAS unsigned char* V = lds + 2 * L * RSQ;
    LAS unsigned char* P = (MODE == 0) ? (lds + 2 * L * RSQ + L * RSV) : K;
    LAS float* H = (LAS float*)lds;
    LAS float* lrow = sf; LAS float* lcol = sf + 128; LAS float* qs = sf + 256; LAS float* flo = sf + 384; LAS float* rowsum = sf + 512; LAS float* npv = sf + 640; LAS float* part = sf + 768; LAS float* dpart = sf + 768 + L * NT;
    const int lane = tid & 63, w = tid >> 6, g4 = lane >> 4, c16 = lane & 15;
    for (int idx = tid; idx < L * 16; idx += NTHR) { const int s = idx >> 4, c8 = idx & 15;
        *(LAS v4u*)(Q + s * RSQ + c8 * 16) = *(const GAS v4u*)(qsrc + (size_t)s * ldq + c8 * 8);
        *(LAS v4u*)(K + s * RSQ + c8 * 16) = *(const GAS v4u*)(ksrc + (size_t)s * ldk + c8 * 8); }
    for (int idx = tid; idx < L * (DV / 8); idx += NTHR) { const int s = idx / (DV / 8), c8 = idx % (DV / 8);
        *(LAS v4u*)(V + s * RSV + c8 * 16) = *(const GAS v4u*)(vsrc + (size_t)s * ldv + c8 * 8); }
    __syncthreads();
    f32x4 pv[TPW];
#pragma unroll
    for (int i = 0; i < TPW; ++i) { const int ti = w * TPW + i, rb = ti / NT, cb = ti % NT; f32x4 a = (f32x4){0.f, 0.f, 0.f, 0.f};
        if (cb <= rb) {
#pragma unroll
            for (int kk = 0; kk < 4; ++kk) a = MFMA16(frag_row<RSQ>(Q, 16 * rb, 32 * kk, lane), frag_row<RSQ>(K, 16 * cb, 32 * kk, lane), a);
            const int s = 16 * cb + c16; const float lc = lcol[s]; float rs[4];
#pragma unroll
            for (int r = 0; r < 4; ++r) { const int t = 16 * rb + 4 * g4 + r; const float pw = (s <= t) ? __expf(lrow[t] + lc) * a[r] * DK_SCALE : 0.f; a[r] = pw; rs[r] = pw; }
            if (MODE == 0) {
#pragma unroll
                for (int r = 0; r < 4; ++r) { float v = rs[r]; v += __shfl_xor(v, 1); v += __shfl_xor(v, 2); v += __shfl_xor(v, 4); v += __shfl_xor(v, 8);
                    if (c16 == 0) part[(16 * rb + 4 * g4 + r) * NT + cb] = v; } }
        } else if (MODE == 0) { if (c16 == 0) {
#pragma unroll
                for (int r = 0; r < 4; ++r) part[(16 * rb + 4 * g4 + r) * NT + cb] = 0.f; } }
        pv[i] = a; }
    __syncthreads();
#pragma unroll
    for (int i = 0; i < TPW; ++i) { const int ti = w * TPW + i, rb = ti / NT, cb = ti % NT;
#pragma unroll
        for (int r = 0; r < 4; ++r) *(LAS bf16*)(P + (16 * rb + 4 * g4 + r) * RSP + (16 * cb + c16) * 2) = (bf16)f2bf(pv[i][r]); }
    for (int idx = tid; idx < L * 16; idx += NTHR) { const int s = idx >> 4, c8 = idx & 15; const float sc = qs[s];
        const v4u x = *(const LAS v4u*)(Q + s * RSQ + c8 * 16); float f[8];
        f[0] = __uint_as_float(x.x << 16) * sc; f[1] = __uint_as_float(x.x & 0xffff0000u) * sc; f[2] = __uint_as_float(x.y << 16) * sc; f[3] = __uint_as_float(x.y & 0xffff0000u) * sc;
        f[4] = __uint_as_float(x.z << 16) * sc; f[5] = __uint_as_float(x.z & 0xffff0000u) * sc; f[6] = __uint_as_float(x.w << 16) * sc; f[7] = __uint_as_float(x.w & 0xffff0000u) * sc;
        v4u o; o.x = pk2(f[0], f[1]); o.y = pk2(f[2], f[3]); o.z = pk2(f[4], f[5]); o.w = pk2(f[6], f[7]);
        *(LAS v4u*)(Q + s * RSQ + c8 * 16) = o;
        if (MODE == 0) { float dsum = 0.f;
#pragma unroll
            for (int j = 0; j < 8; ++j) dsum += f[j] * npv[8 * c8 + j];
            dpart[s * 16 + c8] = dsum; } }
    __syncthreads();
    if (MODE == 0 && tid < L) { float a = 0.f;
#pragma unroll
        for (int j = 0; j < NT; ++j) a += part[tid * NT + j];
#pragma unroll
        for (int j = 0; j < 16; ++j) a += dpart[tid * 16 + j];
        rowsum[tid] = a; }
    f32x4 acc[NT][NCB];
#pragma unroll
    for (int rb = 0; rb < NT; ++rb)
#pragma unroll
        for (int i = 0; i < NCB; ++i) acc[rb][i] = (f32x4){0.f, 0.f, 0.f, 0.f};
#pragma unroll
    for (int kk = 0; kk < 4; ++kk) { bf16x8 bfr[NCB];
#pragma unroll
        for (int i = 0; i < NCB; ++i) bfr[i] = *(const GAS bf16x8*)(stT + (size_t)(16 * (w * NCB + i) + c16) * 128 + 32 * kk + 8 * g4);
#pragma unroll
        for (int rb = 0; rb < NT; ++rb) { const bf16x8 a = frag_row<RSQ>(Q, 16 * rb, 32 * kk, lane);
#pragma unroll
            for (int i = 0; i < NCB; ++i) acc[rb][i] = MFMA16(a, bfr[i], acc[rb][i]); } }
#pragma unroll
    for (int kk = 0; kk < L / 32; ++kk) { bf16x8 bfr[NCB];
#pragma unroll
        for (int i = 0; i < NCB; ++i) bfr[i] = frag_tr<RSV>(V, 32 * kk, 16 * (w * NCB + i), lane);
#pragma unroll
        for (int rb = 0; rb < NT; ++rb) { const bf16x8 a = frag_row<RSP>(P, 16 * rb, 32 * kk, lane);
#pragma unroll
            for (int i = 0; i < NCB; ++i) acc[rb][i] = MFMA16(a, bfr[i], acc[rb][i]); } }
    __syncthreads();
#pragma unroll
    for (int rb = 0; rb < NT; ++rb)
#pragma unroll
        for (int i = 0; i < NCB; ++i)
#pragma unroll
            for (int r = 0; r < 4; ++r) { const int t = 16 * rb + 4 * g4 + r, e = 16 * (w * NCB + i) + c16; float hv = acc[rb][i][r];
                if (MODE == 0) hv = hv / fmaxf(fabsf(rowsum[t]), flo[t]);
                H[t * DV + e] = hv; }
    __syncthreads();
    for (int t = w; t < L; t += NWAVES) { float hv[DV / 64]; float s1 = 0.f;
#pragma unroll
        for (int i = 0; i < DV / 64; ++i) { hv[i] = H[t * DV + lane + 64 * i]; s1 += hv[i]; }
        float mu = 0.f; if (MODE == 1) { mu = wave_sum(s1) * (1.f / DV); }
        float s2 = 0.f;
#pragma unroll
        for (int i = 0; i < DV / 64; ++i) { hv[i] -= mu; s2 += hv[i] * hv[i]; }
        const float rstd = 1.0f / sqrtf(wave_sum(s2) * (1.f / DV) + NORM_EPS);
#pragma unroll
        for (int i = 0; i < DV / 64; ++i) { const int e = lane + 64 * i; const float gt = bf2f(gate[(size_t)t * ldg + e]);
            const float act = (MODE == 0) ? sigmoid_f(gt) : gt * sigmoid_f(gt);
            y[(size_t)t * ldy + e] = (bf16)f2bf(hv[i] * rstd * gain[e] * act); } }
    __syncthreads();
}
namespace att {
constexpr int D = 128, LDQKV = NPROJ, LDO = 1024;
constexpr float THR = 8.f; constexpr bool WSKIP = false;
constexpr float SCALE = 0.08838834764831845f;
constexpr int NW = 8, QBLK = 32, KVBLK = 64, QB = NW * QBLK;
constexpr int SHM_V = KVBLK * D * 2, SHM_K = KVBLK * D * 2;
constexpr int LDS_BYTES = 2 * SHM_V + 2 * SHM_K + NW * 64 * 4;

using bf16 = unsigned short;
typedef short bf16x8 __attribute__((ext_vector_type(8)));
typedef short s16x4 __attribute__((ext_vector_type(4)));
typedef float f32x16 __attribute__((ext_vector_type(16)));
typedef float f32x4 __attribute__((ext_vector_type(4)));
typedef unsigned u32x4 __attribute__((ext_vector_type(4)));
template <class A, class Bt> struct same_t { static constexpr bool v = false; };
template <class A> struct same_t<A, A> { static constexpr bool v = true; };

#define KSWZ(row, colB) ((row) * 256 + ((colB) ^ (((row) & 7) << 4)))
#define SBAR() __builtin_amdgcn_sched_barrier(0)
__device__ __forceinline__ int v_st(int k, int c) { const int kk = (k & ~0xC) | ((k & 4) << 1) | ((k & 8) >> 1); return ((kk >> 3) * 4 + (c >> 5)) * 512 + ((kk & 7) * 32 + (c & 31)) * 2; }
__device__ __forceinline__ int v_rd_base(int lane) { return ((lane & 3) << 3) | (((lane >> 2) & 3) << 6) | (((lane >> 4) & 1) << 5) | (((lane >> 5) & 1) << 8); }
constexpr int v_rd_off(int d0, int ks, int half) { return d0 * 512 + ks * 4096 + half * 2048; }
__device__ __forceinline__ int crow(int r, int hi) { return (r & 3) + 8 * (r >> 2) + 4 * hi; }
__device__ __forceinline__ unsigned cvtpk(float lo, float hi) {
    unsigned r; asm volatile("v_cvt_pk_bf16_f32 %0, %1, %2" : "=v"(r) : "v"(lo), "v"(hi)); return r;
}
__device__ __forceinline__ bf16x8 pack8(f32x4 a, f32x4 b) {
    u32x4 w = {cvtpk(a[0], a[1]), cvtpk(a[2], a[3]), cvtpk(b[0], b[1]), cvtpk(b[2], b[3])};
    return *reinterpret_cast<bf16x8*>(&w);
}
template <class T> __device__ __forceinline__ bf16x8 load8(const T* p) {
    if constexpr (same_t<T, float>::v) { return pack8(*(const f32x4*)p, *(const f32x4*)(p + 4)); }
    else { return *reinterpret_cast<const bf16x8*>(p); }
}
__device__ __forceinline__ void mask_bits(f32x16& p0, f32x16& p1, unsigned long long mw, int hi) {
    const unsigned a = (unsigned)mw >> (4 * hi), b = (unsigned)(mw >> 32) >> (4 * hi);
#pragma unroll
    for (int r = 0; r < 16; ++r) {
        const int c = (r & 3) + 8 * (r >> 2);
        const unsigned ma = (unsigned)(((int)(a << (31 - c))) >> 31), mb = (unsigned)(((int)(b << (31 - c))) >> 31);
        p0[r] = __uint_as_float((__float_as_uint(p0[r]) & ma) | (0xff800000u & ~ma));
        p1[r] = __uint_as_float((__float_as_uint(p1[r]) & mb) | (0xff800000u & ~mb));
    }
}
__device__ __forceinline__ void partialSM(f32x16& p0, f32x16& p1, float& m_reg, float& mn, float& alpha) {
    float pmax = p0[0]; for (int r = 1; r < 16; ++r) pmax = fmaxf(pmax, p0[r]); for (int r = 0; r < 16; ++r) pmax = fmaxf(pmax, p1[r]);
    { auto rr = __builtin_amdgcn_permlane32_swap(__float_as_uint(pmax), __float_as_uint(pmax), false, false);
      pmax = fmaxf(__uint_as_float(rr[0]), __uint_as_float(rr[1])); }
    constexpr float C2 = 1.4426950408889634f * SCALE;
    if (__builtin_expect(__all((pmax - m_reg) * SCALE <= THR), 1)) { mn = m_reg; alpha = 1.f; }
    else { mn = fmaxf(m_reg, pmax); alpha = __builtin_amdgcn_exp2f((m_reg - mn) * C2); m_reg = mn; }
    const float mnL = -mn * C2;
    for (int r = 0; r < 16; ++r) p0[r] = fmaf(p0[r], C2, mnL); for (int r = 0; r < 16; ++r) p1[r] = fmaf(p1[r], C2, mnL);
    for (int r = 0; r < 16; ++r) p0[r] = __builtin_amdgcn_exp2f(p0[r]);
}
__device__ __forceinline__ void finishSM(f32x16& p0, f32x16& p1, float alpha, float& l_reg, bf16x8& pa0, bf16x8& pa1, bf16x8& pa2, bf16x8& pa3) {
    for (int r = 0; r < 16; ++r) p1[r] = __builtin_amdgcn_exp2f(p1[r]);
    float ps = 0; for (int r = 0; r < 16; ++r) ps += p0[r]; for (int r = 0; r < 16; ++r) ps += p1[r];
    { auto rr = __builtin_amdgcn_permlane32_swap(__float_as_uint(ps), __float_as_uint(ps), false, false);
      ps = __uint_as_float(rr[0]) + __uint_as_float(rr[1]); }
    l_reg = l_reg * alpha + ps;
#define PK4(P, B_, OUT) do { unsigned a0 = cvtpk(P[B_+0], P[B_+1]), a1 = cvtpk(P[B_+2], P[B_+3]);                          \
        unsigned b0 = cvtpk(P[B_+4], P[B_+5]), b1 = cvtpk(P[B_+6], P[B_+7]);                                             \
        auto r0 = __builtin_amdgcn_permlane32_swap(a0, b0, false, false); auto r1 = __builtin_amdgcn_permlane32_swap(a1, b1, false, false); \
        u32x4 w = {r0[0], r1[0], r0[1], r1[1]}; OUT = *reinterpret_cast<bf16x8*>(&w); } while (0)
    PK4(p0, 0, pa0); PK4(p0, 8, pa1); PK4(p1, 0, pa2); PK4(p1, 8, pa3);
#undef PK4
}
template <int KB, bool SK>
__device__ __forceinline__ void qkt(f32x16& p0, f32x16& p1, const char* K_lds, int r32, int hi, const bf16x8* qr, bool act) {
    if (SK && !act) { const float NEG = -__builtin_inff();
#pragma unroll
        for (int r = 0; r < 16; ++r) { p0[r] = NEG; p1[r] = NEG; } return; }
    p0 = f32x16{}; p1 = f32x16{};
    const char* kb[4];
#pragma unroll
    for (int dd = 0; dd < 4; ++dd) kb[dd] = K_lds + KB * SHM_K + KSWZ(r32, (dd * 16 + hi * 8) * 2);
#pragma unroll
    for (int d0 = 0; d0 < 8; ++d0) { const char* a = kb[d0 & 3] + (d0 >> 2) * 128;
        bf16x8 b0 = *reinterpret_cast<const bf16x8*>(a);
        bf16x8 b1 = *reinterpret_cast<const bf16x8*>(a + 32 * 256);
        p0 = __builtin_amdgcn_mfma_f32_32x32x16_bf16(b0, qr[d0], p0, 0, 0, 0);
        p1 = __builtin_amdgcn_mfma_f32_32x32x16_bf16(b1, qr[d0], p1, 0, 0, 0); }
}
template <int VB, bool SK>
__device__ __forceinline__ void pv_tile(f32x16* o, int vb0, bf16x8 pa0, bf16x8 pa1, bf16x8 pa2, bf16x8 pa3, bool act) {
    if (SK && !act) return;
#define TRRD(dst, off) asm volatile("ds_read_b64_tr_b16 %0, %1 offset:%2" : "=&v"(dst) : "v"(vb0), "i"(off) : "memory")
#define PV_D0(d0) do { s16x4 l0, l1, l2, l3, h0, h1, h2, h3; constexpr int b_ = VB * SHM_V + v_rd_off(d0, 0, 0);     \
        TRRD(l0, b_); TRRD(h0, b_ + 2048); TRRD(l1, b_ + 4096); TRRD(h1, b_ + 6144); TRRD(l2, b_ + 8192); TRRD(h2, b_ + 10240); TRRD(l3, b_ + 12288); TRRD(h3, b_ + 14336); \
        asm volatile("s_waitcnt lgkmcnt(0)" ::: "memory"); SBAR();                 \
        o[d0] = __builtin_amdgcn_mfma_f32_32x32x16_bf16(pa0, (bf16x8){l0[0], l0[1], l0[2], l0[3], h0[0], h0[1], h0[2], h0[3]}, o[d0], 0, 0, 0);   \
        o[d0] = __builtin_amdgcn_mfma_f32_32x32x16_bf16(pa1, (bf16x8){l1[0], l1[1], l1[2], l1[3], h1[0], h1[1], h1[2], h1[3]}, o[d0], 0, 0, 0);   \
        o[d0] = __builtin_amdgcn_mfma_f32_32x32x16_bf16(pa2, (bf16x8){l2[0], l2[1], l2[2], l2[3], h2[0], h2[1], h2[2], h2[3]}, o[d0], 0, 0, 0);   \
        o[d0] = __builtin_amdgcn_mfma_f32_32x32x16_bf16(pa3, (bf16x8){l3[0], l3[1], l3[2], l3[3], h3[0], h3[1], h3[2], h3[3]}, o[d0], 0, 0, 0); } while (0)
    PV_D0(0); PV_D0(1); PV_D0(2); PV_D0(3);
#undef PV_D0
#undef TRRD
}

template <class TIn, class TOut> struct BlockRef { const TIn* Q; const TIn* K; const TIn* V; TOut* O; const unsigned long long* M; int P0; };
template <class TIn> struct Seam {
    bf16x8 qr[8];
    bf16x8 st_v0, st_v1, st_k0, st_k1; f32x4 sf0, sf1, sf2, sf3;
    f32x4 tq[16];
};
__device__ __forceinline__ int swa_jlo(int P0, int W) { const int lowk = P0 - W + 1; return lowk > 0 ? lowk / KVBLK : 0; }
#define ROW(p, k0, rr) ((p) + (size_t)((k0) + (rr)) * LDQKV + sc)
#define VMW() asm volatile("s_waitcnt vmcnt(0)" ::: "memory")
#define VMWN(n) asm volatile("s_waitcnt vmcnt(%0)" :: "i"(n) : "memory")
#define LD16U(base, off) (*reinterpret_cast<const bf16x8*>((const char*)(base) + (off)))
#define SLOAD_H(Kp, Vp, k0) do { const char* kb_ = (const char*)((Kp) + (size_t)(k0) * LDQKV); const char* vb_ = (const char*)((Vp) + (size_t)(k0) * LDQKV);                 \
                         S.st_v0 = LD16U(vb_, soff); S.st_v1 = LD16U(vb_ + (size_t)32 * LDQKV * 2, soff);                                  \
                         S.st_k0 = LD16U(kb_, soff); S.st_k1 = LD16U(kb_ + (size_t)32 * LDQKV * 2, soff); } while (0)
#define SWRITE_HK(bf) do { *(bf16x8*)(K_lds + (bf) * SHM_K + kws) = S.st_k0; *(bf16x8*)(K_lds + (bf) * SHM_K + kws + 32 * 256) = S.st_k1; } while (0)
#define SWRITE_HV(bf) do { *(bf16x8*)(V_lds + (bf) * SHM_V + vst0) = S.st_v0; *(bf16x8*)(V_lds + (bf) * SHM_V + vst1) = S.st_v1; } while (0)
#define SWRITE_H(bf) do { SWRITE_HV(bf); SWRITE_HK(bf); } while (0)
#define SLOAD_F(p, k0) do { S.sf0 = *(const f32x4*)ROW(p, k0, sr); S.sf1 = *(const f32x4*)(ROW(p, k0, sr) + 4);                \
                            S.sf2 = *(const f32x4*)ROW(p, k0, 32 + sr); S.sf3 = *(const f32x4*)(ROW(p, k0, 32 + sr) + 4); } while (0)
#define SWRITE_KF(bf) do { *(bf16x8*)(K_lds + (bf) * SHM_K + kws) = pack8(S.sf0, S.sf1); *(bf16x8*)(K_lds + (bf) * SHM_K + kws + 32 * 256) = pack8(S.sf2, S.sf3); } while (0)
#define SWRITE_VF(bf) do { *(bf16x8*)(V_lds + (bf) * SHM_V + vst0) = pack8(S.sf0, S.sf1); *(bf16x8*)(V_lds + (bf) * SHM_V + vst1) = pack8(S.sf2, S.sf3); } while (0)
template <class TIn, class TOut>
__device__ __forceinline__ void causal_swa_prime(const BlockRef<TIn, TOut>& cur, int W, char* lds, Seam<TIn>& S) {
    constexpr bool F32 = same_t<TIn, float>::v;
    int tid_o = threadIdx.x; asm volatile("" : "+v"(tid_o));
    const int tid = tid_o, wid = __builtin_amdgcn_readfirstlane(tid >> 6), lane = tid & 63, r32 = lane & 31, hi = lane >> 5;
    const int sr = tid >> 4, sc = (tid & 15) * 8, kws = KSWZ(sr, sc * 2); char* K_lds = lds + 2 * SHM_V; const unsigned soff = (unsigned)(sr * LDQKV + sc) * 2u;
    const int kb0 = swa_jlo(cur.P0, W) * KVBLK;
    for (int d0 = 0; d0 < 8; ++d0) S.qr[d0] = load8<TIn>(cur.Q + (size_t)(wid * QBLK + r32) * LDQKV + d0 * 16 + hi * 8);
    if constexpr (F32) { SLOAD_F((const float*)cur.K, kb0); VMW(); SWRITE_KF(0); SBAR(); SLOAD_F((const float*)cur.V, kb0); }
    else { SLOAD_H(cur.K, cur.V, kb0); VMW(); SWRITE_HK(0); }
    __syncthreads();
}
template <class TIn, class TOut>
__device__ __forceinline__ void causal_swa_block(const BlockRef<TIn, TOut>& cur, const BlockRef<TIn, TOut>& nxt, int skv, int W, char* lds, Seam<TIn>& S) {
    constexpr bool F32 = same_t<TIn, float>::v;
    int tid_o = threadIdx.x; asm volatile("" : "+v"(tid_o));
    const int tid = tid_o, wid = __builtin_amdgcn_readfirstlane(tid >> 6), lane = tid & 63, r32 = lane & 31, hi = lane >> 5;
    const int j_lo = swa_jlo(cur.P0, W);
    int j_hi = (cur.P0 + QB - 1) / KVBLK + 1; if (j_hi > skv / KVBLK) j_hi = skv / KVBLK;
    const int NT = j_hi - j_lo;
    const int kbn = swa_jlo(nxt.P0, W) * KVBLK;
    const int qlo = cur.P0 + wid * QBLK, qm = qlo + r32 - 4 * hi;
    char* V_lds = lds; char* K_lds = lds + 2 * SHM_V;
    const unsigned mlane = (unsigned)(wid * QBLK + r32) * 1024u;
    float* ws = (float*)(lds + 2 * SHM_V + 2 * SHM_K) + wid * 64; float* li_l = ws, * al_l = ws + 32;
    float m_reg = -1e30f, l_reg = 0; f32x16 o[4] = {};
    const unsigned soff = (unsigned)((tid >> 4) * LDQKV + (tid & 15) * 8) * 2u;
    const int sr = tid >> 4, sc = (tid & 15) * 8, vst0 = v_st(sr, sc), vst1 = v_st(32 + sr, sc), kws = KSWZ(sr, sc * 2);
    const int vb0 = (int)(uintptr_t)V_lds + v_rd_base(lane);
    const TIn* Kh = cur.K; const TIn* Vh = cur.V;
#define RESC(a) do { if (__any((a) < 1.f)) { if (hi == 0) al_l[r32] = (a); asm volatile("s_waitcnt lgkmcnt(0)" ::: "memory");              \
                     for (int d_ = 0; d_ < 4; ++d_) for (int r = 0; r < 16; ++r) o[d_][r] *= al_l[crow(r, hi)]; } } while (0)
#define KBASE(t) ((j_lo + (t)) * KVBLK)
#define ACT(t) (KBASE(t) <= qlo + QBLK - 1 && KBASE(t) + KVBLK - 1 >= qlo - W + 1)
#define MASKT(P0_, P1_, mw_) mask_bits(P0_, P1_, mw_, hi)
#define MLOAD(t) (*(const unsigned long long*)((const char*)cur.M + (size_t)((j_lo + (t)) * 8) + mlane))
    constexpr int NQL = F32 ? 16 : 8;
    constexpr bool SK = WSKIP && !F32;
#define SEAM_K0() do { VMWN(NQL); if constexpr (F32) { SWRITE_KF(0); SBAR(); SLOAD_F((const float*)nxt.V, kbn); } else { SWRITE_HK(0); } SBAR(); } while (0)
    f32x16 pA0, pA1, pB0, pB1; float mnA, mnB, alA, alB; bf16x8 pa0, pa1, pa2, pa3;
    if constexpr (F32) { VMW(); SWRITE_VF(0); SBAR(); } else { SWRITE_HV(0); SBAR(); }
    if (NT > 1) { if constexpr (F32) SLOAD_F((const float*)Kh, KBASE(1)); else SLOAD_H(Kh, Vh, KBASE(1)); }
    SBAR(); qkt<0, SK>(pA0, pA1, K_lds, r32, hi, S.qr, ACT(0));
    if constexpr (F32) { if (NT > 1) { VMW(); SWRITE_KF(1); SBAR(); SLOAD_F((const float*)Vh, KBASE(1)); } }
    MASKT(pA0, pA1, MLOAD(0)); partialSM(pA0, pA1, m_reg, mnA, alA);
    if (NT > 1) { VMW(); if constexpr (F32) { SWRITE_VF(1); SBAR(); if (NT > 2) SLOAD_F((const float*)Kh, KBASE(2)); } else SWRITE_H(1); }
    __syncthreads();
#define HALF_STEP(PX0, PX1, mnX, alX, PY0, PY1, alY, t, KB, VB, SB) do {                                                      \
        SBAR(); qkt<KB, SK>(PX0, PX1, K_lds, r32, hi, S.qr, ACT(t));                                             \
        finishSM(PY0, PY1, alY, l_reg, pa0, pa1, pa2, pa3); SBAR();                                                           \
        if ((t) + 1 < NT) { if constexpr (F32) { VMW(); SWRITE_KF(SB); SBAR(); SLOAD_F((const float*)Vh, KBASE((t) + 1)); }  \
                            else { SLOAD_H(Kh, Vh, KBASE((t) + 1)); } SBAR(); }                                               \
        pv_tile<VB, SK>(o, vb0, pa0, pa1, pa2, pa3, ACT((t) - 1)); MASKT(PX0, PX1, MLOAD(t)); partialSM(PX0, PX1, m_reg, mnX, alX);                                        \
        __syncthreads();                                                                                                      \
        if ((t) + 1 < NT) { VMW(); if constexpr (F32) { SWRITE_VF(SB); SBAR(); if ((t) + 2 < NT) SLOAD_F((const float*)Kh, KBASE((t) + 2)); } \
                            else { SWRITE_H(SB); } }                                                                          \
        RESC(alX); __syncthreads(); } while (0)
    for (int t = 1; t + 1 < NT; t += 2) {
        HALF_STEP(pB0, pB1, mnB, alB, pA0, pA1, alA, t, 1, 0, 0);
        HALF_STEP(pA0, pA1, mnA, alA, pB0, pB1, alB, t + 1, 0, 1, 1);
    }
    const bool even = (NT & 1) == 0;
    if (even) { SBAR(); qkt<1, SK>(pB0, pB1, K_lds, r32, hi, S.qr, ACT(NT - 1)); SBAR(); }
#define QROW(e) (nxt.Q + (size_t)(wid * QBLK + r32) * LDQKV + ((e) >> 1) * 16 + hi * 8 + ((e) & 1) * 4)
    if constexpr (F32) { SLOAD_F((const float*)nxt.K, kbn); SBAR();
#pragma unroll
        for (int e = 0; e < 8; ++e) S.tq[e] = *(const f32x4*)QROW(e); }
    else { SLOAD_H(nxt.K, nxt.V, kbn); SBAR();
#pragma unroll
        for (int d0 = 0; d0 < 8; ++d0) S.qr[d0] = load8<TIn>(nxt.Q + (size_t)(wid * QBLK + r32) * LDQKV + d0 * 16 + hi * 8); }
    SBAR();
    finishSM(pA0, pA1, alA, l_reg, pa0, pa1, pa2, pa3); SBAR();
    if constexpr (F32) {
#pragma unroll
        for (int e = 8; e < 16; ++e) S.tq[e] = *(const f32x4*)QROW(e); SBAR(); }
#undef QROW
    pv_tile<0, SK>(o, vb0, pa0, pa1, pa2, pa3, ACT(even ? NT - 2 : NT - 1));
    if (even) { MASKT(pB0, pB1, MLOAD(NT - 1)); partialSM(pB0, pB1, m_reg, mnB, alB); __syncthreads(); RESC(alB);
        finishSM(pB0, pB1, alB, l_reg, pa0, pa1, pa2, pa3); SBAR(); pv_tile<1, SK>(o, vb0, pa0, pa1, pa2, pa3, ACT(NT - 1)); }
    SBAR(); SEAM_K0();
    if (hi == 0) li_l[r32] = l_reg; asm volatile("s_waitcnt lgkmcnt(0)" ::: "memory");
    float rli[16];
#pragma unroll
    for (int r = 0; r < 16; ++r) rli[r] = __builtin_amdgcn_rcpf(li_l[crow(r, hi)]);
    TOut* Ow = cur.O + (size_t)(wid * QBLK) * LDO;
#pragma unroll
    for (int r = 0; r < 16; ++r) { const int orow = crow(r, hi);
#pragma unroll
        for (int d0 = 0; d0 < 4; ++d0) { const float v = o[d0][r] * rli[r];
            if constexpr (same_t<TOut, float>::v) { Ow[(size_t)orow * LDO + d0 * 32 + r32] = v; }
            else { const float vn = __shfl_xor(v, 1);
                   if ((r32 & 1) == 0) *(unsigned*)(Ow + (size_t)orow * LDO + d0 * 32 + r32) = cvtpk(v, vn); } } }
    if constexpr (F32) {
#pragma unroll
        for (int d0 = 0; d0 < 8; ++d0) S.qr[d0] = pack8(S.tq[2 * d0], S.tq[2 * d0 + 1]); }
    __syncthreads();
#undef RESC
#undef KBASE
#undef ACT
#undef MASKT
#undef MLOAD
#undef SEAM_K0
#undef HALF_STEP
}
#undef ROW
#undef VMW
#undef VMWN
#undef SLOAD_H
#undef LD16U
#undef SWRITE_HK
#undef SWRITE_HV
#undef SWRITE_H
#undef SLOAD_F
#undef SWRITE_KF
#undef SWRITE_VF

}


template <int NC> __device__ __forceinline__ void scan_elems(const bf16* __restrict__ delta, bf16* __restrict__ prev, size_t cstride, const LAS float* dec, const LAS float* inj) {
    f32x4 st = (f32x4){0.f, 0.f, 0.f, 0.f};
#pragma unroll 8
    for (int c = 0; c < NC; ++c) { const v2u x = *(const GAS v2u*)(delta + (size_t)c * cstride);
        v2u o; o.x = pk2(st[0], st[1]); o.y = pk2(st[2], st[3]); *(GAS v2u*)(prev + (size_t)c * cstride) = o;
        const float d = dec[c], j = inj[c];
        st[0] = d * st[0] + j * __uint_as_float(x.x << 16); st[1] = d * st[1] + j * __uint_as_float(x.x & 0xffff0000u);
        st[2] = d * st[2] + j * __uint_as_float(x.y << 16); st[3] = d * st[3] + j * __uint_as_float(x.y & 0xffff0000u); }
}

struct Args {
    const float* x; const float* norm_mix; const float* norm_ffn; const float* w_in; const float* att_q_norm; const float* att_k_norm; const float* mlstm_conv; const float* mlstm_gate_bias;
    const float* mlstm_out_norm; const float* ret_out_norm; const float* w_b_att; const float* w_b_mlstm; const float* w_b_ret; const float* w_out; const float* w_ffn_in; const float* w_ffn_out;
    float* out; unsigned char* ws; int layer_lo, layer_hi, ph_lo, ph_hi;
};
constexpr int PH_PER_LAYER = 16;
__device__ __forceinline__ float ret_lngamma(int hd) { return log1pf(-exp2f(-5.0f - (float)hd)); }
#define PHASE_FN static __device__ __forceinline__ void
#define OPAQUE_PTR(p) asm volatile("" : "+s"(p))
#define WS_PTRS(ws) OPAQUE_PTR(ws); \
    bf16* const H = (bf16*)((ws) + WS_H); bf16* const PROJ = (bf16*)((ws) + WS_PROJ); float* const SMALL = (float*)((ws) + WS_SMALL); bf16* const MQK = (bf16*)((ws) + WS_MQK); \
    bf16* const IKB = (bf16*)((ws) + WS_IKB); float* const IWF = (float*)((ws) + WS_IWF); float* const GIF = (float*)((ws) + WS_GIF); float* const SC = (float*)((ws) + WS_SC); \
    unsigned long long* const MB = (unsigned long long*)((ws) + WS_MB); bf16* const DCM = (bf16*)((ws) + WS_DCM); bf16* const CPM = (bf16*)((ws) + WS_CPM); \
    float* const DN = (float*)((ws) + WS_MISC + MISC_DN); float* const NPREV = (float*)((ws) + WS_MISC + MISC_NPREV); float* const AB = (float*)((ws) + WS_MISC + MISC_AB); float* const MPREV = (float*)((ws) + WS_MISC + MISC_MPREV); \
    bf16* const DRR = (bf16*)((ws) + WS_DRR); bf16* const RPR = (bf16*)((ws) + WS_RPR); bf16* const YA = (bf16*)((ws) + WS_YA); bf16* const YM = (bf16*)((ws) + WS_YM); bf16* const YR = (bf16*)((ws) + WS_YR); \
    float* const MERGEDF = (float*)((ws) + WS_MERGEDF); bf16* const MERGED = (bf16*)((ws) + WS_MERGED); bf16* const ACT = (bf16*)((ws) + WS_ACT); \
    float* const ROPE128 = (float*)((ws) + WS_ROPE128); float* const ROPE64 = (float*)((ws) + WS_ROPE64); \
    (void)H; (void)PROJ; (void)SMALL; (void)MQK; (void)IKB; (void)IWF; (void)GIF; (void)SC; (void)MB; (void)DCM; (void)CPM; (void)DN; (void)NPREV; (void)AB; (void)MPREV; (void)DRR; (void)RPR; (void)YA; (void)YM; (void)YR; \
    (void)MERGEDF; (void)MERGED; (void)ACT; (void)ROPE128; (void)ROPE64
#define TIDS() int tid_ = threadIdx.x; asm volatile("" : "+v"(tid_)); int bx_ = blockIdx.x; asm volatile("" : "+s"(bx_));   \
    const int tid = tid_, lane = tid & 63, wave = __builtin_amdgcn_readfirstlane(tid >> 6); const int G = gridDim.x, bx = bx_; const int gw = bx * NWAVES + wave, NGW = G * NWAVES; \
    (void)lane; (void)wave; (void)gw; (void)NGW; (void)G; (void)bx

PHASE_FN ph_prologue(LAS unsigned char* lds, unsigned char* ws, const float* w_in, const float* w_b_att, const float* w_b_mlstm, const float* w_b_ret, const float* w_out, const float* w_ffn_in, const float* w_ffn_out) {
    TIDS(); WS_PTRS(ws);
    LAS float* scr = (LAS float*)(lds + wave * 16384);
    for (int l = 0; l < DEPTH; ++l) { unsigned char* wl = ws + WS_W + (size_t)l * W_LAYER;
        transpose_matrix(w_in + (size_t)l * DM * LPROJ, DM, LPROJ, NPROJ_PAD, (bf16*)(wl + WO_IN), scr, gw, NGW, lane, MapWin());
        transpose_matrix(w_b_att + (size_t)l * 1024 * DM, 1024, DM, DM, (bf16*)(wl + WO_B), scr, gw, NGW, lane, MapIdent());
        transpose_matrix(w_b_mlstm + (size_t)l * 1024 * DM, 1024, DM, DM, (bf16*)(wl + WO_B + 4 * MiB), scr, gw, NGW, lane, MapIdent());
        transpose_matrix(w_b_ret + (size_t)l * 1024 * DM, 1024, DM, DM, (bf16*)(wl + WO_B + 8 * MiB), scr, gw, NGW, lane, MapIdent());
        transpose_matrix(w_out + (size_t)l * DM * DM, DM, DM, DM, (bf16*)(wl + WO_OUT), scr, gw, NGW, lane, MapIdent());
        transpose_matrix(w_ffn_in + (size_t)l * DM * 2 * FF, DM, 2 * FF, 2 * FF, (bf16*)(wl + WO_FIN), scr, gw, NGW, lane, MapFfn());
        transpose_matrix(w_ffn_out + (size_t)l * FF * DM, FF, DM, DM, (bf16*)(wl + WO_FOUT), scr, gw, NGW, lane, MapIdent()); }
    for (int i = gw * 64 + lane; i < S * 96; i += NGW * 64) {
        if (i < S * 64) { const int t = i >> 6, f = i & 63; const float inv = (float)pow(10000.0, -(double)f * 2.0 / 128.0); const float ang = (float)t * inv;
            ROPE128[2 * i] = (float)cos((double)ang); ROPE128[2 * i + 1] = (float)sin((double)ang); }
        else { const int k = i - S * 64, t = k >> 5, f = k & 31; const float inv = (float)pow(10000.0, -(double)f * 2.0 / 64.0); const float ang = (float)t * inv;
            ROPE64[2 * k] = (float)cos((double)ang); ROPE64[2 * k + 1] = (float)sin((double)ang); } }
}
PHASE_FN ph_rmsnorm(const float* xin, const float* gain, bf16* Hout) { TIDS(); for (int m = gw; m < S; m += NGW) rms_row_to_bf16(xin + (size_t)m * DM, gain, Hout + (size_t)m * DM, lane); }
PHASE_FN ph_gemm_proj(LAS unsigned char* lds, unsigned char* ws, const bf16* Wt) { TIDS(); WS_PTRS(ws);
    pg8::Gemm g{H, Wt, S, NPROJ_PAD, DM}; pg8::StaticOrder so; so.init(S, NPROJ_PAD, G, bx); pg8::EpiProj E{PROJ, NPROJ, SMALL, PC_G / 256, NPROJ / 256};
    pg8::gemm_phase<pg8::EpiProj, pg8::StaticOrder, true, true>(lds, g, so, E); }
PHASE_FN ph_pp(unsigned char* ws, const float* gq, const float* gk, const float* convw, const float* gbias) { TIDS(); WS_PTRS(ws);
    PPArgs a{PROJ, SMALL, MQK, IKB, IWF, GIF, ROPE128, ROPE64, gq, gk, convw, gbias};
    for (int m = gw; m < S; m += NGW) pp_row(a, m, lane); }
PHASE_FN ph_scores(unsigned char* ws) { TIDS(); WS_PTRS(ws);
    for (int u = gw; u < 8320; u += NGW) { int g = (int)((sqrtf(1.0f + 2.0f * (float)u) - 1.0f) * 0.5f); while (2 * (g + 1) * (g + 2) <= u) ++g; while (2 * g * (g + 1) > u) --g;
        const int r = u - 2 * g * (g + 1); score_wave_unit(PROJ, IKB, IWF, SC, 4 * g + r / (g + 1), r % (g + 1), lane); } }
PHASE_FN ph_deltas(LAS unsigned char* lds, unsigned char* ws) { TIDS(); WS_PTRS(ws); LAS float* const sf = (LAS float*)(lds + SCR_OFF);
    for (int u = bx; u < 1024; u += G) {
        if (u < 512) { const int hd = u >> 7, c = u & 127, t0 = c * 64;
            if (wave == 0) { const float iv = GIF[(size_t)(t0 + lane) * 8 + hd], fv = GIF[(size_t)(t0 + lane) * 8 + 4 + hd]; float b = log_sigmoid_f(fv);
#pragma unroll
                for (int o = 1; o < 64; o <<= 1) { const float y = __shfl_up(b, o); if (lane >= o) b += y; }
                const float bend = __shfl(b, 63), gl = bend - b + iv, A = wave_max(gl);
                sf[lane] = __expf(gl - A); if (lane == 0) { AB[(hd * 128 + c) * 2] = A; AB[(hd * 128 + c) * 2 + 1] = bend; } }
            __syncthreads();
            chunk_delta<64, 256>(lds, MQK + (size_t)t0 * 1024 + 512 + hd * 128, 1024, PROJ + (size_t)t0 * NPROJ + PC_MV + hd * 256, NPROJ, sf, DCM + (size_t)(hd * 128 + c) * 32768, DN + (hd * 128 + c) * 128, tid);
        } else { const int v = u - 512, hd = v >> 6, c = v & 63, t0 = c * 128; const float lg = ret_lngamma(hd);
            if (tid < 128) sf[tid] = __expf(lg * (float)(127 - tid));
            __syncthreads();
            chunk_delta<128, 128>(lds, PROJ + (size_t)t0 * NPROJ + PC_RK + hd * 128, NPROJ, PROJ + (size_t)t0 * NPROJ + PC_RV + hd * 128, NPROJ, sf, DRR + (size_t)(hd * 64 + c) * 16384, nullptr, tid); }
    } }
PHASE_FN ph_select(LAS unsigned char* lds, unsigned char* ws) { TIDS(); WS_PTRS(ws); select_rows_wg(lds, SC, MB, bx, G, tid); }
PHASE_FN ph_scans(LAS unsigned char* lds, unsigned char* ws) { TIDS(); WS_PTRS(ws); LAS float* const sf = (LAS float*)(lds + SCR_OFF);
    for (int u = bx; u < 128; u += G) {
        LAS float* dec = sf; LAS float* inj = sf + 128; LAS float* av = sf + 256; LAS float* bv = sf + 384;
        if (u < 64) { const int hd = u >> 4, p = u & 15;
            if (tid < 128) { av[tid] = AB[(hd * 128 + tid) * 2]; bv[tid] = AB[(hd * 128 + tid) * 2 + 1]; }
            __syncthreads();
            if (tid == 0) { float m = 0.f; for (int c = 0; c < 128; ++c) { const float mn = fmaxf(bv[c] + m, av[c]); dec[c] = __expf(bv[c] + m - mn); inj[c] = __expf(av[c] - mn); if (p == 0) MPREV[hd * 128 + c] = m; m = mn; } }
            __syncthreads();
            const size_t e4 = (size_t)hd * 128 * 32768 + p * 2048 + tid * 4;
            scan_elems<128>(DCM + e4, CPM + e4, 32768, dec, inj);
            if (p == 0 && tid < 128) { float st = 0.f; for (int c = 0; c < 128; ++c) { NPREV[(hd * 128 + c) * 128 + tid] = st; st = dec[c] * st + inj[c] * DN[(hd * 128 + c) * 128 + tid]; } }
        } else { const int v = u - 64, hd = v >> 3, p = v & 7; const float dg = __expf(128.0f * ret_lngamma(hd));
            if (tid < 64) { dec[tid] = dg; inj[tid] = 1.0f; }
            __syncthreads();
            const size_t e4 = (size_t)hd * 64 * 16384 + p * 2048 + tid * 4;
            scan_elems<64>(DRR + e4, RPR + e4, 16384, dec, inj); }
        __syncthreads(); } }
PHASE_FN ph_attention(char* alds, unsigned char* ws) { TIDS(); WS_PTRS(ws);
    typedef att::BlockRef<bf16, bf16> BR; att::Seam<bf16> seam;
#define ATT_REF(r, item_, pass_) do { const int hd_ = (item_) >> 4, y_ = (item_) & 15, qb_ = (pass_) ? 31 - y_ : y_; \
        (r).Q = PROJ + (size_t)qb_ * 256 * NPROJ + PC_AQ + hd_ * 128; (r).K = PROJ + PC_AK + hd_ * 128; (r).V = PROJ + PC_AV + hd_ * 128; (r).O = YA + (size_t)qb_ * 256 * 1024 + hd_ * 128; \
        (r).M = MB + (size_t)qb_ * 256 * 128; (r).P0 = qb_ * 256; } while (0)
    if (bx < 128) { int item = bx, pass = 0; BR cur; ATT_REF(cur, item, 0); att::causal_swa_prime<bf16, bf16>(cur, 1 << 30, alds, seam);
        for (;;) { const bool more_pass = pass == 0, more_item = item + G < 128, last = !more_pass && !more_item;
            int itn = item, pn = pass + 1; if (!more_pass) { pn = 0; itn = more_item ? item + G : item; }
            BR nxt = cur; if (!last) ATT_REF(nxt, itn, pn);
            att::causal_swa_block<bf16, bf16>(cur, nxt, S, 1 << 30, alds, seam);
            if (last) break; cur = nxt; item = itn; pass = pn; } }
    __syncthreads(); }
PHASE_FN ph_outs(LAS unsigned char* lds, unsigned char* ws, const float* gain_m, const float* gain_r) { TIDS(); WS_PTRS(ws); LAS float* const sf = (LAS float*)(lds + SCR_OFF);
    for (int u = bx; u < 1024; u += G) {
        if (u < 512) { const int hd = u >> 7, c = u & 127, t0 = c * 64;
            if (wave == 0) { const float iv = GIF[(size_t)(t0 + lane) * 8 + hd], fv = GIF[(size_t)(t0 + lane) * 8 + 4 + hd]; float b = log_sigmoid_f(fv);
#pragma unroll
                for (int o = 1; o < 64; o <<= 1) { const float y = __shfl_up(b, o); if (lane >= o) b += y; }
                const float mp = MPREV[hd * 128 + c]; float pm = iv - b;
#pragma unroll
                for (int o = 1; o < 64; o <<= 1) { const float y = __shfl_up(pm, o); if (lane >= o) pm = fmaxf(pm, y); }
                const float mt = fmaxf(b + mp, b + pm);
                sf[lane] = b - mt; sf[128 + lane] = iv - b; sf[256 + lane] = __expf(b + mp - mt); sf[384 + lane] = __expf(-mt); sf[512 + lane] = 0.f; }
            if (wave == 1) { sf[640 + lane] = NPREV[(hd * 128 + c) * 128 + lane]; sf[640 + 64 + lane] = NPREV[(hd * 128 + c) * 128 + 64 + lane]; }
            __syncthreads();
            chunk_out<64, 256, 0>(lds, sf, MQK + (size_t)t0 * 1024 + hd * 128, 1024, MQK + (size_t)t0 * 1024 + 512 + hd * 128, 1024, PROJ + (size_t)t0 * NPROJ + PC_MV + hd * 256, NPROJ,
                                  CPM + (size_t)(hd * 128 + c) * 32768, gain_m + hd * 256, PROJ + (size_t)t0 * NPROJ + PC_MO + hd * 256, NPROJ, YM + (size_t)t0 * 1024 + hd * 256, 1024, tid);
        } else { const int v = u - 512, hd = v >> 6, c = v & 63, t0 = c * 128; const float lg = ret_lngamma(hd);
            if (tid < 128) { sf[tid] = lg * (float)tid; sf[128 + tid] = -lg * (float)tid; sf[256 + tid] = __expf(lg * (float)(tid + 1)); }
            __syncthreads();
            chunk_out<128, 128, 1>(lds, sf, PROJ + (size_t)t0 * NPROJ + PC_RQ + hd * 128, NPROJ, PROJ + (size_t)t0 * NPROJ + PC_RK + hd * 128, NPROJ, PROJ + (size_t)t0 * NPROJ + PC_RV + hd * 128, NPROJ,
                                   RPR + (size_t)(hd * 64 + c) * 16384, gain_r + hd * 128, PROJ + (size_t)t0 * NPROJ + PC_RG + hd * 128, NPROJ, YR + (size_t)t0 * 1024 + hd * 128, 1024, tid); }
    } }
template <int MODE> PHASE_FN ph_gemm_branch(LAS unsigned char* lds, unsigned char* ws, const bf16* A, const bf16* Wt, int gcol) { TIDS(); WS_PTRS(ws);
    pg8::Gemm g{A, Wt, S, DM, 1024}; pg8::StaticOrder so; so.init(S, DM, G, bx); pg8::EpiBranch<MODE> E{PROJ + PC_G + gcol, NPROJ, MERGEDF, MERGED, DM};
    pg8::gemm_phase<pg8::EpiBranch<MODE>, pg8::StaticOrder, true, true>(lds, g, so, E); }
PHASE_FN ph_gemm_resid(LAS unsigned char* lds, const bf16* A, const bf16* Wt, int K, const float* base, float* out) { TIDS();
    pg8::Gemm g{A, Wt, S, DM, K}; pg8::StaticOrder so; so.init(S, DM, G, bx); pg8::EpiResid E{base, out, DM};
    pg8::gemm_phase<pg8::EpiResid, pg8::StaticOrder, true, true>(lds, g, so, E); }
PHASE_FN ph_gemm_ffn_in(LAS unsigned char* lds, unsigned char* ws, const bf16* Wt) { TIDS(); WS_PTRS(ws);
    pg8::Gemm g{H, Wt, S, 2 * FF, DM}; pg8::StaticOrder so; so.init(S, 2 * FF, G, bx); pg8::EpiSwiGLU E{ACT, FF};
    pg8::gemm_phase<pg8::EpiSwiGLU, pg8::StaticOrder, true, true>(lds, g, so, E); }

typedef const __attribute__((address_space(4))) Args* ArgsP;
__device__ __forceinline__ ArgsP fresh_args() { ArgsP ap = (ArgsP)__builtin_amdgcn_kernarg_segment_ptr(); asm volatile("" : "+s"(ap)); return ap; }
#define SEAM() do { if constexpr (one_launch) { ArgsP ap_ = fresh_args(); XcdBarrier b_; b_.bar = (unsigned*)(ap_->ws + WS_CTL) + CW_BAR; b_.x = xb_xcc_id(); b_.st = (volatile LAS unsigned*)(lds + MISC_OFF); xcd_barrier(b_); } } while (0)
#define IN(k) (PLO <= (k) && (k) < PHI)
#define WL(ap, layer) ((ap)->ws + WS_W + (size_t)(layer) * W_LAYER)
template <int PLO, int PHI, bool LAST> __device__ __forceinline__ void layer_phases(const int layer, LAS unsigned char* lds, unsigned char* lds_raw) {
    constexpr bool one_launch = (PHI - PLO > 1);
    if constexpr (IN(1)) { ArgsP ap = fresh_args(); ph_rmsnorm(layer == 0 ? ap->x : ap->out, ap->norm_mix + layer * DM, (bf16*)(ap->ws + WS_H)); SEAM(); }
    if constexpr (IN(2)) { ArgsP ap = fresh_args(); ph_gemm_proj(lds, ap->ws, (const bf16*)(WL(ap, layer) + WO_IN)); SEAM(); }
    if constexpr (IN(3)) { ArgsP ap = fresh_args(); ph_pp(ap->ws, ap->att_q_norm + layer * 128, ap->att_k_norm + layer * 128, ap->mlstm_conv + layer * 4096, ap->mlstm_gate_bias + layer * 8); SEAM(); }
    if constexpr (IN(4)) { ArgsP ap = fresh_args(); ph_scores(ap->ws); }
    if constexpr (IN(5)) { ArgsP ap = fresh_args(); ph_deltas(lds, ap->ws); SEAM(); }
    if constexpr (IN(6)) { ArgsP ap = fresh_args(); ph_select(lds, ap->ws); }
    if constexpr (IN(7)) { ArgsP ap = fresh_args(); ph_scans(lds, ap->ws); SEAM(); }
    if constexpr (IN(8)) { ArgsP ap = fresh_args(); ph_attention((char*)lds_raw, ap->ws); }
    if constexpr (IN(9)) { ArgsP ap = fresh_args(); ph_outs(lds, ap->ws, ap->mlstm_out_norm + layer * 1024, ap->ret_out_norm + layer * 1024); SEAM(); }
    if constexpr (IN(10)) { ArgsP ap = fresh_args(); ph_gemm_branch<0>(lds, ap->ws, (const bf16*)(ap->ws + WS_YA), (const bf16*)(WL(ap, layer) + WO_B), 0); }
    if constexpr (IN(11)) { ArgsP ap = fresh_args(); ph_gemm_branch<1>(lds, ap->ws, (const bf16*)(ap->ws + WS_YM), (const bf16*)(WL(ap, layer) + WO_B + 4 * MiB), DM); }
    if constexpr (IN(12)) { ArgsP ap = fresh_args(); ph_gemm_branch<2>(lds, ap->ws, (const bf16*)(ap->ws + WS_YR), (const bf16*)(WL(ap, layer) + WO_B + 8 * MiB), 2 * DM); SEAM(); }
    if constexpr (IN(13)) { ArgsP ap = fresh_args(); ph_gemm_resid(lds, (const bf16*)(ap->ws + WS_MERGED), (const bf16*)(WL(ap, layer) + WO_OUT), DM, layer == 0 ? ap->x : ap->out, ap->out); SEAM(); }
    if constexpr (IN(14)) { ArgsP ap = fresh_args(); ph_rmsnorm(ap->out, ap->norm_ffn + layer * DM, (bf16*)(ap->ws + WS_H)); SEAM(); }
    if constexpr (IN(15)) { ArgsP ap = fresh_args(); ph_gemm_ffn_in(lds, ap->ws, (const bf16*)(WL(ap, layer) + WO_FIN)); SEAM(); }
    if constexpr (IN(16)) { ArgsP ap = fresh_args(); ph_gemm_resid(lds, (const bf16*)(ap->ws + WS_ACT), (const bf16*)(WL(ap, layer) + WO_FOUT), FF, ap->out, ap->out); if constexpr (!LAST) SEAM(); }
}
template <int PLO, int PHI> __global__ void __launch_bounds__(NTHR, 2) fwd(Args args_unused) {
    (void)args_unused;
    extern __shared__ __attribute__((aligned(16))) unsigned char lds_raw[];
    LAS unsigned char* lds = (LAS unsigned char*)lds_raw;
    if (threadIdx.x < 64) ((volatile LAS unsigned*)(lds + MISC_OFF))[threadIdx.x] = 0u;
    __syncthreads();
    constexpr bool one_launch = (PHI - PLO > 1);
    if constexpr (one_launch) { ArgsP ap = fresh_args(); (void)xcd_barrier_post((unsigned*)(ap->ws + WS_CTL) + CW_BAR, (volatile LAS unsigned*)(lds + MISC_OFF)); }
    if constexpr (PLO == 0) { ArgsP ap = fresh_args(); ph_prologue(lds, ap->ws, ap->w_in, ap->w_b_att, ap->w_b_mlstm, ap->w_b_ret, ap->w_out, ap->w_ffn_in, ap->w_ffn_out); if (PHI > 1) SEAM(); }
    if constexpr (one_launch) { static_assert(DEPTH == 4, "four inlined layer sites");
        layer_phases<PLO, PHI, false>(0, lds, lds_raw); layer_phases<PLO, PHI, false>(1, lds, lds_raw); layer_phases<PLO, PHI, false>(2, lds, lds_raw); layer_phases<PLO, PHI, true>(3, lds, lds_raw); }
    else if constexpr (PLO > 0) { ArgsP ap = fresh_args(); layer_phases<PLO, PHI, true>(ap->layer_lo, lds, lds_raw); }
}
#undef IN
#undef SEAM
#undef WL

#ifndef ONE_LAUNCH
#define ONE_LAUNCH 1
#endif
typedef void (*kern_t)(Args);
template <int P> static kern_t phase_kernel(int p) { if (p == P) return fwd<P, P + 1>; if constexpr (P < PH_PER_LAYER) return phase_kernel<P + 1>(p); else return nullptr; }
extern "C" void kernel_launch(void* const* d_in, const int* in_sizes, int n_in, void* d_out, int out_size, void* d_ws, size_t ws_size, hipStream_t stream) {
    static int grid = 0;
    if (grid == 0) {
        if (n_in != 16 || in_sizes[0] != S * DM || out_size != S * DM || ws_size < WS_END) { fprintf(stderr, "kernel_launch: unexpected shapes (n_in %d, in0 %d, out %d, ws %zu < %zu); nothing launched\n", n_in, n_in > 0 ? in_sizes[0] : -1, out_size, ws_size, (size_t)WS_END); grid = -1; return; }
        int dev = 0, cus = 0;
        if (hipGetDevice(&dev) != hipSuccess || hipDeviceGetAttribute(&cus, hipDeviceAttributeMultiprocessorCount, dev) != hipSuccess) { grid = -1; return; }
#if ONE_LAUNCH
        if (hipFuncSetAttribute((const void*)fwd<0, PH_PER_LAYER + 1>, hipFuncAttributeMaxDynamicSharedMemorySize, LDS_BYTES) != hipSuccess) { grid = -1; return; }
#else
        for (int p = 0; p <= PH_PER_LAYER; ++p) if (hipFuncSetAttribute((const void*)phase_kernel<0>(p), hipFuncAttributeMaxDynamicSharedMemorySize, LDS_BYTES) != hipSuccess) { fprintf(stderr, "kernel_launch: hipFuncSetAttribute failed\n"); grid = -1; return; }
#endif
        (void)hipGetLastError();
        grid = cus;
    }
    if (grid < 0) return;
    (void)hipMemsetAsync((char*)d_ws + WS_CTL, 0, CTL_ZERO_BYTES, stream);
    Args a{};
    a.x = (const float*)d_in[0]; a.norm_mix = (const float*)d_in[1]; a.norm_ffn = (const float*)d_in[2]; a.w_in = (const float*)d_in[3]; a.att_q_norm = (const float*)d_in[4]; a.att_k_norm = (const float*)d_in[5];
    a.mlstm_conv = (const float*)d_in[6]; a.mlstm_gate_bias = (const float*)d_in[7]; a.mlstm_out_norm = (const float*)d_in[8]; a.ret_out_norm = (const float*)d_in[9];
    a.w_b_att = (const float*)d_in[10]; a.w_b_mlstm = (const float*)d_in[11]; a.w_b_ret = (const float*)d_in[12]; a.w_out = (const float*)d_in[13]; a.w_ffn_in = (const float*)d_in[14]; a.w_ffn_out = (const float*)d_in[15];
    a.out = (float*)d_out; a.ws = (unsigned char*)d_ws;
#if ONE_LAUNCH
    a.layer_lo = 0; a.layer_hi = DEPTH; a.ph_lo = 0; a.ph_hi = PH_PER_LAYER + 1; hipLaunchKernelGGL((fwd<0, PH_PER_LAYER + 1>), dim3(grid), dim3(NTHR), LDS_BYTES, stream, a);
#else
    a.layer_lo = 0; a.layer_hi = 0; a.ph_lo = 0; a.ph_hi = 1; hipLaunchKernelGGL((fwd<0, 1>), dim3(grid), dim3(NTHR), LDS_BYTES, stream, a);
    for (int l = 0; l < DEPTH; ++l) for (int p = 1; p <= PH_PER_LAYER; ++p) { a.layer_lo = l; a.layer_hi = l + 1; a.ph_lo = p; a.ph_hi = p + 1; hipLaunchKernelGGL(phase_kernel<0>(p), dim3(grid), dim3(NTHR), LDS_BYTES, stream, a); }
#endif
}
```

```cpp
#include <hip/hip_runtime.h>
#include <cstdio>
#include <cstdint>
namespace pg8 {
#define PG8_LAS __attribute__((address_space(3)))
typedef unsigned short bf16_t;
typedef short bf16x8 __attribute__((ext_vector_type(8)));
typedef float f32x4 __attribute__((ext_vector_type(4)));
typedef unsigned u32x4 __attribute__((ext_vector_type(4)));
constexpr int BM = 256, BK = 64, HALF = 128, HTB = HALF * BK * 2  , STAGE_BYTES = 8 * HTB, NXCD = 8, WGM = 8;

__host__ __device__ __forceinline__ int lds_byte(int r, int c) { const int st = (r >> 4) * 2 + (c >> 5), rr = r & 15, cc = c & 31, ob = rr * 64 + cc * 2; return st * 1024 + (ob ^ (((ob >> 9) & 1) << 5)); }
__host__ __device__ __forceinline__ void stage_rc(int b, int& R, int& C) { const int st = b / 1024, sb = b % 1024, swz = sb ^ (((sb >> 9) & 1) << 5); R = (st >> 1) * 16 + swz / 64; C = (st & 1) * 32 + (swz % 64) / 2; }
__host__ __device__ __forceinline__ int perm32(int rho) { const int n = rho >> 4, i = rho & 15; return 8 * (i >> 2) + 4 * n + (i & 3); }

struct Unit { int pm, pn; };
struct Gemm { const bf16_t* A; const bf16_t* Bt; int M, N, K; };

struct StaticOrder {
    int nM, nN, nwg, G, c;
    __host__ __device__ void init(int M, int N, int G_, int c_) { nM = M / BM; nN = N / BM; nwg = nM * nN; G = G_; c = c_; }
    __host__ __device__ bool next(int i, Unit& u) const {
        const long L = (long)i * G + c; if (L >= nwg) return false;
        int wgid = (int)L; { const int q = nwg / NXCD, r = nwg % NXCD, xcd = wgid % NXCD, off = wgid / NXCD; wgid = (xcd < r ? xcd * (q + 1) : r * (q + 1) + (xcd - r) * q) + off; }
        const int nig = WGM * nN, gid = wgid / nig, fm = gid * WGM, gsz = (nM - fm) < WGM ? (nM - fm) : WGM;
        u.pm = fm + ((wgid % nig) % gsz); u.pn = (wgid % nig) / gsz; return true;
    }
    __device__ __forceinline__ void a_ready(const Unit&) const {}
    __device__ __forceinline__ void done(const Unit&) const {}
};

__device__ __forceinline__ unsigned cvt_pk_bf16(float lo, float hi) { unsigned r; asm volatile("v_cvt_pk_bf16_f32 %0, %1, %2" : "=v"(r) : "v"(lo), "v"(hi)); return r; }
typedef float f32x2 __attribute__((ext_vector_type(2)));
__device__ __forceinline__ float sigmoid_f(float x) { return __builtin_amdgcn_rcpf(1.0f + __builtin_amdgcn_exp2f(-1.4426950408889634f * x)); }
struct EpiProj {
    static constexpr bool PERM = true, AFTER_DRAIN = false;
    bf16_t* P; int ldp; float* Sm; int ngate0, nbf;
    __device__ __forceinline__ void operator()(const f32x4 (&acc)[2][2][4][2], const Unit& u, int wr, int wc, int fr, int fq) const {
        const int row0 = u.pm * BM + wr * 64 + fr, col0 = u.pn * BM + wc * 32 + 8 * fq;
        if (u.pn >= nbf) {
            const int c0 = wc * 32 + 8 * fq;
#pragma unroll
            for (int ai = 0; ai < 2; ++ai)
#pragma unroll
                for (int m = 0; m < 4; ++m) { float* rowp = Sm + (size_t)(row0 + ai * HALF + m * 16) * 256 + c0;
#pragma unroll
                    for (int bj = 0; bj < 2; ++bj) { *(f32x4*)(rowp + bj * HALF) = acc[ai][bj][m][0]; *(f32x4*)(rowp + bj * HALF + 4) = acc[ai][bj][m][1]; } }
            return;
        }
        const bool sg = u.pn >= ngate0;
#pragma unroll
        for (int ai = 0; ai < 2; ++ai)
#pragma unroll
            for (int m = 0; m < 4; ++m) { bf16_t* rowp = P + (size_t)(row0 + ai * HALF + m * 16) * ldp + col0;
#pragma unroll
                for (int bj = 0; bj < 2; ++bj) { f32x4 v0 = acc[ai][bj][m][0], v1 = acc[ai][bj][m][1];
                    if (sg) {
#pragma unroll
                        for (int j = 0; j < 4; ++j) { v0[j] = sigmoid_f(v0[j]); v1[j] = sigmoid_f(v1[j]); } }
                    u32x4 w; w.x = cvt_pk_bf16(v0[0], v0[1]); w.y = cvt_pk_bf16(v0[2], v0[3]); w.z = cvt_pk_bf16(v1[0], v1[1]); w.w = cvt_pk_bf16(v1[2], v1[3]);
                    *(u32x4*)(rowp + bj * HALF) = w; } }
    }
};
__device__ __forceinline__ f32x4 bf4_lo(u32x4 w) { return (f32x4){__uint_as_float(w.x << 16), __uint_as_float(w.x & 0xffff0000u), __uint_as_float(w.y << 16), __uint_as_float(w.y & 0xffff0000u)}; }
__device__ __forceinline__ f32x4 bf4_hi(u32x4 w) { return (f32x4){__uint_as_float(w.z << 16), __uint_as_float(w.z & 0xffff0000u), __uint_as_float(w.w << 16), __uint_as_float(w.w & 0xffff0000u)}; }
template <int MODE> struct EpiBranch {
    static constexpr bool PERM = true, AFTER_DRAIN = false;
    const bf16_t* G; int ldg; float* T; bf16_t* O; int ldt;
    __device__ __forceinline__ void operator()(const f32x4 (&acc)[2][2][4][2], const Unit& u, int wr, int wc, int fr, int fq) const {
        const int row0 = u.pm * BM + wr * 64 + fr, col0 = u.pn * BM + wc * 32 + 8 * fq;
#pragma unroll
        for (int ai = 0; ai < 2; ++ai)
#pragma unroll
            for (int m = 0; m < 4; ++m) { const size_t r = (size_t)(row0 + ai * HALF + m * 16);
#pragma unroll
                for (int bj = 0; bj < 2; ++bj) { const u32x4 g = *(const u32x4*)(G + r * ldg + col0 + bj * HALF);
                    f32x4 v0 = acc[ai][bj][m][0] * bf4_lo(g), v1 = acc[ai][bj][m][1] * bf4_hi(g);
                    float* tp = T + r * ldt + col0 + bj * HALF;
                    if (MODE >= 1) { v0 = v0 + *(const f32x4*)tp; v1 = v1 + *(const f32x4*)(tp + 4); }
                    if (MODE <= 1) { *(f32x4*)tp = v0; *(f32x4*)(tp + 4) = v1; }
                    else { u32x4 w; w.x = cvt_pk_bf16(v0[0], v0[1]); w.y = cvt_pk_bf16(v0[2], v0[3]); w.z = cvt_pk_bf16(v1[0], v1[1]); w.w = cvt_pk_bf16(v1[2], v1[3]);
                        *(u32x4*)(O + r * ldt + col0 + bj * HALF) = w; } } }
    }
};
struct EpiResid {
    static constexpr bool PERM = false, AFTER_DRAIN = false;
    const float* base; float* out; int ldc;
    __device__ __forceinline__ void operator()(const f32x4 (&acc)[2][2][4][2], const Unit& u, int wr, int wc, int fr, int fq) const {
        const int row0 = u.pm * BM + wr * 64 + fr, col0 = u.pn * BM + wc * 32 + 4 * fq;
#pragma unroll
        for (int ai = 0; ai < 2; ++ai)
#pragma unroll
            for (int m = 0; m < 4; ++m) { const size_t off = (size_t)(row0 + ai * HALF + m * 16) * ldc + col0;
#pragma unroll
                for (int bj = 0; bj < 2; ++bj)
#pragma unroll
                    for (int n = 0; n < 2; ++n) *(f32x4*)(out + off + bj * HALF + n * 16) = *(const f32x4*)(base + off + bj * HALF + n * 16) + acc[ai][bj][m][n]; }
    }
};
struct EpiSwiGLU {
    static constexpr bool PERM = true, AFTER_DRAIN = false;
    bf16_t* O; int ldc;
    __device__ __forceinline__ void operator()(const f32x4 (&acc)[2][2][4][2], const Unit& u, int wr, int wc, int fr, int fq) const {
        const int row0 = u.pm * BM + wr * 64 + fr, col0 = u.pn * HALF + wc * 32 + 8 * fq;
#pragma unroll
        for (int ai = 0; ai < 2; ++ai)
#pragma unroll
            for (int m = 0; m < 4; ++m) { f32x4 v0, v1;
#pragma unroll
                for (int j = 0; j < 4; ++j) { const float g0 = acc[ai][0][m][0][j], g1 = acc[ai][0][m][1][j];
                    v0[j] = g0 * sigmoid_f(g0) * acc[ai][1][m][0][j]; v1[j] = g1 * sigmoid_f(g1) * acc[ai][1][m][1][j]; }
                u32x4 w; w.x = cvt_pk_bf16(v0[0], v0[1]); w.y = cvt_pk_bf16(v0[2], v0[3]); w.z = cvt_pk_bf16(v1[0], v1[1]); w.w = cvt_pk_bf16(v1[2], v1[3]);
                *(u32x4*)(O + (size_t)(row0 + ai * HALF + m * 16) * ldc + col0) = w; }
    }
};
template <class Epi, class Sched, bool ALIGN_EPI = false, bool SP2 = false>
__device__ __forceinline__ void gemm_phase(PG8_LAS unsigned char* lds, const Gemm g, const Sched& S, const Epi& E) {
    int tid_o = threadIdx.x; asm volatile("" : "+v"(tid_o));
    const int tid = tid_o, wid = __builtin_amdgcn_readfirstlane(tid >> 6), lane = tid & 63, wr = wid >> 2, wc = wid & 3, fr = lane & 15, fq = lane >> 4;
    const int K = g.K, nt = K / BK;
    unsigned voffA[2], voffB[2];
#pragma unroll
    for (int i = 0; i < 2; ++i) { int R, C; stage_rc(tid * 16 + i * 8192, R, C); const int Rb = Epi::PERM ? ((R & ~31) + perm32(R & 31)) : R;
        voffA[i] = (unsigned)(R * K + C) * 2u; voffB[i] = (unsigned)(Rb * K + C) * 2u; }
    const size_t kstep = (size_t)(BK * 2);
    const size_t hstep = (size_t)HALF * K * 2;
    const size_t tstep = 2 * hstep;
    const unsigned ldsw = (unsigned)wid * 1024u;
    const int aoff = lds_byte(wr * 64 + fr, fq * 8), boff = lds_byte(wc * 32 + fr, fq * 8);
#define PG8_SA(b, h) (((b) * 2 + (h)) * HTB)
#define PG8_SB(b, h) ((4 + (b) * 2 + (h)) * HTB)
#define PG8_STAGE(bufoff, gbase, voff) do { _Pragma("unroll") for (int _i = 0; _i < 2; ++_i) \
        __builtin_amdgcn_global_load_lds((const unsigned*)((const char*)(gbase) + (voff)[_i]), (PG8_LAS unsigned*)(lds + (bufoff) + ldsw + _i * 8192), 16, 0, 0); } while (0)
#define PG8_LDA(dst, b, h) do { _Pragma("unroll") for (int m = 0; m < 4; ++m) _Pragma("unroll") for (int k = 0; k < 2; ++k) dst[m][k] = *(const PG8_LAS bf16x8*)(lds + PG8_SA(b, h) + aoff + m * 2048 + k * 1024); } while (0)
#define PG8_LDB(dst, b, h) do { _Pragma("unroll") for (int n = 0; n < 2; ++n) _Pragma("unroll") for (int k = 0; k < 2; ++k) dst[n][k] = *(const PG8_LAS bf16x8*)(lds + PG8_SB(b, h) + boff + n * 2048 + k * 1024); } while (0)
#define PG8_MMA(ai, bj, At, Bt) do { __builtin_amdgcn_s_setprio(1); _Pragma("unroll") for (int m = 0; m < 4; ++m) _Pragma("unroll") for (int n = 0; n < 2; ++n) _Pragma("unroll") for (int k = 0; k < 2; ++k) \
        acc[ai][bj][m][n] = __builtin_amdgcn_mfma_f32_16x16x32_bf16(Bt[n][k], At[m][k], acc[ai][bj][m][n], 0, 0, 0); __builtin_amdgcn_s_setprio(0); } while (0)
#define PG8_WAIT_V(n) asm volatile("s_waitcnt vmcnt(" #n ")" ::: "memory")
#define PG8_WAIT_L(n) asm volatile("s_waitcnt lgkmcnt(" #n ")" ::: "memory")
#define PG8_BAR __builtin_amdgcn_s_barrier()
#define PG8_SCHED __builtin_amdgcn_sched_barrier(0)
    Unit cur, nxt; int ui = 0;
    if (!S.next(0, cur)) return;
    f32x4 acc[2][2][4][2];
#pragma unroll
    for (int a = 0; a < 2; ++a)
#pragma unroll
        for (int b = 0; b < 2; ++b)
#pragma unroll
            for (int m = 0; m < 4; ++m)
#pragma unroll
                for (int n = 0; n < 2; ++n) acc[a][b][m][n] = (f32x4){0.f, 0.f, 0.f, 0.f};
    bf16x8 At[4][2], B0[2][2], B1[2][2];
    const char* cA = (const char*)g.A + (size_t)cur.pm * tstep; const char* cB = (const char*)g.Bt + (size_t)cur.pn * tstep;
    S.a_ready(cur);
    if constexpr (SP2) {
        PG8_STAGE(PG8_SB(0, 0), cB, voffB); PG8_STAGE(PG8_SB(0, 1), cB + hstep, voffB); PG8_STAGE(PG8_SA(0, 0), cA, voffA); PG8_STAGE(PG8_SA(0, 1), cA + hstep, voffA);
        if (wr == 1) PG8_BAR;
        PG8_WAIT_V(2); PG8_BAR;
        PG8_STAGE(PG8_SB(1, 0), cB + kstep, voffB); PG8_STAGE(PG8_SA(1, 0), cA + kstep, voffA); PG8_STAGE(PG8_SB(1, 1), cB + hstep + kstep, voffB);
        PG8_WAIT_V(6); PG8_BAR;
    } else {
        PG8_STAGE(PG8_SB(0, 0), cB, voffB); PG8_STAGE(PG8_SA(0, 0), cA, voffA); PG8_STAGE(PG8_SB(0, 1), cB + hstep, voffB); PG8_STAGE(PG8_SA(0, 1), cA + hstep, voffA);
        if (wr == 1) PG8_BAR;
        PG8_WAIT_V(4); PG8_BAR;
        PG8_STAGE(PG8_SB(1, 0), cB + kstep, voffB); PG8_STAGE(PG8_SA(1, 0), cA + kstep, voffA); PG8_STAGE(PG8_SB(1, 1), cB + hstep + kstep, voffB);
        PG8_WAIT_V(6); PG8_BAR;
    }
    for (;;) {
        const bool has_next = S.next(ui + 1, nxt);
        const char* nA = has_next ? (const char*)g.A + (size_t)nxt.pm * tstep : cA; const char* nB = has_next ? (const char*)g.Bt + (size_t)nxt.pn * tstep : cB;
        for (int t = 0; t < nt; t += 2) {
            const bool last = (t == nt - 2);
            const char* a1 = cA + (size_t)(t + 1) * kstep;
            const char* a2 = last ? nA : cA + (size_t)(t + 2) * kstep; const char* b2 = last ? nB : cB + (size_t)(t + 2) * kstep;
            const char* a3 = a2 + kstep; const char* b3 = b2 + kstep;
            if (last && has_next) S.a_ready(nxt);
            if constexpr (SP2) {
            PG8_LDB(B0, 0, 0); PG8_LDB(B1, 0, 1); PG8_SCHED; PG8_LDA(At, 0, 0); PG8_STAGE(PG8_SA(1, 1), a1 + hstep, voffA);
            PG8_WAIT_V(8); PG8_WAIT_L(0); PG8_BAR; PG8_MMA(0, 0, At, B0); PG8_MMA(0, 1, At, B1); PG8_BAR; PG8_SCHED;
            PG8_LDA(At, 0, 1); PG8_STAGE(PG8_SB(0, 0), b2, voffB); PG8_STAGE(PG8_SB(0, 1), b2 + hstep, voffB); PG8_STAGE(PG8_SA(0, 0), a2, voffA);
            PG8_WAIT_V(8); PG8_WAIT_L(0); PG8_BAR; PG8_MMA(1, 0, At, B0); PG8_MMA(1, 1, At, B1); PG8_BAR; PG8_SCHED;
            PG8_LDB(B0, 1, 0); PG8_LDB(B1, 1, 1); PG8_SCHED; PG8_LDA(At, 1, 0); PG8_STAGE(PG8_SA(0, 1), a2 + hstep, voffA);
            PG8_WAIT_V(8); PG8_WAIT_L(0); PG8_BAR; PG8_MMA(0, 0, At, B0); PG8_MMA(0, 1, At, B1); PG8_BAR; PG8_SCHED;
            PG8_LDA(At, 1, 1); PG8_STAGE(PG8_SB(1, 0), b3, voffB); PG8_STAGE(PG8_SB(1, 1), b3 + hstep, voffB); PG8_STAGE(PG8_SA(1, 0), a3, voffA);
            PG8_WAIT_V(8); PG8_WAIT_L(0); PG8_BAR; PG8_MMA(1, 0, At, B0); PG8_MMA(1, 1, At, B1); PG8_BAR; PG8_SCHED;
            } else {
            PG8_LDB(B0, 0, 0); PG8_SCHED; PG8_LDA(At, 0, 0); PG8_STAGE(PG8_SA(1, 1), a1 + hstep, voffA);
            PG8_WAIT_L(8); PG8_BAR; PG8_WAIT_L(0); PG8_MMA(0, 0, At, B0); PG8_BAR; PG8_SCHED;
            PG8_LDB(B1, 0, 1); PG8_STAGE(PG8_SB(0, 0), b2, voffB);
            PG8_BAR; PG8_WAIT_L(0); PG8_MMA(0, 1, At, B1); PG8_BAR;
            PG8_LDA(At, 0, 1); PG8_STAGE(PG8_SA(0, 0), a2, voffA);
            PG8_BAR; PG8_WAIT_L(0); PG8_MMA(1, 0, At, B0); PG8_BAR; PG8_SCHED;
            PG8_STAGE(PG8_SB(0, 1), b2 + hstep, voffB);
            PG8_WAIT_V(6); PG8_BAR; PG8_MMA(1, 1, At, B1); PG8_BAR;
            PG8_LDB(B0, 1, 0); PG8_SCHED; PG8_LDA(At, 1, 0); PG8_STAGE(PG8_SA(0, 1), a2 + hstep, voffA);
            PG8_WAIT_L(8); PG8_BAR; PG8_WAIT_L(0); PG8_MMA(0, 0, At, B0); PG8_BAR; PG8_SCHED;
            PG8_LDB(B1, 1, 1); PG8_STAGE(PG8_SB(1, 0), b3, voffB);
            PG8_BAR; PG8_WAIT_L(0); PG8_MMA(0, 1, At, B1); PG8_BAR;
            PG8_LDA(At, 1, 1); PG8_STAGE(PG8_SA(1, 0), a3, voffA);
            PG8_BAR; PG8_WAIT_L(0); PG8_MMA(1, 0, At, B0); PG8_BAR; PG8_SCHED;
            PG8_STAGE(PG8_SB(1, 1), b3 + hstep, voffB);
            PG8_WAIT_V(6); PG8_BAR; PG8_MMA(1, 1, At, B1); PG8_BAR;
            }
        }
        if constexpr (ALIGN_EPI) { if (wr == 0) PG8_BAR; }
        if constexpr (!Epi::AFTER_DRAIN) { E(acc, cur, wr, wc, fr, fq); S.done(cur); }
        if (!has_next) break;
#pragma unroll
        for (int a = 0; a < 2; ++a)
#pragma unroll
            for (int b = 0; b < 2; ++b)
#pragma unroll
                for (int m = 0; m < 4; ++m)
#pragma unroll
                    for (int n = 0; n < 2; ++n) acc[a][b][m][n] = (f32x4){0.f, 0.f, 0.f, 0.f};
        cur = nxt; cA = nA; cB = nB; ++ui;
        if constexpr (ALIGN_EPI) { if (wr == 1) PG8_BAR; }
    }
    PG8_WAIT_V(0);
    if constexpr (!ALIGN_EPI) { if (wr == 0) PG8_BAR; }
    PG8_BAR;
    if constexpr (Epi::AFTER_DRAIN) { E.fused(acc, cur, wr, wc, fr, fq, lds, wid, lane); S.done(cur); }
#undef PG8_SA
#undef PG8_SB
#undef PG8_STAGE
#undef PG8_LDA
#undef PG8_LDB
#undef PG8_MMA
#undef PG8_WAIT_V
#undef PG8_WAIT_L
#undef PG8_BAR
#undef PG8_SCHED
}
}

using pg8::sigmoid_f;
constexpr int NWAVES = 8, NTHR = 512;
constexpr int S = 8192, DM = 2048, DEPTH = 4, FF = 5632;
constexpr int NPROJ = 16896, NPROJ_PAD = 17152, LPROJ = 16976;
constexpr int PC_AQ = 0, PC_AK = 1024, PC_AV = 2048, PC_IQ = 3072, PC_MQ = 3584, PC_MK = 4096, PC_MV = 4608, PC_MO = 5632, PC_RQ = 6656, PC_RK = 7680, PC_RV = 8704, PC_RG = 9728, PC_G = 10752;
constexpr int LC_IK = 3584, LC_IW = 3648, LC_MI = 5704, LC_MF = 5708;
constexpr float NORM_EPS = 1e-6f;
constexpr size_t MiB = 1u << 20;
constexpr size_t WS_CTL = 0, CTL_ZERO_BYTES = 1 * MiB;
constexpr size_t WS_ROPE128 = 2 * MiB, WS_ROPE64 = 6 * MiB;
constexpr size_t WS_W = 16 * MiB, W_LAYER = 153 * MiB;
constexpr size_t WO_IN = 0, WO_B = 67 * MiB, WO_OUT = 79 * MiB, WO_FIN = 87 * MiB, WO_FOUT = 131 * MiB;
constexpr size_t WS_H = 640 * MiB, WS_PROJ = 672 * MiB, WS_SMALL = 936 * MiB, WS_MQK = 944 * MiB, WS_IKB = 960 * MiB, WS_IWF = 961 * MiB, WS_GIF = WS_IWF + 512 * 1024;
constexpr size_t WS_SC = 964 * MiB, WS_MB = 1220 * MiB, WS_DCM = 1228 * MiB, WS_CPM = 1260 * MiB, WS_MISC = 1292 * MiB, WS_DRR = 1294 * MiB, WS_RPR = 1310 * MiB;
constexpr size_t WS_YA = 1328 * MiB, WS_YM = 1344 * MiB, WS_YR = 1360 * MiB, WS_MERGEDF = 1376 * MiB, WS_MERGED = 1440 * MiB, WS_ACT = 1472 * MiB, WS_END = 1560 * MiB;
constexpr size_t MISC_DN = 0, MISC_NPREV = 256 * 1024, MISC_AB = 512 * 1024, MISC_MPREV = 520 * 1024;
constexpr int CW_BAR = 4096;
constexpr int LDS_BYTES = 147456, MISC_OFF = 147456 - 256;

#define GAS __attribute__((address_space(1)))
#define LAS __attribute__((address_space(3)))
typedef unsigned short bf16;
typedef unsigned v4u __attribute__((ext_vector_type(4)));
typedef unsigned v2u __attribute__((ext_vector_type(2)));
typedef float f32x4 __attribute__((ext_vector_type(4)));
typedef float f32x16 __attribute__((ext_vector_type(16)));
typedef short bf16x8 __attribute__((ext_vector_type(8)));
typedef short s16x4 __attribute__((ext_vector_type(4)));
#define LDS_WAIT() asm volatile("s_waitcnt lgkmcnt(0)" ::: "memory")
#define VM_WAIT() asm volatile("s_waitcnt vmcnt(0)" ::: "memory")
__device__ __forceinline__ unsigned f2bf(float f) { unsigned u = __builtin_bit_cast(unsigned, f); return (u + 0x7fffu + ((u >> 16) & 1u)) >> 16; }
__device__ __forceinline__ unsigned pk2(float lo, float hi) { return f2bf(lo) | (f2bf(hi) << 16); }
__device__ __forceinline__ float bf2f(bf16 b) { return __uint_as_float(((unsigned)b) << 16); }
__device__ __forceinline__ float wave_sum(float v) {
#pragma unroll
    for (int o = 1; o < 64; o <<= 1) v += __shfl_xor(v, o);
    return v;
}
__device__ __forceinline__ float wave_max(float v) {
#pragma unroll
    for (int o = 1; o < 64; o <<= 1) v = fmaxf(v, __shfl_xor(v, o));
    return v;
}
#define XB_TMO      128
#define XB_XCNT(j)  (256  + 64 * (j))
#define XB_XSUB(j)  (1280 + 64 * (j))
#define XB_XGEN(j)  (2304 + 64 * (j))
#define XB_TOP      3328
#define XB_TOPGEN   3392
#define XCD_BAR_WORDS 3456
#define XB_SPIN_CAP (1u << 18)

__device__ __forceinline__ unsigned xb_ld(unsigned* p)              { return __hip_atomic_load(p, __ATOMIC_RELAXED, __HIP_MEMORY_SCOPE_AGENT); }
__device__ __forceinline__ unsigned xb_add(unsigned* p, unsigned v) { return __hip_atomic_fetch_add(p, v, __ATOMIC_RELAXED, __HIP_MEMORY_SCOPE_AGENT); }
__device__ __forceinline__ unsigned xb_xcc_id() { return (unsigned)__builtin_amdgcn_s_getreg((3 << 11) | 20) & 0xFu; }
#define XB_SPIN(cond, bar) do { unsigned _sp = 0; while (cond) { __builtin_amdgcn_s_sleep(1); \
    if ((++_sp & 255u) == 0u) { if (xb_ld(&(bar)[XB_TMO])) break; if (_sp > XB_SPIN_CAP) { atomicAdd(&(bar)[XB_TMO], 1u); break; } } } } while (0)

struct XcdBarrier {
    unsigned* bar; unsigned x;
    volatile LAS unsigned* st;
};

__device__ __forceinline__ XcdBarrier xcd_barrier_post(unsigned* bar, volatile LAS unsigned* st) {
    XcdBarrier b; b.bar = bar; b.x = xb_xcc_id(); b.st = st;
    if (threadIdx.x == 0) (void)xb_add(&bar[XB_XCNT(b.x)], 1u);
    return b;
}
__device__ __forceinline__ void xcd_barrier_complete(unsigned* bar, unsigned x, unsigned& nloc, unsigned& nx) {
    const unsigned G = gridDim.x * gridDim.y * gridDim.z;
    unsigned sum, cnt, mine, sp = 0u;
    for (;;) {
        sum = 0u; cnt = 0u; mine = 0u;
#pragma unroll
        for (unsigned j = 0; j < 16; ++j) { const unsigned c = xb_ld(&bar[XB_XCNT(j)]); sum += c; cnt += (c > 0u) ? 1u : 0u; mine = (j == x) ? c : mine; }
        if (sum == G) break;
        __builtin_amdgcn_s_sleep(1);
        if ((++sp & 255u) == 0u) { if (xb_ld(&bar[XB_TMO])) break; if (sp > XB_SPIN_CAP) { atomicAdd(&bar[XB_TMO], 1u); break; } }
    }
    nloc = mine > 0u ? mine : 1u; nx = cnt > 0u ? cnt : 1u;
}

__device__ __forceinline__ void xcd_barrier(const XcdBarrier& b) {
    asm volatile("s_waitcnt vmcnt(0)" ::: "memory");
    __syncthreads();
    if (threadIdx.x == 0) {
        unsigned* bar = b.bar;
        __builtin_amdgcn_s_waitcnt(0);
        unsigned nloc = b.st[0], nx = b.st[1];
        if (nloc == 0u) { xcd_barrier_complete(bar, b.x, nloc, nx); b.st[0] = nloc; b.st[1] = nx; }
        const unsigned old = xb_add(&bar[XB_XSUB(b.x)], 1u);
        const unsigned gen = old / nloc;
        if (old + 1u == (gen + 1u) * nloc) {
            __builtin_amdgcn_fence(__ATOMIC_RELEASE, "agent");
            asm volatile("s_waitcnt vmcnt(0)" ::: "memory");
            const unsigned og = xb_add(&bar[XB_TOP], 1u);
            const unsigned tg = og / nx;
            if (og + 1u == (tg + 1u) * nx) xb_add(&bar[XB_TOPGEN], 1u);
            else XB_SPIN(xb_ld(&bar[XB_TOPGEN]) == tg, bar);
            __builtin_amdgcn_fence(__ATOMIC_ACQUIRE, "agent");
            xb_add(&bar[XB_XGEN(b.x)], 1u);
            asm volatile("s_waitcnt vmcnt(0)" ::: "memory");
        } else {
            XB_SPIN(xb_ld(&bar[XB_XGEN(b.x)]) == gen, bar);
            __builtin_amdgcn_fence(__ATOMIC_ACQUIRE, "agent");
            asm volatile("s_waitcnt vmcnt(0)" ::: "memory");
        }
    }
    __syncthreads();
}

struct MapIdent { __device__ __forceinline__ int operator()(int p) const { return p; } };
struct MapWin { __device__ __forceinline__ int operator()(int p) const {
    if (p < 3584) return p; if (p < 5632) return p + 72; if (p < NPROJ) return p + 80;
    const int r = p - NPROJ; if (r < 64) return LC_IK + r; if (r < 72) return LC_IW + (r - 64); if (r < 76) return LC_MI + (r - 72); if (r < 80) return LC_MF + (r - 76); return -1; } };
struct MapFfn { __device__ __forceinline__ int operator()(int p) const { const int t = p >> 8, r = p & 255; return r < 128 ? 128 * t + r : FF + 128 * t + (r - 128); } };
template <class Map> __device__ __forceinline__ void transpose_item(const float* W, int K, int N, bf16* WT, LAS float* scr, int item, int nblk, int lane, const Map& map) {
    const int kb = item / nblk, nb = item % nblk, k0 = 64 * kb, p0 = 64 * nb;
    const int n4 = lane & 15, kr = lane >> 4, nl = map(p0 + 4 * n4);
    f32x4 v[16];
#pragma unroll
    for (int i = 0; i < 16; ++i) v[i] = nl >= 0 ? *(const GAS f32x4*)(W + (size_t)(k0 + kr + 4 * i) * N + nl) : (f32x4){0.f, 0.f, 0.f, 0.f};
#pragma unroll
    for (int i = 0; i < 16; ++i) { LAS float* d = scr + (kr + 4 * i) * 65 + 4 * n4; d[0] = v[i][0]; d[1] = v[i][1]; d[2] = v[i][2]; d[3] = v[i][3]; }
    LDS_WAIT(); asm volatile("" ::: "memory");
    const int c = lane & 7;
#pragma unroll
    for (int j = 0; j < 8; ++j) { const int n = (lane >> 3) + 8 * j; const LAS float* s = scr + (8 * c) * 65 + n;
        v4u o; o.x = pk2(s[0 * 65], s[1 * 65]); o.y = pk2(s[2 * 65], s[3 * 65]); o.z = pk2(s[4 * 65], s[5 * 65]); o.w = pk2(s[6 * 65], s[7 * 65]);
        *(GAS v4u*)(WT + (size_t)(p0 + n) * K + k0 + 8 * c) = o; }
    LDS_WAIT(); asm volatile("" ::: "memory");
}
template <class Map> __device__ __forceinline__ void transpose_matrix(const float* W, int K, int N, int Nphys, bf16* WT, LAS float* scr, int gw, int ngw, int lane, const Map& map) {
    const int nblk = Nphys / 64, nit = (K / 64) * nblk;
    for (int it = gw; it < nit; it += ngw) transpose_item(W, K, N, WT, scr, it, nblk, lane, map);
}

__device__ __forceinline__ void rms_row_to_bf16(const float* xrow, const float* gain, bf16* orow, int lane) {
    const GAS f32x4* xr = (const GAS f32x4*)xrow + lane; const GAS f32x4* gr = (const GAS f32x4*)gain + lane;
    f32x4 v[8]; float s = 0.f;
#pragma unroll
    for (int j = 0; j < 8; ++j) { v[j] = xr[64 * j]; s += (v[j].x * v[j].x + v[j].y * v[j].y) + (v[j].z * v[j].z + v[j].w * v[j].w); }
    const float rstd = 1.0f / sqrtf(wave_sum(s) * (1.f / DM) + NORM_EPS);
    GAS unsigned long long* o8 = (GAS unsigned long long*)orow + lane;
#pragma unroll
    for (int j = 0; j < 8; ++j) { const f32x4 g = gr[64 * j]; o8[64 * j] = (unsigned long long)pk2(v[j].x * rstd * g.x, v[j].y * rstd * g.y) | ((unsigned long long)pk2(v[j].z * rstd * g.z, v[j].w * rstd * g.w) << 32); }
}

struct PPArgs { bf16* proj; const float* small; bf16* mqk; bf16* ikb; float* iwf; float* gif; const float* rope128; const float* rope64; const float* gq; const float* gk; const float* convw; const float* gbias; };
__device__ __forceinline__ void pp_row(const PPArgs& a, int t, int lane) {
    bf16* pr = a.proj + (size_t)t * NPROJ;
    const float2 cs = ((const float2*)a.rope128)[t * 64 + lane];
    const float2 c6 = ((const float2*)a.rope64)[t * 32 + (lane & 31)];
#pragma unroll 1
    for (int which = 0; which < 2; ++which) {
        const float* gn = which ? a.gk : a.gq; const float g1 = gn[lane], g2 = gn[64 + lane];
#pragma unroll 2
        for (int hh = 0; hh < 8; ++hh) { bf16* p = pr + (which ? PC_AK : PC_AQ) + hh * 128;
            const float x1 = bf2f(p[lane]), x2 = bf2f(p[64 + lane]);
            const float rstd = 1.0f / sqrtf(wave_sum(x1 * x1 + x2 * x2) * (1.f / 128.f) + NORM_EPS);
            const float y1 = x1 * rstd * g1, y2 = x2 * rstd * g2;
            p[lane] = (bf16)f2bf(y1 * cs.x - y2 * cs.y); p[64 + lane] = (bf16)f2bf(y2 * cs.x + y1 * cs.y); }
    }
#pragma unroll 1
    for (int which = 0; which < 2; ++which) {
#pragma unroll 2
        for (int hh = 0; hh < 8; ++hh) { bf16* p = pr + (which ? PC_RK : PC_RQ) + hh * 128;
            const float y1 = bf2f(p[lane]), y2 = bf2f(p[64 + lane]);
            p[lane] = (bf16)f2bf(y1 * cs.x - y2 * cs.y); p[64 + lane] = (bf16)f2bf(y2 * cs.x + y1 * cs.y); }
    }
#pragma unroll
    for (int p4 = 0; p4 < 4; ++p4) { bf16* p = pr + PC_IQ + (2 * p4 + (lane >> 5)) * 64; const int i = lane & 31;
        const float y1 = bf2f(p[i]), y2 = bf2f(p[32 + i]);
        p[i] = (bf16)f2bf(y1 * c6.x - y2 * c6.y); p[32 + i] = (bf16)f2bf(y2 * c6.x + y1 * c6.y); }
    const float* sm = a.small + (size_t)t * 256;
    if (lane < 32) { const float y1 = sm[lane], y2 = sm[32 + lane];
        a.ikb[(size_t)t * 64 + lane] = (bf16)f2bf(y1 * c6.x - y2 * c6.y); a.ikb[(size_t)t * 64 + 32 + lane] = (bf16)f2bf(y2 * c6.x + y1 * c6.y); }
    if (lane < 8) { a.iwf[(size_t)t * 8 + lane] = sm[64 + lane] * (0.35355339059327373f * 0.125f);
        a.gif[(size_t)t * 8 + lane] = sm[72 + lane] + a.gbias[lane]; }
#pragma unroll 4
    for (int i = 0; i < 16; ++i) { const int c = lane + 64 * i; float acc = 0.f;
#pragma unroll
        for (int j = 0; j < 4; ++j) { const int tt = t - 3 + j; if (tt >= 0) acc += a.convw[j * 1024 + c] * bf2f(a.proj[(size_t)tt * NPROJ + PC_MQ + c]); }
        a.mqk[(size_t)t * 1024 + c] = (bf16)f2bf(acc); }
}

__device__ __forceinline__ void score_wave_unit(const bf16* proj, const bf16* ikb, const float* iwf, float* sc, int qb, int kb, int lane) {
    const int r = lane & 31, h = lane >> 5, q = qb * 32 + r, s0 = kb * 128;
    bf16x8 ka[4][4];
#pragma unroll
    for (int b = 0; b < 4; ++b)
#pragma unroll
        for (int kk = 0; kk < 4; ++kk) ka[b][kk] = *(const bf16x8*)(ikb + (size_t)(s0 + 32 * b + r) * 64 + 16 * kk + 8 * h);
    f32x16 scv[4];
#pragma unroll
    for (int b = 0; b < 4; ++b)
#pragma unroll
        for (int e = 0; e < 16; ++e) scv[b][e] = 0.f;
#pragma unroll 1
    for (int j = 0; j < 8; ++j) {
        bf16x8 qf[4];
#pragma unroll
        for (int kk = 0; kk < 4; ++kk) qf[kk] = *(const bf16x8*)(proj + (size_t)q * NPROJ + PC_IQ + j * 64 + 16 * kk + 8 * h);
        const float wj = iwf[(size_t)q * 8 + j];
#pragma unroll
        for (int b = 0; b < 4; ++b) { f32x16 acc;
#pragma unroll
            for (int e = 0; e < 16; ++e) acc[e] = 0.f;
#pragma unroll
            for (int kk = 0; kk < 4; ++kk) acc = __builtin_amdgcn_mfma_f32_32x32x16_bf16(ka[b][kk], qf[kk], acc, 0, 0, 0);
#pragma unroll
            for (int e = 0; e < 16; ++e) scv[b][e] += wj * fmaxf(acc[e], 0.f); }
    }
#pragma unroll
    for (int b = 0; b < 4; ++b)
#pragma unroll
        for (int g = 0; g < 4; ++g) *(f32x4*)(sc + (size_t)q * S + s0 + 32 * b + 8 * g + 4 * h) = (f32x4){scv[b][4 * g], scv[b][4 * g + 1], scv[b][4 * g + 2], scv[b][4 * g + 3]};
}

#define SEL_BAR() do { asm volatile("s_waitcnt lgkmcnt(0)" ::: "memory"); __builtin_amdgcn_s_barrier(); asm volatile("" ::: "memory"); } while (0)
__device__ __forceinline__ void select_rows_wg(LAS unsigned char* lds, const float* sc, unsigned long long* mb, int row0, int rstep, int tid) {
    LAS unsigned* hist = (LAS unsigned*)lds;
    LAS float* red = (LAS float*)(hist + 2112); LAS unsigned* lcnt = hist + 2128;
    LAS float* lval = (LAS float*)(hist + 2144); LAS int* lidx = (LAS int*)(hist + 2144 + 8192);
    const int lane = tid & 63, w = tid >> 6;
    float nx[16], ny[16], nz[16];
#define SEL_LOAD(dst, t_) do { const float* scr_ = sc + (size_t)(t_) * S; _Pragma("unroll") for (int i = 0; i < 16; ++i) { const int s_ = i * 512 + tid; dst[i] = (s_ <= (t_)) ? scr_[s_] : 0.f; } } while (0)
    if (row0 < S) SEL_LOAD(nx, row0);
    if (row0 + rstep < S) SEL_LOAD(ny, row0 + rstep);
    if (row0 + 2 * rstep < S) SEL_LOAD(nz, row0 + 2 * rstep);
    if (tid < 2) lcnt[tid] = 0u;
    for (int j = tid; j < 2112; j += NTHR) hist[j] = 0u;
    int par = 0;
    for (int t = row0; t < S; t += rstep) {
        float v[16];
#pragma unroll
        for (int i = 0; i < 16; ++i) { v[i] = nx[i]; nx[i] = ny[i]; ny[i] = nz[i]; }
        if (t + 3 * rstep < S) SEL_LOAD(nz, t + 3 * rstep);
        unsigned long long* mbr = mb + (size_t)t * 128;
        if (t < 256) {
#pragma unroll
            for (int i = 0; i < 16; ++i) { const unsigned long long m = __builtin_amdgcn_ballot_w64(i * 512 + tid <= t); if (lane == 0) mbr[i * 8 + w] = m; }
            continue; }
        const int nround = (t >> 9) + 1;
        float mn = 3.0e38f, mx = -3.0e38f;
#pragma unroll
        for (int i = 0; i < 16; ++i) if (i * 512 + tid <= t) { mn = fminf(mn, v[i]); mx = fmaxf(mx, v[i]); }
#pragma unroll
        for (int o = 1; o < 64; o <<= 1) { mn = fminf(mn, __shfl_xor(mn, o)); mx = fmaxf(mx, __shfl_xor(mx, o)); }
        if (lane == 0) { red[w] = mn; red[8 + w] = mx; }
        SEL_BAR();
        mn = red[0]; mx = red[8];
#pragma unroll
        for (int j = 1; j < 8; ++j) { mn = fminf(mn, red[j]); mx = fmaxf(mx, red[8 + j]); }
        const float scale = (mx > mn) ? 2047.0f / (mx - mn) : 0.f;
        int bin[16];
#pragma unroll
        for (int i = 0; i < 16; ++i) { int b = (int)((v[i] - mn) * scale); b = b < 0 ? 0 : (b > 2047 ? 2047 : b); bin[i] = b;
            if (i < nround && i * 512 + tid <= t) (void)__hip_atomic_fetch_add(hist + b + (b >> 5), 1u, __ATOMIC_RELAXED, __HIP_MEMORY_SCOPE_WORKGROUP); }
        SEL_BAR();
        unsigned hb[32]; unsigned ts = 0u;
#pragma unroll
        for (int k = 0; k < 32; ++k) { hb[k] = hist[33 * lane + k]; ts += hb[k]; }
        unsigned suf = ts;
#pragma unroll
        for (int o = 1; o < 64; o <<= 1) { const unsigned y = __shfl_down(suf, o); if (lane + o < 64) suf += y; }
        unsigned above = suf - ts; int bloc = -1; unsigned aloc = 0u;
        const bool own = above < 256u && above + ts >= 256u;
#pragma unroll
        for (int k = 31; k >= 0; --k) { if (own && bloc < 0 && above + hb[k] >= 256u) { bloc = 32 * lane + k; aloc = above; } above += hb[k]; }
        const unsigned long long om = __builtin_amdgcn_ballot_w64(own);
        const int ol = om ? (int)__builtin_ctzll(om) : 0;
        const int bstar = __shfl(bloc, ol); const unsigned need = 256u - (unsigned)__shfl((int)aloc, ol);
#pragma unroll
        for (int i = 0; i < 16; ++i) { const int s = i * 512 + tid;
            if (i < nround && s <= t && bin[i] == bstar) { const unsigned k = __hip_atomic_fetch_add(lcnt + par, 1u, __ATOMIC_RELAXED, __HIP_MEMORY_SCOPE_WORKGROUP); lval[k] = v[i]; lidx[k] = s; } }
        SEL_BAR();
        const int nl = (int)lcnt[par];
#pragma unroll
        for (int i = 0; i < 16; ++i) { const int s = i * 512 + tid; bool sel = false;
            if (i < nround && s <= t) {
                if (bin[i] > bstar) sel = true;
                else if (bin[i] == bstar) { unsigned rank = 0u; const float x = v[i];
                    for (int j = 0; j < nl; ++j) { const float y = lval[j]; const int sj = lidx[j]; rank += (y > x || (y == x && sj < s)) ? 1u : 0u; }
                    sel = rank < need; } }
            const unsigned long long m = __builtin_amdgcn_ballot_w64(sel);
            if (lane == 0) mbr[i * 8 + w] = m; }
#pragma unroll
        for (int i = 0; i < 16; ++i) if (i < nround && i * 512 + tid <= t) hist[bin[i] + (bin[i] >> 5)] = 0u;
        if (tid == 0) lcnt[par ^ 1] = 0u;
        par ^= 1;
    }
    SEL_BAR();
#undef SEL_LOAD
}

template <int RS> __device__ __forceinline__ bf16x8 frag_row(const LAS unsigned char* base, int r0, int k0, int lane) {
    return *(const LAS bf16x8*)(base + (r0 + (lane & 15)) * RS + (k0 + 8 * (lane >> 4)) * 2);
}
template <int RS> __device__ __forceinline__ bf16x8 frag_tr(const LAS unsigned char* base, int k0, int c0, int lane) {
    const int g = lane >> 4, q = (lane & 15) >> 2, p = lane & 3;
    const unsigned a = (unsigned)(size_t)(base + (k0 + 8 * g + q) * RS + (c0 + 4 * p) * 2);
    s16x4 lo, hi;
    asm volatile("ds_read_b64_tr_b16 %0, %2\n\tds_read_b64_tr_b16 %1, %2 offset:%3\n\ts_waitcnt lgkmcnt(0)" : "=&v"(lo), "=&v"(hi) : "v"(a), "i"(4 * RS) : "memory");
    return (bf16x8){lo[0], lo[1], lo[2], lo[3], hi[0], hi[1], hi[2], hi[3]};
}
#define MFMA16(a, b, c) __builtin_amdgcn_mfma_f32_16x16x32_bf16((a), (b), (c), 0, 0, 0)
constexpr int SCR_OFF = 114688;
constexpr float DK_SCALE = 0.08838834764831845f;
__device__ __forceinline__ float log_sigmoid_f(float x) { return fminf(x, 0.f) - log1pf(expf(-fabsf(x))); }

template <int L, int DV> __device__ __forceinline__ void chunk_delta(LAS unsigned char* lds, const bf16* ksrc, int ldk, const bf16* vsrc, int ldv, const LAS float* wcol, bf16* outT, float* dn, int tid) {
    constexpr int RSK = (128 + 8) * 2, RSV = (DV + 8) * 2, NCB = DV / 128;
    LAS unsigned char* KA = lds; LAS unsigned char* V = lds + L * RSK;
    const int lane = tid & 63, w = tid >> 6;
    for (int idx = tid; idx < L * 16; idx += NTHR) { const int s = idx >> 4, c8 = idx & 15;
        const v4u x = *(const GAS v4u*)(ksrc + (size_t)s * ldk + c8 * 8); const float sc = DK_SCALE * wcol[s]; v4u o;
        o.x = pk2(__uint_as_float(x.x << 16) * sc, __uint_as_float(x.x & 0xffff0000u) * sc); o.y = pk2(__uint_as_float(x.y << 16) * sc, __uint_as_float(x.y & 0xffff0000u) * sc);
        o.z = pk2(__uint_as_float(x.z << 16) * sc, __uint_as_float(x.z & 0xffff0000u) * sc); o.w = pk2(__uint_as_float(x.w << 16) * sc, __uint_as_float(x.w & 0xffff0000u) * sc);
        *(LAS v4u*)(KA + s * RSK + c8 * 16) = o; }
    for (int idx = tid; idx < L * (DV / 8); idx += NTHR) { const int s = idx / (DV / 8), c8 = idx % (DV / 8);
        *(LAS v4u*)(V + s * RSV + c8 * 16) = *(const GAS v4u*)(vsrc + (size_t)s * ldv + c8 * 8); }
    __syncthreads();
    f32x4 acc[8][NCB];
#pragma unroll
    for (int db = 0; db < 8; ++db)
#pragma unroll
        for (int i = 0; i < NCB; ++i) acc[db][i] = (f32x4){0.f, 0.f, 0.f, 0.f};
#pragma unroll
    for (int kk = 0; kk < L / 32; ++kk) {
        bf16x8 bfr[NCB];
#pragma unroll
        for (int i = 0; i < NCB; ++i) bfr[i] = frag_tr<RSV>(V, 32 * kk, 16 * (w * NCB + i), lane);
#pragma unroll
        for (int db = 0; db < 8; ++db) { const bf16x8 a = frag_tr<RSK>(KA, 32 * kk, 16 * db, lane);
#pragma unroll
            for (int i = 0; i < NCB; ++i) acc[db][i] = MFMA16(a, bfr[i], acc[db][i]); }
    }
#pragma unroll
    for (int db = 0; db < 8; ++db)
#pragma unroll
        for (int i = 0; i < NCB; ++i) { const int e = 16 * (w * NCB + i) + (lane & 15), d0 = 16 * db + 4 * (lane >> 4);
            v2u o; o.x = pk2(acc[db][i][0], acc[db][i][1]); o.y = pk2(acc[db][i][2], acc[db][i][3]);
            *(GAS v2u*)(outT + (size_t)e * 128 + d0) = o; }
    if (dn != nullptr && tid < 128) { float s_ = 0.f;
        for (int s = 0; s < L; ++s) s_ += bf2f(*(const LAS bf16*)(KA + s * RSK + tid * 2));
        dn[tid] = s_; }
    __syncthreads();
}

template <int L, int DV, int MODE> __device__ __forceinline__ void chunk_out(LAS unsigned char* lds, LAS float* sf, const bf16* qsrc, int ldq, const bf16* ksrc, int ldk, const bf16* vsrc, int ldv,
                                                                              const bf16* stT, const float* gain, const bf16* gate, int ldg, bf16* y, int ldy, int tid) {
    constexpr int RSQ = (128 + 8) * 2, RSV = (DV + 8) * 2, RSP = (L + 8) * 2, NCB = DV / 128, NT = L / 16, TPW = NT * NT / 8;
    LAS unsigned char* Q = lds; LAS unsigned char* K = lds + L * RSQ; LAS unsigned char* V = lds + 2 * L * RSQ;
    LAS unsigned char* P = (MODE == 0) ? (lds + 2 * L * RSQ + L * RSV) : K;
    LAS float* H = (LAS float*)lds;
    LAS float* lrow = sf; LAS float* lcol = sf + 128; LAS float* qs = sf + 256; LAS float* flo = sf + 384; LAS float* rowsum = sf + 512; LAS float* npv = sf + 640; LAS float* part = sf + 768; LAS float* dpart = sf + 768 + L * NT;
    const int lane = tid & 63, w = tid >> 6, g4 = lane >> 4, c16 = lane & 15;
    for (int idx = tid; idx < L * 16; idx += NTHR) { const int s = idx >> 4, c8 = idx & 15;
        *(LAS v4u*)(Q + s * RSQ + c8 * 16) = *(const GAS v4u*)(qsrc + (size_t)s * ldq + c8 * 8);
        *(LAS v4u*)(K + s * RSQ + c8 * 16) = *(const GAS v4u*)(ksrc + (size_t)s * ldk + c8 * 8); }
    for (int idx = tid; idx < L * (DV / 8); idx += NTHR) { const int s = idx / (DV / 8), c8 = idx % (DV / 8);
        *(LAS v4u*)(V + s * RSV + c8 * 16) = *(const GAS v4u*)(vsrc + (size_t)s * ldv + c8 * 8); }
    __syncthreads();
    f32x4 pv[TPW];
#pragma unroll
    for (int i = 0; i < TPW; ++i) { const int ti = w * TPW + i, rb = ti / NT, cb = ti % NT; f32x4 a = (f32x4){0.f, 0.f, 0.f, 0.f};
        if (cb <= rb) {
#pragma unroll
            for (int kk = 0; kk < 4; ++kk) a = MFMA16(frag_row<RSQ>(Q, 16 * rb, 32 * kk, lane), frag_row<RSQ>(K, 16 * cb, 32 * kk, lane), a);
            const int s = 16 * cb + c16; const float lc = lcol[s]; float rs[4];
#pragma unroll
            for (int r = 0; r < 4; ++r) { const int t = 16 * rb + 4 * g4 + r; const float pw = (s <= t) ? __expf(lrow[t] + lc) * a[r] * DK_SCALE : 0.f; a[r] = pw; rs[r] = pw; }
            if (MODE == 0) {
#pragma unroll
                for (int r = 0; r < 4; ++r) { float v = rs[r]; v += __shfl_xor(v, 1); v += __shfl_xor(v, 2); v += __shfl_xor(v, 4); v += __shfl_xor(v, 8);
                    if (c16 == 0) part[(16 * rb + 4 * g4 + r) * NT + cb] = v; } }
        } else if (MODE == 0) { if (c16 == 0) {
#pragma unroll
                for (int r = 0; r < 4; ++r) part[(16 * rb + 4 * g4 + r) * NT + cb] = 0.f; } }
        pv[i] = a; }
    __syncthreads();
#pragma unroll
    for (int i = 0; i < TPW; ++i) { const int ti = w * TPW + i, rb = ti / NT, cb = ti % NT;
#pragma unroll
        for (int r = 0; r < 4; ++r) *(LAS bf16*)(P + (16 * rb + 4 * g4 + r) * RSP + (16 * cb + c16) * 2) = (bf16)f2bf(pv[i][r]); }
    for (int idx = tid; idx < L * 16; idx += NTHR) { const int s = idx >> 4, c8 = idx & 15; const float sc = qs[s];
        const v4u x = *(const LAS v4u*)(Q + s * RSQ + c8 * 16); float f[8];
        f[0] = __uint_as_float(x.x << 16) * sc; f[1] = __uint_as_float(x.x & 0xffff0000u) * sc; f[2] = __uint_as_float(x.y << 16) * sc; f[3] = __uint_as_float(x.y & 0xffff0000u) * sc;
        f[4] = __uint_as_float(x.z << 16) * sc; f[5] = __uint_as_float(x.z & 0xffff0000u) * sc; f[6] = __uint_as_float(x.w << 16) * sc; f[7] = __uint_as_float(x.w & 0xffff0000u) * sc;
        v4u o; o.x = pk2(f[0], f[1]); o.y = pk2(f[2], f[3]); o.z = pk2(f[4], f[5]); o.w = pk2(f[6], f[7]);
        *(LAS v4u*)(Q + s * RSQ + c8 * 16) = o;
        if (MODE == 0) { float dsum = 0.f;
#pragma unroll
            for (int j = 0; j < 8; ++j) dsum += f[j] * npv[8 * c8 + j];
            dpart[s * 16 + c8] = dsum; } }
    __syncthreads();
    if (MODE == 0 && tid < L) { float a = 0.f;
#pragma unroll
        for (int j = 0; j < NT; ++j) a += part[tid * NT + j];
#pragma unroll
        for (int j = 0; j < 16; ++j) a += dpart[tid * 16 + j];
        rowsum[tid] = a; }
    f32x4 acc[NT][NCB];
#pragma unroll
    for (int rb = 0; rb < NT; ++rb)
#pragma unroll
        for (int i = 0; i < NCB; ++i) acc[rb][i] = (f32x4){0.f, 0.f, 0.f, 0.f};
#pragma unroll
    for (int kk = 0; kk < 4; ++kk) { bf16x8 bfr[NCB];
#pragma unroll
        for (int i = 0; i < NCB; ++i) bfr[i] = *(const GAS bf16x8*)(stT + (size_t)(16 * (w * NCB + i) + c16) * 128 + 32 * kk + 8 * g4);
#pragma unroll
        for (int rb = 0; rb < NT; ++rb) { const bf16x8 a = frag_row<RSQ>(Q, 16 * rb, 32 * kk, lane);
#pragma unroll
            for (int i = 0; i < NCB; ++i) acc[rb][i] = MFMA16(a, bfr[i], acc[rb][i]); } }
#pragma unroll
    for (int kk = 0; kk < L / 32; ++kk) { bf16x8 bfr[NCB];
#pragma unroll
        for (int i = 0; i < NCB; ++i) bfr[i] = frag_tr<RSV>(V, 32 * kk, 16 * (w * NCB + i), lane);
#pragma unroll
        for (int rb = 0; rb < NT; ++rb) { const bf16x8 a = frag_row<RSP>(P, 16 * rb, 32 * kk, lane);
#pragma unroll
            for (int i = 0; i < NCB; ++i) acc[rb][i] = MFMA16(a, bfr[i], acc[rb][i]); } }
    __syncthreads();
#pragma unroll
    for (int rb = 0; rb < NT; ++rb)
#pragma unroll
        for (int i = 0; i < NCB; ++i)
#pragma unroll
            for (int r = 0; r < 4; ++r) { const int t = 16 * rb + 4 * g4 + r, e = 16 * (w * NCB + i) + c16; float hv = acc[rb][i][r];
                if (MODE == 0) hv = hv / fmaxf(fabsf(rowsum[t]), flo[t]);
                H[t * DV + e] = hv; }
    __syncthreads();
    for (int t = w; t < L; t += NWAVES) { float hv[DV / 64]; float s1 = 0.f;
#pragma unroll
        for (int i = 0; i < DV / 64; ++i) { hv[i] = H[t * DV + lane + 64 * i]; s1 += hv[i]; }
        float mu = 0.f; if (MODE == 1) { mu = wave_sum(s1) * (1.f / DV); }
        float s2 = 0.f;
#pragma unroll
        for (int i = 0; i < DV / 64; ++i) { hv[i] -= mu; s2 += hv[i] * hv[i]; }
        const float rstd = 1.0f / sqrtf(wave_sum(s2) * (1.f / DV) + NORM_EPS);
#pragma unroll
        for (int i = 0; i < DV / 64; ++i) { const int e = lane + 64 * i; const float gt = bf2f(gate[(size_t)t * ldg + e]);
            const float act = (MODE == 0) ? sigmoid_f(gt) : gt * sigmoid_f(gt);
            y[(size_t)t * ldy + e] = (bf16)f2bf(hv[i] * rstd * gain[e] * act); } }
    __syncthreads();
}
namespace att {
constexpr int D = 128, LDQKV = NPROJ, LDO = 1024;
constexpr float THR = 8.f; constexpr bool WSKIP = false;
constexpr float SCALE = 0.08838834764831845f;
constexpr int NW = 8, QBLK = 32, KVBLK = 64, QB = NW * QBLK;
constexpr int SHM_V = KVBLK * D * 2, SHM_K = KVBLK * D * 2;
constexpr int LDS_BYTES = 2 * SHM_V + 2 * SHM_K + NW * 64 * 4;

using bf16 = unsigned short;
typedef short bf16x8 __attribute__((ext_vector_type(8)));
typedef short s16x4 __attribute__((ext_vector_type(4)));
typedef float f32x16 __attribute__((ext_vector_type(16)));
typedef float f32x4 __attribute__((ext_vector_type(4)));
typedef unsigned u32x4 __attribute__((ext_vector_type(4)));
template <class A, class Bt> struct same_t { static constexpr bool v = false; };
template <class A> struct same_t<A, A> { static constexpr bool v = true; };

#define KSWZ(row, colB) ((row) * 256 + ((colB) ^ (((row) & 7) << 4)))
#define SBAR() __builtin_amdgcn_sched_barrier(0)
__device__ __forceinline__ int v_st(int k, int c) { const int kk = (k & ~0xC) | ((k & 4) << 1) | ((k & 8) >> 1); return ((kk >> 3) * 4 + (c >> 5)) * 512 + ((kk & 7) * 32 + (c & 31)) * 2; }
__device__ __forceinline__ int v_rd_base(int lane) { return ((lane & 3) << 3) | (((lane >> 2) & 3) << 6) | (((lane >> 4) & 1) << 5) | (((lane >> 5) & 1) << 8); }
constexpr int v_rd_off(int d0, int ks, int half) { return d0 * 512 + ks * 4096 + half * 2048; }
__device__ __forceinline__ int crow(int r, int hi) { return (r & 3) + 8 * (r >> 2) + 4 * hi; }
__device__ __forceinline__ unsigned cvtpk(float lo, float hi) {
    unsigned r; asm volatile("v_cvt_pk_bf16_f32 %0, %1, %2" : "=v"(r) : "v"(lo), "v"(hi)); return r;
}
__device__ __forceinline__ bf16x8 pack8(f32x4 a, f32x4 b) {
    u32x4 w = {cvtpk(a[0], a[1]), cvtpk(a[2], a[3]), cvtpk(b[0], b[1]), cvtpk(b[2], b[3])};
    return *reinterpret_cast<bf16x8*>(&w);
}
template <class T> __device__ __forceinline__ bf16x8 load8(const T* p) {
    if constexpr (same_t<T, float>::v) { return pack8(*(const f32x4*)p, *(const f32x4*)(p + 4)); }
    else { return *reinterpret_cast<const bf16x8*>(p); }
}
__device__ __forceinline__ void mask_bits(f32x16& p0, f32x16& p1, unsigned long long mw, int hi) {
    const unsigned a = (unsigned)mw >> (4 * hi), b = (unsigned)(mw >> 32) >> (4 * hi);
#pragma unroll
    for (int r = 0; r < 16; ++r) {
        const int c = (r & 3) + 8 * (r >> 2);
        const unsigned ma = (unsigned)(((int)(a << (31 - c))) >> 31), mb = (unsigned)(((int)(b << (31 - c))) >> 31);
        p0[r] = __uint_as_float((__float_as_uint(p0[r]) & ma) | (0xff800000u & ~ma));
        p1[r] = __uint_as_float((__float_as_uint(p1[r]) & mb) | (0xff800000u & ~mb));
    }
}
__device__ __forceinline__ void partialSM(f32x16& p0, f32x16& p1, float& m_reg, float& mn, float& alpha) {
    float pmax = p0[0]; for (int r = 1; r < 16; ++r) pmax = fmaxf(pmax, p0[r]); for (int r = 0; r < 16; ++r) pmax = fmaxf(pmax, p1[r]);
    { auto rr = __builtin_amdgcn_permlane32_swap(__float_as_uint(pmax), __float_as_uint(pmax), false, false);
      pmax = fmaxf(__uint_as_float(rr[0]), __uint_as_float(rr[1])); }
    constexpr float C2 = 1.4426950408889634f * SCALE;
    if (__builtin_expect(__all((pmax - m_reg) * SCALE <= THR), 1)) { mn = m_reg; alpha = 1.f; }
    else { mn = fmaxf(m_reg, pmax); alpha = __builtin_amdgcn_exp2f((m_reg - mn) * C2); m_reg = mn; }
    const float mnL = -mn * C2;
    for (int r = 0; r < 16; ++r) p0[r] = fmaf(p0[r], C2, mnL); for (int r = 0; r < 16; ++r) p1[r] = fmaf(p1[r], C2, mnL);
    for (int r = 0; r < 16; ++r) p0[r] = __builtin_amdgcn_exp2f(p0[r]);
}
__device__ __forceinline__ void finishSM(f32x16& p0, f32x16& p1, float alpha, float& l_reg, bf16x8& pa0, bf16x8& pa1, bf16x8& pa2, bf16x8& pa3) {
    for (int r = 0; r < 16; ++r) p1[r] = __builtin_amdgcn_exp2f(p1[r]);
    float ps = 0; for (int r = 0; r < 16; ++r) ps += p0[r]; for (int r = 0; r < 16; ++r) ps += p1[r];
    { auto rr = __builtin_amdgcn_permlane32_swap(__float_as_uint(ps), __float_as_uint(ps), false, false);
      ps = __uint_as_float(rr[0]) + __uint_as_float(rr[1]); }
    l_reg = l_reg * alpha + ps;
#define PK4(P, B_, OUT) do { unsigned a0 = cvtpk(P[B_+0], P[B_+1]), a1 = cvtpk(P[B_+2], P[B_+3]);                          \
        unsigned b0 = cvtpk(P[B_+4], P[B_+5]), b1 = cvtpk(P[B_+6], P[B_+7]);                                             \
        auto r0 = __builtin_amdgcn_permlane32_swap(a0, b0, false, false); auto r1 = __builtin_amdgcn_permlane32_swap(a1, b1, false, false); \
        u32x4 w = {r0[0], r1[0], r0[1], r1[1]}; OUT = *reinterpret_cast<bf16x8*>(&w); } while (0)
    PK4(p0, 0, pa0); PK4(p0, 8, pa1); PK4(p1, 0, pa2); PK4(p1, 8, pa3);
#undef PK4
}
template <int KB, bool SK>
__device__ __forceinline__ void qkt(f32x16& p0, f32x16& p1, const char* K_lds, int r32, int hi, const bf16x8* qr, bool act) {
    if (SK && !act) { const float NEG = -__builtin_inff();
#pragma unroll
        for (int r = 0; r < 16; ++r) { p0[r] = NEG; p1[r] = NEG; } return; }
    p0 = f32x16{}; p1 = f32x16{};
    const char* kb[4];
#pragma unroll
    for (int dd = 0; dd < 4; ++dd) kb[dd] = K_lds + KB * SHM_K + KSWZ(r32, (dd * 16 + hi * 8) * 2);
#pragma unroll
    for (int d0 = 0; d0 < 8; ++d0) { const char* a = kb[d0 & 3] + (d0 >> 2) * 128;
        bf16x8 b0 = *reinterpret_cast<const bf16x8*>(a);
        bf16x8 b1 = *reinterpret_cast<const bf16x8*>(a + 32 * 256);
        p0 = __builtin_amdgcn_mfma_f32_32x32x16_bf16(b0, qr[d0], p0, 0, 0, 0);
        p1 = __builtin_amdgcn_mfma_f32_32x32x16_bf16(b1, qr[d0], p1, 0, 0, 0); }
}
template <int VB, bool SK>
__device__ __forceinline__ void pv_tile(f32x16* o, int vb0, bf16x8 pa0, bf16x8 pa1, bf16x8 pa2, bf16x8 pa3, bool act) {
    if (SK && !act) return;
#define TRRD(dst, off) asm volatile("ds_read_b64_tr_b16 %0, %1 offset:%2" : "=&v"(dst) : "v"(vb0), "i"(off) : "memory")
#define PV_D0(d0) do { s16x4 l0, l1, l2, l3, h0, h1, h2, h3; constexpr int b_ = VB * SHM_V + v_rd_off(d0, 0, 0);     \
        TRRD(l0, b_); TRRD(h0, b_ + 2048); TRRD(l1, b_ + 4096); TRRD(h1, b_ + 6144); TRRD(l2, b_ + 8192); TRRD(h2, b_ + 10240); TRRD(l3, b_ + 12288); TRRD(h3, b_ + 14336); \
        asm volatile("s_waitcnt lgkmcnt(0)" ::: "memory"); SBAR();                 \
        o[d0] = __builtin_amdgcn_mfma_f32_32x32x16_bf16(pa0, (bf16x8){l0[0], l0[1], l0[2], l0[3], h0[0], h0[1], h0[2], h0[3]}, o[d0], 0, 0, 0);   \
        o[d0] = __builtin_amdgcn_mfma_f32_32x32x16_bf16(pa1, (bf16x8){l1[0], l1[1], l1[2], l1[3], h1[0], h1[1], h1[2], h1[3]}, o[d0], 0, 0, 0);   \
        o[d0] = __builtin_amdgcn_mfma_f32_32x32x16_bf16(pa2, (bf16x8){l2[0], l2[1], l2[2], l2[3], h2[0], h2[1], h2[2], h2[3]}, o[d0], 0, 0, 0);   \
        o[d0] = __builtin_amdgcn_mfma_f32_32x32x16_bf16(pa3, (bf16x8){l3[0], l3[1], l3[2], l3[3], h3[0], h3[1], h3[2], h3[3]}, o[d0], 0, 0, 0); } while (0)
    PV_D0(0); PV_D0(1); PV_D0(2); PV_D0(3);
#undef PV_D0
#undef TRRD
}

template <class TIn, class TOut> struct BlockRef { const TIn* Q; const TIn* K; const TIn* V; TOut* O; const unsigned long long* M; int P0; };
template <class TIn> struct Seam {
    bf16x8 qr[8];
    bf16x8 st_v0, st_v1, st_k0, st_k1; f32x4 sf0, sf1, sf2, sf3;
    f32x4 tq[16];
};
__device__ __forceinline__ int swa_jlo(int P0, int W) { const int lowk = P0 - W + 1; return lowk > 0 ? lowk / KVBLK : 0; }
#define ROW(p, k0, rr) ((p) + (size_t)((k0) + (rr)) * LDQKV + sc)
#define VMW() asm volatile("s_waitcnt vmcnt(0)" ::: "memory")
#define VMWN(n) asm volatile("s_waitcnt vmcnt(%0)" :: "i"(n) : "memory")
#define LD16U(base, off) (*reinterpret_cast<const bf16x8*>((const char*)(base) + (off)))
#define SLOAD_H(Kp, Vp, k0) do { const char* kb_ = (const char*)((Kp) + (size_t)(k0) * LDQKV); const char* vb_ = (const char*)((Vp) + (size_t)(k0) * LDQKV);                 \
                         S.st_v0 = LD16U(vb_, soff); S.st_v1 = LD16U(vb_ + (size_t)32 * LDQKV * 2, soff);                                  \
                         S.st_k0 = LD16U(kb_, soff); S.st_k1 = LD16U(kb_ + (size_t)32 * LDQKV * 2, soff); } while (0)
#define SWRITE_HK(bf) do { *(bf16x8*)(K_lds + (bf) * SHM_K + kws) = S.st_k0; *(bf16x8*)(K_lds + (bf) * SHM_K + kws + 32 * 256) = S.st_k1; } while (0)
#define SWRITE_HV(bf) do { *(bf16x8*)(V_lds + (bf) * SHM_V + vst0) = S.st_v0; *(bf16x8*)(V_lds + (bf) * SHM_V + vst1) = S.st_v1; } while (0)
#define SWRITE_H(bf) do { SWRITE_HV(bf); SWRITE_HK(bf); } while (0)
#define SLOAD_F(p, k0) do { S.sf0 = *(const f32x4*)ROW(p, k0, sr); S.sf1 = *(const f32x4*)(ROW(p, k0, sr) + 4);                \
                            S.sf2 = *(const f32x4*)ROW(p, k0, 32 + sr); S.sf3 = *(const f32x4*)(ROW(p, k0, 32 + sr) + 4); } while (0)
#define SWRITE_KF(bf) do { *(bf16x8*)(K_lds + (bf) * SHM_K + kws) = pack8(S.sf0, S.sf1); *(bf16x8*)(K_lds + (bf) * SHM_K + kws + 32 * 256) = pack8(S.sf2, S.sf3); } while (0)
#define SWRITE_VF(bf) do { *(bf16x8*)(V_lds + (bf) * SHM_V + vst0) = pack8(S.sf0, S.sf1); *(bf16x8*)(V_lds + (bf) * SHM_V + vst1) = pack8(S.sf2, S.sf3); } while (0)
template <class TIn, class TOut>
__device__ __forceinline__ void causal_swa_prime(const BlockRef<TIn, TOut>& cur, int W, char* lds, Seam<TIn>& S) {
    constexpr bool F32 = same_t<TIn, float>::v;
    int tid_o = threadIdx.x; asm volatile("" : "+v"(tid_o));
    const int tid = tid_o, wid = __builtin_amdgcn_readfirstlane(tid >> 6), lane = tid & 63, r32 = lane & 31, hi = lane >> 5;
    const int sr = tid >> 4, sc = (tid & 15) * 8, kws = KSWZ(sr, sc * 2); char* K_lds = lds + 2 * SHM_V; const unsigned soff = (unsigned)(sr * LDQKV + sc) * 2u;
    const int kb0 = swa_jlo(cur.P0, W) * KVBLK;
    for (int d0 = 0; d0 < 8; ++d0) S.qr[d0] = load8<TIn>(cur.Q + (size_t)(wid * QBLK + r32) * LDQKV + d0 * 16 + hi * 8);
    if constexpr (F32) { SLOAD_F((const float*)cur.K, kb0); VMW(); SWRITE_KF(0); SBAR(); SLOAD_F((const float*)cur.V, kb0); }
    else { SLOAD_H(cur.K, cur.V, kb0); VMW(); SWRITE_HK(0); }
    __syncthreads();
}
template <class TIn, class TOut>
__device__ __forceinline__ void causal_swa_block(const BlockRef<TIn, TOut>& cur, const BlockRef<TIn, TOut>& nxt, int skv, int W, char* lds, Seam<TIn>& S) {
    constexpr bool F32 = same_t<TIn, float>::v;
    int tid_o = threadIdx.x; asm volatile("" : "+v"(tid_o));
    const int tid = tid_o, wid = __builtin_amdgcn_readfirstlane(tid >> 6), lane = tid & 63, r32 = lane & 31, hi = lane >> 5;
    const int j_lo = swa_jlo(cur.P0, W);
    int j_hi = (cur.P0 + QB - 1) / KVBLK + 1; if (j_hi > skv / KVBLK) j_hi = skv / KVBLK;
    const int NT = j_hi - j_lo;
    const int kbn = swa_jlo(nxt.P0, W) * KVBLK;
    const int qlo = cur.P0 + wid * QBLK, qm = qlo + r32 - 4 * hi;
    char* V_lds = lds; char* K_lds = lds + 2 * SHM_V;
    const unsigned mlane = (unsigned)(wid * QBLK + r32) * 1024u;
    float* ws = (float*)(lds + 2 * SHM_V + 2 * SHM_K) + wid * 64; float* li_l = ws, * al_l = ws + 32;
    float m_reg = -1e30f, l_reg = 0; f32x16 o[4] = {};
    const unsigned soff = (unsigned)((tid >> 4) * LDQKV + (tid & 15) * 8) * 2u;
    const int sr = tid >> 4, sc = (tid & 15) * 8, vst0 = v_st(sr, sc), vst1 = v_st(32 + sr, sc), kws = KSWZ(sr, sc * 2);
    const int vb0 = (int)(uintptr_t)V_lds + v_rd_base(lane);
    const TIn* Kh = cur.K; const TIn* Vh = cur.V;
#define RESC(a) do { if (__any((a) < 1.f)) { if (hi == 0) al_l[r32] = (a); asm volatile("s_waitcnt lgkmcnt(0)" ::: "memory");              \
                     for (int d_ = 0; d_ < 4; ++d_) for (int r = 0; r < 16; ++r) o[d_][r] *= al_l[crow(r, hi)]; } } while (0)
#define KBASE(t) ((j_lo + (t)) * KVBLK)
#define ACT(t) (KBASE(t) <= qlo + QBLK - 1 && KBASE(t) + KVBLK - 1 >= qlo - W + 1)
#define MASKT(P0_, P1_, mw_) mask_bits(P0_, P1_, mw_, hi)
#define MLOAD(t) (*(const unsigned long long*)((const char*)cur.M + (size_t)((j_lo + (t)) * 8) + mlane))
    constexpr int NQL = F32 ? 16 : 8;
    constexpr bool SK = WSKIP && !F32;
#define SEAM_K0() do { VMWN(NQL); if constexpr (F32) { SWRITE_KF(0); SBAR(); SLOAD_F((const float*)nxt.V, kbn); } else { SWRITE_HK(0); } SBAR(); } while (0)
    f32x16 pA0, pA1, pB0, pB1; float mnA, mnB, alA, alB; bf16x8 pa0, pa1, pa2, pa3;
    if constexpr (F32) { VMW(); SWRITE_VF(0); SBAR(); } else { SWRITE_HV(0); SBAR(); }
    if (NT > 1) { if constexpr (F32) SLOAD_F((const float*)Kh, KBASE(1)); else SLOAD_H(Kh, Vh, KBASE(1)); }
    SBAR(); qkt<0, SK>(pA0, pA1, K_lds, r32, hi, S.qr, ACT(0));
    if constexpr (F32) { if (NT > 1) { VMW(); SWRITE_KF(1); SBAR(); SLOAD_F((const float*)Vh, KBASE(1)); } }
    MASKT(pA0, pA1, MLOAD(0)); partialSM(pA0, pA1, m_reg, mnA, alA);
    if (NT > 1) { VMW(); if constexpr (F32) { SWRITE_VF(1); SBAR(); if (NT > 2) SLOAD_F((const float*)Kh, KBASE(2)); } else SWRITE_H(1); }
    __syncthreads();
#define HALF_STEP(PX0, PX1, mnX, alX, PY0, PY1, alY, t, KB, VB, SB) do {                                                      \
        SBAR(); qkt<KB, SK>(PX0, PX1, K_lds, r32, hi, S.qr, ACT(t));                                             \
        finishSM(PY0, PY1, alY, l_reg, pa0, pa1, pa2, pa3); SBAR();                                                           \
        if ((t) + 1 < NT) { if constexpr (F32) { VMW(); SWRITE_KF(SB); SBAR(); SLOAD_F((const float*)Vh, KBASE((t) + 1)); }  \
                            else { SLOAD_H(Kh, Vh, KBASE((t) + 1)); } SBAR(); }                                               \
        pv_tile<VB, SK>(o, vb0, pa0, pa1, pa2, pa3, ACT((t) - 1)); MASKT(PX0, PX1, MLOAD(t)); partialSM(PX0, PX1, m_reg, mnX, alX);                                        \
        __syncthreads();                                                                                                      \
        if ((t) + 1 < NT) { VMW(); if constexpr (F32) { SWRITE_VF(SB); SBAR(); if ((t) + 2 < NT) SLOAD_F((const float*)Kh, KBASE((t) + 2)); } \
                            else { SWRITE_H(SB); } }                                                                          \
        RESC(alX); __syncthreads(); } while (0)
    for (int t = 1; t + 1 < NT; t += 2) {
        HALF_STEP(pB0, pB1, mnB, alB, pA0, pA1, alA, t, 1, 0, 0);
        HALF_STEP(pA0, pA1, mnA, alA, pB0, pB1, alB, t + 1, 0, 1, 1);
    }
    const bool even = (NT & 1) == 0;
    if (even) { SBAR(); qkt<1, SK>(pB0, pB1, K_lds, r32, hi, S.qr, ACT(NT - 1)); SBAR(); }
#define QROW(e) (nxt.Q + (size_t)(wid * QBLK + r32) * LDQKV + ((e) >> 1) * 16 + hi * 8 + ((e) & 1) * 4)
    if constexpr (F32) { SLOAD_F((const float*)nxt.K, kbn); SBAR();
#pragma unroll
        for (int e = 0; e < 8; ++e) S.tq[e] = *(const f32x4*)QROW(e); }
    else { SLOAD_H(nxt.K, nxt.V, kbn); SBAR();
#pragma unroll
        for (int d0 = 0; d0 < 8; ++d0) S.qr[d0] = load8<TIn>(nxt.Q + (size_t)(wid * QBLK + r32) * LDQKV + d0 * 16 + hi * 8); }
    SBAR();
    finishSM(pA0, pA1, alA, l_reg, pa0, pa1, pa2, pa3); SBAR();
    if constexpr (F32) {
#pragma unroll
        for (int e = 8; e < 16; ++e) S.tq[e] = *(const f32x4*)QROW(e); SBAR(); }
#undef QROW
    pv_tile<0, SK>(o, vb0, pa0, pa1, pa2, pa3, ACT(even ? NT - 2 : NT - 1));
    if (even) { MASKT(pB0, pB1, MLOAD(NT - 1)); partialSM(pB0, pB1, m_reg, mnB, alB); __syncthreads(); RESC(alB);
        finishSM(pB0, pB1, alB, l_reg, pa0, pa1, pa2, pa3); SBAR(); pv_tile<1, SK>(o, vb0, pa0, pa1, pa2, pa3, ACT(NT - 1)); }
    SBAR(); SEAM_K0();
    if (hi == 0) li_l[r32] = l_reg; asm volatile("s_waitcnt lgkmcnt(0)" ::: "memory");
    float rli[16];
#pragma unroll
    for (int r = 0; r < 16; ++r) rli[r] = __builtin_amdgcn_rcpf(li_l[crow(r, hi)]);
    TOut* Ow = cur.O + (size_t)(wid * QBLK) * LDO;
#pragma unroll
    for (int r = 0; r < 16; ++r) { const int orow = crow(r, hi);
#pragma unroll
        for (int d0 = 0; d0 < 4; ++d0) { const float v = o[d0][r] * rli[r];
            if constexpr (same_t<TOut, float>::v) { Ow[(size_t)orow * LDO + d0 * 32 + r32] = v; }
            else { const float vn = __shfl_xor(v, 1);
                   if ((r32 & 1) == 0) *(unsigned*)(Ow + (size_t)orow * LDO + d0 * 32 + r32) = cvtpk(v, vn); } } }
    if constexpr (F32) {
#pragma unroll
        for (int d0 = 0; d0 < 8; ++d0) S.qr[d0] = pack8(S.tq[2 * d0], S.tq[2 * d0 + 1]); }
    __syncthreads();
#undef RESC
#undef KBASE
#undef ACT
#undef MASKT
#undef MLOAD
#undef SEAM_K0
#undef HALF_STEP
}
#undef ROW
#undef VMW
#undef VMWN
#undef SLOAD_H
#undef LD16U
#undef SWRITE_HK
#undef SWRITE_HV
#undef SWRITE_H
#undef SLOAD_F
#undef SWRITE_KF
#undef SWRITE_VF

}


template <int NC> __device__ __forceinline__ void scan_elems(const bf16* __restrict__ delta, bf16* __restrict__ prev, size_t cstride, const LAS float* dec, const LAS float* inj) {
    f32x4 st = (f32x4){0.f, 0.f, 0.f, 0.f};
#pragma unroll 8
    for (int c = 0; c < NC; ++c) { const v2u x = *(const GAS v2u*)(delta + (size_t)c * cstride);
        v2u o; o.x = pk2(st[0], st[1]); o.y = pk2(st[2], st[3]); *(GAS v2u*)(prev + (size_t)c * cstride) = o;
        const float d = dec[c], j = inj[c];
        st[0] = d * st[0] + j * __uint_as_float(x.x << 16); st[1] = d * st[1] + j * __uint_as_float(x.x & 0xffff0000u);
        st[2] = d * st[2] + j * __uint_as_float(x.y << 16); st[3] = d * st[3] + j * __uint_as_float(x.y & 0xffff0000u); }
}

struct Args {
    const float* x; const float* norm_mix; const float* norm_ffn; const float* w_in; const float* att_q_norm; const float* att_k_norm; const float* mlstm_conv; const float* mlstm_gate_bias;
    const float* mlstm_out_norm; const float* ret_out_norm; const float* w_b_att; const float* w_b_mlstm; const float* w_b_ret; const float* w_out; const float* w_ffn_in; const float* w_ffn_out;
    float* out; unsigned char* ws; int layer_lo, layer_hi, ph_lo, ph_hi;
};
constexpr int PH_PER_LAYER = 16;
__device__ __forceinline__ float ret_lngamma(int hd) { return log1pf(-exp2f(-5.0f - (float)hd)); }
#define PHASE_FN static __device__ __forceinline__ void
#define OPAQUE_PTR(p) asm volatile("" : "+s"(p))
#define WS_PTRS(ws) OPAQUE_PTR(ws); \
    bf16* const H = (bf16*)((ws) + WS_H); bf16* const PROJ = (bf16*)((ws) + WS_PROJ); float* const SMALL = (float*)((ws) + WS_SMALL); bf16* const MQK = (bf16*)((ws) + WS_MQK); \
    bf16* const IKB = (bf16*)((ws) + WS_IKB); float* const IWF = (float*)((ws) + WS_IWF); float* const GIF = (float*)((ws) + WS_GIF); float* const SC = (float*)((ws) + WS_SC); \
    unsigned long long* const MB = (unsigned long long*)((ws) + WS_MB); bf16* const DCM = (bf16*)((ws) + WS_DCM); bf16* const CPM = (bf16*)((ws) + WS_CPM); \
    float* const DN = (float*)((ws) + WS_MISC + MISC_DN); float* const NPREV = (float*)((ws) + WS_MISC + MISC_NPREV); float* const AB = (float*)((ws) + WS_MISC + MISC_AB); float* const MPREV = (float*)((ws) + WS_MISC + MISC_MPREV); \
    bf16* const DRR = (bf16*)((ws) + WS_DRR); bf16* const RPR = (bf16*)((ws) + WS_RPR); bf16* const YA = (bf16*)((ws) + WS_YA); bf16* const YM = (bf16*)((ws) + WS_YM); bf16* const YR = (bf16*)((ws) + WS_YR); \
    float* const MERGEDF = (float*)((ws) + WS_MERGEDF); bf16* const MERGED = (bf16*)((ws) + WS_MERGED); bf16* const ACT = (bf16*)((ws) + WS_ACT); \
    float* const ROPE128 = (float*)((ws) + WS_ROPE128); float* const ROPE64 = (float*)((ws) + WS_ROPE64); \
    (void)H; (void)PROJ; (void)SMALL; (void)MQK; (void)IKB; (void)IWF; (void)GIF; (void)SC; (void)MB; (void)DCM; (void)CPM; (void)DN; (void)NPREV; (void)AB; (void)MPREV; (void)DRR; (void)RPR; (void)YA; (void)YM; (void)YR; \
    (void)MERGEDF; (void)MERGED; (void)ACT; (void)ROPE128; (void)ROPE64
#define TIDS() int tid_ = threadIdx.x; asm volatile("" : "+v"(tid_)); int bx_ = blockIdx.x; asm volatile("" : "+s"(bx_));   \
    const int tid = tid_, lane = tid & 63, wave = __builtin_amdgcn_readfirstlane(tid >> 6); const int G = gridDim.x, bx = bx_; const int gw = bx * NWAVES + wave, NGW = G * NWAVES; \
    (void)lane; (void)wave; (void)gw; (void)NGW; (void)G; (void)bx

PHASE_FN ph_prologue(LAS unsigned char* lds, unsigned char* ws, const float* w_in, const float* w_b_att, const float* w_b_mlstm, const float* w_b_ret, const float* w_out, const float* w_ffn_in, const float* w_ffn_out) {
    TIDS(); WS_PTRS(ws);
    LAS float* scr = (LAS float*)(lds + wave * 16640);
    for (int l = 0; l < DEPTH; ++l) { unsigned char* wl = ws + WS_W + (size_t)l * W_LAYER;
        transpose_matrix(w_in + (size_t)l * DM * LPROJ, DM, LPROJ, NPROJ_PAD, (bf16*)(wl + WO_IN), scr, gw, NGW, lane, MapWin());
        transpose_matrix(w_b_att + (size_t)l * 1024 * DM, 1024, DM, DM, (bf16*)(wl + WO_B), scr, gw, NGW, lane, MapIdent());
        transpose_matrix(w_b_mlstm + (size_t)l * 1024 * DM, 1024, DM, DM, (bf16*)(wl + WO_B + 4 * MiB), scr, gw, NGW, lane, MapIdent());
        transpose_matrix(w_b_ret + (size_t)l * 1024 * DM, 1024, DM, DM, (bf16*)(wl + WO_B + 8 * MiB), scr, gw, NGW, lane, MapIdent());
        transpose_matrix(w_out + (size_t)l * DM * DM, DM, DM, DM, (bf16*)(wl + WO_OUT), scr, gw, NGW, lane, MapIdent());
        transpose_matrix(w_ffn_in + (size_t)l * DM * 2 * FF, DM, 2 * FF, 2 * FF, (bf16*)(wl + WO_FIN), scr, gw, NGW, lane, MapFfn());
        transpose_matrix(w_ffn_out + (size_t)l * FF * DM, FF, DM, DM, (bf16*)(wl + WO_FOUT), scr, gw, NGW, lane, MapIdent()); }
    for (int i = gw * 64 + lane; i < S * 96; i += NGW * 64) {
        if (i < S * 64) { const int t = i >> 6, f = i & 63; const float inv = (float)pow(10000.0, -(double)f * 2.0 / 128.0); const float ang = (float)t * inv;
            ROPE128[2 * i] = (float)cos((double)ang); ROPE128[2 * i + 1] = (float)sin((double)ang); }
        else { const int k = i - S * 64, t = k >> 5, f = k & 31; const float inv = (float)pow(10000.0, -(double)f * 2.0 / 64.0); const float ang = (float)t * inv;
            ROPE64[2 * k] = (float)cos((double)ang); ROPE64[2 * k + 1] = (float)sin((double)ang); } }
}
PHASE_FN ph_rmsnorm(const float* xin, const float* gain, bf16* Hout) { TIDS(); for (int m = gw; m < S; m += NGW) rms_row_to_bf16(xin + (size_t)m * DM, gain, Hout + (size_t)m * DM, lane); }
PHASE_FN ph_gemm_proj(LAS unsigned char* lds, unsigned char* ws, const bf16* Wt) { TIDS(); WS_PTRS(ws);
    pg8::Gemm g{H, Wt, S, NPROJ_PAD, DM}; pg8::StaticOrder so; so.init(S, NPROJ_PAD, G, bx); pg8::EpiProj E{PROJ, NPROJ, SMALL, PC_G / 256, NPROJ / 256};
    pg8::gemm_phase<pg8::EpiProj, pg8::StaticOrder, true, true>(lds, g, so, E); }
PHASE_FN ph_pp(unsigned char* ws, const float* gq, const float* gk, const float* convw, const float* gbias) { TIDS(); WS_PTRS(ws);
    PPArgs a{PROJ, SMALL, MQK, IKB, IWF, GIF, ROPE128, ROPE64, gq, gk, convw, gbias};
    for (int m = gw; m < S; m += NGW) pp_row(a, m, lane); }
PHASE_FN ph_scores(unsigned char* ws) { TIDS(); WS_PTRS(ws);
    for (int u = gw; u < 8320; u += NGW) { int g = (int)((sqrtf(1.0f + 2.0f * (float)u) - 1.0f) * 0.5f); while (2 * (g + 1) * (g + 2) <= u) ++g; while (2 * g * (g + 1) > u) --g;
        const int r = u - 2 * g * (g + 1); score_wave_unit(PROJ, IKB, IWF, SC, 4 * g + r / (g + 1), r % (g + 1), lane); } }
PHASE_FN ph_deltas(LAS unsigned char* lds, unsigned char* ws) { TIDS(); WS_PTRS(ws); LAS float* const sf = (LAS float*)(lds + SCR_OFF);
    for (int u = bx; u < 1024; u += G) {
        if (u < 512) { const int hd = u >> 7, c = u & 127, t0 = c * 64;
            if (wave == 0) { const float iv = GIF[(size_t)(t0 + lane) * 8 + hd], fv = GIF[(size_t)(t0 + lane) * 8 + 4 + hd]; float b = log_sigmoid_f(fv);
#pragma unroll
                for (int o = 1; o < 64; o <<= 1) { const float y = __shfl_up(b, o); if (lane >= o) b += y; }
                const float bend = __shfl(b, 63), gl = bend - b + iv, A = wave_max(gl);
                sf[lane] = __expf(gl - A); if (lane == 0) { AB[(hd * 128 + c) * 2] = A; AB[(hd * 128 + c) * 2 + 1] = bend; } }
            __syncthreads();
            chunk_delta<64, 256>(lds, MQK + (size_t)t0 * 1024 + 512 + hd * 128, 1024, PROJ + (size_t)t0 * NPROJ + PC_MV + hd * 256, NPROJ, sf, DCM + (size_t)(hd * 128 + c) * 32768, DN + (hd * 128 + c) * 128, tid);
        } else { const int v = u - 512, hd = v >> 6, c = v & 63, t0 = c * 128; const float lg = ret_lngamma(hd);
            if (tid < 128) sf[tid] = __expf(lg * (float)(127 - tid));
            __syncthreads();
            chunk_delta<128, 128>(lds, PROJ + (size_t)t0 * NPROJ + PC_RK + hd * 128, NPROJ, PROJ + (size_t)t0 * NPROJ + PC_RV + hd * 128, NPROJ, sf, DRR + (size_t)(hd * 64 + c) * 16384, nullptr, tid); }
    } }
PHASE_FN ph_select(LAS unsigned char* lds, unsigned char* ws) { TIDS(); WS_PTRS(ws); select_rows_wg(lds, SC, MB, bx, G, tid); }
PHASE_FN ph_scans(LAS unsigned char* lds, unsigned char* ws) { TIDS(); WS_PTRS(ws); LAS float* const sf = (LAS float*)(lds + SCR_OFF);
    for (int u = bx; u < 128; u += G) {
        LAS float* dec = sf; LAS float* inj = sf + 128; LAS float* av = sf + 256; LAS float* bv = sf + 384;
        if (u < 64) { const int hd = u >> 4, p = u & 15;
            if (tid < 128) { av[tid] = AB[(hd * 128 + tid) * 2]; bv[tid] = AB[(hd * 128 + tid) * 2 + 1]; }
            __syncthreads();
            if (tid == 0) { float m = 0.f; for (int c = 0; c < 128; ++c) { const float mn = fmaxf(bv[c] + m, av[c]); dec[c] = __expf(bv[c] + m - mn); inj[c] = __expf(av[c] - mn); if (p == 0) MPREV[hd * 128 + c] = m; m = mn; } }
            __syncthreads();
            const size_t e4 = (size_t)hd * 128 * 32768 + p * 2048 + tid * 4;
            scan_elems<128>(DCM + e4, CPM + e4, 32768, dec, inj);
            if (p == 0 && tid < 128) { float st = 0.f; for (int c = 0; c < 128; ++c) { NPREV[(hd * 128 + c) * 128 + tid] = st; st = dec[c] * st + inj[c] * DN[(hd * 128 + c) * 128 + tid]; } }
        } else { const int v = u - 64, hd = v >> 3, p = v & 7; const float dg = __expf(128.0f * ret_lngamma(hd));
            if (tid < 64) { dec[tid] = dg; inj[tid] = 1.0f; }
            __syncthreads();
            const size_t e4 = (size_t)hd * 64 * 16384 + p * 2048 + tid * 4;
            scan_elems<64>(DRR + e4, RPR + e4, 16384, dec, inj); }
        __syncthreads(); } }
PHASE_FN ph_attention(char* alds, unsigned char* ws) { TIDS(); WS_PTRS(ws);
    typedef att::BlockRef<bf16, bf16> BR; att::Seam<bf16> seam;
#define ATT_REF(r, item_, pass_) do { const int hd_ = (item_) >> 4, y_ = (item_) & 15, qb_ = (pass_) ? 31 - y_ : y_; \
        (r).Q = PROJ + (size_t)qb_ * 256 * NPROJ + PC_AQ + hd_ * 128; (r).K = PROJ + PC_AK + hd_ * 128; (r).V = PROJ + PC_AV + hd_ * 128; (r).O = YA + (size_t)qb_ * 256 * 1024 + hd_ * 128; \
        (r).M = MB + (size_t)qb_ * 256 * 128; (r).P0 = qb_ * 256; } while (0)
    if (bx < 128) { int item = bx, pass = 0; BR cur; ATT_REF(cur, item, 0); att::causal_swa_prime<bf16, bf16>(cur, 1 << 30, alds, seam);
        for (;;) { const bool more_pass = pass == 0, more_item = item + G < 128, last = !more_pass && !more_item;
            int itn = item, pn = pass + 1; if (!more_pass) { pn = 0; itn = more_item ? item + G : item; }
            BR nxt = cur; if (!last) ATT_REF(nxt, itn, pn);
            att::causal_swa_block<bf16, bf16>(cur, nxt, S, 1 << 30, alds, seam);
            if (last) break; cur = nxt; item = itn; pass = pn; } }
    __syncthreads(); }
PHASE_FN ph_outs(LAS unsigned char* lds, unsigned char* ws, const float* gain_m, const float* gain_r, int u0, int ustep) { TIDS(); WS_PTRS(ws); LAS float* const sf = (LAS float*)(lds + SCR_OFF);
    for (int u = u0; u < 1024; u += ustep) {
        if (u < 512) { const int hd = u >> 7, c = u & 127, t0 = c * 64;
            if (wave == 0) { const float iv = GIF[(size_t)(t0 + lane) * 8 + hd], fv = GIF[(size_t)(t0 + lane) * 8 + 4 + hd]; float b = log_sigmoid_f(fv);
#pragma unroll
                for (int o = 1; o < 64; o <<= 1) { const float y = __shfl_up(b, o); if (lane >= o) b += y; }
                const float mp = MPREV[hd * 128 + c]; float pm = iv - b;
#pragma unroll
                for (int o = 1; o < 64; o <<= 1) { const float y = __shfl_up(pm, o); if (lane >= o) pm = fmaxf(pm, y); }
                const float mt = fmaxf(b + mp, b + pm);
                sf[lane] = b - mt; sf[128 + lane] = iv - b; sf[256 + lane] = __expf(b + mp - mt); sf[384 + lane] = __expf(-mt); sf[512 + lane] = 0.f; }
            if (wave == 1) { sf[640 + lane] = NPREV[(hd * 128 + c) * 128 + lane]; sf[640 + 64 + lane] = NPREV[(hd * 128 + c) * 128 + 64 + lane]; }
            __syncthreads();
            chunk_out<64, 256, 0>(lds, sf, MQK + (size_t)t0 * 1024 + hd * 128, 1024, MQK + (size_t)t0 * 1024 + 512 + hd * 128, 1024, PROJ + (size_t)t0 * NPROJ + PC_MV + hd * 256, NPROJ,
                                  CPM + (size_t)(hd * 128 + c) * 32768, gain_m + hd * 256, PROJ + (size_t)t0 * NPROJ + PC_MO + hd * 256, NPROJ, YM + (size_t)t0 * 1024 + hd * 256, 1024, tid);
        } else { const int v = u - 512, hd = v >> 6, c = v & 63, t0 = c * 128; const float lg = ret_lngamma(hd);
            if (tid < 128) { sf[tid] = lg * (float)tid; sf[128 + tid] = -lg * (float)tid; sf[256 + tid] = __expf(lg * (float)(tid + 1)); }
            __syncthreads();
            chunk_out<128, 128, 1>(lds, sf, PROJ + (size_t)t0 * NPROJ + PC_RQ + hd * 128, NPROJ, PROJ + (size_t)t0 * NPROJ + PC_RK + hd * 128, NPROJ, PROJ + (size_t)t0 * NPROJ + PC_RV + hd * 128, NPROJ,
                                   RPR + (size_t)(hd * 64 + c) * 16384, gain_r + hd * 128, PROJ + (size_t)t0 * NPROJ + PC_RG + hd * 128, NPROJ, YR + (size_t)t0 * 1024 + hd * 128, 1024, tid); }
    } }
template <int MODE> PHASE_FN ph_gemm_branch(LAS unsigned char* lds, unsigned char* ws, const bf16* A, const bf16* Wt, int gcol) { TIDS(); WS_PTRS(ws);
    pg8::Gemm g{A, Wt, S, DM, 1024}; pg8::StaticOrder so; so.init(S, DM, G, bx); pg8::EpiBranch<MODE> E{PROJ + PC_G + gcol, NPROJ, MERGEDF, MERGED, DM};
    pg8::gemm_phase<pg8::EpiBranch<MODE>, pg8::StaticOrder, true, true>(lds, g, so, E); }
PHASE_FN ph_gemm_resid(LAS unsigned char* lds, const bf16* A, const bf16* Wt, int K, const float* base, float* out) { TIDS();
    pg8::Gemm g{A, Wt, S, DM, K}; pg8::StaticOrder so; so.init(S, DM, G, bx); pg8::EpiResid E{base, out, DM};
    pg8::gemm_phase<pg8::EpiResid, pg8::StaticOrder, true, true>(lds, g, so, E); }
PHASE_FN ph_gemm_ffn_in(LAS unsigned char* lds, unsigned char* ws, const bf16* Wt) { TIDS(); WS_PTRS(ws);
    pg8::Gemm g{H, Wt, S, 2 * FF, DM}; pg8::StaticOrder so; so.init(S, 2 * FF, G, bx); pg8::EpiSwiGLU E{ACT, FF};
    pg8::gemm_phase<pg8::EpiSwiGLU, pg8::StaticOrder, true, true>(lds, g, so, E); }


#ifndef SYN_PROBE
#define SYN_PROBE 0
#endif
PHASE_FN ph_probe(LAS unsigned char* lds) { TIDS();
    LAS unsigned* hist = (LAS unsigned*)lds;
    if (SYN_PROBE == 1) {
        unsigned x = (unsigned)tid * 2654435761u + 12345u;
        for (int r = 0; r < 32; ++r) {
#pragma unroll
            for (int i = 0; i < 16; ++i) { x = x * 1664525u + 1013904223u; (void)__hip_atomic_fetch_add(hist + ((x >> 10) & 2047u), 1u, __ATOMIC_RELAXED, __HIP_MEMORY_SCOPE_WORKGROUP); }
            SEL_BAR(); } }
    if (SYN_PROBE == 2) {
        float acc = 0.f; float v[16];
#pragma unroll
        for (int i = 0; i < 16; ++i) v[i] = (float)((tid * 16 + i) % 977);
        for (int r = 0; r < 32 * 8; ++r) { const float c1 = 100.f + (float)(r & 7) + acc * 1e-30f, c2 = c1 * 2.f, c3 = c1 * 3.f; unsigned n1 = 0, n2 = 0, n3 = 0;
#pragma unroll
            for (int i = 0; i < 16; ++i) { n1 += (unsigned)__builtin_popcountll(__builtin_amdgcn_ballot_w64(v[i] >= c1)); n2 += (unsigned)__builtin_popcountll(__builtin_amdgcn_ballot_w64(v[i] >= c2)); n3 += (unsigned)__builtin_popcountll(__builtin_amdgcn_ballot_w64(v[i] >= c3)); }
            if (lane == 0) { hist[(r & 1) * 24 + wave] = n1; hist[(r & 1) * 24 + 8 + wave] = n2; hist[(r & 1) * 24 + 16 + wave] = n3; }
            SEL_BAR();
            unsigned t1 = 0;
#pragma unroll
            for (int j = 0; j < 24; ++j) t1 += hist[(r & 1) * 24 + j];
            acc += (float)t1; }
        if (acc == 12345.f) hist[100] = 1u; }
    if (SYN_PROBE == 3) {
        float a = (float)tid;
        for (int r = 0; r < 32; ++r) {
#pragma unroll
            for (int k = 0; k < 4; ++k)
#pragma unroll
                for (int o = 1; o < 64; o <<= 1) a = fmaxf(a, __shfl_xor(a, o) * 0.999f);
        }
        if (a == 12345.f) hist[100] = 1u; }
    __syncthreads(); }
typedef const __attribute__((address_space(4))) Args* ArgsP;
__device__ __forceinline__ ArgsP fresh_args() { ArgsP ap = (ArgsP)__builtin_amdgcn_kernarg_segment_ptr(); asm volatile("" : "+s"(ap)); return ap; }
#ifndef DUP_PHASE
#define DUP_PHASE -1
#endif
#define SEAM() do { if constexpr (one_launch) { ArgsP ap_ = fresh_args(); XcdBarrier b_; b_.bar = (unsigned*)(ap_->ws + WS_CTL) + CW_BAR; b_.x = xb_xcc_id(); b_.st = (volatile LAS unsigned*)(lds + MISC_OFF); xcd_barrier(b_); } } while (0)
#define IN(k) (PLO <= (k) && (k) < PHI)
#define WL(ap, layer) ((ap)->ws + WS_W + (size_t)(layer) * W_LAYER)
template <int PLO, int PHI, bool LAST> __device__ __forceinline__ void layer_phases(const int layer, LAS unsigned char* lds, unsigned char* lds_raw) {
    constexpr bool one_launch = (PHI - PLO > 1);
    if constexpr (IN(1)) { ArgsP ap = fresh_args(); ph_rmsnorm(layer == 0 ? ap->x : ap->out, ap->norm_mix + layer * DM, (bf16*)(ap->ws + WS_H)); if constexpr (DUP_PHASE == 1) { SEAM(); ph_rmsnorm(layer == 0 ? ap->x : ap->out, ap->norm_mix + layer * DM, (bf16*)(ap->ws + WS_H)); } SEAM(); }
    if constexpr (IN(2)) { ArgsP ap = fresh_args(); ph_gemm_proj(lds, ap->ws, (const bf16*)(WL(ap, layer) + WO_IN)); if constexpr (DUP_PHASE == 2) { SEAM(); ph_gemm_proj(lds, ap->ws, (const bf16*)(WL(ap, layer) + WO_IN)); } SEAM(); }
    if constexpr (IN(3)) { ArgsP ap = fresh_args(); ph_pp(ap->ws, ap->att_q_norm + layer * 128, ap->att_k_norm + layer * 128, ap->mlstm_conv + layer * 4096, ap->mlstm_gate_bias + layer * 8); if constexpr (DUP_PHASE == 3) { SEAM(); ph_pp(ap->ws, ap->att_q_norm + layer * 128, ap->att_k_norm + layer * 128, ap->mlstm_conv + layer * 4096, ap->mlstm_gate_bias + layer * 8); } SEAM(); }
    if constexpr (IN(4)) { ArgsP ap = fresh_args(); ph_scores(ap->ws); if constexpr (DUP_PHASE == 4) { SEAM(); ph_scores(ap->ws); } }
    if constexpr (IN(5)) { ArgsP ap = fresh_args(); ph_deltas(lds, ap->ws); if constexpr (DUP_PHASE == 5) { SEAM(); ph_deltas(lds, ap->ws); } SEAM(); }
    if constexpr (IN(6) && SYN_PROBE != 0) { ph_probe(lds); }
    if constexpr (IN(6)) { ArgsP ap = fresh_args(); ph_select(lds, ap->ws); if constexpr (DUP_PHASE == 6) { SEAM(); ph_select(lds, ap->ws); } }
    if constexpr (IN(7)) { ArgsP ap = fresh_args(); ph_scans(lds, ap->ws); if constexpr (DUP_PHASE == 7) { SEAM(); ph_scans(lds, ap->ws); } SEAM(); }
    if constexpr (IN(8) && IN(9)) {
        ArgsP ap = fresh_args(); const bool split = gridDim.x == 256;
        if (!split || blockIdx.x < 128) ph_attention((char*)lds_raw, ap->ws);
        if (!split || blockIdx.x >= 128) ph_outs(lds, ap->ws, ap->mlstm_out_norm + layer * 1024, ap->ret_out_norm + layer * 1024, split ? (int)blockIdx.x - 128 : (int)blockIdx.x, split ? 128 : (int)gridDim.x);
        SEAM(); }
    else {
    if constexpr (IN(8)) { ArgsP ap = fresh_args(); ph_attention((char*)lds_raw, ap->ws); }
    if constexpr (IN(9)) { ArgsP ap = fresh_args(); ph_outs(lds, ap->ws, ap->mlstm_out_norm + layer * 1024, ap->ret_out_norm + layer * 1024, (int)blockIdx.x, (int)gridDim.x); SEAM(); }
    }
    if constexpr (IN(10)) { ArgsP ap = fresh_args(); ph_gemm_branch<0>(lds, ap->ws, (const bf16*)(ap->ws + WS_YA), (const bf16*)(WL(ap, layer) + WO_B), 0); if constexpr (DUP_PHASE == 10) { SEAM(); ph_gemm_branch<0>(lds, ap->ws, (const bf16*)(ap->ws + WS_YA), (const bf16*)(WL(ap, layer) + WO_B), 0); } }
    if constexpr (IN(11)) { ArgsP ap = fresh_args(); ph_gemm_branch<1>(lds, ap->ws, (const bf16*)(ap->ws + WS_YM), (const bf16*)(WL(ap, layer) + WO_B + 4 * MiB), DM); if constexpr (DUP_PHASE == 11) { SEAM(); ph_gemm_branch<1>(lds, ap->ws, (const bf16*)(ap->ws + WS_YM), (const bf16*)(WL(ap, layer) + WO_B + 4 * MiB), DM); } }
    if constexpr (IN(12)) { ArgsP ap = fresh_args(); ph_gemm_branch<2>(lds, ap->ws, (const bf16*)(ap->ws + WS_YR), (const bf16*)(WL(ap, layer) + WO_B + 8 * MiB), 2 * DM); if constexpr (DUP_PHASE == 12) { SEAM(); ph_gemm_branch<2>(lds, ap->ws, (const bf16*)(ap->ws + WS_YR), (const bf16*)(WL(ap, layer) + WO_B + 8 * MiB), 2 * DM); } SEAM(); }
    if constexpr (IN(13)) { ArgsP ap = fresh_args(); ph_gemm_resid(lds, (const bf16*)(ap->ws + WS_MERGED), (const bf16*)(WL(ap, layer) + WO_OUT), DM, layer == 0 ? ap->x : ap->out, ap->out); SEAM(); }
    if constexpr (IN(14)) { ArgsP ap = fresh_args(); ph_rmsnorm(ap->out, ap->norm_ffn + layer * DM, (bf16*)(ap->ws + WS_H)); if constexpr (DUP_PHASE == 14) { SEAM(); ph_rmsnorm(ap->out, ap->norm_ffn + layer * DM, (bf16*)(ap->ws + WS_H)); } SEAM(); }
    if constexpr (IN(15)) { ArgsP ap = fresh_args(); ph_gemm_ffn_in(lds, ap->ws, (const bf16*)(WL(ap, layer) + WO_FIN)); if constexpr (DUP_PHASE == 15) { SEAM(); ph_gemm_ffn_in(lds, ap->ws, (const bf16*)(WL(ap, layer) + WO_FIN)); } SEAM(); }
    if constexpr (IN(16)) { ArgsP ap = fresh_args(); ph_gemm_resid(lds, (const bf16*)(ap->ws + WS_ACT), (const bf16*)(WL(ap, layer) + WO_FOUT), FF, ap->out, ap->out); if constexpr (!LAST) SEAM(); }
}
template <int PLO, int PHI> __global__ void __launch_bounds__(NTHR, 2) fwd(Args args_unused) {
    (void)args_unused;
    extern __shared__ __attribute__((aligned(16))) unsigned char lds_raw[];
    LAS unsigned char* lds = (LAS unsigned char*)lds_raw;
    if (threadIdx.x < 64) ((volatile LAS unsigned*)(lds + MISC_OFF))[threadIdx.x] = 0u;
    __syncthreads();
    constexpr bool one_launch = (PHI - PLO > 1);
    if constexpr (one_launch) { ArgsP ap = fresh_args(); (void)xcd_barrier_post((unsigned*)(ap->ws + WS_CTL) + CW_BAR, (volatile LAS unsigned*)(lds + MISC_OFF)); }
    if constexpr (PLO == 0) { ArgsP ap = fresh_args(); ph_prologue(lds, ap->ws, ap->w_in, ap->w_b_att, ap->w_b_mlstm, ap->w_b_ret, ap->w_out, ap->w_ffn_in, ap->w_ffn_out);
        if constexpr (DUP_PHASE == 0) { SEAM(); ph_prologue(lds, ap->ws, ap->w_in, ap->w_b_att, ap->w_b_mlstm, ap->w_b_ret, ap->w_out, ap->w_ffn_in, ap->w_ffn_out); }
        if (PHI > 1) SEAM(); }
    if constexpr (one_launch) { static_assert(DEPTH == 4, "four inlined layer sites");
        layer_phases<PLO, PHI, false>(0, lds, lds_raw); layer_phases<PLO, PHI, false>(1, lds, lds_raw); layer_phases<PLO, PHI, false>(2, lds, lds_raw); layer_phases<PLO, PHI, true>(3, lds, lds_raw); }
    else if constexpr (PLO > 0) { ArgsP ap = fresh_args(); layer_phases<PLO, PHI, true>(ap->layer_lo, lds, lds_raw); }
}
#undef IN
#undef SEAM
#undef WL

#ifndef ONE_LAUNCH
#define ONE_LAUNCH 1
#endif
typedef void (*kern_t)(Args);
template <int P> static kern_t phase_kernel(int p) { if (p == P) return fwd<P, P + 1>; if constexpr (P < PH_PER_LAYER) return phase_kernel<P + 1>(p); else return nullptr; }
extern "C" void kernel_launch(void* const* d_in, const int* in_sizes, int n_in, void* d_out, int out_size, void* d_ws, size_t ws_size, hipStream_t stream) {
    static int grid = 0;
    if (grid == 0) {
        if (n_in != 16 || in_sizes[0] != S * DM || out_size != S * DM || ws_size < WS_END) { fprintf(stderr, "kernel_launch: unexpected shapes (n_in %d, in0 %d, out %d, ws %zu < %zu); nothing launched\n", n_in, n_in > 0 ? in_sizes[0] : -1, out_size, ws_size, (size_t)WS_END); grid = -1; return; }
        int dev = 0, cus = 0;
        if (hipGetDevice(&dev) != hipSuccess || hipDeviceGetAttribute(&cus, hipDeviceAttributeMultiprocessorCount, dev) != hipSuccess) { grid = -1; return; }
#if ONE_LAUNCH
        if (hipFuncSetAttribute((const void*)fwd<0, PH_PER_LAYER + 1>, hipFuncAttributeMaxDynamicSharedMemorySize, LDS_BYTES) != hipSuccess) { grid = -1; return; }
#else
        for (int p = 0; p <= PH_PER_LAYER; ++p) if (hipFuncSetAttribute((const void*)phase_kernel<0>(p), hipFuncAttributeMaxDynamicSharedMemorySize, LDS_BYTES) != hipSuccess) { fprintf(stderr, "kernel_launch: hipFuncSetAttribute failed\n"); grid = -1; return; }
#endif
        (void)hipGetLastError();
        grid = cus;
    }
    if (grid < 0) return;
    (void)hipMemsetAsync((char*)d_ws + WS_CTL, 0, CTL_ZERO_BYTES, stream);
    Args a{};
    a.x = (const float*)d_in[0]; a.norm_mix = (const float*)d_in[1]; a.norm_ffn = (const float*)d_in[2]; a.w_in = (const float*)d_in[3]; a.att_q_norm = (const float*)d_in[4]; a.att_k_norm = (const float*)d_in[5];
    a.mlstm_conv = (const float*)d_in[6]; a.mlstm_gate_bias = (const float*)d_in[7]; a.mlstm_out_norm = (const float*)d_in[8]; a.ret_out_norm = (const float*)d_in[9];
    a.w_b_att = (const float*)d_in[10]; a.w_b_mlstm = (const float*)d_in[11]; a.w_b_ret = (const float*)d_in[12]; a.w_out = (const float*)d_in[13]; a.w_ffn_in = (const float*)d_in[14]; a.w_ffn_out = (const float*)d_in[15];
    a.out = (float*)d_out; a.ws = (unsigned char*)d_ws;
#if ONE_LAUNCH
    a.layer_lo = 0; a.layer_hi = DEPTH; a.ph_lo = 0; a.ph_hi = PH_PER_LAYER + 1; hipLaunchKernelGGL((fwd<0, PH_PER_LAYER + 1>), dim3(grid), dim3(NTHR), LDS_BYTES, stream, a);
#else
    a.layer_lo = 0; a.layer_hi = 0; a.ph_lo = 0; a.ph_hi = 1; hipLaunchKernelGGL((fwd<0, 1>), dim3(grid), dim3(NTHR), LDS_BYTES, stream, a);
    for (int l = 0; l < DEPTH; ++l) for (int p = 1; p <= PH_PER_LAYER; ++p) { a.layer_lo = l; a.layer_hi = l + 1; a.ph_lo = p; a.ph_hi = p + 1; hipLaunchKernelGGL(phase_kernel<0>(p), dim3(grid), dim3(NTHR), LDS_BYTES, stream, a); }
#endif
}
```

```cpp
#include <hip/hip_runtime.h>
#include <cstdio>
#include <cstdint>
__device__ __forceinline__ int my_tid();
namespace pg8 {
#define PG8_LAS __attribute__((address_space(3)))
typedef unsigned short bf16_t;
typedef short bf16x8 __attribute__((ext_vector_type(8)));
typedef float f32x4 __attribute__((ext_vector_type(4)));
typedef unsigned u32x4 __attribute__((ext_vector_type(4)));
constexpr int BM = 256, BK = 64, HALF = 128, HTB = HALF * BK * 2  , STAGE_BYTES = 8 * HTB, NXCD = 8, WGM = 8;

__host__ __device__ __forceinline__ int lds_byte(int r, int c) { const int st = (r >> 4) * 2 + (c >> 5), rr = r & 15, cc = c & 31, ob = rr * 64 + cc * 2; return st * 1024 + (ob ^ (((ob >> 9) & 1) << 5)); }
__host__ __device__ __forceinline__ void stage_rc(int b, int& R, int& C) { const int st = b / 1024, sb = b % 1024, swz = sb ^ (((sb >> 9) & 1) << 5); R = (st >> 1) * 16 + swz / 64; C = (st & 1) * 32 + (swz % 64) / 2; }
__host__ __device__ __forceinline__ int perm32(int rho) { const int n = rho >> 4, i = rho & 15; return 8 * (i >> 2) + 4 * n + (i & 3); }

struct Unit { int pm, pn; };
struct Gemm { const bf16_t* A; const bf16_t* Bt; int M, N, K; };

struct StaticOrder {
    int nM, nN, nwg, G, c;
    __host__ __device__ void init(int M, int N, int G_, int c_) { nM = M / BM; nN = N / BM; nwg = nM * nN; G = G_; c = c_; }
    __host__ __device__ bool next(int i, Unit& u) const {
        const long L = (long)i * G + c; if (L >= nwg) return false;
        int wgid = (int)L; { const int q = nwg / NXCD, r = nwg % NXCD, xcd = wgid % NXCD, off = wgid / NXCD; wgid = (xcd < r ? xcd * (q + 1) : r * (q + 1) + (xcd - r) * q) + off; }
        const int nig = WGM * nN, gid = wgid / nig, fm = gid * WGM, gsz = (nM - fm) < WGM ? (nM - fm) : WGM;
        u.pm = fm + ((wgid % nig) % gsz); u.pn = (wgid % nig) / gsz; return true;
    }
    __device__ __forceinline__ void a_ready(const Unit&) const {}
    __device__ __forceinline__ void done(const Unit&) const {}
};

__device__ __forceinline__ unsigned cvt_pk_bf16(float lo, float hi) { unsigned r; asm volatile("v_cvt_pk_bf16_f32 %0, %1, %2" : "=v"(r) : "v"(lo), "v"(hi)); return r; }
typedef float f32x2 __attribute__((ext_vector_type(2)));
__device__ __forceinline__ float sigmoid_f(float x) { return __builtin_amdgcn_rcpf(1.0f + __builtin_amdgcn_exp2f(-1.4426950408889634f * x)); }
struct EpiProj {
    static constexpr bool PERM = true, AFTER_DRAIN = false;
    bf16_t* P; int ldp; float* Sm; int ngate0, nbf;
    __device__ __forceinline__ void operator()(const f32x4 (&acc)[2][2][4][2], const Unit& u, int wr, int wc, int fr, int fq) const {
        const int row0 = u.pm * BM + wr * 64 + fr, col0 = u.pn * BM + wc * 32 + 8 * fq;
        if (u.pn >= nbf) {
            const int c0 = wc * 32 + 8 * fq;
#pragma unroll
            for (int ai = 0; ai < 2; ++ai)
#pragma unroll
                for (int m = 0; m < 4; ++m) { float* rowp = Sm + (size_t)(row0 + ai * HALF + m * 16) * 256 + c0;
#pragma unroll
                    for (int bj = 0; bj < 2; ++bj) { *(f32x4*)(rowp + bj * HALF) = acc[ai][bj][m][0]; *(f32x4*)(rowp + bj * HALF + 4) = acc[ai][bj][m][1]; } }
            return;
        }
        const bool sg = u.pn >= ngate0;
#pragma unroll
        for (int ai = 0; ai < 2; ++ai)
#pragma unroll
            for (int m = 0; m < 4; ++m) { bf16_t* rowp = P + (size_t)(row0 + ai * HALF + m * 16) * ldp + col0;
#pragma unroll
                for (int bj = 0; bj < 2; ++bj) { f32x4 v0 = acc[ai][bj][m][0], v1 = acc[ai][bj][m][1];
                    if (sg) {
#pragma unroll
                        for (int j = 0; j < 4; ++j) { v0[j] = sigmoid_f(v0[j]); v1[j] = sigmoid_f(v1[j]); } }
                    u32x4 w; w.x = cvt_pk_bf16(v0[0], v0[1]); w.y = cvt_pk_bf16(v0[2], v0[3]); w.z = cvt_pk_bf16(v1[0], v1[1]); w.w = cvt_pk_bf16(v1[2], v1[3]);
                    *(u32x4*)(rowp + bj * HALF) = w; } }
    }
};
__device__ __forceinline__ f32x4 bf4_lo(u32x4 w) { return (f32x4){__uint_as_float(w.x << 16), __uint_as_float(w.x & 0xffff0000u), __uint_as_float(w.y << 16), __uint_as_float(w.y & 0xffff0000u)}; }
__device__ __forceinline__ f32x4 bf4_hi(u32x4 w) { return (f32x4){__uint_as_float(w.z << 16), __uint_as_float(w.z & 0xffff0000u), __uint_as_float(w.w << 16), __uint_as_float(w.w & 0xffff0000u)}; }
template <int MODE> struct EpiBranch {
    static constexpr bool PERM = true, AFTER_DRAIN = false;
    const bf16_t* G; int ldg; float* T; bf16_t* O; int ldt;
    __device__ __forceinline__ void operator()(const f32x4 (&acc)[2][2][4][2], const Unit& u, int wr, int wc, int fr, int fq) const {
        const int row0 = u.pm * BM + wr * 64 + fr, col0 = u.pn * BM + wc * 32 + 8 * fq;
#pragma unroll
        for (int ai = 0; ai < 2; ++ai)
#pragma unroll
            for (int m = 0; m < 4; ++m) { const size_t r = (size_t)(row0 + ai * HALF + m * 16);
#pragma unroll
                for (int bj = 0; bj < 2; ++bj) { const u32x4 g = *(const u32x4*)(G + r * ldg + col0 + bj * HALF);
                    f32x4 v0 = acc[ai][bj][m][0] * bf4_lo(g), v1 = acc[ai][bj][m][1] * bf4_hi(g);
                    float* tp = T + r * ldt + col0 + bj * HALF;
                    if (MODE >= 1) { v0 = v0 + *(const f32x4*)tp; v1 = v1 + *(const f32x4*)(tp + 4); }
                    if (MODE <= 1) { *(f32x4*)tp = v0; *(f32x4*)(tp + 4) = v1; }
                    else { u32x4 w; w.x = cvt_pk_bf16(v0[0], v0[1]); w.y = cvt_pk_bf16(v0[2], v0[3]); w.z = cvt_pk_bf16(v1[0], v1[1]); w.w = cvt_pk_bf16(v1[2], v1[3]);
                        *(u32x4*)(O + r * ldt + col0 + bj * HALF) = w; } } }
    }
};
struct EpiResid {
    static constexpr bool PERM = false, AFTER_DRAIN = false;
    const float* base; float* out; int ldc;
    __device__ __forceinline__ void operator()(const f32x4 (&acc)[2][2][4][2], const Unit& u, int wr, int wc, int fr, int fq) const {
        const int row0 = u.pm * BM + wr * 64 + fr, col0 = u.pn * BM + wc * 32 + 4 * fq;
#pragma unroll
        for (int ai = 0; ai < 2; ++ai)
#pragma unroll
            for (int m = 0; m < 4; ++m) { const size_t off = (size_t)(row0 + ai * HALF + m * 16) * ldc + col0;
#pragma unroll
                for (int bj = 0; bj < 2; ++bj)
#pragma unroll
                    for (int n = 0; n < 2; ++n) *(f32x4*)(out + off + bj * HALF + n * 16) = *(const f32x4*)(base + off + bj * HALF + n * 16) + acc[ai][bj][m][n]; }
    }
};
struct EpiSwiGLU {
    static constexpr bool PERM = true, AFTER_DRAIN = false;
    bf16_t* O; int ldc;
    __device__ __forceinline__ void operator()(const f32x4 (&acc)[2][2][4][2], const Unit& u, int wr, int wc, int fr, int fq) const {
        const int row0 = u.pm * BM + wr * 64 + fr, col0 = u.pn * HALF + wc * 32 + 8 * fq;
#pragma unroll
        for (int ai = 0; ai < 2; ++ai)
#pragma unroll
            for (int m = 0; m < 4; ++m) { f32x4 v0, v1;
#pragma unroll
                for (int j = 0; j < 4; ++j) { const float g0 = acc[ai][0][m][0][j], g1 = acc[ai][0][m][1][j];
                    v0[j] = g0 * sigmoid_f(g0) * acc[ai][1][m][0][j]; v1[j] = g1 * sigmoid_f(g1) * acc[ai][1][m][1][j]; }
                u32x4 w; w.x = cvt_pk_bf16(v0[0], v0[1]); w.y = cvt_pk_bf16(v0[2], v0[3]); w.z = cvt_pk_bf16(v1[0], v1[1]); w.w = cvt_pk_bf16(v1[2], v1[3]);
                *(u32x4*)(O + (size_t)(row0 + ai * HALF + m * 16) * ldc + col0) = w; }
    }
};
template <class Epi, class Sched, bool ALIGN_EPI = false, bool SP2 = false>
__device__ __forceinline__ void gemm_phase(PG8_LAS unsigned char* lds, const Gemm g, const Sched& S, const Epi& E) {
    int tid_o = my_tid(); asm volatile("" : "+v"(tid_o));
    const int tid = tid_o, wid = __builtin_amdgcn_readfirstlane(tid >> 6), lane = tid & 63, wr = wid >> 2, wc = wid & 3, fr = lane & 15, fq = lane >> 4;
    const int K = g.K, nt = K / BK;
    unsigned voffA[2], voffB[2];
#pragma unroll
    for (int i = 0; i < 2; ++i) { int R, C; stage_rc(tid * 16 + i * 8192, R, C); const int Rb = Epi::PERM ? ((R & ~31) + perm32(R & 31)) : R;
        voffA[i] = (unsigned)(R * K + C) * 2u; voffB[i] = (unsigned)(Rb * K + C) * 2u; }
    const size_t kstep = (size_t)(BK * 2);
    const size_t hstep = (size_t)HALF * K * 2;
    const size_t tstep = 2 * hstep;
    const unsigned ldsw = (unsigned)wid * 1024u;
    const int aoff = lds_byte(wr * 64 + fr, fq * 8), boff = lds_byte(wc * 32 + fr, fq * 8);
#define PG8_SA(b, h) (((b) * 2 + (h)) * HTB)
#define PG8_SB(b, h) ((4 + (b) * 2 + (h)) * HTB)
#define PG8_STAGE(bufoff, gbase, voff) do { _Pragma("unroll") for (int _i = 0; _i < 2; ++_i) \
        __builtin_amdgcn_global_load_lds((const unsigned*)((const char*)(gbase) + (voff)[_i]), (PG8_LAS unsigned*)(lds + (bufoff) + ldsw + _i * 8192), 16, 0, 0); } while (0)
#define PG8_LDA(dst, b, h) do { _Pragma("unroll") for (int m = 0; m < 4; ++m) _Pragma("unroll") for (int k = 0; k < 2; ++k) dst[m][k] = *(const PG8_LAS bf16x8*)(lds + PG8_SA(b, h) + aoff + m * 2048 + k * 1024); } while (0)
#define PG8_LDB(dst, b, h) do { _Pragma("unroll") for (int n = 0; n < 2; ++n) _Pragma("unroll") for (int k = 0; k < 2; ++k) dst[n][k] = *(const PG8_LAS bf16x8*)(lds + PG8_SB(b, h) + boff + n * 2048 + k * 1024); } while (0)
#define PG8_MMA(ai, bj, At, Bt) do { __builtin_amdgcn_s_setprio(1); _Pragma("unroll") for (int m = 0; m < 4; ++m) _Pragma("unroll") for (int n = 0; n < 2; ++n) _Pragma("unroll") for (int k = 0; k < 2; ++k) \
        acc[ai][bj][m][n] = __builtin_amdgcn_mfma_f32_16x16x32_bf16(Bt[n][k], At[m][k], acc[ai][bj][m][n], 0, 0, 0); __builtin_amdgcn_s_setprio(0); } while (0)
#define PG8_WAIT_V(n) asm volatile("s_waitcnt vmcnt(" #n ")" ::: "memory")
#define PG8_WAIT_L(n) asm volatile("s_waitcnt lgkmcnt(" #n ")" ::: "memory")
#define PG8_BAR __builtin_amdgcn_s_barrier()
#define PG8_SCHED __builtin_amdgcn_sched_barrier(0)
    Unit cur, nxt; int ui = 0;
    if (!S.next(0, cur)) return;
    f32x4 acc[2][2][4][2];
#pragma unroll
    for (int a = 0; a < 2; ++a)
#pragma unroll
        for (int b = 0; b < 2; ++b)
#pragma unroll
            for (int m = 0; m < 4; ++m)
#pragma unroll
                for (int n = 0; n < 2; ++n) acc[a][b][m][n] = (f32x4){0.f, 0.f, 0.f, 0.f};
    bf16x8 At[4][2], B0[2][2], B1[2][2];
    const char* cA = (const char*)g.A + (size_t)cur.pm * tstep; const char* cB = (const char*)g.Bt + (size_t)cur.pn * tstep;
    S.a_ready(cur);
    if constexpr (SP2) {
        PG8_STAGE(PG8_SB(0, 0), cB, voffB); PG8_STAGE(PG8_SB(0, 1), cB + hstep, voffB); PG8_STAGE(PG8_SA(0, 0), cA, voffA); PG8_STAGE(PG8_SA(0, 1), cA + hstep, voffA);
        if (wr == 1) PG8_BAR;
        PG8_WAIT_V(2); PG8_BAR;
        PG8_STAGE(PG8_SB(1, 0), cB + kstep, voffB); PG8_STAGE(PG8_SA(1, 0), cA + kstep, voffA); PG8_STAGE(PG8_SB(1, 1), cB + hstep + kstep, voffB);
        PG8_WAIT_V(6); PG8_BAR;
    } else {
        PG8_STAGE(PG8_SB(0, 0), cB, voffB); PG8_STAGE(PG8_SA(0, 0), cA, voffA); PG8_STAGE(PG8_SB(0, 1), cB + hstep, voffB); PG8_STAGE(PG8_SA(0, 1), cA + hstep, voffA);
        if (wr == 1) PG8_BAR;
        PG8_WAIT_V(4); PG8_BAR;
        PG8_STAGE(PG8_SB(1, 0), cB + kstep, voffB); PG8_STAGE(PG8_SA(1, 0), cA + kstep, voffA); PG8_STAGE(PG8_SB(1, 1), cB + hstep + kstep, voffB);
        PG8_WAIT_V(6); PG8_BAR;
    }
    for (;;) {
        const bool has_next = S.next(ui + 1, nxt);
        const char* nA = has_next ? (const char*)g.A + (size_t)nxt.pm * tstep : cA; const char* nB = has_next ? (const char*)g.Bt + (size_t)nxt.pn * tstep : cB;
        for (int t = 0; t < nt; t += 2) {
            const bool last = (t == nt - 2);
            const char* a1 = cA + (size_t)(t + 1) * kstep;
            const char* a2 = last ? nA : cA + (size_t)(t + 2) * kstep; const char* b2 = last ? nB : cB + (size_t)(t + 2) * kstep;
            const char* a3 = a2 + kstep; const char* b3 = b2 + kstep;
            if (last && has_next) S.a_ready(nxt);
            if constexpr (SP2) {
            PG8_LDB(B0, 0, 0); PG8_LDB(B1, 0, 1); PG8_SCHED; PG8_LDA(At, 0, 0); PG8_STAGE(PG8_SA(1, 1), a1 + hstep, voffA);
            PG8_WAIT_V(8); PG8_WAIT_L(0); PG8_BAR; PG8_MMA(0, 0, At, B0); PG8_MMA(0, 1, At, B1); PG8_BAR; PG8_SCHED;
            PG8_LDA(At, 0, 1); PG8_STAGE(PG8_SB(0, 0), b2, voffB); PG8_STAGE(PG8_SB(0, 1), b2 + hstep, voffB); PG8_STAGE(PG8_SA(0, 0), a2, voffA);
            PG8_WAIT_V(8); PG8_WAIT_L(0); PG8_BAR; PG8_MMA(1, 0, At, B0); PG8_MMA(1, 1, At, B1); PG8_BAR; PG8_SCHED;
            PG8_LDB(B0, 1, 0); PG8_LDB(B1, 1, 1); PG8_SCHED; PG8_LDA(At, 1, 0); PG8_STAGE(PG8_SA(0, 1), a2 + hstep, voffA);
            PG8_WAIT_V(8); PG8_WAIT_L(0); PG8_BAR; PG8_MMA(0, 0, At, B0); PG8_MMA(0, 1, At, B1); PG8_BAR; PG8_SCHED;
            PG8_LDA(At, 1, 1); PG8_STAGE(PG8_SB(1, 0), b3, voffB); PG8_STAGE(PG8_SB(1, 1), b3 + hstep, voffB); PG8_STAGE(PG8_SA(1, 0), a3, voffA);
            PG8_WAIT_V(8); PG8_WAIT_L(0); PG8_BAR; PG8_MMA(1, 0, At, B0); PG8_MMA(1, 1, At, B1); PG8_BAR; PG8_SCHED;
            } else {
            PG8_LDB(B0, 0, 0); PG8_SCHED; PG8_LDA(At, 0, 0); PG8_STAGE(PG8_SA(1, 1), a1 + hstep, voffA);
            PG8_WAIT_L(8); PG8_BAR; PG8_WAIT_L(0); PG8_MMA(0, 0, At, B0); PG8_BAR; PG8_SCHED;
            PG8_LDB(B1, 0, 1); PG8_STAGE(PG8_SB(0, 0), b2, voffB);
            PG8_BAR; PG8_WAIT_L(0); PG8_MMA(0, 1, At, B1); PG8_BAR;
            PG8_LDA(At, 0, 1); PG8_STAGE(PG8_SA(0, 0), a2, voffA);
            PG8_BAR; PG8_WAIT_L(0); PG8_MMA(1, 0, At, B0); PG8_BAR; PG8_SCHED;
            PG8_STAGE(PG8_SB(0, 1), b2 + hstep, voffB);
            PG8_WAIT_V(6); PG8_BAR; PG8_MMA(1, 1, At, B1); PG8_BAR;
            PG8_LDB(B0, 1, 0); PG8_SCHED; PG8_LDA(At, 1, 0); PG8_STAGE(PG8_SA(0, 1), a2 + hstep, voffA);
            PG8_WAIT_L(8); PG8_BAR; PG8_WAIT_L(0); PG8_MMA(0, 0, At, B0); PG8_BAR; PG8_SCHED;
            PG8_LDB(B1, 1, 1); PG8_STAGE(PG8_SB(1, 0), b3, voffB);
            PG8_BAR; PG8_WAIT_L(0); PG8_MMA(0, 1, At, B1); PG8_BAR;
            PG8_LDA(At, 1, 1); PG8_STAGE(PG8_SA(1, 0), a3, voffA);
            PG8_BAR; PG8_WAIT_L(0); PG8_MMA(1, 0, At, B0); PG8_BAR; PG8_SCHED;
            PG8_STAGE(PG8_SB(1, 1), b3 + hstep, voffB);
            PG8_WAIT_V(6); PG8_BAR; PG8_MMA(1, 1, At, B1); PG8_BAR;
            }
        }
        if constexpr (ALIGN_EPI) { if (wr == 0) PG8_BAR; }
        if constexpr (!Epi::AFTER_DRAIN) { E(acc, cur, wr, wc, fr, fq); S.done(cur); }
        if (!has_next) break;
#pragma unroll
        for (int a = 0; a < 2; ++a)
#pragma unroll
            for (int b = 0; b < 2; ++b)
#pragma unroll
                for (int m = 0; m < 4; ++m)
#pragma unroll
                    for (int n = 0; n < 2; ++n) acc[a][b][m][n] = (f32x4){0.f, 0.f, 0.f, 0.f};
        cur = nxt; cA = nA; cB = nB; ++ui;
        if constexpr (ALIGN_EPI) { if (wr == 1) PG8_BAR; }
    }
    PG8_WAIT_V(0);
    if constexpr (!ALIGN_EPI) { if (wr == 0) PG8_BAR; }
    PG8_BAR;
    if constexpr (Epi::AFTER_DRAIN) { E.fused(acc, cur, wr, wc, fr, fq, lds, wid, lane); S.done(cur); }
#undef PG8_SA
#undef PG8_SB
#undef PG8_STAGE
#undef PG8_LDA
#undef PG8_LDB
#undef PG8_MMA
#undef PG8_WAIT_V
#undef PG8_WAIT_L
#undef PG8_BAR
#undef PG8_SCHED
}
}

using pg8::sigmoid_f;
constexpr int NWAVES = 8, NTHR = 512;
constexpr int S = 8192, DM = 2048, DEPTH = 4, FF = 5632;
constexpr int NPROJ = 16896, NPROJ_PAD = 17152, LPROJ = 16976;
constexpr int PC_AQ = 0, PC_AK = 1024, PC_AV = 2048, PC_IQ = 3072, PC_MQ = 3584, PC_MK = 4096, PC_MV = 4608, PC_MO = 5632, PC_RQ = 6656, PC_RK = 7680, PC_RV = 8704, PC_RG = 9728, PC_G = 10752;
constexpr int LC_IK = 3584, LC_IW = 3648, LC_MI = 5704, LC_MF = 5708;
constexpr float NORM_EPS = 1e-6f;
constexpr size_t MiB = 1u << 20;
constexpr size_t WS_CTL = 0, CTL_ZERO_BYTES = 1 * MiB;
constexpr size_t WS_ROPE128 = 2 * MiB, WS_ROPE64 = 6 * MiB;
constexpr size_t WS_W = 16 * MiB, W_LAYER = 153 * MiB;
constexpr size_t WO_IN = 0, WO_B = 67 * MiB, WO_OUT = 79 * MiB, WO_FIN = 87 * MiB, WO_FOUT = 131 * MiB;
constexpr size_t WS_H = 640 * MiB, WS_PROJ = 672 * MiB, WS_SMALL = 936 * MiB, WS_MQK = 944 * MiB, WS_IKB = 960 * MiB, WS_IWF = 961 * MiB, WS_GIF = WS_IWF + 512 * 1024;
constexpr size_t WS_SC = 964 * MiB, WS_MB = 1220 * MiB, WS_DCM = 1228 * MiB, WS_CPM = 1260 * MiB, WS_MISC = 1292 * MiB, WS_DRR = 1294 * MiB, WS_RPR = 1310 * MiB;
constexpr size_t WS_YA = 1328 * MiB, WS_YM = 1344 * MiB, WS_YR = 1360 * MiB, WS_MERGEDF = 1376 * MiB, WS_MERGED = 1440 * MiB, WS_ACT = 1472 * MiB, WS_END = 1560 * MiB;
constexpr size_t MISC_DN = 0, MISC_NPREV = 256 * 1024, MISC_AB = 512 * 1024, MISC_MPREV = 520 * 1024;
constexpr int CW_BAR = 4096;
constexpr int LDS_BYTES = 147456, MISC_OFF = 147456 - 1024;

#define GAS __attribute__((address_space(1)))
#define LAS __attribute__((address_space(3)))
typedef unsigned short bf16;
typedef unsigned v4u __attribute__((ext_vector_type(4)));
typedef unsigned v2u __attribute__((ext_vector_type(2)));
typedef float f32x4 __attribute__((ext_vector_type(4)));
typedef float f32x16 __attribute__((ext_vector_type(16)));
typedef short bf16x8 __attribute__((ext_vector_type(8)));
typedef short s16x4 __attribute__((ext_vector_type(4)));
#define LDS_WAIT() asm volatile("s_waitcnt lgkmcnt(0)" ::: "memory")
#define VM_WAIT() asm volatile("s_waitcnt vmcnt(0)" ::: "memory")
__device__ __forceinline__ unsigned f2bf(float f) { unsigned u = __builtin_bit_cast(unsigned, f); return (u + 0x7fffu + ((u >> 16) & 1u)) >> 16; }
__device__ __forceinline__ unsigned pk2(float lo, float hi) { return f2bf(lo) | (f2bf(hi) << 16); }
__device__ __forceinline__ float bf2f(bf16 b) { return __uint_as_float(((unsigned)b) << 16); }
template <int CTRL, int RMASK, int BMASK> __device__ __forceinline__ float dpp_f(float old, float src) { return __builtin_bit_cast(float, __builtin_amdgcn_update_dpp(__builtin_bit_cast(int, old), __builtin_bit_cast(int, src), CTRL, RMASK, BMASK, false)); }
template <int CTRL, int RMASK, int BMASK> __device__ __forceinline__ unsigned dpp_u(unsigned src) { return (unsigned)__builtin_amdgcn_update_dpp(0, (int)src, CTRL, RMASK, BMASK, false); }
__device__ __forceinline__ float wave_sum(float x) {
    x += dpp_f<0xB1, 0xf, 0xf>(0.f, x); x += dpp_f<0x4E, 0xf, 0xf>(0.f, x); x += dpp_f<0x141, 0xf, 0xf>(0.f, x); x += dpp_f<0x140, 0xf, 0xf>(0.f, x);
    x += dpp_f<0x142, 0xa, 0xf>(0.f, x); x += dpp_f<0x143, 0xc, 0xf>(0.f, x);
    return __builtin_bit_cast(float, __builtin_amdgcn_readlane(__builtin_bit_cast(int, x), 63)); }
__device__ __forceinline__ float wave_max(float x) {
    x = fmaxf(x, dpp_f<0xB1, 0xf, 0xf>(x, x)); x = fmaxf(x, dpp_f<0x4E, 0xf, 0xf>(x, x)); x = fmaxf(x, dpp_f<0x141, 0xf, 0xf>(x, x)); x = fmaxf(x, dpp_f<0x140, 0xf, 0xf>(x, x));
    x = fmaxf(x, dpp_f<0x142, 0xa, 0xf>(x, x)); x = fmaxf(x, dpp_f<0x143, 0xc, 0xf>(x, x));
    return __builtin_bit_cast(float, __builtin_amdgcn_readlane(__builtin_bit_cast(int, x), 63)); }
__device__ __forceinline__ unsigned lane_id_v() { unsigned l; asm volatile("v_mbcnt_lo_u32_b32 %0, -1, 0\n\tv_mbcnt_hi_u32_b32 %0, -1, %0" : "=v"(l)); return l; }
__device__ __forceinline__ int my_tid() {
    const unsigned slot = (unsigned)__builtin_amdgcn_s_getreg((5 << 11) | 4) & 63u;
    extern __shared__ __attribute__((aligned(16))) unsigned char lds_raw_t[];
    const unsigned wv = ((volatile LAS unsigned*)((LAS unsigned char*)lds_raw_t + MISC_OFF))[64 + slot];
    return (int)(__builtin_amdgcn_readfirstlane(wv) * 64u + lane_id_v());
}
__device__ __forceinline__ float shfl_idx_f(float x, int src_lane) { return __builtin_bit_cast(float, __builtin_amdgcn_ds_bpermute(src_lane << 2, __builtin_bit_cast(int, x))); }
__device__ __forceinline__ float wave_prefix_sum_f(float x) {
    float y = x + dpp_f<0x111, 0xf, 0xf>(0.f, x); y += dpp_f<0x112, 0xf, 0xf>(0.f, x); y += dpp_f<0x113, 0xf, 0xf>(0.f, x);
    y += dpp_f<0x114, 0xf, 0xe>(0.f, y); y += dpp_f<0x118, 0xf, 0xc>(0.f, y); y += dpp_f<0x142, 0xa, 0xf>(0.f, y); y += dpp_f<0x143, 0xc, 0xf>(0.f, y); return y; }
__device__ __forceinline__ float wave_prefix_max_f(float x) {
    const float N = -3.0e38f;
    float y = fmaxf(x, dpp_f<0x111, 0xf, 0xf>(N, x)); y = fmaxf(y, dpp_f<0x112, 0xf, 0xf>(N, x)); y = fmaxf(y, dpp_f<0x113, 0xf, 0xf>(N, x));
    y = fmaxf(y, dpp_f<0x114, 0xf, 0xe>(N, y)); y = fmaxf(y, dpp_f<0x118, 0xf, 0xc>(N, y)); y = fmaxf(y, dpp_f<0x142, 0xa, 0xf>(N, y)); y = fmaxf(y, dpp_f<0x143, 0xc, 0xf>(N, y)); return y; }
#define XB_TMO      128
#define XB_XCNT(j)  (256  + 64 * (j))
#define XB_XSUB(j)  (1280 + 64 * (j))
#define XB_XGEN(j)  (2304 + 64 * (j))
#define XB_TOP      3328
#define XB_TOPGEN   3392
#define XCD_BAR_WORDS 3456
#define XB_SPIN_CAP (1u << 18)

__device__ __forceinline__ unsigned xb_ld(unsigned* p)              { return __hip_atomic_load(p, __ATOMIC_RELAXED, __HIP_MEMORY_SCOPE_AGENT); }
__device__ __forceinline__ unsigned xb_add(unsigned* p, unsigned v) { return __hip_atomic_fetch_add(p, v, __ATOMIC_RELAXED, __HIP_MEMORY_SCOPE_AGENT); }
__device__ __forceinline__ unsigned xb_xcc_id() { return (unsigned)__builtin_amdgcn_s_getreg((3 << 11) | 20) & 0xFu; }
#define XB_SPIN(cond, bar) do { unsigned _sp = 0; while (cond) { __builtin_amdgcn_s_sleep(1); \
    if ((++_sp & 255u) == 0u) { if (xb_ld(&(bar)[XB_TMO])) break; if (_sp > XB_SPIN_CAP) { atomicAdd(&(bar)[XB_TMO], 1u); break; } } } } while (0)

struct XcdBarrier {
    unsigned* bar; unsigned x;
    volatile LAS unsigned* st;
};

__device__ __forceinline__ XcdBarrier xcd_barrier_post(unsigned* bar, volatile LAS unsigned* st) {
    XcdBarrier b; b.bar = bar; b.x = xb_xcc_id(); b.st = st;
    if (my_tid() == 0) (void)xb_add(&bar[XB_XCNT(b.x)], 1u);
    return b;
}
__device__ __forceinline__ void xcd_barrier_complete(unsigned* bar, unsigned x, unsigned& nloc, unsigned& nx) {
    const unsigned G = gridDim.x * gridDim.y * gridDim.z;
    unsigned sum, cnt, mine, sp = 0u;
    for (;;) {
        sum = 0u; cnt = 0u; mine = 0u;
#pragma unroll
        for (unsigned j = 0; j < 16; ++j) { const unsigned c = xb_ld(&bar[XB_XCNT(j)]); sum += c; cnt += (c > 0u) ? 1u : 0u; mine = (j == x) ? c : mine; }
        if (sum == G) break;
        __builtin_amdgcn_s_sleep(1);
        if ((++sp & 255u) == 0u) { if (xb_ld(&bar[XB_TMO])) break; if (sp > XB_SPIN_CAP) { atomicAdd(&bar[XB_TMO], 1u); break; } }
    }
    nloc = mine > 0u ? mine : 1u; nx = cnt > 0u ? cnt : 1u;
}

__device__ __forceinline__ void xcd_barrier(const XcdBarrier& b) {
    asm volatile("s_waitcnt vmcnt(0)" ::: "memory");
    __syncthreads();
    if (my_tid() == 0) {
        unsigned* bar = b.bar;
        __builtin_amdgcn_s_waitcnt(0);
        unsigned nloc = b.st[0], nx = b.st[1];
        if (nloc == 0u) { xcd_barrier_complete(bar, b.x, nloc, nx); b.st[0] = nloc; b.st[1] = nx; }
        const unsigned old = xb_add(&bar[XB_XSUB(b.x)], 1u);
        const unsigned gen = old / nloc;
        if (old + 1u == (gen + 1u) * nloc) {
            __builtin_amdgcn_fence(__ATOMIC_RELEASE, "agent");
            asm volatile("s_waitcnt vmcnt(0)" ::: "memory");
            const unsigned og = xb_add(&bar[XB_TOP], 1u);
            const unsigned tg = og / nx;
            if (og + 1u == (tg + 1u) * nx) xb_add(&bar[XB_TOPGEN], 1u);
            else XB_SPIN(xb_ld(&bar[XB_TOPGEN]) == tg, bar);
            __builtin_amdgcn_fence(__ATOMIC_ACQUIRE, "agent");
            xb_add(&bar[XB_XGEN(b.x)], 1u);
            asm volatile("s_waitcnt vmcnt(0)" ::: "memory");
        } else {
            XB_SPIN(xb_ld(&bar[XB_XGEN(b.x)]) == gen, bar);
            __builtin_amdgcn_fence(__ATOMIC_ACQUIRE, "agent");
            asm volatile("s_waitcnt vmcnt(0)" ::: "memory");
        }
    }
    __syncthreads();
}

struct MapIdent { __device__ __forceinline__ int operator()(int p) const { return p; } };
struct MapWin { __device__ __forceinline__ int operator()(int p) const {
    if (p < 3584) return p; if (p < 5632) return p + 72; if (p < NPROJ) return p + 80;
    const int r = p - NPROJ; if (r < 64) return LC_IK + r; if (r < 72) return LC_IW + (r - 64); if (r < 76) return LC_MI + (r - 72); if (r < 80) return LC_MF + (r - 76); return -1; } };
struct MapFfn { __device__ __forceinline__ int operator()(int p) const { const int t = p >> 8, r = p & 255; return r < 128 ? 128 * t + r : FF + 128 * t + (r - 128); } };
template <class Map> __device__ __forceinline__ void transpose_item(const float* W, int K, int N, bf16* WT, LAS float* scr, int item, int nblk, int lane, const Map& map) {
    const int kb = item / nblk, nb = item % nblk, k0 = 64 * kb, p0 = 64 * nb;
    const int n4 = lane & 15, kr = lane >> 4, nl = map(p0 + 4 * n4);
    f32x4 v[16];
#pragma unroll
    for (int i = 0; i < 16; ++i) v[i] = nl >= 0 ? *(const GAS f32x4*)(W + (size_t)(k0 + kr + 4 * i) * N + nl) : (f32x4){0.f, 0.f, 0.f, 0.f};
#pragma unroll
    for (int i = 0; i < 16; ++i) { LAS float* d = scr + (kr + 4 * i) * 65 + 4 * n4; d[0] = v[i][0]; d[1] = v[i][1]; d[2] = v[i][2]; d[3] = v[i][3]; }
    LDS_WAIT(); asm volatile("" ::: "memory");
    const int c = lane & 7;
#pragma unroll
    for (int j = 0; j < 8; ++j) { const int n = (lane >> 3) + 8 * j; const LAS float* s = scr + (8 * c) * 65 + n;
        v4u o; o.x = pk2(s[0 * 65], s[1 * 65]); o.y = pk2(s[2 * 65], s[3 * 65]); o.z = pk2(s[4 * 65], s[5 * 65]); o.w = pk2(s[6 * 65], s[7 * 65]);
        *(GAS v4u*)(WT + (size_t)(p0 + n) * K + k0 + 8 * c) = o; }
    LDS_WAIT(); asm volatile("" ::: "memory");
}
template <class Map> __device__ __forceinline__ void transpose_matrix(const float* W, int K, int N, int Nphys, bf16* WT, LAS float* scr, int gw, int ngw, int lane, const Map& map) {
    const int nblk = Nphys / 64, nit = (K / 64) * nblk;
    for (int it = gw; it < nit; it += ngw) transpose_item(W, K, N, WT, scr, it, nblk, lane, map);
}

__device__ __forceinline__ void rms_row_to_bf16(const float* xrow, const float* gain, bf16* orow, int lane) {
    const GAS f32x4* xr = (const GAS f32x4*)xrow + lane; const GAS f32x4* gr = (const GAS f32x4*)gain + lane;
    f32x4 v[8]; float s = 0.f;
#pragma unroll
    for (int j = 0; j < 8; ++j) { v[j] = xr[64 * j]; s += (v[j].x * v[j].x + v[j].y * v[j].y) + (v[j].z * v[j].z + v[j].w * v[j].w); }
    const float rstd = 1.0f / sqrtf(wave_sum(s) * (1.f / DM) + NORM_EPS);
    GAS unsigned long long* o8 = (GAS unsigned long long*)orow + lane;
#pragma unroll
    for (int j = 0; j < 8; ++j) { const f32x4 g = gr[64 * j]; o8[64 * j] = (unsigned long long)pk2(v[j].x * rstd * g.x, v[j].y * rstd * g.y) | ((unsigned long long)pk2(v[j].z * rstd * g.z, v[j].w * rstd * g.w) << 32); }
}

struct PPArgs { bf16* proj; const float* small; bf16* mqk; bf16* ikb; float* iwf; float* gif; const float* rope128; const float* rope64; const float* gq; const float* gk; const float* convw; const float* gbias; };
__device__ __forceinline__ void pp_row(const PPArgs& a, int t, int lane) {
    bf16* pr = a.proj + (size_t)t * NPROJ;
    const float2 cs = ((const float2*)a.rope128)[t * 64 + lane];
    const float2 c6 = ((const float2*)a.rope64)[t * 32 + (lane & 31)];
#pragma unroll 1
    for (int which = 0; which < 2; ++which) {
        const float* gn = which ? a.gk : a.gq; const float g1 = gn[lane], g2 = gn[64 + lane];
#pragma unroll 2
        for (int hh = 0; hh < 8; ++hh) { bf16* p = pr + (which ? PC_AK : PC_AQ) + hh * 128;
            const float x1 = bf2f(p[lane]), x2 = bf2f(p[64 + lane]);
            const float rstd = 1.0f / sqrtf(wave_sum(x1 * x1 + x2 * x2) * (1.f / 128.f) + NORM_EPS);
            const float y1 = x1 * rstd * g1, y2 = x2 * rstd * g2;
            p[lane] = (bf16)f2bf(y1 * cs.x - y2 * cs.y); p[64 + lane] = (bf16)f2bf(y2 * cs.x + y1 * cs.y); }
    }
#pragma unroll 1
    for (int which = 0; which < 2; ++which) {
#pragma unroll 2
        for (int hh = 0; hh < 8; ++hh) { bf16* p = pr + (which ? PC_RK : PC_RQ) + hh * 128;
            const float y1 = bf2f(p[lane]), y2 = bf2f(p[64 + lane]);
            p[lane] = (bf16)f2bf(y1 * cs.x - y2 * cs.y); p[64 + lane] = (bf16)f2bf(y2 * cs.x + y1 * cs.y); }
    }
#pragma unroll
    for (int p4 = 0; p4 < 4; ++p4) { bf16* p = pr + PC_IQ + (2 * p4 + (lane >> 5)) * 64; const int i = lane & 31;
        const float y1 = bf2f(p[i]), y2 = bf2f(p[32 + i]);
        p[i] = (bf16)f2bf(y1 * c6.x - y2 * c6.y); p[32 + i] = (bf16)f2bf(y2 * c6.x + y1 * c6.y); }
    const float* sm = a.small + (size_t)t * 256;
    if (lane < 32) { const float y1 = sm[lane], y2 = sm[32 + lane];
        a.ikb[(size_t)t * 64 + lane] = (bf16)f2bf(y1 * c6.x - y2 * c6.y); a.ikb[(size_t)t * 64 + 32 + lane] = (bf16)f2bf(y2 * c6.x + y1 * c6.y); }
    if (lane < 8) { a.iwf[(size_t)t * 8 + lane] = sm[64 + lane] * (0.35355339059327373f * 0.125f);
        a.gif[(size_t)t * 8 + lane] = sm[72 + lane] + a.gbias[lane]; }
#pragma unroll 4
    for (int i = 0; i < 16; ++i) { const int c = lane + 64 * i; float acc = 0.f;
#pragma unroll
        for (int j = 0; j < 4; ++j) { const int tt = t - 3 + j; if (tt >= 0) acc += a.convw[j * 1024 + c] * bf2f(a.proj[(size_t)tt * NPROJ + PC_MQ + c]); }
        a.mqk[(size_t)t * 1024 + c] = (bf16)f2bf(acc); }
}

__device__ __forceinline__ void score_wave_unit(const bf16* proj, const bf16* ikb, const float* iwf, float* sc, int qb, int kb, int lane) {
    const int r = lane & 31, h = lane >> 5, q = qb * 32 + r, s0 = kb * 128;
    bf16x8 ka[4][4];
#pragma unroll
    for (int b = 0; b < 4; ++b)
#pragma unroll
        for (int kk = 0; kk < 4; ++kk) ka[b][kk] = *(const bf16x8*)(ikb + (size_t)(s0 + 32 * b + r) * 64 + 16 * kk + 8 * h);
    f32x16 scv[4];
#pragma unroll
    for (int b = 0; b < 4; ++b)
#pragma unroll
        for (int e = 0; e < 16; ++e) scv[b][e] = 0.f;
#pragma unroll 1
    for (int j = 0; j < 8; ++j) {
        bf16x8 qf[4];
#pragma unroll
        for (int kk = 0; kk < 4; ++kk) qf[kk] = *(const bf16x8*)(proj + (size_t)q * NPROJ + PC_IQ + j * 64 + 16 * kk + 8 * h);
        const float wj = iwf[(size_t)q * 8 + j];
#pragma unroll
        for (int b = 0; b < 4; ++b) { f32x16 acc;
#pragma unroll
            for (int e = 0; e < 16; ++e) acc[e] = 0.f;
#pragma unroll
            for (int kk = 0; kk < 4; ++kk) acc = __builtin_amdgcn_mfma_f32_32x32x16_bf16(ka[b][kk], qf[kk], acc, 0, 0, 0);
#pragma unroll
            for (int e = 0; e < 16; ++e) scv[b][e] += wj * fmaxf(acc[e], 0.f); }
    }
#pragma unroll
    for (int b = 0; b < 4; ++b)
#pragma unroll
        for (int g = 0; g < 4; ++g) *(f32x4*)(sc + (size_t)q * S + s0 + 32 * b + 8 * g + 4 * h) = (f32x4){scv[b][4 * g], scv[b][4 * g + 1], scv[b][4 * g + 2], scv[b][4 * g + 3]};
}


__device__ __forceinline__ float wave_max_dpp(float x) { return wave_max(x); }
__device__ __forceinline__ float wave_min_dpp(float x) { return -wave_max_dpp(-x); }
__device__ __forceinline__ unsigned wave_prefix_dpp(unsigned x) {
    unsigned y = x + dpp_u<0x111, 0xf, 0xf>(x); y += dpp_u<0x112, 0xf, 0xf>(x); y += dpp_u<0x113, 0xf, 0xf>(x);
    y += dpp_u<0x114, 0xf, 0xe>(y); y += dpp_u<0x118, 0xf, 0xc>(y); y += dpp_u<0x142, 0xa, 0xf>(y); y += dpp_u<0x143, 0xc, 0xf>(y);
    return y; }
#define SEL_BAR() do { asm volatile("s_waitcnt lgkmcnt(0)" ::: "memory"); __builtin_amdgcn_s_barrier(); asm volatile("" ::: "memory"); } while (0)
__device__ __forceinline__ void select_rows_wg(LAS unsigned char* lds, const float* sc, unsigned long long* mb, int row0, int rstep, int tid) {
    LAS unsigned* hist = (LAS unsigned*)lds;
    LAS float* red = (LAS float*)(hist + 2176); LAS unsigned* lcnt = hist + 2192;
    LAS float* lval = (LAS float*)(hist + 2208); LAS int* lidx = (LAS int*)(hist + 2208 + 8192); LAS unsigned* lsel = hist + 2208 + 16384;
    const int lane = tid & 63, w = tid >> 6;
    float nx[16];
#define SEL_LOAD(t_) do { const float* scr_ = sc + (size_t)(t_) * S + tid; _Pragma("unroll") for (int i = 0; i < 16; ++i) nx[i] = scr_[i * 512]; } while (0)
    if (row0 < S) SEL_LOAD(row0);
    if (tid < 2) lcnt[tid] = 0u;
    for (int j = tid; j < 2176; j += NTHR) hist[j] = 0u;
    if (tid == 0) lsel[0] = 0u;
    int par = 0;
    for (int t = row0; t < S; t += rstep) {
        float v[16];
#pragma unroll
        for (int i = 0; i < 16; ++i) v[i] = (i * 512 + tid <= t) ? nx[i] : -3.0e38f;
        if (t + rstep < S) SEL_LOAD(t + rstep);
        unsigned long long* mbr = mb + (size_t)t * 128;
        unsigned long long mword = 0ull;
        if (t >= 256) {
            const int nround = (t >> 9) + 1;
            float mn = 3.0e38f, mx = -3.0e38f;
#pragma unroll
            for (int i = 0; i < 16; ++i) { mx = fmaxf(mx, v[i]); mn = fminf(mn, (i * 512 + tid <= t) ? v[i] : 3.0e38f); }
            mn = wave_min_dpp(mn); mx = wave_max_dpp(mx);
            if (lane == 0) { red[w] = mn; red[8 + w] = mx; }
            SEL_BAR();
            mn = red[0]; mx = red[8];
#pragma unroll
            for (int j = 1; j < 8; ++j) { mn = fminf(mn, red[j]); mx = fmaxf(mx, red[8 + j]); }
            const float scale = (mx > mn) ? 2047.0f / (mx - mn) : 0.f;
            int bin[16];
#pragma unroll
            for (int i = 0; i < 16; ++i) { int b = (int)((v[i] - mn) * scale); b = b < 0 ? 0 : (b > 2047 ? 2047 : b); const bool ok = i * 512 + tid <= t; bin[i] = ok ? b : -1;
                if (i < nround) (void)__hip_atomic_fetch_add(hist + (ok ? b + (b >> 5) : 2112 + lane), 1u, __ATOMIC_RELAXED, __HIP_MEMORY_SCOPE_WORKGROUP); }
            SEL_BAR();
            unsigned hb[32]; unsigned ts = 0u; const int blk = 63 - lane;
#pragma unroll
            for (int k = 0; k < 32; ++k) { hb[k] = hist[33 * blk + k]; ts += hb[k]; }
            const unsigned suf = wave_prefix_dpp(ts);
            unsigned above = suf - ts; int bloc = 0; unsigned aloc = 0u; bool found = false;
            const bool own = above < 256u && above + ts >= 256u;
#pragma unroll
            for (int k = 31; k >= 0; --k) { const bool hit = own && !found && above + hb[k] >= 256u; bloc = hit ? 32 * blk + k : bloc; aloc = hit ? above : aloc; found = found || hit; above += hb[k]; }
            const unsigned long long om = __builtin_amdgcn_ballot_w64(own);
            const int ol = om ? (int)__builtin_ctzll(om) : 0;
            const int bstar = __builtin_amdgcn_readlane(bloc, ol); const unsigned need = 256u - (unsigned)__builtin_amdgcn_readlane((int)aloc, ol);
            int ks[16];
#pragma unroll
            for (int i = 0; i < 16; ++i) { ks[i] = -1; if (bin[i] == bstar) { const unsigned k = __hip_atomic_fetch_add(lcnt + par, 1u, __ATOMIC_RELAXED, __HIP_MEMORY_SCOPE_WORKGROUP); lval[k] = v[i]; lidx[k] = i * 512 + tid; ks[i] = (int)k; } }
            SEL_BAR();
            const int nl = (int)lcnt[par];
            for (int k = tid; k < nl; k += NTHR) { const float x = lval[k]; const int s = lidx[k]; unsigned rank = 0u;
                for (int j = 0; j < nl; ++j) { const float y = lval[j]; const int sj = lidx[j]; rank += (y > x || (y == x && sj < s)) ? 1u : 0u; }
                lsel[k] = rank < need ? 1u : 0u; }
            SEL_BAR();
#pragma unroll
            for (int i = 0; i < 16; ++i) { const unsigned lv = lsel[ks[i] < 0 ? 0 : ks[i]]; const bool sel = bin[i] > bstar || (ks[i] >= 0 && lv != 0u);
                const unsigned long long m = __builtin_amdgcn_ballot_w64(sel); mword = (lane == i) ? m : mword; }
#pragma unroll
            for (int i = 0; i < 16; ++i) if (i < nround) hist[bin[i] >= 0 ? bin[i] + (bin[i] >> 5) : 2112 + lane] = 0u;
            if (tid == 0) lcnt[par ^ 1] = 0u;
            par ^= 1;
        } else {
#pragma unroll
            for (int i = 0; i < 16; ++i) { const unsigned long long m = __builtin_amdgcn_ballot_w64(i * 512 + tid <= t); mword = (lane == i) ? m : mword; }
        }
        if (lane < 16) mbr[lane * 8 + w] = mword;
    }
    SEL_BAR();
#undef SEL_LOAD
}

template <int RS> __device__ __forceinline__ bf16x8 frag_row(const LAS unsigned char* base, int r0, int k0, int lane) {
    return *(const LAS bf16x8*)(base + (r0 + (lane & 15)) * RS + (k0 + 8 * (lane >> 4)) * 2);
}
template <int RS> __device__ __forceinline__ bf16x8 frag_tr(const LAS unsigned char* base, int k0, int c0, int lane) {
    const int g = lane >> 4, q = (lane & 15) >> 2, p = lane & 3;
    const unsigned a = (unsigned)(size_t)(base + (k0 + 8 * g + q) * RS + (c0 + 4 * p) * 2);
    s16x4 lo, hi;
    asm volatile("ds_read_b64_tr_b16 %0, %2\n\tds_read_b64_tr_b16 %1, %2 offset:%3\n\ts_waitcnt lgkmcnt(0)" : "=&v"(lo), "=&v"(hi) : "v"(a), "i"(4 * RS) : "memory");
    return (bf16x8){lo[0], lo[1], lo[2], lo[3], hi[0], hi[1], hi[2], hi[3]};
}
#define MFMA16(a, b, c) __builtin_amdgcn_mfma_f32_16x16x32_bf16((a), (b), (c), 0, 0, 0)
constexpr int SCR_OFF = 114688;
constexpr float DK_SCALE = 0.08838834764831845f;
__device__ __forceinline__ float log_sigmoid_f(float x) { return fminf(x, 0.f) - log1pf(expf(-fabsf(x))); }

template <int L, int DV> __device__ __forceinline__ void chunk_delta(LAS unsigned char* lds, const bf16* ksrc, int ldk, const bf16* vsrc, int ldv, const LAS float* wcol, bf16* outT, float* dn, int tid) {
    constexpr int RSK = (128 + 8) * 2, RSV = (DV + 8) * 2, NCB = DV / 128;
    LAS unsigned char* KA = lds; LAS unsigned char* V = lds + L * RSK;
    const int lane = tid & 63, w = tid >> 6;
    for (int idx = tid; idx < L * 16; idx += NTHR) { const int s = idx >> 4, c8 = idx & 15;
        const v4u x = *(const GAS v4u*)(ksrc + (size_t)s * ldk + c8 * 8); const float sc = DK_SCALE * wcol[s]; v4u o;
        o.x = pk2(__uint_as_float(x.x << 16) * sc, __uint_as_float(x.x & 0xffff0000u) * sc); o.y = pk2(__uint_as_float(x.y << 16) * sc, __uint_as_float(x.y & 0xffff0000u) * sc);
        o.z = pk2(__uint_as_float(x.z << 16) * sc, __uint_as_float(x.z & 0xffff0000u) * sc); o.w = pk2(__uint_as_float(x.w << 16) * sc, __uint_as_float(x.w & 0xffff0000u) * sc);
        *(LAS v4u*)(KA + s * RSK + c8 * 16) = o; }
    for (int idx = tid; idx < L * (DV / 8); idx += NTHR) { const int s = idx / (DV / 8), c8 = idx % (DV / 8);
        *(LAS v4u*)(V + s * RSV + c8 * 16) = *(const GAS v4u*)(vsrc + (size_t)s * ldv + c8 * 8); }
    __syncthreads();
    f32x4 acc[8][NCB];
#pragma unroll
    for (int db = 0; db < 8; ++db)
#pragma unroll
        for (int i = 0; i < NCB; ++i) acc[db][i] = (f32x4){0.f, 0.f, 0.f, 0.f};
#pragma unroll
    for (int kk = 0; kk < L / 32; ++kk) {
        bf16x8 bfr[NCB];
#pragma unroll
        for (int i = 0; i < NCB; ++i) bfr[i] = frag_tr<RSV>(V, 32 * kk, 16 * (w * NCB + i), lane);
#pragma unroll
        for (int db = 0; db < 8; ++db) { const bf16x8 a = frag_tr<RSK>(KA, 32 * kk, 16 * db, lane);
#pragma unroll
            for (int i = 0; i < NCB; ++i) acc[db][i] = MFMA16(a, bfr[i], acc[db][i]); }
    }
#pragma unroll
    for (int db = 0; db < 8; ++db)
#pragma unroll
        for (int i = 0; i < NCB; ++i) { const int e = 16 * (w * NCB + i) + (lane & 15), d0 = 16 * db + 4 * (lane >> 4);
            v2u o; o.x = pk2(acc[db][i][0], acc[db][i][1]); o.y = pk2(acc[db][i][2], acc[db][i][3]);
            *(GAS v2u*)(outT + (size_t)e * 128 + d0) = o; }
    if (dn != nullptr && tid < 128) { float s_ = 0.f;
        for (int s = 0; s < L; ++s) s_ += bf2f(*(const LAS bf16*)(KA + s * RSK + tid * 2));
        dn[tid] = s_; }
    __syncthreads();
}

template <int L, int DV, int MODE> __device__ __forceinline__ void chunk_out(LAS unsigned char* lds, LAS float* sf, const bf16* qsrc, int ldq, const bf16* ksrc, int ldk, const bf16* vsrc, int ldv,
                                                                              const bf16* stT, const float* gain, const bf16* gate, int ldg, bf16* y, int ldy, int tid) {
    constexpr int RSQ = (128 + 8) * 2, RSV = (DV + 8) * 2, RSP = (L + 8) * 2, NCB = DV / 128, NT = L / 16, TPW = NT * NT / 8;
    LAS unsigned char* Q = lds; LAS unsigned char* K = lds + L * RSQ; LAS unsigned char* V = lds + 2 * L * RSQ;
    LAS unsigned char* P = (MODE == 0) ? (lds + 2 * L * RSQ + L * RSV) : K;
    LAS float* H = (LAS float*)lds;
    LAS float* lrow = sf; LAS float* lcol = sf + 128; LAS float* qs = sf + 256; LAS float* flo = sf + 384; LAS float* rowsum = sf + 512; LAS float* npv = sf + 640; LAS float* part = sf + 768; LAS float* dpart = sf + 768 + L * NT;
    const int lane = tid & 63, w = tid >> 6, g4 = lane >> 4, c16 = lane & 15;
    for (int idx = tid; idx < L * 16; idx += NTHR) { const int s = idx >> 4, c8 = idx & 15;
        *(LAS v4u*)(Q + s * RSQ + c8 * 16) = *(const GAS v4u*)(qsrc + (size_t)s * ldq + c8 * 8);
        *(LAS v4u*)(K + s * RSQ + c8 * 16) = *(const GAS v4u*)(ksrc + (size_t)s * ldk + c8 * 8); }
    for (int idx = tid; idx < L * (DV / 8); idx += NTHR) { const int s = idx / (DV / 8), c8 = idx % (DV / 8);
        *(LAS v4u*)(V + s * RSV + c8 * 16) = *(const GAS v4u*)(vsrc + (size_t)s * ldv + c8 * 8); }
    __syncthreads();
    f32x4 pv[TPW];
#pragma unroll
    for (int i = 0; i < TPW; ++i) { const int ti = w * TPW + i, rb = ti / NT, cb = ti % NT; f32x4 a = (f32x4){0.f, 0.f, 0.f, 0.f};
        if (cb <= rb) {
#pragma unroll
            for (int kk = 0; kk < 4; ++kk) a = MFMA16(frag_row<RSQ>(Q, 16 * rb, 32 * kk, lane), frag_row<RSQ>(K, 16 * cb, 32 * kk, lane), a);
            const int s = 16 * cb + c16; const float lc = lcol[s]; float rs[4];
#pragma unroll
            for (int r = 0; r < 4; ++r) { const int t = 16 * rb + 4 * g4 + r; const float pw = (s <= t) ? __expf(lrow[t] + lc) * a[r] * DK_SCALE : 0.f; a[r] = pw; rs[r] = pw; }
            if (MODE == 0) {
#pragma unroll
                for (int r = 0; r < 4; ++r) { float v = rs[r]; v += dpp_f<0xB1, 0xf, 0xf>(0.f, v); v += dpp_f<0x4E, 0xf, 0xf>(0.f, v); v += dpp_f<0x141, 0xf, 0xf>(0.f, v); v += dpp_f<0x140, 0xf, 0xf>(0.f, v);
                    if (c16 == 0) part[(16 * rb + 4 * g4 + r) * NT + cb] = v; } }
        } else if (MODE == 0) { if (c16 == 0) {
#pragma unroll
                for (int r = 0; r < 4; ++r) part[(16 * rb + 4 * g4 + r) * NT + cb] = 0.f; } }
        pv[i] = a; }
    __syncthreads();
#pragma unroll
    for (int i = 0; i < TPW; ++i) { const int ti = w * TPW + i, rb = ti / NT, cb = ti % NT;
#pragma unroll
        for (int r = 0; r < 4; ++r) *(LAS bf16*)(P + (16 * rb + 4 * g4 + r) * RSP + (16 * cb + c16) * 2) = (bf16)f2bf(pv[i][r]); }
    for (int idx = tid; idx < L * 16; idx += NTHR) { const int s = idx >> 4, c8 = idx & 15; const float sc = qs[s];
        const v4u x = *(const LAS v4u*)(Q + s * RSQ + c8 * 16); float f[8];
        f[0] = __uint_as_float(x.x << 16) * sc; f[1] = __uint_as_float(x.x & 0xffff0000u) * sc; f[2] = __uint_as_float(x.y << 16) * sc; f[3] = __uint_as_float(x.y & 0xffff0000u) * sc;
        f[4] = __uint_as_float(x.z << 16) * sc; f[5] = __uint_as_float(x.z & 0xffff0000u) * sc; f[6] = __uint_as_float(x.w << 16) * sc; f[7] = __uint_as_float(x.w & 0xffff0000u) * sc;
        v4u o; o.x = pk2(f[0], f[1]); o.y = pk2(f[2], f[3]); o.z = pk2(f[4], f[5]); o.w = pk2(f[6], f[7]);
        *(LAS v4u*)(Q + s * RSQ + c8 * 16) = o;
        if (MODE == 0) { float dsum = 0.f;
#pragma unroll
            for (int j = 0; j < 8; ++j) dsum += f[j] * npv[8 * c8 + j];
            dpart[s * 16 + c8] = dsum; } }
    __syncthreads();
    if (MODE == 0 && tid < L) { float a = 0.f;
#pragma unroll
        for (int j = 0; j < NT; ++j) a += part[tid * NT + j];
#pragma unroll
        for (int j = 0; j < 16; ++j) a += dpart[tid * 16 + j];
        rowsum[tid] = a; }
    f32x4 acc[NT][NCB];
#pragma unroll
    for (int rb = 0; rb < NT; ++rb)
#pragma unroll
        for (int i = 0; i < NCB; ++i) acc[rb][i] = (f32x4){0.f, 0.f, 0.f, 0.f};
#pragma unroll
    for (int kk = 0; kk < 4; ++kk) { bf16x8 bfr[NCB];
#pragma unroll
        for (int i = 0; i < NCB; ++i) bfr[i] = *(const GAS bf16x8*)(stT + (size_t)(16 * (w * NCB + i) + c16) * 128 + 32 * kk + 8 * g4);
#pragma unroll
        for (int rb = 0; rb < NT; ++rb) { const bf16x8 a = frag_row<RSQ>(Q, 16 * rb, 32 * kk, lane);
#pragma unroll
            for (int i = 0; i < NCB; ++i) acc[rb][i] = MFMA16(a, bfr[i], acc[rb][i]); } }
#pragma unroll
    for (int kk = 0; kk < L / 32; ++kk) { bf16x8 bfr[NCB];
#pragma unroll
        for (int i = 0; i < NCB; ++i) bfr[i] = frag_tr<RSV>(V, 32 * kk, 16 * (w * NCB + i), lane);
#pragma unroll
        for (int rb = 0; rb < NT; ++rb) { const bf16x8 a = frag_row<RSP>(P, 16 * rb, 32 * kk, lane);
#pragma unroll
            for (int i = 0; i < NCB; ++i) acc[rb][i] = MFMA16(a, bfr[i], acc[rb][i]); } }
    __syncthreads();
#pragma unroll
    for (int rb = 0; rb < NT; ++rb)
#pragma unroll
        for (int i = 0; i < NCB; ++i)
#pragma unroll
            for (int r = 0; r < 4; ++r) { const int t = 16 * rb + 4 * g4 + r, e = 16 * (w * NCB + i) + c16; float hv = acc[rb][i][r];
                if (MODE == 0) hv = hv / fmaxf(fabsf(rowsum[t]), flo[t]);
                H[t * DV + e] = hv; }
    __syncthreads();
    for (int t = w; t < L; t += NWAVES) { float hv[DV / 64]; float s1 = 0.f;
#pragma unroll
        for (int i = 0; i < DV / 64; ++i) { hv[i] = H[t * DV + lane + 64 * i]; s1 += hv[i]; }
        float mu = 0.f; if (MODE == 1) { mu = wave_sum(s1) * (1.f / DV); }
        float s2 = 0.f;
#pragma unroll
        for (int i = 0; i < DV / 64; ++i) { hv[i] -= mu; s2 += hv[i] * hv[i]; }
        const float rstd = 1.0f / sqrtf(wave_sum(s2) * (1.f / DV) + NORM_EPS);
#pragma unroll
        for (int i = 0; i < DV / 64; ++i) { const int e = lane + 64 * i; const float gt = bf2f(gate[(size_t)t * ldg + e]);
            const float act = (MODE == 0) ? sigmoid_f(gt) : gt * sigmoid_f(gt);
            y[(size_t)t * ldy + e] = (bf16)f2bf(hv[i] * rstd * gain[e] * act); } }
    __syncthreads();
}
namespace att {
constexpr int D = 128, LDQKV = NPROJ, LDO = 1024;
constexpr float THR = 8.f; constexpr bool WSKIP = false;
constexpr float SCALE = 0.08838834764831845f;
constexpr int NW = 8, QBLK = 32, KVBLK = 64, QB = NW * QBLK;
constexpr int SHM_V = KVBLK * D * 2, SHM_K = KVBLK * D * 2;
constexpr int LDS_BYTES = 2 * SHM_V + 2 * SHM_K + NW * 64 * 4;

using bf16 = unsigned short;
typedef short bf16x8 __attribute__((ext_vector_type(8)));
typedef short s16x4 __attribute__((ext_vector_type(4)));
typedef float f32x16 __attribute__((ext_vector_type(16)));
typedef float f32x4 __attribute__((ext_vector_type(4)));
typedef unsigned u32x4 __attribute__((ext_vector_type(4)));
template <class A, class Bt> struct same_t { static constexpr bool v = false; };
template <class A> struct same_t<A, A> { static constexpr bool v = true; };

#define KSWZ(row, colB) ((row) * 256 + ((colB) ^ (((row) & 7) << 4)))
#define SBAR() __builtin_amdgcn_sched_barrier(0)
__device__ __forceinline__ int v_st(int k, int c) { const int kk = (k & ~0xC) | ((k & 4) << 1) | ((k & 8) >> 1); return ((kk >> 3) * 4 + (c >> 5)) * 512 + ((kk & 7) * 32 + (c & 31)) * 2; }
__device__ __forceinline__ int v_rd_base(int lane) { return ((lane & 3) << 3) | (((lane >> 2) & 3) << 6) | (((lane >> 4) & 1) << 5) | (((lane >> 5) & 1) << 8); }
constexpr int v_rd_off(int d0, int ks, int half) { return d0 * 512 + ks * 4096 + half * 2048; }
__device__ __forceinline__ int crow(int r, int hi) { return (r & 3) + 8 * (r >> 2) + 4 * hi; }
__device__ __forceinline__ unsigned cvtpk(float lo, float hi) {
    unsigned r; asm volatile("v_cvt_pk_bf16_f32 %0, %1, %2" : "=v"(r) : "v"(lo), "v"(hi)); return r;
}
__device__ __forceinline__ bf16x8 pack8(f32x4 a, f32x4 b) {
    u32x4 w = {cvtpk(a[0], a[1]), cvtpk(a[2], a[3]), cvtpk(b[0], b[1]), cvtpk(b[2], b[3])};
    return *reinterpret_cast<bf16x8*>(&w);
}
template <class T> __device__ __forceinline__ bf16x8 load8(const T* p) {
    if constexpr (same_t<T, float>::v) { return pack8(*(const f32x4*)p, *(const f32x4*)(p + 4)); }
    else { return *reinterpret_cast<const bf16x8*>(p); }
}
__device__ __forceinline__ unsigned long long mask_word(const char* tile_base, int row) { unsigned off = (unsigned)row; asm volatile("" : "+v"(off)); off *= 1024u; return *(const unsigned long long*)(tile_base + off); }
__device__ __forceinline__ void mask_bits(f32x16& p0, f32x16& p1, unsigned long long mw, int hi) {
    const unsigned a = (unsigned)mw >> (4 * hi), b = (unsigned)(mw >> 32) >> (4 * hi);
#pragma unroll
    for (int r = 0; r < 16; ++r) {
        const int c = (r & 3) + 8 * (r >> 2);
        const unsigned ma = (unsigned)(((int)(a << (31 - c))) >> 31), mb = (unsigned)(((int)(b << (31 - c))) >> 31);
        p0[r] = __uint_as_float((__float_as_uint(p0[r]) & ma) | (0xff800000u & ~ma));
        p1[r] = __uint_as_float((__float_as_uint(p1[r]) & mb) | (0xff800000u & ~mb));
    }
}
__device__ __forceinline__ void partialSM(f32x16& p0, f32x16& p1, float& m_reg, float& mn, float& alpha) {
    float pmax = p0[0]; for (int r = 1; r < 16; ++r) pmax = fmaxf(pmax, p0[r]); for (int r = 0; r < 16; ++r) pmax = fmaxf(pmax, p1[r]);
    { auto rr = __builtin_amdgcn_permlane32_swap(__float_as_uint(pmax), __float_as_uint(pmax), false, false);
      pmax = fmaxf(__uint_as_float(rr[0]), __uint_as_float(rr[1])); }
    constexpr float C2 = 1.4426950408889634f * SCALE;
    if (__builtin_expect(__all((pmax - m_reg) * SCALE <= THR), 1)) { mn = m_reg; alpha = 1.f; }
    else { mn = fmaxf(m_reg, pmax); alpha = __builtin_amdgcn_exp2f((m_reg - mn) * C2); m_reg = mn; }
    const float mnL = -mn * C2;
    for (int r = 0; r < 16; ++r) p0[r] = fmaf(p0[r], C2, mnL); for (int r = 0; r < 16; ++r) p1[r] = fmaf(p1[r], C2, mnL);
    for (int r = 0; r < 16; ++r) p0[r] = __builtin_amdgcn_exp2f(p0[r]);
}
__device__ __forceinline__ void finishSM(f32x16& p0, f32x16& p1, float alpha, float& l_reg, bf16x8& pa0, bf16x8& pa1, bf16x8& pa2, bf16x8& pa3) {
    for (int r = 0; r < 16; ++r) p1[r] = __builtin_amdgcn_exp2f(p1[r]);
    float ps = 0; for (int r = 0; r < 16; ++r) ps += p0[r]; for (int r = 0; r < 16; ++r) ps += p1[r];
    { auto rr = __builtin_amdgcn_permlane32_swap(__float_as_uint(ps), __float_as_uint(ps), false, false);
      ps = __uint_as_float(rr[0]) + __uint_as_float(rr[1]); }
    l_reg = l_reg * alpha + ps;
#define PK4(P, B_, OUT) do { unsigned a0 = cvtpk(P[B_+0], P[B_+1]), a1 = cvtpk(P[B_+2], P[B_+3]);                          \
        unsigned b0 = cvtpk(P[B_+4], P[B_+5]), b1 = cvtpk(P[B_+6], P[B_+7]);                                             \
        auto r0 = __builtin_amdgcn_permlane32_swap(a0, b0, false, false); auto r1 = __builtin_amdgcn_permlane32_swap(a1, b1, false, false); \
        u32x4 w = {r0[0], r1[0], r0[1], r1[1]}; OUT = *reinterpret_cast<bf16x8*>(&w); } while (0)
    PK4(p0, 0, pa0); PK4(p0, 8, pa1); PK4(p1, 0, pa2); PK4(p1, 8, pa3);
#undef PK4
}
template <int KB, bool SK>
__device__ __forceinline__ void qkt(f32x16& p0, f32x16& p1, const char* K_lds, int r32, int hi, const bf16x8* qr, bool act) {
    if (SK && !act) { const float NEG = -__builtin_inff();
#pragma unroll
        for (int r = 0; r < 16; ++r) { p0[r] = NEG; p1[r] = NEG; } return; }
    p0 = f32x16{}; p1 = f32x16{};
    const char* kb[4];
#pragma unroll
    for (int dd = 0; dd < 4; ++dd) kb[dd] = K_lds + KB * SHM_K + KSWZ(r32, (dd * 16 + hi * 8) * 2);
#pragma unroll
    for (int d0 = 0; d0 < 8; ++d0) { const char* a = kb[d0 & 3] + (d0 >> 2) * 128;
        bf16x8 b0 = *reinterpret_cast<const bf16x8*>(a);
        bf16x8 b1 = *reinterpret_cast<const bf16x8*>(a + 32 * 256);
        p0 = __builtin_amdgcn_mfma_f32_32x32x16_bf16(b0, qr[d0], p0, 0, 0, 0);
        p1 = __builtin_amdgcn_mfma_f32_32x32x16_bf16(b1, qr[d0], p1, 0, 0, 0); }
}
template <int VB, bool SK>
__device__ __forceinline__ void pv_tile(f32x16* o, int vb0, bf16x8 pa0, bf16x8 pa1, bf16x8 pa2, bf16x8 pa3, bool act) {
    if (SK && !act) return;
#define TRRD(dst, off) asm volatile("ds_read_b64_tr_b16 %0, %1 offset:%2" : "=&v"(dst) : "v"(vb0), "i"(off) : "memory")
#define PV_D0(d0) do { s16x4 l0, l1, l2, l3, h0, h1, h2, h3; constexpr int b_ = VB * SHM_V + v_rd_off(d0, 0, 0);     \
        TRRD(l0, b_); TRRD(h0, b_ + 2048); TRRD(l1, b_ + 4096); TRRD(h1, b_ + 6144); TRRD(l2, b_ + 8192); TRRD(h2, b_ + 10240); TRRD(l3, b_ + 12288); TRRD(h3, b_ + 14336); \
        asm volatile("s_waitcnt lgkmcnt(0)" ::: "memory"); SBAR();                 \
        o[d0] = __builtin_amdgcn_mfma_f32_32x32x16_bf16(pa0, (bf16x8){l0[0], l0[1], l0[2], l0[3], h0[0], h0[1], h0[2], h0[3]}, o[d0], 0, 0, 0);   \
        o[d0] = __builtin_amdgcn_mfma_f32_32x32x16_bf16(pa1, (bf16x8){l1[0], l1[1], l1[2], l1[3], h1[0], h1[1], h1[2], h1[3]}, o[d0], 0, 0, 0);   \
        o[d0] = __builtin_amdgcn_mfma_f32_32x32x16_bf16(pa2, (bf16x8){l2[0], l2[1], l2[2], l2[3], h2[0], h2[1], h2[2], h2[3]}, o[d0], 0, 0, 0);   \
        o[d0] = __builtin_amdgcn_mfma_f32_32x32x16_bf16(pa3, (bf16x8){l3[0], l3[1], l3[2], l3[3], h3[0], h3[1], h3[2], h3[3]}, o[d0], 0, 0, 0); } while (0)
    PV_D0(0); PV_D0(1); PV_D0(2); PV_D0(3);
#undef PV_D0
#undef TRRD
}

template <class TIn, class TOut> struct BlockRef { const TIn* Q; const TIn* K; const TIn* V; TOut* O; const unsigned long long* M; int P0; };
template <class TIn> struct Seam {
    bf16x8 qr[8];
    bf16x8 st_v0, st_v1, st_k0, st_k1; f32x4 sf0, sf1, sf2, sf3;
    f32x4 tq[16];
};
__device__ __forceinline__ int swa_jlo(int P0, int W) { const int lowk = P0 - W + 1; return lowk > 0 ? lowk / KVBLK : 0; }
#define ROW(p, k0, rr) ((p) + (size_t)((k0) + (rr)) * LDQKV + sc)
#define VMW() asm volatile("s_waitcnt vmcnt(0)" ::: "memory")
#define VMWN(n) asm volatile("s_waitcnt vmcnt(%0)" :: "i"(n) : "memory")
#define LD16U(base, off) (*reinterpret_cast<const bf16x8*>((const char*)(base) + (off)))
#define SLOAD_H(Kp, Vp, k0) do { const char* kb_ = (const char*)((Kp) + (size_t)(k0) * LDQKV); const char* vb_ = (const char*)((Vp) + (size_t)(k0) * LDQKV);                 \
                         S.st_v0 = LD16U(vb_, soff); S.st_v1 = LD16U(vb_ + (size_t)32 * LDQKV * 2, soff);                                  \
                         S.st_k0 = LD16U(kb_, soff); S.st_k1 = LD16U(kb_ + (size_t)32 * LDQKV * 2, soff); } while (0)
#define SWRITE_HK(bf) do { *(bf16x8*)(K_lds + (bf) * SHM_K + kws) = S.st_k0; *(bf16x8*)(K_lds + (bf) * SHM_K + kws + 32 * 256) = S.st_k1; } while (0)
#define SWRITE_HV(bf) do { *(bf16x8*)(V_lds + (bf) * SHM_V + vst0) = S.st_v0; *(bf16x8*)(V_lds + (bf) * SHM_V + vst1) = S.st_v1; } while (0)
#define SWRITE_H(bf) do { SWRITE_HV(bf); SWRITE_HK(bf); } while (0)
#define SLOAD_F(p, k0) do { S.sf0 = *(const f32x4*)ROW(p, k0, sr); S.sf1 = *(const f32x4*)(ROW(p, k0, sr) + 4);                \
                            S.sf2 = *(const f32x4*)ROW(p, k0, 32 + sr); S.sf3 = *(const f32x4*)(ROW(p, k0, 32 + sr) + 4); } while (0)
#define SWRITE_KF(bf) do { *(bf16x8*)(K_lds + (bf) * SHM_K + kws) = pack8(S.sf0, S.sf1); *(bf16x8*)(K_lds + (bf) * SHM_K + kws + 32 * 256) = pack8(S.sf2, S.sf3); } while (0)
#define SWRITE_VF(bf) do { *(bf16x8*)(V_lds + (bf) * SHM_V + vst0) = pack8(S.sf0, S.sf1); *(bf16x8*)(V_lds + (bf) * SHM_V + vst1) = pack8(S.sf2, S.sf3); } while (0)
template <class TIn, class TOut>
__device__ __forceinline__ void causal_swa_prime(const BlockRef<TIn, TOut>& cur, int W, char* lds, Seam<TIn>& S) {
    constexpr bool F32 = same_t<TIn, float>::v;
    int tid_o = my_tid(); asm volatile("" : "+v"(tid_o));
    const int tid = tid_o, wid = __builtin_amdgcn_readfirstlane(tid >> 6), lane = tid & 63, r32 = lane & 31, hi = lane >> 5;
    const int sr = tid >> 4, sc = (tid & 15) * 8, kws = KSWZ(sr, sc * 2); char* K_lds = lds + 2 * SHM_V; const unsigned soff = (unsigned)(sr * LDQKV + sc) * 2u;
    const int kb0 = swa_jlo(cur.P0, W) * KVBLK;
    for (int d0 = 0; d0 < 8; ++d0) S.qr[d0] = load8<TIn>(cur.Q + (size_t)(wid * QBLK + r32) * LDQKV + d0 * 16 + hi * 8);
    if constexpr (F32) { SLOAD_F((const float*)cur.K, kb0); VMW(); SWRITE_KF(0); SBAR(); SLOAD_F((const float*)cur.V, kb0); }
    else { SLOAD_H(cur.K, cur.V, kb0); VMW(); SWRITE_HK(0); }
    __syncthreads();
}
template <class TIn, class TOut>
__device__ __forceinline__ void causal_swa_block(const BlockRef<TIn, TOut>& cur, const BlockRef<TIn, TOut>& nxt, int skv, int W, char* lds, Seam<TIn>& S) {
    constexpr bool F32 = same_t<TIn, float>::v;
    int tid_o = my_tid(); asm volatile("" : "+v"(tid_o));
    const int tid = tid_o, wid = __builtin_amdgcn_readfirstlane(tid >> 6), lane = tid & 63, r32 = lane & 31, hi = lane >> 5;
    const int j_lo = swa_jlo(cur.P0, W);
    int j_hi = (cur.P0 + QB - 1) / KVBLK + 1; if (j_hi > skv / KVBLK) j_hi = skv / KVBLK;
    const int NT = j_hi - j_lo;
    const int kbn = swa_jlo(nxt.P0, W) * KVBLK;
    const int qlo = cur.P0 + wid * QBLK, qm = qlo + r32 - 4 * hi;
    char* V_lds = lds; char* K_lds = lds + 2 * SHM_V;
    float* ws = (float*)(lds + 2 * SHM_V + 2 * SHM_K) + wid * 64; float* li_l = ws, * al_l = ws + 32;
    float m_reg = -1e30f, l_reg = 0; f32x16 o[4] = {};
    const unsigned soff = (unsigned)((tid >> 4) * LDQKV + (tid & 15) * 8) * 2u;
    const int sr = tid >> 4, sc = (tid & 15) * 8, vst0 = v_st(sr, sc), vst1 = v_st(32 + sr, sc), kws = KSWZ(sr, sc * 2);
    const int vb0 = (int)(uintptr_t)V_lds + v_rd_base(lane);
    const TIn* Kh = cur.K; const TIn* Vh = cur.V;
#define RESC(a) do { if (__any((a) < 1.f)) { if (hi == 0) al_l[r32] = (a); asm volatile("s_waitcnt lgkmcnt(0)" ::: "memory");              \
                     for (int d_ = 0; d_ < 4; ++d_) for (int r = 0; r < 16; ++r) o[d_][r] *= al_l[crow(r, hi)]; } } while (0)
#define KBASE(t) ((j_lo + (t)) * KVBLK)
#define ACT(t) (KBASE(t) <= qlo + QBLK - 1 && KBASE(t) + KVBLK - 1 >= qlo - W + 1)
#define MASKT(P0_, P1_, mw_) mask_bits(P0_, P1_, mw_, hi)
#define MLOAD(t) mask_word((const char*)cur.M + (size_t)((j_lo + (t)) * 8), wid * QBLK + r32)
    constexpr int NQL = F32 ? 16 : 8;
    constexpr bool SK = WSKIP && !F32;
#define SEAM_K0() do { VMWN(NQL); if constexpr (F32) { SWRITE_KF(0); SBAR(); SLOAD_F((const float*)nxt.V, kbn); } else { SWRITE_HK(0); } SBAR(); } while (0)
    f32x16 pA0, pA1, pB0, pB1; float mnA, mnB, alA, alB; bf16x8 pa0, pa1, pa2, pa3;
    if constexpr (F32) { VMW(); SWRITE_VF(0); SBAR(); } else { SWRITE_HV(0); SBAR(); }
    if (NT > 1) { if constexpr (F32) SLOAD_F((const float*)Kh, KBASE(1)); else SLOAD_H(Kh, Vh, KBASE(1)); }
    SBAR(); qkt<0, SK>(pA0, pA1, K_lds, r32, hi, S.qr, ACT(0));
    if constexpr (F32) { if (NT > 1) { VMW(); SWRITE_KF(1); SBAR(); SLOAD_F((const float*)Vh, KBASE(1)); } }
    MASKT(pA0, pA1, MLOAD(0)); partialSM(pA0, pA1, m_reg, mnA, alA);
    if (NT > 1) { VMW(); if constexpr (F32) { SWRITE_VF(1); SBAR(); if (NT > 2) SLOAD_F((const float*)Kh, KBASE(2)); } else SWRITE_H(1); }
    __syncthreads();
#define HALF_STEP(PX0, PX1, mnX, alX, PY0, PY1, alY, t, KB, VB, SB) do {                                                      \
        SBAR(); qkt<KB, SK>(PX0, PX1, K_lds, r32, hi, S.qr, ACT(t));                                             \
        finishSM(PY0, PY1, alY, l_reg, pa0, pa1, pa2, pa3); SBAR();                                                           \
        if ((t) + 1 < NT) { if constexpr (F32) { VMW(); SWRITE_KF(SB); SBAR(); SLOAD_F((const float*)Vh, KBASE((t) + 1)); }  \
                            else { SLOAD_H(Kh, Vh, KBASE((t) + 1)); } SBAR(); }                                               \
        pv_tile<VB, SK>(o, vb0, pa0, pa1, pa2, pa3, ACT((t) - 1)); MASKT(PX0, PX1, MLOAD(t)); partialSM(PX0, PX1, m_reg, mnX, alX);                                        \
        __syncthreads();                                                                                                      \
        if ((t) + 1 < NT) { VMW(); if constexpr (F32) { SWRITE_VF(SB); SBAR(); if ((t) + 2 < NT) SLOAD_F((const float*)Kh, KBASE((t) + 2)); } \
                            else { SWRITE_H(SB); } }                                                                          \
        RESC(alX); __syncthreads(); } while (0)
    for (int t = 1; t + 1 < NT; t += 2) {
        HALF_STEP(pB0, pB1, mnB, alB, pA0, pA1, alA, t, 1, 0, 0);
        HALF_STEP(pA0, pA1, mnA, alA, pB0, pB1, alB, t + 1, 0, 1, 1);
    }
    const bool even = (NT & 1) == 0;
    if (even) { SBAR(); qkt<1, SK>(pB0, pB1, K_lds, r32, hi, S.qr, ACT(NT - 1)); SBAR(); }
#define QROW(e) (nxt.Q + (size_t)(wid * QBLK + r32) * LDQKV + ((e) >> 1) * 16 + hi * 8 + ((e) & 1) * 4)
    if constexpr (F32) { SLOAD_F((const float*)nxt.K, kbn); SBAR();
#pragma unroll
        for (int e = 0; e < 8; ++e) S.tq[e] = *(const f32x4*)QROW(e); }
    else { SLOAD_H(nxt.K, nxt.V, kbn); SBAR();
#pragma unroll
        for (int d0 = 0; d0 < 8; ++d0) S.qr[d0] = load8<TIn>(nxt.Q + (size_t)(wid * QBLK + r32) * LDQKV + d0 * 16 + hi * 8); }
    SBAR();
    finishSM(pA0, pA1, alA, l_reg, pa0, pa1, pa2, pa3); SBAR();
    if constexpr (F32) {
#pragma unroll
        for (int e = 8; e < 16; ++e) S.tq[e] = *(const f32x4*)QROW(e); SBAR(); }
#undef QROW
    pv_tile<0, SK>(o, vb0, pa0, pa1, pa2, pa3, ACT(even ? NT - 2 : NT - 1));
    if (even) { MASKT(pB0, pB1, MLOAD(NT - 1)); partialSM(pB0, pB1, m_reg, mnB, alB); __syncthreads(); RESC(alB);
        finishSM(pB0, pB1, alB, l_reg, pa0, pa1, pa2, pa3); SBAR(); pv_tile<1, SK>(o, vb0, pa0, pa1, pa2, pa3, ACT(NT - 1)); }
    SBAR(); SEAM_K0();
    if (hi == 0) li_l[r32] = l_reg; asm volatile("s_waitcnt lgkmcnt(0)" ::: "memory");
    float rli[16];
#pragma unroll
    for (int r = 0; r < 16; ++r) rli[r] = __builtin_amdgcn_rcpf(li_l[crow(r, hi)]);
    TOut* Ow = cur.O + (size_t)(wid * QBLK) * LDO;
#pragma unroll
    for (int r = 0; r < 16; ++r) { const int orow = crow(r, hi);
#pragma unroll
        for (int d0 = 0; d0 < 4; ++d0) { const float v = o[d0][r] * rli[r];
            if constexpr (same_t<TOut, float>::v) { Ow[(size_t)orow * LDO + d0 * 32 + r32] = v; }
            else { const float vn = __builtin_bit_cast(float, __builtin_amdgcn_update_dpp(0, __builtin_bit_cast(int, v), 0xB1, 0xf, 0xf, false));
                   if ((r32 & 1) == 0) *(unsigned*)(Ow + (size_t)orow * LDO + d0 * 32 + r32) = cvtpk(v, vn); } } }
    if constexpr (F32) {
#pragma unroll
        for (int d0 = 0; d0 < 8; ++d0) S.qr[d0] = pack8(S.tq[2 * d0], S.tq[2 * d0 + 1]); }
    __syncthreads();
#undef RESC
#undef KBASE
#undef ACT
#undef MASKT
#undef MLOAD
#undef SEAM_K0
#undef HALF_STEP
}
#undef ROW
#undef VMW
#undef VMWN
#undef SLOAD_H
#undef LD16U
#undef SWRITE_HK
#undef SWRITE_HV
#undef SWRITE_H
#undef SLOAD_F
#undef SWRITE_KF
#undef SWRITE_VF

}


template <int NC> __device__ __forceinline__ void scan_elems(const bf16* __restrict__ delta, bf16* __restrict__ prev, size_t cstride, const LAS float* dec, const LAS float* inj) {
    f32x4 st = (f32x4){0.f, 0.f, 0.f, 0.f};
#pragma unroll 8
    for (int c = 0; c < NC; ++c) { const v2u x = *(const GAS v2u*)(delta + (size_t)c * cstride);
        v2u o; o.x = pk2(st[0], st[1]); o.y = pk2(st[2], st[3]); *(GAS v2u*)(prev + (size_t)c * cstride) = o;
        const float d = dec[c], j = inj[c];
        st[0] = d * st[0] + j * __uint_as_float(x.x << 16); st[1] = d * st[1] + j * __uint_as_float(x.x & 0xffff0000u);
        st[2] = d * st[2] + j * __uint_as_float(x.y << 16); st[3] = d * st[3] + j * __uint_as_float(x.y & 0xffff0000u); }
}

struct Args {
    const float* x; const float* norm_mix; const float* norm_ffn; const float* w_in; const float* att_q_norm; const float* att_k_norm; const float* mlstm_conv; const float* mlstm_gate_bias;
    const float* mlstm_out_norm; const float* ret_out_norm; const float* w_b_att; const float* w_b_mlstm; const float* w_b_ret; const float* w_out; const float* w_ffn_in; const float* w_ffn_out;
    float* out; unsigned char* ws; int layer_lo, layer_hi, ph_lo, ph_hi;
};
constexpr int PH_PER_LAYER = 16;
__device__ __forceinline__ float ret_lngamma(int hd) { return log1pf(-exp2f(-5.0f - (float)hd)); }
#define PHASE_FN static __device__ __forceinline__ void
#define OPAQUE_PTR(p) asm volatile("" : "+s"(p))
#define WS_PTRS(ws) OPAQUE_PTR(ws); \
    bf16* const H = (bf16*)((ws) + WS_H); bf16* const PROJ = (bf16*)((ws) + WS_PROJ); float* const SMALL = (float*)((ws) + WS_SMALL); bf16* const MQK = (bf16*)((ws) + WS_MQK); \
    bf16* const IKB = (bf16*)((ws) + WS_IKB); float* const IWF = (float*)((ws) + WS_IWF); float* const GIF = (float*)((ws) + WS_GIF); float* const SC = (float*)((ws) + WS_SC); \
    unsigned long long* const MB = (unsigned long long*)((ws) + WS_MB); bf16* const DCM = (bf16*)((ws) + WS_DCM); bf16* const CPM = (bf16*)((ws) + WS_CPM); \
    float* const DN = (float*)((ws) + WS_MISC + MISC_DN); float* const NPREV = (float*)((ws) + WS_MISC + MISC_NPREV); float* const AB = (float*)((ws) + WS_MISC + MISC_AB); float* const MPREV = (float*)((ws) + WS_MISC + MISC_MPREV); \
    bf16* const DRR = (bf16*)((ws) + WS_DRR); bf16* const RPR = (bf16*)((ws) + WS_RPR); bf16* const YA = (bf16*)((ws) + WS_YA); bf16* const YM = (bf16*)((ws) + WS_YM); bf16* const YR = (bf16*)((ws) + WS_YR); \
    float* const MERGEDF = (float*)((ws) + WS_MERGEDF); bf16* const MERGED = (bf16*)((ws) + WS_MERGED); bf16* const ACT = (bf16*)((ws) + WS_ACT); \
    float* const ROPE128 = (float*)((ws) + WS_ROPE128); float* const ROPE64 = (float*)((ws) + WS_ROPE64); \
    (void)H; (void)PROJ; (void)SMALL; (void)MQK; (void)IKB; (void)IWF; (void)GIF; (void)SC; (void)MB; (void)DCM; (void)CPM; (void)DN; (void)NPREV; (void)AB; (void)MPREV; (void)DRR; (void)RPR; (void)YA; (void)YM; (void)YR; \
    (void)MERGEDF; (void)MERGED; (void)ACT; (void)ROPE128; (void)ROPE64
#define TIDS() int tid_ = my_tid(); asm volatile("" : "+v"(tid_)); int bx_ = blockIdx.x; asm volatile("" : "+s"(bx_));   \
    const int tid = tid_, lane = tid & 63, wave = __builtin_amdgcn_readfirstlane(tid >> 6); const int G = gridDim.x, bx = bx_; const int gw = bx * NWAVES + wave, NGW = G * NWAVES; \
    (void)lane; (void)wave; (void)gw; (void)NGW; (void)G; (void)bx

constexpr int CV_IN = 32 * 268, CV_B = 16 * 32, CV_OUT = 32 * 32, CV_FIN = 32 * 176, CV_FOUT = 88 * 32, CV_ITEMS = CV_IN + 3 * CV_B + CV_OUT + CV_FIN + CV_FOUT;
__device__ __forceinline__ void convert_layer_items(LAS float* scr, unsigned char* ws, int l, const float* w_in, const float* w_b_att, const float* w_b_mlstm, const float* w_b_ret, const float* w_out, const float* w_ffn_in,
                                                    const float* w_ffn_out, int it0, int it1, int wv, int nwv, int lane) {
    unsigned char* wl = ws + WS_W + (size_t)l * W_LAYER;
    for (int it = it0 + wv; it < it1; it += nwv) { int r = it;
        if (r < CV_IN) { transpose_item(w_in + (size_t)l * DM * LPROJ, DM, LPROJ, (bf16*)(wl + WO_IN), scr, r, NPROJ_PAD / 64, lane, MapWin()); continue; } r -= CV_IN;
        if (r < CV_B) { transpose_item(w_b_att + (size_t)l * 1024 * DM, 1024, DM, (bf16*)(wl + WO_B), scr, r, DM / 64, lane, MapIdent()); continue; } r -= CV_B;
        if (r < CV_B) { transpose_item(w_b_mlstm + (size_t)l * 1024 * DM, 1024, DM, (bf16*)(wl + WO_B + 4 * MiB), scr, r, DM / 64, lane, MapIdent()); continue; } r -= CV_B;
        if (r < CV_B) { transpose_item(w_b_ret + (size_t)l * 1024 * DM, 1024, DM, (bf16*)(wl + WO_B + 8 * MiB), scr, r, DM / 64, lane, MapIdent()); continue; } r -= CV_B;
        if (r < CV_OUT) { transpose_item(w_out + (size_t)l * DM * DM, DM, DM, (bf16*)(wl + WO_OUT), scr, r, DM / 64, lane, MapIdent()); continue; } r -= CV_OUT;
        if (r < CV_FIN) { transpose_item(w_ffn_in + (size_t)l * DM * 2 * FF, DM, 2 * FF, (bf16*)(wl + WO_FIN), scr, r, 2 * FF / 64, lane, MapFfn()); continue; } r -= CV_FIN;
        transpose_item(w_ffn_out + (size_t)l * FF * DM, FF, DM, (bf16*)(wl + WO_FOUT), scr, r, DM / 64, lane, MapIdent()); }
}
PHASE_FN ph_prologue(LAS unsigned char* lds, unsigned char* ws, const float* w_in, const float* w_b_att, const float* w_b_mlstm, const float* w_b_ret, const float* w_out, const float* w_ffn_in, const float* w_ffn_out, bool all_layers) {
    TIDS(); WS_PTRS(ws);
    LAS float* scr = (LAS float*)(lds + wave * 16640);
    for (int l = 0; l < (all_layers ? DEPTH : 1); ++l) convert_layer_items(scr, ws, l, w_in, w_b_att, w_b_mlstm, w_b_ret, w_out, w_ffn_in, w_ffn_out, 0, CV_ITEMS, gw, NGW, lane);
    for (int i = gw * 64 + lane; i < S * 96; i += NGW * 64) {
        if (i < S * 64) { const int t = i >> 6, f = i & 63; const float inv = (float)pow(10000.0, -(double)f * 2.0 / 128.0); const float ang = (float)t * inv;
            ROPE128[2 * i] = (float)cos((double)ang); ROPE128[2 * i + 1] = (float)sin((double)ang); }
        else { const int k = i - S * 64, t = k >> 5, f = k & 31; const float inv = (float)pow(10000.0, -(double)f * 2.0 / 64.0); const float ang = (float)t * inv;
            ROPE64[2 * k] = (float)cos((double)ang); ROPE64[2 * k + 1] = (float)sin((double)ang); } }
}
PHASE_FN ph_convert_tail(LAS unsigned char* lds, unsigned char* ws, int l, const float* w_in, const float* w_b_att, const float* w_b_mlstm, const float* w_b_ret, const float* w_out, const float* w_ffn_in, const float* w_ffn_out,
                         int rem, int it0, int it1) {
    TIDS(); if (rem <= 0 || rem >= G || bx < rem) return;
    LAS float* scr = (LAS float*)(lds + wave * 16640);
    convert_layer_items(scr, ws, l, w_in, w_b_att, w_b_mlstm, w_b_ret, w_out, w_ffn_in, w_ffn_out, it0, it1, (bx - rem) * NWAVES + wave, (G - rem) * NWAVES, lane);
    __syncthreads(); }
PHASE_FN ph_rmsnorm(const float* xin, const float* gain, bf16* Hout) { TIDS(); for (int m = gw; m < S; m += NGW) rms_row_to_bf16(xin + (size_t)m * DM, gain, Hout + (size_t)m * DM, lane); }
PHASE_FN ph_gemm_proj(LAS unsigned char* lds, unsigned char* ws, const bf16* Wt) { TIDS(); WS_PTRS(ws);
    pg8::Gemm g{H, Wt, S, NPROJ_PAD, DM}; pg8::StaticOrder so; so.init(S, NPROJ_PAD, G, bx); pg8::EpiProj E{PROJ, NPROJ, SMALL, PC_G / 256, NPROJ / 256};
    pg8::gemm_phase<pg8::EpiProj, pg8::StaticOrder, true, true>(lds, g, so, E); }
PHASE_FN ph_pp(unsigned char* ws, const float* gq, const float* gk, const float* convw, const float* gbias) { TIDS(); WS_PTRS(ws);
    PPArgs a{PROJ, SMALL, MQK, IKB, IWF, GIF, ROPE128, ROPE64, gq, gk, convw, gbias};
    for (int m = gw; m < S; m += NGW) pp_row(a, m, lane); }
PHASE_FN ph_scores(unsigned char* ws) { TIDS(); WS_PTRS(ws);
    for (int u = gw; u < 8320; u += NGW) { int g = (int)((sqrtf(1.0f + 2.0f * (float)u) - 1.0f) * 0.5f); while (2 * (g + 1) * (g + 2) <= u) ++g; while (2 * g * (g + 1) > u) --g;
        const int r = u - 2 * g * (g + 1); score_wave_unit(PROJ, IKB, IWF, SC, 4 * g + r / (g + 1), r % (g + 1), lane); } }
PHASE_FN ph_deltas(LAS unsigned char* lds, unsigned char* ws) { TIDS(); WS_PTRS(ws); LAS float* const sf = (LAS float*)(lds + SCR_OFF);
    for (int u = bx; u < 1024; u += G) {
        if (u < 512) { const int hd = u >> 7, c = u & 127, t0 = c * 64;
            if (wave == 0) { const float iv = GIF[(size_t)(t0 + lane) * 8 + hd], fv = GIF[(size_t)(t0 + lane) * 8 + 4 + hd]; float b = log_sigmoid_f(fv);
                b = wave_prefix_sum_f(b);
                const float bend = __builtin_bit_cast(float, __builtin_amdgcn_readlane(__builtin_bit_cast(int, b), 63)), gl = bend - b + iv, A = wave_max(gl);
                sf[lane] = __expf(gl - A); if (lane == 0) { AB[(hd * 128 + c) * 2] = A; AB[(hd * 128 + c) * 2 + 1] = bend; } }
            __syncthreads();
            chunk_delta<64, 256>(lds, MQK + (size_t)t0 * 1024 + 512 + hd * 128, 1024, PROJ + (size_t)t0 * NPROJ + PC_MV + hd * 256, NPROJ, sf, DCM + (size_t)(hd * 128 + c) * 32768, DN + (hd * 128 + c) * 128, tid);
        } else { const int v = u - 512, hd = v >> 6, c = v & 63, t0 = c * 128; const float lg = ret_lngamma(hd);
            if (tid < 128) sf[tid] = __expf(lg * (float)(127 - tid));
            __syncthreads();
            chunk_delta<128, 128>(lds, PROJ + (size_t)t0 * NPROJ + PC_RK + hd * 128, NPROJ, PROJ + (size_t)t0 * NPROJ + PC_RV + hd * 128, NPROJ, sf, DRR + (size_t)(hd * 64 + c) * 16384, nullptr, tid); }
    } }
PHASE_FN ph_select(LAS unsigned char* lds, unsigned char* ws) { TIDS(); WS_PTRS(ws); select_rows_wg(lds, SC, MB, bx, G, tid); }
PHASE_FN ph_scans(LAS unsigned char* lds, unsigned char* ws) { TIDS(); WS_PTRS(ws); LAS float* const sf = (LAS float*)(lds + SCR_OFF);
    for (int u = bx; u < 128; u += G) {
        LAS float* dec = sf; LAS float* inj = sf + 128; LAS float* av = sf + 256; LAS float* bv = sf + 384;
        if (u < 64) { const int hd = u >> 4, p = u & 15;
            if (tid < 128) { av[tid] = AB[(hd * 128 + tid) * 2]; bv[tid] = AB[(hd * 128 + tid) * 2 + 1]; }
            __syncthreads();
            if (tid == 0) { float m = 0.f; for (int c = 0; c < 128; ++c) { const float mn = fmaxf(bv[c] + m, av[c]); dec[c] = __expf(bv[c] + m - mn); inj[c] = __expf(av[c] - mn); if (p == 0) MPREV[hd * 128 + c] = m; m = mn; } }
            __syncthreads();
            const size_t e4 = (size_t)hd * 128 * 32768 + p * 2048 + tid * 4;
            scan_elems<128>(DCM + e4, CPM + e4, 32768, dec, inj);
            if (p == 0 && tid < 128) { float st = 0.f; for (int c = 0; c < 128; ++c) { NPREV[(hd * 128 + c) * 128 + tid] = st; st = dec[c] * st + inj[c] * DN[(hd * 128 + c) * 128 + tid]; } }
        } else { const int v = u - 64, hd = v >> 3, p = v & 7; const float dg = __expf(128.0f * ret_lngamma(hd));
            if (tid < 64) { dec[tid] = dg; inj[tid] = 1.0f; }
            __syncthreads();
            const size_t e4 = (size_t)hd * 64 * 16384 + p * 2048 + tid * 4;
            scan_elems<64>(DRR + e4, RPR + e4, 16384, dec, inj); }
        __syncthreads(); } }
PHASE_FN ph_attention(char* alds, unsigned char* ws) { TIDS(); WS_PTRS(ws);
    typedef att::BlockRef<bf16, bf16> BR; att::Seam<bf16> seam;
#define ATT_REF(r, item_, pass_) do { const int hd_ = (item_) >> 4, y_ = (item_) & 15, qb_ = (pass_) ? 31 - y_ : y_; \
        (r).Q = PROJ + (size_t)qb_ * 256 * NPROJ + PC_AQ + hd_ * 128; (r).K = PROJ + PC_AK + hd_ * 128; (r).V = PROJ + PC_AV + hd_ * 128; (r).O = YA + (size_t)qb_ * 256 * 1024 + hd_ * 128; \
        (r).M = MB + (size_t)qb_ * 256 * 128; (r).P0 = qb_ * 256; } while (0)
    if (bx < 128) { int item = bx, pass = 0; BR cur; ATT_REF(cur, item, 0); att::causal_swa_prime<bf16, bf16>(cur, 1 << 30, alds, seam);
        for (;;) { const bool more_pass = pass == 0, more_item = item + G < 128, last = !more_pass && !more_item;
            int itn = item, pn = pass + 1; if (!more_pass) { pn = 0; itn = more_item ? item + G : item; }
            BR nxt = cur; if (!last) ATT_REF(nxt, itn, pn);
            att::causal_swa_block<bf16, bf16>(cur, nxt, S, 1 << 30, alds, seam);
            if (last) break; cur = nxt; item = itn; pass = pn; } }
    __syncthreads(); }
PHASE_FN ph_outs(LAS unsigned char* lds, unsigned char* ws, const float* gain_m, const float* gain_r, int u0, int ustep) { TIDS(); WS_PTRS(ws); LAS float* const sf = (LAS float*)(lds + SCR_OFF);
    for (int u = u0; u < 1024; u += ustep) {
        if (u < 512) { const int hd = u >> 7, c = u & 127, t0 = c * 64;
            if (wave == 0) { const float iv = GIF[(size_t)(t0 + lane) * 8 + hd], fv = GIF[(size_t)(t0 + lane) * 8 + 4 + hd]; float b = log_sigmoid_f(fv);
                b = wave_prefix_sum_f(b);
                const float mp = MPREV[hd * 128 + c]; const float pm = wave_prefix_max_f(iv - b);
                const float mt = fmaxf(b + mp, b + pm);
                sf[lane] = b - mt; sf[128 + lane] = iv - b; sf[256 + lane] = __expf(b + mp - mt); sf[384 + lane] = __expf(-mt); sf[512 + lane] = 0.f; }
            if (wave == 1) { sf[640 + lane] = NPREV[(hd * 128 + c) * 128 + lane]; sf[640 + 64 + lane] = NPREV[(hd * 128 + c) * 128 + 64 + lane]; }
            __syncthreads();
            chunk_out<64, 256, 0>(lds, sf, MQK + (size_t)t0 * 1024 + hd * 128, 1024, MQK + (size_t)t0 * 1024 + 512 + hd * 128, 1024, PROJ + (size_t)t0 * NPROJ + PC_MV + hd * 256, NPROJ,
                                  CPM + (size_t)(hd * 128 + c) * 32768, gain_m + hd * 256, PROJ + (size_t)t0 * NPROJ + PC_MO + hd * 256, NPROJ, YM + (size_t)t0 * 1024 + hd * 256, 1024, tid);
        } else { const int v = u - 512, hd = v >> 6, c = v & 63, t0 = c * 128; const float lg = ret_lngamma(hd);
            if (tid < 128) { sf[tid] = lg * (float)tid; sf[128 + tid] = -lg * (float)tid; sf[256 + tid] = __expf(lg * (float)(tid + 1)); }
            __syncthreads();
            chunk_out<128, 128, 1>(lds, sf, PROJ + (size_t)t0 * NPROJ + PC_RQ + hd * 128, NPROJ, PROJ + (size_t)t0 * NPROJ + PC_RK + hd * 128, NPROJ, PROJ + (size_t)t0 * NPROJ + PC_RV + hd * 128, NPROJ,
                                   RPR + (size_t)(hd * 64 + c) * 16384, gain_r + hd * 128, PROJ + (size_t)t0 * NPROJ + PC_RG + hd * 128, NPROJ, YR + (size_t)t0 * 1024 + hd * 128, 1024, tid); }
    } }
template <int MODE> PHASE_FN ph_gemm_branch(LAS unsigned char* lds, unsigned char* ws, const bf16* A, const bf16* Wt, int gcol) { TIDS(); WS_PTRS(ws);
    pg8::Gemm g{A, Wt, S, DM, 1024}; pg8::StaticOrder so; so.init(S, DM, G, bx); pg8::EpiBranch<MODE> E{PROJ + PC_G + gcol, NPROJ, MERGEDF, MERGED, DM};
    pg8::gemm_phase<pg8::EpiBranch<MODE>, pg8::StaticOrder, true, true>(lds, g, so, E); }
PHASE_FN ph_gemm_resid(LAS unsigned char* lds, const bf16* A, const bf16* Wt, int K, const float* base, float* out) { TIDS();
    pg8::Gemm g{A, Wt, S, DM, K}; pg8::StaticOrder so; so.init(S, DM, G, bx); pg8::EpiResid E{base, out, DM};
    pg8::gemm_phase<pg8::EpiResid, pg8::StaticOrder, true, true>(lds, g, so, E); }
PHASE_FN ph_gemm_ffn_in(LAS unsigned char* lds, unsigned char* ws, const bf16* Wt) { TIDS(); WS_PTRS(ws);
    pg8::Gemm g{H, Wt, S, 2 * FF, DM}; pg8::StaticOrder so; so.init(S, 2 * FF, G, bx); pg8::EpiSwiGLU E{ACT, FF};
    pg8::gemm_phase<pg8::EpiSwiGLU, pg8::StaticOrder, true, true>(lds, g, so, E); }


#ifndef SYN_PROBE
#define SYN_PROBE 0
#endif
PHASE_FN ph_probe(LAS unsigned char* lds) { TIDS();
    LAS unsigned* hist = (LAS unsigned*)lds;
    if (SYN_PROBE == 1) {
        unsigned x = (unsigned)tid * 2654435761u + 12345u;
        for (int r = 0; r < 32; ++r) {
#pragma unroll
            for (int i = 0; i < 16; ++i) { x = x * 1664525u + 1013904223u; (void)__hip_atomic_fetch_add(hist + ((x >> 10) & 2047u), 1u, __ATOMIC_RELAXED, __HIP_MEMORY_SCOPE_WORKGROUP); }
            SEL_BAR(); } }
    if (SYN_PROBE == 2) {
        float acc = 0.f; float v[16];
#pragma unroll
        for (int i = 0; i < 16; ++i) v[i] = (float)((tid * 16 + i) % 977);
        for (int r = 0; r < 32 * 8; ++r) { const float c1 = 100.f + (float)(r & 7) + acc * 1e-30f, c2 = c1 * 2.f, c3 = c1 * 3.f; unsigned n1 = 0, n2 = 0, n3 = 0;
#pragma unroll
            for (int i = 0; i < 16; ++i) { n1 += (unsigned)__builtin_popcountll(__builtin_amdgcn_ballot_w64(v[i] >= c1)); n2 += (unsigned)__builtin_popcountll(__builtin_amdgcn_ballot_w64(v[i] >= c2)); n3 += (unsigned)__builtin_popcountll(__builtin_amdgcn_ballot_w64(v[i] >= c3)); }
            if (lane == 0) { hist[(r & 1) * 24 + wave] = n1; hist[(r & 1) * 24 + 8 + wave] = n2; hist[(r & 1) * 24 + 16 + wave] = n3; }
            SEL_BAR();
            unsigned t1 = 0;
#pragma unroll
            for (int j = 0; j < 24; ++j) t1 += hist[(r & 1) * 24 + j];
            acc += (float)t1; }
        if (acc == 12345.f) hist[100] = 1u; }
    if (SYN_PROBE == 3) {
        float a = (float)tid;
        for (int r = 0; r < 32; ++r) {
#pragma unroll
            for (int k = 0; k < 4; ++k)
#pragma unroll
                for (int o = 1; o < 64; o <<= 1) a = fmaxf(a, shfl_idx_f(a, (int)(lane_id_v() ^ (unsigned)o)) * 0.999f);
        }
        if (a == 12345.f) hist[100] = 1u; }
    __syncthreads(); }
typedef const __attribute__((address_space(4))) Args* ArgsP;
__device__ __forceinline__ ArgsP fresh_args() { ArgsP ap = (ArgsP)__builtin_amdgcn_kernarg_segment_ptr(); asm volatile("" : "+s"(ap)); return ap; }
#ifndef DUP_PHASE
#define DUP_PHASE -1
#endif
#define SEAM() do { if constexpr (one_launch) { ArgsP ap_ = fresh_args(); XcdBarrier b_; b_.bar = (unsigned*)(ap_->ws + WS_CTL) + CW_BAR; b_.x = xb_xcc_id(); b_.st = (volatile LAS unsigned*)(lds + MISC_OFF); xcd_barrier(b_); } } while (0)
#define IN(k) (PLO <= (k) && (k) < PHI)
#define WL(ap, layer) ((ap)->ws + WS_W + (size_t)(layer) * W_LAYER)
template <int PLO, int PHI, bool LAST> __device__ __forceinline__ void layer_phases(const int layer, LAS unsigned char* lds, unsigned char* lds_raw) {
    constexpr bool one_launch = (PHI - PLO > 1);
    if constexpr (IN(1)) { ArgsP ap = fresh_args(); ph_rmsnorm(layer == 0 ? ap->x : ap->out, ap->norm_mix + layer * DM, (bf16*)(ap->ws + WS_H)); if constexpr (DUP_PHASE == 1) { SEAM(); ph_rmsnorm(layer == 0 ? ap->x : ap->out, ap->norm_mix + layer * DM, (bf16*)(ap->ws + WS_H)); } SEAM(); }
    constexpr int CV_S1 = 10880, CV_S2 = 10880;
    if constexpr (IN(2)) { ArgsP ap = fresh_args(); ph_gemm_proj(lds, ap->ws, (const bf16*)(WL(ap, layer) + WO_IN));
        if constexpr (one_launch && !LAST) { ArgsP aq = fresh_args(); ph_convert_tail(lds, aq->ws, layer + 1, aq->w_in, aq->w_b_att, aq->w_b_mlstm, aq->w_b_ret, aq->w_out, aq->w_ffn_in, aq->w_ffn_out, ((S / 256) * (NPROJ_PAD / 256)) % (int)gridDim.x, 0, CV_S1); } if constexpr (DUP_PHASE == 2) { SEAM(); ph_gemm_proj(lds, ap->ws, (const bf16*)(WL(ap, layer) + WO_IN)); } SEAM(); }
    if constexpr (IN(3)) { ArgsP ap = fresh_args(); ph_pp(ap->ws, ap->att_q_norm + layer * 128, ap->att_k_norm + layer * 128, ap->mlstm_conv + layer * 4096, ap->mlstm_gate_bias + layer * 8); if constexpr (DUP_PHASE == 3) { SEAM(); ph_pp(ap->ws, ap->att_q_norm + layer * 128, ap->att_k_norm + layer * 128, ap->mlstm_conv + layer * 4096, ap->mlstm_gate_bias + layer * 8); } SEAM(); }
    if constexpr (IN(4)) { ArgsP ap = fresh_args(); ph_scores(ap->ws); if constexpr (DUP_PHASE == 4) { SEAM(); ph_scores(ap->ws); } }
    if constexpr (IN(5)) { ArgsP ap = fresh_args(); ph_deltas(lds, ap->ws); if constexpr (DUP_PHASE == 5) { SEAM(); ph_deltas(lds, ap->ws); } SEAM(); }
    if constexpr (IN(6) && SYN_PROBE != 0) { ph_probe(lds); }
    if constexpr (IN(6)) { ArgsP ap = fresh_args(); ph_select(lds, ap->ws); if constexpr (DUP_PHASE == 6) { SEAM(); ph_select(lds, ap->ws); } }
    if constexpr (IN(7) && one_launch && !LAST) { ArgsP aq = fresh_args(); ph_convert_tail(lds, aq->ws, layer + 1, aq->w_in, aq->w_b_att, aq->w_b_mlstm, aq->w_b_ret, aq->w_out, aq->w_ffn_in, aq->w_ffn_out, 128, CV_S1, CV_S2); }
    if constexpr (IN(7)) { ArgsP ap = fresh_args(); ph_scans(lds, ap->ws); if constexpr (DUP_PHASE == 7) { SEAM(); ph_scans(lds, ap->ws); } SEAM(); }
    if constexpr (IN(8) && IN(9)) {
        ArgsP ap = fresh_args(); const bool split = gridDim.x == 256;
        if (!split || blockIdx.x < 128) ph_attention((char*)lds_raw, ap->ws);
        if (!split || blockIdx.x >= 128) ph_outs(lds, ap->ws, ap->mlstm_out_norm + layer * 1024, ap->ret_out_norm + layer * 1024, split ? (int)blockIdx.x - 128 : (int)blockIdx.x, split ? 128 : (int)gridDim.x);
        SEAM(); }
    else {
    if constexpr (IN(8)) { ArgsP ap = fresh_args(); ph_attention((char*)lds_raw, ap->ws); }
    if constexpr (IN(9)) { ArgsP ap = fresh_args(); ph_outs(lds, ap->ws, ap->mlstm_out_norm + layer * 1024, ap->ret_out_norm + layer * 1024, (int)blockIdx.x, (int)gridDim.x); SEAM(); }
    }
    if constexpr (IN(10)) { ArgsP ap = fresh_args(); ph_gemm_branch<0>(lds, ap->ws, (const bf16*)(ap->ws + WS_YA), (const bf16*)(WL(ap, layer) + WO_B), 0); if constexpr (DUP_PHASE == 10) { SEAM(); ph_gemm_branch<0>(lds, ap->ws, (const bf16*)(ap->ws + WS_YA), (const bf16*)(WL(ap, layer) + WO_B), 0); } }
    if constexpr (IN(11)) { ArgsP ap = fresh_args(); ph_gemm_branch<1>(lds, ap->ws, (const bf16*)(ap->ws + WS_YM), (const bf16*)(WL(ap, layer) + WO_B + 4 * MiB), DM); if constexpr (DUP_PHASE == 11) { SEAM(); ph_gemm_branch<1>(lds, ap->ws, (const bf16*)(ap->ws + WS_YM), (const bf16*)(WL(ap, layer) + WO_B + 4 * MiB), DM); } }
    if constexpr (IN(12)) { ArgsP ap = fresh_args(); ph_gemm_branch<2>(lds, ap->ws, (const bf16*)(ap->ws + WS_YR), (const bf16*)(WL(ap, layer) + WO_B + 8 * MiB), 2 * DM); if constexpr (DUP_PHASE == 12) { SEAM(); ph_gemm_branch<2>(lds, ap->ws, (const bf16*)(ap->ws + WS_YR), (const bf16*)(WL(ap, layer) + WO_B + 8 * MiB), 2 * DM); } SEAM(); }
    if constexpr (IN(13)) { ArgsP ap = fresh_args(); ph_gemm_resid(lds, (const bf16*)(ap->ws + WS_MERGED), (const bf16*)(WL(ap, layer) + WO_OUT), DM, layer == 0 ? ap->x : ap->out, ap->out); SEAM(); }
    if constexpr (IN(14)) { ArgsP ap = fresh_args(); ph_rmsnorm(ap->out, ap->norm_ffn + layer * DM, (bf16*)(ap->ws + WS_H)); if constexpr (DUP_PHASE == 14) { SEAM(); ph_rmsnorm(ap->out, ap->norm_ffn + layer * DM, (bf16*)(ap->ws + WS_H)); } SEAM(); }
    if constexpr (IN(15)) { ArgsP ap = fresh_args(); ph_gemm_ffn_in(lds, ap->ws, (const bf16*)(WL(ap, layer) + WO_FIN));
        if constexpr (one_launch && !LAST) { ArgsP aq = fresh_args(); ph_convert_tail(lds, aq->ws, layer + 1, aq->w_in, aq->w_b_att, aq->w_b_mlstm, aq->w_b_ret, aq->w_out, aq->w_ffn_in, aq->w_ffn_out, ((S / 256) * (2 * FF / 256)) % (int)gridDim.x, CV_S2, CV_ITEMS); } if constexpr (DUP_PHASE == 15) { SEAM(); ph_gemm_ffn_in(lds, ap->ws, (const bf16*)(WL(ap, layer) + WO_FIN)); } SEAM(); }
    if constexpr (IN(16)) { ArgsP ap = fresh_args(); ph_gemm_resid(lds, (const bf16*)(ap->ws + WS_ACT), (const bf16*)(WL(ap, layer) + WO_FOUT), FF, ap->out, ap->out); if constexpr (!LAST) SEAM(); }
}
template <int PLO, int PHI> __global__ void __launch_bounds__(NTHR, 2) fwd(Args args_unused) {
    (void)args_unused;
    extern __shared__ __attribute__((aligned(16))) unsigned char lds_raw[];
    LAS unsigned char* lds = (LAS unsigned char*)lds_raw;
    if (threadIdx.x < 64) ((volatile LAS unsigned*)(lds + MISC_OFF))[threadIdx.x] = 0u;
    if ((threadIdx.x & 63) == 0) ((volatile LAS unsigned*)(lds + MISC_OFF))[64 + ((unsigned)__builtin_amdgcn_s_getreg((5 << 11) | 4) & 63u)] = threadIdx.x >> 6;
    __syncthreads();
    constexpr bool one_launch = (PHI - PLO > 1);
    if constexpr (one_launch) { ArgsP ap = fresh_args(); (void)xcd_barrier_post((unsigned*)(ap->ws + WS_CTL) + CW_BAR, (volatile LAS unsigned*)(lds + MISC_OFF)); }
    if constexpr (PLO == 0) { ArgsP ap = fresh_args(); ph_prologue(lds, ap->ws, ap->w_in, ap->w_b_att, ap->w_b_mlstm, ap->w_b_ret, ap->w_out, ap->w_ffn_in, ap->w_ffn_out, !one_launch);
        if constexpr (DUP_PHASE == 0) { SEAM(); ph_prologue(lds, ap->ws, ap->w_in, ap->w_b_att, ap->w_b_mlstm, ap->w_b_ret, ap->w_out, ap->w_ffn_in, ap->w_ffn_out, !one_launch); }
        if (PHI > 1) SEAM(); }
    if constexpr (one_launch) { static_assert(DEPTH == 4, "four inlined layer sites");
        layer_phases<PLO, PHI, false>(0, lds, lds_raw); layer_phases<PLO, PHI, false>(1, lds, lds_raw); layer_phases<PLO, PHI, false>(2, lds, lds_raw); layer_phases<PLO, PHI, true>(3, lds, lds_raw); }
    else if constexpr (PLO > 0) { ArgsP ap = fresh_args(); layer_phases<PLO, PHI, true>(ap->layer_lo, lds, lds_raw); }
}
#undef IN
#undef SEAM
#undef WL

#ifndef ONE_LAUNCH
#define ONE_LAUNCH 1
#endif
typedef void (*kern_t)(Args);
template <int P> static kern_t phase_kernel(int p) { if (p == P) return fwd<P, P + 1>; if constexpr (P < PH_PER_LAYER) return phase_kernel<P + 1>(p); else return nullptr; }
extern "C" void kernel_launch(void* const* d_in, const int* in_sizes, int n_in, void* d_out, int out_size, void* d_ws, size_t ws_size, hipStream_t stream) {
    static int grid = 0;
    if (grid == 0) {
        if (n_in != 16 || in_sizes[0] != S * DM || out_size != S * DM || ws_size < WS_END) { fprintf(stderr, "kernel_launch: unexpected shapes (n_in %d, in0 %d, out %d, ws %zu < %zu); nothing launched\n", n_in, n_in > 0 ? in_sizes[0] : -1, out_size, ws_size, (size_t)WS_END); grid = -1; return; }
        int dev = 0, cus = 0;
        if (hipGetDevice(&dev) != hipSuccess || hipDeviceGetAttribute(&cus, hipDeviceAttributeMultiprocessorCount, dev) != hipSuccess) { grid = -1; return; }
#if ONE_LAUNCH
        if (hipFuncSetAttribute((const void*)fwd<0, PH_PER_LAYER + 1>, hipFuncAttributeMaxDynamicSharedMemorySize, LDS_BYTES) != hipSuccess) { grid = -1; return; }
#else
        for (int p = 0; p <= PH_PER_LAYER; ++p) if (hipFuncSetAttribute((const void*)phase_kernel<0>(p), hipFuncAttributeMaxDynamicSharedMemorySize, LDS_BYTES) != hipSuccess) { fprintf(stderr, "kernel_launch: hipFuncSetAttribute failed\n"); grid = -1; return; }
#endif
        (void)hipGetLastError();
        grid = cus;
    }
    if (grid < 0) return;
    (void)hipMemsetAsync((char*)d_ws + WS_CTL, 0, CTL_ZERO_BYTES, stream);
    Args a{};
    a.x = (const float*)d_in[0]; a.norm_mix = (const float*)d_in[1]; a.norm_ffn = (const float*)d_in[2]; a.w_in = (const float*)d_in[3]; a.att_q_norm = (const float*)d_in[4]; a.att_k_norm = (const float*)d_in[5];
    a.mlstm_conv = (const float*)d_in[6]; a.mlstm_gate_bias = (const float*)d_in[7]; a.mlstm_out_norm = (const float*)d_in[8]; a.ret_out_norm = (const float*)d_in[9];
    a.w_b_att = (const float*)d_in[10]; a.w_b_mlstm = (const float*)d_in[11]; a.w_b_ret = (const float*)d_in[12]; a.w_out = (const float*)d_in[13]; a.w_ffn_in = (const float*)d_in[14]; a.w_ffn_out = (const float*)d_in[15];
    a.out = (float*)d_out; a.ws = (unsigned char*)d_ws;
#if ONE_LAUNCH
    a.layer_lo = 0; a.layer_hi = DEPTH; a.ph_lo = 0; a.ph_hi = PH_PER_LAYER + 1; hipLaunchKernelGGL((fwd<0, PH_PER_LAYER + 1>), dim3(grid), dim3(NTHR), LDS_BYTES, stream, a);
#else
    a.layer_lo = 0; a.layer_hi = 0; a.ph_lo = 0; a.ph_hi = 1; hipLaunchKernelGGL((fwd<0, 1>), dim3(grid), dim3(NTHR), LDS_BYTES, stream, a);
    for (int l = 0; l < DEPTH; ++l) for (int p = 1; p <= PH_PER_LAYER; ++p) { a.layer_lo = l; a.layer_hi = l + 1; a.ph_lo = p; a.ph_hi = p + 1; hipLaunchKernelGGL(phase_kernel<0>(p), dim3(grid), dim3(NTHR), LDS_BYTES, stream, a); }
#endif
}
```

```cpp
#include <hip/hip_runtime.h>
#include <cstdio>
#include <cstdint>
__device__ __forceinline__ int my_tid();
namespace pg8 {
#define PG8_LAS __attribute__((address_space(3)))
typedef unsigned short bf16_t;
typedef short bf16x8 __attribute__((ext_vector_type(8)));
typedef float f32x4 __attribute__((ext_vector_type(4)));
typedef unsigned u32x4 __attribute__((ext_vector_type(4)));
constexpr int BM = 256, BK = 64, HALF = 128, HTB = HALF * BK * 2  , STAGE_BYTES = 8 * HTB, NXCD = 8, WGM = 8;

__host__ __device__ __forceinline__ int lds_byte(int r, int c) { const int st = (r >> 4) * 2 + (c >> 5), rr = r & 15, cc = c & 31, ob = rr * 64 + cc * 2; return st * 1024 + (ob ^ (((ob >> 9) & 1) << 5)); }
__host__ __device__ __forceinline__ void stage_rc(int b, int& R, int& C) { const int st = b / 1024, sb = b % 1024, swz = sb ^ (((sb >> 9) & 1) << 5); R = (st >> 1) * 16 + swz / 64; C = (st & 1) * 32 + (swz % 64) / 2; }
__host__ __device__ __forceinline__ int perm32(int rho) { const int n = rho >> 4, i = rho & 15; return 8 * (i >> 2) + 4 * n + (i & 3); }

struct Unit { int pm, pn; };
struct Gemm { const bf16_t* A; const bf16_t* Bt; int M, N, K; };

struct StaticOrder {
    int nM, nN, nwg, G, c;
    __host__ __device__ void init(int M, int N, int G_, int c_) { nM = M / BM; nN = N / BM; nwg = nM * nN; G = G_; c = c_; }
    __host__ __device__ bool next(int i, Unit& u) const {
        const long L = (long)i * G + c; if (L >= nwg) return false;
        int wgid = (int)L; { const int q = nwg / NXCD, r = nwg % NXCD, xcd = wgid % NXCD, off = wgid / NXCD; wgid = (xcd < r ? xcd * (q + 1) : r * (q + 1) + (xcd - r) * q) + off; }
        const int nig = WGM * nN, gid = wgid / nig, fm = gid * WGM, gsz = (nM - fm) < WGM ? (nM - fm) : WGM;
        u.pm = fm + ((wgid % nig) % gsz); u.pn = (wgid % nig) / gsz; return true;
    }
    __device__ __forceinline__ void a_ready(const Unit&) const {}
    __device__ __forceinline__ void done(const Unit&) const {}
};

__device__ __forceinline__ unsigned cvt_pk_bf16(float lo, float hi) { unsigned r; asm volatile("v_cvt_pk_bf16_f32 %0, %1, %2" : "=v"(r) : "v"(lo), "v"(hi)); return r; }
typedef float f32x2 __attribute__((ext_vector_type(2)));
__device__ __forceinline__ float sigmoid_f(float x) { return __builtin_amdgcn_rcpf(1.0f + __builtin_amdgcn_exp2f(-1.4426950408889634f * x)); }
struct EpiProj {
    static constexpr bool PERM = true, AFTER_DRAIN = false;
    bf16_t* P; int ldp; float* Sm; int ngate0, nbf;
    __device__ __forceinline__ void operator()(const f32x4 (&acc)[2][2][4][2], const Unit& u, int wr, int wc, int fr, int fq) const {
        const int row0 = u.pm * BM + wr * 64 + fr, col0 = u.pn * BM + wc * 32 + 8 * fq;
        if (u.pn >= nbf) {
            const int c0 = wc * 32 + 8 * fq;
#pragma unroll
            for (int ai = 0; ai < 2; ++ai)
#pragma unroll
                for (int m = 0; m < 4; ++m) { float* rowp = Sm + (size_t)(row0 + ai * HALF + m * 16) * 256 + c0;
#pragma unroll
                    for (int bj = 0; bj < 2; ++bj) { *(f32x4*)(rowp + bj * HALF) = acc[ai][bj][m][0]; *(f32x4*)(rowp + bj * HALF + 4) = acc[ai][bj][m][1]; } }
            return;
        }
        const bool sg = u.pn >= ngate0;
#pragma unroll
        for (int ai = 0; ai < 2; ++ai)
#pragma unroll
            for (int m = 0; m < 4; ++m) { bf16_t* rowp = P + (size_t)(row0 + ai * HALF + m * 16) * ldp + col0;
#pragma unroll
                for (int bj = 0; bj < 2; ++bj) { f32x4 v0 = acc[ai][bj][m][0], v1 = acc[ai][bj][m][1];
                    if (sg) {
#pragma unroll
                        for (int j = 0; j < 4; ++j) { v0[j] = sigmoid_f(v0[j]); v1[j] = sigmoid_f(v1[j]); } }
                    u32x4 w; w.x = cvt_pk_bf16(v0[0], v0[1]); w.y = cvt_pk_bf16(v0[2], v0[3]); w.z = cvt_pk_bf16(v1[0], v1[1]); w.w = cvt_pk_bf16(v1[2], v1[3]);
                    *(u32x4*)(rowp + bj * HALF) = w; } }
    }
};
__device__ __forceinline__ f32x4 bf4_lo(u32x4 w) { return (f32x4){__uint_as_float(w.x << 16), __uint_as_float(w.x & 0xffff0000u), __uint_as_float(w.y << 16), __uint_as_float(w.y & 0xffff0000u)}; }
__device__ __forceinline__ f32x4 bf4_hi(u32x4 w) { return (f32x4){__uint_as_float(w.z << 16), __uint_as_float(w.z & 0xffff0000u), __uint_as_float(w.w << 16), __uint_as_float(w.w & 0xffff0000u)}; }
template <int MODE> struct EpiBranch {
    static constexpr bool PERM = true, AFTER_DRAIN = false;
    const bf16_t* G; int ldg; float* T; bf16_t* O; int ldt;
    __device__ __forceinline__ void operator()(const f32x4 (&acc)[2][2][4][2], const Unit& u, int wr, int wc, int fr, int fq) const {
        const int row0 = u.pm * BM + wr * 64 + fr, col0 = u.pn * BM + wc * 32 + 8 * fq;
#pragma unroll
        for (int ai = 0; ai < 2; ++ai)
#pragma unroll
            for (int m = 0; m < 4; ++m) { const size_t r = (size_t)(row0 + ai * HALF + m * 16);
#pragma unroll
                for (int bj = 0; bj < 2; ++bj) { const u32x4 g = *(const u32x4*)(G + r * ldg + col0 + bj * HALF);
                    f32x4 v0 = acc[ai][bj][m][0] * bf4_lo(g), v1 = acc[ai][bj][m][1] * bf4_hi(g);
                    float* tp = T + r * ldt + col0 + bj * HALF;
                    if (MODE >= 1) { v0 = v0 + *(const f32x4*)tp; v1 = v1 + *(const f32x4*)(tp + 4); }
                    if (MODE <= 1) { *(f32x4*)tp = v0; *(f32x4*)(tp + 4) = v1; }
                    else { u32x4 w; w.x = cvt_pk_bf16(v0[0], v0[1]); w.y = cvt_pk_bf16(v0[2], v0[3]); w.z = cvt_pk_bf16(v1[0], v1[1]); w.w = cvt_pk_bf16(v1[2], v1[3]);
                        *(u32x4*)(O + r * ldt + col0 + bj * HALF) = w; } } }
    }
};
struct EpiResid {
    static constexpr bool PERM = false, AFTER_DRAIN = false;
    const float* base; float* out; int ldc;
    __device__ __forceinline__ void operator()(const f32x4 (&acc)[2][2][4][2], const Unit& u, int wr, int wc, int fr, int fq) const {
        const int row0 = u.pm * BM + wr * 64 + fr, col0 = u.pn * BM + wc * 32 + 4 * fq;
#pragma unroll
        for (int ai = 0; ai < 2; ++ai)
#pragma unroll
            for (int m = 0; m < 4; ++m) { const size_t off = (size_t)(row0 + ai * HALF + m * 16) * ldc + col0;
#pragma unroll
                for (int bj = 0; bj < 2; ++bj)
#pragma unroll
                    for (int n = 0; n < 2; ++n) *(f32x4*)(out + off + bj * HALF + n * 16) = *(const f32x4*)(base + off + bj * HALF + n * 16) + acc[ai][bj][m][n]; }
    }
};
struct EpiSwiGLU {
    static constexpr bool PERM = true, AFTER_DRAIN = false;
    bf16_t* O; int ldc;
    __device__ __forceinline__ void operator()(const f32x4 (&acc)[2][2][4][2], const Unit& u, int wr, int wc, int fr, int fq) const {
        const int row0 = u.pm * BM + wr * 64 + fr, col0 = u.pn * HALF + wc * 32 + 8 * fq;
#pragma unroll
        for (int ai = 0; ai < 2; ++ai)
#pragma unroll
            for (int m = 0; m < 4; ++m) { f32x4 v0, v1;
#pragma unroll
                for (int j = 0; j < 4; ++j) { const float g0 = acc[ai][0][m][0][j], g1 = acc[ai][0][m][1][j];
                    v0[j] = g0 * sigmoid_f(g0) * acc[ai][1][m][0][j]; v1[j] = g1 * sigmoid_f(g1) * acc[ai][1][m][1][j]; }
                u32x4 w; w.x = cvt_pk_bf16(v0[0], v0[1]); w.y = cvt_pk_bf16(v0[2], v0[3]); w.z = cvt_pk_bf16(v1[0], v1[1]); w.w = cvt_pk_bf16(v1[2], v1[3]);
                *(u32x4*)(O + (size_t)(row0 + ai * HALF + m * 16) * ldc + col0) = w; }
    }
};
template <class Epi, class Sched, bool ALIGN_EPI = false, bool SP2 = false>
__device__ __forceinline__ void gemm_phase(PG8_LAS unsigned char* lds, const Gemm g, const Sched& S, const Epi& E) {
    int tid_o = my_tid(); asm volatile("" : "+v"(tid_o));
    const int tid = tid_o, wid = __builtin_amdgcn_readfirstlane(tid >> 6), lane = tid & 63, wr = wid >> 2, wc = wid & 3, fr = lane & 15, fq = lane >> 4;
    const int K = g.K, nt = K / BK;
    unsigned voffA[2], voffB[2];
#pragma unroll
    for (int i = 0; i < 2; ++i) { int R, C; stage_rc(tid * 16 + i * 8192, R, C); const int Rb = Epi::PERM ? ((R & ~31) + perm32(R & 31)) : R;
        voffA[i] = (unsigned)(R * K + C) * 2u; voffB[i] = (unsigned)(Rb * K + C) * 2u; }
    const size_t kstep = (size_t)(BK * 2);
    const size_t hstep = (size_t)HALF * K * 2;
    const size_t tstep = 2 * hstep;
    const unsigned ldsw = (unsigned)wid * 1024u;
    const int aoff = lds_byte(wr * 64 + fr, fq * 8), boff = lds_byte(wc * 32 + fr, fq * 8);
#define PG8_SA(b, h) (((b) * 2 + (h)) * HTB)
#define PG8_SB(b, h) ((4 + (b) * 2 + (h)) * HTB)
#define PG8_STAGE(bufoff, gbase, voff) do { _Pragma("unroll") for (int _i = 0; _i < 2; ++_i) \
        __builtin_amdgcn_global_load_lds((const unsigned*)((const char*)(gbase) + (voff)[_i]), (PG8_LAS unsigned*)(lds + (bufoff) + ldsw + _i * 8192), 16, 0, 0); } while (0)
#define PG8_LDA(dst, b, h) do { _Pragma("unroll") for (int m = 0; m < 4; ++m) _Pragma("unroll") for (int k = 0; k < 2; ++k) dst[m][k] = *(const PG8_LAS bf16x8*)(lds + PG8_SA(b, h) + aoff + m * 2048 + k * 1024); } while (0)
#define PG8_LDB(dst, b, h) do { _Pragma("unroll") for (int n = 0; n < 2; ++n) _Pragma("unroll") for (int k = 0; k < 2; ++k) dst[n][k] = *(const PG8_LAS bf16x8*)(lds + PG8_SB(b, h) + boff + n * 2048 + k * 1024); } while (0)
#define PG8_MMA(ai, bj, At, Bt) do { __builtin_amdgcn_s_setprio(1); _Pragma("unroll") for (int m = 0; m < 4; ++m) _Pragma("unroll") for (int n = 0; n < 2; ++n) _Pragma("unroll") for (int k = 0; k < 2; ++k) \
        acc[ai][bj][m][n] = __builtin_amdgcn_mfma_f32_16x16x32_bf16(Bt[n][k], At[m][k], acc[ai][bj][m][n], 0, 0, 0); __builtin_amdgcn_s_setprio(0); } while (0)
#define PG8_WAIT_V(n) asm volatile("s_waitcnt vmcnt(" #n ")" ::: "memory")
#define PG8_WAIT_L(n) asm volatile("s_waitcnt lgkmcnt(" #n ")" ::: "memory")
#define PG8_BAR __builtin_amdgcn_s_barrier()
#define PG8_SCHED __builtin_amdgcn_sched_barrier(0)
    Unit cur, nxt; int ui = 0;
    if (!S.next(0, cur)) return;
    f32x4 acc[2][2][4][2];
#pragma unroll
    for (int a = 0; a < 2; ++a)
#pragma unroll
        for (int b = 0; b < 2; ++b)
#pragma unroll
            for (int m = 0; m < 4; ++m)
#pragma unroll
                for (int n = 0; n < 2; ++n) acc[a][b][m][n] = (f32x4){0.f, 0.f, 0.f, 0.f};
    bf16x8 At[4][2], B0[2][2], B1[2][2];
    const char* cA = (const char*)g.A + (size_t)cur.pm * tstep; const char* cB = (const char*)g.Bt + (size_t)cur.pn * tstep;
    S.a_ready(cur);
    if constexpr (SP2) {
        PG8_STAGE(PG8_SB(0, 0), cB, voffB); PG8_STAGE(PG8_SB(0, 1), cB + hstep, voffB); PG8_STAGE(PG8_SA(0, 0), cA, voffA); PG8_STAGE(PG8_SA(0, 1), cA + hstep, voffA);
        if (wr == 1) PG8_BAR;
        PG8_WAIT_V(2); PG8_BAR;
        PG8_STAGE(PG8_SB(1, 0), cB + kstep, voffB); PG8_STAGE(PG8_SA(1, 0), cA + kstep, voffA); PG8_STAGE(PG8_SB(1, 1), cB + hstep + kstep, voffB);
        PG8_WAIT_V(6); PG8_BAR;
    } else {
        PG8_STAGE(PG8_SB(0, 0), cB, voffB); PG8_STAGE(PG8_SA(0, 0), cA, voffA); PG8_STAGE(PG8_SB(0, 1), cB + hstep, voffB); PG8_STAGE(PG8_SA(0, 1), cA + hstep, voffA);
        if (wr == 1) PG8_BAR;
        PG8_WAIT_V(4); PG8_BAR;
        PG8_STAGE(PG8_SB(1, 0), cB + kstep, voffB); PG8_STAGE(PG8_SA(1, 0), cA + kstep, voffA); PG8_STAGE(PG8_SB(1, 1), cB + hstep + kstep, voffB);
        PG8_WAIT_V(6); PG8_BAR;
    }
    for (;;) {
        const bool has_next = S.next(ui + 1, nxt);
        const char* nA = has_next ? (const char*)g.A + (size_t)nxt.pm * tstep : cA; const char* nB = has_next ? (const char*)g.Bt + (size_t)nxt.pn * tstep : cB;
        for (int t = 0; t < nt; t += 2) {
            const bool last = (t == nt - 2);
            const char* a1 = cA + (size_t)(t + 1) * kstep;
            const char* a2 = last ? nA : cA + (size_t)(t + 2) * kstep; const char* b2 = last ? nB : cB + (size_t)(t + 2) * kstep;
            const char* a3 = a2 + kstep; const char* b3 = b2 + kstep;
            if (last && has_next) S.a_ready(nxt);
            if constexpr (SP2) {
            PG8_LDB(B0, 0, 0); PG8_LDB(B1, 0, 1); PG8_SCHED; PG8_LDA(At, 0, 0); PG8_STAGE(PG8_SA(1, 1), a1 + hstep, voffA);
            PG8_WAIT_V(8); PG8_WAIT_L(0); PG8_BAR; PG8_MMA(0, 0, At, B0); PG8_MMA(0, 1, At, B1); PG8_BAR; PG8_SCHED;
            PG8_LDA(At, 0, 1); PG8_STAGE(PG8_SB(0, 0), b2, voffB); PG8_STAGE(PG8_SB(0, 1), b2 + hstep, voffB); PG8_STAGE(PG8_SA(0, 0), a2, voffA);
            PG8_WAIT_V(8); PG8_WAIT_L(0); PG8_BAR; PG8_MMA(1, 0, At, B0); PG8_MMA(1, 1, At, B1); PG8_BAR; PG8_SCHED;
            PG8_LDB(B0, 1, 0); PG8_LDB(B1, 1, 1); PG8_SCHED; PG8_LDA(At, 1, 0); PG8_STAGE(PG8_SA(0, 1), a2 + hstep, voffA);
            PG8_WAIT_V(8); PG8_WAIT_L(0); PG8_BAR; PG8_MMA(0, 0, At, B0); PG8_MMA(0, 1, At, B1); PG8_BAR; PG8_SCHED;
            PG8_LDA(At, 1, 1); PG8_STAGE(PG8_SB(1, 0), b3, voffB); PG8_STAGE(PG8_SB(1, 1), b3 + hstep, voffB); PG8_STAGE(PG8_SA(1, 0), a3, voffA);
            PG8_WAIT_V(8); PG8_WAIT_L(0); PG8_BAR; PG8_MMA(1, 0, At, B0); PG8_MMA(1, 1, At, B1); PG8_BAR; PG8_SCHED;
            } else {
            PG8_LDB(B0, 0, 0); PG8_SCHED; PG8_LDA(At, 0, 0); PG8_STAGE(PG8_SA(1, 1), a1 + hstep, voffA);
            PG8_WAIT_L(8); PG8_BAR; PG8_WAIT_L(0); PG8_MMA(0, 0, At, B0); PG8_BAR; PG8_SCHED;
            PG8_LDB(B1, 0, 1); PG8_STAGE(PG8_SB(0, 0), b2, voffB);
            PG8_BAR; PG8_WAIT_L(0); PG8_MMA(0, 1, At, B1); PG8_BAR;
            PG8_LDA(At, 0, 1); PG8_STAGE(PG8_SA(0, 0), a2, voffA);
            PG8_BAR; PG8_WAIT_L(0); PG8_MMA(1, 0, At, B0); PG8_BAR; PG8_SCHED;
            PG8_STAGE(PG8_SB(0, 1), b2 + hstep, voffB);
            PG8_WAIT_V(6); PG8_BAR; PG8_MMA(1, 1, At, B1); PG8_BAR;
            PG8_LDB(B0, 1, 0); PG8_SCHED; PG8_LDA(At, 1, 0); PG8_STAGE(PG8_SA(0, 1), a2 + hstep, voffA);
            PG8_WAIT_L(8); PG8_BAR; PG8_WAIT_L(0); PG8_MMA(0, 0, At, B0); PG8_BAR; PG8_SCHED;
            PG8_LDB(B1, 1, 1); PG8_STAGE(PG8_SB(1, 0), b3, voffB);
            PG8_BAR; PG8_WAIT_L(0); PG8_MMA(0, 1, At, B1); PG8_BAR;
            PG8_LDA(At, 1, 1); PG8_STAGE(PG8_SA(1, 0), a3, voffA);
            PG8_BAR; PG8_WAIT_L(0); PG8_MMA(1, 0, At, B0); PG8_BAR; PG8_SCHED;
            PG8_STAGE(PG8_SB(1, 1), b3 + hstep, voffB);
            PG8_WAIT_V(6); PG8_BAR; PG8_MMA(1, 1, At, B1); PG8_BAR;
            }
        }
        if constexpr (ALIGN_EPI) { if (wr == 0) PG8_BAR; }
        if constexpr (!Epi::AFTER_DRAIN) { E(acc, cur, wr, wc, fr, fq); S.done(cur); }
        if (!has_next) break;
#pragma unroll
        for (int a = 0; a < 2; ++a)
#pragma unroll
            for (int b = 0; b < 2; ++b)
#pragma unroll
                for (int m = 0; m < 4; ++m)
#pragma unroll
                    for (int n = 0; n < 2; ++n) acc[a][b][m][n] = (f32x4){0.f, 0.f, 0.f, 0.f};
        cur = nxt; cA = nA; cB = nB; ++ui;
        if constexpr (ALIGN_EPI) { if (wr == 1) PG8_BAR; }
    }
    PG8_WAIT_V(0);
    if constexpr (!ALIGN_EPI) { if (wr == 0) PG8_BAR; }
    PG8_BAR;
    if constexpr (Epi::AFTER_DRAIN) { E.fused(acc, cur, wr, wc, fr, fq, lds, wid, lane); S.done(cur); }
#undef PG8_SA
#undef PG8_SB
#undef PG8_STAGE
#undef PG8_LDA
#undef PG8_LDB
#undef PG8_MMA
#undef PG8_WAIT_V
#undef PG8_WAIT_L
#undef PG8_BAR
#undef PG8_SCHED
}
}

using pg8::sigmoid_f;
constexpr int NWAVES = 8, NTHR = 512;
constexpr int S = 8192, DM = 2048, DEPTH = 4, FF = 5632;
constexpr int NPROJ = 16896, NPROJ_PAD = 17152, LPROJ = 16976;
constexpr int PC_AQ = 0, PC_AK = 1024, PC_AV = 2048, PC_IQ = 3072, PC_MQ = 3584, PC_MK = 4096, PC_MV = 4608, PC_MO = 5632, PC_RQ = 6656, PC_RK = 7680, PC_RV = 8704, PC_RG = 9728, PC_G = 10752;
constexpr int LC_IK = 3584, LC_IW = 3648, LC_MI = 5704, LC_MF = 5708;
constexpr float NORM_EPS = 1e-6f;
constexpr size_t MiB = 1u << 20;
constexpr size_t WS_CTL = 0, CTL_ZERO_BYTES = 1 * MiB;
constexpr size_t WS_ROPE128 = 2 * MiB, WS_ROPE64 = 6 * MiB;
constexpr size_t WS_W = 16 * MiB, W_LAYER = 153 * MiB;
constexpr size_t WO_IN = 0, WO_B = 67 * MiB, WO_OUT = 79 * MiB, WO_FIN = 87 * MiB, WO_FOUT = 131 * MiB;
constexpr size_t WS_H = 640 * MiB, WS_PROJ = 672 * MiB, WS_SMALL = 936 * MiB, WS_MQK = 944 * MiB, WS_IKB = 960 * MiB, WS_IWF = 961 * MiB, WS_GIF = WS_IWF + 512 * 1024;
constexpr size_t WS_SC = 964 * MiB, WS_MB = 1220 * MiB, WS_DCM = 1228 * MiB, WS_CPM = 1260 * MiB, WS_MISC = 1292 * MiB, WS_DRR = 1294 * MiB, WS_RPR = 1310 * MiB;
constexpr size_t WS_YA = 1328 * MiB, WS_YM = 1344 * MiB, WS_YR = 1360 * MiB, WS_MERGEDF = 1376 * MiB, WS_MERGED = 1440 * MiB, WS_ACT = 1472 * MiB, WS_END = 1560 * MiB;
constexpr size_t MISC_DN = 0, MISC_NPREV = 256 * 1024, MISC_AB = 512 * 1024, MISC_MPREV = 520 * 1024;
constexpr int CW_BAR = 4096;
constexpr int LDS_BYTES = 147456, MISC_OFF = 147456 - 1024;

#define GAS __attribute__((address_space(1)))
#define LAS __attribute__((address_space(3)))
typedef unsigned short bf16;
typedef unsigned v4u __attribute__((ext_vector_type(4)));
typedef unsigned v2u __attribute__((ext_vector_type(2)));
typedef float f32x4 __attribute__((ext_vector_type(4)));
typedef float f32x16 __attribute__((ext_vector_type(16)));
typedef short bf16x8 __attribute__((ext_vector_type(8)));
typedef short s16x4 __attribute__((ext_vector_type(4)));
#define LDS_WAIT() asm volatile("s_waitcnt lgkmcnt(0)" ::: "memory")
#define VM_WAIT() asm volatile("s_waitcnt vmcnt(0)" ::: "memory")
__device__ __forceinline__ unsigned f2bf(float f) { unsigned u = __builtin_bit_cast(unsigned, f); return (u + 0x7fffu + ((u >> 16) & 1u)) >> 16; }
__device__ __forceinline__ unsigned pk2(float lo, float hi) { return f2bf(lo) | (f2bf(hi) << 16); }
__device__ __forceinline__ float bf2f(bf16 b) { return __uint_as_float(((unsigned)b) << 16); }
template <int CTRL, int RMASK, int BMASK> __device__ __forceinline__ float dpp_f(float old, float src) { return __builtin_bit_cast(float, __builtin_amdgcn_update_dpp(__builtin_bit_cast(int, old), __builtin_bit_cast(int, src), CTRL, RMASK, BMASK, false)); }
template <int CTRL, int RMASK, int BMASK> __device__ __forceinline__ unsigned dpp_u(unsigned src) { return (unsigned)__builtin_amdgcn_update_dpp(0, (int)src, CTRL, RMASK, BMASK, false); }
__device__ __forceinline__ float wave_sum(float x) {
    x += dpp_f<0xB1, 0xf, 0xf>(0.f, x); x += dpp_f<0x4E, 0xf, 0xf>(0.f, x); x += dpp_f<0x141, 0xf, 0xf>(0.f, x); x += dpp_f<0x140, 0xf, 0xf>(0.f, x);
    x += dpp_f<0x142, 0xa, 0xf>(0.f, x); x += dpp_f<0x143, 0xc, 0xf>(0.f, x);
    return __builtin_bit_cast(float, __builtin_amdgcn_readlane(__builtin_bit_cast(int, x), 63)); }
__device__ __forceinline__ float wave_max(float x) {
    x = fmaxf(x, dpp_f<0xB1, 0xf, 0xf>(x, x)); x = fmaxf(x, dpp_f<0x4E, 0xf, 0xf>(x, x)); x = fmaxf(x, dpp_f<0x141, 0xf, 0xf>(x, x)); x = fmaxf(x, dpp_f<0x140, 0xf, 0xf>(x, x));
    x = fmaxf(x, dpp_f<0x142, 0xa, 0xf>(x, x)); x = fmaxf(x, dpp_f<0x143, 0xc, 0xf>(x, x));
    return __builtin_bit_cast(float, __builtin_amdgcn_readlane(__builtin_bit_cast(int, x), 63)); }
__device__ __forceinline__ unsigned lane_id_v() { unsigned l; asm volatile("v_mbcnt_lo_u32_b32 %0, -1, 0\n\tv_mbcnt_hi_u32_b32 %0, -1, %0" : "=v"(l)); return l; }
__device__ __forceinline__ int my_tid() {
    const unsigned slot = (unsigned)__builtin_amdgcn_s_getreg((5 << 11) | 4) & 63u;
    extern __shared__ __attribute__((aligned(16))) unsigned char lds_raw_t[];
    const unsigned wv = ((volatile LAS unsigned*)((LAS unsigned char*)lds_raw_t + MISC_OFF))[64 + slot];
    return (int)(__builtin_amdgcn_readfirstlane(wv) * 64u + lane_id_v());
}
__device__ __forceinline__ float shfl_idx_f(float x, int src_lane) { return __builtin_bit_cast(float, __builtin_amdgcn_ds_bpermute(src_lane << 2, __builtin_bit_cast(int, x))); }
__device__ __forceinline__ float wave_prefix_sum_f(float x) {
    float y = x + dpp_f<0x111, 0xf, 0xf>(0.f, x); y += dpp_f<0x112, 0xf, 0xf>(0.f, x); y += dpp_f<0x113, 0xf, 0xf>(0.f, x);
    y += dpp_f<0x114, 0xf, 0xe>(0.f, y); y += dpp_f<0x118, 0xf, 0xc>(0.f, y); y += dpp_f<0x142, 0xa, 0xf>(0.f, y); y += dpp_f<0x143, 0xc, 0xf>(0.f, y); return y; }
__device__ __forceinline__ float wave_prefix_max_f(float x) {
    const float N = -3.0e38f;
    float y = fmaxf(x, dpp_f<0x111, 0xf, 0xf>(N, x)); y = fmaxf(y, dpp_f<0x112, 0xf, 0xf>(N, x)); y = fmaxf(y, dpp_f<0x113, 0xf, 0xf>(N, x));
    y = fmaxf(y, dpp_f<0x114, 0xf, 0xe>(N, y)); y = fmaxf(y, dpp_f<0x118, 0xf, 0xc>(N, y)); y = fmaxf(y, dpp_f<0x142, 0xa, 0xf>(N, y)); y = fmaxf(y, dpp_f<0x143, 0xc, 0xf>(N, y)); return y; }
#define XB_TMO      128
#define XB_XCNT(j)  (256  + 64 * (j))
#define XB_XSUB(j)  (1280 + 64 * (j))
#define XB_XGEN(j)  (2304 + 64 * (j))
#define XB_TOP      3328
#define XB_TOPGEN   3392
#define XCD_BAR_WORDS 3456
#define XB_SPIN_CAP (1u << 18)

__device__ __forceinline__ unsigned xb_ld(unsigned* p)              { return __hip_atomic_load(p, __ATOMIC_RELAXED, __HIP_MEMORY_SCOPE_AGENT); }
__device__ __forceinline__ unsigned xb_add(unsigned* p, unsigned v) { return __hip_atomic_fetch_add(p, v, __ATOMIC_RELAXED, __HIP_MEMORY_SCOPE_AGENT); }
__device__ __forceinline__ unsigned xb_xcc_id() { return (unsigned)__builtin_amdgcn_s_getreg((3 << 11) | 20) & 0xFu; }
#define XB_SPIN(cond, bar) do { unsigned _sp = 0; while (cond) { __builtin_amdgcn_s_sleep(1); \
    if ((++_sp & 255u) == 0u) { if (xb_ld(&(bar)[XB_TMO])) break; if (_sp > XB_SPIN_CAP) { atomicAdd(&(bar)[XB_TMO], 1u); break; } } } } while (0)

struct XcdBarrier {
    unsigned* bar; unsigned x;
    volatile LAS unsigned* st;
};

__device__ __forceinline__ XcdBarrier xcd_barrier_post(unsigned* bar, volatile LAS unsigned* st) {
    XcdBarrier b; b.bar = bar; b.x = xb_xcc_id(); b.st = st;
    if (my_tid() == 0) (void)xb_add(&bar[XB_XCNT(b.x)], 1u);
    return b;
}
__device__ __forceinline__ void xcd_barrier_complete(unsigned* bar, unsigned x, unsigned& nloc, unsigned& nx) {
    const unsigned G = gridDim.x * gridDim.y * gridDim.z;
    unsigned sum, cnt, mine, sp = 0u;
    for (;;) {
        sum = 0u; cnt = 0u; mine = 0u;
#pragma unroll
        for (unsigned j = 0; j < 16; ++j) { const unsigned c = xb_ld(&bar[XB_XCNT(j)]); sum += c; cnt += (c > 0u) ? 1u : 0u; mine = (j == x) ? c : mine; }
        if (sum == G) break;
        __builtin_amdgcn_s_sleep(1);
        if ((++sp & 255u) == 0u) { if (xb_ld(&bar[XB_TMO])) break; if (sp > XB_SPIN_CAP) { atomicAdd(&bar[XB_TMO], 1u); break; } }
    }
    nloc = mine > 0u ? mine : 1u; nx = cnt > 0u ? cnt : 1u;
}

__device__ __forceinline__ void xcd_barrier(const XcdBarrier& b) {
    asm volatile("s_waitcnt vmcnt(0)" ::: "memory");
    __syncthreads();
    if (my_tid() == 0) {
        unsigned* bar = b.bar;
        __builtin_amdgcn_s_waitcnt(0);
        unsigned nloc = b.st[0], nx = b.st[1];
        if (nloc == 0u) { xcd_barrier_complete(bar, b.x, nloc, nx); b.st[0] = nloc; b.st[1] = nx; }
        const unsigned old = xb_add(&bar[XB_XSUB(b.x)], 1u);
        const unsigned gen = old / nloc;
        if (old + 1u == (gen + 1u) * nloc) {
            __builtin_amdgcn_fence(__ATOMIC_RELEASE, "agent");
            asm volatile("s_waitcnt vmcnt(0)" ::: "memory");
            const unsigned og = xb_add(&bar[XB_TOP], 1u);
            const unsigned tg = og / nx;
            if (og + 1u == (tg + 1u) * nx) xb_add(&bar[XB_TOPGEN], 1u);
            else XB_SPIN(xb_ld(&bar[XB_TOPGEN]) == tg, bar);
            __builtin_amdgcn_fence(__ATOMIC_ACQUIRE, "agent");
            xb_add(&bar[XB_XGEN(b.x)], 1u);
            asm volatile("s_waitcnt vmcnt(0)" ::: "memory");
        } else {
            XB_SPIN(xb_ld(&bar[XB_XGEN(b.x)]) == gen, bar);
            __builtin_amdgcn_fence(__ATOMIC_ACQUIRE, "agent");
            asm volatile("s_waitcnt vmcnt(0)" ::: "memory");
        }
    }
    __syncthreads();
}

struct MapIdent { __device__ __forceinline__ int operator()(int p) const { return p; } };
struct MapWin { __device__ __forceinline__ int operator()(int p) const {
    if (p < 3584) return p; if (p < 5632) return p + 72; if (p < NPROJ) return p + 80;
    const int r = p - NPROJ; if (r < 64) return LC_IK + r; if (r < 72) return LC_IW + (r - 64); if (r < 76) return LC_MI + (r - 72); if (r < 80) return LC_MF + (r - 76); return -1; } };
struct MapFfn { __device__ __forceinline__ int operator()(int p) const { const int t = p >> 8, r = p & 255; return r < 128 ? 128 * t + r : FF + 128 * t + (r - 128); } };
template <class Map> __device__ __forceinline__ void transpose_item(const float* W, int K, int N, bf16* WT, LAS float* scr, int item, int nblk, int lane, const Map& map) {
    const int kb = item / nblk, nb = item % nblk, k0 = 64 * kb, p0 = 64 * nb;
    const int n4 = lane & 15, kr = lane >> 4, nl = map(p0 + 4 * n4);
    f32x4 v[16];
#pragma unroll
    for (int i = 0; i < 16; ++i) v[i] = nl >= 0 ? *(const GAS f32x4*)(W + (size_t)(k0 + kr + 4 * i) * N + nl) : (f32x4){0.f, 0.f, 0.f, 0.f};
#pragma unroll
    for (int i = 0; i < 16; ++i) { LAS float* d = scr + (kr + 4 * i) * 65 + 4 * n4; d[0] = v[i][0]; d[1] = v[i][1]; d[2] = v[i][2]; d[3] = v[i][3]; }
    LDS_WAIT(); asm volatile("" ::: "memory");
    const int c = lane & 7;
#pragma unroll
    for (int j = 0; j < 8; ++j) { const int n = (lane >> 3) + 8 * j; const LAS float* s = scr + (8 * c) * 65 + n;
        v4u o; o.x = pk2(s[0 * 65], s[1 * 65]); o.y = pk2(s[2 * 65], s[3 * 65]); o.z = pk2(s[4 * 65], s[5 * 65]); o.w = pk2(s[6 * 65], s[7 * 65]);
        *(GAS v4u*)(WT + (size_t)(p0 + n) * K + k0 + 8 * c) = o; }
    LDS_WAIT(); asm volatile("" ::: "memory");
}
template <class Map> __device__ __forceinline__ void transpose_matrix(const float* W, int K, int N, int Nphys, bf16* WT, LAS float* scr, int gw, int ngw, int lane, const Map& map) {
    const int nblk = Nphys / 64, nit = (K / 64) * nblk;
    for (int it = gw; it < nit; it += ngw) transpose_item(W, K, N, WT, scr, it, nblk, lane, map);
}

__device__ __forceinline__ void rms_row_to_bf16(const float* xrow, const float* gain, bf16* orow, int lane) {
    const GAS f32x4* xr = (const GAS f32x4*)xrow + lane; const GAS f32x4* gr = (const GAS f32x4*)gain + lane;
    f32x4 v[8]; float s = 0.f;
#pragma unroll
    for (int j = 0; j < 8; ++j) { v[j] = xr[64 * j]; s += (v[j].x * v[j].x + v[j].y * v[j].y) + (v[j].z * v[j].z + v[j].w * v[j].w); }
    const float rstd = 1.0f / sqrtf(wave_sum(s) * (1.f / DM) + NORM_EPS);
    GAS unsigned long long* o8 = (GAS unsigned long long*)orow + lane;
#pragma unroll
    for (int j = 0; j < 8; ++j) { const f32x4 g = gr[64 * j]; o8[64 * j] = (unsigned long long)pk2(v[j].x * rstd * g.x, v[j].y * rstd * g.y) | ((unsigned long long)pk2(v[j].z * rstd * g.z, v[j].w * rstd * g.w) << 32); }
}

struct PPArgs { bf16* proj; const float* small; bf16* mqk; bf16* ikb; unsigned char* sgn; float* gif; const float* rope128; const float* rope64; const float* gq; const float* gk; const float* convw; const float* gbias; };
__device__ __forceinline__ void bf8_unpack(const v4u w, float (&f)[8]) { f[0] = __uint_as_float(w.x << 16); f[1] = __uint_as_float(w.x & 0xffff0000u); f[2] = __uint_as_float(w.y << 16); f[3] = __uint_as_float(w.y & 0xffff0000u);
    f[4] = __uint_as_float(w.z << 16); f[5] = __uint_as_float(w.z & 0xffff0000u); f[6] = __uint_as_float(w.w << 16); f[7] = __uint_as_float(w.w & 0xffff0000u); }
__device__ __forceinline__ v4u bf8_pack(const float (&f)[8]) { v4u o; o.x = pk2(f[0], f[1]); o.y = pk2(f[2], f[3]); o.z = pk2(f[4], f[5]); o.w = pk2(f[6], f[7]); return o; }
__device__ __forceinline__ float sum8_dpp(float x) {
    x += dpp_f<0xB1, 0xf, 0xf>(0.f, x); x += dpp_f<0x4E, 0xf, 0xf>(0.f, x); x += dpp_f<0x141, 0xf, 0xf>(0.f, x); return x; }
__device__ __forceinline__ void pp_row(const PPArgs& a, int t, int lane, const f32x4 (&cw)[16]) {
    bf16* pr = a.proj + (size_t)t * NPROJ;
    const int hd = lane >> 3, d0 = (lane & 7) * 8;
    float cs[8], sn[8];
#pragma unroll
    for (int i = 0; i < 4; ++i) { const f32x4 c = *(const f32x4*)(a.rope128 + ((size_t)t * 64 + d0 + 2 * i) * 2); cs[2 * i] = c[0]; sn[2 * i] = c[1]; cs[2 * i + 1] = c[2]; sn[2 * i + 1] = c[3]; }
#pragma unroll
    for (int seg = 0; seg < 4; ++seg) {
        const int base = seg == 0 ? PC_AQ : (seg == 1 ? PC_AK : (seg == 2 ? PC_RQ : PC_RK));
        bf16* p = pr + base + hd * 128 + d0; float x1[8], x2[8];
        bf8_unpack(*(const GAS v4u*)p, x1); bf8_unpack(*(const GAS v4u*)(p + 64), x2);
        if (seg < 2) { const float* gn = seg ? a.gk : a.gq; float ss = 0.f;
#pragma unroll
            for (int i = 0; i < 8; ++i) ss += x1[i] * x1[i] + x2[i] * x2[i];
            const float rstd = 1.0f / sqrtf(sum8_dpp(ss) * (1.f / 128.f) + NORM_EPS);
            const f32x4 ga = *(const f32x4*)(gn + d0), gb = *(const f32x4*)(gn + d0 + 4), gc = *(const f32x4*)(gn + 64 + d0), gd = *(const f32x4*)(gn + 64 + d0 + 4);
#pragma unroll
            for (int i = 0; i < 4; ++i) { x1[i] *= rstd * ga[i]; x1[4 + i] *= rstd * gb[i]; x2[i] *= rstd * gc[i]; x2[4 + i] *= rstd * gd[i]; } }
        float o1[8], o2[8];
#pragma unroll
        for (int i = 0; i < 8; ++i) { o1[i] = x1[i] * cs[i] - x2[i] * sn[i]; o2[i] = x2[i] * cs[i] + x1[i] * sn[i]; }
        *(GAS v4u*)p = bf8_pack(o1); *(GAS v4u*)(p + 64) = bf8_pack(o2); }
    const float* sm = a.small + (size_t)t * 256;
    {
        const int e0 = (lane & 7) * 4; const f32x4 ca = *(const f32x4*)(a.rope64 + ((size_t)t * 32 + e0) * 2), cb = *(const f32x4*)(a.rope64 + ((size_t)t * 32 + e0 + 2) * 2);
        const float c4[4] = {ca[0], ca[2], cb[0], cb[2]}, s4[4] = {ca[1], ca[3], cb[1], cb[3]};
        bf16* p = pr + PC_IQ + hd * 64 + e0; const v2u lo = *(const GAS v2u*)p, hi = *(const GAS v2u*)(p + 32);
        const float aw = fabsf(sm[64 + hd]) * (0.35355339059327373f * 0.125f);
        const float y1[4] = {__uint_as_float(lo.x << 16), __uint_as_float(lo.x & 0xffff0000u), __uint_as_float(lo.y << 16), __uint_as_float(lo.y & 0xffff0000u)};
        const float y2[4] = {__uint_as_float(hi.x << 16), __uint_as_float(hi.x & 0xffff0000u), __uint_as_float(hi.y << 16), __uint_as_float(hi.y & 0xffff0000u)};
        float q1[4], q2[4];
#pragma unroll
        for (int i = 0; i < 4; ++i) { q1[i] = (y1[i] * c4[i] - y2[i] * s4[i]) * aw; q2[i] = (y2[i] * c4[i] + y1[i] * s4[i]) * aw; }
        v2u w1, w2; w1.x = pk2(q1[0], q1[1]); w1.y = pk2(q1[2], q1[3]); w2.x = pk2(q2[0], q2[1]); w2.y = pk2(q2[2], q2[3]);
        *(GAS v2u*)p = w1; *(GAS v2u*)(p + 32) = w2;
        if (lane < 8) { const f32x4 k1 = *(const f32x4*)(sm + e0), k2 = *(const f32x4*)(sm + 32 + e0); float r1[4], r2[4];
#pragma unroll
            for (int i = 0; i < 4; ++i) { r1[i] = k1[i] * c4[i] - k2[i] * s4[i]; r2[i] = k2[i] * c4[i] + k1[i] * s4[i]; }
            v2u u1, u2; u1.x = pk2(r1[0], r1[1]); u1.y = pk2(r1[2], r1[3]); u2.x = pk2(r2[0], r2[1]); u2.y = pk2(r2[2], r2[3]);
            *(GAS v2u*)(a.ikb + (size_t)t * 64 + e0) = u1; *(GAS v2u*)(a.ikb + (size_t)t * 64 + 32 + e0) = u2; } }
    { const unsigned long long nb = __builtin_amdgcn_ballot_w64(lane < 8 && sm[64 + (lane & 7)] < 0.f); if (lane == 0) a.sgn[t] = (unsigned char)(nb & 0xffull); }
    if (lane < 8) a.gif[(size_t)t * 8 + lane] = sm[72 + lane] + a.gbias[lane];
    {
        float acc[16];
#pragma unroll
        for (int i = 0; i < 16; ++i) acc[i] = 0.f;
#pragma unroll
        for (int j = 0; j < 4; ++j) { const int tt = t - 3 + j; if (tt >= 0) { const bf16* xp = a.proj + (size_t)tt * NPROJ + PC_MQ + 16 * lane; float xa[8], xb[8];
                bf8_unpack(*(const GAS v4u*)xp, xa); bf8_unpack(*(const GAS v4u*)(xp + 8), xb);
#pragma unroll
                for (int i = 0; i < 4; ++i) { acc[i] += cw[j * 4][i] * xa[i]; acc[4 + i] += cw[j * 4 + 1][i] * xa[4 + i]; acc[8 + i] += cw[j * 4 + 2][i] * xb[i]; acc[12 + i] += cw[j * 4 + 3][i] * xb[4 + i]; } } }
        float oa[8], ob[8];
#pragma unroll
        for (int i = 0; i < 8; ++i) { oa[i] = acc[i]; ob[i] = acc[8 + i]; }
        bf16* mp = a.mqk + (size_t)t * 1024 + 16 * lane; *(GAS v4u*)mp = bf8_pack(oa); *(GAS v4u*)(mp + 8) = bf8_pack(ob); }
}

__device__ __forceinline__ void score_wave_unit(const bf16* proj, const bf16* ikb, const unsigned char* sgn, float* sc, int qb, int kb, int lane) {
    const int r = lane & 31, h = lane >> 5, q0 = qb * 32, s0 = kb * 64;
    bf16x8 ka[2][4];
#pragma unroll
    for (int b = 0; b < 2; ++b)
#pragma unroll
        for (int kk = 0; kk < 4; ++kk) ka[b][kk] = *(const bf16x8*)(ikb + (size_t)(s0 + 32 * b + r) * 64 + 16 * kk + 8 * h);
    const bf16* qrow = proj + (size_t)(q0 + r) * NPROJ + PC_IQ + 8 * h;
    unsigned sg[4];
#pragma unroll
    for (int g = 0; g < 4; ++g) sg[g] = *(const unsigned*)(sgn + q0 + 8 * g + 4 * h);
    f32x16 scv[2];
#pragma unroll
    for (int b = 0; b < 2; ++b)
#pragma unroll
        for (int e = 0; e < 16; ++e) scv[b][e] = 0.f;
    bf16x8 qa[4], qb2[4];
#pragma unroll
    for (int kk = 0; kk < 4; ++kk) qa[kk] = *(const bf16x8*)(qrow + 16 * kk);
#define SCORE_HEAD(QF, j_) do { unsigned t_[4]; _Pragma("unroll") for (int g = 0; g < 4; ++g) t_[g] = sg[g] << (7 - (j_)); \
        _Pragma("unroll") for (int b = 0; b < 2; ++b) { f32x16 acc; _Pragma("unroll") for (int e = 0; e < 16; ++e) acc[e] = 0.f; \
        _Pragma("unroll") for (int kk = 0; kk < 4; ++kk) acc = __builtin_amdgcn_mfma_f32_32x32x16_bf16(QF[kk], ka[b][kk], acc, 0, 0, 0); \
        _Pragma("unroll") for (int e = 0; e < 16; ++e) { const unsigned sb = (t_[e >> 2] << (24 - 8 * (e & 3))) & 0x80000000u; scv[b][e] += __uint_as_float(__float_as_uint(fmaxf(acc[e], 0.f)) | sb); } } } while (0)
#pragma unroll 1
    for (int j = 0; j < 8; j += 2) {
#pragma unroll
        for (int kk = 0; kk < 4; ++kk) qb2[kk] = *(const bf16x8*)(qrow + (j + 1) * 64 + 16 * kk);
        __builtin_amdgcn_sched_barrier(0);
        SCORE_HEAD(qa, j);
        __builtin_amdgcn_sched_barrier(0);
        if (j + 2 < 8) {
#pragma unroll
            for (int kk = 0; kk < 4; ++kk) qa[kk] = *(const bf16x8*)(qrow + (j + 2) * 64 + 16 * kk); }
        __builtin_amdgcn_sched_barrier(0);
        SCORE_HEAD(qb2, j + 1);
    }
#undef SCORE_HEAD
#pragma unroll
    for (int b = 0; b < 2; ++b)
#pragma unroll
        for (int e = 0; e < 16; ++e) sc[(size_t)(q0 + (e & 3) + 8 * (e >> 2) + 4 * h) * S + s0 + 32 * b + r] = scv[b][e];
}


__device__ __forceinline__ float wave_max_dpp(float x) { return wave_max(x); }
__device__ __forceinline__ float wave_min_dpp(float x) { return -wave_max_dpp(-x); }
__device__ __forceinline__ unsigned wave_prefix_dpp(unsigned x) {
    unsigned y = x + dpp_u<0x111, 0xf, 0xf>(x); y += dpp_u<0x112, 0xf, 0xf>(x); y += dpp_u<0x113, 0xf, 0xf>(x);
    y += dpp_u<0x114, 0xf, 0xe>(y); y += dpp_u<0x118, 0xf, 0xc>(y); y += dpp_u<0x142, 0xa, 0xf>(y); y += dpp_u<0x143, 0xc, 0xf>(y);
    return y; }
#define SEL_BAR() do { asm volatile("s_waitcnt lgkmcnt(0)" ::: "memory"); __builtin_amdgcn_s_barrier(); asm volatile("" ::: "memory"); } while (0)
__device__ __forceinline__ void select_rows_wg(LAS unsigned char* lds, const float* sc, unsigned long long* mb, int row0, int rstep, int tid) {
    LAS unsigned* hist = (LAS unsigned*)lds;
    LAS unsigned* btot = hist + 2176;
    LAS float* red = (LAS float*)(hist + 2240); LAS unsigned* lcnt = hist + 2256;
    LAS float* lval = (LAS float*)(hist + 2272); LAS int* lidx = (LAS int*)(hist + 2272 + 8192); LAS unsigned* lsel = hist + 2272 + 16384;
    const int lane = tid & 63, w = tid >> 6;
    float nx[16];
#define SEL_LOAD(t_) do { const float* scr_ = sc + (size_t)(t_) * S + tid; _Pragma("unroll") for (int i = 0; i < 16; ++i) nx[i] = scr_[i * 512]; } while (0)
    if (row0 < S) SEL_LOAD(row0);
    if (tid < 2) lcnt[tid] = 0u;
    for (int j = tid; j < 2240; j += NTHR) hist[j] = 0u;
    if (tid == 0) lsel[0] = 0u;
    int par = 0;
    for (int t = row0; t < S; t += rstep) {
        float v[16];
#pragma unroll
        for (int i = 0; i < 16; ++i) v[i] = (i * 512 + tid <= t) ? nx[i] : -3.0e38f;
        if (t + rstep < S) SEL_LOAD(t + rstep);
        unsigned long long* mbr = mb + (size_t)t * 128;
        unsigned long long mword = 0ull;
        if (t >= 256) {
            const int nround = (t >> 9) + 1;
            float mn = 3.0e38f, mx = -3.0e38f;
#pragma unroll
            for (int i = 0; i < 16; ++i) { mx = fmaxf(mx, v[i]); mn = fminf(mn, (i * 512 + tid <= t) ? v[i] : 3.0e38f); }
            mn = wave_min_dpp(mn); mx = wave_max_dpp(mx);
            if (lane == 0) { red[w] = mn; red[8 + w] = mx; }
            SEL_BAR();
            mn = red[0]; mx = red[8];
#pragma unroll
            for (int j = 1; j < 8; ++j) { mn = fminf(mn, red[j]); mx = fmaxf(mx, red[8 + j]); }
            const float scale = (mx > mn) ? 2047.0f / (mx - mn) : 0.f;
            int bin[16];
#pragma unroll
            for (int i = 0; i < 16; ++i) { int b = (int)((v[i] - mn) * scale); b = b < 0 ? 0 : (b > 2047 ? 2047 : b); const bool ok = i * 512 + tid <= t; bin[i] = ok ? b : -1;
                if (i < nround) { (void)__hip_atomic_fetch_add(hist + (ok ? b + (b >> 5) : 2112 + lane), 1u, __ATOMIC_RELAXED, __HIP_MEMORY_SCOPE_WORKGROUP);
                    (void)__hip_atomic_fetch_add(btot + (ok ? (b >> 5) : 0), ok ? 1u : 0u, __ATOMIC_RELAXED, __HIP_MEMORY_SCOPE_WORKGROUP); } }
            SEL_BAR();
            const unsigned bt = btot[63 - lane]; const unsigned sufb = wave_prefix_dpp(bt);
            const unsigned long long ob = __builtin_amdgcn_ballot_w64(sufb >= 256u);
            const int olb = ob ? (int)__builtin_ctzll(ob) : 0; const int blk = 63 - olb;
            const unsigned above_blk = (unsigned)__builtin_amdgcn_readlane((int)(sufb - bt), olb);
            const unsigned hbn = (lane < 32) ? hist[33 * blk + 31 - lane] : 0u; const unsigned sufn = wave_prefix_dpp(hbn) + above_blk;
            const unsigned long long on = __builtin_amdgcn_ballot_w64(lane < 32 && sufn >= 256u);
            const int oln = on ? (int)__builtin_ctzll(on) : 0;
            const int bstar = 32 * blk + 31 - oln; const unsigned need = 256u - (unsigned)__builtin_amdgcn_readlane((int)(sufn - hbn), oln);
            int ks[16];
#pragma unroll
            for (int i = 0; i < 16; ++i) { ks[i] = -1; if (bin[i] == bstar) { const unsigned k = __hip_atomic_fetch_add(lcnt + par, 1u, __ATOMIC_RELAXED, __HIP_MEMORY_SCOPE_WORKGROUP); lval[k] = v[i]; lidx[k] = i * 512 + tid; ks[i] = (int)k; } }
            SEL_BAR();
            const int nl = (int)lcnt[par];
            for (int k = tid; k < nl; k += NTHR) { const float x = lval[k]; const int s = lidx[k]; unsigned rank = 0u;
                for (int j = 0; j < nl; ++j) { const float y = lval[j]; const int sj = lidx[j]; rank += (y > x || (y == x && sj < s)) ? 1u : 0u; }
                lsel[k] = rank < need ? 1u : 0u; }
            SEL_BAR();
#pragma unroll
            for (int i = 0; i < 16; ++i) { const unsigned lv = lsel[ks[i] < 0 ? 0 : ks[i]]; const bool sel = bin[i] > bstar || (ks[i] >= 0 && lv != 0u);
                const unsigned long long m = __builtin_amdgcn_ballot_w64(sel); mword = (lane == i) ? m : mword; }
#pragma unroll
            for (int i = 0; i < 16; ++i) if (i < nround) hist[bin[i] >= 0 ? bin[i] + (bin[i] >> 5) : 2112 + lane] = 0u;
            if (tid < 64) btot[tid] = 0u;
            if (tid == 0) lcnt[par ^ 1] = 0u;
            par ^= 1;
        } else {
#pragma unroll
            for (int i = 0; i < 16; ++i) { const unsigned long long m = __builtin_amdgcn_ballot_w64(i * 512 + tid <= t); mword = (lane == i) ? m : mword; }
        }
        if (lane < 16) mbr[lane * 8 + w] = mword;
    }
    SEL_BAR();
#undef SEL_LOAD
}

template <int RS> __device__ __forceinline__ bf16x8 frag_row(const LAS unsigned char* base, int r0, int k0, int lane) {
    return *(const LAS bf16x8*)(base + (r0 + (lane & 15)) * RS + (k0 + 8 * (lane >> 4)) * 2);
}
template <int RS> __device__ __forceinline__ bf16x8 frag_tr(const LAS unsigned char* base, int k0, int c0, int lane) {
    const int g = lane >> 4, q = (lane & 15) >> 2, p = lane & 3;
    const unsigned a = (unsigned)(size_t)(base + (k0 + 8 * g + q) * RS + (c0 + 4 * p) * 2);
    s16x4 lo, hi;
    asm volatile("ds_read_b64_tr_b16 %0, %2\n\tds_read_b64_tr_b16 %1, %2 offset:%3\n\ts_waitcnt lgkmcnt(0)" : "=&v"(lo), "=&v"(hi) : "v"(a), "i"(4 * RS) : "memory");
    return (bf16x8){lo[0], lo[1], lo[2], lo[3], hi[0], hi[1], hi[2], hi[3]};
}
#define MFMA16(a, b, c) __builtin_amdgcn_mfma_f32_16x16x32_bf16((a), (b), (c), 0, 0, 0)
constexpr int SCR_OFF = 114688;
constexpr float DK_SCALE = 0.08838834764831845f;
__device__ __forceinline__ float log_sigmoid_f(float x) { return fminf(x, 0.f) - log1pf(expf(-fabsf(x))); }

template <int L, int DV> __device__ __forceinline__ void chunk_delta(LAS unsigned char* lds, const bf16* ksrc, int ldk, const bf16* vsrc, int ldv, const LAS float* wcol, bf16* outT, float* dn, int tid) {
    constexpr int RSK = (128 + 8) * 2, RSV = (DV + 8) * 2, NCB = DV / 128;
    LAS unsigned char* KA = lds; LAS unsigned char* V = lds + L * RSK;
    const int lane = tid & 63, w = tid >> 6;
    for (int idx = tid; idx < L * 16; idx += NTHR) { const int s = idx >> 4, c8 = idx & 15;
        const v4u x = *(const GAS v4u*)(ksrc + (size_t)s * ldk + c8 * 8); const float sc = DK_SCALE * wcol[s]; v4u o;
        o.x = pk2(__uint_as_float(x.x << 16) * sc, __uint_as_float(x.x & 0xffff0000u) * sc); o.y = pk2(__uint_as_float(x.y << 16) * sc, __uint_as_float(x.y & 0xffff0000u) * sc);
        o.z = pk2(__uint_as_float(x.z << 16) * sc, __uint_as_float(x.z & 0xffff0000u) * sc); o.w = pk2(__uint_as_float(x.w << 16) * sc, __uint_as_float(x.w & 0xffff0000u) * sc);
        *(LAS v4u*)(KA + s * RSK + c8 * 16) = o; }
    for (int idx = tid; idx < L * (DV / 8); idx += NTHR) { const int s = idx / (DV / 8), c8 = idx % (DV / 8);
        *(LAS v4u*)(V + s * RSV + c8 * 16) = *(const GAS v4u*)(vsrc + (size_t)s * ldv + c8 * 8); }
    __syncthreads();
    f32x4 acc[8][NCB];
#pragma unroll
    for (int db = 0; db < 8; ++db)
#pragma unroll
        for (int i = 0; i < NCB; ++i) acc[db][i] = (f32x4){0.f, 0.f, 0.f, 0.f};
#pragma unroll
    for (int kk = 0; kk < L / 32; ++kk) {
        bf16x8 bfr[NCB];
#pragma unroll
        for (int i = 0; i < NCB; ++i) bfr[i] = frag_tr<RSV>(V, 32 * kk, 16 * (w * NCB + i), lane);
#pragma unroll
        for (int db = 0; db < 8; ++db) { const bf16x8 a = frag_tr<RSK>(KA, 32 * kk, 16 * db, lane);
#pragma unroll
            for (int i = 0; i < NCB; ++i) acc[db][i] = MFMA16(a, bfr[i], acc[db][i]); }
    }
#pragma unroll
    for (int db = 0; db < 8; ++db)
#pragma unroll
        for (int i = 0; i < NCB; ++i) { const int e = 16 * (w * NCB + i) + (lane & 15), d0 = 16 * db + 4 * (lane >> 4);
            v2u o; o.x = pk2(acc[db][i][0], acc[db][i][1]); o.y = pk2(acc[db][i][2], acc[db][i][3]);
            *(GAS v2u*)(outT + (size_t)e * 128 + d0) = o; }
    if (dn != nullptr && tid < 128) { float s_ = 0.f;
        for (int s = 0; s < L; ++s) s_ += bf2f(*(const LAS bf16*)(KA + s * RSK + tid * 2));
        dn[tid] = s_; }
    __syncthreads();
}

template <int L, int DV, int MODE> __device__ __forceinline__ void chunk_out(LAS unsigned char* lds, LAS float* sf, const bf16* qsrc, int ldq, const bf16* ksrc, int ldk, const bf16* vsrc, int ldv,
                                                                              const bf16* stT, const float* gain, const bf16* gate, int ldg, bf16* y, int ldy, int tid) {
    constexpr int RSQ = (128 + 8) * 2, RSV = (DV + 8) * 2, RSP = (L + 8) * 2, NCB = DV / 128, NT = L / 16, TPW = NT * NT / 8;
    LAS unsigned char* Q = lds; LAS unsigned char* K = lds + L * RSQ; LAS unsigned char* V = lds + 2 * L * RSQ;
    LAS unsigned char* P = (MODE == 0) ? (lds + 2 * L * RSQ + L * RSV) : K;
    LAS float* H = (LAS float*)lds;
    LAS float* lrow = sf; LAS float* lcol = sf + 128; LAS float* qs = sf + 256; LAS float* flo = sf + 384; LAS float* rowsum = sf + 512; LAS float* npv = sf + 640; LAS float* part = sf + 768; LAS float* dpart = sf + 768 + L * NT;
    const int lane = tid & 63, w = tid >> 6, g4 = lane >> 4, c16 = lane & 15;
    for (int idx = tid; idx < L * 16; idx += NTHR) { const int s = idx >> 4, c8 = idx & 15;
        *(LAS v4u*)(Q + s * RSQ + c8 * 16) = *(const GAS v4u*)(qsrc + (size_t)s * ldq + c8 * 8);
        *(LAS v4u*)(K + s * RSQ + c8 * 16) = *(const GAS v4u*)(ksrc + (size_t)s * ldk + c8 * 8); }
    for (int idx = tid; idx < L * (DV / 8); idx += NTHR) { const int s = idx / (DV / 8), c8 = idx % (DV / 8);
        *(LAS v4u*)(V + s * RSV + c8 * 16) = *(const GAS v4u*)(vsrc + (size_t)s * ldv + c8 * 8); }
    __syncthreads();
    f32x4 pv[TPW];
#pragma unroll
    for (int i = 0; i < TPW; ++i) { const int ti = w * TPW + i, rb = ti / NT, cb = ti % NT; f32x4 a = (f32x4){0.f, 0.f, 0.f, 0.f};
        if (cb <= rb) {
#pragma unroll
            for (int kk = 0; kk < 4; ++kk) a = MFMA16(frag_row<RSQ>(Q, 16 * rb, 32 * kk, lane), frag_row<RSQ>(K, 16 * cb, 32 * kk, lane), a);
            const int s = 16 * cb + c16; const float lc = lcol[s]; float rs[4];
#pragma unroll
            for (int r = 0; r < 4; ++r) { const int t = 16 * rb + 4 * g4 + r; const float pw = (s <= t) ? __expf(lrow[t] + lc) * a[r] * DK_SCALE : 0.f; a[r] = pw; rs[r] = pw; }
            if (MODE == 0) {
#pragma unroll
                for (int r = 0; r < 4; ++r) { float v = rs[r]; v += dpp_f<0xB1, 0xf, 0xf>(0.f, v); v += dpp_f<0x4E, 0xf, 0xf>(0.f, v); v += dpp_f<0x141, 0xf, 0xf>(0.f, v); v += dpp_f<0x140, 0xf, 0xf>(0.f, v);
                    if (c16 == 0) part[(16 * rb + 4 * g4 + r) * NT + cb] = v; } }
        } else if (MODE == 0) { if (c16 == 0) {
#pragma unroll
                for (int r = 0; r < 4; ++r) part[(16 * rb + 4 * g4 + r) * NT + cb] = 0.f; } }
        pv[i] = a; }
    __syncthreads();
#pragma unroll
    for (int i = 0; i < TPW; ++i) { const int ti = w * TPW + i, rb = ti / NT, cb = ti % NT;
#pragma unroll
        for (int r = 0; r < 4; ++r) *(LAS bf16*)(P + (16 * rb + 4 * g4 + r) * RSP + (16 * cb + c16) * 2) = (bf16)f2bf(pv[i][r]); }
    for (int idx = tid; idx < L * 16; idx += NTHR) { const int s = idx >> 4, c8 = idx & 15; const float sc = qs[s];
        const v4u x = *(const LAS v4u*)(Q + s * RSQ + c8 * 16); float f[8];
        f[0] = __uint_as_float(x.x << 16) * sc; f[1] = __uint_as_float(x.x & 0xffff0000u) * sc; f[2] = __uint_as_float(x.y << 16) * sc; f[3] = __uint_as_float(x.y & 0xffff0000u) * sc;
        f[4] = __uint_as_float(x.z << 16) * sc; f[5] = __uint_as_float(x.z & 0xffff0000u) * sc; f[6] = __uint_as_float(x.w << 16) * sc; f[7] = __uint_as_float(x.w & 0xffff0000u) * sc;
        v4u o; o.x = pk2(f[0], f[1]); o.y = pk2(f[2], f[3]); o.z = pk2(f[4], f[5]); o.w = pk2(f[6], f[7]);
        *(LAS v4u*)(Q + s * RSQ + c8 * 16) = o;
        if (MODE == 0) { float dsum = 0.f;
#pragma unroll
            for (int j = 0; j < 8; ++j) dsum += f[j] * npv[8 * c8 + j];
            dpart[s * 16 + c8] = dsum; } }
    __syncthreads();
    if (MODE == 0 && tid < L) { float a = 0.f;
#pragma unroll
        for (int j = 0; j < NT; ++j) a += part[tid * NT + j];
#pragma unroll
        for (int j = 0; j < 16; ++j) a += dpart[tid * 16 + j];
        rowsum[tid] = a; }
    f32x4 acc[NT][NCB];
#pragma unroll
    for (int rb = 0; rb < NT; ++rb)
#pragma unroll
        for (int i = 0; i < NCB; ++i) acc[rb][i] = (f32x4){0.f, 0.f, 0.f, 0.f};
#pragma unroll
    for (int kk = 0; kk < 4; ++kk) { bf16x8 bfr[NCB];
#pragma unroll
        for (int i = 0; i < NCB; ++i) bfr[i] = *(const GAS bf16x8*)(stT + (size_t)(16 * (w * NCB + i) + c16) * 128 + 32 * kk + 8 * g4);
#pragma unroll
        for (int rb = 0; rb < NT; ++rb) { const bf16x8 a = frag_row<RSQ>(Q, 16 * rb, 32 * kk, lane);
#pragma unroll
            for (int i = 0; i < NCB; ++i) acc[rb][i] = MFMA16(a, bfr[i], acc[rb][i]); } }
#pragma unroll
    for (int kk = 0; kk < L / 32; ++kk) { bf16x8 bfr[NCB];
#pragma unroll
        for (int i = 0; i < NCB; ++i) bfr[i] = frag_tr<RSV>(V, 32 * kk, 16 * (w * NCB + i), lane);
#pragma unroll
        for (int rb = 0; rb < NT; ++rb) { const bf16x8 a = frag_row<RSP>(P, 16 * rb, 32 * kk, lane);
#pragma unroll
            for (int i = 0; i < NCB; ++i) acc[rb][i] = MFMA16(a, bfr[i], acc[rb][i]); } }
    __syncthreads();
#pragma unroll
    for (int rb = 0; rb < NT; ++rb)
#pragma unroll
        for (int i = 0; i < NCB; ++i)
#pragma unroll
            for (int r = 0; r < 4; ++r) { const int t = 16 * rb + 4 * g4 + r, e = 16 * (w * NCB + i) + c16; float hv = acc[rb][i][r];
                if (MODE == 0) hv = hv / fmaxf(fabsf(rowsum[t]), flo[t]);
                H[t * DV + e] = hv; }
    __syncthreads();
    for (int t = w; t < L; t += NWAVES) { float hv[DV / 64]; float s1 = 0.f;
#pragma unroll
        for (int i = 0; i < DV / 64; ++i) { hv[i] = H[t * DV + lane + 64 * i]; s1 += hv[i]; }
        float mu = 0.f; if (MODE == 1) { mu = wave_sum(s1) * (1.f / DV); }
        float s2 = 0.f;
#pragma unroll
        for (int i = 0; i < DV / 64; ++i) { hv[i] -= mu; s2 += hv[i] * hv[i]; }
        const float rstd = 1.0f / sqrtf(wave_sum(s2) * (1.f / DV) + NORM_EPS);
#pragma unroll
        for (int i = 0; i < DV / 64; ++i) { const int e = lane + 64 * i; const float gt = bf2f(gate[(size_t)t * ldg + e]);
            const float act = (MODE == 0) ? sigmoid_f(gt) : gt * sigmoid_f(gt);
            y[(size_t)t * ldy + e] = (bf16)f2bf(hv[i] * rstd * gain[e] * act); } }
    __syncthreads();
}
namespace att {
constexpr int D = 128, LDQKV = NPROJ, LDO = 1024;
constexpr float THR = 8.f; constexpr bool WSKIP = false;
constexpr float SCALE = 0.08838834764831845f;
constexpr int NW = 8, QBLK = 32, KVBLK = 64, QB = NW * QBLK;
constexpr int SHM_V = KVBLK * D * 2, SHM_K = KVBLK * D * 2;
constexpr int LDS_BYTES = 2 * SHM_V + 2 * SHM_K + NW * 64 * 4;

using bf16 = unsigned short;
typedef short bf16x8 __attribute__((ext_vector_type(8)));
typedef short s16x4 __attribute__((ext_vector_type(4)));
typedef float f32x16 __attribute__((ext_vector_type(16)));
typedef float f32x4 __attribute__((ext_vector_type(4)));
typedef unsigned u32x4 __attribute__((ext_vector_type(4)));
template <class A, class Bt> struct same_t { static constexpr bool v = false; };
template <class A> struct same_t<A, A> { static constexpr bool v = true; };

#define KSWZ(row, colB) ((row) * 256 + ((colB) ^ (((row) & 7) << 4)))
#define SBAR() __builtin_amdgcn_sched_barrier(0)
__device__ __forceinline__ int v_st(int k, int c) { const int kk = (k & ~0xC) | ((k & 4) << 1) | ((k & 8) >> 1); return ((kk >> 3) * 4 + (c >> 5)) * 512 + ((kk & 7) * 32 + (c & 31)) * 2; }
__device__ __forceinline__ int v_rd_base(int lane) { return ((lane & 3) << 3) | (((lane >> 2) & 3) << 6) | (((lane >> 4) & 1) << 5) | (((lane >> 5) & 1) << 8); }
constexpr int v_rd_off(int d0, int ks, int half) { return d0 * 512 + ks * 4096 + half * 2048; }
__device__ __forceinline__ int crow(int r, int hi) { return (r & 3) + 8 * (r >> 2) + 4 * hi; }
__device__ __forceinline__ unsigned cvtpk(float lo, float hi) {
    unsigned r; asm volatile("v_cvt_pk_bf16_f32 %0, %1, %2" : "=v"(r) : "v"(lo), "v"(hi)); return r;
}
__device__ __forceinline__ bf16x8 pack8(f32x4 a, f32x4 b) {
    u32x4 w = {cvtpk(a[0], a[1]), cvtpk(a[2], a[3]), cvtpk(b[0], b[1]), cvtpk(b[2], b[3])};
    return *reinterpret_cast<bf16x8*>(&w);
}
template <class T> __device__ __forceinline__ bf16x8 load8(const T* p) {
    if constexpr (same_t<T, float>::v) { return pack8(*(const f32x4*)p, *(const f32x4*)(p + 4)); }
    else { return *reinterpret_cast<const bf16x8*>(p); }
}
__device__ __forceinline__ unsigned long long mask_word(const char* tile_base, int row) { unsigned off = (unsigned)row; asm volatile("" : "+v"(off)); off *= 1024u; return *(const unsigned long long*)(tile_base + off); }
__device__ __forceinline__ void mask_bits(f32x16& p0, f32x16& p1, unsigned long long mw, int hi) {
    const unsigned a = (unsigned)mw >> (4 * hi), b = (unsigned)(mw >> 32) >> (4 * hi);
#pragma unroll
    for (int r = 0; r < 16; ++r) {
        const int c = (r & 3) + 8 * (r >> 2);
        const unsigned ma = (unsigned)(((int)(a << (31 - c))) >> 31), mb = (unsigned)(((int)(b << (31 - c))) >> 31);
        p0[r] = __uint_as_float((__float_as_uint(p0[r]) & ma) | (0xff800000u & ~ma));
        p1[r] = __uint_as_float((__float_as_uint(p1[r]) & mb) | (0xff800000u & ~mb));
    }
}
__device__ __forceinline__ void partialSM(f32x16& p0, f32x16& p1, float& m_reg, float& mn, float& alpha) {
    float pmax = p0[0]; for (int r = 1; r < 16; ++r) pmax = fmaxf(pmax, p0[r]); for (int r = 0; r < 16; ++r) pmax = fmaxf(pmax, p1[r]);
    { auto rr = __builtin_amdgcn_permlane32_swap(__float_as_uint(pmax), __float_as_uint(pmax), false, false);
      pmax = fmaxf(__uint_as_float(rr[0]), __uint_as_float(rr[1])); }
    constexpr float C2 = 1.4426950408889634f * SCALE;
    if (__builtin_expect(__all((pmax - m_reg) * SCALE <= THR), 1)) { mn = m_reg; alpha = 1.f; }
    else { mn = fmaxf(m_reg, pmax); alpha = __builtin_amdgcn_exp2f((m_reg - mn) * C2); m_reg = mn; }
    const float mnL = -mn * C2;
    for (int r = 0; r < 16; ++r) p0[r] = fmaf(p0[r], C2, mnL); for (int r = 0; r < 16; ++r) p1[r] = fmaf(p1[r], C2, mnL);
    for (int r = 0; r < 16; ++r) p0[r] = __builtin_amdgcn_exp2f(p0[r]);
}
__device__ __forceinline__ void finishSM(f32x16& p0, f32x16& p1, float alpha, float& l_reg, bf16x8& pa0, bf16x8& pa1, bf16x8& pa2, bf16x8& pa3) {
    for (int r = 0; r < 16; ++r) p1[r] = __builtin_amdgcn_exp2f(p1[r]);
    float ps = 0; for (int r = 0; r < 16; ++r) ps += p0[r]; for (int r = 0; r < 16; ++r) ps += p1[r];
    { auto rr = __builtin_amdgcn_permlane32_swap(__float_as_uint(ps), __float_as_uint(ps), false, false);
      ps = __uint_as_float(rr[0]) + __uint_as_float(rr[1]); }
    l_reg = l_reg * alpha + ps;
#define PK4(P, B_, OUT) do { unsigned a0 = cvtpk(P[B_+0], P[B_+1]), a1 = cvtpk(P[B_+2], P[B_+3]);                          \
        unsigned b0 = cvtpk(P[B_+4], P[B_+5]), b1 = cvtpk(P[B_+6], P[B_+7]);                                             \
        auto r0 = __builtin_amdgcn_permlane32_swap(a0, b0, false, false); auto r1 = __builtin_amdgcn_permlane32_swap(a1, b1, false, false); \
        u32x4 w = {r0[0], r1[0], r0[1], r1[1]}; OUT = *reinterpret_cast<bf16x8*>(&w); } while (0)
    PK4(p0, 0, pa0); PK4(p0, 8, pa1); PK4(p1, 0, pa2); PK4(p1, 8, pa3);
#undef PK4
}
template <int KB, bool SK>
__device__ __forceinline__ void qkt(f32x16& p0, f32x16& p1, const char* K_lds, int r32, int hi, const bf16x8* qr, bool act) {
    if (SK && !act) { const float NEG = -__builtin_inff();
#pragma unroll
        for (int r = 0; r < 16; ++r) { p0[r] = NEG; p1[r] = NEG; } return; }
    p0 = f32x16{}; p1 = f32x16{};
    const char* kb[4];
#pragma unroll
    for (int dd = 0; dd < 4; ++dd) kb[dd] = K_lds + KB * SHM_K + KSWZ(r32, (dd * 16 + hi * 8) * 2);
#pragma unroll
    for (int d0 = 0; d0 < 8; ++d0) { const char* a = kb[d0 & 3] + (d0 >> 2) * 128;
        bf16x8 b0 = *reinterpret_cast<const bf16x8*>(a);
        bf16x8 b1 = *reinterpret_cast<const bf16x8*>(a + 32 * 256);
        p0 = __builtin_amdgcn_mfma_f32_32x32x16_bf16(b0, qr[d0], p0, 0, 0, 0);
        p1 = __builtin_amdgcn_mfma_f32_32x32x16_bf16(b1, qr[d0], p1, 0, 0, 0); }
}
template <int VB, bool SK>
__device__ __forceinline__ void pv_tile(f32x16* o, int vb0, bf16x8 pa0, bf16x8 pa1, bf16x8 pa2, bf16x8 pa3, bool act) {
    if (SK && !act) return;
#define TRRD(dst, off) asm volatile("ds_read_b64_tr_b16 %0, %1 offset:%2" : "=&v"(dst) : "v"(vb0), "i"(off) : "memory")
#define PV_D0(d0) do { s16x4 l0, l1, l2, l3, h0, h1, h2, h3; constexpr int b_ = VB * SHM_V + v_rd_off(d0, 0, 0);     \
        TRRD(l0, b_); TRRD(h0, b_ + 2048); TRRD(l1, b_ + 4096); TRRD(h1, b_ + 6144); TRRD(l2, b_ + 8192); TRRD(h2, b_ + 10240); TRRD(l3, b_ + 12288); TRRD(h3, b_ + 14336); \
        asm volatile("s_waitcnt lgkmcnt(0)" ::: "memory"); SBAR();                 \
        o[d0] = __builtin_amdgcn_mfma_f32_32x32x16_bf16(pa0, (bf16x8){l0[0], l0[1], l0[2], l0[3], h0[0], h0[1], h0[2], h0[3]}, o[d0], 0, 0, 0);   \
        o[d0] = __builtin_amdgcn_mfma_f32_32x32x16_bf16(pa1, (bf16x8){l1[0], l1[1], l1[2], l1[3], h1[0], h1[1], h1[2], h1[3]}, o[d0], 0, 0, 0);   \
        o[d0] = __builtin_amdgcn_mfma_f32_32x32x16_bf16(pa2, (bf16x8){l2[0], l2[1], l2[2], l2[3], h2[0], h2[1], h2[2], h2[3]}, o[d0], 0, 0, 0);   \
        o[d0] = __builtin_amdgcn_mfma_f32_32x32x16_bf16(pa3, (bf16x8){l3[0], l3[1], l3[2], l3[3], h3[0], h3[1], h3[2], h3[3]}, o[d0], 0, 0, 0); } while (0)
    PV_D0(0); PV_D0(1); PV_D0(2); PV_D0(3);
#undef PV_D0
#undef TRRD
}

template <class TIn, class TOut> struct BlockRef { const TIn* Q; const TIn* K; const TIn* V; TOut* O; const unsigned long long* M; int P0; };
template <class TIn> struct Seam {
    bf16x8 qr[8];
    bf16x8 st_v0, st_v1, st_k0, st_k1; f32x4 sf0, sf1, sf2, sf3;
    f32x4 tq[16];
};
__device__ __forceinline__ int swa_jlo(int P0, int W) { const int lowk = P0 - W + 1; return lowk > 0 ? lowk / KVBLK : 0; }
#define ROW(p, k0, rr) ((p) + (size_t)((k0) + (rr)) * LDQKV + sc)
#define VMW() asm volatile("s_waitcnt vmcnt(0)" ::: "memory")
#define VMWN(n) asm volatile("s_waitcnt vmcnt(%0)" :: "i"(n) : "memory")
#define LD16U(base, off) (*reinterpret_cast<const bf16x8*>((const char*)(base) + (off)))
#define SLOAD_H(Kp, Vp, k0) do { const char* kb_ = (const char*)((Kp) + (size_t)(k0) * LDQKV); const char* vb_ = (const char*)((Vp) + (size_t)(k0) * LDQKV);                 \
                         S.st_v0 = LD16U(vb_, soff); S.st_v1 = LD16U(vb_ + (size_t)32 * LDQKV * 2, soff);                                  \
                         S.st_k0 = LD16U(kb_, soff); S.st_k1 = LD16U(kb_ + (size_t)32 * LDQKV * 2, soff); } while (0)
#define SWRITE_HK(bf) do { *(bf16x8*)(K_lds + (bf) * SHM_K + kws) = S.st_k0; *(bf16x8*)(K_lds + (bf) * SHM_K + kws + 32 * 256) = S.st_k1; } while (0)
#define SWRITE_HV(bf) do { *(bf16x8*)(V_lds + (bf) * SHM_V + vst0) = S.st_v0; *(bf16x8*)(V_lds + (bf) * SHM_V + vst1) = S.st_v1; } while (0)
#define SWRITE_H(bf) do { SWRITE_HV(bf); SWRITE_HK(bf); } while (0)
#define SLOAD_F(p, k0) do { S.sf0 = *(const f32x4*)ROW(p, k0, sr); S.sf1 = *(const f32x4*)(ROW(p, k0, sr) + 4);                \
                            S.sf2 = *(const f32x4*)ROW(p, k0, 32 + sr); S.sf3 = *(const f32x4*)(ROW(p, k0, 32 + sr) + 4); } while (0)
#define SWRITE_KF(bf) do { *(bf16x8*)(K_lds + (bf) * SHM_K + kws) = pack8(S.sf0, S.sf1); *(bf16x8*)(K_lds + (bf) * SHM_K + kws + 32 * 256) = pack8(S.sf2, S.sf3); } while (0)
#define SWRITE_VF(bf) do { *(bf16x8*)(V_lds + (bf) * SHM_V + vst0) = pack8(S.sf0, S.sf1); *(bf16x8*)(V_lds + (bf) * SHM_V + vst1) = pack8(S.sf2, S.sf3); } while (0)
template <class TIn, class TOut>
__device__ __forceinline__ void causal_swa_prime(const BlockRef<TIn, TOut>& cur, int W, char* lds, Seam<TIn>& S) {
    constexpr bool F32 = same_t<TIn, float>::v;
    int tid_o = my_tid(); asm volatile("" : "+v"(tid_o));
    const int tid = tid_o, wid = __builtin_amdgcn_readfirstlane(tid >> 6), lane = tid & 63, r32 = lane & 31, hi = lane >> 5;
    const int sr = tid >> 4, sc = (tid & 15) * 8, kws = KSWZ(sr, sc * 2); char* K_lds = lds + 2 * SHM_V; const unsigned soff = (unsigned)(sr * LDQKV + sc) * 2u;
    const int kb0 = swa_jlo(cur.P0, W) * KVBLK;
    for (int d0 = 0; d0 < 8; ++d0) S.qr[d0] = load8<TIn>(cur.Q + (size_t)(wid * QBLK + r32) * LDQKV + d0 * 16 + hi * 8);
    if constexpr (F32) { SLOAD_F((const float*)cur.K, kb0); VMW(); SWRITE_KF(0); SBAR(); SLOAD_F((const float*)cur.V, kb0); }
    else { SLOAD_H(cur.K, cur.V, kb0); VMW(); SWRITE_HK(0); }
    __syncthreads();
}
template <class TIn, class TOut>
__device__ __forceinline__ void causal_swa_block(const BlockRef<TIn, TOut>& cur, const BlockRef<TIn, TOut>& nxt, int skv, int W, char* lds, Seam<TIn>& S) {
    constexpr bool F32 = same_t<TIn, float>::v;
    int tid_o = my_tid(); asm volatile("" : "+v"(tid_o));
    const int tid = tid_o, wid = __builtin_amdgcn_readfirstlane(tid >> 6), lane = tid & 63, r32 = lane & 31, hi = lane >> 5;
    const int j_lo = swa_jlo(cur.P0, W);
    int j_hi = (cur.P0 + QB - 1) / KVBLK + 1; if (j_hi > skv / KVBLK) j_hi = skv / KVBLK;
    const int NT = j_hi - j_lo;
    const int kbn = swa_jlo(nxt.P0, W) * KVBLK;
    const int qlo = cur.P0 + wid * QBLK, qm = qlo + r32 - 4 * hi;
    char* V_lds = lds; char* K_lds = lds + 2 * SHM_V;
    float* ws = (float*)(lds + 2 * SHM_V + 2 * SHM_K) + wid * 64; float* li_l = ws, * al_l = ws + 32;
    float m_reg = -1e30f, l_reg = 0; f32x16 o[4] = {};
    const unsigned soff = (unsigned)((tid >> 4) * LDQKV + (tid & 15) * 8) * 2u;
    const int sr = tid >> 4, sc = (tid & 15) * 8, vst0 = v_st(sr, sc), vst1 = v_st(32 + sr, sc), kws = KSWZ(sr, sc * 2);
    const int vb0 = (int)(uintptr_t)V_lds + v_rd_base(lane);
    const TIn* Kh = cur.K; const TIn* Vh = cur.V;
#define RESC(a) do { if (__any((a) < 1.f)) { if (hi == 0) al_l[r32] = (a); asm volatile("s_waitcnt lgkmcnt(0)" ::: "memory");              \
                     for (int d_ = 0; d_ < 4; ++d_) for (int r = 0; r < 16; ++r) o[d_][r] *= al_l[crow(r, hi)]; } } while (0)
#define KBASE(t) ((j_lo + (t)) * KVBLK)
#define ACT(t) (KBASE(t) <= qlo + QBLK - 1 && KBASE(t) + KVBLK - 1 >= qlo - W + 1)
#define MASKT(P0_, P1_, mw_) mask_bits(P0_, P1_, mw_, hi)
#define MLOAD(t) mask_word((const char*)cur.M + (size_t)((j_lo + (t)) * 8), wid * QBLK + r32)
    constexpr int NQL = F32 ? 16 : 8;
    constexpr bool SK = WSKIP && !F32;
#define SEAM_K0() do { VMWN(NQL); if constexpr (F32) { SWRITE_KF(0); SBAR(); SLOAD_F((const float*)nxt.V, kbn); } else { SWRITE_HK(0); } SBAR(); } while (0)
    f32x16 pA0, pA1, pB0, pB1; float mnA, mnB, alA, alB; bf16x8 pa0, pa1, pa2, pa3;
    if constexpr (F32) { VMW(); SWRITE_VF(0); SBAR(); } else { SWRITE_HV(0); SBAR(); }
    if (NT > 1) { if constexpr (F32) SLOAD_F((const float*)Kh, KBASE(1)); else SLOAD_H(Kh, Vh, KBASE(1)); }
    SBAR(); qkt<0, SK>(pA0, pA1, K_lds, r32, hi, S.qr, ACT(0));
    if constexpr (F32) { if (NT > 1) { VMW(); SWRITE_KF(1); SBAR(); SLOAD_F((const float*)Vh, KBASE(1)); } }
    MASKT(pA0, pA1, MLOAD(0)); partialSM(pA0, pA1, m_reg, mnA, alA);
    if (NT > 1) { VMW(); if constexpr (F32) { SWRITE_VF(1); SBAR(); if (NT > 2) SLOAD_F((const float*)Kh, KBASE(2)); } else SWRITE_H(1); }
    __syncthreads();
#define HALF_STEP(PX0, PX1, mnX, alX, PY0, PY1, alY, t, KB, VB, SB) do {                                                      \
        SBAR(); qkt<KB, SK>(PX0, PX1, K_lds, r32, hi, S.qr, ACT(t));                                             \
        finishSM(PY0, PY1, alY, l_reg, pa0, pa1, pa2, pa3); SBAR();                                                           \
        if ((t) + 1 < NT) { if constexpr (F32) { VMW(); SWRITE_KF(SB); SBAR(); SLOAD_F((const float*)Vh, KBASE((t) + 1)); }  \
                            else { SLOAD_H(Kh, Vh, KBASE((t) + 1)); } SBAR(); }                                               \
        pv_tile<VB, SK>(o, vb0, pa0, pa1, pa2, pa3, ACT((t) - 1)); MASKT(PX0, PX1, MLOAD(t)); partialSM(PX0, PX1, m_reg, mnX, alX);                                        \
        __syncthreads();                                                                                                      \
        if ((t) + 1 < NT) { VMW(); if constexpr (F32) { SWRITE_VF(SB); SBAR(); if ((t) + 2 < NT) SLOAD_F((const float*)Kh, KBASE((t) + 2)); } \
                            else { SWRITE_H(SB); } }                                                                          \
        RESC(alX); __syncthreads(); } while (0)
    for (int t = 1; t + 1 < NT; t += 2) {
        HALF_STEP(pB0, pB1, mnB, alB, pA0, pA1, alA, t, 1, 0, 0);
        HALF_STEP(pA0, pA1, mnA, alA, pB0, pB1, alB, t + 1, 0, 1, 1);
    }
    const bool even = (NT & 1) == 0;
    if (even) { SBAR(); qkt<1, SK>(pB0, pB1, K_lds, r32, hi, S.qr, ACT(NT - 1)); SBAR(); }
#define QROW(e) (nxt.Q + (size_t)(wid * QBLK + r32) * LDQKV + ((e) >> 1) * 16 + hi * 8 + ((e) & 1) * 4)
    if constexpr (F32) { SLOAD_F((const float*)nxt.K, kbn); SBAR();
#pragma unroll
        for (int e = 0; e < 8; ++e) S.tq[e] = *(const f32x4*)QROW(e); }
    else { SLOAD_H(nxt.K, nxt.V, kbn); SBAR();
#pragma unroll
        for (int d0 = 0; d0 < 8; ++d0) S.qr[d0] = load8<TIn>(nxt.Q + (size_t)(wid * QBLK + r32) * LDQKV + d0 * 16 + hi * 8); }
    SBAR();
    finishSM(pA0, pA1, alA, l_reg, pa0, pa1, pa2, pa3); SBAR();
    if constexpr (F32) {
#pragma unroll
        for (int e = 8; e < 16; ++e) S.tq[e] = *(const f32x4*)QROW(e); SBAR(); }
#undef QROW
    pv_tile<0, SK>(o, vb0, pa0, pa1, pa2, pa3, ACT(even ? NT - 2 : NT - 1));
    if (even) { MASKT(pB0, pB1, MLOAD(NT - 1)); partialSM(pB0, pB1, m_reg, mnB, alB); __syncthreads(); RESC(alB);
        finishSM(pB0, pB1, alB, l_reg, pa0, pa1, pa2, pa3); SBAR(); pv_tile<1, SK>(o, vb0, pa0, pa1, pa2, pa3, ACT(NT - 1)); }
    SBAR(); SEAM_K0();
    if (hi == 0) li_l[r32] = l_reg; asm volatile("s_waitcnt lgkmcnt(0)" ::: "memory");
    float rli[16];
#pragma unroll
    for (int r = 0; r < 16; ++r) rli[r] = __builtin_amdgcn_rcpf(li_l[crow(r, hi)]);
    TOut* Ow = cur.O + (size_t)(wid * QBLK) * LDO;
#pragma unroll
    for (int r = 0; r < 16; ++r) { const int orow = crow(r, hi);
#pragma unroll
        for (int d0 = 0; d0 < 4; ++d0) { const float v = o[d0][r] * rli[r];
            if constexpr (same_t<TOut, float>::v) { Ow[(size_t)orow * LDO + d0 * 32 + r32] = v; }
            else { const float vn = __builtin_bit_cast(float, __builtin_amdgcn_update_dpp(0, __builtin_bit_cast(int, v), 0xB1, 0xf, 0xf, false));
                   if ((r32 & 1) == 0) *(unsigned*)(Ow + (size_t)orow * LDO + d0 * 32 + r32) = cvtpk(v, vn); } } }
    if constexpr (F32) {
#pragma unroll
        for (int d0 = 0; d0 < 8; ++d0) S.qr[d0] = pack8(S.tq[2 * d0], S.tq[2 * d0 + 1]); }
    __syncthreads();
#undef RESC
#undef KBASE
#undef ACT
#undef MASKT
#undef MLOAD
#undef SEAM_K0
#undef HALF_STEP
}
#undef ROW
#undef VMW
#undef VMWN
#undef SLOAD_H
#undef LD16U
#undef SWRITE_HK
#undef SWRITE_HV
#undef SWRITE_H
#undef SLOAD_F
#undef SWRITE_KF
#undef SWRITE_VF

}


template <int NC> __device__ __forceinline__ void scan_elems(const bf16* __restrict__ delta, bf16* __restrict__ prev, size_t cstride, const LAS float* dec, const LAS float* inj) {
    f32x4 st = (f32x4){0.f, 0.f, 0.f, 0.f};
#pragma unroll 8
    for (int c = 0; c < NC; ++c) { const v2u x = *(const GAS v2u*)(delta + (size_t)c * cstride);
        v2u o; o.x = pk2(st[0], st[1]); o.y = pk2(st[2], st[3]); *(GAS v2u*)(prev + (size_t)c * cstride) = o;
        const float d = dec[c], j = inj[c];
        st[0] = d * st[0] + j * __uint_as_float(x.x << 16); st[1] = d * st[1] + j * __uint_as_float(x.x & 0xffff0000u);
        st[2] = d * st[2] + j * __uint_as_float(x.y << 16); st[3] = d * st[3] + j * __uint_as_float(x.y & 0xffff0000u); }
}

struct Args {
    const float* x; const float* norm_mix; const float* norm_ffn; const float* w_in; const float* att_q_norm; const float* att_k_norm; const float* mlstm_conv; const float* mlstm_gate_bias;
    const float* mlstm_out_norm; const float* ret_out_norm; const float* w_b_att; const float* w_b_mlstm; const float* w_b_ret; const float* w_out; const float* w_ffn_in; const float* w_ffn_out;
    float* out; unsigned char* ws; int layer_lo, layer_hi, ph_lo, ph_hi;
};
constexpr int PH_PER_LAYER = 16;
__device__ __forceinline__ float ret_lngamma(int hd) { return log1pf(-exp2f(-5.0f - (float)hd)); }
#define PHASE_FN static __device__ __forceinline__ void
#define OPAQUE_PTR(p) asm volatile("" : "+s"(p))
#define WS_PTRS(ws) OPAQUE_PTR(ws); \
    bf16* const H = (bf16*)((ws) + WS_H); bf16* const PROJ = (bf16*)((ws) + WS_PROJ); float* const SMALL = (float*)((ws) + WS_SMALL); bf16* const MQK = (bf16*)((ws) + WS_MQK); \
    bf16* const IKB = (bf16*)((ws) + WS_IKB); unsigned char* const IWF = (unsigned char*)((ws) + WS_IWF); float* const GIF = (float*)((ws) + WS_GIF); float* const SC = (float*)((ws) + WS_SC); \
    unsigned long long* const MB = (unsigned long long*)((ws) + WS_MB); bf16* const DCM = (bf16*)((ws) + WS_DCM); bf16* const CPM = (bf16*)((ws) + WS_CPM); \
    float* const DN = (float*)((ws) + WS_MISC + MISC_DN); float* const NPREV = (float*)((ws) + WS_MISC + MISC_NPREV); float* const AB = (float*)((ws) + WS_MISC + MISC_AB); float* const MPREV = (float*)((ws) + WS_MISC + MISC_MPREV); \
    bf16* const DRR = (bf16*)((ws) + WS_DRR); bf16* const RPR = (bf16*)((ws) + WS_RPR); bf16* const YA = (bf16*)((ws) + WS_YA); bf16* const YM = (bf16*)((ws) + WS_YM); bf16* const YR = (bf16*)((ws) + WS_YR); \
    float* const MERGEDF = (float*)((ws) + WS_MERGEDF); bf16* const MERGED = (bf16*)((ws) + WS_MERGED); bf16* const ACT = (bf16*)((ws) + WS_ACT); \
    float* const ROPE128 = (float*)((ws) + WS_ROPE128); float* const ROPE64 = (float*)((ws) + WS_ROPE64); \
    (void)H; (void)PROJ; (void)SMALL; (void)MQK; (void)IKB; (void)IWF; (void)GIF; (void)SC; (void)MB; (void)DCM; (void)CPM; (void)DN; (void)NPREV; (void)AB; (void)MPREV; (void)DRR; (void)RPR; (void)YA; (void)YM; (void)YR; \
    (void)MERGEDF; (void)MERGED; (void)ACT; (void)ROPE128; (void)ROPE64
#define TIDS() int tid_ = my_tid(); asm volatile("" : "+v"(tid_)); int bx_ = blockIdx.x; asm volatile("" : "+s"(bx_));   \
    const int tid = tid_, lane = tid & 63, wave = __builtin_amdgcn_readfirstlane(tid >> 6); const int G = gridDim.x, bx = bx_; const int gw = bx * NWAVES + wave, NGW = G * NWAVES; \
    (void)lane; (void)wave; (void)gw; (void)NGW; (void)G; (void)bx

constexpr int CV_IN = 32 * 268, CV_B = 16 * 32, CV_OUT = 32 * 32, CV_FIN = 32 * 176, CV_FOUT = 88 * 32, CV_ITEMS = CV_IN + 3 * CV_B + CV_OUT + CV_FIN + CV_FOUT;
__device__ __forceinline__ void convert_layer_items(LAS float* scr, unsigned char* ws, int l, const float* w_in, const float* w_b_att, const float* w_b_mlstm, const float* w_b_ret, const float* w_out, const float* w_ffn_in,
                                                    const float* w_ffn_out, int it0, int it1, int wv, int nwv, int lane) {
    unsigned char* wl = ws + WS_W + (size_t)l * W_LAYER;
    for (int it = it0 + wv; it < it1; it += nwv) { int r = it;
        if (r < CV_IN) { transpose_item(w_in + (size_t)l * DM * LPROJ, DM, LPROJ, (bf16*)(wl + WO_IN), scr, r, NPROJ_PAD / 64, lane, MapWin()); continue; } r -= CV_IN;
        if (r < CV_B) { transpose_item(w_b_att + (size_t)l * 1024 * DM, 1024, DM, (bf16*)(wl + WO_B), scr, r, DM / 64, lane, MapIdent()); continue; } r -= CV_B;
        if (r < CV_B) { transpose_item(w_b_mlstm + (size_t)l * 1024 * DM, 1024, DM, (bf16*)(wl + WO_B + 4 * MiB), scr, r, DM / 64, lane, MapIdent()); continue; } r -= CV_B;
        if (r < CV_B) { transpose_item(w_b_ret + (size_t)l * 1024 * DM, 1024, DM, (bf16*)(wl + WO_B + 8 * MiB), scr, r, DM / 64, lane, MapIdent()); continue; } r -= CV_B;
        if (r < CV_OUT) { transpose_item(w_out + (size_t)l * DM * DM, DM, DM, (bf16*)(wl + WO_OUT), scr, r, DM / 64, lane, MapIdent()); continue; } r -= CV_OUT;
        if (r < CV_FIN) { transpose_item(w_ffn_in + (size_t)l * DM * 2 * FF, DM, 2 * FF, (bf16*)(wl + WO_FIN), scr, r, 2 * FF / 64, lane, MapFfn()); continue; } r -= CV_FIN;
        transpose_item(w_ffn_out + (size_t)l * FF * DM, FF, DM, (bf16*)(wl + WO_FOUT), scr, r, DM / 64, lane, MapIdent()); }
}
PHASE_FN ph_prologue(LAS unsigned char* lds, unsigned char* ws, const float* w_in, const float* w_b_att, const float* w_b_mlstm, const float* w_b_ret, const float* w_out, const float* w_ffn_in, const float* w_ffn_out, bool all_layers) {
    TIDS(); WS_PTRS(ws);
    LAS float* scr = (LAS float*)(lds + wave * 16640);
    for (int l = 0; l < (all_layers ? DEPTH : 1); ++l) convert_layer_items(scr, ws, l, w_in, w_b_att, w_b_mlstm, w_b_ret, w_out, w_ffn_in, w_ffn_out, 0, CV_ITEMS, gw, NGW, lane);
    for (int i = gw * 64 + lane; i < S * 96; i += NGW * 64) {
        if (i < S * 64) { const int t = i >> 6, f = i & 63; const float inv = (float)pow(10000.0, -(double)f * 2.0 / 128.0); const float ang = (float)t * inv;
            ROPE128[2 * i] = (float)cos((double)ang); ROPE128[2 * i + 1] = (float)sin((double)ang); }
        else { const int k = i - S * 64, t = k >> 5, f = k & 31; const float inv = (float)pow(10000.0, -(double)f * 2.0 / 64.0); const float ang = (float)t * inv;
            ROPE64[2 * k] = (float)cos((double)ang); ROPE64[2 * k + 1] = (float)sin((double)ang); } }
}
PHASE_FN ph_convert_tail(LAS unsigned char* lds, unsigned char* ws, int l, const float* w_in, const float* w_b_att, const float* w_b_mlstm, const float* w_b_ret, const float* w_out, const float* w_ffn_in, const float* w_ffn_out,
                         int rem, int it0, int it1) {
    TIDS(); if (rem <= 0 || rem >= G || bx < rem) return;
    LAS float* scr = (LAS float*)(lds + wave * 16640);
    convert_layer_items(scr, ws, l, w_in, w_b_att, w_b_mlstm, w_b_ret, w_out, w_ffn_in, w_ffn_out, it0, it1, (bx - rem) * NWAVES + wave, (G - rem) * NWAVES, lane);
    __syncthreads(); }
PHASE_FN ph_rmsnorm(const float* xin, const float* gain, bf16* Hout) { TIDS(); for (int m = gw; m < S; m += NGW) rms_row_to_bf16(xin + (size_t)m * DM, gain, Hout + (size_t)m * DM, lane); }
PHASE_FN ph_gemm_proj(LAS unsigned char* lds, unsigned char* ws, const bf16* Wt) { TIDS(); WS_PTRS(ws);
    pg8::Gemm g{H, Wt, S, NPROJ_PAD, DM}; pg8::StaticOrder so; so.init(S, NPROJ_PAD, G, bx); pg8::EpiProj E{PROJ, NPROJ, SMALL, PC_G / 256, NPROJ / 256};
    pg8::gemm_phase<pg8::EpiProj, pg8::StaticOrder, true, true>(lds, g, so, E); }
PHASE_FN ph_pp(unsigned char* ws, const float* gq, const float* gk, const float* convw, const float* gbias) { TIDS(); WS_PTRS(ws);
    PPArgs a{PROJ, SMALL, MQK, IKB, IWF, GIF, ROPE128, ROPE64, gq, gk, convw, gbias};
    f32x4 cw[16];
#pragma unroll
    for (int j = 0; j < 4; ++j)
#pragma unroll
        for (int q = 0; q < 4; ++q) cw[j * 4 + q] = *(const f32x4*)(convw + j * 1024 + 16 * lane + 4 * q);
    for (int m = gw; m < S; m += NGW) pp_row(a, m, lane, cw); }
PHASE_FN ph_scores(unsigned char* ws) { TIDS(); WS_PTRS(ws);
    for (int u = gw; u < 16512; u += NGW) { int g = (int)((sqrtf(1.0f + 4.0f * (float)u) - 1.0f) * 0.5f); while ((g + 1) * (g + 2) <= u) ++g; while (g * (g + 1) > u) --g;
        const int r = u - g * (g + 1); score_wave_unit(PROJ, IKB, IWF, SC, 2 * g + r / (g + 1), r % (g + 1), lane); } }
PHASE_FN ph_deltas(LAS unsigned char* lds, unsigned char* ws) { TIDS(); WS_PTRS(ws); LAS float* const sf = (LAS float*)(lds + SCR_OFF);
    for (int u = bx; u < 1024; u += G) {
        if (u < 512) { const int hd = u >> 7, c = u & 127, t0 = c * 64;
            if (wave == 0) { const float iv = GIF[(size_t)(t0 + lane) * 8 + hd], fv = GIF[(size_t)(t0 + lane) * 8 + 4 + hd]; float b = log_sigmoid_f(fv);
                b = wave_prefix_sum_f(b);
                const float bend = __builtin_bit_cast(float, __builtin_amdgcn_readlane(__builtin_bit_cast(int, b), 63)), gl = bend - b + iv, A = wave_max(gl);
                sf[lane] = __expf(gl - A); if (lane == 0) { AB[(hd * 128 + c) * 2] = A; AB[(hd * 128 + c) * 2 + 1] = bend; } }
            __syncthreads();
            chunk_delta<64, 256>(lds, MQK + (size_t)t0 * 1024 + 512 + hd * 128, 1024, PROJ + (size_t)t0 * NPROJ + PC_MV + hd * 256, NPROJ, sf, DCM + (size_t)(hd * 128 + c) * 32768, DN + (hd * 128 + c) * 128, tid);
        } else { const int v = u - 512, hd = v >> 6, c = v & 63, t0 = c * 128; const float lg = ret_lngamma(hd);
            if (tid < 128) sf[tid] = __expf(lg * (float)(127 - tid));
            __syncthreads();
            chunk_delta<128, 128>(lds, PROJ + (size_t)t0 * NPROJ + PC_RK + hd * 128, NPROJ, PROJ + (size_t)t0 * NPROJ + PC_RV + hd * 128, NPROJ, sf, DRR + (size_t)(hd * 64 + c) * 16384, nullptr, tid); }
    } }
PHASE_FN ph_select(LAS unsigned char* lds, unsigned char* ws) { TIDS(); WS_PTRS(ws); select_rows_wg(lds, SC, MB, bx, G, tid); }
PHASE_FN ph_scans(LAS unsigned char* lds, unsigned char* ws) { TIDS(); WS_PTRS(ws); LAS float* const sf = (LAS float*)(lds + SCR_OFF);
    for (int u = bx; u < 128; u += G) {
        LAS float* dec = sf; LAS float* inj = sf + 128; LAS float* av = sf + 256; LAS float* bv = sf + 384;
        if (u < 64) { const int hd = u >> 4, p = u & 15;
            if (tid < 128) { av[tid] = AB[(hd * 128 + tid) * 2]; bv[tid] = AB[(hd * 128 + tid) * 2 + 1]; }
            __syncthreads();
            if (tid == 0) { float m = 0.f; for (int c = 0; c < 128; ++c) { const float mn = fmaxf(bv[c] + m, av[c]); dec[c] = __expf(bv[c] + m - mn); inj[c] = __expf(av[c] - mn); if (p == 0) MPREV[hd * 128 + c] = m; m = mn; } }
            __syncthreads();
            const size_t e4 = (size_t)hd * 128 * 32768 + p * 2048 + tid * 4;
            scan_elems<128>(DCM + e4, CPM + e4, 32768, dec, inj);
            if (p == 0 && tid < 128) { float st = 0.f; for (int c = 0; c < 128; ++c) { NPREV[(hd * 128 + c) * 128 + tid] = st; st = dec[c] * st + inj[c] * DN[(hd * 128 + c) * 128 + tid]; } }
        } else { const int v = u - 64, hd = v >> 3, p = v & 7; const float dg = __expf(128.0f * ret_lngamma(hd));
            if (tid < 64) { dec[tid] = dg; inj[tid] = 1.0f; }
            __syncthreads();
            const size_t e4 = (size_t)hd * 64 * 16384 + p * 2048 + tid * 4;
            scan_elems<64>(DRR + e4, RPR + e4, 16384, dec, inj); }
        __syncthreads(); } }
PHASE_FN ph_attention(char* alds, unsigned char* ws) { TIDS(); WS_PTRS(ws);
    typedef att::BlockRef<bf16, bf16> BR; att::Seam<bf16> seam;
#define ATT_REF(r, item_, pass_) do { const int hd_ = (item_) >> 4, y_ = (item_) & 15, qb_ = (pass_) ? 31 - y_ : y_; \
        (r).Q = PROJ + (size_t)qb_ * 256 * NPROJ + PC_AQ + hd_ * 128; (r).K = PROJ + PC_AK + hd_ * 128; (r).V = PROJ + PC_AV + hd_ * 128; (r).O = YA + (size_t)qb_ * 256 * 1024 + hd_ * 128; \
        (r).M = MB + (size_t)qb_ * 256 * 128; (r).P0 = qb_ * 256; } while (0)
    if (bx < 128) { int item = bx, pass = 0; BR cur; ATT_REF(cur, item, 0); att::causal_swa_prime<bf16, bf16>(cur, 1 << 30, alds, seam);
        for (;;) { const bool more_pass = pass == 0, more_item = item + G < 128, last = !more_pass && !more_item;
            int itn = item, pn = pass + 1; if (!more_pass) { pn = 0; itn = more_item ? item + G : item; }
            BR nxt = cur; if (!last) ATT_REF(nxt, itn, pn);
            att::causal_swa_block<bf16, bf16>(cur, nxt, S, 1 << 30, alds, seam);
            if (last) break; cur = nxt; item = itn; pass = pn; } }
    __syncthreads(); }
PHASE_FN ph_outs(LAS unsigned char* lds, unsigned char* ws, const float* gain_m, const float* gain_r, int u0, int ustep) { TIDS(); WS_PTRS(ws); LAS float* const sf = (LAS float*)(lds + SCR_OFF);
    for (int u = u0; u < 1024; u += ustep) {
        if (u < 512) { const int hd = u >> 7, c = u & 127, t0 = c * 64;
            if (wave == 0) { const float iv = GIF[(size_t)(t0 + lane) * 8 + hd], fv = GIF[(size_t)(t0 + lane) * 8 + 4 + hd]; float b = log_sigmoid_f(fv);
                b = wave_prefix_sum_f(b);
                const float mp = MPREV[hd * 128 + c]; const float pm = wave_prefix_max_f(iv - b);
                const float mt = fmaxf(b + mp, b + pm);
                sf[lane] = b - mt; sf[128 + lane] = iv - b; sf[256 + lane] = __expf(b + mp - mt); sf[384 + lane] = __expf(-mt); sf[512 + lane] = 0.f; }
            if (wave == 1) { sf[640 + lane] = NPREV[(hd * 128 + c) * 128 + lane]; sf[640 + 64 + lane] = NPREV[(hd * 128 + c) * 128 + 64 + lane]; }
            __syncthreads();
            chunk_out<64, 256, 0>(lds, sf, MQK + (size_t)t0 * 1024 + hd * 128, 1024, MQK + (size_t)t0 * 1024 + 512 + hd * 128, 1024, PROJ + (size_t)t0 * NPROJ + PC_MV + hd * 256, NPROJ,
                                  CPM + (size_t)(hd * 128 + c) * 32768, gain_m + hd * 256, PROJ + (size_t)t0 * NPROJ + PC_MO + hd * 256, NPROJ, YM + (size_t)t0 * 1024 + hd * 256, 1024, tid);
        } else { const int v = u - 512, hd = v >> 6, c = v & 63, t0 = c * 128; const float lg = ret_lngamma(hd);
            if (tid < 128) { sf[tid] = lg * (float)tid; sf[128 + tid] = -lg * (float)tid; sf[256 + tid] = __expf(lg * (float)(tid + 1)); }
            __syncthreads();
            chunk_out<128, 128, 1>(lds, sf, PROJ + (size_t)t0 * NPROJ + PC_RQ + hd * 128, NPROJ, PROJ + (size_t)t0 * NPROJ + PC_RK + hd * 128, NPROJ, PROJ + (size_t)t0 * NPROJ + PC_RV + hd * 128, NPROJ,
                                   RPR + (size_t)(hd * 64 + c) * 16384, gain_r + hd * 128, PROJ + (size_t)t0 * NPROJ + PC_RG + hd * 128, NPROJ, YR + (size_t)t0 * 1024 + hd * 128, 1024, tid); }
    } }
template <int MODE> PHASE_FN ph_gemm_branch(LAS unsigned char* lds, unsigned char* ws, const bf16* A, const bf16* Wt, int gcol) { TIDS(); WS_PTRS(ws);
    pg8::Gemm g{A, Wt, S, DM, 1024}; pg8::StaticOrder so; so.init(S, DM, G, bx); pg8::EpiBranch<MODE> E{PROJ + PC_G + gcol, NPROJ, MERGEDF, MERGED, DM};
    pg8::gemm_phase<pg8::EpiBranch<MODE>, pg8::StaticOrder, true, true>(lds, g, so, E); }
PHASE_FN ph_gemm_resid(LAS unsigned char* lds, const bf16* A, const bf16* Wt, int K, const float* base, float* out) { TIDS();
    pg8::Gemm g{A, Wt, S, DM, K}; pg8::StaticOrder so; so.init(S, DM, G, bx); pg8::EpiResid E{base, out, DM};
    pg8::gemm_phase<pg8::EpiResid, pg8::StaticOrder, true, true>(lds, g, so, E); }
PHASE_FN ph_gemm_ffn_in(LAS unsigned char* lds, unsigned char* ws, const bf16* Wt) { TIDS(); WS_PTRS(ws);
    pg8::Gemm g{H, Wt, S, 2 * FF, DM}; pg8::StaticOrder so; so.init(S, 2 * FF, G, bx); pg8::EpiSwiGLU E{ACT, FF};
    pg8::gemm_phase<pg8::EpiSwiGLU, pg8::StaticOrder, true, true>(lds, g, so, E); }


#ifndef SYN_PROBE
#define SYN_PROBE 0
#endif
PHASE_FN ph_probe(LAS unsigned char* lds) { TIDS();
    LAS unsigned* hist = (LAS unsigned*)lds;
    if (SYN_PROBE == 1) {
        unsigned x = (unsigned)tid * 2654435761u + 12345u;
        for (int r = 0; r < 32; ++r) {
#pragma unroll
            for (int i = 0; i < 16; ++i) { x = x * 1664525u + 1013904223u; (void)__hip_atomic_fetch_add(hist + ((x >> 10) & 2047u), 1u, __ATOMIC_RELAXED, __HIP_MEMORY_SCOPE_WORKGROUP); }
            SEL_BAR(); } }
    if (SYN_PROBE == 2) {
        float acc = 0.f; float v[16];
#pragma unroll
        for (int i = 0; i < 16; ++i) v[i] = (float)((tid * 16 + i) % 977);
        for (int r = 0; r < 32 * 8; ++r) { const float c1 = 100.f + (float)(r & 7) + acc * 1e-30f, c2 = c1 * 2.f, c3 = c1 * 3.f; unsigned n1 = 0, n2 = 0, n3 = 0;
#pragma unroll
            for (int i = 0; i < 16; ++i) { n1 += (unsigned)__builtin_popcountll(__builtin_amdgcn_ballot_w64(v[i] >= c1)); n2 += (unsigned)__builtin_popcountll(__builtin_amdgcn_ballot_w64(v[i] >= c2)); n3 += (unsigned)__builtin_popcountll(__builtin_amdgcn_ballot_w64(v[i] >= c3)); }
            if (lane == 0) { hist[(r & 1) * 24 + wave] = n1; hist[(r & 1) * 24 + 8 + wave] = n2; hist[(r & 1) * 24 + 16 + wave] = n3; }
            SEL_BAR();
            unsigned t1 = 0;
#pragma unroll
            for (int j = 0; j < 24; ++j) t1 += hist[(r & 1) * 24 + j];
            acc += (float)t1; }
        if (acc == 12345.f) hist[100] = 1u; }
    if (SYN_PROBE == 3) {
        float a = (float)tid;
        for (int r = 0; r < 32; ++r) {
#pragma unroll
            for (int k = 0; k < 4; ++k)
#pragma unroll
                for (int o = 1; o < 64; o <<= 1) a = fmaxf(a, shfl_idx_f(a, (int)(lane_id_v() ^ (unsigned)o)) * 0.999f);
        }
        if (a == 12345.f) hist[100] = 1u; }
    __syncthreads(); }
typedef const __attribute__((address_space(4))) Args* ArgsP;
__device__ __forceinline__ ArgsP fresh_args() { ArgsP ap = (ArgsP)__builtin_amdgcn_kernarg_segment_ptr(); asm volatile("" : "+s"(ap)); return ap; }
#ifndef DUP_PHASE
#define DUP_PHASE -1
#endif
#define SEAM() do { if constexpr (one_launch) { ArgsP ap_ = fresh_args(); XcdBarrier b_; b_.bar = (unsigned*)(ap_->ws + WS_CTL) + CW_BAR; b_.x = xb_xcc_id(); b_.st = (volatile LAS unsigned*)(lds + MISC_OFF); xcd_barrier(b_); } } while (0)
#define IN(k) (PLO <= (k) && (k) < PHI)
#define WL(ap, layer) ((ap)->ws + WS_W + (size_t)(layer) * W_LAYER)
template <int PLO, int PHI, bool LAST> __device__ __forceinline__ void layer_phases(const int layer, LAS unsigned char* lds, unsigned char* lds_raw) {
    constexpr bool one_launch = (PHI - PLO > 1);
    if constexpr (IN(1)) { ArgsP ap = fresh_args(); ph_rmsnorm(layer == 0 ? ap->x : ap->out, ap->norm_mix + layer * DM, (bf16*)(ap->ws + WS_H)); if constexpr (DUP_PHASE == 1) { SEAM(); ph_rmsnorm(layer == 0 ? ap->x : ap->out, ap->norm_mix + layer * DM, (bf16*)(ap->ws + WS_H)); } SEAM(); }
    constexpr int CV_S1 = 10880, CV_S2 = 10880;
    if constexpr (IN(2)) { ArgsP ap = fresh_args(); ph_gemm_proj(lds, ap->ws, (const bf16*)(WL(ap, layer) + WO_IN));
        if constexpr (one_launch && !LAST) { ArgsP aq = fresh_args(); ph_convert_tail(lds, aq->ws, layer + 1, aq->w_in, aq->w_b_att, aq->w_b_mlstm, aq->w_b_ret, aq->w_out, aq->w_ffn_in, aq->w_ffn_out, ((S / 256) * (NPROJ_PAD / 256)) % (int)gridDim.x, 0, CV_S1); } if constexpr (DUP_PHASE == 2) { SEAM(); ph_gemm_proj(lds, ap->ws, (const bf16*)(WL(ap, layer) + WO_IN)); } SEAM(); }
    if constexpr (IN(3)) { ArgsP ap = fresh_args(); ph_pp(ap->ws, ap->att_q_norm + layer * 128, ap->att_k_norm + layer * 128, ap->mlstm_conv + layer * 4096, ap->mlstm_gate_bias + layer * 8); if constexpr (DUP_PHASE == 23) { SEAM(); ph_gemm_proj(lds, ap->ws, (const bf16*)(WL(ap, layer) + WO_IN)); SEAM(); ph_pp(ap->ws, ap->att_q_norm + layer * 128, ap->att_k_norm + layer * 128, ap->mlstm_conv + layer * 4096, ap->mlstm_gate_bias + layer * 8); } if constexpr (DUP_PHASE == 3) { SEAM(); ph_pp(ap->ws, ap->att_q_norm + layer * 128, ap->att_k_norm + layer * 128, ap->mlstm_conv + layer * 4096, ap->mlstm_gate_bias + layer * 8); } SEAM(); }
    if constexpr (IN(4)) { ArgsP ap = fresh_args(); ph_scores(ap->ws); if constexpr (DUP_PHASE == 4) { SEAM(); ph_scores(ap->ws); } }
    if constexpr (IN(5)) { ArgsP ap = fresh_args(); ph_deltas(lds, ap->ws); if constexpr (DUP_PHASE == 5) { SEAM(); ph_deltas(lds, ap->ws); } SEAM(); }
    if constexpr (IN(6) && SYN_PROBE != 0) { ph_probe(lds); }
    if constexpr (IN(6)) { ArgsP ap = fresh_args(); ph_select(lds, ap->ws); if constexpr (DUP_PHASE == 6) { SEAM(); ph_select(lds, ap->ws); } }
    if constexpr (IN(7) && one_launch && !LAST) { ArgsP aq = fresh_args(); ph_convert_tail(lds, aq->ws, layer + 1, aq->w_in, aq->w_b_att, aq->w_b_mlstm, aq->w_b_ret, aq->w_out, aq->w_ffn_in, aq->w_ffn_out, 128, CV_S1, CV_S2); }
    if constexpr (IN(7)) { ArgsP ap = fresh_args(); ph_scans(lds, ap->ws); if constexpr (DUP_PHASE == 7) { SEAM(); ph_scans(lds, ap->ws); } SEAM(); }
    if constexpr (IN(8) && IN(9)) {
        ArgsP ap = fresh_args(); const bool split = gridDim.x == 256;
        if (!split || blockIdx.x < 128) ph_attention((char*)lds_raw, ap->ws);
        if (!split || blockIdx.x >= 128) ph_outs(lds, ap->ws, ap->mlstm_out_norm + layer * 1024, ap->ret_out_norm + layer * 1024, split ? (int)blockIdx.x - 128 : (int)blockIdx.x, split ? 128 : (int)gridDim.x);
        SEAM(); }
    else {
    if constexpr (IN(8)) { ArgsP ap = fresh_args(); ph_attention((char*)lds_raw, ap->ws); }
    if constexpr (IN(9)) { ArgsP ap = fresh_args(); ph_outs(lds, ap->ws, ap->mlstm_out_norm + layer * 1024, ap->ret_out_norm + layer * 1024, (int)blockIdx.x, (int)gridDim.x); SEAM(); }
    }
    if constexpr (IN(10)) { ArgsP ap = fresh_args(); ph_gemm_branch<0>(lds, ap->ws, (const bf16*)(ap->ws + WS_YA), (const bf16*)(WL(ap, layer) + WO_B), 0); if constexpr (DUP_PHASE == 10) { SEAM(); ph_gemm_branch<0>(lds, ap->ws, (const bf16*)(ap->ws + WS_YA), (const bf16*)(WL(ap, layer) + WO_B), 0); } }
    if constexpr (IN(11)) { ArgsP ap = fresh_args(); ph_gemm_branch<1>(lds, ap->ws, (const bf16*)(ap->ws + WS_YM), (const bf16*)(WL(ap, layer) + WO_B + 4 * MiB), DM); if constexpr (DUP_PHASE == 11) { SEAM(); ph_gemm_branch<1>(lds, ap->ws, (const bf16*)(ap->ws + WS_YM), (const bf16*)(WL(ap, layer) + WO_B + 4 * MiB), DM); } }
    if constexpr (IN(12)) { ArgsP ap = fresh_args(); ph_gemm_branch<2>(lds, ap->ws, (const bf16*)(ap->ws + WS_YR), (const bf16*)(WL(ap, layer) + WO_B + 8 * MiB), 2 * DM); if constexpr (DUP_PHASE == 12) { SEAM(); ph_gemm_branch<2>(lds, ap->ws, (const bf16*)(ap->ws + WS_YR), (const bf16*)(WL(ap, layer) + WO_B + 8 * MiB), 2 * DM); } SEAM(); }
    if constexpr (IN(13)) { ArgsP ap = fresh_args(); ph_gemm_resid(lds, (const bf16*)(ap->ws + WS_MERGED), (const bf16*)(WL(ap, layer) + WO_OUT), DM, layer == 0 ? ap->x : ap->out, ap->out); SEAM(); }
    if constexpr (IN(14)) { ArgsP ap = fresh_args(); ph_rmsnorm(ap->out, ap->norm_ffn + layer * DM, (bf16*)(ap->ws + WS_H)); if constexpr (DUP_PHASE == 14) { SEAM(); ph_rmsnorm(ap->out, ap->norm_ffn + layer * DM, (bf16*)(ap->ws + WS_H)); } SEAM(); }
    if constexpr (IN(15)) { ArgsP ap = fresh_args(); ph_gemm_ffn_in(lds, ap->ws, (const bf16*)(WL(ap, layer) + WO_FIN));
        if constexpr (one_launch && !LAST) { ArgsP aq = fresh_args(); ph_convert_tail(lds, aq->ws, layer + 1, aq->w_in, aq->w_b_att, aq->w_b_mlstm, aq->w_b_ret, aq->w_out, aq->w_ffn_in, aq->w_ffn_out, ((S / 256) * (2 * FF / 256)) % (int)gridDim.x, CV_S2, CV_ITEMS); } if constexpr (DUP_PHASE == 15) { SEAM(); ph_gemm_ffn_in(lds, ap->ws, (const bf16*)(WL(ap, layer) + WO_FIN)); } SEAM(); }
    if constexpr (IN(16)) { ArgsP ap = fresh_args(); ph_gemm_resid(lds, (const bf16*)(ap->ws + WS_ACT), (const bf16*)(WL(ap, layer) + WO_FOUT), FF, ap->out, ap->out); if constexpr (!LAST) SEAM(); }
}
template <int PLO, int PHI> __global__ void __launch_bounds__(NTHR, 2) fwd(Args args_unused) {
    (void)args_unused;
    extern __shared__ __attribute__((aligned(16))) unsigned char lds_raw[];
    LAS unsigned char* lds = (LAS unsigned char*)lds_raw;
    if (threadIdx.x < 64) ((volatile LAS unsigned*)(lds + MISC_OFF))[threadIdx.x] = 0u;
    if ((threadIdx.x & 63) == 0) ((volatile LAS unsigned*)(lds + MISC_OFF))[64 + ((unsigned)__builtin_amdgcn_s_getreg((5 << 11) | 4) & 63u)] = threadIdx.x >> 6;
    __syncthreads();
    constexpr bool one_launch = (PHI - PLO > 1);
    if constexpr (one_launch) { ArgsP ap = fresh_args(); (void)xcd_barrier_post((unsigned*)(ap->ws + WS_CTL) + CW_BAR, (volatile LAS unsigned*)(lds + MISC_OFF)); }
    if constexpr (PLO == 0) { ArgsP ap = fresh_args(); ph_prologue(lds, ap->ws, ap->w_in, ap->w_b_att, ap->w_b_mlstm, ap->w_b_ret, ap->w_out, ap->w_ffn_in, ap->w_ffn_out, !one_launch);
        if constexpr (DUP_PHASE == 0) { SEAM(); ph_prologue(lds, ap->ws, ap->w_in, ap->w_b_att, ap->w_b_mlstm, ap->w_b_ret, ap->w_out, ap->w_ffn_in, ap->w_ffn_out, !one_launch); }
        if (PHI > 1) SEAM(); }
    if constexpr (one_launch) { static_assert(DEPTH == 4, "four inlined layer sites");
        layer_phases<PLO, PHI, false>(0, lds, lds_raw); layer_phases<PLO, PHI, false>(1, lds, lds_raw); layer_phases<PLO, PHI, false>(2, lds, lds_raw); layer_phases<PLO, PHI, true>(3, lds, lds_raw); }
    else if constexpr (PLO > 0) { ArgsP ap = fresh_args(); layer_phases<PLO, PHI, true>(ap->layer_lo, lds, lds_raw); }
}
#undef IN
#undef SEAM
#undef WL

#ifndef ONE_LAUNCH
#define ONE_LAUNCH 1
#endif
typedef void (*kern_t)(Args);
template <int P> static kern_t phase_kernel(int p) { if (p == P) return fwd<P, P + 1>; if constexpr (P < PH_PER_LAYER) return phase_kernel<P + 1>(p); else return nullptr; }
extern "C" void kernel_launch(void* const* d_in, const int* in_sizes, int n_in, void* d_out, int out_size, void* d_ws, size_t ws_size, hipStream_t stream) {
    static int grid = 0;
    if (grid == 0) {
        if (n_in != 16 || in_sizes[0] != S * DM || out_size != S * DM || ws_size < WS_END) { fprintf(stderr, "kernel_launch: unexpected shapes (n_in %d, in0 %d, out %d, ws %zu < %zu); nothing launched\n", n_in, n_in > 0 ? in_sizes[0] : -1, out_size, ws_size, (size_t)WS_END); grid = -1; return; }
        int dev = 0, cus = 0;
        if (hipGetDevice(&dev) != hipSuccess || hipDeviceGetAttribute(&cus, hipDeviceAttributeMultiprocessorCount, dev) != hipSuccess) { grid = -1; return; }
#if ONE_LAUNCH
        if (hipFuncSetAttribute((const void*)fwd<0, PH_PER_LAYER + 1>, hipFuncAttributeMaxDynamicSharedMemorySize, LDS_BYTES) != hipSuccess) { grid = -1; return; }
#else
        for (int p = 0; p <= PH_PER_LAYER; ++p) if (hipFuncSetAttribute((const void*)phase_kernel<0>(p), hipFuncAttributeMaxDynamicSharedMemorySize, LDS_BYTES) != hipSuccess) { fprintf(stderr, "kernel_launch: hipFuncSetAttribute failed\n"); grid = -1; return; }
#endif
        (void)hipGetLastError();
        grid = cus;
    }
    if (grid < 0) return;
    (void)hipMemsetAsync((char*)d_ws + WS_CTL, 0, CTL_ZERO_BYTES, stream);
    Args a{};
    a.x = (const float*)d_in[0]; a.norm_mix = (const float*)d_in[1]; a.norm_ffn = (const float*)d_in[2]; a.w_in = (const float*)d_in[3]; a.att_q_norm = (const float*)d_in[4]; a.att_k_norm = (const float*)d_in[5];
    a.mlstm_conv = (const float*)d_in[6]; a.mlstm_gate_bias = (const float*)d_in[7]; a.mlstm_out_norm = (const float*)d_in[8]; a.ret_out_norm = (const float*)d_in[9];
    a.w_b_att = (const float*)d_in[10]; a.w_b_mlstm = (const float*)d_in[11]; a.w_b_ret = (const float*)d_in[12]; a.w_out = (const float*)d_in[13]; a.w_ffn_in = (const float*)d_in[14]; a.w_ffn_out = (const float*)d_in[15];
    a.out = (float*)d_out; a.ws = (unsigned char*)d_ws;
#if ONE_LAUNCH
    a.layer_lo = 0; a.layer_hi = DEPTH; a.ph_lo = 0; a.ph_hi = PH_PER_LAYER + 1; hipLaunchKernelGGL((fwd<0, PH_PER_LAYER + 1>), dim3(grid), dim3(NTHR), LDS_BYTES, stream, a);
#else
    a.layer_lo = 0; a.layer_hi = 0; a.ph_lo = 0; a.ph_hi = 1; hipLaunchKernelGGL((fwd<0, 1>), dim3(grid), dim3(NTHR), LDS_BYTES, stream, a);
    for (int l = 0; l < DEPTH; ++l) for (int p = 1; p <= PH_PER_LAYER; ++p) { a.layer_lo = l; a.layer_hi = l + 1; a.ph_lo = p; a.ph_hi = p + 1; hipLaunchKernelGGL(phase_kernel<0>(p), dim3(grid), dim3(NTHR), LDS_BYTES, stream, a); }
#endif
}
```

```cpp
#include <hip/hip_runtime.h>
#include <cstdio>
#include <cstdint>
__device__ __forceinline__ int my_tid();
namespace pg8 {
#define PG8_LAS __attribute__((address_space(3)))
typedef unsigned short bf16_t;
typedef short bf16x8 __attribute__((ext_vector_type(8)));
typedef float f32x4 __attribute__((ext_vector_type(4)));
typedef unsigned u32x4 __attribute__((ext_vector_type(4)));
constexpr int BM = 256, BK = 64, HALF = 128, HTB = HALF * BK * 2  , STAGE_BYTES = 8 * HTB, NXCD = 8, WGM = 8;

__host__ __device__ __forceinline__ int lds_byte(int r, int c) { const int st = (r >> 4) * 2 + (c >> 5), rr = r & 15, cc = c & 31, ob = rr * 64 + cc * 2; return st * 1024 + (ob ^ (((ob >> 9) & 1) << 5)); }
__host__ __device__ __forceinline__ void stage_rc(int b, int& R, int& C) { const int st = b / 1024, sb = b % 1024, swz = sb ^ (((sb >> 9) & 1) << 5); R = (st >> 1) * 16 + swz / 64; C = (st & 1) * 32 + (swz % 64) / 2; }
__host__ __device__ __forceinline__ int perm32(int rho) { const int n = rho >> 4, i = rho & 15; return 8 * (i >> 2) + 4 * n + (i & 3); }

struct Unit { int pm, pn; };
struct Gemm { const bf16_t* A; const bf16_t* Bt; int M, N, K; };

struct StaticOrder {
    int nM, nN, nwg, G, c;
    __host__ __device__ void init(int M, int N, int G_, int c_) { nM = M / BM; nN = N / BM; nwg = nM * nN; G = G_; c = c_; }
    __host__ __device__ bool next(int i, Unit& u) const {
        const long L = (long)i * G + c; if (L >= nwg) return false;
        int wgid = (int)L; { const int q = nwg / NXCD, r = nwg % NXCD, xcd = wgid % NXCD, off = wgid / NXCD; wgid = (xcd < r ? xcd * (q + 1) : r * (q + 1) + (xcd - r) * q) + off; }
        const int nig = WGM * nN, gid = wgid / nig, fm = gid * WGM, gsz = (nM - fm) < WGM ? (nM - fm) : WGM;
        u.pm = fm + ((wgid % nig) % gsz); u.pn = (wgid % nig) / gsz; return true;
    }
    __device__ __forceinline__ void a_ready(const Unit&) const {}
    __device__ __forceinline__ void done(const Unit&) const {}
};

__device__ __forceinline__ unsigned cvt_pk_bf16(float lo, float hi) { unsigned r; asm volatile("v_cvt_pk_bf16_f32 %0, %1, %2" : "=v"(r) : "v"(lo), "v"(hi)); return r; }
typedef float f32x2 __attribute__((ext_vector_type(2)));
__device__ __forceinline__ float sigmoid_f(float x) { return __builtin_amdgcn_rcpf(1.0f + __builtin_amdgcn_exp2f(-1.4426950408889634f * x)); }
struct EpiProj {
    static constexpr bool PERM = true, AFTER_DRAIN = false;
    bf16_t* P; int ldp; float* Sm; int ngate0, nbf;
    __device__ __forceinline__ void operator()(const f32x4 (&acc)[2][2][4][2], const Unit& u, int wr, int wc, int fr, int fq) const {
        const int row0 = u.pm * BM + wr * 64 + fr, col0 = u.pn * BM + wc * 32 + 8 * fq;
        if (u.pn >= nbf) {
            const int c0 = wc * 32 + 8 * fq;
#pragma unroll
            for (int ai = 0; ai < 2; ++ai)
#pragma unroll
                for (int m = 0; m < 4; ++m) { float* rowp = Sm + (size_t)(row0 + ai * HALF + m * 16) * 256 + c0;
#pragma unroll
                    for (int bj = 0; bj < 2; ++bj) { *(f32x4*)(rowp + bj * HALF) = acc[ai][bj][m][0]; *(f32x4*)(rowp + bj * HALF + 4) = acc[ai][bj][m][1]; } }
            return;
        }
        const bool sg = u.pn >= ngate0;
#pragma unroll
        for (int ai = 0; ai < 2; ++ai)
#pragma unroll
            for (int m = 0; m < 4; ++m) { bf16_t* rowp = P + (size_t)(row0 + ai * HALF + m * 16) * ldp + col0;
#pragma unroll
                for (int bj = 0; bj < 2; ++bj) { f32x4 v0 = acc[ai][bj][m][0], v1 = acc[ai][bj][m][1];
                    if (sg) {
#pragma unroll
                        for (int j = 0; j < 4; ++j) { v0[j] = sigmoid_f(v0[j]); v1[j] = sigmoid_f(v1[j]); } }
                    u32x4 w; w.x = cvt_pk_bf16(v0[0], v0[1]); w.y = cvt_pk_bf16(v0[2], v0[3]); w.z = cvt_pk_bf16(v1[0], v1[1]); w.w = cvt_pk_bf16(v1[2], v1[3]);
                    *(u32x4*)(rowp + bj * HALF) = w; } }
    }
};
__device__ __forceinline__ f32x4 bf4_lo(u32x4 w) { return (f32x4){__uint_as_float(w.x << 16), __uint_as_float(w.x & 0xffff0000u), __uint_as_float(w.y << 16), __uint_as_float(w.y & 0xffff0000u)}; }
__device__ __forceinline__ f32x4 bf4_hi(u32x4 w) { return (f32x4){__uint_as_float(w.z << 16), __uint_as_float(w.z & 0xffff0000u), __uint_as_float(w.w << 16), __uint_as_float(w.w & 0xffff0000u)}; }
template <int MODE> struct EpiBranch {
    static constexpr bool PERM = true, AFTER_DRAIN = false;
    const bf16_t* G; int ldg; float* T; bf16_t* O; int ldt;
    __device__ __forceinline__ void operator()(const f32x4 (&acc)[2][2][4][2], const Unit& u, int wr, int wc, int fr, int fq) const {
        const int row0 = u.pm * BM + wr * 64 + fr, col0 = u.pn * BM + wc * 32 + 8 * fq;
#pragma unroll
        for (int ai = 0; ai < 2; ++ai)
#pragma unroll
            for (int m = 0; m < 4; ++m) { const size_t r = (size_t)(row0 + ai * HALF + m * 16);
#pragma unroll
                for (int bj = 0; bj < 2; ++bj) { const u32x4 g = *(const u32x4*)(G + r * ldg + col0 + bj * HALF);
                    f32x4 v0 = acc[ai][bj][m][0] * bf4_lo(g), v1 = acc[ai][bj][m][1] * bf4_hi(g);
                    float* tp = T + r * ldt + col0 + bj * HALF;
                    if (MODE >= 1) { v0 = v0 + *(const f32x4*)tp; v1 = v1 + *(const f32x4*)(tp + 4); }
                    if (MODE <= 1) { *(f32x4*)tp = v0; *(f32x4*)(tp + 4) = v1; }
                    else { u32x4 w; w.x = cvt_pk_bf16(v0[0], v0[1]); w.y = cvt_pk_bf16(v0[2], v0[3]); w.z = cvt_pk_bf16(v1[0], v1[1]); w.w = cvt_pk_bf16(v1[2], v1[3]);
                        *(u32x4*)(O + r * ldt + col0 + bj * HALF) = w; } } }
    }
};
struct EpiResid {
    static constexpr bool PERM = false, AFTER_DRAIN = false;
    const float* base; float* out; int ldc;
    __device__ __forceinline__ void operator()(const f32x4 (&acc)[2][2][4][2], const Unit& u, int wr, int wc, int fr, int fq) const {
        const int row0 = u.pm * BM + wr * 64 + fr, col0 = u.pn * BM + wc * 32 + 4 * fq;
#pragma unroll
        for (int ai = 0; ai < 2; ++ai)
#pragma unroll
            for (int m = 0; m < 4; ++m) { const size_t off = (size_t)(row0 + ai * HALF + m * 16) * ldc + col0;
#pragma unroll
                for (int bj = 0; bj < 2; ++bj)
#pragma unroll
                    for (int n = 0; n < 2; ++n) *(f32x4*)(out + off + bj * HALF + n * 16) = *(const f32x4*)(base + off + bj * HALF + n * 16) + acc[ai][bj][m][n]; }
    }
};
struct EpiSwiGLU {
    static constexpr bool PERM = true, AFTER_DRAIN = false;
    bf16_t* O; int ldc;
    __device__ __forceinline__ void operator()(const f32x4 (&acc)[2][2][4][2], const Unit& u, int wr, int wc, int fr, int fq) const {
        const int row0 = u.pm * BM + wr * 64 + fr, col0 = u.pn * HALF + wc * 32 + 8 * fq;
#pragma unroll
        for (int ai = 0; ai < 2; ++ai)
#pragma unroll
            for (int m = 0; m < 4; ++m) { f32x4 v0, v1;
#pragma unroll
                for (int j = 0; j < 4; ++j) { const float g0 = acc[ai][0][m][0][j], g1 = acc[ai][0][m][1][j];
                    v0[j] = g0 * sigmoid_f(g0) * acc[ai][1][m][0][j]; v1[j] = g1 * sigmoid_f(g1) * acc[ai][1][m][1][j]; }
                u32x4 w; w.x = cvt_pk_bf16(v0[0], v0[1]); w.y = cvt_pk_bf16(v0[2], v0[3]); w.z = cvt_pk_bf16(v1[0], v1[1]); w.w = cvt_pk_bf16(v1[2], v1[3]);
                *(u32x4*)(O + (size_t)(row0 + ai * HALF + m * 16) * ldc + col0) = w; }
    }
};
template <class Epi, class Sched, bool ALIGN_EPI = false, bool SP2 = false>
__device__ __forceinline__ void gemm_phase(PG8_LAS unsigned char* lds, const Gemm g, const Sched& S, const Epi& E) {
    int tid_o = my_tid(); asm volatile("" : "+v"(tid_o));
    const int tid = tid_o, wid = __builtin_amdgcn_readfirstlane(tid >> 6), lane = tid & 63, wr = wid >> 2, wc = wid & 3, fr = lane & 15, fq = lane >> 4;
    const int K = g.K, nt = K / BK;
    unsigned voffA[2], voffB[2];
#pragma unroll
    for (int i = 0; i < 2; ++i) { int R, C; stage_rc(tid * 16 + i * 8192, R, C); const int Rb = Epi::PERM ? ((R & ~31) + perm32(R & 31)) : R;
        voffA[i] = (unsigned)(R * K + C) * 2u; voffB[i] = (unsigned)(Rb * K + C) * 2u; }
    const size_t kstep = (size_t)(BK * 2);
    const size_t hstep = (size_t)HALF * K * 2;
    const size_t tstep = 2 * hstep;
    const unsigned ldsw = (unsigned)wid * 1024u;
    const int aoff = lds_byte(wr * 64 + fr, fq * 8), boff = lds_byte(wc * 32 + fr, fq * 8);
#define PG8_SA(b, h) (((b) * 2 + (h)) * HTB)
#define PG8_SB(b, h) ((4 + (b) * 2 + (h)) * HTB)
#define PG8_STAGE(bufoff, gbase, voff) do { _Pragma("unroll") for (int _i = 0; _i < 2; ++_i) \
        __builtin_amdgcn_global_load_lds((const unsigned*)((const char*)(gbase) + (voff)[_i]), (PG8_LAS unsigned*)(lds + (bufoff) + ldsw + _i * 8192), 16, 0, 0); } while (0)
#define PG8_LDA(dst, b, h) do { _Pragma("unroll") for (int m = 0; m < 4; ++m) _Pragma("unroll") for (int k = 0; k < 2; ++k) dst[m][k] = *(const PG8_LAS bf16x8*)(lds + PG8_SA(b, h) + aoff + m * 2048 + k * 1024); } while (0)
#define PG8_LDB(dst, b, h) do { _Pragma("unroll") for (int n = 0; n < 2; ++n) _Pragma("unroll") for (int k = 0; k < 2; ++k) dst[n][k] = *(const PG8_LAS bf16x8*)(lds + PG8_SB(b, h) + boff + n * 2048 + k * 1024); } while (0)
#define PG8_MMA(ai, bj, At, Bt) do { __builtin_amdgcn_s_setprio(1); _Pragma("unroll") for (int m = 0; m < 4; ++m) _Pragma("unroll") for (int n = 0; n < 2; ++n) _Pragma("unroll") for (int k = 0; k < 2; ++k) \
        acc[ai][bj][m][n] = __builtin_amdgcn_mfma_f32_16x16x32_bf16(Bt[n][k], At[m][k], acc[ai][bj][m][n], 0, 0, 0); __builtin_amdgcn_s_setprio(0); } while (0)
#define PG8_WAIT_V(n) asm volatile("s_waitcnt vmcnt(" #n ")" ::: "memory")
#define PG8_WAIT_L(n) asm volatile("s_waitcnt lgkmcnt(" #n ")" ::: "memory")
#define PG8_BAR __builtin_amdgcn_s_barrier()
#define PG8_SCHED __builtin_amdgcn_sched_barrier(0)
    Unit cur, nxt; int ui = 0;
    if (!S.next(0, cur)) return;
    f32x4 acc[2][2][4][2];
#pragma unroll
    for (int a = 0; a < 2; ++a)
#pragma unroll
        for (int b = 0; b < 2; ++b)
#pragma unroll
            for (int m = 0; m < 4; ++m)
#pragma unroll
                for (int n = 0; n < 2; ++n) acc[a][b][m][n] = (f32x4){0.f, 0.f, 0.f, 0.f};
    bf16x8 At[4][2], B0[2][2], B1[2][2];
    const char* cA = (const char*)g.A + (size_t)cur.pm * tstep; const char* cB = (const char*)g.Bt + (size_t)cur.pn * tstep;
    S.a_ready(cur);
    if constexpr (SP2) {
        PG8_STAGE(PG8_SB(0, 0), cB, voffB); PG8_STAGE(PG8_SB(0, 1), cB + hstep, voffB); PG8_STAGE(PG8_SA(0, 0), cA, voffA); PG8_STAGE(PG8_SA(0, 1), cA + hstep, voffA);
        if (wr == 1) PG8_BAR;
        PG8_WAIT_V(2); PG8_BAR;
        PG8_STAGE(PG8_SB(1, 0), cB + kstep, voffB); PG8_STAGE(PG8_SA(1, 0), cA + kstep, voffA); PG8_STAGE(PG8_SB(1, 1), cB + hstep + kstep, voffB);
        PG8_WAIT_V(6); PG8_BAR;
    } else {
        PG8_STAGE(PG8_SB(0, 0), cB, voffB); PG8_STAGE(PG8_SA(0, 0), cA, voffA); PG8_STAGE(PG8_SB(0, 1), cB + hstep, voffB); PG8_STAGE(PG8_SA(0, 1), cA + hstep, voffA);
        if (wr == 1) PG8_BAR;
        PG8_WAIT_V(4); PG8_BAR;
        PG8_STAGE(PG8_SB(1, 0), cB + kstep, voffB); PG8_STAGE(PG8_SA(1, 0), cA + kstep, voffA); PG8_STAGE(PG8_SB(1, 1), cB + hstep + kstep, voffB);
        PG8_WAIT_V(6); PG8_BAR;
    }
    for (;;) {
        const bool has_next = S.next(ui + 1, nxt);
        const char* nA = has_next ? (const char*)g.A + (size_t)nxt.pm * tstep : cA; const char* nB = has_next ? (const char*)g.Bt + (size_t)nxt.pn * tstep : cB;
        for (int t = 0; t < nt; t += 2) {
            const bool last = (t == nt - 2);
            const char* a1 = cA + (size_t)(t + 1) * kstep;
            const char* a2 = last ? nA : cA + (size_t)(t + 2) * kstep; const char* b2 = last ? nB : cB + (size_t)(t + 2) * kstep;
            const char* a3 = a2 + kstep; const char* b3 = b2 + kstep;
            if (last && has_next) S.a_ready(nxt);
            if constexpr (SP2) {
            PG8_LDB(B0, 0, 0); PG8_LDB(B1, 0, 1); PG8_SCHED; PG8_LDA(At, 0, 0); PG8_STAGE(PG8_SA(1, 1), a1 + hstep, voffA);
            PG8_WAIT_V(8); PG8_WAIT_L(0); PG8_BAR; PG8_MMA(0, 0, At, B0); PG8_MMA(0, 1, At, B1); PG8_BAR; PG8_SCHED;
            PG8_LDA(At, 0, 1); PG8_STAGE(PG8_SB(0, 0), b2, voffB); PG8_STAGE(PG8_SB(0, 1), b2 + hstep, voffB); PG8_STAGE(PG8_SA(0, 0), a2, voffA);
            PG8_WAIT_V(8); PG8_WAIT_L(0); PG8_BAR; PG8_MMA(1, 0, At, B0); PG8_MMA(1, 1, At, B1); PG8_BAR; PG8_SCHED;
            PG8_LDB(B0, 1, 0); PG8_LDB(B1, 1, 1); PG8_SCHED; PG8_LDA(At, 1, 0); PG8_STAGE(PG8_SA(0, 1), a2 + hstep, voffA);
            PG8_WAIT_V(8); PG8_WAIT_L(0); PG8_BAR; PG8_MMA(0, 0, At, B0); PG8_MMA(0, 1, At, B1); PG8_BAR; PG8_SCHED;
            PG8_LDA(At, 1, 1); PG8_STAGE(PG8_SB(1, 0), b3, voffB); PG8_STAGE(PG8_SB(1, 1), b3 + hstep, voffB); PG8_STAGE(PG8_SA(1, 0), a3, voffA);
            PG8_WAIT_V(8); PG8_WAIT_L(0); PG8_BAR; PG8_MMA(1, 0, At, B0); PG8_MMA(1, 1, At, B1); PG8_BAR; PG8_SCHED;
            } else {
            PG8_LDB(B0, 0, 0); PG8_SCHED; PG8_LDA(At, 0, 0); PG8_STAGE(PG8_SA(1, 1), a1 + hstep, voffA);
            PG8_WAIT_L(8); PG8_BAR; PG8_WAIT_L(0); PG8_MMA(0, 0, At, B0); PG8_BAR; PG8_SCHED;
            PG8_LDB(B1, 0, 1); PG8_STAGE(PG8_SB(0, 0), b2, voffB);
            PG8_BAR; PG8_WAIT_L(0); PG8_MMA(0, 1, At, B1); PG8_BAR;
            PG8_LDA(At, 0, 1); PG8_STAGE(PG8_SA(0, 0), a2, voffA);
            PG8_BAR; PG8_WAIT_L(0); PG8_MMA(1, 0, At, B0); PG8_BAR; PG8_SCHED;
            PG8_STAGE(PG8_SB(0, 1), b2 + hstep, voffB);
            PG8_WAIT_V(6); PG8_BAR; PG8_MMA(1, 1, At, B1); PG8_BAR;
            PG8_LDB(B0, 1, 0); PG8_SCHED; PG8_LDA(At, 1, 0); PG8_STAGE(PG8_SA(0, 1), a2 + hstep, voffA);
            PG8_WAIT_L(8); PG8_BAR; PG8_WAIT_L(0); PG8_MMA(0, 0, At, B0); PG8_BAR; PG8_SCHED;
            PG8_LDB(B1, 1, 1); PG8_STAGE(PG8_SB(1, 0), b3, voffB);
            PG8_BAR; PG8_WAIT_L(0); PG8_MMA(0, 1, At, B1); PG8_BAR;
            PG8_LDA(At, 1, 1); PG8_STAGE(PG8_SA(1, 0), a3, voffA);
            PG8_BAR; PG8_WAIT_L(0); PG8_MMA(1, 0, At, B0); PG8_BAR; PG8_SCHED;
            PG8_STAGE(PG8_SB(1, 1), b3 + hstep, voffB);
            PG8_WAIT_V(6); PG8_BAR; PG8_MMA(1, 1, At, B1); PG8_BAR;
            }
        }
        if constexpr (ALIGN_EPI) { if (wr == 0) PG8_BAR; }
        if constexpr (!Epi::AFTER_DRAIN) { E(acc, cur, wr, wc, fr, fq); S.done(cur); }
        if (!has_next) break;
#pragma unroll
        for (int a = 0; a < 2; ++a)
#pragma unroll
            for (int b = 0; b < 2; ++b)
#pragma unroll
                for (int m = 0; m < 4; ++m)
#pragma unroll
                    for (int n = 0; n < 2; ++n) acc[a][b][m][n] = (f32x4){0.f, 0.f, 0.f, 0.f};
        cur = nxt; cA = nA; cB = nB; ++ui;
        if constexpr (ALIGN_EPI) { if (wr == 1) PG8_BAR; }
    }
    PG8_WAIT_V(0);
    if constexpr (!ALIGN_EPI) { if (wr == 0) PG8_BAR; }
    PG8_BAR;
    if constexpr (Epi::AFTER_DRAIN) { E.fused(acc, cur, wr, wc, fr, fq, lds, wid, lane); S.done(cur); }
#undef PG8_SA
#undef PG8_SB
#undef PG8_STAGE
#undef PG8_LDA
#undef PG8_LDB
#undef PG8_MMA
#undef PG8_WAIT_V
#undef PG8_WAIT_L
#undef PG8_BAR
#undef PG8_SCHED
}
}

using pg8::sigmoid_f;
constexpr int NWAVES = 8, NTHR = 512;
constexpr int S = 8192, DM = 2048, DEPTH = 4, FF = 5632;
constexpr int NPROJ = 16896, NPROJ_PAD = 17152, LPROJ = 16976;
constexpr int PC_AQ = 0, PC_AK = 1024, PC_AV = 2048, PC_IQ = 3072, PC_MQ = 3584, PC_MK = 4096, PC_MV = 4608, PC_MO = 5632, PC_RQ = 6656, PC_RK = 7680, PC_RV = 8704, PC_RG = 9728, PC_G = 10752;
constexpr int LC_IK = 3584, LC_IW = 3648, LC_MI = 5704, LC_MF = 5708;
constexpr float NORM_EPS = 1e-6f;
constexpr size_t MiB = 1u << 20;
constexpr size_t WS_CTL = 0, CTL_ZERO_BYTES = 1 * MiB;
constexpr size_t WS_ROPE128 = 2 * MiB, WS_ROPE64 = 6 * MiB;
constexpr size_t WS_W = 16 * MiB, W_LAYER = 153 * MiB;
constexpr size_t WO_IN = 0, WO_B = 67 * MiB, WO_OUT = 79 * MiB, WO_FIN = 87 * MiB, WO_FOUT = 131 * MiB;
constexpr size_t WS_H = 640 * MiB, WS_PROJ = 672 * MiB, WS_SMALL = 936 * MiB, WS_MQK = 944 * MiB, WS_IKB = 960 * MiB, WS_IWF = 961 * MiB, WS_GIF = WS_IWF + 512 * 1024;
constexpr size_t WS_SC = 964 * MiB, WS_MB = 1220 * MiB, WS_DCM = 1228 * MiB, WS_CPM = 1260 * MiB, WS_MISC = 1292 * MiB, WS_DRR = 1294 * MiB, WS_RPR = 1310 * MiB;
constexpr size_t WS_YA = 1328 * MiB, WS_YM = 1344 * MiB, WS_YR = 1360 * MiB, WS_MERGEDF = 1376 * MiB, WS_MERGED = 1440 * MiB, WS_ACT = 1472 * MiB, WS_END = 1560 * MiB;
constexpr size_t MISC_DN = 0, MISC_NPREV = 256 * 1024, MISC_AB = 512 * 1024, MISC_MPREV = 520 * 1024;
constexpr int CW_BAR = 4096;
constexpr int LDS_BYTES = 147456, MISC_OFF = 147456 - 1024;

#define GAS __attribute__((address_space(1)))
#define LAS __attribute__((address_space(3)))
typedef unsigned short bf16;
typedef unsigned v4u __attribute__((ext_vector_type(4)));
typedef unsigned v2u __attribute__((ext_vector_type(2)));
typedef float f32x4 __attribute__((ext_vector_type(4)));
typedef float f32x16 __attribute__((ext_vector_type(16)));
typedef short bf16x8 __attribute__((ext_vector_type(8)));
typedef short s16x4 __attribute__((ext_vector_type(4)));
#define LDS_WAIT() asm volatile("s_waitcnt lgkmcnt(0)" ::: "memory")
#define VM_WAIT() asm volatile("s_waitcnt vmcnt(0)" ::: "memory")
__device__ __forceinline__ unsigned f2bf(float f) { unsigned u = __builtin_bit_cast(unsigned, f); return (u + 0x7fffu + ((u >> 16) & 1u)) >> 16; }
__device__ __forceinline__ unsigned pk2(float lo, float hi) { return f2bf(lo) | (f2bf(hi) << 16); }
__device__ __forceinline__ float bf2f(bf16 b) { return __uint_as_float(((unsigned)b) << 16); }
template <int CTRL, int RMASK, int BMASK> __device__ __forceinline__ float dpp_f(float old, float src) { return __builtin_bit_cast(float, __builtin_amdgcn_update_dpp(__builtin_bit_cast(int, old), __builtin_bit_cast(int, src), CTRL, RMASK, BMASK, false)); }
template <int CTRL, int RMASK, int BMASK> __device__ __forceinline__ unsigned dpp_u(unsigned src) { return (unsigned)__builtin_amdgcn_update_dpp(0, (int)src, CTRL, RMASK, BMASK, false); }
__device__ __forceinline__ float wave_sum(float x) {
    x += dpp_f<0xB1, 0xf, 0xf>(0.f, x); x += dpp_f<0x4E, 0xf, 0xf>(0.f, x); x += dpp_f<0x141, 0xf, 0xf>(0.f, x); x += dpp_f<0x140, 0xf, 0xf>(0.f, x);
    x += dpp_f<0x142, 0xa, 0xf>(0.f, x); x += dpp_f<0x143, 0xc, 0xf>(0.f, x);
    return __builtin_bit_cast(float, __builtin_amdgcn_readlane(__builtin_bit_cast(int, x), 63)); }
__device__ __forceinline__ float wave_max(float x) {
    x = fmaxf(x, dpp_f<0xB1, 0xf, 0xf>(x, x)); x = fmaxf(x, dpp_f<0x4E, 0xf, 0xf>(x, x)); x = fmaxf(x, dpp_f<0x141, 0xf, 0xf>(x, x)); x = fmaxf(x, dpp_f<0x140, 0xf, 0xf>(x, x));
    x = fmaxf(x, dpp_f<0x142, 0xa, 0xf>(x, x)); x = fmaxf(x, dpp_f<0x143, 0xc, 0xf>(x, x));
    return __builtin_bit_cast(float, __builtin_amdgcn_readlane(__builtin_bit_cast(int, x), 63)); }
__device__ __forceinline__ unsigned lane_id_v() { unsigned l; asm volatile("v_mbcnt_lo_u32_b32 %0, -1, 0\n\tv_mbcnt_hi_u32_b32 %0, -1, %0" : "=v"(l)); return l; }
__device__ __forceinline__ int my_tid() {
    const unsigned slot = (unsigned)__builtin_amdgcn_s_getreg((5 << 11) | 4) & 63u;
    extern __shared__ __attribute__((aligned(16))) unsigned char lds_raw_t[];
    const unsigned wv = ((volatile LAS unsigned*)((LAS unsigned char*)lds_raw_t + MISC_OFF))[64 + slot];
    return (int)(__builtin_amdgcn_readfirstlane(wv) * 64u + lane_id_v());
}
__device__ __forceinline__ float shfl_idx_f(float x, int src_lane) { return __builtin_bit_cast(float, __builtin_amdgcn_ds_bpermute(src_lane << 2, __builtin_bit_cast(int, x))); }
__device__ __forceinline__ float wave_prefix_sum_f(float x) {
    float y = x + dpp_f<0x111, 0xf, 0xf>(0.f, x); y += dpp_f<0x112, 0xf, 0xf>(0.f, x); y += dpp_f<0x113, 0xf, 0xf>(0.f, x);
    y += dpp_f<0x114, 0xf, 0xe>(0.f, y); y += dpp_f<0x118, 0xf, 0xc>(0.f, y); y += dpp_f<0x142, 0xa, 0xf>(0.f, y); y += dpp_f<0x143, 0xc, 0xf>(0.f, y); return y; }
__device__ __forceinline__ float wave_prefix_max_f(float x) {
    const float N = -3.0e38f;
    float y = fmaxf(x, dpp_f<0x111, 0xf, 0xf>(N, x)); y = fmaxf(y, dpp_f<0x112, 0xf, 0xf>(N, x)); y = fmaxf(y, dpp_f<0x113, 0xf, 0xf>(N, x));
    y = fmaxf(y, dpp_f<0x114, 0xf, 0xe>(N, y)); y = fmaxf(y, dpp_f<0x118, 0xf, 0xc>(N, y)); y = fmaxf(y, dpp_f<0x142, 0xa, 0xf>(N, y)); y = fmaxf(y, dpp_f<0x143, 0xc, 0xf>(N, y)); return y; }
#define XB_TMO      128
#define XB_XCNT(j)  (256  + 64 * (j))
#define XB_XSUB(j)  (1280 + 64 * (j))
#define XB_XGEN(j)  (2304 + 64 * (j))
#define XB_TOP      3328
#define XB_TOPGEN   3392
#define XCD_BAR_WORDS 3456
#define XB_SPIN_CAP (1u << 18)

__device__ __forceinline__ unsigned xb_ld(unsigned* p)              { return __hip_atomic_load(p, __ATOMIC_RELAXED, __HIP_MEMORY_SCOPE_AGENT); }
__device__ __forceinline__ unsigned xb_add(unsigned* p, unsigned v) { return __hip_atomic_fetch_add(p, v, __ATOMIC_RELAXED, __HIP_MEMORY_SCOPE_AGENT); }
__device__ __forceinline__ unsigned xb_xcc_id() { return (unsigned)__builtin_amdgcn_s_getreg((3 << 11) | 20) & 0xFu; }
#define XB_SPIN(cond, bar) do { unsigned _sp = 0; while (cond) { __builtin_amdgcn_s_sleep(1); \
    if ((++_sp & 255u) == 0u) { if (xb_ld(&(bar)[XB_TMO])) break; if (_sp > XB_SPIN_CAP) { atomicAdd(&(bar)[XB_TMO], 1u); break; } } } } while (0)

struct XcdBarrier {
    unsigned* bar; unsigned x;
    volatile LAS unsigned* st;
};

__device__ __forceinline__ XcdBarrier xcd_barrier_post(unsigned* bar, volatile LAS unsigned* st) {
    XcdBarrier b; b.bar = bar; b.x = xb_xcc_id(); b.st = st;
    if (my_tid() == 0) (void)xb_add(&bar[XB_XCNT(b.x)], 1u);
    return b;
}
__device__ __forceinline__ void xcd_barrier_complete(unsigned* bar, unsigned x, unsigned& nloc, unsigned& nx) {
    const unsigned G = gridDim.x * gridDim.y * gridDim.z;
    unsigned sum, cnt, mine, sp = 0u;
    for (;;) {
        sum = 0u; cnt = 0u; mine = 0u;
#pragma unroll
        for (unsigned j = 0; j < 16; ++j) { const unsigned c = xb_ld(&bar[XB_XCNT(j)]); sum += c; cnt += (c > 0u) ? 1u : 0u; mine = (j == x) ? c : mine; }
        if (sum == G) break;
        __builtin_amdgcn_s_sleep(1);
        if ((++sp & 255u) == 0u) { if (xb_ld(&bar[XB_TMO])) break; if (sp > XB_SPIN_CAP) { atomicAdd(&bar[XB_TMO], 1u); break; } }
    }
    nloc = mine > 0u ? mine : 1u; nx = cnt > 0u ? cnt : 1u;
}

__device__ __forceinline__ void xcd_barrier(const XcdBarrier& b) {
    asm volatile("s_waitcnt vmcnt(0)" ::: "memory");
    __syncthreads();
    if (my_tid() == 0) {
        unsigned* bar = b.bar;
        __builtin_amdgcn_s_waitcnt(0);
        unsigned nloc = b.st[0], nx = b.st[1];
        if (nloc == 0u) { xcd_barrier_complete(bar, b.x, nloc, nx); b.st[0] = nloc; b.st[1] = nx; }
        const unsigned old = xb_add(&bar[XB_XSUB(b.x)], 1u);
        const unsigned gen = old / nloc;
        if (old + 1u == (gen + 1u) * nloc) {
            __builtin_amdgcn_fence(__ATOMIC_RELEASE, "agent");
            asm volatile("s_waitcnt vmcnt(0)" ::: "memory");
            const unsigned og = xb_add(&bar[XB_TOP], 1u);
            const unsigned tg = og / nx;
            if (og + 1u == (tg + 1u) * nx) xb_add(&bar[XB_TOPGEN], 1u);
            else XB_SPIN(xb_ld(&bar[XB_TOPGEN]) == tg, bar);
            __builtin_amdgcn_fence(__ATOMIC_ACQUIRE, "agent");
            xb_add(&bar[XB_XGEN(b.x)], 1u);
            asm volatile("s_waitcnt vmcnt(0)" ::: "memory");
        } else {
            XB_SPIN(xb_ld(&bar[XB_XGEN(b.x)]) == gen, bar);
            __builtin_amdgcn_fence(__ATOMIC_ACQUIRE, "agent");
            asm volatile("s_waitcnt vmcnt(0)" ::: "memory");
        }
    }
    __syncthreads();
}

struct MapIdent { __device__ __forceinline__ int operator()(int p) const { return p; } };
struct MapWin { __device__ __forceinline__ int operator()(int p) const {
    if (p < 3584) return p; if (p < 5632) return p + 72; if (p < NPROJ) return p + 80;
    const int r = p - NPROJ; if (r < 64) return LC_IK + r; if (r < 72) return LC_IW + (r - 64); if (r < 76) return LC_MI + (r - 72); if (r < 80) return LC_MF + (r - 76); return -1; } };
struct MapFfn { __device__ __forceinline__ int operator()(int p) const { const int t = p >> 8, r = p & 255; return r < 128 ? 128 * t + r : FF + 128 * t + (r - 128); } };
template <class Map> __device__ __forceinline__ void transpose_item(const float* W, int K, int N, bf16* WT, LAS float* scr, int item, int nblk, int lane, const Map& map) {
    const int kb = item / nblk, nb = item % nblk, k0 = 64 * kb, p0 = 64 * nb;
    const int n4 = lane & 15, kr = lane >> 4, nl = map(p0 + 4 * n4);
    f32x4 v[16];
#pragma unroll
    for (int i = 0; i < 16; ++i) v[i] = nl >= 0 ? *(const GAS f32x4*)(W + (size_t)(k0 + kr + 4 * i) * N + nl) : (f32x4){0.f, 0.f, 0.f, 0.f};
#pragma unroll
    for (int i = 0; i < 16; ++i) { LAS float* d = scr + (kr + 4 * i) * 65 + 4 * n4; d[0] = v[i][0]; d[1] = v[i][1]; d[2] = v[i][2]; d[3] = v[i][3]; }
    LDS_WAIT(); asm volatile("" ::: "memory");
    const int c = lane & 7;
#pragma unroll
    for (int j = 0; j < 8; ++j) { const int n = (lane >> 3) + 8 * j; const LAS float* s = scr + (8 * c) * 65 + n;
        v4u o; o.x = pk2(s[0 * 65], s[1 * 65]); o.y = pk2(s[2 * 65], s[3 * 65]); o.z = pk2(s[4 * 65], s[5 * 65]); o.w = pk2(s[6 * 65], s[7 * 65]);
        *(GAS v4u*)(WT + (size_t)(p0 + n) * K + k0 + 8 * c) = o; }
    LDS_WAIT(); asm volatile("" ::: "memory");
}
template <class Map> __device__ __forceinline__ void transpose_matrix(const float* W, int K, int N, int Nphys, bf16* WT, LAS float* scr, int gw, int ngw, int lane, const Map& map) {
    const int nblk = Nphys / 64, nit = (K / 64) * nblk;
    for (int it = gw; it < nit; it += ngw) transpose_item(W, K, N, WT, scr, it, nblk, lane, map);
}

__device__ __forceinline__ void rms_row_to_bf16(const float* xrow, const float* gain, bf16* orow, int lane) {
    const GAS f32x4* xr = (const GAS f32x4*)xrow + lane; const GAS f32x4* gr = (const GAS f32x4*)gain + lane;
    f32x4 v[8]; float s = 0.f;
#pragma unroll
    for (int j = 0; j < 8; ++j) { v[j] = xr[64 * j]; s += (v[j].x * v[j].x + v[j].y * v[j].y) + (v[j].z * v[j].z + v[j].w * v[j].w); }
    const float rstd = 1.0f / sqrtf(wave_sum(s) * (1.f / DM) + NORM_EPS);
    GAS unsigned long long* o8 = (GAS unsigned long long*)orow + lane;
#pragma unroll
    for (int j = 0; j < 8; ++j) { const f32x4 g = gr[64 * j]; o8[64 * j] = (unsigned long long)pk2(v[j].x * rstd * g.x, v[j].y * rstd * g.y) | ((unsigned long long)pk2(v[j].z * rstd * g.z, v[j].w * rstd * g.w) << 32); }
}

struct PPArgs { bf16* proj; const float* small; bf16* mqk; bf16* ikb; unsigned char* sgn; float* gif; const float* rope128; const float* rope64; const float* gq; const float* gk; const float* convw; const float* gbias; };
__device__ __forceinline__ void bf8_unpack(const v4u w, float (&f)[8]) { f[0] = __uint_as_float(w.x << 16); f[1] = __uint_as_float(w.x & 0xffff0000u); f[2] = __uint_as_float(w.y << 16); f[3] = __uint_as_float(w.y & 0xffff0000u);
    f[4] = __uint_as_float(w.z << 16); f[5] = __uint_as_float(w.z & 0xffff0000u); f[6] = __uint_as_float(w.w << 16); f[7] = __uint_as_float(w.w & 0xffff0000u); }
__device__ __forceinline__ v4u bf8_pack(const float (&f)[8]) { v4u o; o.x = pk2(f[0], f[1]); o.y = pk2(f[2], f[3]); o.z = pk2(f[4], f[5]); o.w = pk2(f[6], f[7]); return o; }
__device__ __forceinline__ float sum8_dpp(float x) {
    x += dpp_f<0xB1, 0xf, 0xf>(0.f, x); x += dpp_f<0x4E, 0xf, 0xf>(0.f, x); x += dpp_f<0x141, 0xf, 0xf>(0.f, x); return x; }
__device__ __forceinline__ void pp_row(const PPArgs& a, int t, int lane, const f32x4 (&cw)[16]) {
    bf16* pr = a.proj + (size_t)t * NPROJ;
    const int hd = lane >> 3, d0 = (lane & 7) * 8;
    float cs[8], sn[8];
#pragma unroll
    for (int i = 0; i < 4; ++i) { const f32x4 c = *(const f32x4*)(a.rope128 + ((size_t)t * 64 + d0 + 2 * i) * 2); cs[2 * i] = c[0]; sn[2 * i] = c[1]; cs[2 * i + 1] = c[2]; sn[2 * i + 1] = c[3]; }
#pragma unroll
    for (int seg = 0; seg < 4; ++seg) {
        const int base = seg == 0 ? PC_AQ : (seg == 1 ? PC_AK : (seg == 2 ? PC_RQ : PC_RK));
        bf16* p = pr + base + hd * 128 + d0; float x1[8], x2[8];
        bf8_unpack(*(const GAS v4u*)p, x1); bf8_unpack(*(const GAS v4u*)(p + 64), x2);
        if (seg < 2) { const float* gn = seg ? a.gk : a.gq; float ss = 0.f;
#pragma unroll
            for (int i = 0; i < 8; ++i) ss += x1[i] * x1[i] + x2[i] * x2[i];
            const float rstd = 1.0f / sqrtf(sum8_dpp(ss) * (1.f / 128.f) + NORM_EPS);
            const f32x4 ga = *(const f32x4*)(gn + d0), gb = *(const f32x4*)(gn + d0 + 4), gc = *(const f32x4*)(gn + 64 + d0), gd = *(const f32x4*)(gn + 64 + d0 + 4);
#pragma unroll
            for (int i = 0; i < 4; ++i) { x1[i] *= rstd * ga[i]; x1[4 + i] *= rstd * gb[i]; x2[i] *= rstd * gc[i]; x2[4 + i] *= rstd * gd[i]; } }
        float o1[8], o2[8];
#pragma unroll
        for (int i = 0; i < 8; ++i) { o1[i] = x1[i] * cs[i] - x2[i] * sn[i]; o2[i] = x2[i] * cs[i] + x1[i] * sn[i]; }
        *(GAS v4u*)p = bf8_pack(o1); *(GAS v4u*)(p + 64) = bf8_pack(o2); }
    const float* sm = a.small + (size_t)t * 256;
    {
        const int e0 = (lane & 7) * 4; const f32x4 ca = *(const f32x4*)(a.rope64 + ((size_t)t * 32 + e0) * 2), cb = *(const f32x4*)(a.rope64 + ((size_t)t * 32 + e0 + 2) * 2);
        const float c4[4] = {ca[0], ca[2], cb[0], cb[2]}, s4[4] = {ca[1], ca[3], cb[1], cb[3]};
        bf16* p = pr + PC_IQ + hd * 64 + e0; const v2u lo = *(const GAS v2u*)p, hi = *(const GAS v2u*)(p + 32);
        const float aw = fabsf(sm[64 + hd]) * (0.35355339059327373f * 0.125f);
        const float y1[4] = {__uint_as_float(lo.x << 16), __uint_as_float(lo.x & 0xffff0000u), __uint_as_float(lo.y << 16), __uint_as_float(lo.y & 0xffff0000u)};
        const float y2[4] = {__uint_as_float(hi.x << 16), __uint_as_float(hi.x & 0xffff0000u), __uint_as_float(hi.y << 16), __uint_as_float(hi.y & 0xffff0000u)};
        float q1[4], q2[4];
#pragma unroll
        for (int i = 0; i < 4; ++i) { q1[i] = (y1[i] * c4[i] - y2[i] * s4[i]) * aw; q2[i] = (y2[i] * c4[i] + y1[i] * s4[i]) * aw; }
        v2u w1, w2; w1.x = pk2(q1[0], q1[1]); w1.y = pk2(q1[2], q1[3]); w2.x = pk2(q2[0], q2[1]); w2.y = pk2(q2[2], q2[3]);
        *(GAS v2u*)p = w1; *(GAS v2u*)(p + 32) = w2;
        if (lane < 8) { const f32x4 k1 = *(const f32x4*)(sm + e0), k2 = *(const f32x4*)(sm + 32 + e0); float r1[4], r2[4];
#pragma unroll
            for (int i = 0; i < 4; ++i) { r1[i] = k1[i] * c4[i] - k2[i] * s4[i]; r2[i] = k2[i] * c4[i] + k1[i] * s4[i]; }
            v2u u1, u2; u1.x = pk2(r1[0], r1[1]); u1.y = pk2(r1[2], r1[3]); u2.x = pk2(r2[0], r2[1]); u2.y = pk2(r2[2], r2[3]);
            *(GAS v2u*)(a.ikb + (size_t)t * 64 + e0) = u1; *(GAS v2u*)(a.ikb + (size_t)t * 64 + 32 + e0) = u2; } }
    { const unsigned long long nb = __builtin_amdgcn_ballot_w64(lane < 8 && sm[64 + (lane & 7)] < 0.f); if (lane == 0) a.sgn[t] = (unsigned char)(nb & 0xffull); }
    if (lane < 8) a.gif[(size_t)t * 8 + lane] = sm[72 + lane] + a.gbias[lane];
    {
        float acc[16];
#pragma unroll
        for (int i = 0; i < 16; ++i) acc[i] = 0.f;
#pragma unroll
        for (int j = 0; j < 4; ++j) { const int tt = t - 3 + j; if (tt >= 0) { const bf16* xp = a.proj + (size_t)tt * NPROJ + PC_MQ + 16 * lane; float xa[8], xb[8];
                bf8_unpack(*(const GAS v4u*)xp, xa); bf8_unpack(*(const GAS v4u*)(xp + 8), xb);
#pragma unroll
                for (int i = 0; i < 4; ++i) { acc[i] += cw[j * 4][i] * xa[i]; acc[4 + i] += cw[j * 4 + 1][i] * xa[4 + i]; acc[8 + i] += cw[j * 4 + 2][i] * xb[i]; acc[12 + i] += cw[j * 4 + 3][i] * xb[4 + i]; } } }
        float oa[8], ob[8];
#pragma unroll
        for (int i = 0; i < 8; ++i) { oa[i] = acc[i]; ob[i] = acc[8 + i]; }
        bf16* mp = a.mqk + (size_t)t * 1024 + 16 * lane; *(GAS v4u*)mp = bf8_pack(oa); *(GAS v4u*)(mp + 8) = bf8_pack(ob); }
}

__device__ __forceinline__ void score_wave_unit(const bf16* proj, const bf16* ikb, const unsigned char* sgn, float* sc, int qb, int kb, int lane) {
    const int r = lane & 31, h = lane >> 5, q0 = qb * 32, s0 = kb * 64;
    bf16x8 ka[2][4];
#pragma unroll
    for (int b = 0; b < 2; ++b)
#pragma unroll
        for (int kk = 0; kk < 4; ++kk) ka[b][kk] = *(const bf16x8*)(ikb + (size_t)(s0 + 32 * b + r) * 64 + 16 * kk + 8 * h);
    const bf16* qrow = proj + (size_t)(q0 + r) * NPROJ + PC_IQ + 8 * h;
    unsigned sg[4];
#pragma unroll
    for (int g = 0; g < 4; ++g) sg[g] = *(const unsigned*)(sgn + q0 + 8 * g + 4 * h);
    f32x16 scv[2];
#pragma unroll
    for (int b = 0; b < 2; ++b)
#pragma unroll
        for (int e = 0; e < 16; ++e) scv[b][e] = 0.f;
    bf16x8 qa[4], qb2[4];
#pragma unroll
    for (int kk = 0; kk < 4; ++kk) qa[kk] = *(const bf16x8*)(qrow + 16 * kk);
#define SCORE_HEAD(QF, j_) do { unsigned t_[4]; _Pragma("unroll") for (int g = 0; g < 4; ++g) t_[g] = sg[g] << (7 - (j_)); \
        _Pragma("unroll") for (int b = 0; b < 2; ++b) { f32x16 acc; _Pragma("unroll") for (int e = 0; e < 16; ++e) acc[e] = 0.f; \
        _Pragma("unroll") for (int kk = 0; kk < 4; ++kk) acc = __builtin_amdgcn_mfma_f32_32x32x16_bf16(QF[kk], ka[b][kk], acc, 0, 0, 0); \
        _Pragma("unroll") for (int e = 0; e < 16; ++e) { const unsigned sb = (t_[e >> 2] << (24 - 8 * (e & 3))) & 0x80000000u; scv[b][e] += __uint_as_float(__float_as_uint(fmaxf(acc[e], 0.f)) | sb); } } } while (0)
#pragma unroll 1
    for (int j = 0; j < 8; j += 2) {
#pragma unroll
        for (int kk = 0; kk < 4; ++kk) qb2[kk] = *(const bf16x8*)(qrow + (j + 1) * 64 + 16 * kk);
        __builtin_amdgcn_sched_barrier(0);
        SCORE_HEAD(qa, j);
        __builtin_amdgcn_sched_barrier(0);
        if (j + 2 < 8) {
#pragma unroll
            for (int kk = 0; kk < 4; ++kk) qa[kk] = *(const bf16x8*)(qrow + (j + 2) * 64 + 16 * kk); }
        __builtin_amdgcn_sched_barrier(0);
        SCORE_HEAD(qb2, j + 1);
    }
#undef SCORE_HEAD
#pragma unroll
    for (int b = 0; b < 2; ++b)
#pragma unroll
        for (int e = 0; e < 16; ++e) sc[(size_t)(q0 + (e & 3) + 8 * (e >> 2) + 4 * h) * S + s0 + 32 * b + r] = scv[b][e];
}


__device__ __forceinline__ float wave_max_dpp(float x) { return wave_max(x); }
__device__ __forceinline__ float wave_min_dpp(float x) { return -wave_max_dpp(-x); }
__device__ __forceinline__ unsigned wave_prefix_dpp(unsigned x) {
    unsigned y = x + dpp_u<0x111, 0xf, 0xf>(x); y += dpp_u<0x112, 0xf, 0xf>(x); y += dpp_u<0x113, 0xf, 0xf>(x);
    y += dpp_u<0x114, 0xf, 0xe>(y); y += dpp_u<0x118, 0xf, 0xc>(y); y += dpp_u<0x142, 0xa, 0xf>(y); y += dpp_u<0x143, 0xc, 0xf>(y);
    return y; }
#define SEL_BAR() do { asm volatile("s_waitcnt lgkmcnt(0)" ::: "memory"); __builtin_amdgcn_s_barrier(); asm volatile("" ::: "memory"); } while (0)
__device__ __forceinline__ void select_rows_wg(LAS unsigned char* lds, const float* sc, unsigned long long* mb, int row0, int rstep, int tid) {
    LAS unsigned* hist = (LAS unsigned*)lds;
    LAS unsigned* btot = hist + 2176;
    LAS float* red = (LAS float*)(hist + 2240); LAS unsigned* lcnt = hist + 2256;
    LAS float* lval = (LAS float*)(hist + 2272); LAS int* lidx = (LAS int*)(hist + 2272 + 8192); LAS unsigned* lsel = hist + 2272 + 16384;
    const int lane = tid & 63, w = tid >> 6;
    f32x4 nx[4];
#define SEL_LOAD(t_) do { const float* scr_ = sc + (size_t)(t_) * S + 4 * tid; _Pragma("unroll") for (int j = 0; j < 4; ++j) nx[j] = *(const GAS f32x4*)(scr_ + 2048 * j); } while (0)
    if (row0 < S) SEL_LOAD(row0);
    if (tid < 2) lcnt[tid] = 0u;
    for (int j = tid; j < 2240; j += NTHR) hist[j] = 0u;
    if (tid == 0) lsel[0] = 0u;
    int par = 0;
    for (int t = row0; t < S; t += rstep) {
        float v[16];
#pragma unroll
        for (int j = 0; j < 4; ++j)
#pragma unroll
            for (int c = 0; c < 4; ++c) v[4 * j + c] = (2048 * j + 4 * tid + c <= t) ? nx[j][c] : -3.0e38f;
        if (t + rstep < S) SEL_LOAD(t + rstep);
        unsigned long long* mbr = mb + (size_t)t * 128;
        bool sel[16];
        if (t >= 256) {
            const int ngrp = (t >> 11) + 1;
            float mn = 3.0e38f, mx = -3.0e38f;
#pragma unroll
            for (int i = 0; i < 16; ++i) { mx = fmaxf(mx, v[i]); mn = fminf(mn, (v[i] > -3.0e38f) ? v[i] : 3.0e38f); }
            mn = wave_min_dpp(mn); mx = wave_max_dpp(mx);
            if (lane == 0) { red[w] = mn; red[8 + w] = mx; }
            SEL_BAR();
            mn = red[0]; mx = red[8];
#pragma unroll
            for (int j = 1; j < 8; ++j) { mn = fminf(mn, red[j]); mx = fmaxf(mx, red[8 + j]); }
            const float scale = (mx > mn) ? 2047.0f / (mx - mn) : 0.f;
            int bin[16];
#pragma unroll
            for (int i = 0; i < 16; ++i) { int b = (int)((v[i] - mn) * scale); b = b < 0 ? 0 : (b > 2047 ? 2047 : b); const bool ok = v[i] > -3.0e38f; bin[i] = ok ? b : -1;
                if ((i >> 2) < ngrp) { (void)__hip_atomic_fetch_add(hist + (ok ? b + (b >> 5) : 2112 + lane), 1u, __ATOMIC_RELAXED, __HIP_MEMORY_SCOPE_WORKGROUP);
                    (void)__hip_atomic_fetch_add(btot + (ok ? (b >> 5) : 0), ok ? 1u : 0u, __ATOMIC_RELAXED, __HIP_MEMORY_SCOPE_WORKGROUP); } }
            SEL_BAR();
            const unsigned bt = btot[63 - lane]; const unsigned sufb = wave_prefix_dpp(bt);
            const unsigned long long ob = __builtin_amdgcn_ballot_w64(sufb >= 256u);
            const int olb = ob ? (int)__builtin_ctzll(ob) : 0; const int blk = 63 - olb;
            const unsigned above_blk = (unsigned)__builtin_amdgcn_readlane((int)(sufb - bt), olb);
            const unsigned hbn = (lane < 32) ? hist[33 * blk + 31 - lane] : 0u; const unsigned sufn = wave_prefix_dpp(hbn) + above_blk;
            const unsigned long long on = __builtin_amdgcn_ballot_w64(lane < 32 && sufn >= 256u);
            const int oln = on ? (int)__builtin_ctzll(on) : 0;
            const int bstar = 32 * blk + 31 - oln; const unsigned need = 256u - (unsigned)__builtin_amdgcn_readlane((int)(sufn - hbn), oln);
            int ks[16];
#pragma unroll
            for (int i = 0; i < 16; ++i) { ks[i] = -1; if (bin[i] == bstar) { const unsigned k = __hip_atomic_fetch_add(lcnt + par, 1u, __ATOMIC_RELAXED, __HIP_MEMORY_SCOPE_WORKGROUP); lval[k] = v[i]; lidx[k] = 2048 * (i >> 2) + 4 * tid + (i & 3); ks[i] = (int)k; } }
            SEL_BAR();
            const int nl = (int)lcnt[par];
            for (int k = tid; k < nl; k += NTHR) { const float x = lval[k]; const int s = lidx[k]; unsigned rank = 0u;
                for (int j = 0; j < nl; ++j) { const float y = lval[j]; const int sj = lidx[j]; rank += (y > x || (y == x && sj < s)) ? 1u : 0u; }
                lsel[k] = rank < need ? 1u : 0u; }
            SEL_BAR();
#pragma unroll
            for (int i = 0; i < 16; ++i) { const unsigned lv = lsel[ks[i] < 0 ? 0 : ks[i]]; sel[i] = bin[i] > bstar || (ks[i] >= 0 && lv != 0u); }
            *(LAS v4u*)(hist + 4 * tid) = (v4u){0u, 0u, 0u, 0u}; if (tid < 48) *(LAS v4u*)(hist + 2048 + 4 * tid) = (v4u){0u, 0u, 0u, 0u};
            if (tid == 0) lcnt[par ^ 1] = 0u;
            par ^= 1;
        } else {
#pragma unroll
            for (int i = 0; i < 16; ++i) sel[i] = v[i] > -3.0e38f;
        }
#pragma unroll
        for (int j = 0; j < 4; ++j) { unsigned long long wd = 0ull;
#pragma unroll
            for (int c = 0; c < 4; ++c) { const unsigned long long b = __builtin_amdgcn_ballot_w64(sel[4 * j + c]); wd |= ((b >> (16 * (lane & 3))) & 0xffffull) << (16 * c); }
            if (lane < 4) mbr[32 * j + 4 * w + lane] = wd; }
    }
    SEL_BAR();
#undef SEL_LOAD
}

template <int RS> __device__ __forceinline__ bf16x8 frag_row(const LAS unsigned char* base, int r0, int k0, int lane) {
    return *(const LAS bf16x8*)(base + (r0 + (lane & 15)) * RS + (k0 + 8 * (lane >> 4)) * 2);
}
template <int RS> __device__ __forceinline__ bf16x8 frag_tr(const LAS unsigned char* base, int k0, int c0, int lane) {
    const int g = lane >> 4, q = (lane & 15) >> 2, p = lane & 3;
    const unsigned a = (unsigned)(size_t)(base + (k0 + 8 * g + q) * RS + (c0 + 4 * p) * 2);
    s16x4 lo, hi;
    asm volatile("ds_read_b64_tr_b16 %0, %2\n\tds_read_b64_tr_b16 %1, %2 offset:%3\n\ts_waitcnt lgkmcnt(0)" : "=&v"(lo), "=&v"(hi) : "v"(a), "i"(4 * RS) : "memory");
    return (bf16x8){lo[0], lo[1], lo[2], lo[3], hi[0], hi[1], hi[2], hi[3]};
}
#define MFMA16(a, b, c) __builtin_amdgcn_mfma_f32_16x16x32_bf16((a), (b), (c), 0, 0, 0)
constexpr int SCR_OFF = 114688;
constexpr float DK_SCALE = 0.08838834764831845f;
__device__ __forceinline__ float log_sigmoid_f(float x) { return fminf(x, 0.f) - log1pf(expf(-fabsf(x))); }

template <int L, int DV> __device__ __forceinline__ void chunk_delta(LAS unsigned char* lds, const bf16* ksrc, int ldk, const bf16* vsrc, int ldv, const LAS float* wcol, bf16* outT, float* dn, int tid) {
    constexpr int RSK = (128 + 8) * 2, RSV = (DV + 8) * 2, NCB = DV / 128;
    LAS unsigned char* KA = lds; LAS unsigned char* V = lds + L * RSK;
    const int lane = tid & 63, w = tid >> 6;
    for (int idx = tid; idx < L * 16; idx += NTHR) { const int s = idx >> 4, c8 = idx & 15;
        const v4u x = *(const GAS v4u*)(ksrc + (size_t)s * ldk + c8 * 8); const float sc = DK_SCALE * wcol[s]; v4u o;
        o.x = pk2(__uint_as_float(x.x << 16) * sc, __uint_as_float(x.x & 0xffff0000u) * sc); o.y = pk2(__uint_as_float(x.y << 16) * sc, __uint_as_float(x.y & 0xffff0000u) * sc);
        o.z = pk2(__uint_as_float(x.z << 16) * sc, __uint_as_float(x.z & 0xffff0000u) * sc); o.w = pk2(__uint_as_float(x.w << 16) * sc, __uint_as_float(x.w & 0xffff0000u) * sc);
        *(LAS v4u*)(KA + s * RSK + c8 * 16) = o; }
    for (int idx = tid; idx < L * (DV / 8); idx += NTHR) { const int s = idx / (DV / 8), c8 = idx % (DV / 8);
        *(LAS v4u*)(V + s * RSV + c8 * 16) = *(const GAS v4u*)(vsrc + (size_t)s * ldv + c8 * 8); }
    __syncthreads();
    f32x4 acc[8][NCB];
#pragma unroll
    for (int db = 0; db < 8; ++db)
#pragma unroll
        for (int i = 0; i < NCB; ++i) acc[db][i] = (f32x4){0.f, 0.f, 0.f, 0.f};
#pragma unroll
    for (int kk = 0; kk < L / 32; ++kk) {
        bf16x8 bfr[NCB];
#pragma unroll
        for (int i = 0; i < NCB; ++i) bfr[i] = frag_tr<RSV>(V, 32 * kk, 16 * (w * NCB + i), lane);
#pragma unroll
        for (int db = 0; db < 8; ++db) { const bf16x8 a = frag_tr<RSK>(KA, 32 * kk, 16 * db, lane);
#pragma unroll
            for (int i = 0; i < NCB; ++i) acc[db][i] = MFMA16(a, bfr[i], acc[db][i]); }
    }
#pragma unroll
    for (int db = 0; db < 8; ++db)
#pragma unroll
        for (int i = 0; i < NCB; ++i) { const int e = 16 * (w * NCB + i) + (lane & 15), d0 = 16 * db + 4 * (lane >> 4);
            v2u o; o.x = pk2(acc[db][i][0], acc[db][i][1]); o.y = pk2(acc[db][i][2], acc[db][i][3]);
            *(GAS v2u*)(outT + (size_t)e * 128 + d0) = o; }
    if (dn != nullptr && tid < 128) { float s_ = 0.f;
        for (int s = 0; s < L; ++s) s_ += bf2f(*(const LAS bf16*)(KA + s * RSK + tid * 2));
        dn[tid] = s_; }
    __syncthreads();
}

template <int L, int DV, int MODE> __device__ __forceinline__ void chunk_out(LAS unsigned char* lds, LAS float* sf, const bf16* qsrc, int ldq, const bf16* ksrc, int ldk, const bf16* vsrc, int ldv,
                                                                              const bf16* stT, const float* gain, const bf16* gate, int ldg, bf16* y, int ldy, int tid) {
    constexpr int RSQ = (128 + 8) * 2, RSV = (DV + 8) * 2, RSP = (L + 8) * 2, NCB = DV / 128, NT = L / 16, TPW = NT * NT / 8;
    LAS unsigned char* Q = lds; LAS unsigned char* K = lds + L * RSQ; LAS unsigned char* V = lds + 2 * L * RSQ;
    LAS unsigned char* P = (MODE == 0) ? (lds + 2 * L * RSQ + L * RSV) : K;
    LAS float* H = (LAS float*)lds;
    LAS float* lrow = sf; LAS float* lcol = sf + 128; LAS float* qs = sf + 256; LAS float* flo = sf + 384; LAS float* rowsum = sf + 512; LAS float* npv = sf + 640; LAS float* part = sf + 768; LAS float* dpart = sf + 768 + L * NT;
    const int lane = tid & 63, w = tid >> 6, g4 = lane >> 4, c16 = lane & 15;
    for (int idx = tid; idx < L * 16; idx += NTHR) { const int s = idx >> 4, c8 = idx & 15;
        *(LAS v4u*)(Q + s * RSQ + c8 * 16) = *(const GAS v4u*)(qsrc + (size_t)s * ldq + c8 * 8);
        *(LAS v4u*)(K + s * RSQ + c8 * 16) = *(const GAS v4u*)(ksrc + (size_t)s * ldk + c8 * 8); }
    for (int idx = tid; idx < L * (DV / 8); idx += NTHR) { const int s = idx / (DV / 8), c8 = idx % (DV / 8);
        *(LAS v4u*)(V + s * RSV + c8 * 16) = *(const GAS v4u*)(vsrc + (size_t)s * ldv + c8 * 8); }
    __syncthreads();
    f32x4 pv[TPW];
#pragma unroll
    for (int i = 0; i < TPW; ++i) { const int ti = w * TPW + i, rb = ti / NT, cb = ti % NT; f32x4 a = (f32x4){0.f, 0.f, 0.f, 0.f};
        if (cb <= rb) {
#pragma unroll
            for (int kk = 0; kk < 4; ++kk) a = MFMA16(frag_row<RSQ>(Q, 16 * rb, 32 * kk, lane), frag_row<RSQ>(K, 16 * cb, 32 * kk, lane), a);
            const int s = 16 * cb + c16; const float lc = lcol[s]; float rs[4];
#pragma unroll
            for (int r = 0; r < 4; ++r) { const int t = 16 * rb + 4 * g4 + r; const float pw = (s <= t) ? __expf(lrow[t] + lc) * a[r] * DK_SCALE : 0.f; a[r] = pw; rs[r] = pw; }
            if (MODE == 0) {
#pragma unroll
                for (int r = 0; r < 4; ++r) { float v = rs[r]; v += dpp_f<0xB1, 0xf, 0xf>(0.f, v); v += dpp_f<0x4E, 0xf, 0xf>(0.f, v); v += dpp_f<0x141, 0xf, 0xf>(0.f, v); v += dpp_f<0x140, 0xf, 0xf>(0.f, v);
                    if (c16 == 0) part[(16 * rb + 4 * g4 + r) * NT + cb] = v; } }
        } else if (MODE == 0) { if (c16 == 0) {
#pragma unroll
                for (int r = 0; r < 4; ++r) part[(16 * rb + 4 * g4 + r) * NT + cb] = 0.f; } }
        pv[i] = a; }
    __syncthreads();
#pragma unroll
    for (int i = 0; i < TPW; ++i) { const int ti = w * TPW + i, rb = ti / NT, cb = ti % NT;
#pragma unroll
        for (int r = 0; r < 4; ++r) *(LAS bf16*)(P + (16 * rb + 4 * g4 + r) * RSP + (16 * cb + c16) * 2) = (bf16)f2bf(pv[i][r]); }
    for (int idx = tid; idx < L * 16; idx += NTHR) { const int s = idx >> 4, c8 = idx & 15; const float sc = qs[s];
        const v4u x = *(const LAS v4u*)(Q + s * RSQ + c8 * 16); float f[8];
        f[0] = __uint_as_float(x.x << 16) * sc; f[1] = __uint_as_float(x.x & 0xffff0000u) * sc; f[2] = __uint_as_float(x.y << 16) * sc; f[3] = __uint_as_float(x.y & 0xffff0000u) * sc;
        f[4] = __uint_as_float(x.z << 16) * sc; f[5] = __uint_as_float(x.z & 0xffff0000u) * sc; f[6] = __uint_as_float(x.w << 16) * sc; f[7] = __uint_as_float(x.w & 0xffff0000u) * sc;
        v4u o; o.x = pk2(f[0], f[1]); o.y = pk2(f[2], f[3]); o.z = pk2(f[4], f[5]); o.w = pk2(f[6], f[7]);
        *(LAS v4u*)(Q + s * RSQ + c8 * 16) = o;
        if (MODE == 0) { float dsum = 0.f;
#pragma unroll
            for (int j = 0; j < 8; ++j) dsum += f[j] * npv[8 * c8 + j];
            dpart[s * 16 + c8] = dsum; } }
    __syncthreads();
    if (MODE == 0 && tid < L) { float a = 0.f;
#pragma unroll
        for (int j = 0; j < NT; ++j) a += part[tid * NT + j];
#pragma unroll
        for (int j = 0; j < 16; ++j) a += dpart[tid * 16 + j];
        rowsum[tid] = a; }
    f32x4 acc[NT][NCB];
#pragma unroll
    for (int rb = 0; rb < NT; ++rb)
#pragma unroll
        for (int i = 0; i < NCB; ++i) acc[rb][i] = (f32x4){0.f, 0.f, 0.f, 0.f};
#pragma unroll
    for (int kk = 0; kk < 4; ++kk) { bf16x8 bfr[NCB];
#pragma unroll
        for (int i = 0; i < NCB; ++i) bfr[i] = *(const GAS bf16x8*)(stT + (size_t)(16 * (w * NCB + i) + c16) * 128 + 32 * kk + 8 * g4);
#pragma unroll
        for (int rb = 0; rb < NT; ++rb) { const bf16x8 a = frag_row<RSQ>(Q, 16 * rb, 32 * kk, lane);
#pragma unroll
            for (int i = 0; i < NCB; ++i) acc[rb][i] = MFMA16(a, bfr[i], acc[rb][i]); } }
#pragma unroll
    for (int kk = 0; kk < L / 32; ++kk) { bf16x8 bfr[NCB];
#pragma unroll
        for (int i = 0; i < NCB; ++i) bfr[i] = frag_tr<RSV>(V, 32 * kk, 16 * (w * NCB + i), lane);
#pragma unroll
        for (int rb = 0; rb < NT; ++rb) { const bf16x8 a = frag_row<RSP>(P, 16 * rb, 32 * kk, lane);
#pragma unroll
            for (int i = 0; i < NCB; ++i) acc[rb][i] = MFMA16(a, bfr[i], acc[rb][i]); } }
    __syncthreads();
#pragma unroll
    for (int rb = 0; rb < NT; ++rb)
#pragma unroll
        for (int i = 0; i < NCB; ++i)
#pragma unroll
            for (int r = 0; r < 4; ++r) { const int t = 16 * rb + 4 * g4 + r, e = 16 * (w * NCB + i) + c16; float hv = acc[rb][i][r];
                if (MODE == 0) hv = hv / fmaxf(fabsf(rowsum[t]), flo[t]);
                H[t * DV + e] = hv; }
    __syncthreads();
    for (int t = w; t < L; t += NWAVES) { float hv[DV / 64]; float s1 = 0.f;
#pragma unroll
        for (int i = 0; i < DV / 64; ++i) { hv[i] = H[t * DV + lane + 64 * i]; s1 += hv[i]; }
        float mu = 0.f; if (MODE == 1) { mu = wave_sum(s1) * (1.f / DV); }
        float s2 = 0.f;
#pragma unroll
        for (int i = 0; i < DV / 64; ++i) { hv[i] -= mu; s2 += hv[i] * hv[i]; }
        const float rstd = 1.0f / sqrtf(wave_sum(s2) * (1.f / DV) + NORM_EPS);
#pragma unroll
        for (int i = 0; i < DV / 64; ++i) { const int e = lane + 64 * i; const float gt = bf2f(gate[(size_t)t * ldg + e]);
            const float act = (MODE == 0) ? sigmoid_f(gt) : gt * sigmoid_f(gt);
            y[(size_t)t * ldy + e] = (bf16)f2bf(hv[i] * rstd * gain[e] * act); } }
    __syncthreads();
}
namespace att {
constexpr int D = 128, LDQKV = NPROJ, LDO = 1024;
constexpr float THR = 8.f; constexpr bool WSKIP = false;
constexpr float SCALE = 0.08838834764831845f;
constexpr int NW = 8, QBLK = 32, KVBLK = 64, QB = NW * QBLK;
constexpr int SHM_V = KVBLK * D * 2, SHM_K = KVBLK * D * 2;
constexpr int LDS_BYTES = 2 * SHM_V + 2 * SHM_K + NW * 64 * 4;

using bf16 = unsigned short;
typedef short bf16x8 __attribute__((ext_vector_type(8)));
typedef short s16x4 __attribute__((ext_vector_type(4)));
typedef float f32x16 __attribute__((ext_vector_type(16)));
typedef float f32x4 __attribute__((ext_vector_type(4)));
typedef unsigned u32x4 __attribute__((ext_vector_type(4)));
template <class A, class Bt> struct same_t { static constexpr bool v = false; };
template <class A> struct same_t<A, A> { static constexpr bool v = true; };

#define KSWZ(row, colB) ((row) * 256 + ((colB) ^ (((row) & 7) << 4)))
#define SBAR() __builtin_amdgcn_sched_barrier(0)
__device__ __forceinline__ int v_st(int k, int c) { const int kk = (k & ~0xC) | ((k & 4) << 1) | ((k & 8) >> 1); return ((kk >> 3) * 4 + (c >> 5)) * 512 + ((kk & 7) * 32 + (c & 31)) * 2; }
__device__ __forceinline__ int v_rd_base(int lane) { return ((lane & 3) << 3) | (((lane >> 2) & 3) << 6) | (((lane >> 4) & 1) << 5) | (((lane >> 5) & 1) << 8); }
constexpr int v_rd_off(int d0, int ks, int half) { return d0 * 512 + ks * 4096 + half * 2048; }
__device__ __forceinline__ int crow(int r, int hi) { return (r & 3) + 8 * (r >> 2) + 4 * hi; }
__device__ __forceinline__ unsigned cvtpk(float lo, float hi) {
    unsigned r; asm volatile("v_cvt_pk_bf16_f32 %0, %1, %2" : "=v"(r) : "v"(lo), "v"(hi)); return r;
}
__device__ __forceinline__ bf16x8 pack8(f32x4 a, f32x4 b) {
    u32x4 w = {cvtpk(a[0], a[1]), cvtpk(a[2], a[3]), cvtpk(b[0], b[1]), cvtpk(b[2], b[3])};
    return *reinterpret_cast<bf16x8*>(&w);
}
template <class T> __device__ __forceinline__ bf16x8 load8(const T* p) {
    if constexpr (same_t<T, float>::v) { return pack8(*(const f32x4*)p, *(const f32x4*)(p + 4)); }
    else { return *reinterpret_cast<const bf16x8*>(p); }
}
__device__ __forceinline__ unsigned long long mask_word(const char* tile_base, int row) { unsigned off = (unsigned)row; asm volatile("" : "+v"(off)); off *= 1024u; return *(const unsigned long long*)(tile_base + off); }
__device__ __forceinline__ void mask_bits(f32x16& p0, f32x16& p1, unsigned long long mw, int hi) {
    const unsigned long long ws = mw >> hi; const unsigned lo = (unsigned)ws, up = (unsigned)(ws >> 32);
#pragma unroll
    for (int r = 0; r < 16; ++r) {
        const int c = 16 * (r & 1) + 2 * (r >> 2); const unsigned x = (r & 2) ? up : lo;
        const unsigned ma = (unsigned)(((int)(x << (31 - c))) >> 31), mb = (unsigned)(((int)(x << (31 - c - 8))) >> 31);
        p0[r] = __uint_as_float((__float_as_uint(p0[r]) & ma) | (0xff800000u & ~ma));
        p1[r] = __uint_as_float((__float_as_uint(p1[r]) & mb) | (0xff800000u & ~mb));
    }
}
__device__ __forceinline__ void partialSM(f32x16& p0, f32x16& p1, float& m_reg, float& mn, float& alpha) {
    float pmax = p0[0]; for (int r = 1; r < 16; ++r) pmax = fmaxf(pmax, p0[r]); for (int r = 0; r < 16; ++r) pmax = fmaxf(pmax, p1[r]);
    { auto rr = __builtin_amdgcn_permlane32_swap(__float_as_uint(pmax), __float_as_uint(pmax), false, false);
      pmax = fmaxf(__uint_as_float(rr[0]), __uint_as_float(rr[1])); }
    constexpr float C2 = 1.4426950408889634f * SCALE;
    if (__builtin_expect(__all((pmax - m_reg) * SCALE <= THR), 1)) { mn = m_reg; alpha = 1.f; }
    else { mn = fmaxf(m_reg, pmax); alpha = __builtin_amdgcn_exp2f((m_reg - mn) * C2); m_reg = mn; }
    const float mnL = -mn * C2;
    for (int r = 0; r < 16; ++r) p0[r] = fmaf(p0[r], C2, mnL); for (int r = 0; r < 16; ++r) p1[r] = fmaf(p1[r], C2, mnL);
    for (int r = 0; r < 16; ++r) p0[r] = __builtin_amdgcn_exp2f(p0[r]);
}
__device__ __forceinline__ void finishSM(f32x16& p0, f32x16& p1, float alpha, float& l_reg, bf16x8& pa0, bf16x8& pa1, bf16x8& pa2, bf16x8& pa3) {
    for (int r = 0; r < 16; ++r) p1[r] = __builtin_amdgcn_exp2f(p1[r]);
    float ps = 0; for (int r = 0; r < 16; ++r) ps += p0[r]; for (int r = 0; r < 16; ++r) ps += p1[r];
    { auto rr = __builtin_amdgcn_permlane32_swap(__float_as_uint(ps), __float_as_uint(ps), false, false);
      ps = __uint_as_float(rr[0]) + __uint_as_float(rr[1]); }
    l_reg = l_reg * alpha + ps;
#define PK4(P, B_, OUT) do { unsigned a0 = cvtpk(P[B_+0], P[B_+1]), a1 = cvtpk(P[B_+2], P[B_+3]);                          \
        unsigned b0 = cvtpk(P[B_+4], P[B_+5]), b1 = cvtpk(P[B_+6], P[B_+7]);                                             \
        auto r0 = __builtin_amdgcn_permlane32_swap(a0, b0, false, false); auto r1 = __builtin_amdgcn_permlane32_swap(a1, b1, false, false); \
        u32x4 w = {r0[0], r1[0], r0[1], r1[1]}; OUT = *reinterpret_cast<bf16x8*>(&w); } while (0)
    PK4(p0, 0, pa0); PK4(p0, 8, pa1); PK4(p1, 0, pa2); PK4(p1, 8, pa3);
#undef PK4
}
template <int KB, bool SK>
__device__ __forceinline__ void qkt(f32x16& p0, f32x16& p1, const char* K_lds, int r32, int hi, const bf16x8* qr, bool act) {
    if (SK && !act) { const float NEG = -__builtin_inff();
#pragma unroll
        for (int r = 0; r < 16; ++r) { p0[r] = NEG; p1[r] = NEG; } return; }
    p0 = f32x16{}; p1 = f32x16{};
    const char* kb[4];
#pragma unroll
    for (int dd = 0; dd < 4; ++dd) kb[dd] = K_lds + KB * SHM_K + KSWZ(r32, (dd * 16 + hi * 8) * 2);
#pragma unroll
    for (int d0 = 0; d0 < 8; ++d0) { const char* a = kb[d0 & 3] + (d0 >> 2) * 128;
        bf16x8 b0 = *reinterpret_cast<const bf16x8*>(a);
        bf16x8 b1 = *reinterpret_cast<const bf16x8*>(a + 32 * 256);
        p0 = __builtin_amdgcn_mfma_f32_32x32x16_bf16(b0, qr[d0], p0, 0, 0, 0);
        p1 = __builtin_amdgcn_mfma_f32_32x32x16_bf16(b1, qr[d0], p1, 0, 0, 0); }
}
template <int VB, bool SK>
__device__ __forceinline__ void pv_tile(f32x16* o, int vb0, bf16x8 pa0, bf16x8 pa1, bf16x8 pa2, bf16x8 pa3, bool act) {
    if (SK && !act) return;
#define TRRD(dst, off) asm volatile("ds_read_b64_tr_b16 %0, %1 offset:%2" : "=&v"(dst) : "v"(vb0), "i"(off) : "memory")
#define PV_D0(d0) do { s16x4 l0, l1, l2, l3, h0, h1, h2, h3; constexpr int b_ = VB * SHM_V + v_rd_off(d0, 0, 0);     \
        TRRD(l0, b_); TRRD(h0, b_ + 2048); TRRD(l1, b_ + 4096); TRRD(h1, b_ + 6144); TRRD(l2, b_ + 8192); TRRD(h2, b_ + 10240); TRRD(l3, b_ + 12288); TRRD(h3, b_ + 14336); \
        asm volatile("s_waitcnt lgkmcnt(0)" ::: "memory"); SBAR();                 \
        o[d0] = __builtin_amdgcn_mfma_f32_32x32x16_bf16(pa0, (bf16x8){l0[0], l0[1], l0[2], l0[3], h0[0], h0[1], h0[2], h0[3]}, o[d0], 0, 0, 0);   \
        o[d0] = __builtin_amdgcn_mfma_f32_32x32x16_bf16(pa1, (bf16x8){l1[0], l1[1], l1[2], l1[3], h1[0], h1[1], h1[2], h1[3]}, o[d0], 0, 0, 0);   \
        o[d0] = __builtin_amdgcn_mfma_f32_32x32x16_bf16(pa2, (bf16x8){l2[0], l2[1], l2[2], l2[3], h2[0], h2[1], h2[2], h2[3]}, o[d0], 0, 0, 0);   \
        o[d0] = __builtin_amdgcn_mfma_f32_32x32x16_bf16(pa3, (bf16x8){l3[0], l3[1], l3[2], l3[3], h3[0], h3[1], h3[2], h3[3]}, o[d0], 0, 0, 0); } while (0)
    PV_D0(0); PV_D0(1); PV_D0(2); PV_D0(3);
#undef PV_D0
#undef TRRD
}

template <class TIn, class TOut> struct BlockRef { const TIn* Q; const TIn* K; const TIn* V; TOut* O; const unsigned long long* M; int P0; };
template <class TIn> struct Seam {
    bf16x8 qr[8];
    bf16x8 st_v0, st_v1, st_k0, st_k1; f32x4 sf0, sf1, sf2, sf3;
    f32x4 tq[16];
};
__device__ __forceinline__ int swa_jlo(int P0, int W) { const int lowk = P0 - W + 1; return lowk > 0 ? lowk / KVBLK : 0; }
#define ROW(p, k0, rr) ((p) + (size_t)((k0) + (rr)) * LDQKV + sc)
#define VMW() asm volatile("s_waitcnt vmcnt(0)" ::: "memory")
#define VMWN(n) asm volatile("s_waitcnt vmcnt(%0)" :: "i"(n) : "memory")
#define LD16U(base, off) (*reinterpret_cast<const bf16x8*>((const char*)(base) + (off)))
#define SLOAD_H(Kp, Vp, k0) do { const char* kb_ = (const char*)((Kp) + (size_t)(k0) * LDQKV); const char* vb_ = (const char*)((Vp) + (size_t)(k0) * LDQKV);                 \
                         S.st_v0 = LD16U(vb_, soff); S.st_v1 = LD16U(vb_ + (size_t)32 * LDQKV * 2, soff);                                  \
                         S.st_k0 = LD16U(kb_, soff); S.st_k1 = LD16U(kb_ + (size_t)32 * LDQKV * 2, soff); } while (0)
#define SWRITE_HK(bf) do { *(bf16x8*)(K_lds + (bf) * SHM_K + kws) = S.st_k0; *(bf16x8*)(K_lds + (bf) * SHM_K + kws + 32 * 256) = S.st_k1; } while (0)
#define SWRITE_HV(bf) do { *(bf16x8*)(V_lds + (bf) * SHM_V + vst0) = S.st_v0; *(bf16x8*)(V_lds + (bf) * SHM_V + vst1) = S.st_v1; } while (0)
#define SWRITE_H(bf) do { SWRITE_HV(bf); SWRITE_HK(bf); } while (0)
#define SLOAD_F(p, k0) do { S.sf0 = *(const f32x4*)ROW(p, k0, sr); S.sf1 = *(const f32x4*)(ROW(p, k0, sr) + 4);                \
                            S.sf2 = *(const f32x4*)ROW(p, k0, 32 + sr); S.sf3 = *(const f32x4*)(ROW(p, k0, 32 + sr) + 4); } while (0)
#define SWRITE_KF(bf) do { *(bf16x8*)(K_lds + (bf) * SHM_K + kws) = pack8(S.sf0, S.sf1); *(bf16x8*)(K_lds + (bf) * SHM_K + kws + 32 * 256) = pack8(S.sf2, S.sf3); } while (0)
#define SWRITE_VF(bf) do { *(bf16x8*)(V_lds + (bf) * SHM_V + vst0) = pack8(S.sf0, S.sf1); *(bf16x8*)(V_lds + (bf) * SHM_V + vst1) = pack8(S.sf2, S.sf3); } while (0)
template <class TIn, class TOut>
__device__ __forceinline__ void causal_swa_prime(const BlockRef<TIn, TOut>& cur, int W, char* lds, Seam<TIn>& S) {
    constexpr bool F32 = same_t<TIn, float>::v;
    int tid_o = my_tid(); asm volatile("" : "+v"(tid_o));
    const int tid = tid_o, wid = __builtin_amdgcn_readfirstlane(tid >> 6), lane = tid & 63, r32 = lane & 31, hi = lane >> 5;
    const int sr = tid >> 4, sc = (tid & 15) * 8, kws = KSWZ(sr, sc * 2); char* K_lds = lds + 2 * SHM_V; const unsigned soff = (unsigned)(sr * LDQKV + sc) * 2u;
    const int kb0 = swa_jlo(cur.P0, W) * KVBLK;
    for (int d0 = 0; d0 < 8; ++d0) S.qr[d0] = load8<TIn>(cur.Q + (size_t)(wid * QBLK + r32) * LDQKV + d0 * 16 + hi * 8);
    if constexpr (F32) { SLOAD_F((const float*)cur.K, kb0); VMW(); SWRITE_KF(0); SBAR(); SLOAD_F((const float*)cur.V, kb0); }
    else { SLOAD_H(cur.K, cur.V, kb0); VMW(); SWRITE_HK(0); }
    __syncthreads();
}
template <class TIn, class TOut>
__device__ __forceinline__ void causal_swa_block(const BlockRef<TIn, TOut>& cur, const BlockRef<TIn, TOut>& nxt, int skv, int W, char* lds, Seam<TIn>& S) {
    constexpr bool F32 = same_t<TIn, float>::v;
    int tid_o = my_tid(); asm volatile("" : "+v"(tid_o));
    const int tid = tid_o, wid = __builtin_amdgcn_readfirstlane(tid >> 6), lane = tid & 63, r32 = lane & 31, hi = lane >> 5;
    const int j_lo = swa_jlo(cur.P0, W);
    int j_hi = (cur.P0 + QB - 1) / KVBLK + 1; if (j_hi > skv / KVBLK) j_hi = skv / KVBLK;
    const int NT = j_hi - j_lo;
    const int kbn = swa_jlo(nxt.P0, W) * KVBLK;
    const int qlo = cur.P0 + wid * QBLK, qm = qlo + r32 - 4 * hi;
    char* V_lds = lds; char* K_lds = lds + 2 * SHM_V;
    float* ws = (float*)(lds + 2 * SHM_V + 2 * SHM_K) + wid * 64; float* li_l = ws, * al_l = ws + 32;
    float m_reg = -1e30f, l_reg = 0; f32x16 o[4] = {};
    const unsigned soff = (unsigned)((tid >> 4) * LDQKV + (tid & 15) * 8) * 2u;
    const int sr = tid >> 4, sc = (tid & 15) * 8, vst0 = v_st(sr, sc), vst1 = v_st(32 + sr, sc), kws = KSWZ(sr, sc * 2);
    const int vb0 = (int)(uintptr_t)V_lds + v_rd_base(lane);
    const TIn* Kh = cur.K; const TIn* Vh = cur.V;
#define RESC(a) do { if (__any((a) < 1.f)) { if (hi == 0) al_l[r32] = (a); asm volatile("s_waitcnt lgkmcnt(0)" ::: "memory");              \
                     for (int d_ = 0; d_ < 4; ++d_) for (int r = 0; r < 16; ++r) o[d_][r] *= al_l[crow(r, hi)]; } } while (0)
#define KBASE(t) ((j_lo + (t)) * KVBLK)
#define ACT(t) (KBASE(t) <= qlo + QBLK - 1 && KBASE(t) + KVBLK - 1 >= qlo - W + 1)
#define MASKT(P0_, P1_, mw_) mask_bits(P0_, P1_, mw_, hi)
#define MLOAD(t) mask_word((const char*)cur.M + (size_t)((j_lo + (t)) * 8), wid * QBLK + r32)
    constexpr int NQL = F32 ? 16 : 8;
    constexpr bool SK = WSKIP && !F32;
#define SEAM_K0() do { VMWN(NQL); if constexpr (F32) { SWRITE_KF(0); SBAR(); SLOAD_F((const float*)nxt.V, kbn); } else { SWRITE_HK(0); } SBAR(); } while (0)
    f32x16 pA0, pA1, pB0, pB1; float mnA, mnB, alA, alB; bf16x8 pa0, pa1, pa2, pa3;
    if constexpr (F32) { VMW(); SWRITE_VF(0); SBAR(); } else { SWRITE_HV(0); SBAR(); }
    if (NT > 1) { if constexpr (F32) SLOAD_F((const float*)Kh, KBASE(1)); else SLOAD_H(Kh, Vh, KBASE(1)); }
    SBAR(); qkt<0, SK>(pA0, pA1, K_lds, r32, hi, S.qr, ACT(0));
    if constexpr (F32) { if (NT > 1) { VMW(); SWRITE_KF(1); SBAR(); SLOAD_F((const float*)Vh, KBASE(1)); } }
    MASKT(pA0, pA1, MLOAD(0)); partialSM(pA0, pA1, m_reg, mnA, alA);
    if (NT > 1) { VMW(); if constexpr (F32) { SWRITE_VF(1); SBAR(); if (NT > 2) SLOAD_F((const float*)Kh, KBASE(2)); } else SWRITE_H(1); }
    __syncthreads();
#define HALF_STEP(PX0, PX1, mnX, alX, PY0, PY1, alY, t, KB, VB, SB) do {                                                      \
        SBAR(); qkt<KB, SK>(PX0, PX1, K_lds, r32, hi, S.qr, ACT(t));                                             \
        finishSM(PY0, PY1, alY, l_reg, pa0, pa1, pa2, pa3); SBAR();                                                           \
        if ((t) + 1 < NT) { if constexpr (F32) { VMW(); SWRITE_KF(SB); SBAR(); SLOAD_F((const float*)Vh, KBASE((t) + 1)); }  \
                            else { SLOAD_H(Kh, Vh, KBASE((t) + 1)); } SBAR(); }                                               \
        pv_tile<VB, SK>(o, vb0, pa0, pa1, pa2, pa3, ACT((t) - 1)); MASKT(PX0, PX1, MLOAD(t)); partialSM(PX0, PX1, m_reg, mnX, alX);                                        \
        __syncthreads();                                                                                                      \
        if ((t) + 1 < NT) { VMW(); if constexpr (F32) { SWRITE_VF(SB); SBAR(); if ((t) + 2 < NT) SLOAD_F((const float*)Kh, KBASE((t) + 2)); } \
                            else { SWRITE_H(SB); } }                                                                          \
        RESC(alX); __syncthreads(); } while (0)
    for (int t = 1; t + 1 < NT; t += 2) {
        HALF_STEP(pB0, pB1, mnB, alB, pA0, pA1, alA, t, 1, 0, 0);
        HALF_STEP(pA0, pA1, mnA, alA, pB0, pB1, alB, t + 1, 0, 1, 1);
    }
    const bool even = (NT & 1) == 0;
    if (even) { SBAR(); qkt<1, SK>(pB0, pB1, K_lds, r32, hi, S.qr, ACT(NT - 1)); SBAR(); }
#define QROW(e) (nxt.Q + (size_t)(wid * QBLK + r32) * LDQKV + ((e) >> 1) * 16 + hi * 8 + ((e) & 1) * 4)
    if constexpr (F32) { SLOAD_F((const float*)nxt.K, kbn); SBAR();
#pragma unroll
        for (int e = 0; e < 8; ++e) S.tq[e] = *(const f32x4*)QROW(e); }
    else { SLOAD_H(nxt.K, nxt.V, kbn); SBAR();
#pragma unroll
        for (int d0 = 0; d0 < 8; ++d0) S.qr[d0] = load8<TIn>(nxt.Q + (size_t)(wid * QBLK + r32) * LDQKV + d0 * 16 + hi * 8); }
    SBAR();
    finishSM(pA0, pA1, alA, l_reg, pa0, pa1, pa2, pa3); SBAR();
    if constexpr (F32) {
#pragma unroll
        for (int e = 8; e < 16; ++e) S.tq[e] = *(const f32x4*)QROW(e); SBAR(); }
#undef QROW
    pv_tile<0, SK>(o, vb0, pa0, pa1, pa2, pa3, ACT(even ? NT - 2 : NT - 1));
    if (even) { MASKT(pB0, pB1, MLOAD(NT - 1)); partialSM(pB0, pB1, m_reg, mnB, alB); __syncthreads(); RESC(alB);
        finishSM(pB0, pB1, alB, l_reg, pa0, pa1, pa2, pa3); SBAR(); pv_tile<1, SK>(o, vb0, pa0, pa1, pa2, pa3, ACT(NT - 1)); }
    SBAR(); SEAM_K0();
    if (hi == 0) li_l[r32] = l_reg; asm volatile("s_waitcnt lgkmcnt(0)" ::: "memory");
    float rli[16];
#pragma unroll
    for (int r = 0; r < 16; ++r) rli[r] = __builtin_amdgcn_rcpf(li_l[crow(r, hi)]);
    TOut* Ow = cur.O + (size_t)(wid * QBLK) * LDO;
#pragma unroll
    for (int r = 0; r < 16; ++r) { const int orow = crow(r, hi);
#pragma unroll
        for (int d0 = 0; d0 < 4; ++d0) { const float v = o[d0][r] * rli[r];
            if constexpr (same_t<TOut, float>::v) { Ow[(size_t)orow * LDO + d0 * 32 + r32] = v; }
            else { const float vn = __builtin_bit_cast(float, __builtin_amdgcn_update_dpp(0, __builtin_bit_cast(int, v), 0xB1, 0xf, 0xf, false));
                   if ((r32 & 1) == 0) *(unsigned*)(Ow + (size_t)orow * LDO + d0 * 32 + r32) = cvtpk(v, vn); } } }
    if constexpr (F32) {
#pragma unroll
        for (int d0 = 0; d0 < 8; ++d0) S.qr[d0] = pack8(S.tq[2 * d0], S.tq[2 * d0 + 1]); }
    __syncthreads();
#undef RESC
#undef KBASE
#undef ACT
#undef MASKT
#undef MLOAD
#undef SEAM_K0
#undef HALF_STEP
}
#undef ROW
#undef VMW
#undef VMWN
#undef SLOAD_H
#undef LD16U
#undef SWRITE_HK
#undef SWRITE_HV
#undef SWRITE_H
#undef SLOAD_F
#undef SWRITE_KF
#undef SWRITE_VF

}


template <int NC> __device__ __forceinline__ void scan_elems(const bf16* __restrict__ delta, bf16* __restrict__ prev, size_t cstride, const LAS float* dec, const LAS float* inj) {
    f32x4 st = (f32x4){0.f, 0.f, 0.f, 0.f};
#pragma unroll 8
    for (int c = 0; c < NC; ++c) { const v2u x = *(const GAS v2u*)(delta + (size_t)c * cstride);
        v2u o; o.x = pk2(st[0], st[1]); o.y = pk2(st[2], st[3]); *(GAS v2u*)(prev + (size_t)c * cstride) = o;
        const float d = dec[c], j = inj[c];
        st[0] = d * st[0] + j * __uint_as_float(x.x << 16); st[1] = d * st[1] + j * __uint_as_float(x.x & 0xffff0000u);
        st[2] = d * st[2] + j * __uint_as_float(x.y << 16); st[3] = d * st[3] + j * __uint_as_float(x.y & 0xffff0000u); }
}

struct Args {
    const float* x; const float* norm_mix; const float* norm_ffn; const float* w_in; const float* att_q_norm; const float* att_k_norm; const float* mlstm_conv; const float* mlstm_gate_bias;
    const float* mlstm_out_norm; const float* ret_out_norm; const float* w_b_att; const float* w_b_mlstm; const float* w_b_ret; const float* w_out; const float* w_ffn_in; const float* w_ffn_out;
    float* out; unsigned char* ws; int layer_lo, layer_hi, ph_lo, ph_hi;
};
constexpr int PH_PER_LAYER = 16;
__device__ __forceinline__ float ret_lngamma(int hd) { return log1pf(-exp2f(-5.0f - (float)hd)); }
#define PHASE_FN static __device__ __forceinline__ void
#define OPAQUE_PTR(p) asm volatile("" : "+s"(p))
#define WS_PTRS(ws) OPAQUE_PTR(ws); \
    bf16* const H = (bf16*)((ws) + WS_H); bf16* const PROJ = (bf16*)((ws) + WS_PROJ); float* const SMALL = (float*)((ws) + WS_SMALL); bf16* const MQK = (bf16*)((ws) + WS_MQK); \
    bf16* const IKB = (bf16*)((ws) + WS_IKB); unsigned char* const IWF = (unsigned char*)((ws) + WS_IWF); float* const GIF = (float*)((ws) + WS_GIF); float* const SC = (float*)((ws) + WS_SC); \
    unsigned long long* const MB = (unsigned long long*)((ws) + WS_MB); bf16* const DCM = (bf16*)((ws) + WS_DCM); bf16* const CPM = (bf16*)((ws) + WS_CPM); \
    float* const DN = (float*)((ws) + WS_MISC + MISC_DN); float* const NPREV = (float*)((ws) + WS_MISC + MISC_NPREV); float* const AB = (float*)((ws) + WS_MISC + MISC_AB); float* const MPREV = (float*)((ws) + WS_MISC + MISC_MPREV); \
    bf16* const DRR = (bf16*)((ws) + WS_DRR); bf16* const RPR = (bf16*)((ws) + WS_RPR); bf16* const YA = (bf16*)((ws) + WS_YA); bf16* const YM = (bf16*)((ws) + WS_YM); bf16* const YR = (bf16*)((ws) + WS_YR); \
    float* const MERGEDF = (float*)((ws) + WS_MERGEDF); bf16* const MERGED = (bf16*)((ws) + WS_MERGED); bf16* const ACT = (bf16*)((ws) + WS_ACT); \
    float* const ROPE128 = (float*)((ws) + WS_ROPE128); float* const ROPE64 = (float*)((ws) + WS_ROPE64); \
    (void)H; (void)PROJ; (void)SMALL; (void)MQK; (void)IKB; (void)IWF; (void)GIF; (void)SC; (void)MB; (void)DCM; (void)CPM; (void)DN; (void)NPREV; (void)AB; (void)MPREV; (void)DRR; (void)RPR; (void)YA; (void)YM; (void)YR; \
    (void)MERGEDF; (void)MERGED; (void)ACT; (void)ROPE128; (void)ROPE64
#define TIDS() int tid_ = my_tid(); asm volatile("" : "+v"(tid_)); int bx_ = blockIdx.x; asm volatile("" : "+s"(bx_));   \
    const int tid = tid_, lane = tid & 63, wave = __builtin_amdgcn_readfirstlane(tid >> 6); const int G = gridDim.x, bx = bx_; const int gw = bx * NWAVES + wave, NGW = G * NWAVES; \
    (void)lane; (void)wave; (void)gw; (void)NGW; (void)G; (void)bx

constexpr int CV_IN = 32 * 268, CV_B = 16 * 32, CV_OUT = 32 * 32, CV_FIN = 32 * 176, CV_FOUT = 88 * 32, CV_ITEMS = CV_IN + 3 * CV_B + CV_OUT + CV_FIN + CV_FOUT;
__device__ __forceinline__ void convert_layer_items(LAS float* scr, unsigned char* ws, int l, const float* w_in, const float* w_b_att, const float* w_b_mlstm, const float* w_b_ret, const float* w_out, const float* w_ffn_in,
                                                    const float* w_ffn_out, int it0, int it1, int wv, int nwv, int lane) {
    unsigned char* wl = ws + WS_W + (size_t)l * W_LAYER;
    for (int it = it0 + wv; it < it1; it += nwv) { int r = it;
        if (r < CV_IN) { transpose_item(w_in + (size_t)l * DM * LPROJ, DM, LPROJ, (bf16*)(wl + WO_IN), scr, r, NPROJ_PAD / 64, lane, MapWin()); continue; } r -= CV_IN;
        if (r < CV_B) { transpose_item(w_b_att + (size_t)l * 1024 * DM, 1024, DM, (bf16*)(wl + WO_B), scr, r, DM / 64, lane, MapIdent()); continue; } r -= CV_B;
        if (r < CV_B) { transpose_item(w_b_mlstm + (size_t)l * 1024 * DM, 1024, DM, (bf16*)(wl + WO_B + 4 * MiB), scr, r, DM / 64, lane, MapIdent()); continue; } r -= CV_B;
        if (r < CV_B) { transpose_item(w_b_ret + (size_t)l * 1024 * DM, 1024, DM, (bf16*)(wl + WO_B + 8 * MiB), scr, r, DM / 64, lane, MapIdent()); continue; } r -= CV_B;
        if (r < CV_OUT) { transpose_item(w_out + (size_t)l * DM * DM, DM, DM, (bf16*)(wl + WO_OUT), scr, r, DM / 64, lane, MapIdent()); continue; } r -= CV_OUT;
        if (r < CV_FIN) { transpose_item(w_ffn_in + (size_t)l * DM * 2 * FF, DM, 2 * FF, (bf16*)(wl + WO_FIN), scr, r, 2 * FF / 64, lane, MapFfn()); continue; } r -= CV_FIN;
        transpose_item(w_ffn_out + (size_t)l * FF * DM, FF, DM, (bf16*)(wl + WO_FOUT), scr, r, DM / 64, lane, MapIdent()); }
}
PHASE_FN ph_prologue(LAS unsigned char* lds, unsigned char* ws, const float* w_in, const float* w_b_att, const float* w_b_mlstm, const float* w_b_ret, const float* w_out, const float* w_ffn_in, const float* w_ffn_out, bool all_layers) {
    TIDS(); WS_PTRS(ws);
    LAS float* scr = (LAS float*)(lds + wave * 16640);
    for (int l = 0; l < (all_layers ? DEPTH : 1); ++l) convert_layer_items(scr, ws, l, w_in, w_b_att, w_b_mlstm, w_b_ret, w_out, w_ffn_in, w_ffn_out, 0, CV_ITEMS, gw, NGW, lane);
    for (int i = gw * 64 + lane; i < S * 96; i += NGW * 64) {
        if (i < S * 64) { const int t = i >> 6, f = i & 63; const float inv = (float)pow(10000.0, -(double)f * 2.0 / 128.0); const float ang = (float)t * inv;
            ROPE128[2 * i] = (float)cos((double)ang); ROPE128[2 * i + 1] = (float)sin((double)ang); }
        else { const int k = i - S * 64, t = k >> 5, f = k & 31; const float inv = (float)pow(10000.0, -(double)f * 2.0 / 64.0); const float ang = (float)t * inv;
            ROPE64[2 * k] = (float)cos((double)ang); ROPE64[2 * k + 1] = (float)sin((double)ang); } }
}
PHASE_FN ph_convert_tail(LAS unsigned char* lds, unsigned char* ws, int l, const float* w_in, const float* w_b_att, const float* w_b_mlstm, const float* w_b_ret, const float* w_out, const float* w_ffn_in, const float* w_ffn_out,
                         int rem, int it0, int it1) {
    TIDS(); if (rem <= 0 || rem >= G || bx < rem) return;
    LAS float* scr = (LAS float*)(lds + wave * 16640);
    convert_layer_items(scr, ws, l, w_in, w_b_att, w_b_mlstm, w_b_ret, w_out, w_ffn_in, w_ffn_out, it0, it1, (bx - rem) * NWAVES + wave, (G - rem) * NWAVES, lane);
    __syncthreads(); }
PHASE_FN ph_rmsnorm(const float* xin, const float* gain, bf16* Hout) { TIDS(); for (int m = gw; m < S; m += NGW) rms_row_to_bf16(xin + (size_t)m * DM, gain, Hout + (size_t)m * DM, lane); }
PHASE_FN ph_gemm_proj(LAS unsigned char* lds, unsigned char* ws, const bf16* Wt) { TIDS(); WS_PTRS(ws);
    pg8::Gemm g{H, Wt, S, NPROJ_PAD, DM}; pg8::StaticOrder so; so.init(S, NPROJ_PAD, G, bx); pg8::EpiProj E{PROJ, NPROJ, SMALL, PC_G / 256, NPROJ / 256};
    pg8::gemm_phase<pg8::EpiProj, pg8::StaticOrder, true, true>(lds, g, so, E); }
PHASE_FN ph_pp(unsigned char* ws, const float* gq, const float* gk, const float* convw, const float* gbias) { TIDS(); WS_PTRS(ws);
    PPArgs a{PROJ, SMALL, MQK, IKB, IWF, GIF, ROPE128, ROPE64, gq, gk, convw, gbias};
    f32x4 cw[16];
#pragma unroll
    for (int j = 0; j < 4; ++j)
#pragma unroll
        for (int q = 0; q < 4; ++q) cw[j * 4 + q] = *(const f32x4*)(convw + j * 1024 + 16 * lane + 4 * q);
    for (int m = gw; m < S; m += NGW) pp_row(a, m, lane, cw); }
PHASE_FN ph_scores(unsigned char* ws) { TIDS(); WS_PTRS(ws);
    for (int u = gw; u < 16512; u += NGW) { int g = (int)((sqrtf(1.0f + 4.0f * (float)u) - 1.0f) * 0.5f); while ((g + 1) * (g + 2) <= u) ++g; while (g * (g + 1) > u) --g;
        const int r = u - g * (g + 1); score_wave_unit(PROJ, IKB, IWF, SC, 2 * g + r / (g + 1), r % (g + 1), lane); } }
PHASE_FN ph_deltas(LAS unsigned char* lds, unsigned char* ws) { TIDS(); WS_PTRS(ws); LAS float* const sf = (LAS float*)(lds + SCR_OFF);
    for (int u = bx; u < 1024; u += G) {
        if (u < 512) { const int hd = u >> 7, c = u & 127, t0 = c * 64;
            if (wave == 0) { const float iv = GIF[(size_t)(t0 + lane) * 8 + hd], fv = GIF[(size_t)(t0 + lane) * 8 + 4 + hd]; float b = log_sigmoid_f(fv);
                b = wave_prefix_sum_f(b);
                const float bend = __builtin_bit_cast(float, __builtin_amdgcn_readlane(__builtin_bit_cast(int, b), 63)), gl = bend - b + iv, A = wave_max(gl);
                sf[lane] = __expf(gl - A); if (lane == 0) { AB[(hd * 128 + c) * 2] = A; AB[(hd * 128 + c) * 2 + 1] = bend; } }
            __syncthreads();
            chunk_delta<64, 256>(lds, MQK + (size_t)t0 * 1024 + 512 + hd * 128, 1024, PROJ + (size_t)t0 * NPROJ + PC_MV + hd * 256, NPROJ, sf, DCM + (size_t)(hd * 128 + c) * 32768, DN + (hd * 128 + c) * 128, tid);
        } else { const int v = u - 512, hd = v >> 6, c = v & 63, t0 = c * 128; const float lg = ret_lngamma(hd);
            if (tid < 128) sf[tid] = __expf(lg * (float)(127 - tid));
            __syncthreads();
            chunk_delta<128, 128>(lds, PROJ + (size_t)t0 * NPROJ + PC_RK + hd * 128, NPROJ, PROJ + (size_t)t0 * NPROJ + PC_RV + hd * 128, NPROJ, sf, DRR + (size_t)(hd * 64 + c) * 16384, nullptr, tid); }
    } }
PHASE_FN ph_select(LAS unsigned char* lds, unsigned char* ws) { TIDS(); WS_PTRS(ws); select_rows_wg(lds, SC, MB, bx, G, tid); }
PHASE_FN ph_scans(LAS unsigned char* lds, unsigned char* ws) { TIDS(); WS_PTRS(ws); LAS float* const sf = (LAS float*)(lds + SCR_OFF);
    for (int u = bx; u < 128; u += G) {
        LAS float* dec = sf; LAS float* inj = sf + 128; LAS float* av = sf + 256; LAS float* bv = sf + 384;
        if (u < 64) { const int hd = u >> 4, p = u & 15;
            if (tid < 128) { av[tid] = AB[(hd * 128 + tid) * 2]; bv[tid] = AB[(hd * 128 + tid) * 2 + 1]; }
            __syncthreads();
            if (tid == 0) { float m = 0.f; for (int c = 0; c < 128; ++c) { const float mn = fmaxf(bv[c] + m, av[c]); dec[c] = __expf(bv[c] + m - mn); inj[c] = __expf(av[c] - mn); if (p == 0) MPREV[hd * 128 + c] = m; m = mn; } }
            __syncthreads();
            const size_t e4 = (size_t)hd * 128 * 32768 + p * 2048 + tid * 4;
            scan_elems<128>(DCM + e4, CPM + e4, 32768, dec, inj);
            if (p == 0 && tid < 128) { float st = 0.f; for (int c = 0; c < 128; ++c) { NPREV[(hd * 128 + c) * 128 + tid] = st; st = dec[c] * st + inj[c] * DN[(hd * 128 + c) * 128 + tid]; } }
        } else { const int v = u - 64, hd = v >> 3, p = v & 7; const float dg = __expf(128.0f * ret_lngamma(hd));
            if (tid < 64) { dec[tid] = dg; inj[tid] = 1.0f; }
            __syncthreads();
            const size_t e4 = (size_t)hd * 64 * 16384 + p * 2048 + tid * 4;
            scan_elems<64>(DRR + e4, RPR + e4, 16384, dec, inj); }
        __syncthreads(); } }
PHASE_FN ph_attention(char* alds, unsigned char* ws) { TIDS(); WS_PTRS(ws);
    typedef att::BlockRef<bf16, bf16> BR; att::Seam<bf16> seam;
#define ATT_REF(r, item_, pass_) do { const int hd_ = (item_) >> 4, y_ = (item_) & 15, qb_ = (pass_) ? 31 - y_ : y_; \
        (r).Q = PROJ + (size_t)qb_ * 256 * NPROJ + PC_AQ + hd_ * 128; (r).K = PROJ + PC_AK + hd_ * 128; (r).V = PROJ + PC_AV + hd_ * 128; (r).O = YA + (size_t)qb_ * 256 * 1024 + hd_ * 128; \
        (r).M = MB + (size_t)qb_ * 256 * 128; (r).P0 = qb_ * 256; } while (0)
    if (bx < 128) { int item = bx, pass = 0; BR cur; ATT_REF(cur, item, 0); att::causal_swa_prime<bf16, bf16>(cur, 1 << 30, alds, seam);
        for (;;) { const bool more_pass = pass == 0, more_item = item + G < 128, last = !more_pass && !more_item;
            int itn = item, pn = pass + 1; if (!more_pass) { pn = 0; itn = more_item ? item + G : item; }
            BR nxt = cur; if (!last) ATT_REF(nxt, itn, pn);
            att::causal_swa_block<bf16, bf16>(cur, nxt, S, 1 << 30, alds, seam);
            if (last) break; cur = nxt; item = itn; pass = pn; } }
    __syncthreads(); }
PHASE_FN ph_outs(LAS unsigned char* lds, unsigned char* ws, const float* gain_m, const float* gain_r, int u0, int ustep) { TIDS(); WS_PTRS(ws); LAS float* const sf = (LAS float*)(lds + SCR_OFF);
    for (int u = u0; u < 1024; u += ustep) {
        if (u < 512) { const int hd = u >> 7, c = u & 127, t0 = c * 64;
            if (wave == 0) { const float iv = GIF[(size_t)(t0 + lane) * 8 + hd], fv = GIF[(size_t)(t0 + lane) * 8 + 4 + hd]; float b = log_sigmoid_f(fv);
                b = wave_prefix_sum_f(b);
                const float mp = MPREV[hd * 128 + c]; const float pm = wave_prefix_max_f(iv - b);
                const float mt = fmaxf(b + mp, b + pm);
                sf[lane] = b - mt; sf[128 + lane] = iv - b; sf[256 + lane] = __expf(b + mp - mt); sf[384 + lane] = __expf(-mt); sf[512 + lane] = 0.f; }
            if (wave == 1) { sf[640 + lane] = NPREV[(hd * 128 + c) * 128 + lane]; sf[640 + 64 + lane] = NPREV[(hd * 128 + c) * 128 + 64 + lane]; }
            __syncthreads();
            chunk_out<64, 256, 0>(lds, sf, MQK + (size_t)t0 * 1024 + hd * 128, 1024, MQK + (size_t)t0 * 1024 + 512 + hd * 128, 1024, PROJ + (size_t)t0 * NPROJ + PC_MV + hd * 256, NPROJ,
                                  CPM + (size_t)(hd * 128 + c) * 32768, gain_m + hd * 256, PROJ + (size_t)t0 * NPROJ + PC_MO + hd * 256, NPROJ, YM + (size_t)t0 * 1024 + hd * 256, 1024, tid);
        } else { const int v = u - 512, hd = v >> 6, c = v & 63, t0 = c * 128; const float lg = ret_lngamma(hd);
            if (tid < 128) { sf[tid] = lg * (float)tid; sf[128 + tid] = -lg * (float)tid; sf[256 + tid] = __expf(lg * (float)(tid + 1)); }
            __syncthreads();
            chunk_out<128, 128, 1>(lds, sf, PROJ + (size_t)t0 * NPROJ + PC_RQ + hd * 128, NPROJ, PROJ + (size_t)t0 * NPROJ + PC_RK + hd * 128, NPROJ, PROJ + (size_t)t0 * NPROJ + PC_RV + hd * 128, NPROJ,
                                   RPR + (size_t)(hd * 64 + c) * 16384, gain_r + hd * 128, PROJ + (size_t)t0 * NPROJ + PC_RG + hd * 128, NPROJ, YR + (size_t)t0 * 1024 + hd * 128, 1024, tid); }
    } }
template <int MODE> PHASE_FN ph_gemm_branch(LAS unsigned char* lds, unsigned char* ws, const bf16* A, const bf16* Wt, int gcol) { TIDS(); WS_PTRS(ws);
    pg8::Gemm g{A, Wt, S, DM, 1024}; pg8::StaticOrder so; so.init(S, DM, G, bx); pg8::EpiBranch<MODE> E{PROJ + PC_G + gcol, NPROJ, MERGEDF, MERGED, DM};
    pg8::gemm_phase<pg8::EpiBranch<MODE>, pg8::StaticOrder, true, true>(lds, g, so, E); }
PHASE_FN ph_gemm_resid(LAS unsigned char* lds, const bf16* A, const bf16* Wt, int K, const float* base, float* out) { TIDS();
    pg8::Gemm g{A, Wt, S, DM, K}; pg8::StaticOrder so; so.init(S, DM, G, bx); pg8::EpiResid E{base, out, DM};
    pg8::gemm_phase<pg8::EpiResid, pg8::StaticOrder, true, true>(lds, g, so, E); }
PHASE_FN ph_gemm_ffn_in(LAS unsigned char* lds, unsigned char* ws, const bf16* Wt) { TIDS(); WS_PTRS(ws);
    pg8::Gemm g{H, Wt, S, 2 * FF, DM}; pg8::StaticOrder so; so.init(S, 2 * FF, G, bx); pg8::EpiSwiGLU E{ACT, FF};
    pg8::gemm_phase<pg8::EpiSwiGLU, pg8::StaticOrder, true, true>(lds, g, so, E); }


#ifndef SYN_PROBE
#define SYN_PROBE 0
#endif
PHASE_FN ph_probe(LAS unsigned char* lds) { TIDS();
    LAS unsigned* hist = (LAS unsigned*)lds;
    if (SYN_PROBE == 1) {
        unsigned x = (unsigned)tid * 2654435761u + 12345u;
        for (int r = 0; r < 32; ++r) {
#pragma unroll
            for (int i = 0; i < 16; ++i) { x = x * 1664525u + 1013904223u; (void)__hip_atomic_fetch_add(hist + ((x >> 10) & 2047u), 1u, __ATOMIC_RELAXED, __HIP_MEMORY_SCOPE_WORKGROUP); }
            SEL_BAR(); } }
    if (SYN_PROBE == 2) {
        float acc = 0.f; float v[16];
#pragma unroll
        for (int i = 0; i < 16; ++i) v[i] = (float)((tid * 16 + i) % 977);
        for (int r = 0; r < 32 * 8; ++r) { const float c1 = 100.f + (float)(r & 7) + acc * 1e-30f, c2 = c1 * 2.f, c3 = c1 * 3.f; unsigned n1 = 0, n2 = 0, n3 = 0;
#pragma unroll
            for (int i = 0; i < 16; ++i) { n1 += (unsigned)__builtin_popcountll(__builtin_amdgcn_ballot_w64(v[i] >= c1)); n2 += (unsigned)__builtin_popcountll(__builtin_amdgcn_ballot_w64(v[i] >= c2)); n3 += (unsigned)__builtin_popcountll(__builtin_amdgcn_ballot_w64(v[i] >= c3)); }
            if (lane == 0) { hist[(r & 1) * 24 + wave] = n1; hist[(r & 1) * 24 + 8 + wave] = n2; hist[(r & 1) * 24 + 16 + wave] = n3; }
            SEL_BAR();
            unsigned t1 = 0;
#pragma unroll
            for (int j = 0; j < 24; ++j) t1 += hist[(r & 1) * 24 + j];
            acc += (float)t1; }
        if (acc == 12345.f) hist[100] = 1u; }
    if (SYN_PROBE == 3) {
        float a = (float)tid;
        for (int r = 0; r < 32; ++r) {
#pragma unroll
            for (int k = 0; k < 4; ++k)
#pragma unroll
                for (int o = 1; o < 64; o <<= 1) a = fmaxf(a, shfl_idx_f(a, (int)(lane_id_v() ^ (unsigned)o)) * 0.999f);
        }
        if (a == 12345.f) hist[100] = 1u; }
    __syncthreads(); }
typedef const __attribute__((address_space(4))) Args* ArgsP;
__device__ __forceinline__ ArgsP fresh_args() { ArgsP ap = (ArgsP)__builtin_amdgcn_kernarg_segment_ptr(); asm volatile("" : "+s"(ap)); return ap; }
#ifndef DUP_PHASE
#define DUP_PHASE -1
#endif
#define SEAM() do { if constexpr (one_launch) { ArgsP ap_ = fresh_args(); XcdBarrier b_; b_.bar = (unsigned*)(ap_->ws + WS_CTL) + CW_BAR; b_.x = xb_xcc_id(); b_.st = (volatile LAS unsigned*)(lds + MISC_OFF); xcd_barrier(b_); } } while (0)
#define IN(k) (PLO <= (k) && (k) < PHI)
#define WL(ap, layer) ((ap)->ws + WS_W + (size_t)(layer) * W_LAYER)
template <int PLO, int PHI, bool LAST> __device__ __forceinline__ void layer_phases(const int layer, LAS unsigned char* lds, unsigned char* lds_raw) {
    constexpr bool one_launch = (PHI - PLO > 1);
    if constexpr (IN(1)) { ArgsP ap = fresh_args(); ph_rmsnorm(layer == 0 ? ap->x : ap->out, ap->norm_mix + layer * DM, (bf16*)(ap->ws + WS_H)); if constexpr (DUP_PHASE == 1) { SEAM(); ph_rmsnorm(layer == 0 ? ap->x : ap->out, ap->norm_mix + layer * DM, (bf16*)(ap->ws + WS_H)); } SEAM(); }
    constexpr int CV_S1 = 10880, CV_S2 = 10880;
    if constexpr (IN(2)) { ArgsP ap = fresh_args(); ph_gemm_proj(lds, ap->ws, (const bf16*)(WL(ap, layer) + WO_IN));
        if constexpr (one_launch && !LAST) { ArgsP aq = fresh_args(); ph_convert_tail(lds, aq->ws, layer + 1, aq->w_in, aq->w_b_att, aq->w_b_mlstm, aq->w_b_ret, aq->w_out, aq->w_ffn_in, aq->w_ffn_out, ((S / 256) * (NPROJ_PAD / 256)) % (int)gridDim.x, 0, CV_S1); } if constexpr (DUP_PHASE == 2) { SEAM(); ph_gemm_proj(lds, ap->ws, (const bf16*)(WL(ap, layer) + WO_IN)); } SEAM(); }
    if constexpr (IN(3)) { ArgsP ap = fresh_args(); ph_pp(ap->ws, ap->att_q_norm + layer * 128, ap->att_k_norm + layer * 128, ap->mlstm_conv + layer * 4096, ap->mlstm_gate_bias + layer * 8); if constexpr (DUP_PHASE == 23) { SEAM(); ph_gemm_proj(lds, ap->ws, (const bf16*)(WL(ap, layer) + WO_IN)); SEAM(); ph_pp(ap->ws, ap->att_q_norm + layer * 128, ap->att_k_norm + layer * 128, ap->mlstm_conv + layer * 4096, ap->mlstm_gate_bias + layer * 8); } if constexpr (DUP_PHASE == 3) { SEAM(); ph_pp(ap->ws, ap->att_q_norm + layer * 128, ap->att_k_norm + layer * 128, ap->mlstm_conv + layer * 4096, ap->mlstm_gate_bias + layer * 8); } SEAM(); }
    if constexpr (IN(4)) { ArgsP ap = fresh_args(); ph_scores(ap->ws); if constexpr (DUP_PHASE == 4) { SEAM(); ph_scores(ap->ws); } }
    if constexpr (IN(5)) { ArgsP ap = fresh_args(); ph_deltas(lds, ap->ws); if constexpr (DUP_PHASE == 5) { SEAM(); ph_deltas(lds, ap->ws); } SEAM(); }
    if constexpr (IN(6) && SYN_PROBE != 0) { ph_probe(lds); }
    if constexpr (IN(6)) { ArgsP ap = fresh_args(); ph_select(lds, ap->ws); if constexpr (DUP_PHASE == 6) { SEAM(); ph_select(lds, ap->ws); } }
    if constexpr (IN(7) && one_launch && !LAST) { ArgsP aq = fresh_args(); ph_convert_tail(lds, aq->ws, layer + 1, aq->w_in, aq->w_b_att, aq->w_b_mlstm, aq->w_b_ret, aq->w_out, aq->w_ffn_in, aq->w_ffn_out, 128, CV_S1, CV_S2); }
    if constexpr (IN(7)) { ArgsP ap = fresh_args(); ph_scans(lds, ap->ws); if constexpr (DUP_PHASE == 7) { SEAM(); ph_scans(lds, ap->ws); } SEAM(); }
    if constexpr (IN(8) && IN(9)) {
        ArgsP ap = fresh_args(); const bool split = gridDim.x == 256;
        if (!split || blockIdx.x < 128) ph_attention((char*)lds_raw, ap->ws);
        if (!split || blockIdx.x >= 128) ph_outs(lds, ap->ws, ap->mlstm_out_norm + layer * 1024, ap->ret_out_norm + layer * 1024, split ? (int)blockIdx.x - 128 : (int)blockIdx.x, split ? 128 : (int)gridDim.x);
        SEAM(); }
    else {
    if constexpr (IN(8)) { ArgsP ap = fresh_args(); ph_attention((char*)lds_raw, ap->ws); }
    if constexpr (IN(9)) { ArgsP ap = fresh_args(); ph_outs(lds, ap->ws, ap->mlstm_out_norm + layer * 1024, ap->ret_out_norm + layer * 1024, (int)blockIdx.x, (int)gridDim.x); SEAM(); }
    }
    if constexpr (IN(10)) { ArgsP ap = fresh_args(); ph_gemm_branch<0>(lds, ap->ws, (const bf16*)(ap->ws + WS_YA), (const bf16*)(WL(ap, layer) + WO_B), 0); if constexpr (DUP_PHASE == 10) { SEAM(); ph_gemm_branch<0>(lds, ap->ws, (const bf16*)(ap->ws + WS_YA), (const bf16*)(WL(ap, layer) + WO_B), 0); } }
    if constexpr (IN(11)) { ArgsP ap = fresh_args(); ph_gemm_branch<1>(lds, ap->ws, (const bf16*)(ap->ws + WS_YM), (const bf16*)(WL(ap, layer) + WO_B + 4 * MiB), DM); if constexpr (DUP_PHASE == 11) { SEAM(); ph_gemm_branch<1>(lds, ap->ws, (const bf16*)(ap->ws + WS_YM), (const bf16*)(WL(ap, layer) + WO_B + 4 * MiB), DM); } }
    if constexpr (IN(12)) { ArgsP ap = fresh_args(); ph_gemm_branch<2>(lds, ap->ws, (const bf16*)(ap->ws + WS_YR), (const bf16*)(WL(ap, layer) + WO_B + 8 * MiB), 2 * DM); if constexpr (DUP_PHASE == 12) { SEAM(); ph_gemm_branch<2>(lds, ap->ws, (const bf16*)(ap->ws + WS_YR), (const bf16*)(WL(ap, layer) + WO_B + 8 * MiB), 2 * DM); } SEAM(); }
    if constexpr (IN(13)) { ArgsP ap = fresh_args(); ph_gemm_resid(lds, (const bf16*)(ap->ws + WS_MERGED), (const bf16*)(WL(ap, layer) + WO_OUT), DM, layer == 0 ? ap->x : ap->out, ap->out); SEAM(); }
    if constexpr (IN(14)) { ArgsP ap = fresh_args(); ph_rmsnorm(ap->out, ap->norm_ffn + layer * DM, (bf16*)(ap->ws + WS_H)); if constexpr (DUP_PHASE == 14) { SEAM(); ph_rmsnorm(ap->out, ap->norm_ffn + layer * DM, (bf16*)(ap->ws + WS_H)); } SEAM(); }
    if constexpr (IN(15)) { ArgsP ap = fresh_args(); ph_gemm_ffn_in(lds, ap->ws, (const bf16*)(WL(ap, layer) + WO_FIN));
        if constexpr (one_launch && !LAST) { ArgsP aq = fresh_args(); ph_convert_tail(lds, aq->ws, layer + 1, aq->w_in, aq->w_b_att, aq->w_b_mlstm, aq->w_b_ret, aq->w_out, aq->w_ffn_in, aq->w_ffn_out, ((S / 256) * (2 * FF / 256)) % (int)gridDim.x, CV_S2, CV_ITEMS); } if constexpr (DUP_PHASE == 15) { SEAM(); ph_gemm_ffn_in(lds, ap->ws, (const bf16*)(WL(ap, layer) + WO_FIN)); } SEAM(); }
    if constexpr (IN(16)) { ArgsP ap = fresh_args(); ph_gemm_resid(lds, (const bf16*)(ap->ws + WS_ACT), (const bf16*)(WL(ap, layer) + WO_FOUT), FF, ap->out, ap->out); if constexpr (!LAST) SEAM(); }
}
template <int PLO, int PHI> __global__ void __launch_bounds__(NTHR, 2) fwd(Args args_unused) {
    (void)args_unused;
    extern __shared__ __attribute__((aligned(16))) unsigned char lds_raw[];
    LAS unsigned char* lds = (LAS unsigned char*)lds_raw;
    if (threadIdx.x < 64) ((volatile LAS unsigned*)(lds + MISC_OFF))[threadIdx.x] = 0u;
    if ((threadIdx.x & 63) == 0) ((volatile LAS unsigned*)(lds + MISC_OFF))[64 + ((unsigned)__builtin_amdgcn_s_getreg((5 << 11) | 4) & 63u)] = threadIdx.x >> 6;
    __syncthreads();
    constexpr bool one_launch = (PHI - PLO > 1);
    if constexpr (one_launch) { ArgsP ap = fresh_args(); (void)xcd_barrier_post((unsigned*)(ap->ws + WS_CTL) + CW_BAR, (volatile LAS unsigned*)(lds + MISC_OFF)); }
    if constexpr (PLO == 0) { ArgsP ap = fresh_args(); ph_prologue(lds, ap->ws, ap->w_in, ap->w_b_att, ap->w_b_mlstm, ap->w_b_ret, ap->w_out, ap->w_ffn_in, ap->w_ffn_out, !one_launch);
        if constexpr (DUP_PHASE == 0) { SEAM(); ph_prologue(lds, ap->ws, ap->w_in, ap->w_b_att, ap->w_b_mlstm, ap->w_b_ret, ap->w_out, ap->w_ffn_in, ap->w_ffn_out, !one_launch); }
        if (PHI > 1) SEAM(); }
    if constexpr (one_launch) { static_assert(DEPTH == 4, "four inlined layer sites");
        layer_phases<PLO, PHI, false>(0, lds, lds_raw); layer_phases<PLO, PHI, false>(1, lds, lds_raw); layer_phases<PLO, PHI, false>(2, lds, lds_raw); layer_phases<PLO, PHI, true>(3, lds, lds_raw); }
    else if constexpr (PLO > 0) { ArgsP ap = fresh_args(); layer_phases<PLO, PHI, true>(ap->layer_lo, lds, lds_raw); }
}
#undef IN
#undef SEAM
#undef WL

#ifndef ONE_LAUNCH
#define ONE_LAUNCH 1
#endif
typedef void (*kern_t)(Args);
template <int P> static kern_t phase_kernel(int p) { if (p == P) return fwd<P, P + 1>; if constexpr (P < PH_PER_LAYER) return phase_kernel<P + 1>(p); else return nullptr; }
extern "C" void kernel_launch(void* const* d_in, const int* in_sizes, int n_in, void* d_out, int out_size, void* d_ws, size_t ws_size, hipStream_t stream) {
    static int grid = 0;
    if (grid == 0) {
        if (n_in != 16 || in_sizes[0] != S * DM || out_size != S * DM || ws_size < WS_END) { fprintf(stderr, "kernel_launch: unexpected shapes (n_in %d, in0 %d, out %d, ws %zu < %zu); nothing launched\n", n_in, n_in > 0 ? in_sizes[0] : -1, out_size, ws_size, (size_t)WS_END); grid = -1; return; }
        int dev = 0, cus = 0;
        if (hipGetDevice(&dev) != hipSuccess || hipDeviceGetAttribute(&cus, hipDeviceAttributeMultiprocessorCount, dev) != hipSuccess) { grid = -1; return; }
#if ONE_LAUNCH
        if (hipFuncSetAttribute((const void*)fwd<0, PH_PER_LAYER + 1>, hipFuncAttributeMaxDynamicSharedMemorySize, LDS_BYTES) != hipSuccess) { grid = -1; return; }
#else
        for (int p = 0; p <= PH_PER_LAYER; ++p) if (hipFuncSetAttribute((const void*)phase_kernel<0>(p), hipFuncAttributeMaxDynamicSharedMemorySize, LDS_BYTES) != hipSuccess) { fprintf(stderr, "kernel_launch: hipFuncSetAttribute failed\n"); grid = -1; return; }
#endif
        (void)hipGetLastError();
        grid = cus;
    }
    if (grid < 0) return;
    (void)hipMemsetAsync((char*)d_ws + WS_CTL, 0, CTL_ZERO_BYTES, stream);
    Args a{};
    a.x = (const float*)d_in[0]; a.norm_mix = (const float*)d_in[1]; a.norm_ffn = (const float*)d_in[2]; a.w_in = (const float*)d_in[3]; a.att_q_norm = (const float*)d_in[4]; a.att_k_norm = (const float*)d_in[5];
    a.mlstm_conv = (const float*)d_in[6]; a.mlstm_gate_bias = (const float*)d_in[7]; a.mlstm_out_norm = (const float*)d_in[8]; a.ret_out_norm = (const float*)d_in[9];
    a.w_b_att = (const float*)d_in[10]; a.w_b_mlstm = (const float*)d_in[11]; a.w_b_ret = (const float*)d_in[12]; a.w_out = (const float*)d_in[13]; a.w_ffn_in = (const float*)d_in[14]; a.w_ffn_out = (const float*)d_in[15];
    a.out = (float*)d_out; a.ws = (unsigned char*)d_ws;
#if ONE_LAUNCH
    a.layer_lo = 0; a.layer_hi = DEPTH; a.ph_lo = 0; a.ph_hi = PH_PER_LAYER + 1; hipLaunchKernelGGL((fwd<0, PH_PER_LAYER + 1>), dim3(grid), dim3(NTHR), LDS_BYTES, stream, a);
#else
    a.layer_lo = 0; a.layer_hi = 0; a.ph_lo = 0; a.ph_hi = 1; hipLaunchKernelGGL((fwd<0, 1>), dim3(grid), dim3(NTHR), LDS_BYTES, stream, a);
    for (int l = 0; l < DEPTH; ++l) for (int p = 1; p <= PH_PER_LAYER; ++p) { a.layer_lo = l; a.layer_hi = l + 1; a.ph_lo = p; a.ph_hi = p + 1; hipLaunchKernelGGL(phase_kernel<0>(p), dim3(grid), dim3(NTHR), LDS_BYTES, stream, a); }
#endif
}
```

```cpp
#include <hip/hip_runtime.h>
#include <cstdio>
#include <cstdint>
__device__ __forceinline__ int my_tid();
namespace pg8 {
#define PG8_LAS __attribute__((address_space(3)))
typedef unsigned short bf16_t;
typedef short bf16x8 __attribute__((ext_vector_type(8)));
typedef float f32x4 __attribute__((ext_vector_type(4)));
typedef unsigned u32x4 __attribute__((ext_vector_type(4)));
constexpr int BM = 256, BK = 64, HALF = 128, HTB = HALF * BK * 2  , STAGE_BYTES = 8 * HTB, NXCD = 8, WGM = 8;

__host__ __device__ __forceinline__ int lds_byte(int r, int c) { const int st = (r >> 4) * 2 + (c >> 5), rr = r & 15, cc = c & 31, ob = rr * 64 + cc * 2; return st * 1024 + (ob ^ (((ob >> 9) & 1) << 5)); }
__host__ __device__ __forceinline__ void stage_rc(int b, int& R, int& C) { const int st = b / 1024, sb = b % 1024, swz = sb ^ (((sb >> 9) & 1) << 5); R = (st >> 1) * 16 + swz / 64; C = (st & 1) * 32 + (swz % 64) / 2; }
__host__ __device__ __forceinline__ int perm32(int rho) { const int n = rho >> 4, i = rho & 15; return 8 * (i >> 2) + 4 * n + (i & 3); }

struct Unit { int pm, pn; };
struct Gemm { const bf16_t* A; const bf16_t* Bt; int M, N, K; };

struct StaticOrder {
    int nM, nN, nwg, G, c;
    __host__ __device__ void init(int M, int N, int G_, int c_) { nM = M / BM; nN = N / BM; nwg = nM * nN; G = G_; c = c_; }
    __host__ __device__ bool next(int i, Unit& u) const {
        const long L = (long)i * G + c; if (L >= nwg) return false;
        int wgid = (int)L; { const int q = nwg / NXCD, r = nwg % NXCD, xcd = wgid % NXCD, off = wgid / NXCD; wgid = (xcd < r ? xcd * (q + 1) : r * (q + 1) + (xcd - r) * q) + off; }
        const int nig = WGM * nN, gid = wgid / nig, fm = gid * WGM, gsz = (nM - fm) < WGM ? (nM - fm) : WGM;
        u.pm = fm + ((wgid % nig) % gsz); u.pn = (wgid % nig) / gsz; return true;
    }
    __device__ __forceinline__ void a_ready(const Unit&) const {}
    __device__ __forceinline__ void done(const Unit&) const {}
};

__device__ __forceinline__ unsigned cvt_pk_bf16(float lo, float hi) { unsigned r; asm volatile("v_cvt_pk_bf16_f32 %0, %1, %2" : "=v"(r) : "v"(lo), "v"(hi)); return r; }
typedef float f32x2 __attribute__((ext_vector_type(2)));
__device__ __forceinline__ float sigmoid_f(float x) { return __builtin_amdgcn_rcpf(1.0f + __builtin_amdgcn_exp2f(-1.4426950408889634f * x)); }
struct EpiProj {
    static constexpr bool PERM = true, AFTER_DRAIN = false;
    bf16_t* P; int ldp; float* Sm; int ngate0, nbf;
    __device__ __forceinline__ void operator()(const f32x4 (&acc)[2][2][4][2], const Unit& u, int wr, int wc, int fr, int fq) const {
        const int row0 = u.pm * BM + wr * 64 + fr, col0 = u.pn * BM + wc * 32 + 8 * fq;
        if (u.pn >= nbf) {
            const int c0 = wc * 32 + 8 * fq;
#pragma unroll
            for (int ai = 0; ai < 2; ++ai)
#pragma unroll
                for (int m = 0; m < 4; ++m) { float* rowp = Sm + (size_t)(row0 + ai * HALF + m * 16) * 256 + c0;
#pragma unroll
                    for (int bj = 0; bj < 2; ++bj) { *(f32x4*)(rowp + bj * HALF) = acc[ai][bj][m][0]; *(f32x4*)(rowp + bj * HALF + 4) = acc[ai][bj][m][1]; } }
            return;
        }
        const bool sg = u.pn >= ngate0;
#pragma unroll
        for (int ai = 0; ai < 2; ++ai)
#pragma unroll
            for (int m = 0; m < 4; ++m) { bf16_t* rowp = P + (size_t)(row0 + ai * HALF + m * 16) * ldp + col0;
#pragma unroll
                for (int bj = 0; bj < 2; ++bj) { f32x4 v0 = acc[ai][bj][m][0], v1 = acc[ai][bj][m][1];
                    if (sg) {
#pragma unroll
                        for (int j = 0; j < 4; ++j) { v0[j] = sigmoid_f(v0[j]); v1[j] = sigmoid_f(v1[j]); } }
                    u32x4 w; w.x = cvt_pk_bf16(v0[0], v0[1]); w.y = cvt_pk_bf16(v0[2], v0[3]); w.z = cvt_pk_bf16(v1[0], v1[1]); w.w = cvt_pk_bf16(v1[2], v1[3]);
                    *(u32x4*)(rowp + bj * HALF) = w; } }
    }
};
__device__ __forceinline__ f32x4 bf4_lo(u32x4 w) { return (f32x4){__uint_as_float(w.x << 16), __uint_as_float(w.x & 0xffff0000u), __uint_as_float(w.y << 16), __uint_as_float(w.y & 0xffff0000u)}; }
__device__ __forceinline__ f32x4 bf4_hi(u32x4 w) { return (f32x4){__uint_as_float(w.z << 16), __uint_as_float(w.z & 0xffff0000u), __uint_as_float(w.w << 16), __uint_as_float(w.w & 0xffff0000u)}; }
template <int MODE> struct EpiBranch {
    static constexpr bool PERM = true, AFTER_DRAIN = false;
    const bf16_t* G; int ldg; float* T; bf16_t* O; int ldt;
    __device__ __forceinline__ void operator()(const f32x4 (&acc)[2][2][4][2], const Unit& u, int wr, int wc, int fr, int fq) const {
        const int row0 = u.pm * BM + wr * 64 + fr, col0 = u.pn * BM + wc * 32 + 8 * fq;
#pragma unroll
        for (int ai = 0; ai < 2; ++ai)
#pragma unroll
            for (int m = 0; m < 4; ++m) { const size_t r = (size_t)(row0 + ai * HALF + m * 16);
#pragma unroll
                for (int bj = 0; bj < 2; ++bj) { const u32x4 g = *(const u32x4*)(G + r * ldg + col0 + bj * HALF);
                    f32x4 v0 = acc[ai][bj][m][0] * bf4_lo(g), v1 = acc[ai][bj][m][1] * bf4_hi(g);
                    float* tp = T + r * ldt + col0 + bj * HALF;
                    if (MODE >= 1) { v0 = v0 + *(const f32x4*)tp; v1 = v1 + *(const f32x4*)(tp + 4); }
                    if (MODE <= 1) { *(f32x4*)tp = v0; *(f32x4*)(tp + 4) = v1; }
                    else { u32x4 w; w.x = cvt_pk_bf16(v0[0], v0[1]); w.y = cvt_pk_bf16(v0[2], v0[3]); w.z = cvt_pk_bf16(v1[0], v1[1]); w.w = cvt_pk_bf16(v1[2], v1[3]);
                        *(u32x4*)(O + r * ldt + col0 + bj * HALF) = w; } } }
    }
};
struct EpiResid {
    static constexpr bool PERM = false, AFTER_DRAIN = false;
    const float* base; float* out; int ldc;
    __device__ __forceinline__ void operator()(const f32x4 (&acc)[2][2][4][2], const Unit& u, int wr, int wc, int fr, int fq) const {
        const int row0 = u.pm * BM + wr * 64 + fr, col0 = u.pn * BM + wc * 32 + 4 * fq;
#pragma unroll
        for (int ai = 0; ai < 2; ++ai)
#pragma unroll
            for (int m = 0; m < 4; ++m) { const size_t off = (size_t)(row0 + ai * HALF + m * 16) * ldc + col0;
#pragma unroll
                for (int bj = 0; bj < 2; ++bj)
#pragma unroll
                    for (int n = 0; n < 2; ++n) *(f32x4*)(out + off + bj * HALF + n * 16) = *(const f32x4*)(base + off + bj * HALF + n * 16) + acc[ai][bj][m][n]; }
    }
};
struct EpiSwiGLU {
    static constexpr bool PERM = true, AFTER_DRAIN = false;
    bf16_t* O; int ldc;
    __device__ __forceinline__ void operator()(const f32x4 (&acc)[2][2][4][2], const Unit& u, int wr, int wc, int fr, int fq) const {
        const int row0 = u.pm * BM + wr * 64 + fr, col0 = u.pn * HALF + wc * 32 + 8 * fq;
#pragma unroll
        for (int ai = 0; ai < 2; ++ai)
#pragma unroll
            for (int m = 0; m < 4; ++m) { f32x4 v0, v1;
#pragma unroll
                for (int j = 0; j < 4; ++j) { const float g0 = acc[ai][0][m][0][j], g1 = acc[ai][0][m][1][j];
                    v0[j] = g0 * sigmoid_f(g0) * acc[ai][1][m][0][j]; v1[j] = g1 * sigmoid_f(g1) * acc[ai][1][m][1][j]; }
                u32x4 w; w.x = cvt_pk_bf16(v0[0], v0[1]); w.y = cvt_pk_bf16(v0[2], v0[3]); w.z = cvt_pk_bf16(v1[0], v1[1]); w.w = cvt_pk_bf16(v1[2], v1[3]);
                *(u32x4*)(O + (size_t)(row0 + ai * HALF + m * 16) * ldc + col0) = w; }
    }
};
template <class Epi, class Sched, bool ALIGN_EPI = false, bool SP2 = false>
__device__ __forceinline__ void gemm_phase(PG8_LAS unsigned char* lds, const Gemm g, const Sched& S, const Epi& E) {
    int tid_o = my_tid(); asm volatile("" : "+v"(tid_o));
    const int tid = tid_o, wid = __builtin_amdgcn_readfirstlane(tid >> 6), lane = tid & 63, wr = wid >> 2, wc = wid & 3, fr = lane & 15, fq = lane >> 4;
    const int K = g.K, nt = K / BK;
    unsigned voffA[2], voffB[2];
#pragma unroll
    for (int i = 0; i < 2; ++i) { int R, C; stage_rc(tid * 16 + i * 8192, R, C); const int Rb = Epi::PERM ? ((R & ~31) + perm32(R & 31)) : R;
        voffA[i] = (unsigned)(R * K + C) * 2u; voffB[i] = (unsigned)(Rb * K + C) * 2u; }
    const size_t kstep = (size_t)(BK * 2);
    const size_t hstep = (size_t)HALF * K * 2;
    const size_t tstep = 2 * hstep;
    const unsigned ldsw = (unsigned)wid * 1024u;
    const int aoff = lds_byte(wr * 64 + fr, fq * 8), boff = lds_byte(wc * 32 + fr, fq * 8);
#define PG8_SA(b, h) (((b) * 2 + (h)) * HTB)
#define PG8_SB(b, h) ((4 + (b) * 2 + (h)) * HTB)
#define PG8_STAGE(bufoff, gbase, voff) do { _Pragma("unroll") for (int _i = 0; _i < 2; ++_i) \
        __builtin_amdgcn_global_load_lds((const unsigned*)((const char*)(gbase) + (voff)[_i]), (PG8_LAS unsigned*)(lds + (bufoff) + ldsw + _i * 8192), 16, 0, 0); } while (0)
#define PG8_LDA(dst, b, h) do { _Pragma("unroll") for (int m = 0; m < 4; ++m) _Pragma("unroll") for (int k = 0; k < 2; ++k) dst[m][k] = *(const PG8_LAS bf16x8*)(lds + PG8_SA(b, h) + aoff + m * 2048 + k * 1024); } while (0)
#define PG8_LDB(dst, b, h) do { _Pragma("unroll") for (int n = 0; n < 2; ++n) _Pragma("unroll") for (int k = 0; k < 2; ++k) dst[n][k] = *(const PG8_LAS bf16x8*)(lds + PG8_SB(b, h) + boff + n * 2048 + k * 1024); } while (0)
#define PG8_MMA(ai, bj, At, Bt) do { __builtin_amdgcn_s_setprio(1); _Pragma("unroll") for (int m = 0; m < 4; ++m) _Pragma("unroll") for (int n = 0; n < 2; ++n) _Pragma("unroll") for (int k = 0; k < 2; ++k) \
        acc[ai][bj][m][n] = __builtin_amdgcn_mfma_f32_16x16x32_bf16(Bt[n][k], At[m][k], acc[ai][bj][m][n], 0, 0, 0); __builtin_amdgcn_s_setprio(0); } while (0)
#define PG8_WAIT_V(n) asm volatile("s_waitcnt vmcnt(" #n ")" ::: "memory")
#define PG8_WAIT_L(n) asm volatile("s_waitcnt lgkmcnt(" #n ")" ::: "memory")
#define PG8_BAR __builtin_amdgcn_s_barrier()
#define PG8_SCHED __builtin_amdgcn_sched_barrier(0)
    Unit cur, nxt; int ui = 0;
    if (!S.next(0, cur)) return;
    f32x4 acc[2][2][4][2];
#pragma unroll
    for (int a = 0; a < 2; ++a)
#pragma unroll
        for (int b = 0; b < 2; ++b)
#pragma unroll
            for (int m = 0; m < 4; ++m)
#pragma unroll
                for (int n = 0; n < 2; ++n) acc[a][b][m][n] = (f32x4){0.f, 0.f, 0.f, 0.f};
    bf16x8 At[4][2], B0[2][2], B1[2][2];
    const char* cA = (const char*)g.A + (size_t)cur.pm * tstep; const char* cB = (const char*)g.Bt + (size_t)cur.pn * tstep;
    S.a_ready(cur);
    if constexpr (SP2) {
        PG8_STAGE(PG8_SB(0, 0), cB, voffB); PG8_STAGE(PG8_SB(0, 1), cB + hstep, voffB); PG8_STAGE(PG8_SA(0, 0), cA, voffA); PG8_STAGE(PG8_SA(0, 1), cA + hstep, voffA);
        if (wr == 1) PG8_BAR;
        PG8_WAIT_V(2); PG8_BAR;
        PG8_STAGE(PG8_SB(1, 0), cB + kstep, voffB); PG8_STAGE(PG8_SA(1, 0), cA + kstep, voffA); PG8_STAGE(PG8_SB(1, 1), cB + hstep + kstep, voffB);
        PG8_WAIT_V(6); PG8_BAR;
    } else {
        PG8_STAGE(PG8_SB(0, 0), cB, voffB); PG8_STAGE(PG8_SA(0, 0), cA, voffA); PG8_STAGE(PG8_SB(0, 1), cB + hstep, voffB); PG8_STAGE(PG8_SA(0, 1), cA + hstep, voffA);
        if (wr == 1) PG8_BAR;
        PG8_WAIT_V(4); PG8_BAR;
        PG8_STAGE(PG8_SB(1, 0), cB + kstep, voffB); PG8_STAGE(PG8_SA(1, 0), cA + kstep, voffA); PG8_STAGE(PG8_SB(1, 1), cB + hstep + kstep, voffB);
        PG8_WAIT_V(6); PG8_BAR;
    }
    for (;;) {
        const bool has_next = S.next(ui + 1, nxt);
        const char* nA = has_next ? (const char*)g.A + (size_t)nxt.pm * tstep : cA; const char* nB = has_next ? (const char*)g.Bt + (size_t)nxt.pn * tstep : cB;
        for (int t = 0; t < nt; t += 2) {
            const bool last = (t == nt - 2);
            const char* a1 = cA + (size_t)(t + 1) * kstep;
            const char* a2 = last ? nA : cA + (size_t)(t + 2) * kstep; const char* b2 = last ? nB : cB + (size_t)(t + 2) * kstep;
            const char* a3 = a2 + kstep; const char* b3 = b2 + kstep;
            if (last && has_next) S.a_ready(nxt);
            if constexpr (SP2) {
            PG8_LDB(B0, 0, 0); PG8_LDB(B1, 0, 1); PG8_SCHED; PG8_LDA(At, 0, 0); PG8_STAGE(PG8_SA(1, 1), a1 + hstep, voffA);
            PG8_WAIT_V(8); PG8_WAIT_L(0); PG8_BAR; PG8_MMA(0, 0, At, B0); PG8_MMA(0, 1, At, B1); PG8_BAR; PG8_SCHED;
            PG8_LDA(At, 0, 1); PG8_STAGE(PG8_SB(0, 0), b2, voffB); PG8_STAGE(PG8_SB(0, 1), b2 + hstep, voffB); PG8_STAGE(PG8_SA(0, 0), a2, voffA);
            PG8_WAIT_V(8); PG8_WAIT_L(0); PG8_BAR; PG8_MMA(1, 0, At, B0); PG8_MMA(1, 1, At, B1); PG8_BAR; PG8_SCHED;
            PG8_LDB(B0, 1, 0); PG8_LDB(B1, 1, 1); PG8_SCHED; PG8_LDA(At, 1, 0); PG8_STAGE(PG8_SA(0, 1), a2 + hstep, voffA);
            PG8_WAIT_V(8); PG8_WAIT_L(0); PG8_BAR; PG8_MMA(0, 0, At, B0); PG8_MMA(0, 1, At, B1); PG8_BAR; PG8_SCHED;
            PG8_LDA(At, 1, 1); PG8_STAGE(PG8_SB(1, 0), b3, voffB); PG8_STAGE(PG8_SB(1, 1), b3 + hstep, voffB); PG8_STAGE(PG8_SA(1, 0), a3, voffA);
            PG8_WAIT_V(8); PG8_WAIT_L(0); PG8_BAR; PG8_MMA(1, 0, At, B0); PG8_MMA(1, 1, At, B1); PG8_BAR; PG8_SCHED;
            } else {
            PG8_LDB(B0, 0, 0); PG8_SCHED; PG8_LDA(At, 0, 0); PG8_STAGE(PG8_SA(1, 1), a1 + hstep, voffA);
            PG8_WAIT_L(8); PG8_BAR; PG8_WAIT_L(0); PG8_MMA(0, 0, At, B0); PG8_BAR; PG8_SCHED;
            PG8_LDB(B1, 0, 1); PG8_STAGE(PG8_SB(0, 0), b2, voffB);
            PG8_BAR; PG8_WAIT_L(0); PG8_MMA(0, 1, At, B1); PG8_BAR;
            PG8_LDA(At, 0, 1); PG8_STAGE(PG8_SA(0, 0), a2, voffA);
            PG8_BAR; PG8_WAIT_L(0); PG8_MMA(1, 0, At, B0); PG8_BAR; PG8_SCHED;
            PG8_STAGE(PG8_SB(0, 1), b2 + hstep, voffB);
            PG8_WAIT_V(6); PG8_BAR; PG8_MMA(1, 1, At, B1); PG8_BAR;
            PG8_LDB(B0, 1, 0); PG8_SCHED; PG8_LDA(At, 1, 0); PG8_STAGE(PG8_SA(0, 1), a2 + hstep, voffA);
            PG8_WAIT_L(8); PG8_BAR; PG8_WAIT_L(0); PG8_MMA(0, 0, At, B0); PG8_BAR; PG8_SCHED;
            PG8_LDB(B1, 1, 1); PG8_STAGE(PG8_SB(1, 0), b3, voffB);
            PG8_BAR; PG8_WAIT_L(0); PG8_MMA(0, 1, At, B1); PG8_BAR;
            PG8_LDA(At, 1, 1); PG8_STAGE(PG8_SA(1, 0), a3, voffA);
            PG8_BAR; PG8_WAIT_L(0); PG8_MMA(1, 0, At, B0); PG8_BAR; PG8_SCHED;
            PG8_STAGE(PG8_SB(1, 1), b3 + hstep, voffB);
            PG8_WAIT_V(6); PG8_BAR; PG8_MMA(1, 1, At, B1); PG8_BAR;
            }
        }
        if constexpr (ALIGN_EPI) { if (wr == 0) PG8_BAR; }
        if constexpr (!Epi::AFTER_DRAIN) { E(acc, cur, wr, wc, fr, fq); S.done(cur); }
        if (!has_next) break;
#pragma unroll
        for (int a = 0; a < 2; ++a)
#pragma unroll
            for (int b = 0; b < 2; ++b)
#pragma unroll
                for (int m = 0; m < 4; ++m)
#pragma unroll
                    for (int n = 0; n < 2; ++n) acc[a][b][m][n] = (f32x4){0.f, 0.f, 0.f, 0.f};
        cur = nxt; cA = nA; cB = nB; ++ui;
        if constexpr (ALIGN_EPI) { if (wr == 1) PG8_BAR; }
    }
    PG8_WAIT_V(0);
    if constexpr (!ALIGN_EPI) { if (wr == 0) PG8_BAR; }
    PG8_BAR;
    if constexpr (Epi::AFTER_DRAIN) { E.fused(acc, cur, wr, wc, fr, fq, lds, wid, lane); S.done(cur); }
#undef PG8_SA
#undef PG8_SB
#undef PG8_STAGE
#undef PG8_LDA
#undef PG8_LDB
#undef PG8_MMA
#undef PG8_WAIT_V
#undef PG8_WAIT_L
#undef PG8_BAR
#undef PG8_SCHED
}
}

using pg8::sigmoid_f;
constexpr int NWAVES = 8, NTHR = 512;
constexpr int S = 8192, DM = 2048, DEPTH = 4, FF = 5632;
constexpr int NPROJ = 16896, NPROJ_PAD = 17152, LPROJ = 16976;
constexpr int PC_AQ = 0, PC_AK = 1024, PC_AV = 2048, PC_IQ = 3072, PC_MQ = 3584, PC_MK = 4096, PC_MV = 4608, PC_MO = 5632, PC_RQ = 6656, PC_RK = 7680, PC_RV = 8704, PC_RG = 9728, PC_G = 10752;
constexpr int LC_IK = 3584, LC_IW = 3648, LC_MI = 5704, LC_MF = 5708;
constexpr float NORM_EPS = 1e-6f;
constexpr size_t MiB = 1u << 20;
constexpr size_t WS_CTL = 0, CTL_ZERO_BYTES = 1 * MiB;
constexpr size_t WS_ROPE128 = 2 * MiB, WS_ROPE64 = 6 * MiB;
constexpr size_t WS_W = 16 * MiB, W_LAYER = 153 * MiB;
constexpr size_t WO_IN = 0, WO_B = 67 * MiB, WO_OUT = 79 * MiB, WO_FIN = 87 * MiB, WO_FOUT = 131 * MiB;
constexpr size_t WS_H = 640 * MiB, WS_PROJ = 672 * MiB, WS_SMALL = 936 * MiB, WS_MQK = 944 * MiB, WS_IKB = 960 * MiB, WS_IWF = 961 * MiB, WS_GIF = WS_IWF + 512 * 1024;
constexpr size_t WS_SC = 964 * MiB, WS_MB = 1220 * MiB, WS_DCM = 1228 * MiB, WS_CPM = 1260 * MiB, WS_MISC = 1292 * MiB, WS_DRR = 1294 * MiB, WS_RPR = 1310 * MiB;
constexpr size_t WS_YA = 1328 * MiB, WS_YM = 1344 * MiB, WS_YR = 1360 * MiB, WS_MERGEDF = 1376 * MiB, WS_MERGED = 1440 * MiB, WS_ACT = 1472 * MiB, WS_END = 1560 * MiB;
constexpr size_t MISC_DN = 0, MISC_NPREV = 256 * 1024, MISC_AB = 512 * 1024, MISC_MPREV = 520 * 1024;
constexpr int CW_BAR = 4096;
constexpr int LDS_BYTES = 147456, MISC_OFF = 147456 - 1024;

#define GAS __attribute__((address_space(1)))
#define LAS __attribute__((address_space(3)))
typedef unsigned short bf16;
typedef unsigned v4u __attribute__((ext_vector_type(4)));
typedef unsigned v2u __attribute__((ext_vector_type(2)));
typedef float f32x4 __attribute__((ext_vector_type(4)));
typedef float f32x16 __attribute__((ext_vector_type(16)));
typedef short bf16x8 __attribute__((ext_vector_type(8)));
typedef short s16x4 __attribute__((ext_vector_type(4)));
#define LDS_WAIT() asm volatile("s_waitcnt lgkmcnt(0)" ::: "memory")
#define VM_WAIT() asm volatile("s_waitcnt vmcnt(0)" ::: "memory")
__device__ __forceinline__ unsigned f2bf(float f) { unsigned u = __builtin_bit_cast(unsigned, f); return (u + 0x7fffu + ((u >> 16) & 1u)) >> 16; }
__device__ __forceinline__ unsigned pk2(float lo, float hi) { return f2bf(lo) | (f2bf(hi) << 16); }
__device__ __forceinline__ float bf2f(bf16 b) { return __uint_as_float(((unsigned)b) << 16); }
template <int CTRL, int RMASK, int BMASK> __device__ __forceinline__ float dpp_f(float old, float src) { return __builtin_bit_cast(float, __builtin_amdgcn_update_dpp(__builtin_bit_cast(int, old), __builtin_bit_cast(int, src), CTRL, RMASK, BMASK, false)); }
template <int CTRL, int RMASK, int BMASK> __device__ __forceinline__ unsigned dpp_u(unsigned src) { return (unsigned)__builtin_amdgcn_update_dpp(0, (int)src, CTRL, RMASK, BMASK, false); }
__device__ __forceinline__ float wave_sum(float x) {
    x += dpp_f<0xB1, 0xf, 0xf>(0.f, x); x += dpp_f<0x4E, 0xf, 0xf>(0.f, x); x += dpp_f<0x141, 0xf, 0xf>(0.f, x); x += dpp_f<0x140, 0xf, 0xf>(0.f, x);
    x += dpp_f<0x142, 0xa, 0xf>(0.f, x); x += dpp_f<0x143, 0xc, 0xf>(0.f, x);
    return __builtin_bit_cast(float, __builtin_amdgcn_readlane(__builtin_bit_cast(int, x), 63)); }
__device__ __forceinline__ float wave_max(float x) {
    x = fmaxf(x, dpp_f<0xB1, 0xf, 0xf>(x, x)); x = fmaxf(x, dpp_f<0x4E, 0xf, 0xf>(x, x)); x = fmaxf(x, dpp_f<0x141, 0xf, 0xf>(x, x)); x = fmaxf(x, dpp_f<0x140, 0xf, 0xf>(x, x));
    x = fmaxf(x, dpp_f<0x142, 0xa, 0xf>(x, x)); x = fmaxf(x, dpp_f<0x143, 0xc, 0xf>(x, x));
    return __builtin_bit_cast(float, __builtin_amdgcn_readlane(__builtin_bit_cast(int, x), 63)); }
__device__ __forceinline__ unsigned lane_id_v() { unsigned l; asm volatile("v_mbcnt_lo_u32_b32 %0, -1, 0\n\tv_mbcnt_hi_u32_b32 %0, -1, %0" : "=v"(l)); return l; }
__device__ __forceinline__ int my_tid() {
    const unsigned slot = (unsigned)__builtin_amdgcn_s_getreg((5 << 11) | 4) & 63u;
    extern __shared__ __attribute__((aligned(16))) unsigned char lds_raw_t[];
    const unsigned wv = ((volatile LAS unsigned*)((LAS unsigned char*)lds_raw_t + MISC_OFF))[64 + slot];
    return (int)(__builtin_amdgcn_readfirstlane(wv) * 64u + lane_id_v());
}
__device__ __forceinline__ float shfl_idx_f(float x, int src_lane) { return __builtin_bit_cast(float, __builtin_amdgcn_ds_bpermute(src_lane << 2, __builtin_bit_cast(int, x))); }
__device__ __forceinline__ float wave_prefix_sum_f(float x) {
    float y = x + dpp_f<0x111, 0xf, 0xf>(0.f, x); y += dpp_f<0x112, 0xf, 0xf>(0.f, x); y += dpp_f<0x113, 0xf, 0xf>(0.f, x);
    y += dpp_f<0x114, 0xf, 0xe>(0.f, y); y += dpp_f<0x118, 0xf, 0xc>(0.f, y); y += dpp_f<0x142, 0xa, 0xf>(0.f, y); y += dpp_f<0x143, 0xc, 0xf>(0.f, y); return y; }
__device__ __forceinline__ float wave_prefix_max_f(float x) {
    const float N = -3.0e38f;
    float y = fmaxf(x, dpp_f<0x111, 0xf, 0xf>(N, x)); y = fmaxf(y, dpp_f<0x112, 0xf, 0xf>(N, x)); y = fmaxf(y, dpp_f<0x113, 0xf, 0xf>(N, x));
    y = fmaxf(y, dpp_f<0x114, 0xf, 0xe>(N, y)); y = fmaxf(y, dpp_f<0x118, 0xf, 0xc>(N, y)); y = fmaxf(y, dpp_f<0x142, 0xa, 0xf>(N, y)); y = fmaxf(y, dpp_f<0x143, 0xc, 0xf>(N, y)); return y; }
#define XB_TMO      128
#define XB_XCNT(j)  (256  + 64 * (j))
#define XB_XSUB(j)  (1280 + 64 * (j))
#define XB_XGEN(j)  (2304 + 64 * (j))
#define XB_TOP      3328
#define XB_TOPGEN   3392
#define XCD_BAR_WORDS 3456
#define XB_SPIN_CAP (1u << 18)

__device__ __forceinline__ unsigned xb_ld(unsigned* p)              { return __hip_atomic_load(p, __ATOMIC_RELAXED, __HIP_MEMORY_SCOPE_AGENT); }
__device__ __forceinline__ unsigned xb_add(unsigned* p, unsigned v) { return __hip_atomic_fetch_add(p, v, __ATOMIC_RELAXED, __HIP_MEMORY_SCOPE_AGENT); }
__device__ __forceinline__ unsigned xb_xcc_id() { return (unsigned)__builtin_amdgcn_s_getreg((3 << 11) | 20) & 0xFu; }
#define XB_SPIN(cond, bar) do { unsigned _sp = 0; while (cond) { __builtin_amdgcn_s_sleep(1); \
    if ((++_sp & 255u) == 0u) { if (xb_ld(&(bar)[XB_TMO])) break; if (_sp > XB_SPIN_CAP) { atomicAdd(&(bar)[XB_TMO], 1u); break; } } } } while (0)

struct XcdBarrier {
    unsigned* bar; unsigned x;
    volatile LAS unsigned* st;
};

__device__ __forceinline__ XcdBarrier xcd_barrier_post(unsigned* bar, volatile LAS unsigned* st) {
    XcdBarrier b; b.bar = bar; b.x = xb_xcc_id(); b.st = st;
    if (my_tid() == 0) (void)xb_add(&bar[XB_XCNT(b.x)], 1u);
    return b;
}
__device__ __forceinline__ void xcd_barrier_complete(unsigned* bar, unsigned x, unsigned& nloc, unsigned& nx) {
    const unsigned G = gridDim.x * gridDim.y * gridDim.z;
    unsigned sum, cnt, mine, sp = 0u;
    for (;;) {
        sum = 0u; cnt = 0u; mine = 0u;
#pragma unroll
        for (unsigned j = 0; j < 16; ++j) { const unsigned c = xb_ld(&bar[XB_XCNT(j)]); sum += c; cnt += (c > 0u) ? 1u : 0u; mine = (j == x) ? c : mine; }
        if (sum == G) break;
        __builtin_amdgcn_s_sleep(1);
        if ((++sp & 255u) == 0u) { if (xb_ld(&bar[XB_TMO])) break; if (sp > XB_SPIN_CAP) { atomicAdd(&bar[XB_TMO], 1u); break; } }
    }
    nloc = mine > 0u ? mine : 1u; nx = cnt > 0u ? cnt : 1u;
}

__device__ __forceinline__ void xcd_barrier(const XcdBarrier& b) {
    asm volatile("s_waitcnt vmcnt(0)" ::: "memory");
    __syncthreads();
    if (my_tid() == 0) {
        unsigned* bar = b.bar;
        __builtin_amdgcn_s_waitcnt(0);
        unsigned nloc = b.st[0], nx = b.st[1];
        if (nloc == 0u) { xcd_barrier_complete(bar, b.x, nloc, nx); b.st[0] = nloc; b.st[1] = nx; }
        const unsigned old = xb_add(&bar[XB_XSUB(b.x)], 1u);
        const unsigned gen = old / nloc;
        if (old + 1u == (gen + 1u) * nloc) {
            __builtin_amdgcn_fence(__ATOMIC_RELEASE, "agent");
            asm volatile("s_waitcnt vmcnt(0)" ::: "memory");
            const unsigned og = xb_add(&bar[XB_TOP], 1u);
            const unsigned tg = og / nx;
            if (og + 1u == (tg + 1u) * nx) xb_add(&bar[XB_TOPGEN], 1u);
            else XB_SPIN(xb_ld(&bar[XB_TOPGEN]) == tg, bar);
            __builtin_amdgcn_fence(__ATOMIC_ACQUIRE, "agent");
            xb_add(&bar[XB_XGEN(b.x)], 1u);
            asm volatile("s_waitcnt vmcnt(0)" ::: "memory");
        } else {
            XB_SPIN(xb_ld(&bar[XB_XGEN(b.x)]) == gen, bar);
            __builtin_amdgcn_fence(__ATOMIC_ACQUIRE, "agent");
            asm volatile("s_waitcnt vmcnt(0)" ::: "memory");
        }
    }
    __syncthreads();
}

struct MapIdent { __device__ __forceinline__ int operator()(int p) const { return p; } };
struct MapWin { __device__ __forceinline__ int operator()(int p) const {
    if (p < 3584) return p; if (p < 5632) return p + 72; if (p < NPROJ) return p + 80;
    const int r = p - NPROJ; if (r < 64) return LC_IK + r; if (r < 72) return LC_IW + (r - 64); if (r < 76) return LC_MI + (r - 72); if (r < 80) return LC_MF + (r - 76); return -1; } };
struct MapFfn { __device__ __forceinline__ int operator()(int p) const { const int t = p >> 8, r = p & 255; return r < 128 ? 128 * t + r : FF + 128 * t + (r - 128); } };
template <class Map> __device__ __forceinline__ void transpose_item(const float* W, int K, int N, bf16* WT, LAS float* scr, int item, int nblk, int lane, const Map& map) {
    const int kb = item / nblk, nb = item % nblk, k0 = 64 * kb, p0 = 64 * nb;
    const int n4 = lane & 15, kr = lane >> 4, nl = map(p0 + 4 * n4);
    f32x4 v[16];
#pragma unroll
    for (int i = 0; i < 16; ++i) v[i] = nl >= 0 ? *(const GAS f32x4*)(W + (size_t)(k0 + kr + 4 * i) * N + nl) : (f32x4){0.f, 0.f, 0.f, 0.f};
#pragma unroll
    for (int i = 0; i < 16; ++i) { LAS float* d = scr + (kr + 4 * i) * 65 + 4 * n4; d[0] = v[i][0]; d[1] = v[i][1]; d[2] = v[i][2]; d[3] = v[i][3]; }
    LDS_WAIT(); asm volatile("" ::: "memory");
    const int c = lane & 7;
#pragma unroll
    for (int j = 0; j < 8; ++j) { const int n = (lane >> 3) + 8 * j; const LAS float* s = scr + (8 * c) * 65 + n;
        v4u o; o.x = pk2(s[0 * 65], s[1 * 65]); o.y = pk2(s[2 * 65], s[3 * 65]); o.z = pk2(s[4 * 65], s[5 * 65]); o.w = pk2(s[6 * 65], s[7 * 65]);
        *(GAS v4u*)(WT + (size_t)(p0 + n) * K + k0 + 8 * c) = o; }
    LDS_WAIT(); asm volatile("" ::: "memory");
}
template <class Map> __device__ __forceinline__ void transpose_matrix(const float* W, int K, int N, int Nphys, bf16* WT, LAS float* scr, int gw, int ngw, int lane, const Map& map) {
    const int nblk = Nphys / 64, nit = (K / 64) * nblk;
    for (int it = gw; it < nit; it += ngw) transpose_item(W, K, N, WT, scr, it, nblk, lane, map);
}

__device__ __forceinline__ void rms_row_to_bf16(const float* xrow, const float* gain, bf16* orow, int lane) {
    const GAS f32x4* xr = (const GAS f32x4*)xrow + lane; const GAS f32x4* gr = (const GAS f32x4*)gain + lane;
    f32x4 v[8]; float s = 0.f;
#pragma unroll
    for (int j = 0; j < 8; ++j) { v[j] = xr[64 * j]; s += (v[j].x * v[j].x + v[j].y * v[j].y) + (v[j].z * v[j].z + v[j].w * v[j].w); }
    const float rstd = 1.0f / sqrtf(wave_sum(s) * (1.f / DM) + NORM_EPS);
    GAS unsigned long long* o8 = (GAS unsigned long long*)orow + lane;
#pragma unroll
    for (int j = 0; j < 8; ++j) { const f32x4 g = gr[64 * j]; o8[64 * j] = (unsigned long long)pk2(v[j].x * rstd * g.x, v[j].y * rstd * g.y) | ((unsigned long long)pk2(v[j].z * rstd * g.z, v[j].w * rstd * g.w) << 32); }
}

struct PPArgs { bf16* proj; const float* small; bf16* mqk; bf16* ikb; unsigned char* sgn; float* gif; const float* rope128; const float* rope64; const float* gq; const float* gk; const float* convw; const float* gbias; };
__device__ __forceinline__ void bf8_unpack(const v4u w, float (&f)[8]) { f[0] = __uint_as_float(w.x << 16); f[1] = __uint_as_float(w.x & 0xffff0000u); f[2] = __uint_as_float(w.y << 16); f[3] = __uint_as_float(w.y & 0xffff0000u);
    f[4] = __uint_as_float(w.z << 16); f[5] = __uint_as_float(w.z & 0xffff0000u); f[6] = __uint_as_float(w.w << 16); f[7] = __uint_as_float(w.w & 0xffff0000u); }
__device__ __forceinline__ v4u bf8_pack(const float (&f)[8]) { v4u o; o.x = pk2(f[0], f[1]); o.y = pk2(f[2], f[3]); o.z = pk2(f[4], f[5]); o.w = pk2(f[6], f[7]); return o; }
__device__ __forceinline__ float sum8_dpp(float x) {
    x += dpp_f<0xB1, 0xf, 0xf>(0.f, x); x += dpp_f<0x4E, 0xf, 0xf>(0.f, x); x += dpp_f<0x141, 0xf, 0xf>(0.f, x); return x; }
__device__ __forceinline__ void pp_row(const PPArgs& a, int t, int lane, const f32x4 (&cw)[16]) {
    bf16* pr = a.proj + (size_t)t * NPROJ;
    const int hd = lane >> 3, d0 = (lane & 7) * 8;
    float cs[8], sn[8];
#pragma unroll
    for (int i = 0; i < 4; ++i) { const f32x4 c = *(const f32x4*)(a.rope128 + ((size_t)t * 64 + d0 + 2 * i) * 2); cs[2 * i] = c[0]; sn[2 * i] = c[1]; cs[2 * i + 1] = c[2]; sn[2 * i + 1] = c[3]; }
#pragma unroll
    for (int seg = 0; seg < 4; ++seg) {
        const int base = seg == 0 ? PC_AQ : (seg == 1 ? PC_AK : (seg == 2 ? PC_RQ : PC_RK));
        bf16* p = pr + base + hd * 128 + d0; float x1[8], x2[8];
        bf8_unpack(*(const GAS v4u*)p, x1); bf8_unpack(*(const GAS v4u*)(p + 64), x2);
        if (seg < 2) { const float* gn = seg ? a.gk : a.gq; float ss = 0.f;
#pragma unroll
            for (int i = 0; i < 8; ++i) ss += x1[i] * x1[i] + x2[i] * x2[i];
            const float rstd = 1.0f / sqrtf(sum8_dpp(ss) * (1.f / 128.f) + NORM_EPS);
            const f32x4 ga = *(const f32x4*)(gn + d0), gb = *(const f32x4*)(gn + d0 + 4), gc = *(const f32x4*)(gn + 64 + d0), gd = *(const f32x4*)(gn + 64 + d0 + 4);
#pragma unroll
            for (int i = 0; i < 4; ++i) { x1[i] *= rstd * ga[i]; x1[4 + i] *= rstd * gb[i]; x2[i] *= rstd * gc[i]; x2[4 + i] *= rstd * gd[i]; } }
        float o1[8], o2[8];
#pragma unroll
        for (int i = 0; i < 8; ++i) { o1[i] = x1[i] * cs[i] - x2[i] * sn[i]; o2[i] = x2[i] * cs[i] + x1[i] * sn[i]; }
        *(GAS v4u*)p = bf8_pack(o1); *(GAS v4u*)(p + 64) = bf8_pack(o2); }
    const float* sm = a.small + (size_t)t * 256;
    {
        const int e0 = (lane & 7) * 4; const f32x4 ca = *(const f32x4*)(a.rope64 + ((size_t)t * 32 + e0) * 2), cb = *(const f32x4*)(a.rope64 + ((size_t)t * 32 + e0 + 2) * 2);
        const float c4[4] = {ca[0], ca[2], cb[0], cb[2]}, s4[4] = {ca[1], ca[3], cb[1], cb[3]};
        bf16* p = pr + PC_IQ + hd * 64 + e0; const v2u lo = *(const GAS v2u*)p, hi = *(const GAS v2u*)(p + 32);
        const float aw = fabsf(sm[64 + hd]) * (0.35355339059327373f * 0.125f);
        const float y1[4] = {__uint_as_float(lo.x << 16), __uint_as_float(lo.x & 0xffff0000u), __uint_as_float(lo.y << 16), __uint_as_float(lo.y & 0xffff0000u)};
        const float y2[4] = {__uint_as_float(hi.x << 16), __uint_as_float(hi.x & 0xffff0000u), __uint_as_float(hi.y << 16), __uint_as_float(hi.y & 0xffff0000u)};
        float q1[4], q2[4];
#pragma unroll
        for (int i = 0; i < 4; ++i) { q1[i] = (y1[i] * c4[i] - y2[i] * s4[i]) * aw; q2[i] = (y2[i] * c4[i] + y1[i] * s4[i]) * aw; }
        v2u w1, w2; w1.x = pk2(q1[0], q1[1]); w1.y = pk2(q1[2], q1[3]); w2.x = pk2(q2[0], q2[1]); w2.y = pk2(q2[2], q2[3]);
        *(GAS v2u*)p = w1; *(GAS v2u*)(p + 32) = w2;
        if (lane < 8) { const f32x4 k1 = *(const f32x4*)(sm + e0), k2 = *(const f32x4*)(sm + 32 + e0); float r1[4], r2[4];
#pragma unroll
            for (int i = 0; i < 4; ++i) { r1[i] = k1[i] * c4[i] - k2[i] * s4[i]; r2[i] = k2[i] * c4[i] + k1[i] * s4[i]; }
            v2u u1, u2; u1.x = pk2(r1[0], r1[1]); u1.y = pk2(r1[2], r1[3]); u2.x = pk2(r2[0], r2[1]); u2.y = pk2(r2[2], r2[3]);
            *(GAS v2u*)(a.ikb + (size_t)t * 64 + e0) = u1; *(GAS v2u*)(a.ikb + (size_t)t * 64 + 32 + e0) = u2; } }
    { const unsigned long long nb = __builtin_amdgcn_ballot_w64(lane < 8 && sm[64 + (lane & 7)] < 0.f); if (lane == 0) a.sgn[t] = (unsigned char)(nb & 0xffull); }
    if (lane < 8) a.gif[(size_t)t * 8 + lane] = sm[72 + lane] + a.gbias[lane];
    {
        float acc[16];
#pragma unroll
        for (int i = 0; i < 16; ++i) acc[i] = 0.f;
#pragma unroll
        for (int j = 0; j < 4; ++j) { const int tt = t - 3 + j; if (tt >= 0) { const bf16* xp = a.proj + (size_t)tt * NPROJ + PC_MQ + 16 * lane; float xa[8], xb[8];
                bf8_unpack(*(const GAS v4u*)xp, xa); bf8_unpack(*(const GAS v4u*)(xp + 8), xb);
#pragma unroll
                for (int i = 0; i < 4; ++i) { acc[i] += cw[j * 4][i] * xa[i]; acc[4 + i] += cw[j * 4 + 1][i] * xa[4 + i]; acc[8 + i] += cw[j * 4 + 2][i] * xb[i]; acc[12 + i] += cw[j * 4 + 3][i] * xb[4 + i]; } } }
        float oa[8], ob[8];
#pragma unroll
        for (int i = 0; i < 8; ++i) { oa[i] = acc[i]; ob[i] = acc[8 + i]; }
        bf16* mp = a.mqk + (size_t)t * 1024 + 16 * lane; *(GAS v4u*)mp = bf8_pack(oa); *(GAS v4u*)(mp + 8) = bf8_pack(ob); }
}

constexpr int SCT_RS = 272, IQT_RS = 1040, IQT_BYTES = 32 * IQT_RS;
__device__ __forceinline__ void score_wave_unit(LAS unsigned char* wt, const LAS unsigned char* iqt, const bf16* ikb, const unsigned char* sgn, float* sc, int qb, int kb, int lane) {
    const int r = lane & 31, h = lane >> 5, q0 = qb * 32, s0 = kb * 64;
    bf16x8 ka[2][4];
#pragma unroll
    for (int b = 0; b < 2; ++b)
#pragma unroll
        for (int kk = 0; kk < 4; ++kk) ka[b][kk] = *(const bf16x8*)(ikb + (size_t)(s0 + 32 * b + r) * 64 + 16 * kk + 8 * h);
    const LAS unsigned char* qrow = iqt + r * IQT_RS + 16 * h;
    const unsigned sb = sgn[q0 + r];
    f32x16 scv[2];
#pragma unroll
    for (int b = 0; b < 2; ++b)
#pragma unroll
        for (int e = 0; e < 16; ++e) scv[b][e] = 0.f;
#pragma unroll 2
    for (int j = 0; j < 8; ++j) { bf16x8 qf[4];
#pragma unroll
        for (int kk = 0; kk < 4; ++kk) qf[kk] = *(const LAS bf16x8*)(qrow + j * 128 + kk * 32);
        const float sj = ((sb >> j) & 1u) ? -1.0f : 1.0f;
#pragma unroll
        for (int b = 0; b < 2; ++b) { f32x16 acc;
#pragma unroll
            for (int e = 0; e < 16; ++e) acc[e] = 0.f;
#pragma unroll
            for (int kk = 0; kk < 4; ++kk) acc = __builtin_amdgcn_mfma_f32_32x32x16_bf16(ka[b][kk], qf[kk], acc, 0, 0, 0);
#pragma unroll
            for (int e = 0; e < 16; ++e) scv[b][e] = fmaf(fmaxf(acc[e], 0.f), sj, scv[b][e]); } }
#pragma unroll
    for (int b = 0; b < 2; ++b)
#pragma unroll
        for (int g = 0; g < 4; ++g) *(LAS f32x4*)(wt + r * SCT_RS + (32 * b + 8 * g + 4 * h) * 4) = (f32x4){scv[b][4 * g], scv[b][4 * g + 1], scv[b][4 * g + 2], scv[b][4 * g + 3]};
#pragma unroll
    for (int k = 0; k < 8; ++k) { const int row = 4 * k + (lane >> 4), c4 = (lane & 15) * 4;
        const f32x4 x = *(const LAS f32x4*)(wt + row * SCT_RS + c4 * 4);
        *(GAS f32x4*)(sc + (size_t)(q0 + row) * S + s0 + c4) = x; }
}


__device__ __forceinline__ float wave_max_dpp(float x) { return wave_max(x); }
__device__ __forceinline__ float wave_min_dpp(float x) { return -wave_max_dpp(-x); }
__device__ __forceinline__ unsigned wave_prefix_dpp(unsigned x) {
    unsigned y = x + dpp_u<0x111, 0xf, 0xf>(x); y += dpp_u<0x112, 0xf, 0xf>(x); y += dpp_u<0x113, 0xf, 0xf>(x);
    y += dpp_u<0x114, 0xf, 0xe>(y); y += dpp_u<0x118, 0xf, 0xc>(y); y += dpp_u<0x142, 0xa, 0xf>(y); y += dpp_u<0x143, 0xc, 0xf>(y);
    return y; }
#define SEL_BAR() do { asm volatile("s_waitcnt lgkmcnt(0)" ::: "memory"); __builtin_amdgcn_s_barrier(); asm volatile("" ::: "memory"); } while (0)
__device__ __forceinline__ void select_rows_wg(LAS unsigned char* lds, const float* sc, unsigned long long* mb, int row0, int rstep, int tid) {
    LAS unsigned* hist = (LAS unsigned*)lds;
    LAS unsigned* btot = hist + 2176;
    LAS float* red = (LAS float*)(hist + 2240); LAS unsigned* lcnt = hist + 2256;
    LAS float* lval = (LAS float*)(hist + 2272); LAS int* lidx = (LAS int*)(hist + 2272 + 8192); LAS unsigned* lsel = hist + 2272 + 16384;
    const int lane = tid & 63, w = tid >> 6;
    f32x4 nx[4];
#define SEL_LOAD(t_) do { const float* scr_ = sc + (size_t)(t_) * S + 4 * tid; _Pragma("unroll") for (int j = 0; j < 4; ++j) nx[j] = *(const GAS f32x4*)(scr_ + 2048 * j); } while (0)
    if (row0 < S) SEL_LOAD(row0);
    if (tid < 2) lcnt[tid] = 0u;
    for (int j = tid; j < 2240; j += NTHR) hist[j] = 0u;
    if (tid == 0) lsel[0] = 0u;
    int par = 0;
    for (int t = row0; t < S; t += rstep) {
        float v[16];
#pragma unroll
        for (int j = 0; j < 4; ++j)
#pragma unroll
            for (int c = 0; c < 4; ++c) v[4 * j + c] = (2048 * j + 4 * tid + c <= t) ? nx[j][c] : -3.0e38f;
        if (t + rstep < S) SEL_LOAD(t + rstep);
        unsigned long long* mbr = mb + (size_t)t * 128;
        bool sel[16];
        if (t >= 256) {
            const int ngrp = (t >> 11) + 1;
            float mn = 3.0e38f, mx = -3.0e38f;
#pragma unroll
            for (int i = 0; i < 16; ++i) { mx = fmaxf(mx, v[i]); mn = fminf(mn, (v[i] > -3.0e38f) ? v[i] : 3.0e38f); }
            mn = wave_min_dpp(mn); mx = wave_max_dpp(mx);
            if (lane == 0) { red[w] = mn; red[8 + w] = mx; }
            SEL_BAR();
            mn = red[0]; mx = red[8];
#pragma unroll
            for (int j = 1; j < 8; ++j) { mn = fminf(mn, red[j]); mx = fmaxf(mx, red[8 + j]); }
            const float scale = (mx > mn) ? 2047.0f / (mx - mn) : 0.f;
            int bin[16];
#pragma unroll
            for (int i = 0; i < 16; ++i) { int b = (int)((v[i] - mn) * scale); b = b < 0 ? 0 : (b > 2047 ? 2047 : b); const bool ok = v[i] > -3.0e38f; bin[i] = ok ? b : -1;
                if ((i >> 2) < ngrp) { (void)__hip_atomic_fetch_add(hist + (ok ? b + (b >> 5) : 2112 + lane), 1u, __ATOMIC_RELAXED, __HIP_MEMORY_SCOPE_WORKGROUP);
                    (void)__hip_atomic_fetch_add(btot + (ok ? (b >> 5) : 0), ok ? 1u : 0u, __ATOMIC_RELAXED, __HIP_MEMORY_SCOPE_WORKGROUP); } }
            SEL_BAR();
            const unsigned bt = btot[63 - lane]; const unsigned sufb = wave_prefix_dpp(bt);
            const unsigned long long ob = __builtin_amdgcn_ballot_w64(sufb >= 256u);
            const int olb = ob ? (int)__builtin_ctzll(ob) : 0; const int blk = 63 - olb;
            const unsigned above_blk = (unsigned)__builtin_amdgcn_readlane((int)(sufb - bt), olb);
            const unsigned hbn = (lane < 32) ? hist[33 * blk + 31 - lane] : 0u; const unsigned sufn = wave_prefix_dpp(hbn) + above_blk;
            const unsigned long long on = __builtin_amdgcn_ballot_w64(lane < 32 && sufn >= 256u);
            const int oln = on ? (int)__builtin_ctzll(on) : 0;
            const int bstar = 32 * blk + 31 - oln; const unsigned need = 256u - (unsigned)__builtin_amdgcn_readlane((int)(sufn - hbn), oln);
            int ks[16];
#pragma unroll
            for (int i = 0; i < 16; ++i) { ks[i] = -1; if (bin[i] == bstar) { const unsigned k = __hip_atomic_fetch_add(lcnt + par, 1u, __ATOMIC_RELAXED, __HIP_MEMORY_SCOPE_WORKGROUP); lval[k] = v[i]; lidx[k] = 2048 * (i >> 2) + 4 * tid + (i & 3); ks[i] = (int)k; } }
            SEL_BAR();
            const int nl = (int)lcnt[par];
            for (int k = tid; k < nl; k += NTHR) { const float x = lval[k]; const int s = lidx[k]; unsigned rank = 0u;
                for (int j = 0; j < nl; ++j) { const float y = lval[j]; const int sj = lidx[j]; rank += (y > x || (y == x && sj < s)) ? 1u : 0u; }
                lsel[k] = rank < need ? 1u : 0u; }
            SEL_BAR();
#pragma unroll
            for (int i = 0; i < 16; ++i) { const unsigned lv = lsel[ks[i] < 0 ? 0 : ks[i]]; sel[i] = bin[i] > bstar || (ks[i] >= 0 && lv != 0u); }
            *(LAS v4u*)(hist + 4 * tid) = (v4u){0u, 0u, 0u, 0u}; if (tid < 48) *(LAS v4u*)(hist + 2048 + 4 * tid) = (v4u){0u, 0u, 0u, 0u};
            if (tid == 0) lcnt[par ^ 1] = 0u;
            par ^= 1;
        } else {
#pragma unroll
            for (int i = 0; i < 16; ++i) sel[i] = v[i] > -3.0e38f;
        }
#pragma unroll
        for (int j = 0; j < 4; ++j) { unsigned long long wd = 0ull;
#pragma unroll
            for (int c = 0; c < 4; ++c) { const unsigned long long b = __builtin_amdgcn_ballot_w64(sel[4 * j + c]); wd |= ((b >> (16 * (lane & 3))) & 0xffffull) << (16 * c); }
            if (lane < 4) mbr[32 * j + 4 * w + lane] = wd; }
    }
    SEL_BAR();
#undef SEL_LOAD
}

template <int RS> __device__ __forceinline__ bf16x8 frag_row(const LAS unsigned char* base, int r0, int k0, int lane) {
    return *(const LAS bf16x8*)(base + (r0 + (lane & 15)) * RS + (k0 + 8 * (lane >> 4)) * 2);
}
template <int RS> __device__ __forceinline__ bf16x8 frag_tr(const LAS unsigned char* base, int k0, int c0, int lane) {
    const int g = lane >> 4, q = (lane & 15) >> 2, p = lane & 3;
    const unsigned a = (unsigned)(size_t)(base + (k0 + 8 * g + q) * RS + (c0 + 4 * p) * 2);
    s16x4 lo, hi;
    asm volatile("ds_read_b64_tr_b16 %0, %2\n\tds_read_b64_tr_b16 %1, %2 offset:%3\n\ts_waitcnt lgkmcnt(0)" : "=&v"(lo), "=&v"(hi) : "v"(a), "i"(4 * RS) : "memory");
    return (bf16x8){lo[0], lo[1], lo[2], lo[3], hi[0], hi[1], hi[2], hi[3]};
}
#define MFMA16(a, b, c) __builtin_amdgcn_mfma_f32_16x16x32_bf16((a), (b), (c), 0, 0, 0)
constexpr int SCR_OFF = 114688;
constexpr float DK_SCALE = 0.08838834764831845f;
__device__ __forceinline__ float log_sigmoid_f(float x) { return fminf(x, 0.f) - log1pf(expf(-fabsf(x))); }

template <int L, int DV> __device__ __forceinline__ void chunk_delta(LAS unsigned char* lds, const bf16* ksrc, int ldk, const bf16* vsrc, int ldv, const LAS float* wcol, bf16* outT, float* dn, int tid) {
    constexpr int RSK = (128 + 8) * 2, RSV = (DV + 8) * 2, NCB = DV / 128;
    LAS unsigned char* KA = lds; LAS unsigned char* V = lds + L * RSK;
    const int lane = tid & 63, w = tid >> 6;
    for (int idx = tid; idx < L * 16; idx += NTHR) { const int s = idx >> 4, c8 = idx & 15;
        const v4u x = *(const GAS v4u*)(ksrc + (size_t)s * ldk + c8 * 8); const float sc = DK_SCALE * wcol[s]; v4u o;
        o.x = pk2(__uint_as_float(x.x << 16) * sc, __uint_as_float(x.x & 0xffff0000u) * sc); o.y = pk2(__uint_as_float(x.y << 16) * sc, __uint_as_float(x.y & 0xffff0000u) * sc);
        o.z = pk2(__uint_as_float(x.z << 16) * sc, __uint_as_float(x.z & 0xffff0000u) * sc); o.w = pk2(__uint_as_float(x.w << 16) * sc, __uint_as_float(x.w & 0xffff0000u) * sc);
        *(LAS v4u*)(KA + s * RSK + c8 * 16) = o; }
    for (int idx = tid; idx < L * (DV / 8); idx += NTHR) { const int s = idx / (DV / 8), c8 = idx % (DV / 8);
        *(LAS v4u*)(V + s * RSV + c8 * 16) = *(const GAS v4u*)(vsrc + (size_t)s * ldv + c8 * 8); }
    __syncthreads();
    f32x4 acc[8][NCB];
#pragma unroll
    for (int db = 0; db < 8; ++db)
#pragma unroll
        for (int i = 0; i < NCB; ++i) acc[db][i] = (f32x4){0.f, 0.f, 0.f, 0.f};
#pragma unroll
    for (int kk = 0; kk < L / 32; ++kk) {
        bf16x8 bfr[NCB];
#pragma unroll
        for (int i = 0; i < NCB; ++i) bfr[i] = frag_tr<RSV>(V, 32 * kk, 16 * (w * NCB + i), lane);
#pragma unroll
        for (int db = 0; db < 8; ++db) { const bf16x8 a = frag_tr<RSK>(KA, 32 * kk, 16 * db, lane);
#pragma unroll
            for (int i = 0; i < NCB; ++i) acc[db][i] = MFMA16(a, bfr[i], acc[db][i]); }
    }
#pragma unroll
    for (int db = 0; db < 8; ++db)
#pragma unroll
        for (int i = 0; i < NCB; ++i) { const int e = 16 * (w * NCB + i) + (lane & 15), d0 = 16 * db + 4 * (lane >> 4);
            v2u o; o.x = pk2(acc[db][i][0], acc[db][i][1]); o.y = pk2(acc[db][i][2], acc[db][i][3]);
            *(GAS v2u*)(outT + (size_t)e * 128 + d0) = o; }
    if (dn != nullptr && tid < 128) { float s_ = 0.f;
        for (int s = 0; s < L; ++s) s_ += bf2f(*(const LAS bf16*)(KA + s * RSK + tid * 2));
        dn[tid] = s_; }
    __syncthreads();
}

template <int L, int DV, int MODE> __device__ __forceinline__ void chunk_out(LAS unsigned char* lds, LAS float* sf, const bf16* qsrc, int ldq, const bf16* ksrc, int ldk, const bf16* vsrc, int ldv,
                                                                              const bf16* stT, const float* gain, const bf16* gate, int ldg, bf16* y, int ldy, int tid) {
    constexpr int RSQ = (128 + 8) * 2, RSV = (DV + 8) * 2, RSP = (L + 8) * 2, NCB = DV / 128, NT = L / 16, TPW = NT * NT / 8;
    LAS unsigned char* Q = lds; LAS unsigned char* K = lds + L * RSQ; LAS unsigned char* V = lds + 2 * L * RSQ;
    LAS unsigned char* P = (MODE == 0) ? (lds + 2 * L * RSQ + L * RSV) : K;
    LAS float* H = (LAS float*)lds;
    LAS float* lrow = sf; LAS float* lcol = sf + 128; LAS float* qs = sf + 256; LAS float* flo = sf + 384; LAS float* rowsum = sf + 512; LAS float* npv = sf + 640; LAS float* part = sf + 768; LAS float* dpart = sf + 768 + L * NT;
    const int lane = tid & 63, w = tid >> 6, g4 = lane >> 4, c16 = lane & 15;
    for (int idx = tid; idx < L * 16; idx += NTHR) { const int s = idx >> 4, c8 = idx & 15;
        *(LAS v4u*)(Q + s * RSQ + c8 * 16) = *(const GAS v4u*)(qsrc + (size_t)s * ldq + c8 * 8);
        *(LAS v4u*)(K + s * RSQ + c8 * 16) = *(const GAS v4u*)(ksrc + (size_t)s * ldk + c8 * 8); }
    for (int idx = tid; idx < L * (DV / 8); idx += NTHR) { const int s = idx / (DV / 8), c8 = idx % (DV / 8);
        *(LAS v4u*)(V + s * RSV + c8 * 16) = *(const GAS v4u*)(vsrc + (size_t)s * ldv + c8 * 8); }
    __syncthreads();
    f32x4 pv[TPW];
#pragma unroll
    for (int i = 0; i < TPW; ++i) { const int ti = w * TPW + i, rb = ti / NT, cb = ti % NT; f32x4 a = (f32x4){0.f, 0.f, 0.f, 0.f};
        if (cb <= rb) {
#pragma unroll
            for (int kk = 0; kk < 4; ++kk) a = MFMA16(frag_row<RSQ>(Q, 16 * rb, 32 * kk, lane), frag_row<RSQ>(K, 16 * cb, 32 * kk, lane), a);
            const int s = 16 * cb + c16; const float lc = lcol[s]; float rs[4];
#pragma unroll
            for (int r = 0; r < 4; ++r) { const int t = 16 * rb + 4 * g4 + r; const float pw = (s <= t) ? __expf(lrow[t] + lc) * a[r] * DK_SCALE : 0.f; a[r] = pw; rs[r] = pw; }
            if (MODE == 0) {
#pragma unroll
                for (int r = 0; r < 4; ++r) { float v = rs[r]; v += dpp_f<0xB1, 0xf, 0xf>(0.f, v); v += dpp_f<0x4E, 0xf, 0xf>(0.f, v); v += dpp_f<0x141, 0xf, 0xf>(0.f, v); v += dpp_f<0x140, 0xf, 0xf>(0.f, v);
                    if (c16 == 0) part[(16 * rb + 4 * g4 + r) * NT + cb] = v; } }
        } else if (MODE == 0) { if (c16 == 0) {
#pragma unroll
                for (int r = 0; r < 4; ++r) part[(16 * rb + 4 * g4 + r) * NT + cb] = 0.f; } }
        pv[i] = a; }
    __syncthreads();
#pragma unroll
    for (int i = 0; i < TPW; ++i) { const int ti = w * TPW + i, rb = ti / NT, cb = ti % NT;
#pragma unroll
        for (int r = 0; r < 4; ++r) *(LAS bf16*)(P + (16 * rb + 4 * g4 + r) * RSP + (16 * cb + c16) * 2) = (bf16)f2bf(pv[i][r]); }
    for (int idx = tid; idx < L * 16; idx += NTHR) { const int s = idx >> 4, c8 = idx & 15; const float sc = qs[s];
        const v4u x = *(const LAS v4u*)(Q + s * RSQ + c8 * 16); float f[8];
        f[0] = __uint_as_float(x.x << 16) * sc; f[1] = __uint_as_float(x.x & 0xffff0000u) * sc; f[2] = __uint_as_float(x.y << 16) * sc; f[3] = __uint_as_float(x.y & 0xffff0000u) * sc;
        f[4] = __uint_as_float(x.z << 16) * sc; f[5] = __uint_as_float(x.z & 0xffff0000u) * sc; f[6] = __uint_as_float(x.w << 16) * sc; f[7] = __uint_as_float(x.w & 0xffff0000u) * sc;
        v4u o; o.x = pk2(f[0], f[1]); o.y = pk2(f[2], f[3]); o.z = pk2(f[4], f[5]); o.w = pk2(f[6], f[7]);
        *(LAS v4u*)(Q + s * RSQ + c8 * 16) = o;
        if (MODE == 0) { float dsum = 0.f;
#pragma unroll
            for (int j = 0; j < 8; ++j) dsum += f[j] * npv[8 * c8 + j];
            dpart[s * 16 + c8] = dsum; } }
    __syncthreads();
    if (MODE == 0 && tid < L) { float a = 0.f;
#pragma unroll
        for (int j = 0; j < NT; ++j) a += part[tid * NT + j];
#pragma unroll
        for (int j = 0; j < 16; ++j) a += dpart[tid * 16 + j];
        rowsum[tid] = a; }
    f32x4 acc[NT][NCB];
#pragma unroll
    for (int rb = 0; rb < NT; ++rb)
#pragma unroll
        for (int i = 0; i < NCB; ++i) acc[rb][i] = (f32x4){0.f, 0.f, 0.f, 0.f};
#pragma unroll
    for (int kk = 0; kk < 4; ++kk) { bf16x8 bfr[NCB];
#pragma unroll
        for (int i = 0; i < NCB; ++i) bfr[i] = *(const GAS bf16x8*)(stT + (size_t)(16 * (w * NCB + i) + c16) * 128 + 32 * kk + 8 * g4);
#pragma unroll
        for (int rb = 0; rb < NT; ++rb) { const bf16x8 a = frag_row<RSQ>(Q, 16 * rb, 32 * kk, lane);
#pragma unroll
            for (int i = 0; i < NCB; ++i) acc[rb][i] = MFMA16(a, bfr[i], acc[rb][i]); } }
#pragma unroll
    for (int kk = 0; kk < L / 32; ++kk) { bf16x8 bfr[NCB];
#pragma unroll
        for (int i = 0; i < NCB; ++i) bfr[i] = frag_tr<RSV>(V, 32 * kk, 16 * (w * NCB + i), lane);
#pragma unroll
        for (int rb = 0; rb < NT; ++rb) { const bf16x8 a = frag_row<RSP>(P, 16 * rb, 32 * kk, lane);
#pragma unroll
            for (int i = 0; i < NCB; ++i) acc[rb][i] = MFMA16(a, bfr[i], acc[rb][i]); } }
    __syncthreads();
#pragma unroll
    for (int rb = 0; rb < NT; ++rb)
#pragma unroll
        for (int i = 0; i < NCB; ++i)
#pragma unroll
            for (int r = 0; r < 4; ++r) { const int t = 16 * rb + 4 * g4 + r, e = 16 * (w * NCB + i) + c16; float hv = acc[rb][i][r];
                if (MODE == 0) hv = hv / fmaxf(fabsf(rowsum[t]), flo[t]);
                H[t * DV + e] = hv; }
    __syncthreads();
    for (int t = w; t < L; t += NWAVES) { float hv[DV / 64]; float s1 = 0.f;
#pragma unroll
        for (int i = 0; i < DV / 64; ++i) { hv[i] = H[t * DV + lane + 64 * i]; s1 += hv[i]; }
        float mu = 0.f; if (MODE == 1) { mu = wave_sum(s1) * (1.f / DV); }
        float s2 = 0.f;
#pragma unroll
        for (int i = 0; i < DV / 64; ++i) { hv[i] -= mu; s2 += hv[i] * hv[i]; }
        const float rstd = 1.0f / sqrtf(wave_sum(s2) * (1.f / DV) + NORM_EPS);
#pragma unroll
        for (int i = 0; i < DV / 64; ++i) { const int e = lane + 64 * i; const float gt = bf2f(gate[(size_t)t * ldg + e]);
            const float act = (MODE == 0) ? sigmoid_f(gt) : gt * sigmoid_f(gt);
            y[(size_t)t * ldy + e] = (bf16)f2bf(hv[i] * rstd * gain[e] * act); } }
    __syncthreads();
}
namespace att {
constexpr int D = 128, LDQKV = NPROJ, LDO = 1024;
constexpr float THR = 8.f; constexpr bool WSKIP = false;
constexpr float SCALE = 0.08838834764831845f;
constexpr int NW = 8, QBLK = 32, KVBLK = 64, QB = NW * QBLK;
constexpr int SHM_V = KVBLK * D * 2, SHM_K = KVBLK * D * 2;
constexpr int LDS_BYTES = 2 * SHM_V + 2 * SHM_K + NW * 64 * 4;

using bf16 = unsigned short;
typedef short bf16x8 __attribute__((ext_vector_type(8)));
typedef short s16x4 __attribute__((ext_vector_type(4)));
typedef float f32x16 __attribute__((ext_vector_type(16)));
typedef float f32x4 __attribute__((ext_vector_type(4)));
typedef unsigned u32x4 __attribute__((ext_vector_type(4)));
template <class A, class Bt> struct same_t { static constexpr bool v = false; };
template <class A> struct same_t<A, A> { static constexpr bool v = true; };

#define KSWZ(row, colB) ((row) * 256 + ((colB) ^ (((row) & 7) << 4)))
#define SBAR() __builtin_amdgcn_sched_barrier(0)
__device__ __forceinline__ int v_st(int k, int c) { const int kk = (k & ~0xC) | ((k & 4) << 1) | ((k & 8) >> 1); return ((kk >> 3) * 4 + (c >> 5)) * 512 + ((kk & 7) * 32 + (c & 31)) * 2; }
__device__ __forceinline__ int v_rd_base(int lane) { return ((lane & 3) << 3) | (((lane >> 2) & 3) << 6) | (((lane >> 4) & 1) << 5) | (((lane >> 5) & 1) << 8); }
constexpr int v_rd_off(int d0, int ks, int half) { return d0 * 512 + ks * 4096 + half * 2048; }
__device__ __forceinline__ int crow(int r, int hi) { return (r & 3) + 8 * (r >> 2) + 4 * hi; }
__device__ __forceinline__ unsigned cvtpk(float lo, float hi) {
    unsigned r; asm volatile("v_cvt_pk_bf16_f32 %0, %1, %2" : "=v"(r) : "v"(lo), "v"(hi)); return r;
}
__device__ __forceinline__ bf16x8 pack8(f32x4 a, f32x4 b) {
    u32x4 w = {cvtpk(a[0], a[1]), cvtpk(a[2], a[3]), cvtpk(b[0], b[1]), cvtpk(b[2], b[3])};
    return *reinterpret_cast<bf16x8*>(&w);
}
template <class T> __device__ __forceinline__ bf16x8 load8(const T* p) {
    if constexpr (same_t<T, float>::v) { return pack8(*(const f32x4*)p, *(const f32x4*)(p + 4)); }
    else { return *reinterpret_cast<const bf16x8*>(p); }
}
__device__ __forceinline__ unsigned long long mask_word(const char* tile_base, int row) { unsigned off = (unsigned)row; asm volatile("" : "+v"(off)); off *= 1024u; return *(const unsigned long long*)(tile_base + off); }
__device__ __forceinline__ void mask_bits(f32x16& p0, f32x16& p1, unsigned long long mw, int hi) {
    const unsigned long long ws = mw >> hi; const unsigned lo = (unsigned)ws, up = (unsigned)(ws >> 32);
#pragma unroll
    for (int r = 0; r < 16; ++r) {
        const int c = 16 * (r & 1) + 2 * (r >> 2); const unsigned x = (r & 2) ? up : lo;
        const unsigned ma = (unsigned)(((int)(x << (31 - c))) >> 31), mb = (unsigned)(((int)(x << (31 - c - 8))) >> 31);
        p0[r] = __uint_as_float((__float_as_uint(p0[r]) & ma) | (0xff800000u & ~ma));
        p1[r] = __uint_as_float((__float_as_uint(p1[r]) & mb) | (0xff800000u & ~mb));
    }
}
__device__ __forceinline__ void partialSM(f32x16& p0, f32x16& p1, float& m_reg, float& mn, float& alpha) {
    float pmax = p0[0]; for (int r = 1; r < 16; ++r) pmax = fmaxf(pmax, p0[r]); for (int r = 0; r < 16; ++r) pmax = fmaxf(pmax, p1[r]);
    { auto rr = __builtin_amdgcn_permlane32_swap(__float_as_uint(pmax), __float_as_uint(pmax), false, false);
      pmax = fmaxf(__uint_as_float(rr[0]), __uint_as_float(rr[1])); }
    constexpr float C2 = 1.4426950408889634f * SCALE;
    if (__builtin_expect(__all((pmax - m_reg) * SCALE <= THR), 1)) { mn = m_reg; alpha = 1.f; }
    else { mn = fmaxf(m_reg, pmax); alpha = __builtin_amdgcn_exp2f((m_reg - mn) * C2); m_reg = mn; }
    const float mnL = -mn * C2;
    for (int r = 0; r < 16; ++r) p0[r] = fmaf(p0[r], C2, mnL); for (int r = 0; r < 16; ++r) p1[r] = fmaf(p1[r], C2, mnL);
    for (int r = 0; r < 16; ++r) p0[r] = __builtin_amdgcn_exp2f(p0[r]);
}
__device__ __forceinline__ void finishSM(f32x16& p0, f32x16& p1, float alpha, float& l_reg, bf16x8& pa0, bf16x8& pa1, bf16x8& pa2, bf16x8& pa3) {
    for (int r = 0; r < 16; ++r) p1[r] = __builtin_amdgcn_exp2f(p1[r]);
    float ps = 0; for (int r = 0; r < 16; ++r) ps += p0[r]; for (int r = 0; r < 16; ++r) ps += p1[r];
    { auto rr = __builtin_amdgcn_permlane32_swap(__float_as_uint(ps), __float_as_uint(ps), false, false);
      ps = __uint_as_float(rr[0]) + __uint_as_float(rr[1]); }
    l_reg = l_reg * alpha + ps;
#define PK4(P, B_, OUT) do { unsigned a0 = cvtpk(P[B_+0], P[B_+1]), a1 = cvtpk(P[B_+2], P[B_+3]);                          \
        unsigned b0 = cvtpk(P[B_+4], P[B_+5]), b1 = cvtpk(P[B_+6], P[B_+7]);                                             \
        auto r0 = __builtin_amdgcn_permlane32_swap(a0, b0, false, false); auto r1 = __builtin_amdgcn_permlane32_swap(a1, b1, false, false); \
        u32x4 w = {r0[0], r1[0], r0[1], r1[1]}; OUT = *reinterpret_cast<bf16x8*>(&w); } while (0)
    PK4(p0, 0, pa0); PK4(p0, 8, pa1); PK4(p1, 0, pa2); PK4(p1, 8, pa3);
#undef PK4
}
template <int KB, bool SK>
__device__ __forceinline__ void qkt(f32x16& p0, f32x16& p1, const char* K_lds, int r32, int hi, const bf16x8* qr, bool act) {
    if (SK && !act) { const float NEG = -__builtin_inff();
#pragma unroll
        for (int r = 0; r < 16; ++r) { p0[r] = NEG; p1[r] = NEG; } return; }
    p0 = f32x16{}; p1 = f32x16{};
    const char* kb[4];
#pragma unroll
    for (int dd = 0; dd < 4; ++dd) kb[dd] = K_lds + KB * SHM_K + KSWZ(r32, (dd * 16 + hi * 8) * 2);
#pragma unroll
    for (int d0 = 0; d0 < 8; ++d0) { const char* a = kb[d0 & 3] + (d0 >> 2) * 128;
        bf16x8 b0 = *reinterpret_cast<const bf16x8*>(a);
        bf16x8 b1 = *reinterpret_cast<const bf16x8*>(a + 32 * 256);
        p0 = __builtin_amdgcn_mfma_f32_32x32x16_bf16(b0, qr[d0], p0, 0, 0, 0);
        p1 = __builtin_amdgcn_mfma_f32_32x32x16_bf16(b1, qr[d0], p1, 0, 0, 0); }
}
template <int VB, bool SK>
__device__ __forceinline__ void pv_tile(f32x16* o, int vb0, bf16x8 pa0, bf16x8 pa1, bf16x8 pa2, bf16x8 pa3, bool act) {
    if (SK && !act) return;
#define TRRD(dst, off) asm volatile("ds_read_b64_tr_b16 %0, %1 offset:%2" : "=&v"(dst) : "v"(vb0), "i"(off) : "memory")
#define PV_D0(d0) do { s16x4 l0, l1, l2, l3, h0, h1, h2, h3; constexpr int b_ = VB * SHM_V + v_rd_off(d0, 0, 0);     \
        TRRD(l0, b_); TRRD(h0, b_ + 2048); TRRD(l1, b_ + 4096); TRRD(h1, b_ + 6144); TRRD(l2, b_ + 8192); TRRD(h2, b_ + 10240); TRRD(l3, b_ + 12288); TRRD(h3, b_ + 14336); \
        asm volatile("s_waitcnt lgkmcnt(0)" ::: "memory"); SBAR();                 \
        o[d0] = __builtin_amdgcn_mfma_f32_32x32x16_bf16(pa0, (bf16x8){l0[0], l0[1], l0[2], l0[3], h0[0], h0[1], h0[2], h0[3]}, o[d0], 0, 0, 0);   \
        o[d0] = __builtin_amdgcn_mfma_f32_32x32x16_bf16(pa1, (bf16x8){l1[0], l1[1], l1[2], l1[3], h1[0], h1[1], h1[2], h1[3]}, o[d0], 0, 0, 0);   \
        o[d0] = __builtin_amdgcn_mfma_f32_32x32x16_bf16(pa2, (bf16x8){l2[0], l2[1], l2[2], l2[3], h2[0], h2[1], h2[2], h2[3]}, o[d0], 0, 0, 0);   \
        o[d0] = __builtin_amdgcn_mfma_f32_32x32x16_bf16(pa3, (bf16x8){l3[0], l3[1], l3[2], l3[3], h3[0], h3[1], h3[2], h3[3]}, o[d0], 0, 0, 0); } while (0)
    PV_D0(0); PV_D0(1); PV_D0(2); PV_D0(3);
#undef PV_D0
#undef TRRD
}

template <class TIn, class TOut> struct BlockRef { const TIn* Q; const TIn* K; const TIn* V; TOut* O; const unsigned long long* M; int P0; };
template <class TIn> struct Seam {
    bf16x8 qr[8];
    bf16x8 st_v0, st_v1, st_k0, st_k1; f32x4 sf0, sf1, sf2, sf3;
    f32x4 tq[16];
};
__device__ __forceinline__ int swa_jlo(int P0, int W) { const int lowk = P0 - W + 1; return lowk > 0 ? lowk / KVBLK : 0; }
#define ROW(p, k0, rr) ((p) + (size_t)((k0) + (rr)) * LDQKV + sc)
#define VMW() asm volatile("s_waitcnt vmcnt(0)" ::: "memory")
#define VMWN(n) asm volatile("s_waitcnt vmcnt(%0)" :: "i"(n) : "memory")
#define LD16U(base, off) (*reinterpret_cast<const bf16x8*>((const char*)(base) + (off)))
#define SLOAD_H(Kp, Vp, k0) do { const char* kb_ = (const char*)((Kp) + (size_t)(k0) * LDQKV); const char* vb_ = (const char*)((Vp) + (size_t)(k0) * LDQKV);                 \
                         S.st_v0 = LD16U(vb_, soff); S.st_v1 = LD16U(vb_ + (size_t)32 * LDQKV * 2, soff);                                  \
                         S.st_k0 = LD16U(kb_, soff); S.st_k1 = LD16U(kb_ + (size_t)32 * LDQKV * 2, soff); } while (0)
#define SWRITE_HK(bf) do { *(bf16x8*)(K_lds + (bf) * SHM_K + kws) = S.st_k0; *(bf16x8*)(K_lds + (bf) * SHM_K + kws + 32 * 256) = S.st_k1; } while (0)
#define SWRITE_HV(bf) do { *(bf16x8*)(V_lds + (bf) * SHM_V + vst0) = S.st_v0; *(bf16x8*)(V_lds + (bf) * SHM_V + vst1) = S.st_v1; } while (0)
#define SWRITE_H(bf) do { SWRITE_HV(bf); SWRITE_HK(bf); } while (0)
#define SLOAD_F(p, k0) do { S.sf0 = *(const f32x4*)ROW(p, k0, sr); S.sf1 = *(const f32x4*)(ROW(p, k0, sr) + 4);                \
                            S.sf2 = *(const f32x4*)ROW(p, k0, 32 + sr); S.sf3 = *(const f32x4*)(ROW(p, k0, 32 + sr) + 4); } while (0)
#define SWRITE_KF(bf) do { *(bf16x8*)(K_lds + (bf) * SHM_K + kws) = pack8(S.sf0, S.sf1); *(bf16x8*)(K_lds + (bf) * SHM_K + kws + 32 * 256) = pack8(S.sf2, S.sf3); } while (0)
#define SWRITE_VF(bf) do { *(bf16x8*)(V_lds + (bf) * SHM_V + vst0) = pack8(S.sf0, S.sf1); *(bf16x8*)(V_lds + (bf) * SHM_V + vst1) = pack8(S.sf2, S.sf3); } while (0)
template <class TIn, class TOut>
__device__ __forceinline__ void causal_swa_prime(const BlockRef<TIn, TOut>& cur, int W, char* lds, Seam<TIn>& S) {
    constexpr bool F32 = same_t<TIn, float>::v;
    int tid_o = my_tid(); asm volatile("" : "+v"(tid_o));
    const int tid = tid_o, wid = __builtin_amdgcn_readfirstlane(tid >> 6), lane = tid & 63, r32 = lane & 31, hi = lane >> 5;
    const int sr = tid >> 4, sc = (tid & 15) * 8, kws = KSWZ(sr, sc * 2); char* K_lds = lds + 2 * SHM_V; const unsigned soff = (unsigned)(sr * LDQKV + sc) * 2u;
    const int kb0 = swa_jlo(cur.P0, W) * KVBLK;
    for (int d0 = 0; d0 < 8; ++d0) S.qr[d0] = load8<TIn>(cur.Q + (size_t)(wid * QBLK + r32) * LDQKV + d0 * 16 + hi * 8);
    if constexpr (F32) { SLOAD_F((const float*)cur.K, kb0); VMW(); SWRITE_KF(0); SBAR(); SLOAD_F((const float*)cur.V, kb0); }
    else { SLOAD_H(cur.K, cur.V, kb0); VMW(); SWRITE_HK(0); }
    __syncthreads();
}
template <class TIn, class TOut>
__device__ __forceinline__ void causal_swa_block(const BlockRef<TIn, TOut>& cur, const BlockRef<TIn, TOut>& nxt, int skv, int W, char* lds, Seam<TIn>& S) {
    constexpr bool F32 = same_t<TIn, float>::v;
    int tid_o = my_tid(); asm volatile("" : "+v"(tid_o));
    const int tid = tid_o, wid = __builtin_amdgcn_readfirstlane(tid >> 6), lane = tid & 63, r32 = lane & 31, hi = lane >> 5;
    const int j_lo = swa_jlo(cur.P0, W);
    int j_hi = (cur.P0 + QB - 1) / KVBLK + 1; if (j_hi > skv / KVBLK) j_hi = skv / KVBLK;
    const int NT = j_hi - j_lo;
    const int kbn = swa_jlo(nxt.P0, W) * KVBLK;
    const int qlo = cur.P0 + wid * QBLK, qm = qlo + r32 - 4 * hi;
    char* V_lds = lds; char* K_lds = lds + 2 * SHM_V;
    float* ws = (float*)(lds + 2 * SHM_V + 2 * SHM_K) + wid * 64; float* li_l = ws, * al_l = ws + 32;
    float m_reg = -1e30f, l_reg = 0; f32x16 o[4] = {};
    const unsigned soff = (unsigned)((tid >> 4) * LDQKV + (tid & 15) * 8) * 2u;
    const int sr = tid >> 4, sc = (tid & 15) * 8, vst0 = v_st(sr, sc), vst1 = v_st(32 + sr, sc), kws = KSWZ(sr, sc * 2);
    const int vb0 = (int)(uintptr_t)V_lds + v_rd_base(lane);
    const TIn* Kh = cur.K; const TIn* Vh = cur.V;
#define RESC(a) do { if (__any((a) < 1.f)) { if (hi == 0) al_l[r32] = (a); asm volatile("s_waitcnt lgkmcnt(0)" ::: "memory");              \
                     for (int d_ = 0; d_ < 4; ++d_) for (int r = 0; r < 16; ++r) o[d_][r] *= al_l[crow(r, hi)]; } } while (0)
#define KBASE(t) ((j_lo + (t)) * KVBLK)
#define ACT(t) (KBASE(t) <= qlo + QBLK - 1 && KBASE(t) + KVBLK - 1 >= qlo - W + 1)
#define MASKT(P0_, P1_, mw_) mask_bits(P0_, P1_, mw_, hi)
#define MLOAD(t) mask_word((const char*)cur.M + (size_t)((j_lo + (t)) * 8), wid * QBLK + r32)
    constexpr int NQL = F32 ? 16 : 8;
    constexpr bool SK = WSKIP && !F32;
#define SEAM_K0() do { VMWN(NQL); if constexpr (F32) { SWRITE_KF(0); SBAR(); SLOAD_F((const float*)nxt.V, kbn); } else { SWRITE_HK(0); } SBAR(); } while (0)
    f32x16 pA0, pA1, pB0, pB1; float mnA, mnB, alA, alB; bf16x8 pa0, pa1, pa2, pa3;
    if constexpr (F32) { VMW(); SWRITE_VF(0); SBAR(); } else { SWRITE_HV(0); SBAR(); }
    if (NT > 1) { if constexpr (F32) SLOAD_F((const float*)Kh, KBASE(1)); else SLOAD_H(Kh, Vh, KBASE(1)); }
    SBAR(); qkt<0, SK>(pA0, pA1, K_lds, r32, hi, S.qr, ACT(0));
    if constexpr (F32) { if (NT > 1) { VMW(); SWRITE_KF(1); SBAR(); SLOAD_F((const float*)Vh, KBASE(1)); } }
    MASKT(pA0, pA1, MLOAD(0)); partialSM(pA0, pA1, m_reg, mnA, alA);
    if (NT > 1) { VMW(); if constexpr (F32) { SWRITE_VF(1); SBAR(); if (NT > 2) SLOAD_F((const float*)Kh, KBASE(2)); } else SWRITE_H(1); }
    __syncthreads();
#define HALF_STEP(PX0, PX1, mnX, alX, PY0, PY1, alY, t, KB, VB, SB) do {                                                      \
        SBAR(); qkt<KB, SK>(PX0, PX1, K_lds, r32, hi, S.qr, ACT(t));                                             \
        finishSM(PY0, PY1, alY, l_reg, pa0, pa1, pa2, pa3); SBAR();                                                           \
        if ((t) + 1 < NT) { if constexpr (F32) { VMW(); SWRITE_KF(SB); SBAR(); SLOAD_F((const float*)Vh, KBASE((t) + 1)); }  \
                            else { SLOAD_H(Kh, Vh, KBASE((t) + 1)); } SBAR(); }                                               \
        pv_tile<VB, SK>(o, vb0, pa0, pa1, pa2, pa3, ACT((t) - 1)); MASKT(PX0, PX1, MLOAD(t)); partialSM(PX0, PX1, m_reg, mnX, alX);                                        \
        __syncthreads();                                                                                                      \
        if ((t) + 1 < NT) { VMW(); if constexpr (F32) { SWRITE_VF(SB); SBAR(); if ((t) + 2 < NT) SLOAD_F((const float*)Kh, KBASE((t) + 2)); } \
                            else { SWRITE_H(SB); } }                                                                          \
        RESC(alX); __syncthreads(); } while (0)
    for (int t = 1; t + 1 < NT; t += 2) {
        HALF_STEP(pB0, pB1, mnB, alB, pA0, pA1, alA, t, 1, 0, 0);
        HALF_STEP(pA0, pA1, mnA, alA, pB0, pB1, alB, t + 1, 0, 1, 1);
    }
    const bool even = (NT & 1) == 0;
    if (even) { SBAR(); qkt<1, SK>(pB0, pB1, K_lds, r32, hi, S.qr, ACT(NT - 1)); SBAR(); }
#define QROW(e) (nxt.Q + (size_t)(wid * QBLK + r32) * LDQKV + ((e) >> 1) * 16 + hi * 8 + ((e) & 1) * 4)
    if constexpr (F32) { SLOAD_F((const float*)nxt.K, kbn); SBAR();
#pragma unroll
        for (int e = 0; e < 8; ++e) S.tq[e] = *(const f32x4*)QROW(e); }
    else { SLOAD_H(nxt.K, nxt.V, kbn); SBAR();
#pragma unroll
        for (int d0 = 0; d0 < 8; ++d0) S.qr[d0] = load8<TIn>(nxt.Q + (size_t)(wid * QBLK + r32) * LDQKV + d0 * 16 + hi * 8); }
    SBAR();
    finishSM(pA0, pA1, alA, l_reg, pa0, pa1, pa2, pa3); SBAR();
    if constexpr (F32) {
#pragma unroll
        for (int e = 8; e < 16; ++e) S.tq[e] = *(const f32x4*)QROW(e); SBAR(); }
#undef QROW
    pv_tile<0, SK>(o, vb0, pa0, pa1, pa2, pa3, ACT(even ? NT - 2 : NT - 1));
    if (even) { MASKT(pB0, pB1, MLOAD(NT - 1)); partialSM(pB0, pB1, m_reg, mnB, alB); __syncthreads(); RESC(alB);
        finishSM(pB0, pB1, alB, l_reg, pa0, pa1, pa2, pa3); SBAR(); pv_tile<1, SK>(o, vb0, pa0, pa1, pa2, pa3, ACT(NT - 1)); }
    SBAR(); SEAM_K0();
    if (hi == 0) li_l[r32] = l_reg; asm volatile("s_waitcnt lgkmcnt(0)" ::: "memory");
    float rli[16];
#pragma unroll
    for (int r = 0; r < 16; ++r) rli[r] = __builtin_amdgcn_rcpf(li_l[crow(r, hi)]);
    TOut* Ow = cur.O + (size_t)(wid * QBLK) * LDO;
#pragma unroll
    for (int r = 0; r < 16; ++r) { const int orow = crow(r, hi);
#pragma unroll
        for (int d0 = 0; d0 < 4; ++d0) { const float v = o[d0][r] * rli[r];
            if constexpr (same_t<TOut, float>::v) { Ow[(size_t)orow * LDO + d0 * 32 + r32] = v; }
            else { const float vn = __builtin_bit_cast(float, __builtin_amdgcn_update_dpp(0, __builtin_bit_cast(int, v), 0xB1, 0xf, 0xf, false));
                   if ((r32 & 1) == 0) *(unsigned*)(Ow + (size_t)orow * LDO + d0 * 32 + r32) = cvtpk(v, vn); } } }
    if constexpr (F32) {
#pragma unroll
        for (int d0 = 0; d0 < 8; ++d0) S.qr[d0] = pack8(S.tq[2 * d0], S.tq[2 * d0 + 1]); }
    __syncthreads();
#undef RESC
#undef KBASE
#undef ACT
#undef MASKT
#undef MLOAD
#undef SEAM_K0
#undef HALF_STEP
}
#undef ROW
#undef VMW
#undef VMWN
#undef SLOAD_H
#undef LD16U
#undef SWRITE_HK
#undef SWRITE_HV
#undef SWRITE_H
#undef SLOAD_F
#undef SWRITE_KF
#undef SWRITE_VF

}


template <int NC> __device__ __forceinline__ void scan_elems(const bf16* __restrict__ delta, bf16* __restrict__ prev, size_t cstride, const LAS float* dec, const LAS float* inj) {
    f32x4 st = (f32x4){0.f, 0.f, 0.f, 0.f};
#pragma unroll 8
    for (int c = 0; c < NC; ++c) { const v2u x = *(const GAS v2u*)(delta + (size_t)c * cstride);
        v2u o; o.x = pk2(st[0], st[1]); o.y = pk2(st[2], st[3]); *(GAS v2u*)(prev + (size_t)c * cstride) = o;
        const float d = dec[c], j = inj[c];
        st[0] = d * st[0] + j * __uint_as_float(x.x << 16); st[1] = d * st[1] + j * __uint_as_float(x.x & 0xffff0000u);
        st[2] = d * st[2] + j * __uint_as_float(x.y << 16); st[3] = d * st[3] + j * __uint_as_float(x.y & 0xffff0000u); }
}

struct Args {
    const float* x; const float* norm_mix; const float* norm_ffn; const float* w_in; const float* att_q_norm; const float* att_k_norm; const float* mlstm_conv; const float* mlstm_gate_bias;
    const float* mlstm_out_norm; const float* ret_out_norm; const float* w_b_att; const float* w_b_mlstm; const float* w_b_ret; const float* w_out; const float* w_ffn_in; const float* w_ffn_out;
    float* out; unsigned char* ws; int layer_lo, layer_hi, ph_lo, ph_hi;
};
constexpr int PH_PER_LAYER = 16;
__device__ __forceinline__ float ret_lngamma(int hd) { return log1pf(-exp2f(-5.0f - (float)hd)); }
#define PHASE_FN static __device__ __forceinline__ void
#define OPAQUE_PTR(p) asm volatile("" : "+s"(p))
#define WS_PTRS(ws) OPAQUE_PTR(ws); \
    bf16* const H = (bf16*)((ws) + WS_H); bf16* const PROJ = (bf16*)((ws) + WS_PROJ); float* const SMALL = (float*)((ws) + WS_SMALL); bf16* const MQK = (bf16*)((ws) + WS_MQK); \
    bf16* const IKB = (bf16*)((ws) + WS_IKB); unsigned char* const IWF = (unsigned char*)((ws) + WS_IWF); float* const GIF = (float*)((ws) + WS_GIF); float* const SC = (float*)((ws) + WS_SC); \
    unsigned long long* const MB = (unsigned long long*)((ws) + WS_MB); bf16* const DCM = (bf16*)((ws) + WS_DCM); bf16* const CPM = (bf16*)((ws) + WS_CPM); \
    float* const DN = (float*)((ws) + WS_MISC + MISC_DN); float* const NPREV = (float*)((ws) + WS_MISC + MISC_NPREV); float* const AB = (float*)((ws) + WS_MISC + MISC_AB); float* const MPREV = (float*)((ws) + WS_MISC + MISC_MPREV); \
    bf16* const DRR = (bf16*)((ws) + WS_DRR); bf16* const RPR = (bf16*)((ws) + WS_RPR); bf16* const YA = (bf16*)((ws) + WS_YA); bf16* const YM = (bf16*)((ws) + WS_YM); bf16* const YR = (bf16*)((ws) + WS_YR); \
    float* const MERGEDF = (float*)((ws) + WS_MERGEDF); bf16* const MERGED = (bf16*)((ws) + WS_MERGED); bf16* const ACT = (bf16*)((ws) + WS_ACT); \
    float* const ROPE128 = (float*)((ws) + WS_ROPE128); float* const ROPE64 = (float*)((ws) + WS_ROPE64); \
    (void)H; (void)PROJ; (void)SMALL; (void)MQK; (void)IKB; (void)IWF; (void)GIF; (void)SC; (void)MB; (void)DCM; (void)CPM; (void)DN; (void)NPREV; (void)AB; (void)MPREV; (void)DRR; (void)RPR; (void)YA; (void)YM; (void)YR; \
    (void)MERGEDF; (void)MERGED; (void)ACT; (void)ROPE128; (void)ROPE64
#define TIDS() int tid_ = my_tid(); asm volatile("" : "+v"(tid_)); int bx_ = blockIdx.x; asm volatile("" : "+s"(bx_));   \
    const int tid = tid_, lane = tid & 63, wave = __builtin_amdgcn_readfirstlane(tid >> 6); const int G = gridDim.x, bx = bx_; const int gw = bx * NWAVES + wave, NGW = G * NWAVES; \
    (void)lane; (void)wave; (void)gw; (void)NGW; (void)G; (void)bx

constexpr int CV_IN = 32 * 268, CV_B = 16 * 32, CV_OUT = 32 * 32, CV_FIN = 32 * 176, CV_FOUT = 88 * 32, CV_ITEMS = CV_IN + 3 * CV_B + CV_OUT + CV_FIN + CV_FOUT;
__device__ __forceinline__ void convert_layer_items(LAS float* scr, unsigned char* ws, int l, const float* w_in, const float* w_b_att, const float* w_b_mlstm, const float* w_b_ret, const float* w_out, const float* w_ffn_in,
                                                    const float* w_ffn_out, int it0, int it1, int wv, int nwv, int lane) {
    unsigned char* wl = ws + WS_W + (size_t)l * W_LAYER;
    for (int it = it0 + wv; it < it1; it += nwv) { int r = it;
        if (r < CV_IN) { transpose_item(w_in + (size_t)l * DM * LPROJ, DM, LPROJ, (bf16*)(wl + WO_IN), scr, r, NPROJ_PAD / 64, lane, MapWin()); continue; } r -= CV_IN;
        if (r < CV_B) { transpose_item(w_b_att + (size_t)l * 1024 * DM, 1024, DM, (bf16*)(wl + WO_B), scr, r, DM / 64, lane, MapIdent()); continue; } r -= CV_B;
        if (r < CV_B) { transpose_item(w_b_mlstm + (size_t)l * 1024 * DM, 1024, DM, (bf16*)(wl + WO_B + 4 * MiB), scr, r, DM / 64, lane, MapIdent()); continue; } r -= CV_B;
        if (r < CV_B) { transpose_item(w_b_ret + (size_t)l * 1024 * DM, 1024, DM, (bf16*)(wl + WO_B + 8 * MiB), scr, r, DM / 64, lane, MapIdent()); continue; } r -= CV_B;
        if (r < CV_OUT) { transpose_item(w_out + (size_t)l * DM * DM, DM, DM, (bf16*)(wl + WO_OUT), scr, r, DM / 64, lane, MapIdent()); continue; } r -= CV_OUT;
        if (r < CV_FIN) { transpose_item(w_ffn_in + (size_t)l * DM * 2 * FF, DM, 2 * FF, (bf16*)(wl + WO_FIN), scr, r, 2 * FF / 64, lane, MapFfn()); continue; } r -= CV_FIN;
        transpose_item(w_ffn_out + (size_t)l * FF * DM, FF, DM, (bf16*)(wl + WO_FOUT), scr, r, DM / 64, lane, MapIdent()); }
}
PHASE_FN ph_prologue(LAS unsigned char* lds, unsigned char* ws, const float* w_in, const float* w_b_att, const float* w_b_mlstm, const float* w_b_ret, const float* w_out, const float* w_ffn_in, const float* w_ffn_out, bool all_layers) {
    TIDS(); WS_PTRS(ws);
    LAS float* scr = (LAS float*)(lds + wave * 16640);
    for (int l = 0; l < (all_layers ? DEPTH : 1); ++l) convert_layer_items(scr, ws, l, w_in, w_b_att, w_b_mlstm, w_b_ret, w_out, w_ffn_in, w_ffn_out, 0, CV_ITEMS, gw, NGW, lane);
    for (int i = gw * 64 + lane; i < S * 96; i += NGW * 64) {
        if (i < S * 64) { const int t = i >> 6, f = i & 63; const float inv = (float)pow(10000.0, -(double)f * 2.0 / 128.0); const float ang = (float)t * inv;
            ROPE128[2 * i] = (float)cos((double)ang); ROPE128[2 * i + 1] = (float)sin((double)ang); }
        else { const int k = i - S * 64, t = k >> 5, f = k & 31; const float inv = (float)pow(10000.0, -(double)f * 2.0 / 64.0); const float ang = (float)t * inv;
            ROPE64[2 * k] = (float)cos((double)ang); ROPE64[2 * k + 1] = (float)sin((double)ang); } }
}
PHASE_FN ph_convert_tail(LAS unsigned char* lds, unsigned char* ws, int l, const float* w_in, const float* w_b_att, const float* w_b_mlstm, const float* w_b_ret, const float* w_out, const float* w_ffn_in, const float* w_ffn_out,
                         int rem, int it0, int it1) {
    TIDS(); if (rem <= 0 || rem >= G || bx < rem) return;
    LAS float* scr = (LAS float*)(lds + wave * 16640);
    convert_layer_items(scr, ws, l, w_in, w_b_att, w_b_mlstm, w_b_ret, w_out, w_ffn_in, w_ffn_out, it0, it1, (bx - rem) * NWAVES + wave, (G - rem) * NWAVES, lane);
    __syncthreads(); }
PHASE_FN ph_rmsnorm(const float* xin, const float* gain, bf16* Hout) { TIDS(); for (int m = gw; m < S; m += NGW) rms_row_to_bf16(xin + (size_t)m * DM, gain, Hout + (size_t)m * DM, lane); }
PHASE_FN ph_gemm_proj(LAS unsigned char* lds, unsigned char* ws, const bf16* Wt) { TIDS(); WS_PTRS(ws);
    pg8::Gemm g{H, Wt, S, NPROJ_PAD, DM}; pg8::StaticOrder so; so.init(S, NPROJ_PAD, G, bx); pg8::EpiProj E{PROJ, NPROJ, SMALL, PC_G / 256, NPROJ / 256};
    pg8::gemm_phase<pg8::EpiProj, pg8::StaticOrder, true, true>(lds, g, so, E); }
PHASE_FN ph_pp(unsigned char* ws, const float* gq, const float* gk, const float* convw, const float* gbias) { TIDS(); WS_PTRS(ws);
    PPArgs a{PROJ, SMALL, MQK, IKB, IWF, GIF, ROPE128, ROPE64, gq, gk, convw, gbias};
    f32x4 cw[16];
#pragma unroll
    for (int j = 0; j < 4; ++j)
#pragma unroll
        for (int q = 0; q < 4; ++q) cw[j * 4 + q] = *(const f32x4*)(convw + j * 1024 + 16 * lane + 4 * q);
    for (int m = gw; m < S; m += NGW) pp_row(a, m, lane, cw); }
PHASE_FN ph_scores(LAS unsigned char* lds, unsigned char* ws) { TIDS(); WS_PTRS(ws);
    LAS unsigned char* iqt = lds; LAS unsigned char* wt = lds + IQT_BYTES + wave * (32 * SCT_RS);
    for (int u = bx; u < 1152; u += G) { int m = 0; while (16 * (m + 1) * (m + 2) <= u) ++m;
        const int r = u - 16 * m * (m + 1), qb = 32 * m + r / (m + 1), c = r % (m + 1), nkb = (qb >> 1) + 1, k0 = 16 * c, k1 = (k0 + 16 < nkb) ? k0 + 16 : nkb;
        {   const int row = tid >> 4, part = tid & 15; const bf16* src = PROJ + (size_t)(qb * 32 + row) * NPROJ + PC_IQ;
#pragma unroll
            for (int i = 0; i < 4; ++i) *(LAS v4u*)(iqt + row * IQT_RS + part * 16 + 256 * i) = *(const GAS v4u*)(src + part * 8 + 128 * i); }
        __syncthreads();
        for (int kb = k0 + wave; kb < k1; kb += NWAVES) score_wave_unit(wt, iqt, IKB, IWF, SC, qb, kb, lane);
        __syncthreads(); }
}
PHASE_FN ph_deltas(LAS unsigned char* lds, unsigned char* ws) { TIDS(); WS_PTRS(ws); LAS float* const sf = (LAS float*)(lds + SCR_OFF);
    for (int u = bx; u < 1024; u += G) {
        if (u < 512) { const int hd = u >> 7, c = u & 127, t0 = c * 64;
            if (wave == 0) { const float iv = GIF[(size_t)(t0 + lane) * 8 + hd], fv = GIF[(size_t)(t0 + lane) * 8 + 4 + hd]; float b = log_sigmoid_f(fv);
                b = wave_prefix_sum_f(b);
                const float bend = __builtin_bit_cast(float, __builtin_amdgcn_readlane(__builtin_bit_cast(int, b), 63)), gl = bend - b + iv, A = wave_max(gl);
                sf[lane] = __expf(gl - A); if (lane == 0) { AB[(hd * 128 + c) * 2] = A; AB[(hd * 128 + c) * 2 + 1] = bend; } }
            __syncthreads();
            chunk_delta<64, 256>(lds, MQK + (size_t)t0 * 1024 + 512 + hd * 128, 1024, PROJ + (size_t)t0 * NPROJ + PC_MV + hd * 256, NPROJ, sf, DCM + (size_t)(hd * 128 + c) * 32768, DN + (hd * 128 + c) * 128, tid);
        } else { const int v = u - 512, hd = v >> 6, c = v & 63, t0 = c * 128; const float lg = ret_lngamma(hd);
            if (tid < 128) sf[tid] = __expf(lg * (float)(127 - tid));
            __syncthreads();
            chunk_delta<128, 128>(lds, PROJ + (size_t)t0 * NPROJ + PC_RK + hd * 128, NPROJ, PROJ + (size_t)t0 * NPROJ + PC_RV + hd * 128, NPROJ, sf, DRR + (size_t)(hd * 64 + c) * 16384, nullptr, tid); }
    } }
PHASE_FN ph_select(LAS unsigned char* lds, unsigned char* ws) { TIDS(); WS_PTRS(ws); select_rows_wg(lds, SC, MB, bx, G, tid); }
PHASE_FN ph_scans(LAS unsigned char* lds, unsigned char* ws) { TIDS(); WS_PTRS(ws); LAS float* const sf = (LAS float*)(lds + SCR_OFF);
    for (int u = bx; u < 128; u += G) {
        LAS float* dec = sf; LAS float* inj = sf + 128; LAS float* av = sf + 256; LAS float* bv = sf + 384;
        if (u < 64) { const int hd = u >> 4, p = u & 15;
            if (tid < 128) { av[tid] = AB[(hd * 128 + tid) * 2]; bv[tid] = AB[(hd * 128 + tid) * 2 + 1]; }
            __syncthreads();
            if (tid == 0) { float m = 0.f; for (int c = 0; c < 128; ++c) { const float mn = fmaxf(bv[c] + m, av[c]); dec[c] = __expf(bv[c] + m - mn); inj[c] = __expf(av[c] - mn); if (p == 0) MPREV[hd * 128 + c] = m; m = mn; } }
            __syncthreads();
            const size_t e4 = (size_t)hd * 128 * 32768 + p * 2048 + tid * 4;
            scan_elems<128>(DCM + e4, CPM + e4, 32768, dec, inj);
            if (p == 0 && tid < 128) { float st = 0.f; for (int c = 0; c < 128; ++c) { NPREV[(hd * 128 + c) * 128 + tid] = st; st = dec[c] * st + inj[c] * DN[(hd * 128 + c) * 128 + tid]; } }
        } else { const int v = u - 64, hd = v >> 3, p = v & 7; const float dg = __expf(128.0f * ret_lngamma(hd));
            if (tid < 64) { dec[tid] = dg; inj[tid] = 1.0f; }
            __syncthreads();
            const size_t e4 = (size_t)hd * 64 * 16384 + p * 2048 + tid * 4;
            scan_elems<64>(DRR + e4, RPR + e4, 16384, dec, inj); }
        __syncthreads(); } }
PHASE_FN ph_attention(char* alds, unsigned char* ws) { TIDS(); WS_PTRS(ws);
    typedef att::BlockRef<bf16, bf16> BR; att::Seam<bf16> seam;
#define ATT_REF(r, item_, pass_) do { const int hd_ = (item_) >> 4, y_ = (item_) & 15, qb_ = (pass_) ? 31 - y_ : y_; \
        (r).Q = PROJ + (size_t)qb_ * 256 * NPROJ + PC_AQ + hd_ * 128; (r).K = PROJ + PC_AK + hd_ * 128; (r).V = PROJ + PC_AV + hd_ * 128; (r).O = YA + (size_t)qb_ * 256 * 1024 + hd_ * 128; \
        (r).M = MB + (size_t)qb_ * 256 * 128; (r).P0 = qb_ * 256; } while (0)
    if (bx < 128) { int item = bx, pass = 0; BR cur; ATT_REF(cur, item, 0); att::causal_swa_prime<bf16, bf16>(cur, 1 << 30, alds, seam);
        for (;;) { const bool more_pass = pass == 0, more_item = item + G < 128, last = !more_pass && !more_item;
            int itn = item, pn = pass + 1; if (!more_pass) { pn = 0; itn = more_item ? item + G : item; }
            BR nxt = cur; if (!last) ATT_REF(nxt, itn, pn);
            att::causal_swa_block<bf16, bf16>(cur, nxt, S, 1 << 30, alds, seam);
            if (last) break; cur = nxt; item = itn; pass = pn; } }
    __syncthreads(); }
PHASE_FN ph_outs(LAS unsigned char* lds, unsigned char* ws, const float* gain_m, const float* gain_r, int u0, int ustep) { TIDS(); WS_PTRS(ws); LAS float* const sf = (LAS float*)(lds + SCR_OFF);
    for (int u = u0; u < 1024; u += ustep) {
        if (u < 512) { const int hd = u >> 7, c = u & 127, t0 = c * 64;
            if (wave == 0) { const float iv = GIF[(size_t)(t0 + lane) * 8 + hd], fv = GIF[(size_t)(t0 + lane) * 8 + 4 + hd]; float b = log_sigmoid_f(fv);
                b = wave_prefix_sum_f(b);
                const float mp = MPREV[hd * 128 + c]; const float pm = wave_prefix_max_f(iv - b);
                const float mt = fmaxf(b + mp, b + pm);
                sf[lane] = b - mt; sf[128 + lane] = iv - b; sf[256 + lane] = __expf(b + mp - mt); sf[384 + lane] = __expf(-mt); sf[512 + lane] = 0.f; }
            if (wave == 1) { sf[640 + lane] = NPREV[(hd * 128 + c) * 128 + lane]; sf[640 + 64 + lane] = NPREV[(hd * 128 + c) * 128 + 64 + lane]; }
            __syncthreads();
            chunk_out<64, 256, 0>(lds, sf, MQK + (size_t)t0 * 1024 + hd * 128, 1024, MQK + (size_t)t0 * 1024 + 512 + hd * 128, 1024, PROJ + (size_t)t0 * NPROJ + PC_MV + hd * 256, NPROJ,
                                  CPM + (size_t)(hd * 128 + c) * 32768, gain_m + hd * 256, PROJ + (size_t)t0 * NPROJ + PC_MO + hd * 256, NPROJ, YM + (size_t)t0 * 1024 + hd * 256, 1024, tid);
        } else { const int v = u - 512, hd = v >> 6, c = v & 63, t0 = c * 128; const float lg = ret_lngamma(hd);
            if (tid < 128) { sf[tid] = lg * (float)tid; sf[128 + tid] = -lg * (float)tid; sf[256 + tid] = __expf(lg * (float)(tid + 1)); }
            __syncthreads();
            chunk_out<128, 128, 1>(lds, sf, PROJ + (size_t)t0 * NPROJ + PC_RQ + hd * 128, NPROJ, PROJ + (size_t)t0 * NPROJ + PC_RK + hd * 128, NPROJ, PROJ + (size_t)t0 * NPROJ + PC_RV + hd * 128, NPROJ,
                                   RPR + (size_t)(hd * 64 + c) * 16384, gain_r + hd * 128, PROJ + (size_t)t0 * NPROJ + PC_RG + hd * 128, NPROJ, YR + (size_t)t0 * 1024 + hd * 128, 1024, tid); }
    } }
template <int MODE> PHASE_FN ph_gemm_branch(LAS unsigned char* lds, unsigned char* ws, const bf16* A, const bf16* Wt, int gcol) { TIDS(); WS_PTRS(ws);
    pg8::Gemm g{A, Wt, S, DM, 1024}; pg8::StaticOrder so; so.init(S, DM, G, bx); pg8::EpiBranch<MODE> E{PROJ + PC_G + gcol, NPROJ, MERGEDF, MERGED, DM};
    pg8::gemm_phase<pg8::EpiBranch<MODE>, pg8::StaticOrder, true, true>(lds, g, so, E); }
PHASE_FN ph_gemm_resid(LAS unsigned char* lds, const bf16* A, const bf16* Wt, int K, const float* base, float* out) { TIDS();
    pg8::Gemm g{A, Wt, S, DM, K}; pg8::StaticOrder so; so.init(S, DM, G, bx); pg8::EpiResid E{base, out, DM};
    pg8::gemm_phase<pg8::EpiResid, pg8::StaticOrder, true, true>(lds, g, so, E); }
PHASE_FN ph_gemm_ffn_in(LAS unsigned char* lds, unsigned char* ws, const bf16* Wt) { TIDS(); WS_PTRS(ws);
    pg8::Gemm g{H, Wt, S, 2 * FF, DM}; pg8::StaticOrder so; so.init(S, 2 * FF, G, bx); pg8::EpiSwiGLU E{ACT, FF};
    pg8::gemm_phase<pg8::EpiSwiGLU, pg8::StaticOrder, true, true>(lds, g, so, E); }


#ifndef SYN_PROBE
#define SYN_PROBE 0
#endif
PHASE_FN ph_probe(LAS unsigned char* lds) { TIDS();
    LAS unsigned* hist = (LAS unsigned*)lds;
    if (SYN_PROBE == 1) {
        unsigned x = (unsigned)tid * 2654435761u + 12345u;
        for (int r = 0; r < 32; ++r) {
#pragma unroll
            for (int i = 0; i < 16; ++i) { x = x * 1664525u + 1013904223u; (void)__hip_atomic_fetch_add(hist + ((x >> 10) & 2047u), 1u, __ATOMIC_RELAXED, __HIP_MEMORY_SCOPE_WORKGROUP); }
            SEL_BAR(); } }
    if (SYN_PROBE == 2) {
        float acc = 0.f; float v[16];
#pragma unroll
        for (int i = 0; i < 16; ++i) v[i] = (float)((tid * 16 + i) % 977);
        for (int r = 0; r < 32 * 8; ++r) { const float c1 = 100.f + (float)(r & 7) + acc * 1e-30f, c2 = c1 * 2.f, c3 = c1 * 3.f; unsigned n1 = 0, n2 = 0, n3 = 0;
#pragma unroll
            for (int i = 0; i < 16; ++i) { n1 += (unsigned)__builtin_popcountll(__builtin_amdgcn_ballot_w64(v[i] >= c1)); n2 += (unsigned)__builtin_popcountll(__builtin_amdgcn_ballot_w64(v[i] >= c2)); n3 += (unsigned)__builtin_popcountll(__builtin_amdgcn_ballot_w64(v[i] >= c3)); }
            if (lane == 0) { hist[(r & 1) * 24 + wave] = n1; hist[(r & 1) * 24 + 8 + wave] = n2; hist[(r & 1) * 24 + 16 + wave] = n3; }
            SEL_BAR();
            unsigned t1 = 0;
#pragma unroll
            for (int j = 0; j < 24; ++j) t1 += hist[(r & 1) * 24 + j];
            acc += (float)t1; }
        if (acc == 12345.f) hist[100] = 1u; }
    if (SYN_PROBE == 3) {
        float a = (float)tid;
        for (int r = 0; r < 32; ++r) {
#pragma unroll
            for (int k = 0; k < 4; ++k)
#pragma unroll
                for (int o = 1; o < 64; o <<= 1) a = fmaxf(a, shfl_idx_f(a, (int)(lane_id_v() ^ (unsigned)o)) * 0.999f);
        }
        if (a == 12345.f) hist[100] = 1u; }
    __syncthreads(); }
typedef const __attribute__((address_space(4))) Args* ArgsP;
__device__ __forceinline__ ArgsP fresh_args() { ArgsP ap = (ArgsP)__builtin_amdgcn_kernarg_segment_ptr(); asm volatile("" : "+s"(ap)); return ap; }
#ifndef DUP_PHASE
#define DUP_PHASE -1
#endif
#define SEAM() do { if constexpr (one_launch) { ArgsP ap_ = fresh_args(); XcdBarrier b_; b_.bar = (unsigned*)(ap_->ws + WS_CTL) + CW_BAR; b_.x = xb_xcc_id(); b_.st = (volatile LAS unsigned*)(lds + MISC_OFF); xcd_barrier(b_); } } while (0)
#define IN(k) (PLO <= (k) && (k) < PHI)
#define WL(ap, layer) ((ap)->ws + WS_W + (size_t)(layer) * W_LAYER)
template <int PLO, int PHI, bool LAST> __device__ __forceinline__ void layer_phases(const int layer, LAS unsigned char* lds, unsigned char* lds_raw) {
    constexpr bool one_launch = (PHI - PLO > 1);
    if constexpr (IN(1)) { ArgsP ap = fresh_args(); ph_rmsnorm(layer == 0 ? ap->x : ap->out, ap->norm_mix + layer * DM, (bf16*)(ap->ws + WS_H)); if constexpr (DUP_PHASE == 1) { SEAM(); ph_rmsnorm(layer == 0 ? ap->x : ap->out, ap->norm_mix + layer * DM, (bf16*)(ap->ws + WS_H)); } SEAM(); }
    constexpr int CV_S1 = 10880, CV_S2 = 10880;
    if constexpr (IN(2)) { ArgsP ap = fresh_args(); ph_gemm_proj(lds, ap->ws, (const bf16*)(WL(ap, layer) + WO_IN));
        if constexpr (one_launch && !LAST) { ArgsP aq = fresh_args(); ph_convert_tail(lds, aq->ws, layer + 1, aq->w_in, aq->w_b_att, aq->w_b_mlstm, aq->w_b_ret, aq->w_out, aq->w_ffn_in, aq->w_ffn_out, ((S / 256) * (NPROJ_PAD / 256)) % (int)gridDim.x, 0, CV_S1); } if constexpr (DUP_PHASE == 2) { SEAM(); ph_gemm_proj(lds, ap->ws, (const bf16*)(WL(ap, layer) + WO_IN)); } SEAM(); }
    if constexpr (IN(3)) { ArgsP ap = fresh_args(); ph_pp(ap->ws, ap->att_q_norm + layer * 128, ap->att_k_norm + layer * 128, ap->mlstm_conv + layer * 4096, ap->mlstm_gate_bias + layer * 8); if constexpr (DUP_PHASE == 23) { SEAM(); ph_gemm_proj(lds, ap->ws, (const bf16*)(WL(ap, layer) + WO_IN)); SEAM(); ph_pp(ap->ws, ap->att_q_norm + layer * 128, ap->att_k_norm + layer * 128, ap->mlstm_conv + layer * 4096, ap->mlstm_gate_bias + layer * 8); } if constexpr (DUP_PHASE == 3) { SEAM(); ph_pp(ap->ws, ap->att_q_norm + layer * 128, ap->att_k_norm + layer * 128, ap->mlstm_conv + layer * 4096, ap->mlstm_gate_bias + layer * 8); } SEAM(); }
    if constexpr (IN(4)) { ArgsP ap = fresh_args(); ph_scores(lds, ap->ws); if constexpr (DUP_PHASE == 4) { SEAM(); ph_scores(lds, ap->ws); } }
    if constexpr (IN(5)) { ArgsP ap = fresh_args(); ph_deltas(lds, ap->ws); if constexpr (DUP_PHASE == 5) { SEAM(); ph_deltas(lds, ap->ws); } SEAM(); }
    if constexpr (IN(6) && SYN_PROBE != 0) { ph_probe(lds); }
    if constexpr (IN(6)) { ArgsP ap = fresh_args(); ph_select(lds, ap->ws); if constexpr (DUP_PHASE == 6) { SEAM(); ph_select(lds, ap->ws); } }
    if constexpr (IN(7) && one_launch && !LAST) { ArgsP aq = fresh_args(); ph_convert_tail(lds, aq->ws, layer + 1, aq->w_in, aq->w_b_att, aq->w_b_mlstm, aq->w_b_ret, aq->w_out, aq->w_ffn_in, aq->w_ffn_out, 128, CV_S1, CV_S2); }
    if constexpr (IN(7)) { ArgsP ap = fresh_args(); ph_scans(lds, ap->ws); if constexpr (DUP_PHASE == 7) { SEAM(); ph_scans(lds, ap->ws); } SEAM(); }
    if constexpr (IN(8) && IN(9)) {
        ArgsP ap = fresh_args(); const bool split = gridDim.x == 256;
        if (!split || blockIdx.x < 128) ph_attention((char*)lds_raw, ap->ws);
        if (!split || blockIdx.x >= 128) ph_outs(lds, ap->ws, ap->mlstm_out_norm + layer * 1024, ap->ret_out_norm + layer * 1024, split ? (int)blockIdx.x - 128 : (int)blockIdx.x, split ? 128 : (int)gridDim.x);
        SEAM(); }
    else {
    if constexpr (IN(8)) { ArgsP ap = fresh_args(); ph_attention((char*)lds_raw, ap->ws); }
    if constexpr (IN(9)) { ArgsP ap = fresh_args(); ph_outs(lds, ap->ws, ap->mlstm_out_norm + layer * 1024, ap->ret_out_norm + layer * 1024, (int)blockIdx.x, (int)gridDim.x); SEAM(); }
    }
    if constexpr (IN(10)) { ArgsP ap = fresh_args(); ph_gemm_branch<0>(lds, ap->ws, (const bf16*)(ap->ws + WS_YA), (const bf16*)(WL(ap, layer) + WO_B), 0); if constexpr (DUP_PHASE == 10) { SEAM(); ph_gemm_branch<0>(lds, ap->ws, (const bf16*)(ap->ws + WS_YA), (const bf16*)(WL(ap, layer) + WO_B), 0); } }
    if constexpr (IN(11)) { ArgsP ap = fresh_args(); ph_gemm_branch<1>(lds, ap->ws, (const bf16*)(ap->ws + WS_YM), (const bf16*)(WL(ap, layer) + WO_B + 4 * MiB), DM); if constexpr (DUP_PHASE == 11) { SEAM(); ph_gemm_branch<1>(lds, ap->ws, (const bf16*)(ap->ws + WS_YM), (const bf16*)(WL(ap, layer) + WO_B + 4 * MiB), DM); } }
    if constexpr (IN(12)) { ArgsP ap = fresh_args(); ph_gemm_branch<2>(lds, ap->ws, (const bf16*)(ap->ws + WS_YR), (const bf16*)(WL(ap, layer) + WO_B + 8 * MiB), 2 * DM); if constexpr (DUP_PHASE == 12) { SEAM(); ph_gemm_branch<2>(lds, ap->ws, (const bf16*)(ap->ws + WS_YR), (const bf16*)(WL(ap, layer) + WO_B + 8 * MiB), 2 * DM); } SEAM(); }
    if constexpr (IN(13)) { ArgsP ap = fresh_args(); ph_gemm_resid(lds, (const bf16*)(ap->ws + WS_MERGED), (const bf16*)(WL(ap, layer) + WO_OUT), DM, layer == 0 ? ap->x : ap->out, ap->out); SEAM(); }
    if constexpr (IN(14)) { ArgsP ap = fresh_args(); ph_rmsnorm(ap->out, ap->norm_ffn + layer * DM, (bf16*)(ap->ws + WS_H)); if constexpr (DUP_PHASE == 14) { SEAM(); ph_rmsnorm(ap->out, ap->norm_ffn + layer * DM, (bf16*)(ap->ws + WS_H)); } SEAM(); }
    if constexpr (IN(15)) { ArgsP ap = fresh_args(); ph_gemm_ffn_in(lds, ap->ws, (const bf16*)(WL(ap, layer) + WO_FIN));
        if constexpr (one_launch && !LAST) { ArgsP aq = fresh_args(); ph_convert_tail(lds, aq->ws, layer + 1, aq->w_in, aq->w_b_att, aq->w_b_mlstm, aq->w_b_ret, aq->w_out, aq->w_ffn_in, aq->w_ffn_out, ((S / 256) * (2 * FF / 256)) % (int)gridDim.x, CV_S2, CV_ITEMS); } if constexpr (DUP_PHASE == 15) { SEAM(); ph_gemm_ffn_in(lds, ap->ws, (const bf16*)(WL(ap, layer) + WO_FIN)); } SEAM(); }
    if constexpr (IN(16)) { ArgsP ap = fresh_args(); ph_gemm_resid(lds, (const bf16*)(ap->ws + WS_ACT), (const bf16*)(WL(ap, layer) + WO_FOUT), FF, ap->out, ap->out); if constexpr (!LAST) SEAM(); }
}
template <int PLO, int PHI> __global__ void __launch_bounds__(NTHR, 2) fwd(Args args_unused) {
    (void)args_unused;
    extern __shared__ __attribute__((aligned(16))) unsigned char lds_raw[];
    LAS unsigned char* lds = (LAS unsigned char*)lds_raw;
    if (threadIdx.x < 64) ((volatile LAS unsigned*)(lds + MISC_OFF))[threadIdx.x] = 0u;
    if ((threadIdx.x & 63) == 0) ((volatile LAS unsigned*)(lds + MISC_OFF))[64 + ((unsigned)__builtin_amdgcn_s_getreg((5 << 11) | 4) & 63u)] = threadIdx.x >> 6;
    __syncthreads();
    constexpr bool one_launch = (PHI - PLO > 1);
    if constexpr (one_launch) { ArgsP ap = fresh_args(); (void)xcd_barrier_post((unsigned*)(ap->ws + WS_CTL) + CW_BAR, (volatile LAS unsigned*)(lds + MISC_OFF)); }
    if constexpr (PLO == 0) { ArgsP ap = fresh_args(); ph_prologue(lds, ap->ws, ap->w_in, ap->w_b_att, ap->w_b_mlstm, ap->w_b_ret, ap->w_out, ap->w_ffn_in, ap->w_ffn_out, !one_launch);
        if constexpr (DUP_PHASE == 0) { SEAM(); ph_prologue(lds, ap->ws, ap->w_in, ap->w_b_att, ap->w_b_mlstm, ap->w_b_ret, ap->w_out, ap->w_ffn_in, ap->w_ffn_out, !one_launch); }
        if (PHI > 1) SEAM(); }
    if constexpr (one_launch) { static_assert(DEPTH == 4, "four inlined layer sites");
        layer_phases<PLO, PHI, false>(0, lds, lds_raw); layer_phases<PLO, PHI, false>(1, lds, lds_raw); layer_phases<PLO, PHI, false>(2, lds, lds_raw); layer_phases<PLO, PHI, true>(3, lds, lds_raw); }
    else if constexpr (PLO > 0) { ArgsP ap = fresh_args(); layer_phases<PLO, PHI, true>(ap->layer_lo, lds, lds_raw); }
}
#undef IN
#undef SEAM
#undef WL

#ifndef ONE_LAUNCH
#define ONE_LAUNCH 1
#endif
typedef void (*kern_t)(Args);
template <int P> static kern_t phase_kernel(int p) { if (p == P) return fwd<P, P + 1>; if constexpr (P < PH_PER_LAYER) return phase_kernel<P + 1>(p); else return nullptr; }
extern "C" void kernel_launch(void* const* d_in, const int* in_sizes, int n_in, void* d_out, int out_size, void* d_ws, size_t ws_size, hipStream_t stream) {
    static int grid = 0;
    if (grid == 0) {
        if (n_in != 16 || in_sizes[0] != S * DM || out_size != S * DM || ws_size < WS_END) { fprintf(stderr, "kernel_launch: unexpected shapes (n_in %d, in0 %d, out %d, ws %zu < %zu); nothing launched\n", n_in, n_in > 0 ? in_sizes[0] : -1, out_size, ws_size, (size_t)WS_END); grid = -1; return; }
        int dev = 0, cus = 0;
        if (hipGetDevice(&dev) != hipSuccess || hipDeviceGetAttribute(&cus, hipDeviceAttributeMultiprocessorCount, dev) != hipSuccess) { grid = -1; return; }
#if ONE_LAUNCH
        if (hipFuncSetAttribute((const void*)fwd<0, PH_PER_LAYER + 1>, hipFuncAttributeMaxDynamicSharedMemorySize, LDS_BYTES) != hipSuccess) { grid = -1; return; }
#else
        for (int p = 0; p <= PH_PER_LAYER; ++p) if (hipFuncSetAttribute((const void*)phase_kernel<0>(p), hipFuncAttributeMaxDynamicSharedMemorySize, LDS_BYTES) != hipSuccess) { fprintf(stderr, "kernel_launch: hipFuncSetAttribute failed\n"); grid = -1; return; }
#endif
        (void)hipGetLastError();
        grid = cus;
    }
    if (grid < 0) return;
    (void)hipMemsetAsync((char*)d_ws + WS_CTL, 0, CTL_ZERO_BYTES, stream);
    Args a{};
    a.x = (const float*)d_in[0]; a.norm_mix = (const float*)d_in[1]; a.norm_ffn = (const float*)d_in[2]; a.w_in = (const float*)d_in[3]; a.att_q_norm = (const float*)d_in[4]; a.att_k_norm = (const float*)d_in[5];
    a.mlstm_conv = (const float*)d_in[6]; a.mlstm_gate_bias = (const float*)d_in[7]; a.mlstm_out_norm = (const float*)d_in[8]; a.ret_out_norm = (const float*)d_in[9];
    a.w_b_att = (const float*)d_in[10]; a.w_b_mlstm = (const float*)d_in[11]; a.w_b_ret = (const float*)d_in[12]; a.w_out = (const float*)d_in[13]; a.w_ffn_in = (const float*)d_in[14]; a.w_ffn_out = (const float*)d_in[15];
    a.out = (float*)d_out; a.ws = (unsigned char*)d_ws;
#if ONE_LAUNCH
    a.layer_lo = 0; a.layer_hi = DEPTH; a.ph_lo = 0; a.ph_hi = PH_PER_LAYER + 1; hipLaunchKernelGGL((fwd<0, PH_PER_LAYER + 1>), dim3(grid), dim3(NTHR), LDS_BYTES, stream, a);
#else
    a.layer_lo = 0; a.layer_hi = 0; a.ph_lo = 0; a.ph_hi = 1; hipLaunchKernelGGL((fwd<0, 1>), dim3(grid), dim3(NTHR), LDS_BYTES, stream, a);
    for (int l = 0; l < DEPTH; ++l) for (int p = 1; p <= PH_PER_LAYER; ++p) { a.layer_lo = l; a.layer_hi = l + 1; a.ph_lo = p; a.ph_hi = p + 1; hipLaunchKernelGGL(phase_kernel<0>(p), dim3(grid), dim3(NTHR), LDS_BYTES, stream, a); }
#endif
}
```

```cpp
#include <hip/hip_runtime.h>
#include <cstdio>
#include <cstdint>
__device__ __forceinline__ int my_tid();
namespace pg8 {
#define PG8_LAS __attribute__((address_space(3)))
typedef unsigned short bf16_t;
typedef short bf16x8 __attribute__((ext_vector_type(8)));
typedef float f32x4 __attribute__((ext_vector_type(4)));
typedef unsigned u32x4 __attribute__((ext_vector_type(4)));
constexpr int BM = 256, BK = 64, HALF = 128, HTB = HALF * BK * 2  , STAGE_BYTES = 8 * HTB, NXCD = 8, WGM = 8;

__host__ __device__ __forceinline__ int lds_byte(int r, int c) { const int st = (r >> 4) * 2 + (c >> 5), rr = r & 15, cc = c & 31, ob = rr * 64 + cc * 2; return st * 1024 + (ob ^ (((ob >> 9) & 1) << 5)); }
__host__ __device__ __forceinline__ void stage_rc(int b, int& R, int& C) { const int st = b / 1024, sb = b % 1024, swz = sb ^ (((sb >> 9) & 1) << 5); R = (st >> 1) * 16 + swz / 64; C = (st & 1) * 32 + (swz % 64) / 2; }
__host__ __device__ __forceinline__ int perm32(int rho) { const int n = rho >> 4, i = rho & 15; return 8 * (i >> 2) + 4 * n + (i & 3); }

struct Unit { int pm, pn; };
struct Gemm { const bf16_t* A; const bf16_t* Bt; int M, N, K; };

struct StaticOrder {
    int nM, nN, nwg, G, c;
    __host__ __device__ void init(int M, int N, int G_, int c_) { nM = M / BM; nN = N / BM; nwg = nM * nN; G = G_; c = c_; }
    __host__ __device__ bool next(int i, Unit& u) const {
        const long L = (long)i * G + c; if (L >= nwg) return false;
        int wgid = (int)L; { const int q = nwg / NXCD, r = nwg % NXCD, xcd = wgid % NXCD, off = wgid / NXCD; wgid = (xcd < r ? xcd * (q + 1) : r * (q + 1) + (xcd - r) * q) + off; }
        const int nig = WGM * nN, gid = wgid / nig, fm = gid * WGM, gsz = (nM - fm) < WGM ? (nM - fm) : WGM;
        u.pm = fm + ((wgid % nig) % gsz); u.pn = (wgid % nig) / gsz; return true;
    }
    __device__ __forceinline__ void a_ready(const Unit&) const {}
    __device__ __forceinline__ void done(const Unit&) const {}
};

__device__ __forceinline__ unsigned cvt_pk_bf16(float lo, float hi) { unsigned r; asm volatile("v_cvt_pk_bf16_f32 %0, %1, %2" : "=v"(r) : "v"(lo), "v"(hi)); return r; }
typedef float f32x2 __attribute__((ext_vector_type(2)));
__device__ __forceinline__ float sigmoid_f(float x) { return __builtin_amdgcn_rcpf(1.0f + __builtin_amdgcn_exp2f(-1.4426950408889634f * x)); }
struct EpiProj {
    static constexpr bool PERM = true, AFTER_DRAIN = false;
    bf16_t* P; int ldp; float* Sm; int ngate0, nbf;
    __device__ __forceinline__ void operator()(const f32x4 (&acc)[2][2][4][2], const Unit& u, int wr, int wc, int fr, int fq) const {
        const int row0 = u.pm * BM + wr * 64 + fr, col0 = u.pn * BM + wc * 32 + 8 * fq;
        if (u.pn >= nbf) {
            const int c0 = wc * 32 + 8 * fq;
#pragma unroll
            for (int ai = 0; ai < 2; ++ai)
#pragma unroll
                for (int m = 0; m < 4; ++m) { float* rowp = Sm + (size_t)(row0 + ai * HALF + m * 16) * 256 + c0;
#pragma unroll
                    for (int bj = 0; bj < 2; ++bj) { *(f32x4*)(rowp + bj * HALF) = acc[ai][bj][m][0]; *(f32x4*)(rowp + bj * HALF + 4) = acc[ai][bj][m][1]; } }
            return;
        }
        const bool sg = u.pn >= ngate0;
#pragma unroll
        for (int ai = 0; ai < 2; ++ai)
#pragma unroll
            for (int m = 0; m < 4; ++m) { bf16_t* rowp = P + (size_t)(row0 + ai * HALF + m * 16) * ldp + col0;
#pragma unroll
                for (int bj = 0; bj < 2; ++bj) { f32x4 v0 = acc[ai][bj][m][0], v1 = acc[ai][bj][m][1];
                    if (sg) {
#pragma unroll
                        for (int j = 0; j < 4; ++j) { v0[j] = sigmoid_f(v0[j]); v1[j] = sigmoid_f(v1[j]); } }
                    u32x4 w; w.x = cvt_pk_bf16(v0[0], v0[1]); w.y = cvt_pk_bf16(v0[2], v0[3]); w.z = cvt_pk_bf16(v1[0], v1[1]); w.w = cvt_pk_bf16(v1[2], v1[3]);
                    *(u32x4*)(rowp + bj * HALF) = w; } }
    }
};
__device__ __forceinline__ f32x4 bf4_lo(u32x4 w) { return (f32x4){__uint_as_float(w.x << 16), __uint_as_float(w.x & 0xffff0000u), __uint_as_float(w.y << 16), __uint_as_float(w.y & 0xffff0000u)}; }
__device__ __forceinline__ f32x4 bf4_hi(u32x4 w) { return (f32x4){__uint_as_float(w.z << 16), __uint_as_float(w.z & 0xffff0000u), __uint_as_float(w.w << 16), __uint_as_float(w.w & 0xffff0000u)}; }
template <int MODE> struct EpiBranch {
    static constexpr bool PERM = true, AFTER_DRAIN = false;
    const bf16_t* G; int ldg; float* T; bf16_t* O; int ldt;
    __device__ __forceinline__ void operator()(const f32x4 (&acc)[2][2][4][2], const Unit& u, int wr, int wc, int fr, int fq) const {
        const int row0 = u.pm * BM + wr * 64 + fr, col0 = u.pn * BM + wc * 32 + 8 * fq;
#pragma unroll
        for (int ai = 0; ai < 2; ++ai)
#pragma unroll
            for (int m = 0; m < 4; ++m) { const size_t r = (size_t)(row0 + ai * HALF + m * 16);
#pragma unroll
                for (int bj = 0; bj < 2; ++bj) { const u32x4 g = *(const u32x4*)(G + r * ldg + col0 + bj * HALF);
                    f32x4 v0 = acc[ai][bj][m][0] * bf4_lo(g), v1 = acc[ai][bj][m][1] * bf4_hi(g);
                    float* tp = T + r * ldt + col0 + bj * HALF;
                    if (MODE >= 1) { v0 = v0 + *(const f32x4*)tp; v1 = v1 + *(const f32x4*)(tp + 4); }
                    if (MODE <= 1) { *(f32x4*)tp = v0; *(f32x4*)(tp + 4) = v1; }
                    else { u32x4 w; w.x = cvt_pk_bf16(v0[0], v0[1]); w.y = cvt_pk_bf16(v0[2], v0[3]); w.z = cvt_pk_bf16(v1[0], v1[1]); w.w = cvt_pk_bf16(v1[2], v1[3]);
                        *(u32x4*)(O + r * ldt + col0 + bj * HALF) = w; } } }
    }
};
struct EpiResid {
    static constexpr bool PERM = false, AFTER_DRAIN = false;
    const float* base; float* out; int ldc;
    __device__ __forceinline__ void operator()(const f32x4 (&acc)[2][2][4][2], const Unit& u, int wr, int wc, int fr, int fq) const {
        const int row0 = u.pm * BM + wr * 64 + fr, col0 = u.pn * BM + wc * 32 + 4 * fq;
#pragma unroll
        for (int ai = 0; ai < 2; ++ai)
#pragma unroll
            for (int m = 0; m < 4; ++m) { const size_t off = (size_t)(row0 + ai * HALF + m * 16) * ldc + col0;
#pragma unroll
                for (int bj = 0; bj < 2; ++bj)
#pragma unroll
                    for (int n = 0; n < 2; ++n) *(f32x4*)(out + off + bj * HALF + n * 16) = *(const f32x4*)(base + off + bj * HALF + n * 16) + acc[ai][bj][m][n]; }
    }
};
struct EpiSwiGLU {
    static constexpr bool PERM = true, AFTER_DRAIN = false;
    bf16_t* O; int ldc;
    __device__ __forceinline__ void operator()(const f32x4 (&acc)[2][2][4][2], const Unit& u, int wr, int wc, int fr, int fq) const {
        const int row0 = u.pm * BM + wr * 64 + fr, col0 = u.pn * HALF + wc * 32 + 8 * fq;
#pragma unroll
        for (int ai = 0; ai < 2; ++ai)
#pragma unroll
            for (int m = 0; m < 4; ++m) { f32x4 v0, v1;
#pragma unroll
                for (int j = 0; j < 4; ++j) { const float g0 = acc[ai][0][m][0][j], g1 = acc[ai][0][m][1][j];
                    v0[j] = g0 * sigmoid_f(g0) * acc[ai][1][m][0][j]; v1[j] = g1 * sigmoid_f(g1) * acc[ai][1][m][1][j]; }
                u32x4 w; w.x = cvt_pk_bf16(v0[0], v0[1]); w.y = cvt_pk_bf16(v0[2], v0[3]); w.z = cvt_pk_bf16(v1[0], v1[1]); w.w = cvt_pk_bf16(v1[2], v1[3]);
                *(u32x4*)(O + (size_t)(row0 + ai * HALF + m * 16) * ldc + col0) = w; }
    }
};
template <class Epi, class Sched, bool ALIGN_EPI = false, bool SP2 = false>
__device__ __forceinline__ void gemm_phase(PG8_LAS unsigned char* lds, const Gemm g, const Sched& S, const Epi& E) {
    int tid_o = my_tid(); asm volatile("" : "+v"(tid_o));
    const int tid = tid_o, wid = __builtin_amdgcn_readfirstlane(tid >> 6), lane = tid & 63, wr = wid >> 2, wc = wid & 3, fr = lane & 15, fq = lane >> 4;
    const int K = g.K, nt = K / BK;
    unsigned voffA[2], voffB[2];
#pragma unroll
    for (int i = 0; i < 2; ++i) { int R, C; stage_rc(tid * 16 + i * 8192, R, C); const int Rb = Epi::PERM ? ((R & ~31) + perm32(R & 31)) : R;
        voffA[i] = (unsigned)(R * K + C) * 2u; voffB[i] = (unsigned)(Rb * K + C) * 2u; }
    const size_t kstep = (size_t)(BK * 2);
    const size_t hstep = (size_t)HALF * K * 2;
    const size_t tstep = 2 * hstep;
    const unsigned ldsw = (unsigned)wid * 1024u;
    const int aoff = lds_byte(wr * 64 + fr, fq * 8), boff = lds_byte(wc * 32 + fr, fq * 8);
#define PG8_SA(b, h) (((b) * 2 + (h)) * HTB)
#define PG8_SB(b, h) ((4 + (b) * 2 + (h)) * HTB)
#define PG8_STAGE(bufoff, gbase, voff) do { _Pragma("unroll") for (int _i = 0; _i < 2; ++_i) \
        __builtin_amdgcn_global_load_lds((const unsigned*)((const char*)(gbase) + (voff)[_i]), (PG8_LAS unsigned*)(lds + (bufoff) + ldsw + _i * 8192), 16, 0, 0); } while (0)
#define PG8_LDA(dst, b, h) do { _Pragma("unroll") for (int m = 0; m < 4; ++m) _Pragma("unroll") for (int k = 0; k < 2; ++k) dst[m][k] = *(const PG8_LAS bf16x8*)(lds + PG8_SA(b, h) + aoff + m * 2048 + k * 1024); } while (0)
#define PG8_LDB(dst, b, h) do { _Pragma("unroll") for (int n = 0; n < 2; ++n) _Pragma("unroll") for (int k = 0; k < 2; ++k) dst[n][k] = *(const PG8_LAS bf16x8*)(lds + PG8_SB(b, h) + boff + n * 2048 + k * 1024); } while (0)
#define PG8_MMA(ai, bj, At, Bt) do { __builtin_amdgcn_s_setprio(1); _Pragma("unroll") for (int m = 0; m < 4; ++m) _Pragma("unroll") for (int n = 0; n < 2; ++n) _Pragma("unroll") for (int k = 0; k < 2; ++k) \
        acc[ai][bj][m][n] = __builtin_amdgcn_mfma_f32_16x16x32_bf16(Bt[n][k], At[m][k], acc[ai][bj][m][n], 0, 0, 0); __builtin_amdgcn_s_setprio(0); } while (0)
#define PG8_WAIT_V(n) asm volatile("s_waitcnt vmcnt(" #n ")" ::: "memory")
#define PG8_WAIT_L(n) asm volatile("s_waitcnt lgkmcnt(" #n ")" ::: "memory")
#define PG8_BAR __builtin_amdgcn_s_barrier()
#define PG8_SCHED __builtin_amdgcn_sched_barrier(0)
    Unit cur, nxt; int ui = 0;
    if (!S.next(0, cur)) return;
    f32x4 acc[2][2][4][2];
#pragma unroll
    for (int a = 0; a < 2; ++a)
#pragma unroll
        for (int b = 0; b < 2; ++b)
#pragma unroll
            for (int m = 0; m < 4; ++m)
#pragma unroll
                for (int n = 0; n < 2; ++n) acc[a][b][m][n] = (f32x4){0.f, 0.f, 0.f, 0.f};
    bf16x8 At[4][2], B0[2][2], B1[2][2];
    const char* cA = (const char*)g.A + (size_t)cur.pm * tstep; const char* cB = (const char*)g.Bt + (size_t)cur.pn * tstep;
    S.a_ready(cur);
    if constexpr (SP2) {
        PG8_STAGE(PG8_SB(0, 0), cB, voffB); PG8_STAGE(PG8_SB(0, 1), cB + hstep, voffB); PG8_STAGE(PG8_SA(0, 0), cA, voffA); PG8_STAGE(PG8_SA(0, 1), cA + hstep, voffA);
        if (wr == 1) PG8_BAR;
        PG8_WAIT_V(2); PG8_BAR;
        PG8_STAGE(PG8_SB(1, 0), cB + kstep, voffB); PG8_STAGE(PG8_SA(1, 0), cA + kstep, voffA); PG8_STAGE(PG8_SB(1, 1), cB + hstep + kstep, voffB);
        PG8_WAIT_V(6); PG8_BAR;
    } else {
        PG8_STAGE(PG8_SB(0, 0), cB, voffB); PG8_STAGE(PG8_SA(0, 0), cA, voffA); PG8_STAGE(PG8_SB(0, 1), cB + hstep, voffB); PG8_STAGE(PG8_SA(0, 1), cA + hstep, voffA);
        if (wr == 1) PG8_BAR;
        PG8_WAIT_V(4); PG8_BAR;
        PG8_STAGE(PG8_SB(1, 0), cB + kstep, voffB); PG8_STAGE(PG8_SA(1, 0), cA + kstep, voffA); PG8_STAGE(PG8_SB(1, 1), cB + hstep + kstep, voffB);
        PG8_WAIT_V(6); PG8_BAR;
    }
    for (;;) {
        const bool has_next = S.next(ui + 1, nxt);
        const char* nA = has_next ? (const char*)g.A + (size_t)nxt.pm * tstep : cA; const char* nB = has_next ? (const char*)g.Bt + (size_t)nxt.pn * tstep : cB;
        for (int t = 0; t < nt; t += 2) {
            const bool last = (t == nt - 2);
            const char* a1 = cA + (size_t)(t + 1) * kstep;
            const char* a2 = last ? nA : cA + (size_t)(t + 2) * kstep; const char* b2 = last ? nB : cB + (size_t)(t + 2) * kstep;
            const char* a3 = a2 + kstep; const char* b3 = b2 + kstep;
            if (last && has_next) S.a_ready(nxt);
            if constexpr (SP2) {
            PG8_LDB(B0, 0, 0); PG8_LDB(B1, 0, 1); PG8_SCHED; PG8_LDA(At, 0, 0); PG8_STAGE(PG8_SA(1, 1), a1 + hstep, voffA);
            PG8_WAIT_V(8); PG8_WAIT_L(0); PG8_BAR; PG8_MMA(0, 0, At, B0); PG8_MMA(0, 1, At, B1); PG8_BAR; PG8_SCHED;
            PG8_LDA(At, 0, 1); PG8_STAGE(PG8_SB(0, 0), b2, voffB); PG8_STAGE(PG8_SB(0, 1), b2 + hstep, voffB); PG8_STAGE(PG8_SA(0, 0), a2, voffA);
            PG8_WAIT_V(8); PG8_WAIT_L(0); PG8_BAR; PG8_MMA(1, 0, At, B0); PG8_MMA(1, 1, At, B1); PG8_BAR; PG8_SCHED;
            PG8_LDB(B0, 1, 0); PG8_LDB(B1, 1, 1); PG8_SCHED; PG8_LDA(At, 1, 0); PG8_STAGE(PG8_SA(0, 1), a2 + hstep, voffA);
            PG8_WAIT_V(8); PG8_WAIT_L(0); PG8_BAR; PG8_MMA(0, 0, At, B0); PG8_MMA(0, 1, At, B1); PG8_BAR; PG8_SCHED;
            PG8_LDA(At, 1, 1); PG8_STAGE(PG8_SB(1, 0), b3, voffB); PG8_STAGE(PG8_SB(1, 1), b3 + hstep, voffB); PG8_STAGE(PG8_SA(1, 0), a3, voffA);
            PG8_WAIT_V(8); PG8_WAIT_L(0); PG8_BAR; PG8_MMA(1, 0, At, B0); PG8_MMA(1, 1, At, B1); PG8_BAR; PG8_SCHED;
            } else {
            PG8_LDB(B0, 0, 0); PG8_SCHED; PG8_LDA(At, 0, 0); PG8_STAGE(PG8_SA(1, 1), a1 + hstep, voffA);
            PG8_WAIT_L(8); PG8_BAR; PG8_WAIT_L(0); PG8_MMA(0, 0, At, B0); PG8_BAR; PG8_SCHED;
            PG8_LDB(B1, 0, 1); PG8_STAGE(PG8_SB(0, 0), b2, voffB);
            PG8_BAR; PG8_WAIT_L(0); PG8_MMA(0, 1, At, B1); PG8_BAR;
            PG8_LDA(At, 0, 1); PG8_STAGE(PG8_SA(0, 0), a2, voffA);
            PG8_BAR; PG8_WAIT_L(0); PG8_MMA(1, 0, At, B0); PG8_BAR; PG8_SCHED;
            PG8_STAGE(PG8_SB(0, 1), b2 + hstep, voffB);
            PG8_WAIT_V(6); PG8_BAR; PG8_MMA(1, 1, At, B1); PG8_BAR;
            PG8_LDB(B0, 1, 0); PG8_SCHED; PG8_LDA(At, 1, 0); PG8_STAGE(PG8_SA(0, 1), a2 + hstep, voffA);
            PG8_WAIT_L(8); PG8_BAR; PG8_WAIT_L(0); PG8_MMA(0, 0, At, B0); PG8_BAR; PG8_SCHED;
            PG8_LDB(B1, 1, 1); PG8_STAGE(PG8_SB(1, 0), b3, voffB);
            PG8_BAR; PG8_WAIT_L(0); PG8_MMA(0, 1, At, B1); PG8_BAR;
            PG8_LDA(At, 1, 1); PG8_STAGE(PG8_SA(1, 0), a3, voffA);
            PG8_BAR; PG8_WAIT_L(0); PG8_MMA(1, 0, At, B0); PG8_BAR; PG8_SCHED;
            PG8_STAGE(PG8_SB(1, 1), b3 + hstep, voffB);
            PG8_WAIT_V(6); PG8_BAR; PG8_MMA(1, 1, At, B1); PG8_BAR;
            }
        }
        if constexpr (ALIGN_EPI) { if (wr == 0) PG8_BAR; }
        if constexpr (!Epi::AFTER_DRAIN) { E(acc, cur, wr, wc, fr, fq); S.done(cur); }
        if (!has_next) break;
#pragma unroll
        for (int a = 0; a < 2; ++a)
#pragma unroll
            for (int b = 0; b < 2; ++b)
#pragma unroll
                for (int m = 0; m < 4; ++m)
#pragma unroll
                    for (int n = 0; n < 2; ++n) acc[a][b][m][n] = (f32x4){0.f, 0.f, 0.f, 0.f};
        cur = nxt; cA = nA; cB = nB; ++ui;
        if constexpr (ALIGN_EPI) { if (wr == 1) PG8_BAR; }
    }
    PG8_WAIT_V(0);
    if constexpr (!ALIGN_EPI) { if (wr == 0) PG8_BAR; }
    PG8_BAR;
    if constexpr (Epi::AFTER_DRAIN) { E.fused(acc, cur, wr, wc, fr, fq, lds, wid, lane); S.done(cur); }
#undef PG8_SA
#undef PG8_SB
#undef PG8_STAGE
#undef PG8_LDA
#undef PG8_LDB
#undef PG8_MMA
#undef PG8_WAIT_V
#undef PG8_WAIT_L
#undef PG8_BAR
#undef PG8_SCHED
}
}

using pg8::sigmoid_f;
constexpr int NWAVES = 8, NTHR = 512;
constexpr int S = 8192, DM = 2048, DEPTH = 4, FF = 5632;
constexpr int NPROJ = 16896, NPROJ_PAD = 17152, LPROJ = 16976;
constexpr int PC_AQ = 0, PC_AK = 1024, PC_AV = 2048, PC_IQ = 3072, PC_MQ = 3584, PC_MK = 4096, PC_MV = 4608, PC_MO = 5632, PC_RQ = 6656, PC_RK = 7680, PC_RV = 8704, PC_RG = 9728, PC_G = 10752;
constexpr int LC_IK = 3584, LC_IW = 3648, LC_MI = 5704, LC_MF = 5708;
constexpr float NORM_EPS = 1e-6f;
constexpr size_t MiB = 1u << 20;
constexpr size_t WS_CTL = 0, CTL_ZERO_BYTES = 1 * MiB;
constexpr size_t WS_ROPE128 = 2 * MiB, WS_ROPE64 = 6 * MiB;
constexpr size_t WS_W = 16 * MiB, W_LAYER = 153 * MiB;
constexpr size_t WO_IN = 0, WO_B = 67 * MiB, WO_OUT = 79 * MiB, WO_FIN = 87 * MiB, WO_FOUT = 131 * MiB;
constexpr size_t WS_H = 640 * MiB, WS_PROJ = 672 * MiB, WS_SMALL = 936 * MiB, WS_MQK = 944 * MiB, WS_IKB = 960 * MiB, WS_IWF = 961 * MiB, WS_GIF = WS_IWF + 512 * 1024;
constexpr size_t WS_SC = 964 * MiB, WS_MB = 1220 * MiB, WS_DCM = 1228 * MiB, WS_CPM = 1260 * MiB, WS_MISC = 1292 * MiB, WS_DRR = 1294 * MiB, WS_RPR = 1310 * MiB;
constexpr size_t WS_YA = 1328 * MiB, WS_YM = 1344 * MiB, WS_YR = 1360 * MiB, WS_MERGEDF = 1376 * MiB, WS_MERGED = 1440 * MiB, WS_ACT = 1472 * MiB, WS_END = 1560 * MiB;
constexpr size_t MISC_DN = 0, MISC_NPREV = 256 * 1024, MISC_AB = 512 * 1024, MISC_MPREV = 520 * 1024;
constexpr int CW_BAR = 4096;
constexpr int LDS_BYTES = 147456, MISC_OFF = 147456 - 1024;

#define GAS __attribute__((address_space(1)))
#define LAS __attribute__((address_space(3)))
typedef unsigned short bf16;
typedef unsigned v4u __attribute__((ext_vector_type(4)));
typedef unsigned v2u __attribute__((ext_vector_type(2)));
typedef float f32x4 __attribute__((ext_vector_type(4)));
typedef float f32x16 __attribute__((ext_vector_type(16)));
typedef short bf16x8 __attribute__((ext_vector_type(8)));
typedef short s16x4 __attribute__((ext_vector_type(4)));
#define LDS_WAIT() asm volatile("s_waitcnt lgkmcnt(0)" ::: "memory")
#define VM_WAIT() asm volatile("s_waitcnt vmcnt(0)" ::: "memory")
__device__ __forceinline__ unsigned f2bf(float f) { unsigned u = __builtin_bit_cast(unsigned, f); return (u + 0x7fffu + ((u >> 16) & 1u)) >> 16; }
__device__ __forceinline__ unsigned pk2(float lo, float hi) { return f2bf(lo) | (f2bf(hi) << 16); }
__device__ __forceinline__ float bf2f(bf16 b) { return __uint_as_float(((unsigned)b) << 16); }
template <int CTRL, int RMASK, int BMASK> __device__ __forceinline__ float dpp_f(float old, float src) { return __builtin_bit_cast(float, __builtin_amdgcn_update_dpp(__builtin_bit_cast(int, old), __builtin_bit_cast(int, src), CTRL, RMASK, BMASK, false)); }
template <int CTRL, int RMASK, int BMASK> __device__ __forceinline__ unsigned dpp_u(unsigned src) { return (unsigned)__builtin_amdgcn_update_dpp(0, (int)src, CTRL, RMASK, BMASK, false); }
__device__ __forceinline__ float wave_sum(float x) {
    x += dpp_f<0xB1, 0xf, 0xf>(0.f, x); x += dpp_f<0x4E, 0xf, 0xf>(0.f, x); x += dpp_f<0x141, 0xf, 0xf>(0.f, x); x += dpp_f<0x140, 0xf, 0xf>(0.f, x);
    x += dpp_f<0x142, 0xa, 0xf>(0.f, x); x += dpp_f<0x143, 0xc, 0xf>(0.f, x);
    return __builtin_bit_cast(float, __builtin_amdgcn_readlane(__builtin_bit_cast(int, x), 63)); }
__device__ __forceinline__ float wave_max(float x) {
    x = fmaxf(x, dpp_f<0xB1, 0xf, 0xf>(x, x)); x = fmaxf(x, dpp_f<0x4E, 0xf, 0xf>(x, x)); x = fmaxf(x, dpp_f<0x141, 0xf, 0xf>(x, x)); x = fmaxf(x, dpp_f<0x140, 0xf, 0xf>(x, x));
    x = fmaxf(x, dpp_f<0x142, 0xa, 0xf>(x, x)); x = fmaxf(x, dpp_f<0x143, 0xc, 0xf>(x, x));
    return __builtin_bit_cast(float, __builtin_amdgcn_readlane(__builtin_bit_cast(int, x), 63)); }
__device__ __forceinline__ unsigned lane_id_v() { unsigned l; asm volatile("v_mbcnt_lo_u32_b32 %0, -1, 0\n\tv_mbcnt_hi_u32_b32 %0, -1, %0" : "=v"(l)); return l; }
__device__ __forceinline__ int my_tid() {
    const unsigned slot = (unsigned)__builtin_amdgcn_s_getreg((5 << 11) | 4) & 63u;
    extern __shared__ __attribute__((aligned(16))) unsigned char lds_raw_t[];
    const unsigned wv = ((volatile LAS unsigned*)((LAS unsigned char*)lds_raw_t + MISC_OFF))[64 + slot];
    return (int)(__builtin_amdgcn_readfirstlane(wv) * 64u + lane_id_v());
}
__device__ __forceinline__ float shfl_idx_f(float x, int src_lane) { return __builtin_bit_cast(float, __builtin_amdgcn_ds_bpermute(src_lane << 2, __builtin_bit_cast(int, x))); }
__device__ __forceinline__ float wave_prefix_sum_f(float x) {
    float y = x + dpp_f<0x111, 0xf, 0xf>(0.f, x); y += dpp_f<0x112, 0xf, 0xf>(0.f, x); y += dpp_f<0x113, 0xf, 0xf>(0.f, x);
    y += dpp_f<0x114, 0xf, 0xe>(0.f, y); y += dpp_f<0x118, 0xf, 0xc>(0.f, y); y += dpp_f<0x142, 0xa, 0xf>(0.f, y); y += dpp_f<0x143, 0xc, 0xf>(0.f, y); return y; }
__device__ __forceinline__ float wave_prefix_max_f(float x) {
    const float N = -3.0e38f;
    float y = fmaxf(x, dpp_f<0x111, 0xf, 0xf>(N, x)); y = fmaxf(y, dpp_f<0x112, 0xf, 0xf>(N, x)); y = fmaxf(y, dpp_f<0x113, 0xf, 0xf>(N, x));
    y = fmaxf(y, dpp_f<0x114, 0xf, 0xe>(N, y)); y = fmaxf(y, dpp_f<0x118, 0xf, 0xc>(N, y)); y = fmaxf(y, dpp_f<0x142, 0xa, 0xf>(N, y)); y = fmaxf(y, dpp_f<0x143, 0xc, 0xf>(N, y)); return y; }
#define XB_TMO      128
#define XB_XCNT(j)  (256  + 64 * (j))
#define XB_XSUB(j)  (1280 + 64 * (j))
#define XB_XGEN(j)  (2304 + 64 * (j))
#define XB_TOP      3328
#define XB_TOPGEN   3392
#define XCD_BAR_WORDS 3456
#define XB_SPIN_CAP (1u << 18)

__device__ __forceinline__ unsigned xb_ld(unsigned* p)              { return __hip_atomic_load(p, __ATOMIC_RELAXED, __HIP_MEMORY_SCOPE_AGENT); }
__device__ __forceinline__ unsigned xb_add(unsigned* p, unsigned v) { return __hip_atomic_fetch_add(p, v, __ATOMIC_RELAXED, __HIP_MEMORY_SCOPE_AGENT); }
__device__ __forceinline__ unsigned xb_xcc_id() { return (unsigned)__builtin_amdgcn_s_getreg((3 << 11) | 20) & 0xFu; }
#define XB_SPIN(cond, bar) do { unsigned _sp = 0; while (cond) { __builtin_amdgcn_s_sleep(1); \
    if ((++_sp & 255u) == 0u) { if (xb_ld(&(bar)[XB_TMO])) break; if (_sp > XB_SPIN_CAP) { atomicAdd(&(bar)[XB_TMO], 1u); break; } } } } while (0)

struct XcdBarrier {
    unsigned* bar; unsigned x;
    volatile LAS unsigned* st;
};

__device__ __forceinline__ XcdBarrier xcd_barrier_post(unsigned* bar, volatile LAS unsigned* st) {
    XcdBarrier b; b.bar = bar; b.x = xb_xcc_id(); b.st = st;
    if (my_tid() == 0) (void)xb_add(&bar[XB_XCNT(b.x)], 1u);
    return b;
}
__device__ __forceinline__ void xcd_barrier_complete(unsigned* bar, unsigned x, unsigned& nloc, unsigned& nx) {
    const unsigned G = gridDim.x * gridDim.y * gridDim.z;
    unsigned sum, cnt, mine, sp = 0u;
    for (;;) {
        sum = 0u; cnt = 0u; mine = 0u;
#pragma unroll
        for (unsigned j = 0; j < 16; ++j) { const unsigned c = xb_ld(&bar[XB_XCNT(j)]); sum += c; cnt += (c > 0u) ? 1u : 0u; mine = (j == x) ? c : mine; }
        if (sum == G) break;
        __builtin_amdgcn_s_sleep(1);
        if ((++sp & 255u) == 0u) { if (xb_ld(&bar[XB_TMO])) break; if (sp > XB_SPIN_CAP) { atomicAdd(&bar[XB_TMO], 1u); break; } }
    }
    nloc = mine > 0u ? mine : 1u; nx = cnt > 0u ? cnt : 1u;
}

__device__ __forceinline__ void xcd_barrier(const XcdBarrier& b) {
    asm volatile("s_waitcnt vmcnt(0)" ::: "memory");
    __syncthreads();
    if (my_tid() == 0) {
        unsigned* bar = b.bar;
        __builtin_amdgcn_s_waitcnt(0);
        unsigned nloc = b.st[0], nx = b.st[1];
        if (nloc == 0u) { xcd_barrier_complete(bar, b.x, nloc, nx); b.st[0] = nloc; b.st[1] = nx; }
        const unsigned old = xb_add(&bar[XB_XSUB(b.x)], 1u);
        const unsigned gen = old / nloc;
        if (old + 1u == (gen + 1u) * nloc) {
            __builtin_amdgcn_fence(__ATOMIC_RELEASE, "agent");
            asm volatile("s_waitcnt vmcnt(0)" ::: "memory");
            const unsigned og = xb_add(&bar[XB_TOP], 1u);
            const unsigned tg = og / nx;
            if (og + 1u == (tg + 1u) * nx) xb_add(&bar[XB_TOPGEN], 1u);
            else XB_SPIN(xb_ld(&bar[XB_TOPGEN]) == tg, bar);
            __builtin_amdgcn_fence(__ATOMIC_ACQUIRE, "agent");
            xb_add(&bar[XB_XGEN(b.x)], 1u);
            asm volatile("s_waitcnt vmcnt(0)" ::: "memory");
        } else {
            XB_SPIN(xb_ld(&bar[XB_XGEN(b.x)]) == gen, bar);
            __builtin_amdgcn_fence(__ATOMIC_ACQUIRE, "agent");
            asm volatile("s_waitcnt vmcnt(0)" ::: "memory");
        }
    }
    __syncthreads();
}

struct MapIdent { __device__ __forceinline__ int operator()(int p) const { return p; } };
struct MapWin { __device__ __forceinline__ int operator()(int p) const {
    if (p < 3584) return p; if (p < 5632) return p + 72; if (p < NPROJ) return p + 80;
    const int r = p - NPROJ; if (r < 64) return LC_IK + r; if (r < 72) return LC_IW + (r - 64); if (r < 76) return LC_MI + (r - 72); if (r < 80) return LC_MF + (r - 76); return -1; } };
struct MapFfn { __device__ __forceinline__ int operator()(int p) const { const int t = p >> 8, r = p & 255; return r < 128 ? 128 * t + r : FF + 128 * t + (r - 128); } };
template <class Map> __device__ __forceinline__ void transpose_item(const float* W, int K, int N, bf16* WT, LAS float* scr, int item, int nblk, int lane, const Map& map) {
    const int kb = item / nblk, nb = item % nblk, k0 = 64 * kb, p0 = 64 * nb;
    const int n4 = lane & 15, kr = lane >> 4, nl = map(p0 + 4 * n4);
    f32x4 v[16];
#pragma unroll
    for (int i = 0; i < 16; ++i) v[i] = nl >= 0 ? *(const GAS f32x4*)(W + (size_t)(k0 + kr + 4 * i) * N + nl) : (f32x4){0.f, 0.f, 0.f, 0.f};
#pragma unroll
    for (int i = 0; i < 16; ++i) { LAS float* d = scr + (kr + 4 * i) * 65 + 4 * n4; d[0] = v[i][0]; d[1] = v[i][1]; d[2] = v[i][2]; d[3] = v[i][3]; }
    LDS_WAIT(); asm volatile("" ::: "memory");
    const int c = lane & 7;
#pragma unroll
    for (int j = 0; j < 8; ++j) { const int n = (lane >> 3) + 8 * j; const LAS float* s = scr + (8 * c) * 65 + n;
        v4u o; o.x = pk2(s[0 * 65], s[1 * 65]); o.y = pk2(s[2 * 65], s[3 * 65]); o.z = pk2(s[4 * 65], s[5 * 65]); o.w = pk2(s[6 * 65], s[7 * 65]);
        *(GAS v4u*)(WT + (size_t)(p0 + n) * K + k0 + 8 * c) = o; }
    LDS_WAIT(); asm volatile("" ::: "memory");
}
template <class Map> __device__ __forceinline__ void transpose_matrix(const float* W, int K, int N, int Nphys, bf16* WT, LAS float* scr, int gw, int ngw, int lane, const Map& map) {
    const int nblk = Nphys / 64, nit = (K / 64) * nblk;
    for (int it = gw; it < nit; it += ngw) transpose_item(W, K, N, WT, scr, it, nblk, lane, map);
}

__device__ __forceinline__ void rms_row_to_bf16(const float* xrow, const float* gain, bf16* orow, int lane) {
    const GAS f32x4* xr = (const GAS f32x4*)xrow + lane; const GAS f32x4* gr = (const GAS f32x4*)gain + lane;
    f32x4 v[8]; float s = 0.f;
#pragma unroll
    for (int j = 0; j < 8; ++j) { v[j] = xr[64 * j]; s += (v[j].x * v[j].x + v[j].y * v[j].y) + (v[j].z * v[j].z + v[j].w * v[j].w); }
    const float rstd = 1.0f / sqrtf(wave_sum(s) * (1.f / DM) + NORM_EPS);
    GAS unsigned long long* o8 = (GAS unsigned long long*)orow + lane;
#pragma unroll
    for (int j = 0; j < 8; ++j) { const f32x4 g = gr[64 * j]; o8[64 * j] = (unsigned long long)pk2(v[j].x * rstd * g.x, v[j].y * rstd * g.y) | ((unsigned long long)pk2(v[j].z * rstd * g.z, v[j].w * rstd * g.w) << 32); }
}

struct PPArgs { bf16* proj; const float* small; bf16* mqk; bf16* ikb; unsigned char* sgn; float* gif; const float* rope128; const float* rope64; const float* gq; const float* gk; const float* convw; const float* gbias; };
__device__ __forceinline__ void bf8_unpack(const v4u w, float (&f)[8]) { f[0] = __uint_as_float(w.x << 16); f[1] = __uint_as_float(w.x & 0xffff0000u); f[2] = __uint_as_float(w.y << 16); f[3] = __uint_as_float(w.y & 0xffff0000u);
    f[4] = __uint_as_float(w.z << 16); f[5] = __uint_as_float(w.z & 0xffff0000u); f[6] = __uint_as_float(w.w << 16); f[7] = __uint_as_float(w.w & 0xffff0000u); }
__device__ __forceinline__ v4u bf8_pack(const float (&f)[8]) { v4u o; o.x = pk2(f[0], f[1]); o.y = pk2(f[2], f[3]); o.z = pk2(f[4], f[5]); o.w = pk2(f[6], f[7]); return o; }
__device__ __forceinline__ float sum8_dpp(float x) {
    x += dpp_f<0xB1, 0xf, 0xf>(0.f, x); x += dpp_f<0x4E, 0xf, 0xf>(0.f, x); x += dpp_f<0x141, 0xf, 0xf>(0.f, x); return x; }
__device__ __forceinline__ void pp_row(const PPArgs& a, int t, int lane, const f32x4 (&cw)[16]) {
    bf16* pr = a.proj + (size_t)t * NPROJ;
    const int hd = lane >> 3, d0 = (lane & 7) * 8;
    float cs[8], sn[8];
#pragma unroll
    for (int i = 0; i < 4; ++i) { const f32x4 c = *(const f32x4*)(a.rope128 + ((size_t)t * 64 + d0 + 2 * i) * 2); cs[2 * i] = c[0]; sn[2 * i] = c[1]; cs[2 * i + 1] = c[2]; sn[2 * i + 1] = c[3]; }
#pragma unroll
    for (int seg = 0; seg < 4; ++seg) {
        const int base = seg == 0 ? PC_AQ : (seg == 1 ? PC_AK : (seg == 2 ? PC_RQ : PC_RK));
        bf16* p = pr + base + hd * 128 + d0; float x1[8], x2[8];
        bf8_unpack(*(const GAS v4u*)p, x1); bf8_unpack(*(const GAS v4u*)(p + 64), x2);
        if (seg < 2) { const float* gn = seg ? a.gk : a.gq; float ss = 0.f;
#pragma unroll
            for (int i = 0; i < 8; ++i) ss += x1[i] * x1[i] + x2[i] * x2[i];
            const float rstd = 1.0f / sqrtf(sum8_dpp(ss) * (1.f / 128.f) + NORM_EPS);
            const f32x4 ga = *(const f32x4*)(gn + d0), gb = *(const f32x4*)(gn + d0 + 4), gc = *(const f32x4*)(gn + 64 + d0), gd = *(const f32x4*)(gn + 64 + d0 + 4);
#pragma unroll
            for (int i = 0; i < 4; ++i) { x1[i] *= rstd * ga[i]; x1[4 + i] *= rstd * gb[i]; x2[i] *= rstd * gc[i]; x2[4 + i] *= rstd * gd[i]; } }
        float o1[8], o2[8];
#pragma unroll
        for (int i = 0; i < 8; ++i) { o1[i] = x1[i] * cs[i] - x2[i] * sn[i]; o2[i] = x2[i] * cs[i] + x1[i] * sn[i]; }
        *(GAS v4u*)p = bf8_pack(o1); *(GAS v4u*)(p + 64) = bf8_pack(o2); }
    const float* sm = a.small + (size_t)t * 256;
    {
        const int e0 = (lane & 7) * 4; const f32x4 ca = *(const f32x4*)(a.rope64 + ((size_t)t * 32 + e0) * 2), cb = *(const f32x4*)(a.rope64 + ((size_t)t * 32 + e0 + 2) * 2);
        const float c4[4] = {ca[0], ca[2], cb[0], cb[2]}, s4[4] = {ca[1], ca[3], cb[1], cb[3]};
        bf16* p = pr + PC_IQ + hd * 64 + e0; const v2u lo = *(const GAS v2u*)p, hi = *(const GAS v2u*)(p + 32);
        const float aw = fabsf(sm[64 + hd]) * (0.35355339059327373f * 0.125f);
        const float y1[4] = {__uint_as_float(lo.x << 16), __uint_as_float(lo.x & 0xffff0000u), __uint_as_float(lo.y << 16), __uint_as_float(lo.y & 0xffff0000u)};
        const float y2[4] = {__uint_as_float(hi.x << 16), __uint_as_float(hi.x & 0xffff0000u), __uint_as_float(hi.y << 16), __uint_as_float(hi.y & 0xffff0000u)};
        float q1[4], q2[4];
#pragma unroll
        for (int i = 0; i < 4; ++i) { q1[i] = (y1[i] * c4[i] - y2[i] * s4[i]) * aw; q2[i] = (y2[i] * c4[i] + y1[i] * s4[i]) * aw; }
        v2u w1, w2; w1.x = pk2(q1[0], q1[1]); w1.y = pk2(q1[2], q1[3]); w2.x = pk2(q2[0], q2[1]); w2.y = pk2(q2[2], q2[3]);
        *(GAS v2u*)p = w1; *(GAS v2u*)(p + 32) = w2;
        if (lane < 8) { const f32x4 k1 = *(const f32x4*)(sm + e0), k2 = *(const f32x4*)(sm + 32 + e0); float r1[4], r2[4];
#pragma unroll
            for (int i = 0; i < 4; ++i) { r1[i] = k1[i] * c4[i] - k2[i] * s4[i]; r2[i] = k2[i] * c4[i] + k1[i] * s4[i]; }
            v2u u1, u2; u1.x = pk2(r1[0], r1[1]); u1.y = pk2(r1[2], r1[3]); u2.x = pk2(r2[0], r2[1]); u2.y = pk2(r2[2], r2[3]);
            *(GAS v2u*)(a.ikb + (size_t)t * 64 + e0) = u1; *(GAS v2u*)(a.ikb + (size_t)t * 64 + 32 + e0) = u2; } }
    { const unsigned long long nb = __builtin_amdgcn_ballot_w64(lane < 8 && sm[64 + (lane & 7)] < 0.f); if (lane == 0) a.sgn[t] = (unsigned char)(nb & 0xffull); }
    if (lane < 8) a.gif[(size_t)t * 8 + lane] = sm[72 + lane] + a.gbias[lane];
    {
        float acc[16];
#pragma unroll
        for (int i = 0; i < 16; ++i) acc[i] = 0.f;
#pragma unroll
        for (int j = 0; j < 4; ++j) { const int tt = t - 3 + j; if (tt >= 0) { const bf16* xp = a.proj + (size_t)tt * NPROJ + PC_MQ + 16 * lane; float xa[8], xb[8];
                bf8_unpack(*(const GAS v4u*)xp, xa); bf8_unpack(*(const GAS v4u*)(xp + 8), xb);
#pragma unroll
                for (int i = 0; i < 4; ++i) { acc[i] += cw[j * 4][i] * xa[i]; acc[4 + i] += cw[j * 4 + 1][i] * xa[4 + i]; acc[8 + i] += cw[j * 4 + 2][i] * xb[i]; acc[12 + i] += cw[j * 4 + 3][i] * xb[4 + i]; } } }
        float oa[8], ob[8];
#pragma unroll
        for (int i = 0; i < 8; ++i) { oa[i] = acc[i]; ob[i] = acc[8 + i]; }
        bf16* mp = a.mqk + (size_t)t * 1024 + 16 * lane; *(GAS v4u*)mp = bf8_pack(oa); *(GAS v4u*)(mp + 8) = bf8_pack(ob); }
}

constexpr int SCT_RS = 272, IQT_RS = 1040, IQT_BYTES = 32 * IQT_RS;
__device__ __forceinline__ void score_wave_unit(LAS unsigned char* wt, const LAS unsigned char* iqt, const bf16* ikb, const unsigned char* sgn, float* sc, int qb, int kb, int lane) {
    const int r = lane & 31, h = lane >> 5, q0 = qb * 32, s0 = kb * 64;
    bf16x8 ka[2][4];
#pragma unroll
    for (int b = 0; b < 2; ++b)
#pragma unroll
        for (int kk = 0; kk < 4; ++kk) ka[b][kk] = *(const bf16x8*)(ikb + (size_t)(s0 + 32 * b + r) * 64 + 16 * kk + 8 * h);
    const LAS unsigned char* qrow = iqt + r * IQT_RS + 16 * h;
    const unsigned sb = sgn[q0 + r];
    f32x16 scv[2];
#pragma unroll
    for (int b = 0; b < 2; ++b)
#pragma unroll
        for (int e = 0; e < 16; ++e) scv[b][e] = 0.f;
#pragma unroll 2
    for (int j = 0; j < 8; ++j) { bf16x8 qf[4];
#pragma unroll
        for (int kk = 0; kk < 4; ++kk) qf[kk] = *(const LAS bf16x8*)(qrow + j * 128 + kk * 32);
        const float sj = ((sb >> j) & 1u) ? -1.0f : 1.0f;
#pragma unroll
        for (int b = 0; b < 2; ++b) { f32x16 acc;
#pragma unroll
            for (int e = 0; e < 16; ++e) acc[e] = 0.f;
#pragma unroll
            for (int kk = 0; kk < 4; ++kk) acc = __builtin_amdgcn_mfma_f32_32x32x16_bf16(ka[b][kk], qf[kk], acc, 0, 0, 0);
#pragma unroll
            for (int e = 0; e < 16; ++e) scv[b][e] = fmaf(fmaxf(acc[e], 0.f), sj, scv[b][e]); } }
#pragma unroll
    for (int b = 0; b < 2; ++b)
#pragma unroll
        for (int g = 0; g < 4; ++g) *(LAS f32x4*)(wt + r * SCT_RS + (32 * b + 8 * g + 4 * h) * 4) = (f32x4){scv[b][4 * g], scv[b][4 * g + 1], scv[b][4 * g + 2], scv[b][4 * g + 3]};
#pragma unroll
    for (int k = 0; k < 8; ++k) { const int row = 4 * k + (lane >> 4), c4 = (lane & 15) * 4;
        const f32x4 x = *(const LAS f32x4*)(wt + row * SCT_RS + c4 * 4);
        *(GAS f32x4*)(sc + (size_t)(q0 + row) * S + s0 + c4) = x; }
}


__device__ __forceinline__ float wave_max_dpp(float x) { return wave_max(x); }
__device__ __forceinline__ float wave_min_dpp(float x) { return -wave_max_dpp(-x); }
__device__ __forceinline__ unsigned wave_prefix_dpp(unsigned x) {
    unsigned y = x + dpp_u<0x111, 0xf, 0xf>(x); y += dpp_u<0x112, 0xf, 0xf>(x); y += dpp_u<0x113, 0xf, 0xf>(x);
    y += dpp_u<0x114, 0xf, 0xe>(y); y += dpp_u<0x118, 0xf, 0xc>(y); y += dpp_u<0x142, 0xa, 0xf>(y); y += dpp_u<0x143, 0xc, 0xf>(y);
    return y; }
#define SEL_BAR() do { asm volatile("s_waitcnt lgkmcnt(0)" ::: "memory"); __builtin_amdgcn_s_barrier(); asm volatile("" ::: "memory"); } while (0)
#define SEL_ROW(i) ((i) < n0 ? row0 + (i) * rstep : xrow0 + ((i) - n0) * xstep)
__device__ __forceinline__ void select_rows_wg(LAS unsigned char* lds, const float* sc, unsigned long long* mb, int row0, int rstep, int n0, int xrow0, int xstep, int n1, int tid) {
    LAS unsigned* hist = (LAS unsigned*)lds;
    LAS unsigned* btot = hist + 2176;
    LAS float* red = (LAS float*)(hist + 2240); LAS unsigned* lcnt = hist + 2256;
    LAS float* lval = (LAS float*)(hist + 2272); LAS int* lidx = (LAS int*)(hist + 2272 + 8192); LAS unsigned* lsel = hist + 2272 + 16384;
    const int lane = tid & 63, w = tid >> 6;
    f32x4 nx[4];
#define SEL_LOAD(t_) do { const float* scr_ = sc + (size_t)(t_) * S + 4 * tid; _Pragma("unroll") for (int j = 0; j < 4; ++j) nx[j] = *(const GAS f32x4*)(scr_ + 2048 * j); } while (0)
    const int nrows = n0 + n1;
    if (nrows > 0) SEL_LOAD(SEL_ROW(0));
    if (tid < 2) lcnt[tid] = 0u;
    for (int j = tid; j < 2240; j += NTHR) hist[j] = 0u;
    if (tid == 0) lsel[0] = 0u;
    int par = 0;
    for (int ri = 0; ri < nrows; ++ri) { const int t = SEL_ROW(ri);
        float v[16];
#pragma unroll
        for (int j = 0; j < 4; ++j)
#pragma unroll
            for (int c = 0; c < 4; ++c) v[4 * j + c] = (2048 * j + 4 * tid + c <= t) ? nx[j][c] : -3.0e38f;
        if (ri + 1 < nrows) SEL_LOAD(SEL_ROW(ri + 1));
        unsigned long long* mbr = mb + (size_t)t * 128;
        bool sel[16];
        if (t >= 256) {
            const int ngrp = (t >> 11) + 1;
            float mn = 3.0e38f, mx = -3.0e38f;
#pragma unroll
            for (int i = 0; i < 16; ++i) { mx = fmaxf(mx, v[i]); mn = fminf(mn, (v[i] > -3.0e38f) ? v[i] : 3.0e38f); }
            mn = wave_min_dpp(mn); mx = wave_max_dpp(mx);
            if (lane == 0) { red[w] = mn; red[8 + w] = mx; }
            SEL_BAR();
            mn = red[0]; mx = red[8];
#pragma unroll
            for (int j = 1; j < 8; ++j) { mn = fminf(mn, red[j]); mx = fmaxf(mx, red[8 + j]); }
            const float scale = (mx > mn) ? 2047.0f / (mx - mn) : 0.f;
            int bin[16];
#pragma unroll
            for (int i = 0; i < 16; ++i) { int b = (int)((v[i] - mn) * scale); b = b < 0 ? 0 : (b > 2047 ? 2047 : b); const bool ok = v[i] > -3.0e38f; bin[i] = ok ? b : -1;
                if ((i >> 2) < ngrp) { (void)__hip_atomic_fetch_add(hist + (ok ? b + (b >> 5) : 2112 + lane), 1u, __ATOMIC_RELAXED, __HIP_MEMORY_SCOPE_WORKGROUP);
                    (void)__hip_atomic_fetch_add(btot + (ok ? (b >> 5) : 0), ok ? 1u : 0u, __ATOMIC_RELAXED, __HIP_MEMORY_SCOPE_WORKGROUP); } }
            SEL_BAR();
            const unsigned bt = btot[63 - lane]; const unsigned sufb = wave_prefix_dpp(bt);
            const unsigned long long ob = __builtin_amdgcn_ballot_w64(sufb >= 256u);
            const int olb = ob ? (int)__builtin_ctzll(ob) : 0; const int blk = 63 - olb;
            const unsigned above_blk = (unsigned)__builtin_amdgcn_readlane((int)(sufb - bt), olb);
            const unsigned hbn = (lane < 32) ? hist[33 * blk + 31 - lane] : 0u; const unsigned sufn = wave_prefix_dpp(hbn) + above_blk;
            const unsigned long long on = __builtin_amdgcn_ballot_w64(lane < 32 && sufn >= 256u);
            const int oln = on ? (int)__builtin_ctzll(on) : 0;
            const int bstar = 32 * blk + 31 - oln; const unsigned need = 256u - (unsigned)__builtin_amdgcn_readlane((int)(sufn - hbn), oln);
            int ks[16];
#pragma unroll
            for (int i = 0; i < 16; ++i) { ks[i] = -1; if (bin[i] == bstar) { const unsigned k = __hip_atomic_fetch_add(lcnt + par, 1u, __ATOMIC_RELAXED, __HIP_MEMORY_SCOPE_WORKGROUP); lval[k] = v[i]; lidx[k] = 2048 * (i >> 2) + 4 * tid + (i & 3); ks[i] = (int)k; } }
            SEL_BAR();
            const int nl = (int)lcnt[par];
            for (int k = tid; k < nl; k += NTHR) { const float x = lval[k]; const int s = lidx[k]; unsigned rank = 0u;
                for (int j = 0; j < nl; ++j) { const float y = lval[j]; const int sj = lidx[j]; rank += (y > x || (y == x && sj < s)) ? 1u : 0u; }
                lsel[k] = rank < need ? 1u : 0u; }
            SEL_BAR();
#pragma unroll
            for (int i = 0; i < 16; ++i) { const unsigned lv = lsel[ks[i] < 0 ? 0 : ks[i]]; sel[i] = bin[i] > bstar || (ks[i] >= 0 && lv != 0u); }
            *(LAS v4u*)(hist + 4 * tid) = (v4u){0u, 0u, 0u, 0u}; if (tid < 48) *(LAS v4u*)(hist + 2048 + 4 * tid) = (v4u){0u, 0u, 0u, 0u};
            if (tid == 0) lcnt[par ^ 1] = 0u;
            par ^= 1;
        } else {
#pragma unroll
            for (int i = 0; i < 16; ++i) sel[i] = v[i] > -3.0e38f;
        }
#pragma unroll
        for (int j = 0; j < 4; ++j) { unsigned long long wd = 0ull;
#pragma unroll
            for (int c = 0; c < 4; ++c) { const unsigned long long b = __builtin_amdgcn_ballot_w64(sel[4 * j + c]); wd |= ((b >> (16 * (lane & 3))) & 0xffffull) << (16 * c); }
            if (lane < 4) mbr[32 * j + 4 * w + lane] = wd; }
    }
    SEL_BAR();
#undef SEL_LOAD
#undef SEL_ROW
}

template <int RS> __device__ __forceinline__ bf16x8 frag_row(const LAS unsigned char* base, int r0, int k0, int lane) {
    return *(const LAS bf16x8*)(base + (r0 + (lane & 15)) * RS + (k0 + 8 * (lane >> 4)) * 2);
}
template <int RS> __device__ __forceinline__ bf16x8 frag_tr(const LAS unsigned char* base, int k0, int c0, int lane) {
    const int g = lane >> 4, q = (lane & 15) >> 2, p = lane & 3;
    const unsigned a = (unsigned)(size_t)(base + (k0 + 8 * g + q) * RS + (c0 + 4 * p) * 2);
    s16x4 lo, hi;
    asm volatile("ds_read_b64_tr_b16 %0, %2\n\tds_read_b64_tr_b16 %1, %2 offset:%3\n\ts_waitcnt lgkmcnt(0)" : "=&v"(lo), "=&v"(hi) : "v"(a), "i"(4 * RS) : "memory");
    return (bf16x8){lo[0], lo[1], lo[2], lo[3], hi[0], hi[1], hi[2], hi[3]};
}
#define MFMA16(a, b, c) __builtin_amdgcn_mfma_f32_16x16x32_bf16((a), (b), (c), 0, 0, 0)
constexpr int SCR_OFF = 114688;
constexpr float DK_SCALE = 0.08838834764831845f;
__device__ __forceinline__ float log_sigmoid_f(float x) { return fminf(x, 0.f) - log1pf(expf(-fabsf(x))); }

template <int L, int DV> __device__ __forceinline__ void chunk_delta(LAS unsigned char* lds, const bf16* ksrc, int ldk, const bf16* vsrc, int ldv, const LAS float* wcol, bf16* outT, float* dn, int tid) {
    constexpr int RSK = (128 + 8) * 2, RSV = (DV + 8) * 2, NCB = DV / 128;
    LAS unsigned char* KA = lds; LAS unsigned char* V = lds + L * RSK;
    const int lane = tid & 63, w = tid >> 6;
    for (int idx = tid; idx < L * 16; idx += NTHR) { const int s = idx >> 4, c8 = idx & 15;
        const v4u x = *(const GAS v4u*)(ksrc + (size_t)s * ldk + c8 * 8); const float sc = DK_SCALE * wcol[s]; v4u o;
        o.x = pk2(__uint_as_float(x.x << 16) * sc, __uint_as_float(x.x & 0xffff0000u) * sc); o.y = pk2(__uint_as_float(x.y << 16) * sc, __uint_as_float(x.y & 0xffff0000u) * sc);
        o.z = pk2(__uint_as_float(x.z << 16) * sc, __uint_as_float(x.z & 0xffff0000u) * sc); o.w = pk2(__uint_as_float(x.w << 16) * sc, __uint_as_float(x.w & 0xffff0000u) * sc);
        *(LAS v4u*)(KA + s * RSK + c8 * 16) = o; }
    for (int idx = tid; idx < L * (DV / 8); idx += NTHR) { const int s = idx / (DV / 8), c8 = idx % (DV / 8);
        *(LAS v4u*)(V + s * RSV + c8 * 16) = *(const GAS v4u*)(vsrc + (size_t)s * ldv + c8 * 8); }
    __syncthreads();
    f32x4 acc[8][NCB];
#pragma unroll
    for (int db = 0; db < 8; ++db)
#pragma unroll
        for (int i = 0; i < NCB; ++i) acc[db][i] = (f32x4){0.f, 0.f, 0.f, 0.f};
#pragma unroll
    for (int kk = 0; kk < L / 32; ++kk) {
        bf16x8 bfr[NCB];
#pragma unroll
        for (int i = 0; i < NCB; ++i) bfr[i] = frag_tr<RSV>(V, 32 * kk, 16 * (w * NCB + i), lane);
#pragma unroll
        for (int db = 0; db < 8; ++db) { const bf16x8 a = frag_tr<RSK>(KA, 32 * kk, 16 * db, lane);
#pragma unroll
            for (int i = 0; i < NCB; ++i) acc[db][i] = MFMA16(a, bfr[i], acc[db][i]); }
    }
#pragma unroll
    for (int db = 0; db < 8; ++db)
#pragma unroll
        for (int i = 0; i < NCB; ++i) { const int e = 16 * (w * NCB + i) + (lane & 15), d0 = 16 * db + 4 * (lane >> 4);
            v2u o; o.x = pk2(acc[db][i][0], acc[db][i][1]); o.y = pk2(acc[db][i][2], acc[db][i][3]);
            *(GAS v2u*)(outT + (size_t)e * 128 + d0) = o; }
    if (dn != nullptr && tid < 128) { float s_ = 0.f;
        for (int s = 0; s < L; ++s) s_ += bf2f(*(const LAS bf16*)(KA + s * RSK + tid * 2));
        dn[tid] = s_; }
    __syncthreads();
}

template <int L, int DV, int MODE> __device__ __forceinline__ void chunk_out(LAS unsigned char* lds, LAS float* sf, const bf16* qsrc, int ldq, const bf16* ksrc, int ldk, const bf16* vsrc, int ldv,
                                                                              const bf16* stT, const float* gain, const bf16* gate, int ldg, bf16* y, int ldy, int tid) {
    constexpr int RSQ = (128 + 8) * 2, RSV = (DV + 8) * 2, RSP = (L + 8) * 2, NCB = DV / 128, NT = L / 16, TPW = NT * NT / 8;
    LAS unsigned char* Q = lds; LAS unsigned char* K = lds + L * RSQ; LAS unsigned char* V = lds + 2 * L * RSQ;
    LAS unsigned char* P = (MODE == 0) ? (lds + 2 * L * RSQ + L * RSV) : K;
    LAS float* H = (LAS float*)lds;
    LAS float* lrow = sf; LAS float* lcol = sf + 128; LAS float* qs = sf + 256; LAS float* flo = sf + 384; LAS float* rowsum = sf + 512; LAS float* npv = sf + 640; LAS float* part = sf + 768; LAS float* dpart = sf + 768 + L * NT;
    const int lane = tid & 63, w = tid >> 6, g4 = lane >> 4, c16 = lane & 15;
    for (int idx = tid; idx < L * 16; idx += NTHR) { const int s = idx >> 4, c8 = idx & 15;
        *(LAS v4u*)(Q + s * RSQ + c8 * 16) = *(const GAS v4u*)(qsrc + (size_t)s * ldq + c8 * 8);
        *(LAS v4u*)(K + s * RSQ + c8 * 16) = *(const GAS v4u*)(ksrc + (size_t)s * ldk + c8 * 8); }
    for (int idx = tid; idx < L * (DV / 8); idx += NTHR) { const int s = idx / (DV / 8), c8 = idx % (DV / 8);
        *(LAS v4u*)(V + s * RSV + c8 * 16) = *(const GAS v4u*)(vsrc + (size_t)s * ldv + c8 * 8); }
    __syncthreads();
    f32x4 pv[TPW];
#pragma unroll
    for (int i = 0; i < TPW; ++i) { const int ti = w * TPW + i, rb = ti / NT, cb = ti % NT; f32x4 a = (f32x4){0.f, 0.f, 0.f, 0.f};
        if (cb <= rb) {
#pragma unroll
            for (int kk = 0; kk < 4; ++kk) a = MFMA16(frag_row<RSQ>(Q, 16 * rb, 32 * kk, lane), frag_row<RSQ>(K, 16 * cb, 32 * kk, lane), a);
            const int s = 16 * cb + c16; const float lc = lcol[s]; float rs[4];
#pragma unroll
            for (int r = 0; r < 4; ++r) { const int t = 16 * rb + 4 * g4 + r; const float pw = (s <= t) ? __expf(lrow[t] + lc) * a[r] * DK_SCALE : 0.f; a[r] = pw; rs[r] = pw; }
            if (MODE == 0) {
#pragma unroll
                for (int r = 0; r < 4; ++r) { float v = rs[r]; v += dpp_f<0xB1, 0xf, 0xf>(0.f, v); v += dpp_f<0x4E, 0xf, 0xf>(0.f, v); v += dpp_f<0x141, 0xf, 0xf>(0.f, v); v += dpp_f<0x140, 0xf, 0xf>(0.f, v);
                    if (c16 == 0) part[(16 * rb + 4 * g4 + r) * NT + cb] = v; } }
        } else if (MODE == 0) { if (c16 == 0) {
#pragma unroll
                for (int r = 0; r < 4; ++r) part[(16 * rb + 4 * g4 + r) * NT + cb] = 0.f; } }
        pv[i] = a; }
    __syncthreads();
#pragma unroll
    for (int i = 0; i < TPW; ++i) { const int ti = w * TPW + i, rb = ti / NT, cb = ti % NT;
#pragma unroll
        for (int r = 0; r < 4; ++r) *(LAS bf16*)(P + (16 * rb + 4 * g4 + r) * RSP + (16 * cb + c16) * 2) = (bf16)f2bf(pv[i][r]); }
    for (int idx = tid; idx < L * 16; idx += NTHR) { const int s = idx >> 4, c8 = idx & 15; const float sc = qs[s];
        const v4u x = *(const LAS v4u*)(Q + s * RSQ + c8 * 16); float f[8];
        f[0] = __uint_as_float(x.x << 16) * sc; f[1] = __uint_as_float(x.x & 0xffff0000u) * sc; f[2] = __uint_as_float(x.y << 16) * sc; f[3] = __uint_as_float(x.y & 0xffff0000u) * sc;
        f[4] = __uint_as_float(x.z << 16) * sc; f[5] = __uint_as_float(x.z & 0xffff0000u) * sc; f[6] = __uint_as_float(x.w << 16) * sc; f[7] = __uint_as_float(x.w & 0xffff0000u) * sc;
        v4u o; o.x = pk2(f[0], f[1]); o.y = pk2(f[2], f[3]); o.z = pk2(f[4], f[5]); o.w = pk2(f[6], f[7]);
        *(LAS v4u*)(Q + s * RSQ + c8 * 16) = o;
        if (MODE == 0) { float dsum = 0.f;
#pragma unroll
            for (int j = 0; j < 8; ++j) dsum += f[j] * npv[8 * c8 + j];
            dpart[s * 16 + c8] = dsum; } }
    __syncthreads();
    if (MODE == 0 && tid < L) { float a = 0.f;
#pragma unroll
        for (int j = 0; j < NT; ++j) a += part[tid * NT + j];
#pragma unroll
        for (int j = 0; j < 16; ++j) a += dpart[tid * 16 + j];
        rowsum[tid] = a; }
    f32x4 acc[NT][NCB];
#pragma unroll
    for (int rb = 0; rb < NT; ++rb)
#pragma unroll
        for (int i = 0; i < NCB; ++i) acc[rb][i] = (f32x4){0.f, 0.f, 0.f, 0.f};
#pragma unroll
    for (int kk = 0; kk < 4; ++kk) { bf16x8 bfr[NCB];
#pragma unroll
        for (int i = 0; i < NCB; ++i) bfr[i] = *(const GAS bf16x8*)(stT + (size_t)(16 * (w * NCB + i) + c16) * 128 + 32 * kk + 8 * g4);
#pragma unroll
        for (int rb = 0; rb < NT; ++rb) { const bf16x8 a = frag_row<RSQ>(Q, 16 * rb, 32 * kk, lane);
#pragma unroll
            for (int i = 0; i < NCB; ++i) acc[rb][i] = MFMA16(a, bfr[i], acc[rb][i]); } }
#pragma unroll
    for (int kk = 0; kk < L / 32; ++kk) { bf16x8 bfr[NCB];
#pragma unroll
        for (int i = 0; i < NCB; ++i) bfr[i] = frag_tr<RSV>(V, 32 * kk, 16 * (w * NCB + i), lane);
#pragma unroll
        for (int rb = 0; rb < NT; ++rb) { const bf16x8 a = frag_row<RSP>(P, 16 * rb, 32 * kk, lane);
#pragma unroll
            for (int i = 0; i < NCB; ++i) acc[rb][i] = MFMA16(a, bfr[i], acc[rb][i]); } }
    __syncthreads();
#pragma unroll
    for (int rb = 0; rb < NT; ++rb)
#pragma unroll
        for (int i = 0; i < NCB; ++i)
#pragma unroll
            for (int r = 0; r < 4; ++r) { const int t = 16 * rb + 4 * g4 + r, e = 16 * (w * NCB + i) + c16; float hv = acc[rb][i][r];
                if (MODE == 0) hv = hv / fmaxf(fabsf(rowsum[t]), flo[t]);
                H[t * DV + e] = hv; }
    __syncthreads();
    for (int t = w; t < L; t += NWAVES) { float hv[DV / 64]; float s1 = 0.f;
#pragma unroll
        for (int i = 0; i < DV / 64; ++i) { hv[i] = H[t * DV + lane + 64 * i]; s1 += hv[i]; }
        float mu = 0.f; if (MODE == 1) { mu = wave_sum(s1) * (1.f / DV); }
        float s2 = 0.f;
#pragma unroll
        for (int i = 0; i < DV / 64; ++i) { hv[i] -= mu; s2 += hv[i] * hv[i]; }
        const float rstd = 1.0f / sqrtf(wave_sum(s2) * (1.f / DV) + NORM_EPS);
#pragma unroll
        for (int i = 0; i < DV / 64; ++i) { const int e = lane + 64 * i; const float gt = bf2f(gate[(size_t)t * ldg + e]);
            const float act = (MODE == 0) ? sigmoid_f(gt) : gt * sigmoid_f(gt);
            y[(size_t)t * ldy + e] = (bf16)f2bf(hv[i] * rstd * gain[e] * act); } }
    __syncthreads();
}
namespace att {
constexpr int D = 128, LDQKV = NPROJ, LDO = 1024;
constexpr float THR = 8.f; constexpr bool WSKIP = false;
constexpr float SCALE = 0.08838834764831845f;
constexpr int NW = 8, QBLK = 32, KVBLK = 64, QB = NW * QBLK;
constexpr int SHM_V = KVBLK * D * 2, SHM_K = KVBLK * D * 2;
constexpr int LDS_BYTES = 2 * SHM_V + 2 * SHM_K + NW * 64 * 4;

using bf16 = unsigned short;
typedef short bf16x8 __attribute__((ext_vector_type(8)));
typedef short s16x4 __attribute__((ext_vector_type(4)));
typedef float f32x16 __attribute__((ext_vector_type(16)));
typedef float f32x4 __attribute__((ext_vector_type(4)));
typedef unsigned u32x4 __attribute__((ext_vector_type(4)));
template <class A, class Bt> struct same_t { static constexpr bool v = false; };
template <class A> struct same_t<A, A> { static constexpr bool v = true; };

#define KSWZ(row, colB) ((row) * 256 + ((colB) ^ (((row) & 7) << 4)))
#define SBAR() __builtin_amdgcn_sched_barrier(0)
__device__ __forceinline__ int v_st(int k, int c) { const int kk = (k & ~0xC) | ((k & 4) << 1) | ((k & 8) >> 1); return ((kk >> 3) * 4 + (c >> 5)) * 512 + ((kk & 7) * 32 + (c & 31)) * 2; }
__device__ __forceinline__ int v_rd_base(int lane) { return ((lane & 3) << 3) | (((lane >> 2) & 3) << 6) | (((lane >> 4) & 1) << 5) | (((lane >> 5) & 1) << 8); }
constexpr int v_rd_off(int d0, int ks, int half) { return d0 * 512 + ks * 4096 + half * 2048; }
__device__ __forceinline__ int crow(int r, int hi) { return (r & 3) + 8 * (r >> 2) + 4 * hi; }
__device__ __forceinline__ unsigned cvtpk(float lo, float hi) {
    unsigned r; asm volatile("v_cvt_pk_bf16_f32 %0, %1, %2" : "=v"(r) : "v"(lo), "v"(hi)); return r;
}
__device__ __forceinline__ bf16x8 pack8(f32x4 a, f32x4 b) {
    u32x4 w = {cvtpk(a[0], a[1]), cvtpk(a[2], a[3]), cvtpk(b[0], b[1]), cvtpk(b[2], b[3])};
    return *reinterpret_cast<bf16x8*>(&w);
}
template <class T> __device__ __forceinline__ bf16x8 load8(const T* p) {
    if constexpr (same_t<T, float>::v) { return pack8(*(const f32x4*)p, *(const f32x4*)(p + 4)); }
    else { return *reinterpret_cast<const bf16x8*>(p); }
}
__device__ __forceinline__ unsigned long long mask_word(const char* tile_base, int row) { unsigned off = (unsigned)row; asm volatile("" : "+v"(off)); off *= 1024u; return *(const unsigned long long*)(tile_base + off); }
__device__ __forceinline__ void mask_bits(f32x16& p0, f32x16& p1, unsigned long long mw, int hi) {
    const unsigned long long ws = mw >> hi; const unsigned lo = (unsigned)ws, up = (unsigned)(ws >> 32);
#pragma unroll
    for (int r = 0; r < 16; ++r) {
        const int c = 16 * (r & 1) + 2 * (r >> 2); const unsigned x = (r & 2) ? up : lo;
        const unsigned ma = (unsigned)(((int)(x << (31 - c))) >> 31), mb = (unsigned)(((int)(x << (31 - c - 8))) >> 31);
        p0[r] = __uint_as_float((__float_as_uint(p0[r]) & ma) | (0xff800000u & ~ma));
        p1[r] = __uint_as_float((__float_as_uint(p1[r]) & mb) | (0xff800000u & ~mb));
    }
}
__device__ __forceinline__ void partialSM(f32x16& p0, f32x16& p1, float& m_reg, float& mn, float& alpha) {
    float pmax = p0[0]; for (int r = 1; r < 16; ++r) pmax = fmaxf(pmax, p0[r]); for (int r = 0; r < 16; ++r) pmax = fmaxf(pmax, p1[r]);
    { auto rr = __builtin_amdgcn_permlane32_swap(__float_as_uint(pmax), __float_as_uint(pmax), false, false);
      pmax = fmaxf(__uint_as_float(rr[0]), __uint_as_float(rr[1])); }
    constexpr float C2 = 1.4426950408889634f * SCALE;
    if (__builtin_expect(__all((pmax - m_reg) * SCALE <= THR), 1)) { mn = m_reg; alpha = 1.f; }
    else { mn = fmaxf(m_reg, pmax); alpha = __builtin_amdgcn_exp2f((m_reg - mn) * C2); m_reg = mn; }
    const float mnL = -mn * C2;
    for (int r = 0; r < 16; ++r) p0[r] = fmaf(p0[r], C2, mnL); for (int r = 0; r < 16; ++r) p1[r] = fmaf(p1[r], C2, mnL);
    for (int r = 0; r < 16; ++r) p0[r] = __builtin_amdgcn_exp2f(p0[r]);
}
__device__ __forceinline__ void finishSM(f32x16& p0, f32x16& p1, float alpha, float& l_reg, bf16x8& pa0, bf16x8& pa1, bf16x8& pa2, bf16x8& pa3) {
    for (int r = 0; r < 16; ++r) p1[r] = __builtin_amdgcn_exp2f(p1[r]);
    float ps = 0; for (int r = 0; r < 16; ++r) ps += p0[r]; for (int r = 0; r < 16; ++r) ps += p1[r];
    { auto rr = __builtin_amdgcn_permlane32_swap(__float_as_uint(ps), __float_as_uint(ps), false, false);
      ps = __uint_as_float(rr[0]) + __uint_as_float(rr[1]); }
    l_reg = l_reg * alpha + ps;
#define PK4(P, B_, OUT) do { unsigned a0 = cvtpk(P[B_+0], P[B_+1]), a1 = cvtpk(P[B_+2], P[B_+3]);                          \
        unsigned b0 = cvtpk(P[B_+4], P[B_+5]), b1 = cvtpk(P[B_+6], P[B_+7]);                                             \
        auto r0 = __builtin_amdgcn_permlane32_swap(a0, b0, false, false); auto r1 = __builtin_amdgcn_permlane32_swap(a1, b1, false, false); \
        u32x4 w = {r0[0], r1[0], r0[1], r1[1]}; OUT = *reinterpret_cast<bf16x8*>(&w); } while (0)
    PK4(p0, 0, pa0); PK4(p0, 8, pa1); PK4(p1, 0, pa2); PK4(p1, 8, pa3);
#undef PK4
}
template <int KB, bool SK>
__device__ __forceinline__ void qkt(f32x16& p0, f32x16& p1, const char* K_lds, int r32, int hi, const bf16x8* qr, bool act) {
    if (SK && !act) { const float NEG = -__builtin_inff();
#pragma unroll
        for (int r = 0; r < 16; ++r) { p0[r] = NEG; p1[r] = NEG; } return; }
    p0 = f32x16{}; p1 = f32x16{};
    const char* kb[4];
#pragma unroll
    for (int dd = 0; dd < 4; ++dd) kb[dd] = K_lds + KB * SHM_K + KSWZ(r32, (dd * 16 + hi * 8) * 2);
#pragma unroll
    for (int d0 = 0; d0 < 8; ++d0) { const char* a = kb[d0 & 3] + (d0 >> 2) * 128;
        bf16x8 b0 = *reinterpret_cast<const bf16x8*>(a);
        bf16x8 b1 = *reinterpret_cast<const bf16x8*>(a + 32 * 256);
        p0 = __builtin_amdgcn_mfma_f32_32x32x16_bf16(b0, qr[d0], p0, 0, 0, 0);
        p1 = __builtin_amdgcn_mfma_f32_32x32x16_bf16(b1, qr[d0], p1, 0, 0, 0); }
}
template <int VB, bool SK>
__device__ __forceinline__ void pv_tile(f32x16* o, int vb0, bf16x8 pa0, bf16x8 pa1, bf16x8 pa2, bf16x8 pa3, bool act) {
    if (SK && !act) return;
#define TRRD(dst, off) asm volatile("ds_read_b64_tr_b16 %0, %1 offset:%2" : "=&v"(dst) : "v"(vb0), "i"(off) : "memory")
#define PV_D0(d0) do { s16x4 l0, l1, l2, l3, h0, h1, h2, h3; constexpr int b_ = VB * SHM_V + v_rd_off(d0, 0, 0);     \
        TRRD(l0, b_); TRRD(h0, b_ + 2048); TRRD(l1, b_ + 4096); TRRD(h1, b_ + 6144); TRRD(l2, b_ + 8192); TRRD(h2, b_ + 10240); TRRD(l3, b_ + 12288); TRRD(h3, b_ + 14336); \
        asm volatile("s_waitcnt lgkmcnt(0)" ::: "memory"); SBAR();                 \
        o[d0] = __builtin_amdgcn_mfma_f32_32x32x16_bf16(pa0, (bf16x8){l0[0], l0[1], l0[2], l0[3], h0[0], h0[1], h0[2], h0[3]}, o[d0], 0, 0, 0);   \
        o[d0] = __builtin_amdgcn_mfma_f32_32x32x16_bf16(pa1, (bf16x8){l1[0], l1[1], l1[2], l1[3], h1[0], h1[1], h1[2], h1[3]}, o[d0], 0, 0, 0);   \
        o[d0] = __builtin_amdgcn_mfma_f32_32x32x16_bf16(pa2, (bf16x8){l2[0], l2[1], l2[2], l2[3], h2[0], h2[1], h2[2], h2[3]}, o[d0], 0, 0, 0);   \
        o[d0] = __builtin_amdgcn_mfma_f32_32x32x16_bf16(pa3, (bf16x8){l3[0], l3[1], l3[2], l3[3], h3[0], h3[1], h3[2], h3[3]}, o[d0], 0, 0, 0); } while (0)
    PV_D0(0); PV_D0(1); PV_D0(2); PV_D0(3);
#undef PV_D0
#undef TRRD
}

template <class TIn, class TOut> struct BlockRef { const TIn* Q; const TIn* K; const TIn* V; TOut* O; const unsigned long long* M; int P0; };
template <class TIn> struct Seam {
    bf16x8 qr[8];
    bf16x8 st_v0, st_v1, st_k0, st_k1; f32x4 sf0, sf1, sf2, sf3;
    f32x4 tq[16];
};
__device__ __forceinline__ int swa_jlo(int P0, int W) { const int lowk = P0 - W + 1; return lowk > 0 ? lowk / KVBLK : 0; }
#define ROW(p, k0, rr) ((p) + (size_t)((k0) + (rr)) * LDQKV + sc)
#define VMW() asm volatile("s_waitcnt vmcnt(0)" ::: "memory")
#define VMWN(n) asm volatile("s_waitcnt vmcnt(%0)" :: "i"(n) : "memory")
#define LD16U(base, off) (*reinterpret_cast<const bf16x8*>((const char*)(base) + (off)))
#define SLOAD_H(Kp, Vp, k0) do { const char* kb_ = (const char*)((Kp) + (size_t)(k0) * LDQKV); const char* vb_ = (const char*)((Vp) + (size_t)(k0) * LDQKV);                 \
                         S.st_v0 = LD16U(vb_, soff); S.st_v1 = LD16U(vb_ + (size_t)32 * LDQKV * 2, soff);                                  \
                         S.st_k0 = LD16U(kb_, soff); S.st_k1 = LD16U(kb_ + (size_t)32 * LDQKV * 2, soff); } while (0)
#define SWRITE_HK(bf) do { *(bf16x8*)(K_lds + (bf) * SHM_K + kws) = S.st_k0; *(bf16x8*)(K_lds + (bf) * SHM_K + kws + 32 * 256) = S.st_k1; } while (0)
#define SWRITE_HV(bf) do { *(bf16x8*)(V_lds + (bf) * SHM_V + vst0) = S.st_v0; *(bf16x8*)(V_lds + (bf) * SHM_V + vst1) = S.st_v1; } while (0)
#define SWRITE_H(bf) do { SWRITE_HV(bf); SWRITE_HK(bf); } while (0)
#define SLOAD_F(p, k0) do { S.sf0 = *(const f32x4*)ROW(p, k0, sr); S.sf1 = *(const f32x4*)(ROW(p, k0, sr) + 4);                \
                            S.sf2 = *(const f32x4*)ROW(p, k0, 32 + sr); S.sf3 = *(const f32x4*)(ROW(p, k0, 32 + sr) + 4); } while (0)
#define SWRITE_KF(bf) do { *(bf16x8*)(K_lds + (bf) * SHM_K + kws) = pack8(S.sf0, S.sf1); *(bf16x8*)(K_lds + (bf) * SHM_K + kws + 32 * 256) = pack8(S.sf2, S.sf3); } while (0)
#define SWRITE_VF(bf) do { *(bf16x8*)(V_lds + (bf) * SHM_V + vst0) = pack8(S.sf0, S.sf1); *(bf16x8*)(V_lds + (bf) * SHM_V + vst1) = pack8(S.sf2, S.sf3); } while (0)
template <class TIn, class TOut>
__device__ __forceinline__ void causal_swa_prime(const BlockRef<TIn, TOut>& cur, int W, char* lds, Seam<TIn>& S) {
    constexpr bool F32 = same_t<TIn, float>::v;
    int tid_o = my_tid(); asm volatile("" : "+v"(tid_o));
    const int tid = tid_o, wid = __builtin_amdgcn_readfirstlane(tid >> 6), lane = tid & 63, r32 = lane & 31, hi = lane >> 5;
    const int sr = tid >> 4, sc = (tid & 15) * 8, kws = KSWZ(sr, sc * 2); char* K_lds = lds + 2 * SHM_V; const unsigned soff = (unsigned)(sr * LDQKV + sc) * 2u;
    const int kb0 = swa_jlo(cur.P0, W) * KVBLK;
    for (int d0 = 0; d0 < 8; ++d0) S.qr[d0] = load8<TIn>(cur.Q + (size_t)(wid * QBLK + r32) * LDQKV + d0 * 16 + hi * 8);
    if constexpr (F32) { SLOAD_F((const float*)cur.K, kb0); VMW(); SWRITE_KF(0); SBAR(); SLOAD_F((const float*)cur.V, kb0); }
    else { SLOAD_H(cur.K, cur.V, kb0); VMW(); SWRITE_HK(0); }
    __syncthreads();
}
template <class TIn, class TOut>
__device__ __forceinline__ void causal_swa_block(const BlockRef<TIn, TOut>& cur, const BlockRef<TIn, TOut>& nxt, int skv, int W, char* lds, Seam<TIn>& S) {
    constexpr bool F32 = same_t<TIn, float>::v;
    int tid_o = my_tid(); asm volatile("" : "+v"(tid_o));
    const int tid = tid_o, wid = __builtin_amdgcn_readfirstlane(tid >> 6), lane = tid & 63, r32 = lane & 31, hi = lane >> 5;
    const int j_lo = swa_jlo(cur.P0, W);
    int j_hi = (cur.P0 + QB - 1) / KVBLK + 1; if (j_hi > skv / KVBLK) j_hi = skv / KVBLK;
    const int NT = j_hi - j_lo;
    const int kbn = swa_jlo(nxt.P0, W) * KVBLK;
    const int qlo = cur.P0 + wid * QBLK, qm = qlo + r32 - 4 * hi;
    char* V_lds = lds; char* K_lds = lds + 2 * SHM_V;
    float* ws = (float*)(lds + 2 * SHM_V + 2 * SHM_K) + wid * 64; float* li_l = ws, * al_l = ws + 32;
    float m_reg = -1e30f, l_reg = 0; f32x16 o[4] = {};
    const unsigned soff = (unsigned)((tid >> 4) * LDQKV + (tid & 15) * 8) * 2u;
    const int sr = tid >> 4, sc = (tid & 15) * 8, vst0 = v_st(sr, sc), vst1 = v_st(32 + sr, sc), kws = KSWZ(sr, sc * 2);
    const int vb0 = (int)(uintptr_t)V_lds + v_rd_base(lane);
    const TIn* Kh = cur.K; const TIn* Vh = cur.V;
#define RESC(a) do { if (__any((a) < 1.f)) { if (hi == 0) al_l[r32] = (a); asm volatile("s_waitcnt lgkmcnt(0)" ::: "memory");              \
                     for (int d_ = 0; d_ < 4; ++d_) for (int r = 0; r < 16; ++r) o[d_][r] *= al_l[crow(r, hi)]; } } while (0)
#define KBASE(t) ((j_lo + (t)) * KVBLK)
#define ACT(t) (KBASE(t) <= qlo + QBLK - 1 && KBASE(t) + KVBLK - 1 >= qlo - W + 1)
#define MASKT(P0_, P1_, mw_) mask_bits(P0_, P1_, mw_, hi)
#define MLOAD(t) mask_word((const char*)cur.M + (size_t)((j_lo + (t)) * 8), wid * QBLK + r32)
    constexpr int NQL = F32 ? 16 : 8;
    constexpr bool SK = WSKIP && !F32;
#define SEAM_K0() do { VMWN(NQL); if constexpr (F32) { SWRITE_KF(0); SBAR(); SLOAD_F((const float*)nxt.V, kbn); } else { SWRITE_HK(0); } SBAR(); } while (0)
    f32x16 pA0, pA1, pB0, pB1; float mnA, mnB, alA, alB; bf16x8 pa0, pa1, pa2, pa3;
    if constexpr (F32) { VMW(); SWRITE_VF(0); SBAR(); } else { SWRITE_HV(0); SBAR(); }
    if (NT > 1) { if constexpr (F32) SLOAD_F((const float*)Kh, KBASE(1)); else SLOAD_H(Kh, Vh, KBASE(1)); }
    SBAR(); qkt<0, SK>(pA0, pA1, K_lds, r32, hi, S.qr, ACT(0));
    if constexpr (F32) { if (NT > 1) { VMW(); SWRITE_KF(1); SBAR(); SLOAD_F((const float*)Vh, KBASE(1)); } }
    MASKT(pA0, pA1, MLOAD(0)); partialSM(pA0, pA1, m_reg, mnA, alA);
    if (NT > 1) { VMW(); if constexpr (F32) { SWRITE_VF(1); SBAR(); if (NT > 2) SLOAD_F((const float*)Kh, KBASE(2)); } else SWRITE_H(1); }
    __syncthreads();
#define HALF_STEP(PX0, PX1, mnX, alX, PY0, PY1, alY, t, KB, VB, SB) do {                                                      \
        SBAR(); qkt<KB, SK>(PX0, PX1, K_lds, r32, hi, S.qr, ACT(t));                                             \
        finishSM(PY0, PY1, alY, l_reg, pa0, pa1, pa2, pa3); SBAR();                                                           \
        if ((t) + 1 < NT) { if constexpr (F32) { VMW(); SWRITE_KF(SB); SBAR(); SLOAD_F((const float*)Vh, KBASE((t) + 1)); }  \
                            else { SLOAD_H(Kh, Vh, KBASE((t) + 1)); } SBAR(); }                                               \
        pv_tile<VB, SK>(o, vb0, pa0, pa1, pa2, pa3, ACT((t) - 1)); MASKT(PX0, PX1, MLOAD(t)); partialSM(PX0, PX1, m_reg, mnX, alX);                                        \
        __syncthreads();                                                                                                      \
        if ((t) + 1 < NT) { VMW(); if constexpr (F32) { SWRITE_VF(SB); SBAR(); if ((t) + 2 < NT) SLOAD_F((const float*)Kh, KBASE((t) + 2)); } \
                            else { SWRITE_H(SB); } }                                                                          \
        RESC(alX); __syncthreads(); } while (0)
    for (int t = 1; t + 1 < NT; t += 2) {
        HALF_STEP(pB0, pB1, mnB, alB, pA0, pA1, alA, t, 1, 0, 0);
        HALF_STEP(pA0, pA1, mnA, alA, pB0, pB1, alB, t + 1, 0, 1, 1);
    }
    const bool even = (NT & 1) == 0;
    if (even) { SBAR(); qkt<1, SK>(pB0, pB1, K_lds, r32, hi, S.qr, ACT(NT - 1)); SBAR(); }
#define QROW(e) (nxt.Q + (size_t)(wid * QBLK + r32) * LDQKV + ((e) >> 1) * 16 + hi * 8 + ((e) & 1) * 4)
    if constexpr (F32) { SLOAD_F((const float*)nxt.K, kbn); SBAR();
#pragma unroll
        for (int e = 0; e < 8; ++e) S.tq[e] = *(const f32x4*)QROW(e); }
    else { SLOAD_H(nxt.K, nxt.V, kbn); SBAR();
#pragma unroll
        for (int d0 = 0; d0 < 8; ++d0) S.qr[d0] = load8<TIn>(nxt.Q + (size_t)(wid * QBLK + r32) * LDQKV + d0 * 16 + hi * 8); }
    SBAR();
    finishSM(pA0, pA1, alA, l_reg, pa0, pa1, pa2, pa3); SBAR();
    if constexpr (F32) {
#pragma unroll
        for (int e = 8; e < 16; ++e) S.tq[e] = *(const f32x4*)QROW(e); SBAR(); }
#undef QROW
    pv_tile<0, SK>(o, vb0, pa0, pa1, pa2, pa3, ACT(even ? NT - 2 : NT - 1));
    if (even) { MASKT(pB0, pB1, MLOAD(NT - 1)); partialSM(pB0, pB1, m_reg, mnB, alB); __syncthreads(); RESC(alB);
        finishSM(pB0, pB1, alB, l_reg, pa0, pa1, pa2, pa3); SBAR(); pv_tile<1, SK>(o, vb0, pa0, pa1, pa2, pa3, ACT(NT - 1)); }
    SBAR(); SEAM_K0();
    if (hi == 0) li_l[r32] = l_reg; asm volatile("s_waitcnt lgkmcnt(0)" ::: "memory");
    float rli[16];
#pragma unroll
    for (int r = 0; r < 16; ++r) rli[r] = __builtin_amdgcn_rcpf(li_l[crow(r, hi)]);
    TOut* Ow = cur.O + (size_t)(wid * QBLK) * LDO;
#pragma unroll
    for (int r = 0; r < 16; ++r) { const int orow = crow(r, hi);
#pragma unroll
        for (int d0 = 0; d0 < 4; ++d0) { const float v = o[d0][r] * rli[r];
            if constexpr (same_t<TOut, float>::v) { Ow[(size_t)orow * LDO + d0 * 32 + r32] = v; }
            else { const float vn = __builtin_bit_cast(float, __builtin_amdgcn_update_dpp(0, __builtin_bit_cast(int, v), 0xB1, 0xf, 0xf, false));
                   if ((r32 & 1) == 0) *(unsigned*)(Ow + (size_t)orow * LDO + d0 * 32 + r32) = cvtpk(v, vn); } } }
    if constexpr (F32) {
#pragma unroll
        for (int d0 = 0; d0 < 8; ++d0) S.qr[d0] = pack8(S.tq[2 * d0], S.tq[2 * d0 + 1]); }
    __syncthreads();
#undef RESC
#undef KBASE
#undef ACT
#undef MASKT
#undef MLOAD
#undef SEAM_K0
#undef HALF_STEP
}
#undef ROW
#undef VMW
#undef VMWN
#undef SLOAD_H
#undef LD16U
#undef SWRITE_HK
#undef SWRITE_HV
#undef SWRITE_H
#undef SLOAD_F
#undef SWRITE_KF
#undef SWRITE_VF

}


template <int NC> __device__ __forceinline__ void scan_elems(const bf16* __restrict__ delta, bf16* __restrict__ prev, size_t cstride, const LAS float* dec, const LAS float* inj) {
    f32x4 st = (f32x4){0.f, 0.f, 0.f, 0.f};
#pragma unroll 8
    for (int c = 0; c < NC; ++c) { const v2u x = *(const GAS v2u*)(delta + (size_t)c * cstride);
        v2u o; o.x = pk2(st[0], st[1]); o.y = pk2(st[2], st[3]); *(GAS v2u*)(prev + (size_t)c * cstride) = o;
        const float d = dec[c], j = inj[c];
        st[0] = d * st[0] + j * __uint_as_float(x.x << 16); st[1] = d * st[1] + j * __uint_as_float(x.x & 0xffff0000u);
        st[2] = d * st[2] + j * __uint_as_float(x.y << 16); st[3] = d * st[3] + j * __uint_as_float(x.y & 0xffff0000u); }
}

struct Args {
    const float* x; const float* norm_mix; const float* norm_ffn; const float* w_in; const float* att_q_norm; const float* att_k_norm; const float* mlstm_conv; const float* mlstm_gate_bias;
    const float* mlstm_out_norm; const float* ret_out_norm; const float* w_b_att; const float* w_b_mlstm; const float* w_b_ret; const float* w_out; const float* w_ffn_in; const float* w_ffn_out;
    float* out; unsigned char* ws; int layer_lo, layer_hi, ph_lo, ph_hi;
};
constexpr int PH_PER_LAYER = 16;
__device__ __forceinline__ float ret_lngamma(int hd) { return log1pf(-exp2f(-5.0f - (float)hd)); }
#define PHASE_FN static __device__ __forceinline__ void
#define OPAQUE_PTR(p) asm volatile("" : "+s"(p))
#define WS_PTRS(ws) OPAQUE_PTR(ws); \
    bf16* const H = (bf16*)((ws) + WS_H); bf16* const PROJ = (bf16*)((ws) + WS_PROJ); float* const SMALL = (float*)((ws) + WS_SMALL); bf16* const MQK = (bf16*)((ws) + WS_MQK); \
    bf16* const IKB = (bf16*)((ws) + WS_IKB); unsigned char* const IWF = (unsigned char*)((ws) + WS_IWF); float* const GIF = (float*)((ws) + WS_GIF); float* const SC = (float*)((ws) + WS_SC); \
    unsigned long long* const MB = (unsigned long long*)((ws) + WS_MB); bf16* const DCM = (bf16*)((ws) + WS_DCM); bf16* const CPM = (bf16*)((ws) + WS_CPM); \
    float* const DN = (float*)((ws) + WS_MISC + MISC_DN); float* const NPREV = (float*)((ws) + WS_MISC + MISC_NPREV); float* const AB = (float*)((ws) + WS_MISC + MISC_AB); float* const MPREV = (float*)((ws) + WS_MISC + MISC_MPREV); \
    bf16* const DRR = (bf16*)((ws) + WS_DRR); bf16* const RPR = (bf16*)((ws) + WS_RPR); bf16* const YA = (bf16*)((ws) + WS_YA); bf16* const YM = (bf16*)((ws) + WS_YM); bf16* const YR = (bf16*)((ws) + WS_YR); \
    float* const MERGEDF = (float*)((ws) + WS_MERGEDF); bf16* const MERGED = (bf16*)((ws) + WS_MERGED); bf16* const ACT = (bf16*)((ws) + WS_ACT); \
    float* const ROPE128 = (float*)((ws) + WS_ROPE128); float* const ROPE64 = (float*)((ws) + WS_ROPE64); \
    (void)H; (void)PROJ; (void)SMALL; (void)MQK; (void)IKB; (void)IWF; (void)GIF; (void)SC; (void)MB; (void)DCM; (void)CPM; (void)DN; (void)NPREV; (void)AB; (void)MPREV; (void)DRR; (void)RPR; (void)YA; (void)YM; (void)YR; \
    (void)MERGEDF; (void)MERGED; (void)ACT; (void)ROPE128; (void)ROPE64
#define TIDS() int tid_ = my_tid(); asm volatile("" : "+v"(tid_)); int bx_ = blockIdx.x; asm volatile("" : "+s"(bx_));   \
    const int tid = tid_, lane = tid & 63, wave = __builtin_amdgcn_readfirstlane(tid >> 6); const int G = gridDim.x, bx = bx_; const int gw = bx * NWAVES + wave, NGW = G * NWAVES; \
    (void)lane; (void)wave; (void)gw; (void)NGW; (void)G; (void)bx

constexpr int CV_IN = 32 * 268, CV_B = 16 * 32, CV_OUT = 32 * 32, CV_FIN = 32 * 176, CV_FOUT = 88 * 32, CV_ITEMS = CV_IN + 3 * CV_B + CV_OUT + CV_FIN + CV_FOUT;
__device__ __forceinline__ void convert_layer_items(LAS float* scr, unsigned char* ws, int l, const float* w_in, const float* w_b_att, const float* w_b_mlstm, const float* w_b_ret, const float* w_out, const float* w_ffn_in,
                                                    const float* w_ffn_out, int it0, int it1, int wv, int nwv, int lane) {
    unsigned char* wl = ws + WS_W + (size_t)l * W_LAYER;
    for (int it = it0 + wv; it < it1; it += nwv) { int r = it;
        if (r < CV_IN) { transpose_item(w_in + (size_t)l * DM * LPROJ, DM, LPROJ, (bf16*)(wl + WO_IN), scr, r, NPROJ_PAD / 64, lane, MapWin()); continue; } r -= CV_IN;
        if (r < CV_B) { transpose_item(w_b_att + (size_t)l * 1024 * DM, 1024, DM, (bf16*)(wl + WO_B), scr, r, DM / 64, lane, MapIdent()); continue; } r -= CV_B;
        if (r < CV_B) { transpose_item(w_b_mlstm + (size_t)l * 1024 * DM, 1024, DM, (bf16*)(wl + WO_B + 4 * MiB), scr, r, DM / 64, lane, MapIdent()); continue; } r -= CV_B;
        if (r < CV_B) { transpose_item(w_b_ret + (size_t)l * 1024 * DM, 1024, DM, (bf16*)(wl + WO_B + 8 * MiB), scr, r, DM / 64, lane, MapIdent()); continue; } r -= CV_B;
        if (r < CV_OUT) { transpose_item(w_out + (size_t)l * DM * DM, DM, DM, (bf16*)(wl + WO_OUT), scr, r, DM / 64, lane, MapIdent()); continue; } r -= CV_OUT;
        if (r < CV_FIN) { transpose_item(w_ffn_in + (size_t)l * DM * 2 * FF, DM, 2 * FF, (bf16*)(wl + WO_FIN), scr, r, 2 * FF / 64, lane, MapFfn()); continue; } r -= CV_FIN;
        transpose_item(w_ffn_out + (size_t)l * FF * DM, FF, DM, (bf16*)(wl + WO_FOUT), scr, r, DM / 64, lane, MapIdent()); }
}
PHASE_FN ph_prologue(LAS unsigned char* lds, unsigned char* ws, const float* w_in, const float* w_b_att, const float* w_b_mlstm, const float* w_b_ret, const float* w_out, const float* w_ffn_in, const float* w_ffn_out, bool all_layers) {
    TIDS(); WS_PTRS(ws);
    LAS float* scr = (LAS float*)(lds + wave * 16640);
    for (int l = 0; l < (all_layers ? DEPTH : 1); ++l) convert_layer_items(scr, ws, l, w_in, w_b_att, w_b_mlstm, w_b_ret, w_out, w_ffn_in, w_ffn_out, 0, CV_ITEMS, gw, NGW, lane);
    for (int i = gw * 64 + lane; i < S * 96; i += NGW * 64) {
        if (i < S * 64) { const int t = i >> 6, f = i & 63; const float inv = (float)pow(10000.0, -(double)f * 2.0 / 128.0); const float ang = (float)t * inv;
            ROPE128[2 * i] = (float)cos((double)ang); ROPE128[2 * i + 1] = (float)sin((double)ang); }
        else { const int k = i - S * 64, t = k >> 5, f = k & 31; const float inv = (float)pow(10000.0, -(double)f * 2.0 / 64.0); const float ang = (float)t * inv;
            ROPE64[2 * k] = (float)cos((double)ang); ROPE64[2 * k + 1] = (float)sin((double)ang); } }
}
PHASE_FN ph_convert_tail(LAS unsigned char* lds, unsigned char* ws, int l, const float* w_in, const float* w_b_att, const float* w_b_mlstm, const float* w_b_ret, const float* w_out, const float* w_ffn_in, const float* w_ffn_out,
                         int rem, int it0, int it1) {
    TIDS(); if (rem <= 0 || rem >= G || bx < rem) return;
    LAS float* scr = (LAS float*)(lds + wave * 16640);
    convert_layer_items(scr, ws, l, w_in, w_b_att, w_b_mlstm, w_b_ret, w_out, w_ffn_in, w_ffn_out, it0, it1, (bx - rem) * NWAVES + wave, (G - rem) * NWAVES, lane);
    __syncthreads(); }
PHASE_FN ph_rmsnorm(const float* xin, const float* gain, bf16* Hout) { TIDS(); for (int m = gw; m < S; m += NGW) rms_row_to_bf16(xin + (size_t)m * DM, gain, Hout + (size_t)m * DM, lane); }
PHASE_FN ph_gemm_proj(LAS unsigned char* lds, unsigned char* ws, const bf16* Wt) { TIDS(); WS_PTRS(ws);
    pg8::Gemm g{H, Wt, S, NPROJ_PAD, DM}; pg8::StaticOrder so; so.init(S, NPROJ_PAD, G, bx); pg8::EpiProj E{PROJ, NPROJ, SMALL, PC_G / 256, NPROJ / 256};
    pg8::gemm_phase<pg8::EpiProj, pg8::StaticOrder, true, true>(lds, g, so, E); }
PHASE_FN ph_pp(unsigned char* ws, const float* gq, const float* gk, const float* convw, const float* gbias) { TIDS(); WS_PTRS(ws);
    PPArgs a{PROJ, SMALL, MQK, IKB, IWF, GIF, ROPE128, ROPE64, gq, gk, convw, gbias};
    f32x4 cw[16];
#pragma unroll
    for (int j = 0; j < 4; ++j)
#pragma unroll
        for (int q = 0; q < 4; ++q) cw[j * 4 + q] = *(const f32x4*)(convw + j * 1024 + 16 * lane + 4 * q);
    for (int m = gw; m < S; m += NGW) pp_row(a, m, lane, cw); }
PHASE_FN ph_scores(LAS unsigned char* lds, unsigned char* ws) { TIDS(); WS_PTRS(ws);
    LAS unsigned char* iqt = lds; LAS unsigned char* wt = lds + IQT_BYTES + wave * (32 * SCT_RS);
    for (int u = bx; u < 1152; u += G) { int m = 0; while (16 * (m + 1) * (m + 2) <= u) ++m;
        const int r = u - 16 * m * (m + 1), qb = 32 * m + r / (m + 1), c = r % (m + 1), nkb = (qb >> 1) + 1, k0 = 16 * c, k1 = (k0 + 16 < nkb) ? k0 + 16 : nkb;
        {   const int row = tid >> 4, part = tid & 15; const bf16* src = PROJ + (size_t)(qb * 32 + row) * NPROJ + PC_IQ;
#pragma unroll
            for (int i = 0; i < 4; ++i) *(LAS v4u*)(iqt + row * IQT_RS + part * 16 + 256 * i) = *(const GAS v4u*)(src + part * 8 + 128 * i); }
        __syncthreads();
        for (int kb = k0 + wave; kb < k1; kb += NWAVES) score_wave_unit(wt, iqt, IKB, IWF, SC, qb, kb, lane);
        __syncthreads(); }
}
PHASE_FN ph_deltas(LAS unsigned char* lds, unsigned char* ws) { TIDS(); WS_PTRS(ws); LAS float* const sf = (LAS float*)(lds + SCR_OFF);
    for (int u = bx; u < 1024; u += G) {
        if (u < 512) { const int hd = u >> 7, c = u & 127, t0 = c * 64;
            if (wave == 0) { const float iv = GIF[(size_t)(t0 + lane) * 8 + hd], fv = GIF[(size_t)(t0 + lane) * 8 + 4 + hd]; float b = log_sigmoid_f(fv);
                b = wave_prefix_sum_f(b);
                const float bend = __builtin_bit_cast(float, __builtin_amdgcn_readlane(__builtin_bit_cast(int, b), 63)), gl = bend - b + iv, A = wave_max(gl);
                sf[lane] = __expf(gl - A); if (lane == 0) { AB[(hd * 128 + c) * 2] = A; AB[(hd * 128 + c) * 2 + 1] = bend; } }
            __syncthreads();
            chunk_delta<64, 256>(lds, MQK + (size_t)t0 * 1024 + 512 + hd * 128, 1024, PROJ + (size_t)t0 * NPROJ + PC_MV + hd * 256, NPROJ, sf, DCM + (size_t)(hd * 128 + c) * 32768, DN + (hd * 128 + c) * 128, tid);
        } else { const int v = u - 512, hd = v >> 6, c = v & 63, t0 = c * 128; const float lg = ret_lngamma(hd);
            if (tid < 128) sf[tid] = __expf(lg * (float)(127 - tid));
            __syncthreads();
            chunk_delta<128, 128>(lds, PROJ + (size_t)t0 * NPROJ + PC_RK + hd * 128, NPROJ, PROJ + (size_t)t0 * NPROJ + PC_RV + hd * 128, NPROJ, sf, DRR + (size_t)(hd * 64 + c) * 16384, nullptr, tid); }
    } }
PHASE_FN ph_select(LAS unsigned char* lds, unsigned char* ws) { TIDS(); WS_PTRS(ws);
    if (G == 256) select_rows_wg(lds, SC, MB, bx, 256, 28, 7168 + (bx - 128), 128, bx >= 128 ? 8 : 0, tid);
    else select_rows_wg(lds, SC, MB, bx, G, (S - bx + G - 1) / G, 0, 0, 0, tid); }
PHASE_FN ph_scans(LAS unsigned char* lds, unsigned char* ws) { TIDS(); WS_PTRS(ws); LAS float* const sf = (LAS float*)(lds + SCR_OFF);
    for (int u = bx; u < 128; u += G) {
        LAS float* dec = sf; LAS float* inj = sf + 128; LAS float* av = sf + 256; LAS float* bv = sf + 384;
        if (u < 64) { const int hd = u >> 4, p = u & 15;
            if (tid < 128) { av[tid] = AB[(hd * 128 + tid) * 2]; bv[tid] = AB[(hd * 128 + tid) * 2 + 1]; }
            __syncthreads();
            if (tid == 0) { float m = 0.f; for (int c = 0; c < 128; ++c) { const float mn = fmaxf(bv[c] + m, av[c]); dec[c] = __expf(bv[c] + m - mn); inj[c] = __expf(av[c] - mn); if (p == 0) MPREV[hd * 128 + c] = m; m = mn; } }
            __syncthreads();
            const size_t e4 = (size_t)hd * 128 * 32768 + p * 2048 + tid * 4;
            scan_elems<128>(DCM + e4, CPM + e4, 32768, dec, inj);
            if (p == 0 && tid < 128) { float st = 0.f; for (int c = 0; c < 128; ++c) { NPREV[(hd * 128 + c) * 128 + tid] = st; st = dec[c] * st + inj[c] * DN[(hd * 128 + c) * 128 + tid]; } }
        } else { const int v = u - 64, hd = v >> 3, p = v & 7; const float dg = __expf(128.0f * ret_lngamma(hd));
            if (tid < 64) { dec[tid] = dg; inj[tid] = 1.0f; }
            __syncthreads();
            const size_t e4 = (size_t)hd * 64 * 16384 + p * 2048 + tid * 4;
            scan_elems<64>(DRR + e4, RPR + e4, 16384, dec, inj); }
        __syncthreads(); } }
PHASE_FN ph_attention(char* alds, unsigned char* ws) { TIDS(); WS_PTRS(ws);
    typedef att::BlockRef<bf16, bf16> BR; att::Seam<bf16> seam;
#define ATT_REF(r, item_, pass_) do { const int hd_ = (item_) >> 4, y_ = (item_) & 15, qb_ = (pass_) ? 31 - y_ : y_; \
        (r).Q = PROJ + (size_t)qb_ * 256 * NPROJ + PC_AQ + hd_ * 128; (r).K = PROJ + PC_AK + hd_ * 128; (r).V = PROJ + PC_AV + hd_ * 128; (r).O = YA + (size_t)qb_ * 256 * 1024 + hd_ * 128; \
        (r).M = MB + (size_t)qb_ * 256 * 128; (r).P0 = qb_ * 256; } while (0)
    if (bx < 128) { int item = bx, pass = 0; BR cur; ATT_REF(cur, item, 0); att::causal_swa_prime<bf16, bf16>(cur, 1 << 30, alds, seam);
        for (;;) { const bool more_pass = pass == 0, more_item = item + G < 128, last = !more_pass && !more_item;
            int itn = item, pn = pass + 1; if (!more_pass) { pn = 0; itn = more_item ? item + G : item; }
            BR nxt = cur; if (!last) ATT_REF(nxt, itn, pn);
            att::causal_swa_block<bf16, bf16>(cur, nxt, S, 1 << 30, alds, seam);
            if (last) break; cur = nxt; item = itn; pass = pn; } }
    __syncthreads(); }
PHASE_FN ph_outs(LAS unsigned char* lds, unsigned char* ws, const float* gain_m, const float* gain_r, int u0, int ustep) { TIDS(); WS_PTRS(ws); LAS float* const sf = (LAS float*)(lds + SCR_OFF);
    for (int u = u0; u < 1024; u += ustep) {
        if (u < 512) { const int hd = u >> 7, c = u & 127, t0 = c * 64;
            if (wave == 0) { const float iv = GIF[(size_t)(t0 + lane) * 8 + hd], fv = GIF[(size_t)(t0 + lane) * 8 + 4 + hd]; float b = log_sigmoid_f(fv);
                b = wave_prefix_sum_f(b);
                const float mp = MPREV[hd * 128 + c]; const float pm = wave_prefix_max_f(iv - b);
                const float mt = fmaxf(b + mp, b + pm);
                sf[lane] = b - mt; sf[128 + lane] = iv - b; sf[256 + lane] = __expf(b + mp - mt); sf[384 + lane] = __expf(-mt); sf[512 + lane] = 0.f; }
            if (wave == 1) { sf[640 + lane] = NPREV[(hd * 128 + c) * 128 + lane]; sf[640 + 64 + lane] = NPREV[(hd * 128 + c) * 128 + 64 + lane]; }
            __syncthreads();
            chunk_out<64, 256, 0>(lds, sf, MQK + (size_t)t0 * 1024 + hd * 128, 1024, MQK + (size_t)t0 * 1024 + 512 + hd * 128, 1024, PROJ + (size_t)t0 * NPROJ + PC_MV + hd * 256, NPROJ,
                                  CPM + (size_t)(hd * 128 + c) * 32768, gain_m + hd * 256, PROJ + (size_t)t0 * NPROJ + PC_MO + hd * 256, NPROJ, YM + (size_t)t0 * 1024 + hd * 256, 1024, tid);
        } else { const int v = u - 512, hd = v >> 6, c = v & 63, t0 = c * 128; const float lg = ret_lngamma(hd);
            if (tid < 128) { sf[tid] = lg * (float)tid; sf[128 + tid] = -lg * (float)tid; sf[256 + tid] = __expf(lg * (float)(tid + 1)); }
            __syncthreads();
            chunk_out<128, 128, 1>(lds, sf, PROJ + (size_t)t0 * NPROJ + PC_RQ + hd * 128, NPROJ, PROJ + (size_t)t0 * NPROJ + PC_RK + hd * 128, NPROJ, PROJ + (size_t)t0 * NPROJ + PC_RV + hd * 128, NPROJ,
                                   RPR + (size_t)(hd * 64 + c) * 16384, gain_r + hd * 128, PROJ + (size_t)t0 * NPROJ + PC_RG + hd * 128, NPROJ, YR + (size_t)t0 * 1024 + hd * 128, 1024, tid); }
    } }
template <int MODE> PHASE_FN ph_gemm_branch(LAS unsigned char* lds, unsigned char* ws, const bf16* A, const bf16* Wt, int gcol) { TIDS(); WS_PTRS(ws);
    pg8::Gemm g{A, Wt, S, DM, 1024}; pg8::StaticOrder so; so.init(S, DM, G, bx); pg8::EpiBranch<MODE> E{PROJ + PC_G + gcol, NPROJ, MERGEDF, MERGED, DM};
    pg8::gemm_phase<pg8::EpiBranch<MODE>, pg8::StaticOrder, true, true>(lds, g, so, E); }
PHASE_FN ph_gemm_resid(LAS unsigned char* lds, const bf16* A, const bf16* Wt, int K, const float* base, float* out) { TIDS();
    pg8::Gemm g{A, Wt, S, DM, K}; pg8::StaticOrder so; so.init(S, DM, G, bx); pg8::EpiResid E{base, out, DM};
    pg8::gemm_phase<pg8::EpiResid, pg8::StaticOrder, true, true>(lds, g, so, E); }
PHASE_FN ph_gemm_ffn_in(LAS unsigned char* lds, unsigned char* ws, const bf16* Wt) { TIDS(); WS_PTRS(ws);
    pg8::Gemm g{H, Wt, S, 2 * FF, DM}; pg8::StaticOrder so; so.init(S, 2 * FF, G, bx); pg8::EpiSwiGLU E{ACT, FF};
    pg8::gemm_phase<pg8::EpiSwiGLU, pg8::StaticOrder, true, true>(lds, g, so, E); }


#ifndef SYN_PROBE
#define SYN_PROBE 0
#endif
PHASE_FN ph_probe(LAS unsigned char* lds) { TIDS();
    LAS unsigned* hist = (LAS unsigned*)lds;
    if (SYN_PROBE == 1) {
        unsigned x = (unsigned)tid * 2654435761u + 12345u;
        for (int r = 0; r < 32; ++r) {
#pragma unroll
            for (int i = 0; i < 16; ++i) { x = x * 1664525u + 1013904223u; (void)__hip_atomic_fetch_add(hist + ((x >> 10) & 2047u), 1u, __ATOMIC_RELAXED, __HIP_MEMORY_SCOPE_WORKGROUP); }
            SEL_BAR(); } }
    if (SYN_PROBE == 2) {
        float acc = 0.f; float v[16];
#pragma unroll
        for (int i = 0; i < 16; ++i) v[i] = (float)((tid * 16 + i) % 977);
        for (int r = 0; r < 32 * 8; ++r) { const float c1 = 100.f + (float)(r & 7) + acc * 1e-30f, c2 = c1 * 2.f, c3 = c1 * 3.f; unsigned n1 = 0, n2 = 0, n3 = 0;
#pragma unroll
            for (int i = 0; i < 16; ++i) { n1 += (unsigned)__builtin_popcountll(__builtin_amdgcn_ballot_w64(v[i] >= c1)); n2 += (unsigned)__builtin_popcountll(__builtin_amdgcn_ballot_w64(v[i] >= c2)); n3 += (unsigned)__builtin_popcountll(__builtin_amdgcn_ballot_w64(v[i] >= c3)); }
            if (lane == 0) { hist[(r & 1) * 24 + wave] = n1; hist[(r & 1) * 24 + 8 + wave] = n2; hist[(r & 1) * 24 + 16 + wave] = n3; }
            SEL_BAR();
            unsigned t1 = 0;
#pragma unroll
            for (int j = 0; j < 24; ++j) t1 += hist[(r & 1) * 24 + j];
            acc += (float)t1; }
        if (acc == 12345.f) hist[100] = 1u; }
    if (SYN_PROBE == 3) {
        float a = (float)tid;
        for (int r = 0; r < 32; ++r) {
#pragma unroll
            for (int k = 0; k < 4; ++k)
#pragma unroll
                for (int o = 1; o < 64; o <<= 1) a = fmaxf(a, shfl_idx_f(a, (int)(lane_id_v() ^ (unsigned)o)) * 0.999f);
        }
        if (a == 12345.f) hist[100] = 1u; }
    __syncthreads(); }
typedef const __attribute__((address_space(4))) Args* ArgsP;
__device__ __forceinline__ ArgsP fresh_args() { ArgsP ap = (ArgsP)__builtin_amdgcn_kernarg_segment_ptr(); asm volatile("" : "+s"(ap)); return ap; }
#ifndef DUP_PHASE
#define DUP_PHASE -1
#endif
#define SEAM() do { if constexpr (one_launch) { ArgsP ap_ = fresh_args(); XcdBarrier b_; b_.bar = (unsigned*)(ap_->ws + WS_CTL) + CW_BAR; b_.x = xb_xcc_id(); b_.st = (volatile LAS unsigned*)(lds + MISC_OFF); xcd_barrier(b_); } } while (0)
#define IN(k) (PLO <= (k) && (k) < PHI)
#define WL(ap, layer) ((ap)->ws + WS_W + (size_t)(layer) * W_LAYER)
template <int PLO, int PHI, bool LAST> __device__ __forceinline__ void layer_phases(const int layer, LAS unsigned char* lds, unsigned char* lds_raw) {
    constexpr bool one_launch = (PHI - PLO > 1);
    if constexpr (IN(1)) { ArgsP ap = fresh_args(); ph_rmsnorm(layer == 0 ? ap->x : ap->out, ap->norm_mix + layer * DM, (bf16*)(ap->ws + WS_H)); if constexpr (DUP_PHASE == 1) { SEAM(); ph_rmsnorm(layer == 0 ? ap->x : ap->out, ap->norm_mix + layer * DM, (bf16*)(ap->ws + WS_H)); } SEAM(); }
    constexpr int CV_S1 = 10880, CV_S2 = 10880;
    if constexpr (IN(2)) { ArgsP ap = fresh_args(); ph_gemm_proj(lds, ap->ws, (const bf16*)(WL(ap, layer) + WO_IN));
        if constexpr (one_launch && !LAST) { ArgsP aq = fresh_args(); ph_convert_tail(lds, aq->ws, layer + 1, aq->w_in, aq->w_b_att, aq->w_b_mlstm, aq->w_b_ret, aq->w_out, aq->w_ffn_in, aq->w_ffn_out, ((S / 256) * (NPROJ_PAD / 256)) % (int)gridDim.x, 0, CV_S1); } if constexpr (DUP_PHASE == 2) { SEAM(); ph_gemm_proj(lds, ap->ws, (const bf16*)(WL(ap, layer) + WO_IN)); } SEAM(); }
    if constexpr (IN(3)) { ArgsP ap = fresh_args(); ph_pp(ap->ws, ap->att_q_norm + layer * 128, ap->att_k_norm + layer * 128, ap->mlstm_conv + layer * 4096, ap->mlstm_gate_bias + layer * 8); if constexpr (DUP_PHASE == 23) { SEAM(); ph_gemm_proj(lds, ap->ws, (const bf16*)(WL(ap, layer) + WO_IN)); SEAM(); ph_pp(ap->ws, ap->att_q_norm + layer * 128, ap->att_k_norm + layer * 128, ap->mlstm_conv + layer * 4096, ap->mlstm_gate_bias + layer * 8); } if constexpr (DUP_PHASE == 3) { SEAM(); ph_pp(ap->ws, ap->att_q_norm + layer * 128, ap->att_k_norm + layer * 128, ap->mlstm_conv + layer * 4096, ap->mlstm_gate_bias + layer * 8); } SEAM(); }
    if constexpr (IN(4)) { ArgsP ap = fresh_args(); ph_scores(lds, ap->ws); if constexpr (DUP_PHASE == 4) { SEAM(); ph_scores(lds, ap->ws); } }
    if constexpr (IN(5)) { ArgsP ap = fresh_args(); ph_deltas(lds, ap->ws); if constexpr (DUP_PHASE == 5) { SEAM(); ph_deltas(lds, ap->ws); } SEAM(); }
    if constexpr (IN(6) && SYN_PROBE != 0) { ph_probe(lds); }
    if constexpr (IN(6)) { ArgsP ap = fresh_args(); ph_select(lds, ap->ws); if constexpr (DUP_PHASE == 6) { SEAM(); ph_select(lds, ap->ws); } }
    if constexpr (IN(7) && one_launch && !LAST) { ArgsP aq = fresh_args(); ph_convert_tail(lds, aq->ws, layer + 1, aq->w_in, aq->w_b_att, aq->w_b_mlstm, aq->w_b_ret, aq->w_out, aq->w_ffn_in, aq->w_ffn_out, 128, CV_S1, CV_S2); }
    if constexpr (IN(7)) { ArgsP ap = fresh_args(); ph_scans(lds, ap->ws); if constexpr (DUP_PHASE == 7) { SEAM(); ph_scans(lds, ap->ws); } SEAM(); }
    if constexpr (IN(8) && IN(9)) {
        ArgsP ap = fresh_args(); const bool split = gridDim.x == 256;
        if (!split || blockIdx.x < 128) ph_attention((char*)lds_raw, ap->ws);
        if (!split || blockIdx.x >= 128) ph_outs(lds, ap->ws, ap->mlstm_out_norm + layer * 1024, ap->ret_out_norm + layer * 1024, split ? (int)blockIdx.x - 128 : (int)blockIdx.x, split ? 128 : (int)gridDim.x);
        SEAM(); }
    else {
    if constexpr (IN(8)) { ArgsP ap = fresh_args(); ph_attention((char*)lds_raw, ap->ws); }
    if constexpr (IN(9)) { ArgsP ap = fresh_args(); ph_outs(lds, ap->ws, ap->mlstm_out_norm + layer * 1024, ap->ret_out_norm + layer * 1024, (int)blockIdx.x, (int)gridDim.x); SEAM(); }
    }
    if constexpr (IN(10)) { ArgsP ap = fresh_args(); ph_gemm_branch<0>(lds, ap->ws, (const bf16*)(ap->ws + WS_YA), (const bf16*)(WL(ap, layer) + WO_B), 0); if constexpr (DUP_PHASE == 10) { SEAM(); ph_gemm_branch<0>(lds, ap->ws, (const bf16*)(ap->ws + WS_YA), (const bf16*)(WL(ap, layer) + WO_B), 0); } }
    if constexpr (IN(11)) { ArgsP ap = fresh_args(); ph_gemm_branch<1>(lds, ap->ws, (const bf16*)(ap->ws + WS_YM), (const bf16*)(WL(ap, layer) + WO_B + 4 * MiB), DM); if constexpr (DUP_PHASE == 11) { SEAM(); ph_gemm_branch<1>(lds, ap->ws, (const bf16*)(ap->ws + WS_YM), (const bf16*)(WL(ap, layer) + WO_B + 4 * MiB), DM); } }
    if constexpr (IN(12)) { ArgsP ap = fresh_args(); ph_gemm_branch<2>(lds, ap->ws, (const bf16*)(ap->ws + WS_YR), (const bf16*)(WL(ap, layer) + WO_B + 8 * MiB), 2 * DM); if constexpr (DUP_PHASE == 12) { SEAM(); ph_gemm_branch<2>(lds, ap->ws, (const bf16*)(ap->ws + WS_YR), (const bf16*)(WL(ap, layer) + WO_B + 8 * MiB), 2 * DM); } SEAM(); }
    if constexpr (IN(13)) { ArgsP ap = fresh_args(); ph_gemm_resid(lds, (const bf16*)(ap->ws + WS_MERGED), (const bf16*)(WL(ap, layer) + WO_OUT), DM, layer == 0 ? ap->x : ap->out, ap->out); SEAM(); }
    if constexpr (IN(14)) { ArgsP ap = fresh_args(); ph_rmsnorm(ap->out, ap->norm_ffn + layer * DM, (bf16*)(ap->ws + WS_H)); if constexpr (DUP_PHASE == 14) { SEAM(); ph_rmsnorm(ap->out, ap->norm_ffn + layer * DM, (bf16*)(ap->ws + WS_H)); } SEAM(); }
    if constexpr (IN(15)) { ArgsP ap = fresh_args(); ph_gemm_ffn_in(lds, ap->ws, (const bf16*)(WL(ap, layer) + WO_FIN));
        if constexpr (one_launch && !LAST) { ArgsP aq = fresh_args(); ph_convert_tail(lds, aq->ws, layer + 1, aq->w_in, aq->w_b_att, aq->w_b_mlstm, aq->w_b_ret, aq->w_out, aq->w_ffn_in, aq->w_ffn_out, ((S / 256) * (2 * FF / 256)) % (int)gridDim.x, CV_S2, CV_ITEMS); } if constexpr (DUP_PHASE == 15) { SEAM(); ph_gemm_ffn_in(lds, ap->ws, (const bf16*)(WL(ap, layer) + WO_FIN)); } SEAM(); }
    if constexpr (IN(16)) { ArgsP ap = fresh_args(); ph_gemm_resid(lds, (const bf16*)(ap->ws + WS_ACT), (const bf16*)(WL(ap, layer) + WO_FOUT), FF, ap->out, ap->out); if constexpr (!LAST) SEAM(); }
}
template <int PLO, int PHI> __global__ void __launch_bounds__(NTHR, 2) fwd(Args args_unused) {
    (void)args_unused;
    extern __shared__ __attribute__((aligned(16))) unsigned char lds_raw[];
    LAS unsigned char* lds = (LAS unsigned char*)lds_raw;
    if (threadIdx.x < 64) ((volatile LAS unsigned*)(lds + MISC_OFF))[threadIdx.x] = 0u;
    if ((threadIdx.x & 63) == 0) ((volatile LAS unsigned*)(lds + MISC_OFF))[64 + ((unsigned)__builtin_amdgcn_s_getreg((5 << 11) | 4) & 63u)] = threadIdx.x >> 6;
    __syncthreads();
    constexpr bool one_launch = (PHI - PLO > 1);
    if constexpr (one_launch) { ArgsP ap = fresh_args(); (void)xcd_barrier_post((unsigned*)(ap->ws + WS_CTL) + CW_BAR, (volatile LAS unsigned*)(lds + MISC_OFF)); }
    if constexpr (PLO == 0) { ArgsP ap = fresh_args(); ph_prologue(lds, ap->ws, ap->w_in, ap->w_b_att, ap->w_b_mlstm, ap->w_b_ret, ap->w_out, ap->w_ffn_in, ap->w_ffn_out, !one_launch);
        if constexpr (DUP_PHASE == 0) { SEAM(); ph_prologue(lds, ap->ws, ap->w_in, ap->w_b_att, ap->w_b_mlstm, ap->w_b_ret, ap->w_out, ap->w_ffn_in, ap->w_ffn_out, !one_launch); }
        if (PHI > 1) SEAM(); }
    if constexpr (one_launch) { static_assert(DEPTH == 4, "four inlined layer sites");
        layer_phases<PLO, PHI, false>(0, lds, lds_raw); layer_phases<PLO, PHI, false>(1, lds, lds_raw); layer_phases<PLO, PHI, false>(2, lds, lds_raw); layer_phases<PLO, PHI, true>(3, lds, lds_raw); }
    else if constexpr (PLO > 0) { ArgsP ap = fresh_args(); layer_phases<PLO, PHI, true>(ap->layer_lo, lds, lds_raw); }
}
#undef IN
#undef SEAM
#undef WL

#ifndef ONE_LAUNCH
#define ONE_LAUNCH 1
#endif
typedef void (*kern_t)(Args);
template <int P> static kern_t phase_kernel(int p) { if (p == P) return fwd<P, P + 1>; if constexpr (P < PH_PER_LAYER) return phase_kernel<P + 1>(p); else return nullptr; }
extern "C" void kernel_launch(void* const* d_in, const int* in_sizes, int n_in, void* d_out, int out_size, void* d_ws, size_t ws_size, hipStream_t stream) {
    static int grid = 0;
    if (grid == 0) {
        if (n_in != 16 || in_sizes[0] != S * DM || out_size != S * DM || ws_size < WS_END) { fprintf(stderr, "kernel_launch: unexpected shapes (n_in %d, in0 %d, out %d, ws %zu < %zu); nothing launched\n", n_in, n_in > 0 ? in_sizes[0] : -1, out_size, ws_size, (size_t)WS_END); grid = -1; return; }
        int dev = 0, cus = 0;
        if (hipGetDevice(&dev) != hipSuccess || hipDeviceGetAttribute(&cus, hipDeviceAttributeMultiprocessorCount, dev) != hipSuccess) { grid = -1; return; }
#if ONE_LAUNCH
        if (hipFuncSetAttribute((const void*)fwd<0, PH_PER_LAYER + 1>, hipFuncAttributeMaxDynamicSharedMemorySize, LDS_BYTES) != hipSuccess) { grid = -1; return; }
#else
        for (int p = 0; p <= PH_PER_LAYER; ++p) if (hipFuncSetAttribute((const void*)phase_kernel<0>(p), hipFuncAttributeMaxDynamicSharedMemorySize, LDS_BYTES) != hipSuccess) { fprintf(stderr, "kernel_launch: hipFuncSetAttribute failed\n"); grid = -1; return; }
#endif
        (void)hipGetLastError();
        grid = cus;
    }
    if (grid < 0) return;
    (void)hipMemsetAsync((char*)d_ws + WS_CTL, 0, CTL_ZERO_BYTES, stream);
    Args a{};
    a.x = (const float*)d_in[0]; a.norm_mix = (const float*)d_in[1]; a.norm_ffn = (const float*)d_in[2]; a.w_in = (const float*)d_in[3]; a.att_q_norm = (const float*)d_in[4]; a.att_k_norm = (const float*)d_in[5];
    a.mlstm_conv = (const float*)d_in[6]; a.mlstm_gate_bias = (const float*)d_in[7]; a.mlstm_out_norm = (const float*)d_in[8]; a.ret_out_norm = (const float*)d_in[9];
    a.w_b_att = (const float*)d_in[10]; a.w_b_mlstm = (const float*)d_in[11]; a.w_b_ret = (const float*)d_in[12]; a.w_out = (const float*)d_in[13]; a.w_ffn_in = (const float*)d_in[14]; a.w_ffn_out = (const float*)d_in[15];
    a.out = (float*)d_out; a.ws = (unsigned char*)d_ws;
#if ONE_LAUNCH
    a.layer_lo = 0; a.layer_hi = DEPTH; a.ph_lo = 0; a.ph_hi = PH_PER_LAYER + 1; hipLaunchKernelGGL((fwd<0, PH_PER_LAYER + 1>), dim3(grid), dim3(NTHR), LDS_BYTES, stream, a);
#else
    a.layer_lo = 0; a.layer_hi = 0; a.ph_lo = 0; a.ph_hi = 1; hipLaunchKernelGGL((fwd<0, 1>), dim3(grid), dim3(NTHR), LDS_BYTES, stream, a);
    for (int l = 0; l < DEPTH; ++l) for (int p = 1; p <= PH_PER_LAYER; ++p) { a.layer_lo = l; a.layer_hi = l + 1; a.ph_lo = p; a.ph_hi = p + 1; hipLaunchKernelGGL(phase_kernel<0>(p), dim3(grid), dim3(NTHR), LDS_BYTES, stream, a); }
#endif
}
```

```cpp
#include <hip/hip_runtime.h>
#include <cstdio>
#include <cstdint>
__device__ __forceinline__ int my_tid();
namespace pg8 {
#define PG8_LAS __attribute__((address_space(3)))
typedef unsigned short bf16_t;
typedef short bf16x8 __attribute__((ext_vector_type(8)));
typedef float f32x4 __attribute__((ext_vector_type(4)));
typedef unsigned u32x4 __attribute__((ext_vector_type(4)));
constexpr int BM = 256, BK = 64, HALF = 128, HTB = HALF * BK * 2  , STAGE_BYTES = 8 * HTB, NXCD = 8, WGM = 8;

__host__ __device__ __forceinline__ int lds_byte(int r, int c) { const int st = (r >> 4) * 2 + (c >> 5), rr = r & 15, cc = c & 31, ob = rr * 64 + cc * 2; return st * 1024 + (ob ^ (((ob >> 9) & 1) << 5)); }
__host__ __device__ __forceinline__ void stage_rc(int b, int& R, int& C) { const int st = b / 1024, sb = b % 1024, swz = sb ^ (((sb >> 9) & 1) << 5); R = (st >> 1) * 16 + swz / 64; C = (st & 1) * 32 + (swz % 64) / 2; }
__host__ __device__ __forceinline__ int perm32(int rho) { const int n = rho >> 4, i = rho & 15; return 8 * (i >> 2) + 4 * n + (i & 3); }

struct Unit { int pm, pn; };
struct Gemm { const bf16_t* A; const bf16_t* Bt; int M, N, K; };

struct StaticOrder {
    int nM, nN, nwg, G, c;
    __host__ __device__ void init(int M, int N, int G_, int c_) { nM = M / BM; nN = N / BM; nwg = nM * nN; G = G_; c = c_; }
    __host__ __device__ bool next(int i, Unit& u) const {
        const long L = (long)i * G + c; if (L >= nwg) return false;
        int wgid = (int)L; { const int q = nwg / NXCD, r = nwg % NXCD, xcd = wgid % NXCD, off = wgid / NXCD; wgid = (xcd < r ? xcd * (q + 1) : r * (q + 1) + (xcd - r) * q) + off; }
        const int nig = WGM * nN, gid = wgid / nig, fm = gid * WGM, gsz = (nM - fm) < WGM ? (nM - fm) : WGM;
        u.pm = fm + ((wgid % nig) % gsz); u.pn = (wgid % nig) / gsz; return true;
    }
    __device__ __forceinline__ void a_ready(const Unit&) const {}
    __device__ __forceinline__ void done(const Unit&) const {}
};

__device__ __forceinline__ unsigned cvt_pk_bf16(float lo, float hi) { unsigned r; asm volatile("v_cvt_pk_bf16_f32 %0, %1, %2" : "=v"(r) : "v"(lo), "v"(hi)); return r; }
typedef float f32x2 __attribute__((ext_vector_type(2)));
__device__ __forceinline__ float sigmoid_f(float x) { return __builtin_amdgcn_rcpf(1.0f + __builtin_amdgcn_exp2f(-1.4426950408889634f * x)); }
struct EpiProj {
    static constexpr bool PERM = true, AFTER_DRAIN = false;
    bf16_t* P; int ldp; float* Sm; int ngate0, nbf;
    __device__ __forceinline__ void operator()(const f32x4 (&acc)[2][2][4][2], const Unit& u, int wr, int wc, int fr, int fq) const {
        const int row0 = u.pm * BM + wr * 64 + fr, col0 = u.pn * BM + wc * 32 + 8 * fq;
        if (u.pn >= nbf) {
            const int c0 = wc * 32 + 8 * fq;
#pragma unroll
            for (int ai = 0; ai < 2; ++ai)
#pragma unroll
                for (int m = 0; m < 4; ++m) { float* rowp = Sm + (size_t)(row0 + ai * HALF + m * 16) * 256 + c0;
#pragma unroll
                    for (int bj = 0; bj < 2; ++bj) { *(f32x4*)(rowp + bj * HALF) = acc[ai][bj][m][0]; *(f32x4*)(rowp + bj * HALF + 4) = acc[ai][bj][m][1]; } }
            return;
        }
        const bool sg = u.pn >= ngate0;
#pragma unroll
        for (int ai = 0; ai < 2; ++ai)
#pragma unroll
            for (int m = 0; m < 4; ++m) { bf16_t* rowp = P + (size_t)(row0 + ai * HALF + m * 16) * ldp + col0;
#pragma unroll
                for (int bj = 0; bj < 2; ++bj) { f32x4 v0 = acc[ai][bj][m][0], v1 = acc[ai][bj][m][1];
                    if (sg) {
#pragma unroll
                        for (int j = 0; j < 4; ++j) { v0[j] = sigmoid_f(v0[j]); v1[j] = sigmoid_f(v1[j]); } }
                    u32x4 w; w.x = cvt_pk_bf16(v0[0], v0[1]); w.y = cvt_pk_bf16(v0[2], v0[3]); w.z = cvt_pk_bf16(v1[0], v1[1]); w.w = cvt_pk_bf16(v1[2], v1[3]);
                    *(u32x4*)(rowp + bj * HALF) = w; } }
    }
};
__device__ __forceinline__ f32x4 bf4_lo(u32x4 w) { return (f32x4){__uint_as_float(w.x << 16), __uint_as_float(w.x & 0xffff0000u), __uint_as_float(w.y << 16), __uint_as_float(w.y & 0xffff0000u)}; }
__device__ __forceinline__ f32x4 bf4_hi(u32x4 w) { return (f32x4){__uint_as_float(w.z << 16), __uint_as_float(w.z & 0xffff0000u), __uint_as_float(w.w << 16), __uint_as_float(w.w & 0xffff0000u)}; }
template <int MODE> struct EpiBranch {
    static constexpr bool PERM = true, AFTER_DRAIN = false;
    const bf16_t* G; int ldg; float* T; bf16_t* O; int ldt;
    __device__ __forceinline__ void operator()(const f32x4 (&acc)[2][2][4][2], const Unit& u, int wr, int wc, int fr, int fq) const {
        const int row0 = u.pm * BM + wr * 64 + fr, col0 = u.pn * BM + wc * 32 + 8 * fq;
#pragma unroll
        for (int ai = 0; ai < 2; ++ai)
#pragma unroll
            for (int m = 0; m < 4; ++m) { const size_t r = (size_t)(row0 + ai * HALF + m * 16);
#pragma unroll
                for (int bj = 0; bj < 2; ++bj) { const u32x4 g = *(const u32x4*)(G + r * ldg + col0 + bj * HALF);
                    f32x4 v0 = acc[ai][bj][m][0] * bf4_lo(g), v1 = acc[ai][bj][m][1] * bf4_hi(g);
                    float* tp = T + r * ldt + col0 + bj * HALF;
                    if (MODE >= 1) { v0 = v0 + *(const f32x4*)tp; v1 = v1 + *(const f32x4*)(tp + 4); }
                    if (MODE <= 1) { *(f32x4*)tp = v0; *(f32x4*)(tp + 4) = v1; }
                    else { u32x4 w; w.x = cvt_pk_bf16(v0[0], v0[1]); w.y = cvt_pk_bf16(v0[2], v0[3]); w.z = cvt_pk_bf16(v1[0], v1[1]); w.w = cvt_pk_bf16(v1[2], v1[3]);
                        *(u32x4*)(O + r * ldt + col0 + bj * HALF) = w; } } }
    }
};
struct EpiResid {
    static constexpr bool PERM = false, AFTER_DRAIN = false;
    const float* base; float* out; int ldc;
    __device__ __forceinline__ void operator()(const f32x4 (&acc)[2][2][4][2], const Unit& u, int wr, int wc, int fr, int fq) const {
        const int row0 = u.pm * BM + wr * 64 + fr, col0 = u.pn * BM + wc * 32 + 4 * fq;
#pragma unroll
        for (int ai = 0; ai < 2; ++ai)
#pragma unroll
            for (int m = 0; m < 4; ++m) { const size_t off = (size_t)(row0 + ai * HALF + m * 16) * ldc + col0;
#pragma unroll
                for (int bj = 0; bj < 2; ++bj)
#pragma unroll
                    for (int n = 0; n < 2; ++n) *(f32x4*)(out + off + bj * HALF + n * 16) = *(const f32x4*)(base + off + bj * HALF + n * 16) + acc[ai][bj][m][n]; }
    }
};
struct EpiSwiGLU {
    static constexpr bool PERM = true, AFTER_DRAIN = false;
    bf16_t* O; int ldc;
    __device__ __forceinline__ void operator()(const f32x4 (&acc)[2][2][4][2], const Unit& u, int wr, int wc, int fr, int fq) const {
        const int row0 = u.pm * BM + wr * 64 + fr, col0 = u.pn * HALF + wc * 32 + 8 * fq;
#pragma unroll
        for (int ai = 0; ai < 2; ++ai)
#pragma unroll
            for (int m = 0; m < 4; ++m) { f32x4 v0, v1;
#pragma unroll
                for (int j = 0; j < 4; ++j) { const float g0 = acc[ai][0][m][0][j], g1 = acc[ai][0][m][1][j];
                    v0[j] = g0 * sigmoid_f(g0) * acc[ai][1][m][0][j]; v1[j] = g1 * sigmoid_f(g1) * acc[ai][1][m][1][j]; }
                u32x4 w; w.x = cvt_pk_bf16(v0[0], v0[1]); w.y = cvt_pk_bf16(v0[2], v0[3]); w.z = cvt_pk_bf16(v1[0], v1[1]); w.w = cvt_pk_bf16(v1[2], v1[3]);
                *(u32x4*)(O + (size_t)(row0 + ai * HALF + m * 16) * ldc + col0) = w; }
    }
};
template <class Epi, class Sched, bool ALIGN_EPI = false, bool SP2 = false>
__device__ __forceinline__ void gemm_phase(PG8_LAS unsigned char* lds, const Gemm g, const Sched& S, const Epi& E) {
    int tid_o = my_tid(); asm volatile("" : "+v"(tid_o));
    const int tid = tid_o, wid = __builtin_amdgcn_readfirstlane(tid >> 6), lane = tid & 63, wr = wid >> 2, wc = wid & 3, fr = lane & 15, fq = lane >> 4;
    const int K = g.K, nt = K / BK;
    unsigned voffA[2], voffB[2];
#pragma unroll
    for (int i = 0; i < 2; ++i) { int R, C; stage_rc(tid * 16 + i * 8192, R, C); const int Rb = Epi::PERM ? ((R & ~31) + perm32(R & 31)) : R;
        voffA[i] = (unsigned)(R * K + C) * 2u; voffB[i] = (unsigned)(Rb * K + C) * 2u; }
    const size_t kstep = (size_t)(BK * 2);
    const size_t hstep = (size_t)HALF * K * 2;
    const size_t tstep = 2 * hstep;
    const unsigned ldsw = (unsigned)wid * 1024u;
    const int aoff = lds_byte(wr * 64 + fr, fq * 8), boff = lds_byte(wc * 32 + fr, fq * 8);
#define PG8_SA(b, h) (((b) * 2 + (h)) * HTB)
#define PG8_SB(b, h) ((4 + (b) * 2 + (h)) * HTB)
#define PG8_STAGE(bufoff, gbase, voff) do { _Pragma("unroll") for (int _i = 0; _i < 2; ++_i) \
        __builtin_amdgcn_global_load_lds((const unsigned*)((const char*)(gbase) + (voff)[_i]), (PG8_LAS unsigned*)(lds + (bufoff) + ldsw + _i * 8192), 16, 0, 0); } while (0)
#define PG8_LDA(dst, b, h) do { _Pragma("unroll") for (int m = 0; m < 4; ++m) _Pragma("unroll") for (int k = 0; k < 2; ++k) dst[m][k] = *(const PG8_LAS bf16x8*)(lds + PG8_SA(b, h) + aoff + m * 2048 + k * 1024); } while (0)
#define PG8_LDB(dst, b, h) do { _Pragma("unroll") for (int n = 0; n < 2; ++n) _Pragma("unroll") for (int k = 0; k < 2; ++k) dst[n][k] = *(const PG8_LAS bf16x8*)(lds + PG8_SB(b, h) + boff + n * 2048 + k * 1024); } while (0)
#define PG8_MMA(ai, bj, At, Bt) do { __builtin_amdgcn_s_setprio(1); _Pragma("unroll") for (int m = 0; m < 4; ++m) _Pragma("unroll") for (int n = 0; n < 2; ++n) _Pragma("unroll") for (int k = 0; k < 2; ++k) \
        acc[ai][bj][m][n] = __builtin_amdgcn_mfma_f32_16x16x32_bf16(Bt[n][k], At[m][k], acc[ai][bj][m][n], 0, 0, 0); __builtin_amdgcn_s_setprio(0); } while (0)
#define PG8_WAIT_V(n) asm volatile("s_waitcnt vmcnt(" #n ")" ::: "memory")
#define PG8_WAIT_L(n) asm volatile("s_waitcnt lgkmcnt(" #n ")" ::: "memory")
#define PG8_BAR __builtin_amdgcn_s_barrier()
#define PG8_SCHED __builtin_amdgcn_sched_barrier(0)
    Unit cur, nxt; int ui = 0;
    if (!S.next(0, cur)) return;
    f32x4 acc[2][2][4][2];
#pragma unroll
    for (int a = 0; a < 2; ++a)
#pragma unroll
        for (int b = 0; b < 2; ++b)
#pragma unroll
            for (int m = 0; m < 4; ++m)
#pragma unroll
                for (int n = 0; n < 2; ++n) acc[a][b][m][n] = (f32x4){0.f, 0.f, 0.f, 0.f};
    bf16x8 At[4][2], B0[2][2], B1[2][2];
    const char* cA = (const char*)g.A + (size_t)cur.pm * tstep; const char* cB = (const char*)g.Bt + (size_t)cur.pn * tstep;
    S.a_ready(cur);
    if constexpr (SP2) {
        PG8_STAGE(PG8_SB(0, 0), cB, voffB); PG8_STAGE(PG8_SB(0, 1), cB + hstep, voffB); PG8_STAGE(PG8_SA(0, 0), cA, voffA); PG8_STAGE(PG8_SA(0, 1), cA + hstep, voffA);
        if (wr == 1) PG8_BAR;
        PG8_WAIT_V(2); PG8_BAR;
        PG8_STAGE(PG8_SB(1, 0), cB + kstep, voffB); PG8_STAGE(PG8_SA(1, 0), cA + kstep, voffA); PG8_STAGE(PG8_SB(1, 1), cB + hstep + kstep, voffB);
        PG8_WAIT_V(6); PG8_BAR;
    } else {
        PG8_STAGE(PG8_SB(0, 0), cB, voffB); PG8_STAGE(PG8_SA(0, 0), cA, voffA); PG8_STAGE(PG8_SB(0, 1), cB + hstep, voffB); PG8_STAGE(PG8_SA(0, 1), cA + hstep, voffA);
        if (wr == 1) PG8_BAR;
        PG8_WAIT_V(4); PG8_BAR;
        PG8_STAGE(PG8_SB(1, 0), cB + kstep, voffB); PG8_STAGE(PG8_SA(1, 0), cA + kstep, voffA); PG8_STAGE(PG8_SB(1, 1), cB + hstep + kstep, voffB);
        PG8_WAIT_V(6); PG8_BAR;
    }
    for (;;) {
        const bool has_next = S.next(ui + 1, nxt);
        const char* nA = has_next ? (const char*)g.A + (size_t)nxt.pm * tstep : cA; const char* nB = has_next ? (const char*)g.Bt + (size_t)nxt.pn * tstep : cB;
        for (int t = 0; t < nt; t += 2) {
            const bool last = (t == nt - 2);
            const char* a1 = cA + (size_t)(t + 1) * kstep;
            const char* a2 = last ? nA : cA + (size_t)(t + 2) * kstep; const char* b2 = last ? nB : cB + (size_t)(t + 2) * kstep;
            const char* a3 = a2 + kstep; const char* b3 = b2 + kstep;
            if (last && has_next) S.a_ready(nxt);
            if constexpr (SP2) {
            PG8_LDB(B0, 0, 0); PG8_LDB(B1, 0, 1); PG8_SCHED; PG8_LDA(At, 0, 0); PG8_STAGE(PG8_SA(1, 1), a1 + hstep, voffA);
            PG8_WAIT_V(8); PG8_WAIT_L(0); PG8_BAR; PG8_MMA(0, 0, At, B0); PG8_MMA(0, 1, At, B1); PG8_BAR; PG8_SCHED;
            PG8_LDA(At, 0, 1); PG8_STAGE(PG8_SB(0, 0), b2, voffB); PG8_STAGE(PG8_SB(0, 1), b2 + hstep, voffB); PG8_STAGE(PG8_SA(0, 0), a2, voffA);
            PG8_WAIT_V(8); PG8_WAIT_L(0); PG8_BAR; PG8_MMA(1, 0, At, B0); PG8_MMA(1, 1, At, B1); PG8_BAR; PG8_SCHED;
            PG8_LDB(B0, 1, 0); PG8_LDB(B1, 1, 1); PG8_SCHED; PG8_LDA(At, 1, 0); PG8_STAGE(PG8_SA(0, 1), a2 + hstep, voffA);
            PG8_WAIT_V(8); PG8_WAIT_L(0); PG8_BAR; PG8_MMA(0, 0, At, B0); PG8_MMA(0, 1, At, B1); PG8_BAR; PG8_SCHED;
            PG8_LDA(At, 1, 1); PG8_STAGE(PG8_SB(1, 0), b3, voffB); PG8_STAGE(PG8_SB(1, 1), b3 + hstep, voffB); PG8_STAGE(PG8_SA(1, 0), a3, voffA);
            PG8_WAIT_V(8); PG8_WAIT_L(0); PG8_BAR; PG8_MMA(1, 0, At, B0); PG8_MMA(1, 1, At, B1); PG8_BAR; PG8_SCHED;
            } else {
            PG8_LDB(B0, 0, 0); PG8_SCHED; PG8_LDA(At, 0, 0); PG8_STAGE(PG8_SA(1, 1), a1 + hstep, voffA);
            PG8_WAIT_L(8); PG8_BAR; PG8_WAIT_L(0); PG8_MMA(0, 0, At, B0); PG8_BAR; PG8_SCHED;
            PG8_LDB(B1, 0, 1); PG8_STAGE(PG8_SB(0, 0), b2, voffB);
            PG8_BAR; PG8_WAIT_L(0); PG8_MMA(0, 1, At, B1); PG8_BAR;
            PG8_LDA(At, 0, 1); PG8_STAGE(PG8_SA(0, 0), a2, voffA);
            PG8_BAR; PG8_WAIT_L(0); PG8_MMA(1, 0, At, B0); PG8_BAR; PG8_SCHED;
            PG8_STAGE(PG8_SB(0, 1), b2 + hstep, voffB);
            PG8_WAIT_V(6); PG8_BAR; PG8_MMA(1, 1, At, B1); PG8_BAR;
            PG8_LDB(B0, 1, 0); PG8_SCHED; PG8_LDA(At, 1, 0); PG8_STAGE(PG8_SA(0, 1), a2 + hstep, voffA);
            PG8_WAIT_L(8); PG8_BAR; PG8_WAIT_L(0); PG8_MMA(0, 0, At, B0); PG8_BAR; PG8_SCHED;
            PG8_LDB(B1, 1, 1); PG8_STAGE(PG8_SB(1, 0), b3, voffB);
            PG8_BAR; PG8_WAIT_L(0); PG8_MMA(0, 1, At, B1); PG8_BAR;
            PG8_LDA(At, 1, 1); PG8_STAGE(PG8_SA(1, 0), a3, voffA);
            PG8_BAR; PG8_WAIT_L(0); PG8_MMA(1, 0, At, B0); PG8_BAR; PG8_SCHED;
            PG8_STAGE(PG8_SB(1, 1), b3 + hstep, voffB);
            PG8_WAIT_V(6); PG8_BAR; PG8_MMA(1, 1, At, B1); PG8_BAR;
            }
        }
        if constexpr (ALIGN_EPI) { if (wr == 0) PG8_BAR; }
        if constexpr (!Epi::AFTER_DRAIN) { E(acc, cur, wr, wc, fr, fq); S.done(cur); }
        if (!has_next) break;
#pragma unroll
        for (int a = 0; a < 2; ++a)
#pragma unroll
            for (int b = 0; b < 2; ++b)
#pragma unroll
                for (int m = 0; m < 4; ++m)
#pragma unroll
                    for (int n = 0; n < 2; ++n) acc[a][b][m][n] = (f32x4){0.f, 0.f, 0.f, 0.f};
        cur = nxt; cA = nA; cB = nB; ++ui;
        if constexpr (ALIGN_EPI) { if (wr == 1) PG8_BAR; }
    }
    PG8_WAIT_V(0);
    if constexpr (!ALIGN_EPI) { if (wr == 0) PG8_BAR; }
    PG8_BAR;
    if constexpr (Epi::AFTER_DRAIN) { E.fused(acc, cur, wr, wc, fr, fq, lds, wid, lane); S.done(cur); }
#undef PG8_SA
#undef PG8_SB
#undef PG8_STAGE
#undef PG8_LDA
#undef PG8_LDB
#undef PG8_MMA
#undef PG8_WAIT_V
#undef PG8_WAIT_L
#undef PG8_BAR
#undef PG8_SCHED
}
}

using pg8::sigmoid_f;
constexpr int NWAVES = 8, NTHR = 512;
constexpr int S = 8192, DM = 2048, DEPTH = 4, FF = 5632;
constexpr int NPROJ = 16896, NPROJ_PAD = 17152, LPROJ = 16976;
constexpr int PC_AQ = 0, PC_AK = 1024, PC_AV = 2048, PC_IQ = 3072, PC_MQ = 3584, PC_MK = 4096, PC_MV = 4608, PC_MO = 5632, PC_RQ = 6656, PC_RK = 7680, PC_RV = 8704, PC_RG = 9728, PC_G = 10752;
constexpr int LC_IK = 3584, LC_IW = 3648, LC_MI = 5704, LC_MF = 5708;
constexpr float NORM_EPS = 1e-6f;
constexpr size_t MiB = 1u << 20;
constexpr size_t WS_CTL = 0, CTL_ZERO_BYTES = 1 * MiB;
constexpr size_t WS_ROPE128 = 2 * MiB, WS_ROPE64 = 6 * MiB;
constexpr size_t WS_W = 16 * MiB, W_LAYER = 153 * MiB;
constexpr size_t WO_IN = 0, WO_B = 67 * MiB, WO_OUT = 79 * MiB, WO_FIN = 87 * MiB, WO_FOUT = 131 * MiB;
constexpr size_t WS_H = 640 * MiB, WS_PROJ = 672 * MiB, WS_SMALL = 936 * MiB, WS_MQK = 944 * MiB, WS_IKB = 960 * MiB, WS_IWF = 961 * MiB, WS_GIF = WS_IWF + 512 * 1024;
constexpr size_t WS_SC = 964 * MiB, WS_MB = 1220 * MiB, WS_DCM = 1228 * MiB, WS_CPM = 1260 * MiB, WS_MISC = 1292 * MiB, WS_DRR = 1294 * MiB, WS_RPR = 1310 * MiB;
constexpr size_t WS_YA = 1328 * MiB, WS_YM = 1344 * MiB, WS_YR = 1360 * MiB, WS_MERGEDF = 1376 * MiB, WS_MERGED = 1440 * MiB, WS_ACT = 1472 * MiB, WS_END = 1560 * MiB;
constexpr size_t MISC_DN = 0, MISC_NPREV = 256 * 1024, MISC_AB = 512 * 1024, MISC_MPREV = 520 * 1024;
constexpr int CW_BAR = 4096;
constexpr int LDS_BYTES = 147456, MISC_OFF = 147456 - 1024;

#define GAS __attribute__((address_space(1)))
#define LAS __attribute__((address_space(3)))
typedef unsigned short bf16;
typedef unsigned v4u __attribute__((ext_vector_type(4)));
typedef unsigned v2u __attribute__((ext_vector_type(2)));
typedef float f32x4 __attribute__((ext_vector_type(4)));
typedef float f32x16 __attribute__((ext_vector_type(16)));
typedef short bf16x8 __attribute__((ext_vector_type(8)));
typedef short s16x4 __attribute__((ext_vector_type(4)));
#define LDS_WAIT() asm volatile("s_waitcnt lgkmcnt(0)" ::: "memory")
#define VM_WAIT() asm volatile("s_waitcnt vmcnt(0)" ::: "memory")
__device__ __forceinline__ unsigned f2bf(float f) { unsigned u = __builtin_bit_cast(unsigned, f); return (u + 0x7fffu + ((u >> 16) & 1u)) >> 16; }
__device__ __forceinline__ unsigned pk2(float lo, float hi) { return f2bf(lo) | (f2bf(hi) << 16); }
__device__ __forceinline__ float bf2f(bf16 b) { return __uint_as_float(((unsigned)b) << 16); }
template <int CTRL, int RMASK, int BMASK> __device__ __forceinline__ float dpp_f(float old, float src) { return __builtin_bit_cast(float, __builtin_amdgcn_update_dpp(__builtin_bit_cast(int, old), __builtin_bit_cast(int, src), CTRL, RMASK, BMASK, false)); }
template <int CTRL, int RMASK, int BMASK> __device__ __forceinline__ unsigned dpp_u(unsigned src) { return (unsigned)__builtin_amdgcn_update_dpp(0, (int)src, CTRL, RMASK, BMASK, false); }
__device__ __forceinline__ float wave_sum(float x) {
    x += dpp_f<0xB1, 0xf, 0xf>(0.f, x); x += dpp_f<0x4E, 0xf, 0xf>(0.f, x); x += dpp_f<0x141, 0xf, 0xf>(0.f, x); x += dpp_f<0x140, 0xf, 0xf>(0.f, x);
    x += dpp_f<0x142, 0xa, 0xf>(0.f, x); x += dpp_f<0x143, 0xc, 0xf>(0.f, x);
    return __builtin_bit_cast(float, __builtin_amdgcn_readlane(__builtin_bit_cast(int, x), 63)); }
__device__ __forceinline__ float wave_max(float x) {
    x = fmaxf(x, dpp_f<0xB1, 0xf, 0xf>(x, x)); x = fmaxf(x, dpp_f<0x4E, 0xf, 0xf>(x, x)); x = fmaxf(x, dpp_f<0x141, 0xf, 0xf>(x, x)); x = fmaxf(x, dpp_f<0x140, 0xf, 0xf>(x, x));
    x = fmaxf(x, dpp_f<0x142, 0xa, 0xf>(x, x)); x = fmaxf(x, dpp_f<0x143, 0xc, 0xf>(x, x));
    return __builtin_bit_cast(float, __builtin_amdgcn_readlane(__builtin_bit_cast(int, x), 63)); }
__device__ __forceinline__ unsigned lane_id_v() { unsigned l; asm volatile("v_mbcnt_lo_u32_b32 %0, -1, 0\n\tv_mbcnt_hi_u32_b32 %0, -1, %0" : "=v"(l)); return l; }
__device__ __forceinline__ int my_tid() {
    const unsigned slot = (unsigned)__builtin_amdgcn_s_getreg((5 << 11) | 4) & 63u;
    extern __shared__ __attribute__((aligned(16))) unsigned char lds_raw_t[];
    const unsigned wv = ((volatile LAS unsigned*)((LAS unsigned char*)lds_raw_t + MISC_OFF))[64 + slot];
    return (int)(__builtin_amdgcn_readfirstlane(wv) * 64u + lane_id_v());
}
__device__ __forceinline__ float shfl_idx_f(float x, int src_lane) { return __builtin_bit_cast(float, __builtin_amdgcn_ds_bpermute(src_lane << 2, __builtin_bit_cast(int, x))); }
__device__ __forceinline__ float wave_prefix_sum_f(float x) {
    float y = x + dpp_f<0x111, 0xf, 0xf>(0.f, x); y += dpp_f<0x112, 0xf, 0xf>(0.f, x); y += dpp_f<0x113, 0xf, 0xf>(0.f, x);
    y += dpp_f<0x114, 0xf, 0xe>(0.f, y); y += dpp_f<0x118, 0xf, 0xc>(0.f, y); y += dpp_f<0x142, 0xa, 0xf>(0.f, y); y += dpp_f<0x143, 0xc, 0xf>(0.f, y); return y; }
__device__ __forceinline__ float wave_prefix_max_f(float x) {
    const float N = -3.0e38f;
    float y = fmaxf(x, dpp_f<0x111, 0xf, 0xf>(N, x)); y = fmaxf(y, dpp_f<0x112, 0xf, 0xf>(N, x)); y = fmaxf(y, dpp_f<0x113, 0xf, 0xf>(N, x));
    y = fmaxf(y, dpp_f<0x114, 0xf, 0xe>(N, y)); y = fmaxf(y, dpp_f<0x118, 0xf, 0xc>(N, y)); y = fmaxf(y, dpp_f<0x142, 0xa, 0xf>(N, y)); y = fmaxf(y, dpp_f<0x143, 0xc, 0xf>(N, y)); return y; }
#define XB_TMO      128
#define XB_XCNT(j)  (256  + 64 * (j))
#define XB_XSUB(j)  (1280 + 64 * (j))
#define XB_XGEN(j)  (2304 + 64 * (j))
#define XB_TOP      3328
#define XB_TOPGEN   3392
#define XCD_BAR_WORDS 3456
#define XB_SPIN_CAP (1u << 18)

__device__ __forceinline__ unsigned xb_ld(unsigned* p)              { return __hip_atomic_load(p, __ATOMIC_RELAXED, __HIP_MEMORY_SCOPE_AGENT); }
__device__ __forceinline__ unsigned xb_add(unsigned* p, unsigned v) { return __hip_atomic_fetch_add(p, v, __ATOMIC_RELAXED, __HIP_MEMORY_SCOPE_AGENT); }
__device__ __forceinline__ unsigned xb_xcc_id() { return (unsigned)__builtin_amdgcn_s_getreg((3 << 11) | 20) & 0xFu; }
#define XB_SPIN(cond, bar) do { unsigned _sp = 0; while (cond) { __builtin_amdgcn_s_sleep(1); \
    if ((++_sp & 255u) == 0u) { if (xb_ld(&(bar)[XB_TMO])) break; if (_sp > XB_SPIN_CAP) { atomicAdd(&(bar)[XB_TMO], 1u); break; } } } } while (0)

struct XcdBarrier {
    unsigned* bar; unsigned x;
    volatile LAS unsigned* st;
};

__device__ __forceinline__ XcdBarrier xcd_barrier_post(unsigned* bar, volatile LAS unsigned* st) {
    XcdBarrier b; b.bar = bar; b.x = xb_xcc_id(); b.st = st;
    if (my_tid() == 0) (void)xb_add(&bar[XB_XCNT(b.x)], 1u);
    return b;
}
__device__ __forceinline__ void xcd_barrier_complete(unsigned* bar, unsigned x, unsigned& nloc, unsigned& nx) {
    const unsigned G = gridDim.x * gridDim.y * gridDim.z;
    unsigned sum, cnt, mine, sp = 0u;
    for (;;) {
        sum = 0u; cnt = 0u; mine = 0u;
#pragma unroll
        for (unsigned j = 0; j < 16; ++j) { const unsigned c = xb_ld(&bar[XB_XCNT(j)]); sum += c; cnt += (c > 0u) ? 1u : 0u; mine = (j == x) ? c : mine; }
        if (sum == G) break;
        __builtin_amdgcn_s_sleep(1);
        if ((++sp & 255u) == 0u) { if (xb_ld(&bar[XB_TMO])) break; if (sp > XB_SPIN_CAP) { atomicAdd(&bar[XB_TMO], 1u); break; } }
    }
    nloc = mine > 0u ? mine : 1u; nx = cnt > 0u ? cnt : 1u;
}

__device__ __forceinline__ void xcd_barrier(const XcdBarrier& b) {
    asm volatile("s_waitcnt vmcnt(0)" ::: "memory");
    __syncthreads();
    if (my_tid() == 0) {
        unsigned* bar = b.bar;
        __builtin_amdgcn_s_waitcnt(0);
        unsigned nloc = b.st[0], nx = b.st[1];
        if (nloc == 0u) { xcd_barrier_complete(bar, b.x, nloc, nx); b.st[0] = nloc; b.st[1] = nx; }
        const unsigned old = xb_add(&bar[XB_XSUB(b.x)], 1u);
        const unsigned gen = old / nloc;
        if (old + 1u == (gen + 1u) * nloc) {
            __builtin_amdgcn_fence(__ATOMIC_RELEASE, "agent");
            asm volatile("s_waitcnt vmcnt(0)" ::: "memory");
            const unsigned og = xb_add(&bar[XB_TOP], 1u);
            const unsigned tg = og / nx;
            if (og + 1u == (tg + 1u) * nx) xb_add(&bar[XB_TOPGEN], 1u);
            else XB_SPIN(xb_ld(&bar[XB_TOPGEN]) == tg, bar);
            __builtin_amdgcn_fence(__ATOMIC_ACQUIRE, "agent");
            xb_add(&bar[XB_XGEN(b.x)], 1u);
            asm volatile("s_waitcnt vmcnt(0)" ::: "memory");
        } else {
            XB_SPIN(xb_ld(&bar[XB_XGEN(b.x)]) == gen, bar);
            __builtin_amdgcn_fence(__ATOMIC_ACQUIRE, "agent");
            asm volatile("s_waitcnt vmcnt(0)" ::: "memory");
        }
    }
    __syncthreads();
}

struct MapIdent { __device__ __forceinline__ int operator()(int p) const { return p; } };
struct MapWin { __device__ __forceinline__ int operator()(int p) const {
    if (p < 3584) return p; if (p < 5632) return p + 72; if (p < NPROJ) return p + 80;
    const int r = p - NPROJ; if (r < 64) return LC_IK + r; if (r < 72) return LC_IW + (r - 64); if (r < 76) return LC_MI + (r - 72); if (r < 80) return LC_MF + (r - 76); return -1; } };
struct MapFfn { __device__ __forceinline__ int operator()(int p) const { const int t = p >> 8, r = p & 255; return r < 128 ? 128 * t + r : FF + 128 * t + (r - 128); } };
template <class Map> __device__ __forceinline__ void transpose_item(const float* W, int K, int N, bf16* WT, LAS float* scr, int item, int nblk, int lane, const Map& map) {
    const int kb = item / nblk, nb = item % nblk, k0 = 64 * kb, p0 = 64 * nb;
    const int n4 = lane & 15, kr = lane >> 4, nl = map(p0 + 4 * n4);
    f32x4 v[16];
#pragma unroll
    for (int i = 0; i < 16; ++i) v[i] = nl >= 0 ? *(const GAS f32x4*)(W + (size_t)(k0 + kr + 4 * i) * N + nl) : (f32x4){0.f, 0.f, 0.f, 0.f};
#pragma unroll
    for (int i = 0; i < 16; ++i) { LAS float* d = scr + (kr + 4 * i) * 65 + 4 * n4; d[0] = v[i][0]; d[1] = v[i][1]; d[2] = v[i][2]; d[3] = v[i][3]; }
    LDS_WAIT(); asm volatile("" ::: "memory");
    const int c = lane & 7;
#pragma unroll
    for (int j = 0; j < 8; ++j) { const int n = (lane >> 3) + 8 * j; const LAS float* s = scr + (8 * c) * 65 + n;
        v4u o; o.x = pk2(s[0 * 65], s[1 * 65]); o.y = pk2(s[2 * 65], s[3 * 65]); o.z = pk2(s[4 * 65], s[5 * 65]); o.w = pk2(s[6 * 65], s[7 * 65]);
        *(GAS v4u*)(WT + (size_t)(p0 + n) * K + k0 + 8 * c) = o; }
    LDS_WAIT(); asm volatile("" ::: "memory");
}
template <class Map> __device__ __forceinline__ void transpose_matrix(const float* W, int K, int N, int Nphys, bf16* WT, LAS float* scr, int gw, int ngw, int lane, const Map& map) {
    const int nblk = Nphys / 64, nit = (K / 64) * nblk;
    for (int it = gw; it < nit; it += ngw) transpose_item(W, K, N, WT, scr, it, nblk, lane, map);
}

__device__ __forceinline__ void rms_row_to_bf16(const float* xrow, const float* gain, bf16* orow, int lane) {
    const GAS f32x4* xr = (const GAS f32x4*)xrow + lane; const GAS f32x4* gr = (const GAS f32x4*)gain + lane;
    f32x4 v[8]; float s = 0.f;
#pragma unroll
    for (int j = 0; j < 8; ++j) { v[j] = xr[64 * j]; s += (v[j].x * v[j].x + v[j].y * v[j].y) + (v[j].z * v[j].z + v[j].w * v[j].w); }
    const float rstd = 1.0f / sqrtf(wave_sum(s) * (1.f / DM) + NORM_EPS);
    GAS unsigned long long* o8 = (GAS unsigned long long*)orow + lane;
#pragma unroll
    for (int j = 0; j < 8; ++j) { const f32x4 g = gr[64 * j]; o8[64 * j] = (unsigned long long)pk2(v[j].x * rstd * g.x, v[j].y * rstd * g.y) | ((unsigned long long)pk2(v[j].z * rstd * g.z, v[j].w * rstd * g.w) << 32); }
}

struct PPArgs { bf16* proj; const float* small; bf16* mqk; bf16* ikb; unsigned char* sgn; float* gif; const float* rope128; const float* rope64; const float* gq; const float* gk; const float* convw; const float* gbias; };
__device__ __forceinline__ void bf8_unpack(const v4u w, float (&f)[8]) { f[0] = __uint_as_float(w.x << 16); f[1] = __uint_as_float(w.x & 0xffff0000u); f[2] = __uint_as_float(w.y << 16); f[3] = __uint_as_float(w.y & 0xffff0000u);
    f[4] = __uint_as_float(w.z << 16); f[5] = __uint_as_float(w.z & 0xffff0000u); f[6] = __uint_as_float(w.w << 16); f[7] = __uint_as_float(w.w & 0xffff0000u); }
__device__ __forceinline__ v4u bf8_pack(const float (&f)[8]) { v4u o; o.x = pk2(f[0], f[1]); o.y = pk2(f[2], f[3]); o.z = pk2(f[4], f[5]); o.w = pk2(f[6], f[7]); return o; }
__device__ __forceinline__ float sum8_dpp(float x) {
    x += dpp_f<0xB1, 0xf, 0xf>(0.f, x); x += dpp_f<0x4E, 0xf, 0xf>(0.f, x); x += dpp_f<0x141, 0xf, 0xf>(0.f, x); return x; }
__device__ __forceinline__ void pp_row(const PPArgs& a, int t, int lane, const f32x4 (&cw)[16]) {
    bf16* pr = a.proj + (size_t)t * NPROJ;
    const int hd = lane >> 3, d0 = (lane & 7) * 8;
    float cs[8], sn[8];
#pragma unroll
    for (int i = 0; i < 4; ++i) { const f32x4 c = *(const f32x4*)(a.rope128 + ((size_t)t * 64 + d0 + 2 * i) * 2); cs[2 * i] = c[0]; sn[2 * i] = c[1]; cs[2 * i + 1] = c[2]; sn[2 * i + 1] = c[3]; }
#pragma unroll
    for (int seg = 0; seg < 4; ++seg) {
        const int base = seg == 0 ? PC_AQ : (seg == 1 ? PC_AK : (seg == 2 ? PC_RQ : PC_RK));
        bf16* p = pr + base + hd * 128 + d0; float x1[8], x2[8];
        bf8_unpack(*(const GAS v4u*)p, x1); bf8_unpack(*(const GAS v4u*)(p + 64), x2);
        if (seg < 2) { const float* gn = seg ? a.gk : a.gq; float ss = 0.f;
#pragma unroll
            for (int i = 0; i < 8; ++i) ss += x1[i] * x1[i] + x2[i] * x2[i];
            const float rstd = 1.0f / sqrtf(sum8_dpp(ss) * (1.f / 128.f) + NORM_EPS);
            const f32x4 ga = *(const f32x4*)(gn + d0), gb = *(const f32x4*)(gn + d0 + 4), gc = *(const f32x4*)(gn + 64 + d0), gd = *(const f32x4*)(gn + 64 + d0 + 4);
#pragma unroll
            for (int i = 0; i < 4; ++i) { x1[i] *= rstd * ga[i]; x1[4 + i] *= rstd * gb[i]; x2[i] *= rstd * gc[i]; x2[4 + i] *= rstd * gd[i]; } }
        float o1[8], o2[8];
#pragma unroll
        for (int i = 0; i < 8; ++i) { o1[i] = x1[i] * cs[i] - x2[i] * sn[i]; o2[i] = x2[i] * cs[i] + x1[i] * sn[i]; }
        *(GAS v4u*)p = bf8_pack(o1); *(GAS v4u*)(p + 64) = bf8_pack(o2); }
    const float* sm = a.small + (size_t)t * 256;
    {
        const int e0 = (lane & 7) * 4; const f32x4 ca = *(const f32x4*)(a.rope64 + ((size_t)t * 32 + e0) * 2), cb = *(const f32x4*)(a.rope64 + ((size_t)t * 32 + e0 + 2) * 2);
        const float c4[4] = {ca[0], ca[2], cb[0], cb[2]}, s4[4] = {ca[1], ca[3], cb[1], cb[3]};
        bf16* p = pr + PC_IQ + hd * 64 + e0; const v2u lo = *(const GAS v2u*)p, hi = *(const GAS v2u*)(p + 32);
        const float aw = fabsf(sm[64 + hd]) * (0.35355339059327373f * 0.125f);
        const float y1[4] = {__uint_as_float(lo.x << 16), __uint_as_float(lo.x & 0xffff0000u), __uint_as_float(lo.y << 16), __uint_as_float(lo.y & 0xffff0000u)};
        const float y2[4] = {__uint_as_float(hi.x << 16), __uint_as_float(hi.x & 0xffff0000u), __uint_as_float(hi.y << 16), __uint_as_float(hi.y & 0xffff0000u)};
        float q1[4], q2[4];
#pragma unroll
        for (int i = 0; i < 4; ++i) { q1[i] = (y1[i] * c4[i] - y2[i] * s4[i]) * aw; q2[i] = (y2[i] * c4[i] + y1[i] * s4[i]) * aw; }
        v2u w1, w2; w1.x = pk2(q1[0], q1[1]); w1.y = pk2(q1[2], q1[3]); w2.x = pk2(q2[0], q2[1]); w2.y = pk2(q2[2], q2[3]);
        *(GAS v2u*)p = w1; *(GAS v2u*)(p + 32) = w2;
        if (lane < 8) { const f32x4 k1 = *(const f32x4*)(sm + e0), k2 = *(const f32x4*)(sm + 32 + e0); float r1[4], r2[4];
#pragma unroll
            for (int i = 0; i < 4; ++i) { r1[i] = k1[i] * c4[i] - k2[i] * s4[i]; r2[i] = k2[i] * c4[i] + k1[i] * s4[i]; }
            v2u u1, u2; u1.x = pk2(r1[0], r1[1]); u1.y = pk2(r1[2], r1[3]); u2.x = pk2(r2[0], r2[1]); u2.y = pk2(r2[2], r2[3]);
            *(GAS v2u*)(a.ikb + (size_t)t * 64 + e0) = u1; *(GAS v2u*)(a.ikb + (size_t)t * 64 + 32 + e0) = u2; } }
    { const unsigned long long nb = __builtin_amdgcn_ballot_w64(lane < 8 && sm[64 + (lane & 7)] < 0.f); if (lane == 0) a.sgn[t] = (unsigned char)(nb & 0xffull); }
    if (lane < 8) a.gif[(size_t)t * 8 + lane] = sm[72 + lane] + a.gbias[lane];
    {
        float acc[16];
#pragma unroll
        for (int i = 0; i < 16; ++i) acc[i] = 0.f;
#pragma unroll
        for (int j = 0; j < 4; ++j) { const int tt = t - 3 + j; if (tt >= 0) { const bf16* xp = a.proj + (size_t)tt * NPROJ + PC_MQ + 16 * lane; float xa[8], xb[8];
                bf8_unpack(*(const GAS v4u*)xp, xa); bf8_unpack(*(const GAS v4u*)(xp + 8), xb);
#pragma unroll
                for (int i = 0; i < 4; ++i) { acc[i] += cw[j * 4][i] * xa[i]; acc[4 + i] += cw[j * 4 + 1][i] * xa[4 + i]; acc[8 + i] += cw[j * 4 + 2][i] * xb[i]; acc[12 + i] += cw[j * 4 + 3][i] * xb[4 + i]; } } }
        float oa[8], ob[8];
#pragma unroll
        for (int i = 0; i < 8; ++i) { oa[i] = acc[i]; ob[i] = acc[8 + i]; }
        bf16* mp = a.mqk + (size_t)t * 1024 + 16 * lane; *(GAS v4u*)mp = bf8_pack(oa); *(GAS v4u*)(mp + 8) = bf8_pack(ob); }
}

constexpr int SCT_RS = 272, IQT_RS = 1040, IQT_BYTES = 32 * IQT_RS;
__device__ __forceinline__ void score_wave_unit(LAS unsigned char* wt, const LAS unsigned char* iqt, const bf16* ikb, const unsigned char* sgn, float* sc, int qb, int kb, int lane) {
    const int r = lane & 31, h = lane >> 5, q0 = qb * 32, s0 = kb * 64;
    bf16x8 ka[2][4];
#pragma unroll
    for (int b = 0; b < 2; ++b)
#pragma unroll
        for (int kk = 0; kk < 4; ++kk) ka[b][kk] = *(const bf16x8*)(ikb + (size_t)(s0 + 32 * b + r) * 64 + 16 * kk + 8 * h);
    const LAS unsigned char* qrow = iqt + r * IQT_RS + 16 * h;
    const unsigned sb = sgn[q0 + r];
    f32x16 scv[2];
#pragma unroll
    for (int b = 0; b < 2; ++b)
#pragma unroll
        for (int e = 0; e < 16; ++e) scv[b][e] = 0.f;
#pragma unroll 2
    for (int j = 0; j < 8; ++j) { bf16x8 qf[4];
#pragma unroll
        for (int kk = 0; kk < 4; ++kk) qf[kk] = *(const LAS bf16x8*)(qrow + j * 128 + kk * 32);
        const float sj = ((sb >> j) & 1u) ? -1.0f : 1.0f;
#pragma unroll
        for (int b = 0; b < 2; ++b) { f32x16 acc;
#pragma unroll
            for (int e = 0; e < 16; ++e) acc[e] = 0.f;
#pragma unroll
            for (int kk = 0; kk < 4; ++kk) acc = __builtin_amdgcn_mfma_f32_32x32x16_bf16(ka[b][kk], qf[kk], acc, 0, 0, 0);
#pragma unroll
            for (int e = 0; e < 16; ++e) scv[b][e] = fmaf(fmaxf(acc[e], 0.f), sj, scv[b][e]); } }
#pragma unroll
    for (int b = 0; b < 2; ++b)
#pragma unroll
        for (int g = 0; g < 4; ++g) *(LAS f32x4*)(wt + r * SCT_RS + (32 * b + 8 * g + 4 * h) * 4) = (f32x4){scv[b][4 * g], scv[b][4 * g + 1], scv[b][4 * g + 2], scv[b][4 * g + 3]};
#pragma unroll
    for (int k = 0; k < 8; ++k) { const int row = 4 * k + (lane >> 4), c4 = (lane & 15) * 4;
        const f32x4 x = *(const LAS f32x4*)(wt + row * SCT_RS + c4 * 4);
        *(GAS f32x4*)(sc + (size_t)(q0 + row) * S + s0 + c4) = x; }
}


__device__ __forceinline__ float wave_max_dpp(float x) { return wave_max(x); }
__device__ __forceinline__ float wave_min_dpp(float x) { return -wave_max_dpp(-x); }
__device__ __forceinline__ unsigned wave_prefix_dpp(unsigned x) {
    unsigned y = x + dpp_u<0x111, 0xf, 0xf>(x); y += dpp_u<0x112, 0xf, 0xf>(x); y += dpp_u<0x113, 0xf, 0xf>(x);
    y += dpp_u<0x114, 0xf, 0xe>(y); y += dpp_u<0x118, 0xf, 0xc>(y); y += dpp_u<0x142, 0xa, 0xf>(y); y += dpp_u<0x143, 0xc, 0xf>(y);
    return y; }
#define SEL_BAR() do { asm volatile("s_waitcnt lgkmcnt(0)" ::: "memory"); __builtin_amdgcn_s_barrier(); asm volatile("" ::: "memory"); } while (0)
#define SEL_ROW(i) ((i) < n0 ? row0 + (i) * rstep : xrow0 + ((i) - n0) * xstep)
__device__ __forceinline__ void select_rows_wg(LAS unsigned char* lds, const float* sc, unsigned long long* mb, int row0, int rstep, int n0, int xrow0, int xstep, int n1, int tid) {
    LAS unsigned* hist = (LAS unsigned*)lds;
    LAS unsigned* btot = hist + 2176;
    LAS float* red = (LAS float*)(hist + 2240); LAS unsigned* lcnt = hist + 2256;
    LAS float* lval = (LAS float*)(hist + 2272); LAS int* lidx = (LAS int*)(hist + 2272 + 8192); LAS unsigned* lsel = hist + 2272 + 16384;
    const int lane = tid & 63, w = tid >> 6;
    f32x4 nx[4];
#define SEL_LOAD(t_) do { const float* scr_ = sc + (size_t)(t_) * S + 4 * tid; _Pragma("unroll") for (int j = 0; j < 4; ++j) nx[j] = *(const GAS f32x4*)(scr_ + 2048 * j); } while (0)
    const int nrows = n0 + n1;
    if (nrows > 0) SEL_LOAD(SEL_ROW(0));
    if (tid < 2) lcnt[tid] = 0u;
    for (int j = tid; j < 2240; j += NTHR) hist[j] = 0u;
    if (tid == 0) lsel[0] = 0u;
    int par = 0;
    for (int ri = 0; ri < nrows; ++ri) { const int t = SEL_ROW(ri);
        float v[16];
#pragma unroll
        for (int j = 0; j < 4; ++j)
#pragma unroll
            for (int c = 0; c < 4; ++c) v[4 * j + c] = (2048 * j + 4 * tid + c <= t) ? nx[j][c] : -3.0e38f;
        if (ri + 1 < nrows) SEL_LOAD(SEL_ROW(ri + 1));
        unsigned long long* mbr = mb + (size_t)t * 128;
        bool sel[16];
        if (t >= 256) {
            const int ngrp = (t >> 11) + 1;
            float mn = 3.0e38f, mx = -3.0e38f;
#pragma unroll
            for (int i = 0; i < 16; ++i) { mx = fmaxf(mx, v[i]); mn = fminf(mn, (v[i] > -3.0e38f) ? v[i] : 3.0e38f); }
            mn = wave_min_dpp(mn); mx = wave_max_dpp(mx);
            if (lane == 0) { red[w] = mn; red[8 + w] = mx; }
            SEL_BAR();
            mn = red[0]; mx = red[8];
#pragma unroll
            for (int j = 1; j < 8; ++j) { mn = fminf(mn, red[j]); mx = fmaxf(mx, red[8 + j]); }
            const float scale = (mx > mn) ? 2047.0f / (mx - mn) : 0.f;
            int bin[16];
#pragma unroll
            for (int i = 0; i < 16; ++i) { int b = (int)((v[i] - mn) * scale); b = b < 0 ? 0 : (b > 2047 ? 2047 : b); const bool ok = v[i] > -3.0e38f; bin[i] = ok ? b : -1;
                if ((i >> 2) < ngrp) { (void)__hip_atomic_fetch_add(hist + (ok ? b + (b >> 5) : 2112 + lane), 1u, __ATOMIC_RELAXED, __HIP_MEMORY_SCOPE_WORKGROUP);
                    (void)__hip_atomic_fetch_add(btot + (ok ? (b >> 5) : 0), ok ? 1u : 0u, __ATOMIC_RELAXED, __HIP_MEMORY_SCOPE_WORKGROUP); } }
            SEL_BAR();
            const unsigned bt = btot[63 - lane]; const unsigned sufb = wave_prefix_dpp(bt);
            const unsigned long long ob = __builtin_amdgcn_ballot_w64(sufb >= 256u);
            const int olb = ob ? (int)__builtin_ctzll(ob) : 0; const int blk = 63 - olb;
            const unsigned above_blk = (unsigned)__builtin_amdgcn_readlane((int)(sufb - bt), olb);
            const unsigned hbn = (lane < 32) ? hist[33 * blk + 31 - lane] : 0u; const unsigned sufn = wave_prefix_dpp(hbn) + above_blk;
            const unsigned long long on = __builtin_amdgcn_ballot_w64(lane < 32 && sufn >= 256u);
            const int oln = on ? (int)__builtin_ctzll(on) : 0;
            const int bstar = 32 * blk + 31 - oln; const unsigned need = 256u - (unsigned)__builtin_amdgcn_readlane((int)(sufn - hbn), oln);
            int ks[16];
#pragma unroll
            for (int i = 0; i < 16; ++i) { ks[i] = -1; if (bin[i] == bstar) { const unsigned k = __hip_atomic_fetch_add(lcnt + par, 1u, __ATOMIC_RELAXED, __HIP_MEMORY_SCOPE_WORKGROUP); lval[k] = v[i]; lidx[k] = 2048 * (i >> 2) + 4 * tid + (i & 3); ks[i] = (int)k; } }
            SEL_BAR();
            const int nl = (int)lcnt[par];
            for (int k = tid; k < nl; k += NTHR) { const float x = lval[k]; const int s = lidx[k]; unsigned rank = 0u;
                for (int j = 0; j < nl; ++j) { const float y = lval[j]; const int sj = lidx[j]; rank += (y > x || (y == x && sj < s)) ? 1u : 0u; }
                lsel[k] = rank < need ? 1u : 0u; }
            SEL_BAR();
#pragma unroll
            for (int i = 0; i < 16; ++i) { const unsigned lv = lsel[ks[i] < 0 ? 0 : ks[i]]; sel[i] = bin[i] > bstar || (ks[i] >= 0 && lv != 0u); }
            *(LAS v4u*)(hist + 4 * tid) = (v4u){0u, 0u, 0u, 0u}; if (tid < 48) *(LAS v4u*)(hist + 2048 + 4 * tid) = (v4u){0u, 0u, 0u, 0u};
            if (tid == 0) lcnt[par ^ 1] = 0u;
            par ^= 1;
        } else {
#pragma unroll
            for (int i = 0; i < 16; ++i) sel[i] = v[i] > -3.0e38f;
        }
#pragma unroll
        for (int j = 0; j < 4; ++j) { unsigned long long wd = 0ull;
#pragma unroll
            for (int c = 0; c < 4; ++c) { const unsigned long long b = __builtin_amdgcn_ballot_w64(sel[4 * j + c]); wd |= ((b >> (16 * (lane & 3))) & 0xffffull) << (16 * c); }
            if (lane < 4) mbr[32 * j + 4 * w + lane] = wd; }
    }
    SEL_BAR();
#undef SEL_LOAD
#undef SEL_ROW
}

template <int RS> __device__ __forceinline__ bf16x8 frag_row(const LAS unsigned char* base, int r0, int k0, int lane) {
    return *(const LAS bf16x8*)(base + (r0 + (lane & 15)) * RS + (k0 + 8 * (lane >> 4)) * 2);
}
template <int RS> __device__ __forceinline__ bf16x8 frag_tr(const LAS unsigned char* base, int k0, int c0, int lane) {
    const int g = lane >> 4, q = (lane & 15) >> 2, p = lane & 3;
    const unsigned a = (unsigned)(size_t)(base + (k0 + 8 * g + q) * RS + (c0 + 4 * p) * 2);
    s16x4 lo, hi;
    asm volatile("ds_read_b64_tr_b16 %0, %2\n\tds_read_b64_tr_b16 %1, %2 offset:%3\n\ts_waitcnt lgkmcnt(0)" : "=&v"(lo), "=&v"(hi) : "v"(a), "i"(4 * RS) : "memory");
    return (bf16x8){lo[0], lo[1], lo[2], lo[3], hi[0], hi[1], hi[2], hi[3]};
}
#define MFMA16(a, b, c) __builtin_amdgcn_mfma_f32_16x16x32_bf16((a), (b), (c), 0, 0, 0)
constexpr int SCR_OFF = 114688;
constexpr float DK_SCALE = 0.08838834764831845f;
__device__ __forceinline__ float log_sigmoid_f(float x) { return fminf(x, 0.f) - log1pf(expf(-fabsf(x))); }

template <int L, int DV> __device__ __forceinline__ void chunk_delta(LAS unsigned char* lds, const bf16* ksrc, int ldk, const bf16* vsrc, int ldv, const LAS float* wcol, bf16* outT, float* dn, int tid) {
    constexpr int RSK = (128 + 8) * 2, RSV = (DV + 8) * 2, NCB = DV / 128;
    LAS unsigned char* KA = lds; LAS unsigned char* V = lds + L * RSK;
    const int lane = tid & 63, w = tid >> 6;
    for (int idx = tid; idx < L * 16; idx += NTHR) { const int s = idx >> 4, c8 = idx & 15;
        const v4u x = *(const GAS v4u*)(ksrc + (size_t)s * ldk + c8 * 8); const float sc = DK_SCALE * wcol[s]; v4u o;
        o.x = pk2(__uint_as_float(x.x << 16) * sc, __uint_as_float(x.x & 0xffff0000u) * sc); o.y = pk2(__uint_as_float(x.y << 16) * sc, __uint_as_float(x.y & 0xffff0000u) * sc);
        o.z = pk2(__uint_as_float(x.z << 16) * sc, __uint_as_float(x.z & 0xffff0000u) * sc); o.w = pk2(__uint_as_float(x.w << 16) * sc, __uint_as_float(x.w & 0xffff0000u) * sc);
        *(LAS v4u*)(KA + s * RSK + c8 * 16) = o; }
    for (int idx = tid; idx < L * (DV / 8); idx += NTHR) { const int s = idx / (DV / 8), c8 = idx % (DV / 8);
        *(LAS v4u*)(V + s * RSV + c8 * 16) = *(const GAS v4u*)(vsrc + (size_t)s * ldv + c8 * 8); }
    __syncthreads();
    f32x4 acc[8][NCB];
#pragma unroll
    for (int db = 0; db < 8; ++db)
#pragma unroll
        for (int i = 0; i < NCB; ++i) acc[db][i] = (f32x4){0.f, 0.f, 0.f, 0.f};
#pragma unroll
    for (int kk = 0; kk < L / 32; ++kk) {
        bf16x8 bfr[NCB];
#pragma unroll
        for (int i = 0; i < NCB; ++i) bfr[i] = frag_tr<RSV>(V, 32 * kk, 16 * (w * NCB + i), lane);
#pragma unroll
        for (int db = 0; db < 8; ++db) { const bf16x8 a = frag_tr<RSK>(KA, 32 * kk, 16 * db, lane);
#pragma unroll
            for (int i = 0; i < NCB; ++i) acc[db][i] = MFMA16(a, bfr[i], acc[db][i]); }
    }
#pragma unroll
    for (int db = 0; db < 8; ++db)
#pragma unroll
        for (int i = 0; i < NCB; ++i) { const int e = 16 * (w * NCB + i) + (lane & 15), d0 = 16 * db + 4 * (lane >> 4);
            v2u o; o.x = pk2(acc[db][i][0], acc[db][i][1]); o.y = pk2(acc[db][i][2], acc[db][i][3]);
            *(GAS v2u*)(outT + (size_t)e * 128 + d0) = o; }
    if (dn != nullptr && tid < 128) { float s_ = 0.f;
        for (int s = 0; s < L; ++s) s_ += bf2f(*(const LAS bf16*)(KA + s * RSK + tid * 2));
        dn[tid] = s_; }
    __syncthreads();
}

template <int L, int DV, int MODE> __device__ __forceinline__ void chunk_out(LAS unsigned char* lds, LAS float* sf, const bf16* qsrc, int ldq, const bf16* ksrc, int ldk, const bf16* vsrc, int ldv,
                                                                              const bf16* stT, const float* gain, const bf16* gate, int ldg, bf16* y, int ldy, int tid) {
    constexpr int RSQ = (128 + 8) * 2, RSV = (DV + 8) * 2, RSP = (L + 8) * 2, NCB = DV / 128, NT = L / 16, TPW = NT * NT / 8;
    LAS unsigned char* Q = lds; LAS unsigned char* K = lds + L * RSQ; LAS unsigned char* V = lds + 2 * L * RSQ;
    LAS unsigned char* P = (MODE == 0) ? (lds + 2 * L * RSQ + L * RSV) : K;
    LAS float* H = (LAS float*)lds;
    LAS float* lrow = sf; LAS float* lcol = sf + 128; LAS float* qs = sf + 256; LAS float* flo = sf + 384; LAS float* rowsum = sf + 512; LAS float* npv = sf + 640; LAS float* part = sf + 768; LAS float* dpart = sf + 768 + L * NT;
    const int lane = tid & 63, w = tid >> 6, g4 = lane >> 4, c16 = lane & 15;
    for (int idx = tid; idx < L * 16; idx += NTHR) { const int s = idx >> 4, c8 = idx & 15;
        *(LAS v4u*)(Q + s * RSQ + c8 * 16) = *(const GAS v4u*)(qsrc + (size_t)s * ldq + c8 * 8);
        *(LAS v4u*)(K + s * RSQ + c8 * 16) = *(const GAS v4u*)(ksrc + (size_t)s * ldk + c8 * 8); }
    for (int idx = tid; idx < L * (DV / 8); idx += NTHR) { const int s = idx / (DV / 8), c8 = idx % (DV / 8);
        *(LAS v4u*)(V + s * RSV + c8 * 16) = *(const GAS v4u*)(vsrc + (size_t)s * ldv + c8 * 8); }
    __syncthreads();
    f32x4 pv[TPW];
#pragma unroll
    for (int i = 0; i < TPW; ++i) { const int ti = w * TPW + i, rb = ti / NT, cb = ti % NT; f32x4 a = (f32x4){0.f, 0.f, 0.f, 0.f};
        if (cb <= rb) {
#pragma unroll
            for (int kk = 0; kk < 4; ++kk) a = MFMA16(frag_row<RSQ>(Q, 16 * rb, 32 * kk, lane), frag_row<RSQ>(K, 16 * cb, 32 * kk, lane), a);
            const int s = 16 * cb + c16; const float lc = lcol[s]; float rs[4];
#pragma unroll
            for (int r = 0; r < 4; ++r) { const int t = 16 * rb + 4 * g4 + r; const float pw = (s <= t) ? __expf(lrow[t] + lc) * a[r] * DK_SCALE : 0.f; a[r] = pw; rs[r] = pw; }
            if (MODE == 0) {
#pragma unroll
                for (int r = 0; r < 4; ++r) { float v = rs[r]; v += dpp_f<0xB1, 0xf, 0xf>(0.f, v); v += dpp_f<0x4E, 0xf, 0xf>(0.f, v); v += dpp_f<0x141, 0xf, 0xf>(0.f, v); v += dpp_f<0x140, 0xf, 0xf>(0.f, v);
                    if (c16 == 0) part[(16 * rb + 4 * g4 + r) * NT + cb] = v; } }
        } else if (MODE == 0) { if (c16 == 0) {
#pragma unroll
                for (int r = 0; r < 4; ++r) part[(16 * rb + 4 * g4 + r) * NT + cb] = 0.f; } }
        pv[i] = a; }
    __syncthreads();
#pragma unroll
    for (int i = 0; i < TPW; ++i) { const int ti = w * TPW + i, rb = ti / NT, cb = ti % NT;
#pragma unroll
        for (int r = 0; r < 4; ++r) *(LAS bf16*)(P + (16 * rb + 4 * g4 + r) * RSP + (16 * cb + c16) * 2) = (bf16)f2bf(pv[i][r]); }
    for (int idx = tid; idx < L * 16; idx += NTHR) { const int s = idx >> 4, c8 = idx & 15; const float sc = qs[s];
        const v4u x = *(const LAS v4u*)(Q + s * RSQ + c8 * 16); float f[8];
        f[0] = __uint_as_float(x.x << 16) * sc; f[1] = __uint_as_float(x.x & 0xffff0000u) * sc; f[2] = __uint_as_float(x.y << 16) * sc; f[3] = __uint_as_float(x.y & 0xffff0000u) * sc;
        f[4] = __uint_as_float(x.z << 16) * sc; f[5] = __uint_as_float(x.z & 0xffff0000u) * sc; f[6] = __uint_as_float(x.w << 16) * sc; f[7] = __uint_as_float(x.w & 0xffff0000u) * sc;
        v4u o; o.x = pk2(f[0], f[1]); o.y = pk2(f[2], f[3]); o.z = pk2(f[4], f[5]); o.w = pk2(f[6], f[7]);
        *(LAS v4u*)(Q + s * RSQ + c8 * 16) = o;
        if (MODE == 0) { float dsum = 0.f;
#pragma unroll
            for (int j = 0; j < 8; ++j) dsum += f[j] * npv[8 * c8 + j];
            dpart[s * 16 + c8] = dsum; } }
    __syncthreads();
    if (MODE == 0 && tid < L) { float a = 0.f;
#pragma unroll
        for (int j = 0; j < NT; ++j) a += part[tid * NT + j];
#pragma unroll
        for (int j = 0; j < 16; ++j) a += dpart[tid * 16 + j];
        rowsum[tid] = a; }
    f32x4 acc[NT][NCB];
#pragma unroll
    for (int rb = 0; rb < NT; ++rb)
#pragma unroll
        for (int i = 0; i < NCB; ++i) acc[rb][i] = (f32x4){0.f, 0.f, 0.f, 0.f};
#pragma unroll
    for (int kk = 0; kk < 4; ++kk) { bf16x8 bfr[NCB];
#pragma unroll
        for (int i = 0; i < NCB; ++i) bfr[i] = *(const GAS bf16x8*)(stT + (size_t)(16 * (w * NCB + i) + c16) * 128 + 32 * kk + 8 * g4);
#pragma unroll
        for (int rb = 0; rb < NT; ++rb) { const bf16x8 a = frag_row<RSQ>(Q, 16 * rb, 32 * kk, lane);
#pragma unroll
            for (int i = 0; i < NCB; ++i) acc[rb][i] = MFMA16(a, bfr[i], acc[rb][i]); } }
#pragma unroll
    for (int kk = 0; kk < L / 32; ++kk) { bf16x8 bfr[NCB];
#pragma unroll
        for (int i = 0; i < NCB; ++i) bfr[i] = frag_tr<RSV>(V, 32 * kk, 16 * (w * NCB + i), lane);
#pragma unroll
        for (int rb = 0; rb < NT; ++rb) { const bf16x8 a = frag_row<RSP>(P, 16 * rb, 32 * kk, lane);
#pragma unroll
            for (int i = 0; i < NCB; ++i) acc[rb][i] = MFMA16(a, bfr[i], acc[rb][i]); } }
    __syncthreads();
#pragma unroll
    for (int rb = 0; rb < NT; ++rb)
#pragma unroll
        for (int i = 0; i < NCB; ++i)
#pragma unroll
            for (int r = 0; r < 4; ++r) { const int t = 16 * rb + 4 * g4 + r, e = 16 * (w * NCB + i) + c16; float hv = acc[rb][i][r];
                if (MODE == 0) hv = hv / fmaxf(fabsf(rowsum[t]), flo[t]);
                H[t * DV + e] = hv; }
    __syncthreads();
    for (int t = w; t < L; t += NWAVES) { float hv[DV / 64]; float s1 = 0.f;
#pragma unroll
        for (int i = 0; i < DV / 64; ++i) { hv[i] = H[t * DV + lane + 64 * i]; s1 += hv[i]; }
        float mu = 0.f; if (MODE == 1) { mu = wave_sum(s1) * (1.f / DV); }
        float s2 = 0.f;
#pragma unroll
        for (int i = 0; i < DV / 64; ++i) { hv[i] -= mu; s2 += hv[i] * hv[i]; }
        const float rstd = 1.0f / sqrtf(wave_sum(s2) * (1.f / DV) + NORM_EPS);
#pragma unroll
        for (int i = 0; i < DV / 64; ++i) { const int e = lane + 64 * i; const float gt = bf2f(gate[(size_t)t * ldg + e]);
            const float act = (MODE == 0) ? sigmoid_f(gt) : gt * sigmoid_f(gt);
            y[(size_t)t * ldy + e] = (bf16)f2bf(hv[i] * rstd * gain[e] * act); } }
    __syncthreads();
}
namespace att {
constexpr int D = 128, LDQKV = NPROJ, LDO = 1024;
constexpr float THR = 8.f; constexpr bool WSKIP = false;
constexpr float SCALE = 0.08838834764831845f;
constexpr int NW = 8, QBLK = 32, KVBLK = 64, QB = NW * QBLK;
constexpr int SHM_V = KVBLK * D * 2, SHM_K = KVBLK * D * 2;
constexpr int LDS_BYTES = 2 * SHM_V + 2 * SHM_K + NW * 64 * 4;

using bf16 = unsigned short;
typedef short bf16x8 __attribute__((ext_vector_type(8)));
typedef short s16x4 __attribute__((ext_vector_type(4)));
typedef float f32x16 __attribute__((ext_vector_type(16)));
typedef float f32x4 __attribute__((ext_vector_type(4)));
typedef unsigned u32x4 __attribute__((ext_vector_type(4)));
template <class A, class Bt> struct same_t { static constexpr bool v = false; };
template <class A> struct same_t<A, A> { static constexpr bool v = true; };

#define KSWZ(row, colB) ((row) * 256 + ((colB) ^ (((row) & 7) << 4)))
#define SBAR() __builtin_amdgcn_sched_barrier(0)
__device__ __forceinline__ int v_st(int k, int c) { const int kk = (k & ~0xC) | ((k & 4) << 1) | ((k & 8) >> 1); return ((kk >> 3) * 4 + (c >> 5)) * 512 + ((kk & 7) * 32 + (c & 31)) * 2; }
__device__ __forceinline__ int v_rd_base(int lane) { return ((lane & 3) << 3) | (((lane >> 2) & 3) << 6) | (((lane >> 4) & 1) << 5) | (((lane >> 5) & 1) << 8); }
constexpr int v_rd_off(int d0, int ks, int half) { return d0 * 512 + ks * 4096 + half * 2048; }
__device__ __forceinline__ int crow(int r, int hi) { return (r & 3) + 8 * (r >> 2) + 4 * hi; }
__device__ __forceinline__ unsigned cvtpk(float lo, float hi) {
    unsigned r; asm volatile("v_cvt_pk_bf16_f32 %0, %1, %2" : "=v"(r) : "v"(lo), "v"(hi)); return r;
}
__device__ __forceinline__ bf16x8 pack8(f32x4 a, f32x4 b) {
    u32x4 w = {cvtpk(a[0], a[1]), cvtpk(a[2], a[3]), cvtpk(b[0], b[1]), cvtpk(b[2], b[3])};
    return *reinterpret_cast<bf16x8*>(&w);
}
template <class T> __device__ __forceinline__ bf16x8 load8(const T* p) {
    if constexpr (same_t<T, float>::v) { return pack8(*(const f32x4*)p, *(const f32x4*)(p + 4)); }
    else { return *reinterpret_cast<const bf16x8*>(p); }
}
__device__ __forceinline__ unsigned long long mask_word(const char* tile_base, int row) { unsigned off = (unsigned)row; asm volatile("" : "+v"(off)); off *= 1024u; return *(const unsigned long long*)(tile_base + off); }
__device__ __forceinline__ void mask_bits(f32x16& p0, f32x16& p1, unsigned long long mw, int hi) {
    const unsigned long long ws = mw >> hi; const unsigned lo = (unsigned)ws, up = (unsigned)(ws >> 32);
#pragma unroll
    for (int r = 0; r < 16; ++r) {
        const int c = 16 * (r & 1) + 2 * (r >> 2); const unsigned x = (r & 2) ? up : lo;
        const unsigned ma = (unsigned)(((int)(x << (31 - c))) >> 31), mb = (unsigned)(((int)(x << (31 - c - 8))) >> 31);
        p0[r] = __uint_as_float((__float_as_uint(p0[r]) & ma) | (0xff800000u & ~ma));
        p1[r] = __uint_as_float((__float_as_uint(p1[r]) & mb) | (0xff800000u & ~mb));
    }
}
__device__ __forceinline__ void partialSM(f32x16& p0, f32x16& p1, float& m_reg, float& mn, float& alpha) {
    float pmax = p0[0]; for (int r = 1; r < 16; ++r) pmax = fmaxf(pmax, p0[r]); for (int r = 0; r < 16; ++r) pmax = fmaxf(pmax, p1[r]);
    { auto rr = __builtin_amdgcn_permlane32_swap(__float_as_uint(pmax), __float_as_uint(pmax), false, false);
      pmax = fmaxf(__uint_as_float(rr[0]), __uint_as_float(rr[1])); }
    constexpr float C2 = 1.4426950408889634f * SCALE;
    if (__builtin_expect(__all((pmax - m_reg) * SCALE <= THR), 1)) { mn = m_reg; alpha = 1.f; }
    else { mn = fmaxf(m_reg, pmax); alpha = __builtin_amdgcn_exp2f((m_reg - mn) * C2); m_reg = mn; }
    const float mnL = -mn * C2;
    for (int r = 0; r < 16; ++r) p0[r] = fmaf(p0[r], C2, mnL); for (int r = 0; r < 16; ++r) p1[r] = fmaf(p1[r], C2, mnL);
    for (int r = 0; r < 16; ++r) p0[r] = __builtin_amdgcn_exp2f(p0[r]);
}
__device__ __forceinline__ void finishSM(f32x16& p0, f32x16& p1, float alpha, float& l_reg, bf16x8& pa0, bf16x8& pa1, bf16x8& pa2, bf16x8& pa3) {
    for (int r = 0; r < 16; ++r) p1[r] = __builtin_amdgcn_exp2f(p1[r]);
    float ps = 0; for (int r = 0; r < 16; ++r) ps += p0[r]; for (int r = 0; r < 16; ++r) ps += p1[r];
    { auto rr = __builtin_amdgcn_permlane32_swap(__float_as_uint(ps), __float_as_uint(ps), false, false);
      ps = __uint_as_float(rr[0]) + __uint_as_float(rr[1]); }
    l_reg = l_reg * alpha + ps;
#define PK4(P, B_, OUT) do { unsigned a0 = cvtpk(P[B_+0], P[B_+1]), a1 = cvtpk(P[B_+2], P[B_+3]);                          \
        unsigned b0 = cvtpk(P[B_+4], P[B_+5]), b1 = cvtpk(P[B_+6], P[B_+7]);                                             \
        auto r0 = __builtin_amdgcn_permlane32_swap(a0, b0, false, false); auto r1 = __builtin_amdgcn_permlane32_swap(a1, b1, false, false); \
        u32x4 w = {r0[0], r1[0], r0[1], r1[1]}; OUT = *reinterpret_cast<bf16x8*>(&w); } while (0)
    PK4(p0, 0, pa0); PK4(p0, 8, pa1); PK4(p1, 0, pa2); PK4(p1, 8, pa3);
#undef PK4
}
template <int KB, bool SK>
__device__ __forceinline__ void qkt(f32x16& p0, f32x16& p1, const char* K_lds, int r32, int hi, const bf16x8* qr, bool act) {
    if (SK && !act) { const float NEG = -__builtin_inff();
#pragma unroll
        for (int r = 0; r < 16; ++r) { p0[r] = NEG; p1[r] = NEG; } return; }
    p0 = f32x16{}; p1 = f32x16{};
    const char* kb[4];
#pragma unroll
    for (int dd = 0; dd < 4; ++dd) kb[dd] = K_lds + KB * SHM_K + KSWZ(r32, (dd * 16 + hi * 8) * 2);
#pragma unroll
    for (int d0 = 0; d0 < 8; ++d0) { const char* a = kb[d0 & 3] + (d0 >> 2) * 128;
        bf16x8 b0 = *reinterpret_cast<const bf16x8*>(a);
        bf16x8 b1 = *reinterpret_cast<const bf16x8*>(a + 32 * 256);
        p0 = __builtin_amdgcn_mfma_f32_32x32x16_bf16(b0, qr[d0], p0, 0, 0, 0);
        p1 = __builtin_amdgcn_mfma_f32_32x32x16_bf16(b1, qr[d0], p1, 0, 0, 0); }
}
template <int VB, bool SK>
__device__ __forceinline__ void pv_tile(f32x16* o, int vb0, bf16x8 pa0, bf16x8 pa1, bf16x8 pa2, bf16x8 pa3, bool act) {
    if (SK && !act) return;
#define TRRD(dst, off) asm volatile("ds_read_b64_tr_b16 %0, %1 offset:%2" : "=&v"(dst) : "v"(vb0), "i"(off) : "memory")
#define PV_D0(d0) do { s16x4 l0, l1, l2, l3, h0, h1, h2, h3; constexpr int b_ = VB * SHM_V + v_rd_off(d0, 0, 0);     \
        TRRD(l0, b_); TRRD(h0, b_ + 2048); TRRD(l1, b_ + 4096); TRRD(h1, b_ + 6144); TRRD(l2, b_ + 8192); TRRD(h2, b_ + 10240); TRRD(l3, b_ + 12288); TRRD(h3, b_ + 14336); \
        asm volatile("s_waitcnt lgkmcnt(0)" ::: "memory"); SBAR();                 \
        o[d0] = __builtin_amdgcn_mfma_f32_32x32x16_bf16(pa0, (bf16x8){l0[0], l0[1], l0[2], l0[3], h0[0], h0[1], h0[2], h0[3]}, o[d0], 0, 0, 0);   \
        o[d0] = __builtin_amdgcn_mfma_f32_32x32x16_bf16(pa1, (bf16x8){l1[0], l1[1], l1[2], l1[3], h1[0], h1[1], h1[2], h1[3]}, o[d0], 0, 0, 0);   \
        o[d0] = __builtin_amdgcn_mfma_f32_32x32x16_bf16(pa2, (bf16x8){l2[0], l2[1], l2[2], l2[3], h2[0], h2[1], h2[2], h2[3]}, o[d0], 0, 0, 0);   \
        o[d0] = __builtin_amdgcn_mfma_f32_32x32x16_bf16(pa3, (bf16x8){l3[0], l3[1], l3[2], l3[3], h3[0], h3[1], h3[2], h3[3]}, o[d0], 0, 0, 0); } while (0)
    PV_D0(0); PV_D0(1); PV_D0(2); PV_D0(3);
#undef PV_D0
#undef TRRD
}

template <class TIn, class TOut> struct BlockRef { const TIn* Q; const TIn* K; const TIn* V; TOut* O; const unsigned long long* M; int P0; };
template <class TIn> struct Seam {
    bf16x8 qr[8];
    bf16x8 st_v0, st_v1, st_k0, st_k1; f32x4 sf0, sf1, sf2, sf3;
    f32x4 tq[16];
};
__device__ __forceinline__ int swa_jlo(int P0, int W) { const int lowk = P0 - W + 1; return lowk > 0 ? lowk / KVBLK : 0; }
#define ROW(p, k0, rr) ((p) + (size_t)((k0) + (rr)) * LDQKV + sc)
#define VMW() asm volatile("s_waitcnt vmcnt(0)" ::: "memory")
#define VMWN(n) asm volatile("s_waitcnt vmcnt(%0)" :: "i"(n) : "memory")
#define LD16U(base, off) (*reinterpret_cast<const bf16x8*>((const char*)(base) + (off)))
#define SLOAD_H(Kp, Vp, k0) do { const char* kb_ = (const char*)((Kp) + (size_t)(k0) * LDQKV); const char* vb_ = (const char*)((Vp) + (size_t)(k0) * LDQKV);                 \
                         S.st_v0 = LD16U(vb_, soff); S.st_v1 = LD16U(vb_ + (size_t)32 * LDQKV * 2, soff);                                  \
                         S.st_k0 = LD16U(kb_, soff); S.st_k1 = LD16U(kb_ + (size_t)32 * LDQKV * 2, soff); } while (0)
#define SWRITE_HK(bf) do { *(bf16x8*)(K_lds + (bf) * SHM_K + kws) = S.st_k0; *(bf16x8*)(K_lds + (bf) * SHM_K + kws + 32 * 256) = S.st_k1; } while (0)
#define SWRITE_HV(bf) do { *(bf16x8*)(V_lds + (bf) * SHM_V + vst0) = S.st_v0; *(bf16x8*)(V_lds + (bf) * SHM_V + vst1) = S.st_v1; } while (0)
#define SWRITE_H(bf) do { SWRITE_HV(bf); SWRITE_HK(bf); } while (0)
#define SLOAD_F(p, k0) do { S.sf0 = *(const f32x4*)ROW(p, k0, sr); S.sf1 = *(const f32x4*)(ROW(p, k0, sr) + 4);                \
                            S.sf2 = *(const f32x4*)ROW(p, k0, 32 + sr); S.sf3 = *(const f32x4*)(ROW(p, k0, 32 + sr) + 4); } while (0)
#define SWRITE_KF(bf) do { *(bf16x8*)(K_lds + (bf) * SHM_K + kws) = pack8(S.sf0, S.sf1); *(bf16x8*)(K_lds + (bf) * SHM_K + kws + 32 * 256) = pack8(S.sf2, S.sf3); } while (0)
#define SWRITE_VF(bf) do { *(bf16x8*)(V_lds + (bf) * SHM_V + vst0) = pack8(S.sf0, S.sf1); *(bf16x8*)(V_lds + (bf) * SHM_V + vst1) = pack8(S.sf2, S.sf3); } while (0)
template <class TIn, class TOut>
__device__ __forceinline__ void causal_swa_prime(const BlockRef<TIn, TOut>& cur, int W, char* lds, Seam<TIn>& S) {
    constexpr bool F32 = same_t<TIn, float>::v;
    int tid_o = my_tid(); asm volatile("" : "+v"(tid_o));
    const int tid = tid_o, wid = __builtin_amdgcn_readfirstlane(tid >> 6), lane = tid & 63, r32 = lane & 31, hi = lane >> 5;
    const int sr = tid >> 4, sc = (tid & 15) * 8, kws = KSWZ(sr, sc * 2); char* K_lds = lds + 2 * SHM_V; const unsigned soff = (unsigned)(sr * LDQKV + sc) * 2u;
    const int kb0 = swa_jlo(cur.P0, W) * KVBLK;
    for (int d0 = 0; d0 < 8; ++d0) S.qr[d0] = load8<TIn>(cur.Q + (size_t)(wid * QBLK + r32) * LDQKV + d0 * 16 + hi * 8);
    if constexpr (F32) { SLOAD_F((const float*)cur.K, kb0); VMW(); SWRITE_KF(0); SBAR(); SLOAD_F((const float*)cur.V, kb0); }
    else { SLOAD_H(cur.K, cur.V, kb0); VMW(); SWRITE_HK(0); }
    __syncthreads();
}
template <class TIn, class TOut>
__device__ __forceinline__ void causal_swa_block(const BlockRef<TIn, TOut>& cur, const BlockRef<TIn, TOut>& nxt, int skv, int W, char* lds, Seam<TIn>& S) {
    constexpr bool F32 = same_t<TIn, float>::v;
    int tid_o = my_tid(); asm volatile("" : "+v"(tid_o));
    const int tid = tid_o, wid = __builtin_amdgcn_readfirstlane(tid >> 6), lane = tid & 63, r32 = lane & 31, hi = lane >> 5;
    const int j_lo = swa_jlo(cur.P0, W);
    int j_hi = (cur.P0 + QB - 1) / KVBLK + 1; if (j_hi > skv / KVBLK) j_hi = skv / KVBLK;
    const int NT = j_hi - j_lo;
    const int kbn = swa_jlo(nxt.P0, W) * KVBLK;
    const int qlo = cur.P0 + wid * QBLK, qm = qlo + r32 - 4 * hi;
    char* V_lds = lds; char* K_lds = lds + 2 * SHM_V;
    float* ws = (float*)(lds + 2 * SHM_V + 2 * SHM_K) + wid * 64; float* li_l = ws, * al_l = ws + 32;
    float m_reg = -1e30f, l_reg = 0; f32x16 o[4] = {};
    const unsigned soff = (unsigned)((tid >> 4) * LDQKV + (tid & 15) * 8) * 2u;
    const int sr = tid >> 4, sc = (tid & 15) * 8, vst0 = v_st(sr, sc), vst1 = vst0 + 8192  , kws = KSWZ(sr, sc * 2);
    const int vb0 = (int)(uintptr_t)V_lds + v_rd_base(lane);
    const TIn* Kh = cur.K; const TIn* Vh = cur.V;
#define RESC(a) do { if (__any((a) < 1.f)) { if (hi == 0) al_l[r32] = (a); asm volatile("s_waitcnt lgkmcnt(0)" ::: "memory");              \
                     for (int d_ = 0; d_ < 4; ++d_) for (int r = 0; r < 16; ++r) o[d_][r] *= al_l[crow(r, hi)]; } } while (0)
#define KBASE(t) ((j_lo + (t)) * KVBLK)
#define ACT(t) (KBASE(t) <= qlo + QBLK - 1 && KBASE(t) + KVBLK - 1 >= qlo - W + 1)
#define MASKT(P0_, P1_, mw_) mask_bits(P0_, P1_, mw_, hi)
#define MLOAD(t) mask_word((const char*)cur.M + (size_t)((j_lo + (t)) * 8), wid * QBLK + r32)
    constexpr int NQL = F32 ? 16 : 8;
    constexpr bool SK = WSKIP && !F32;
#define SEAM_K0() do { VMWN(NQL); if constexpr (F32) { SWRITE_KF(0); SBAR(); SLOAD_F((const float*)nxt.V, kbn); } else { SWRITE_HK(0); } SBAR(); } while (0)
    f32x16 pA0, pA1, pB0, pB1; float mnA, mnB, alA, alB; bf16x8 pa0, pa1, pa2, pa3;
    if constexpr (F32) { VMW(); SWRITE_VF(0); SBAR(); } else { SWRITE_HV(0); SBAR(); }
    if (NT > 1) { if constexpr (F32) SLOAD_F((const float*)Kh, KBASE(1)); else SLOAD_H(Kh, Vh, KBASE(1)); }
    SBAR(); qkt<0, SK>(pA0, pA1, K_lds, r32, hi, S.qr, ACT(0));
    if constexpr (F32) { if (NT > 1) { VMW(); SWRITE_KF(1); SBAR(); SLOAD_F((const float*)Vh, KBASE(1)); } }
    unsigned long long mwn = MLOAD(NT > 1 ? 1 : 0);
    MASKT(pA0, pA1, MLOAD(0)); partialSM(pA0, pA1, m_reg, mnA, alA);
    if (NT > 1) { VMW(); if constexpr (F32) { SWRITE_VF(1); SBAR(); if (NT > 2) SLOAD_F((const float*)Kh, KBASE(2)); } else SWRITE_H(1); }
    __syncthreads();
#define HALF_STEP(PX0, PX1, mnX, alX, PY0, PY1, alY, t, KB, VB, SB) do {                                                      \
        SBAR(); qkt<KB, SK>(PX0, PX1, K_lds, r32, hi, S.qr, ACT(t));                                             \
        finishSM(PY0, PY1, alY, l_reg, pa0, pa1, pa2, pa3); SBAR();                                                           \
        if ((t) + 1 < NT) { if constexpr (F32) { VMW(); SWRITE_KF(SB); SBAR(); SLOAD_F((const float*)Vh, KBASE((t) + 1)); }  \
                            else { SLOAD_H(Kh, Vh, KBASE((t) + 1)); } SBAR(); }                                               \
        pv_tile<VB, SK>(o, vb0, pa0, pa1, pa2, pa3, ACT((t) - 1)); { const unsigned long long mwc_ = mwn; mwn = MLOAD((t) + 1 < NT ? (t) + 1 : (t)); MASKT(PX0, PX1, mwc_); } partialSM(PX0, PX1, m_reg, mnX, alX);                                        \
        __syncthreads();                                                                                                      \
        if ((t) + 1 < NT) { VMW(); if constexpr (F32) { SWRITE_VF(SB); SBAR(); if ((t) + 2 < NT) SLOAD_F((const float*)Kh, KBASE((t) + 2)); } \
                            else { SWRITE_H(SB); } }                                                                          \
        RESC(alX); __syncthreads(); } while (0)
    for (int t = 1; t + 1 < NT; t += 2) {
        HALF_STEP(pB0, pB1, mnB, alB, pA0, pA1, alA, t, 1, 0, 0);
        HALF_STEP(pA0, pA1, mnA, alA, pB0, pB1, alB, t + 1, 0, 1, 1);
    }
    const bool even = (NT & 1) == 0;
    if (even) { SBAR(); qkt<1, SK>(pB0, pB1, K_lds, r32, hi, S.qr, ACT(NT - 1)); SBAR(); }
#define QROW(e) (nxt.Q + (size_t)(wid * QBLK + r32) * LDQKV + ((e) >> 1) * 16 + hi * 8 + ((e) & 1) * 4)
    if constexpr (F32) { SLOAD_F((const float*)nxt.K, kbn); SBAR();
#pragma unroll
        for (int e = 0; e < 8; ++e) S.tq[e] = *(const f32x4*)QROW(e); }
    else { SLOAD_H(nxt.K, nxt.V, kbn); SBAR();
#pragma unroll
        for (int d0 = 0; d0 < 8; ++d0) S.qr[d0] = load8<TIn>(nxt.Q + (size_t)(wid * QBLK + r32) * LDQKV + d0 * 16 + hi * 8); }
    SBAR();
    finishSM(pA0, pA1, alA, l_reg, pa0, pa1, pa2, pa3); SBAR();
    if constexpr (F32) {
#pragma unroll
        for (int e = 8; e < 16; ++e) S.tq[e] = *(const f32x4*)QROW(e); SBAR(); }
#undef QROW
    pv_tile<0, SK>(o, vb0, pa0, pa1, pa2, pa3, ACT(even ? NT - 2 : NT - 1));
    if (even) { MASKT(pB0, pB1, mwn); partialSM(pB0, pB1, m_reg, mnB, alB); __syncthreads(); RESC(alB);
        finishSM(pB0, pB1, alB, l_reg, pa0, pa1, pa2, pa3); SBAR(); pv_tile<1, SK>(o, vb0, pa0, pa1, pa2, pa3, ACT(NT - 1)); }
    SBAR(); SEAM_K0();
    if (hi == 0) li_l[r32] = l_reg; asm volatile("s_waitcnt lgkmcnt(0)" ::: "memory");
    float rli[16];
#pragma unroll
    for (int r = 0; r < 16; ++r) rli[r] = __builtin_amdgcn_rcpf(li_l[crow(r, hi)]);
    TOut* Ow = cur.O + (size_t)(wid * QBLK) * LDO;
#pragma unroll
    for (int r = 0; r < 16; ++r) { const int orow = crow(r, hi);
#pragma unroll
        for (int d0 = 0; d0 < 4; ++d0) { const float v = o[d0][r] * rli[r];
            if constexpr (same_t<TOut, float>::v) { Ow[(size_t)orow * LDO + d0 * 32 + r32] = v; }
            else { const float vn = __builtin_bit_cast(float, __builtin_amdgcn_update_dpp(0, __builtin_bit_cast(int, v), 0xB1, 0xf, 0xf, false));
                   if ((r32 & 1) == 0) *(unsigned*)(Ow + (size_t)orow * LDO + d0 * 32 + r32) = cvtpk(v, vn); } } }
    if constexpr (F32) {
#pragma unroll
        for (int d0 = 0; d0 < 8; ++d0) S.qr[d0] = pack8(S.tq[2 * d0], S.tq[2 * d0 + 1]); }
    __syncthreads();
#undef RESC
#undef KBASE
#undef ACT
#undef MASKT
#undef MLOAD
#undef SEAM_K0
#undef HALF_STEP
}
#undef ROW
#undef VMW
#undef VMWN
#undef SLOAD_H
#undef LD16U
#undef SWRITE_HK
#undef SWRITE_HV
#undef SWRITE_H
#undef SLOAD_F
#undef SWRITE_KF
#undef SWRITE_VF

}


template <int NC> __device__ __forceinline__ void scan_elems(const bf16* __restrict__ delta, bf16* __restrict__ prev, size_t cstride, const LAS float* dec, const LAS float* inj) {
    f32x4 st = (f32x4){0.f, 0.f, 0.f, 0.f};
#pragma unroll 8
    for (int c = 0; c < NC; ++c) { const v2u x = *(const GAS v2u*)(delta + (size_t)c * cstride);
        v2u o; o.x = pk2(st[0], st[1]); o.y = pk2(st[2], st[3]); *(GAS v2u*)(prev + (size_t)c * cstride) = o;
        const float d = dec[c], j = inj[c];
        st[0] = d * st[0] + j * __uint_as_float(x.x << 16); st[1] = d * st[1] + j * __uint_as_float(x.x & 0xffff0000u);
        st[2] = d * st[2] + j * __uint_as_float(x.y << 16); st[3] = d * st[3] + j * __uint_as_float(x.y & 0xffff0000u); }
}

struct Args {
    const float* x; const float* norm_mix; const float* norm_ffn; const float* w_in; const float* att_q_norm; const float* att_k_norm; const float* mlstm_conv; const float* mlstm_gate_bias;
    const float* mlstm_out_norm; const float* ret_out_norm; const float* w_b_att; const float* w_b_mlstm; const float* w_b_ret; const float* w_out; const float* w_ffn_in; const float* w_ffn_out;
    float* out; unsigned char* ws; int layer_lo, layer_hi, ph_lo, ph_hi;
};
constexpr int PH_PER_LAYER = 16;
__device__ __forceinline__ float ret_lngamma(int hd) { return log1pf(-exp2f(-5.0f - (float)hd)); }
#define PHASE_FN static __device__ __forceinline__ void
#define OPAQUE_PTR(p) asm volatile("" : "+s"(p))
#define WS_PTRS(ws) OPAQUE_PTR(ws); \
    bf16* const H = (bf16*)((ws) + WS_H); bf16* const PROJ = (bf16*)((ws) + WS_PROJ); float* const SMALL = (float*)((ws) + WS_SMALL); bf16* const MQK = (bf16*)((ws) + WS_MQK); \
    bf16* const IKB = (bf16*)((ws) + WS_IKB); unsigned char* const IWF = (unsigned char*)((ws) + WS_IWF); float* const GIF = (float*)((ws) + WS_GIF); float* const SC = (float*)((ws) + WS_SC); \
    unsigned long long* const MB = (unsigned long long*)((ws) + WS_MB); bf16* const DCM = (bf16*)((ws) + WS_DCM); bf16* const CPM = (bf16*)((ws) + WS_CPM); \
    float* const DN = (float*)((ws) + WS_MISC + MISC_DN); float* const NPREV = (float*)((ws) + WS_MISC + MISC_NPREV); float* const AB = (float*)((ws) + WS_MISC + MISC_AB); float* const MPREV = (float*)((ws) + WS_MISC + MISC_MPREV); \
    bf16* const DRR = (bf16*)((ws) + WS_DRR); bf16* const RPR = (bf16*)((ws) + WS_RPR); bf16* const YA = (bf16*)((ws) + WS_YA); bf16* const YM = (bf16*)((ws) + WS_YM); bf16* const YR = (bf16*)((ws) + WS_YR); \
    float* const MERGEDF = (float*)((ws) + WS_MERGEDF); bf16* const MERGED = (bf16*)((ws) + WS_MERGED); bf16* const ACT = (bf16*)((ws) + WS_ACT); \
    float* const ROPE128 = (float*)((ws) + WS_ROPE128); float* const ROPE64 = (float*)((ws) + WS_ROPE64); \
    (void)H; (void)PROJ; (void)SMALL; (void)MQK; (void)IKB; (void)IWF; (void)GIF; (void)SC; (void)MB; (void)DCM; (void)CPM; (void)DN; (void)NPREV; (void)AB; (void)MPREV; (void)DRR; (void)RPR; (void)YA; (void)YM; (void)YR; \
    (void)MERGEDF; (void)MERGED; (void)ACT; (void)ROPE128; (void)ROPE64
#define TIDS() int tid_ = my_tid(); asm volatile("" : "+v"(tid_)); int bx_ = blockIdx.x; asm volatile("" : "+s"(bx_));   \
    const int tid = tid_, lane = tid & 63, wave = __builtin_amdgcn_readfirstlane(tid >> 6); const int G = gridDim.x, bx = bx_; const int gw = bx * NWAVES + wave, NGW = G * NWAVES; \
    (void)lane; (void)wave; (void)gw; (void)NGW; (void)G; (void)bx

constexpr int CV_IN = 32 * 268, CV_B = 16 * 32, CV_OUT = 32 * 32, CV_FIN = 32 * 176, CV_FOUT = 88 * 32, CV_ITEMS = CV_IN + 3 * CV_B + CV_OUT + CV_FIN + CV_FOUT;
__device__ __forceinline__ void convert_layer_items(LAS float* scr, unsigned char* ws, int l, const float* w_in, const float* w_b_att, const float* w_b_mlstm, const float* w_b_ret, const float* w_out, const float* w_ffn_in,
                                                    const float* w_ffn_out, int it0, int it1, int wv, int nwv, int lane) {
    unsigned char* wl = ws + WS_W + (size_t)l * W_LAYER;
    for (int it = it0 + wv; it < it1; it += nwv) { int r = it;
        if (r < CV_IN) { transpose_item(w_in + (size_t)l * DM * LPROJ, DM, LPROJ, (bf16*)(wl + WO_IN), scr, r, NPROJ_PAD / 64, lane, MapWin()); continue; } r -= CV_IN;
        if (r < CV_B) { transpose_item(w_b_att + (size_t)l * 1024 * DM, 1024, DM, (bf16*)(wl + WO_B), scr, r, DM / 64, lane, MapIdent()); continue; } r -= CV_B;
        if (r < CV_B) { transpose_item(w_b_mlstm + (size_t)l * 1024 * DM, 1024, DM, (bf16*)(wl + WO_B + 4 * MiB), scr, r, DM / 64, lane, MapIdent()); continue; } r -= CV_B;
        if (r < CV_B) { transpose_item(w_b_ret + (size_t)l * 1024 * DM, 1024, DM, (bf16*)(wl + WO_B + 8 * MiB), scr, r, DM / 64, lane, MapIdent()); continue; } r -= CV_B;
        if (r < CV_OUT) { transpose_item(w_out + (size_t)l * DM * DM, DM, DM, (bf16*)(wl + WO_OUT), scr, r, DM / 64, lane, MapIdent()); continue; } r -= CV_OUT;
        if (r < CV_FIN) { transpose_item(w_ffn_in + (size_t)l * DM * 2 * FF, DM, 2 * FF, (bf16*)(wl + WO_FIN), scr, r, 2 * FF / 64, lane, MapFfn()); continue; } r -= CV_FIN;
        transpose_item(w_ffn_out + (size_t)l * FF * DM, FF, DM, (bf16*)(wl + WO_FOUT), scr, r, DM / 64, lane, MapIdent()); }
}
PHASE_FN ph_prologue(LAS unsigned char* lds, unsigned char* ws, const float* w_in, const float* w_b_att, const float* w_b_mlstm, const float* w_b_ret, const float* w_out, const float* w_ffn_in, const float* w_ffn_out, bool all_layers) {
    TIDS(); WS_PTRS(ws);
    LAS float* scr = (LAS float*)(lds + wave * 16640);
    for (int l = 0; l < (all_layers ? DEPTH : 1); ++l) convert_layer_items(scr, ws, l, w_in, w_b_att, w_b_mlstm, w_b_ret, w_out, w_ffn_in, w_ffn_out, 0, CV_ITEMS, gw, NGW, lane);
    for (int i = gw * 64 + lane; i < S * 96; i += NGW * 64) {
        if (i < S * 64) { const int t = i >> 6, f = i & 63; const float inv = (float)pow(10000.0, -(double)f * 2.0 / 128.0); const float ang = (float)t * inv;
            ROPE128[2 * i] = (float)cos((double)ang); ROPE128[2 * i + 1] = (float)sin((double)ang); }
        else { const int k = i - S * 64, t = k >> 5, f = k & 31; const float inv = (float)pow(10000.0, -(double)f * 2.0 / 64.0); const float ang = (float)t * inv;
            ROPE64[2 * k] = (float)cos((double)ang); ROPE64[2 * k + 1] = (float)sin((double)ang); } }
}
PHASE_FN ph_convert_tail(LAS unsigned char* lds, unsigned char* ws, int l, const float* w_in, const float* w_b_att, const float* w_b_mlstm, const float* w_b_ret, const float* w_out, const float* w_ffn_in, const float* w_ffn_out,
                         int rem, int it0, int it1) {
    TIDS(); if (rem <= 0 || rem >= G || bx < rem) return;
    LAS float* scr = (LAS float*)(lds + wave * 16640);
    convert_layer_items(scr, ws, l, w_in, w_b_att, w_b_mlstm, w_b_ret, w_out, w_ffn_in, w_ffn_out, it0, it1, (bx - rem) * NWAVES + wave, (G - rem) * NWAVES, lane);
    __syncthreads(); }
PHASE_FN ph_rmsnorm(const float* xin, const float* gain, bf16* Hout) { TIDS(); for (int m = gw; m < S; m += NGW) rms_row_to_bf16(xin + (size_t)m * DM, gain, Hout + (size_t)m * DM, lane); }
PHASE_FN ph_gemm_proj(LAS unsigned char* lds, unsigned char* ws, const bf16* Wt) { TIDS(); WS_PTRS(ws);
    pg8::Gemm g{H, Wt, S, NPROJ_PAD, DM}; pg8::StaticOrder so; so.init(S, NPROJ_PAD, G, bx); pg8::EpiProj E{PROJ, NPROJ, SMALL, PC_G / 256, NPROJ / 256};
    pg8::gemm_phase<pg8::EpiProj, pg8::StaticOrder, true, true>(lds, g, so, E); }
PHASE_FN ph_pp(unsigned char* ws, const float* gq, const float* gk, const float* convw, const float* gbias) { TIDS(); WS_PTRS(ws);
    PPArgs a{PROJ, SMALL, MQK, IKB, IWF, GIF, ROPE128, ROPE64, gq, gk, convw, gbias};
    f32x4 cw[16];
#pragma unroll
    for (int j = 0; j < 4; ++j)
#pragma unroll
        for (int q = 0; q < 4; ++q) cw[j * 4 + q] = *(const f32x4*)(convw + j * 1024 + 16 * lane + 4 * q);
    for (int m = gw; m < S; m += NGW) pp_row(a, m, lane, cw); }
PHASE_FN ph_scores(LAS unsigned char* lds, unsigned char* ws) { TIDS(); WS_PTRS(ws);
    LAS unsigned char* iqt = lds; LAS unsigned char* wt = lds + IQT_BYTES + wave * (32 * SCT_RS);
    for (int u = bx; u < 1152; u += G) { int m = 0; while (16 * (m + 1) * (m + 2) <= u) ++m;
        const int r = u - 16 * m * (m + 1), qb = 32 * m + r / (m + 1), c = r % (m + 1), nkb = (qb >> 1) + 1, k0 = 16 * c, k1 = (k0 + 16 < nkb) ? k0 + 16 : nkb;
        {   const int row = tid >> 4, part = tid & 15; const bf16* src = PROJ + (size_t)(qb * 32 + row) * NPROJ + PC_IQ;
#pragma unroll
            for (int i = 0; i < 4; ++i) *(LAS v4u*)(iqt + row * IQT_RS + part * 16 + 256 * i) = *(const GAS v4u*)(src + part * 8 + 128 * i); }
        __syncthreads();
        for (int kb = k0 + wave; kb < k1; kb += NWAVES) score_wave_unit(wt, iqt, IKB, IWF, SC, qb, kb, lane);
        __syncthreads(); }
}
PHASE_FN ph_deltas(LAS unsigned char* lds, unsigned char* ws) { TIDS(); WS_PTRS(ws); LAS float* const sf = (LAS float*)(lds + SCR_OFF);
    for (int u = bx; u < 1024; u += G) {
        if (u < 512) { const int hd = u >> 7, c = u & 127, t0 = c * 64;
            if (wave == 0) { const float iv = GIF[(size_t)(t0 + lane) * 8 + hd], fv = GIF[(size_t)(t0 + lane) * 8 + 4 + hd]; float b = log_sigmoid_f(fv);
                b = wave_prefix_sum_f(b);
                const float bend = __builtin_bit_cast(float, __builtin_amdgcn_readlane(__builtin_bit_cast(int, b), 63)), gl = bend - b + iv, A = wave_max(gl);
                sf[lane] = __expf(gl - A); if (lane == 0) { AB[(hd * 128 + c) * 2] = A; AB[(hd * 128 + c) * 2 + 1] = bend; } }
            __syncthreads();
            chunk_delta<64, 256>(lds, MQK + (size_t)t0 * 1024 + 512 + hd * 128, 1024, PROJ + (size_t)t0 * NPROJ + PC_MV + hd * 256, NPROJ, sf, DCM + (size_t)(hd * 128 + c) * 32768, DN + (hd * 128 + c) * 128, tid);
        } else { const int v = u - 512, hd = v >> 6, c = v & 63, t0 = c * 128; const float lg = ret_lngamma(hd);
            if (tid < 128) sf[tid] = __expf(lg * (float)(127 - tid));
            __syncthreads();
            chunk_delta<128, 128>(lds, PROJ + (size_t)t0 * NPROJ + PC_RK + hd * 128, NPROJ, PROJ + (size_t)t0 * NPROJ + PC_RV + hd * 128, NPROJ, sf, DRR + (size_t)(hd * 64 + c) * 16384, nullptr, tid); }
    } }
PHASE_FN ph_select(LAS unsigned char* lds, unsigned char* ws) { TIDS(); WS_PTRS(ws);
    if (G == 256) select_rows_wg(lds, SC, MB, bx, 256, 28, 7168 + (bx - 128), 128, bx >= 128 ? 8 : 0, tid);
    else select_rows_wg(lds, SC, MB, bx, G, (S - bx + G - 1) / G, 0, 0, 0, tid); }
PHASE_FN ph_scans(LAS unsigned char* lds, unsigned char* ws) { TIDS(); WS_PTRS(ws); LAS float* const sf = (LAS float*)(lds + SCR_OFF);
    for (int u = bx; u < 128; u += G) {
        LAS float* dec = sf; LAS float* inj = sf + 128; LAS float* av = sf + 256; LAS float* bv = sf + 384;
        if (u < 64) { const int hd = u >> 4, p = u & 15;
            if (tid < 128) { av[tid] = AB[(hd * 128 + tid) * 2]; bv[tid] = AB[(hd * 128 + tid) * 2 + 1]; }
            __syncthreads();
            if (tid == 0) { float m = 0.f; for (int c = 0; c < 128; ++c) { const float mn = fmaxf(bv[c] + m, av[c]); dec[c] = __expf(bv[c] + m - mn); inj[c] = __expf(av[c] - mn); if (p == 0) MPREV[hd * 128 + c] = m; m = mn; } }
            __syncthreads();
            const size_t e4 = (size_t)hd * 128 * 32768 + p * 2048 + tid * 4;
            scan_elems<128>(DCM + e4, CPM + e4, 32768, dec, inj);
            if (p == 0 && tid < 128) { float st = 0.f; for (int c = 0; c < 128; ++c) { NPREV[(hd * 128 + c) * 128 + tid] = st; st = dec[c] * st + inj[c] * DN[(hd * 128 + c) * 128 + tid]; } }
        } else { const int v = u - 64, hd = v >> 3, p = v & 7; const float dg = __expf(128.0f * ret_lngamma(hd));
            if (tid < 64) { dec[tid] = dg; inj[tid] = 1.0f; }
            __syncthreads();
            const size_t e4 = (size_t)hd * 64 * 16384 + p * 2048 + tid * 4;
            scan_elems<64>(DRR + e4, RPR + e4, 16384, dec, inj); }
        __syncthreads(); } }
PHASE_FN ph_attention(char* alds, unsigned char* ws) { TIDS(); WS_PTRS(ws);
    typedef att::BlockRef<bf16, bf16> BR; att::Seam<bf16> seam;
#define ATT_REF(r, item_, pass_) do { const int hd_ = (item_) >> 4, y_ = (item_) & 15, qb_ = (pass_) ? 31 - y_ : y_; \
        (r).Q = PROJ + (size_t)qb_ * 256 * NPROJ + PC_AQ + hd_ * 128; (r).K = PROJ + PC_AK + hd_ * 128; (r).V = PROJ + PC_AV + hd_ * 128; (r).O = YA + (size_t)qb_ * 256 * 1024 + hd_ * 128; \
        (r).M = MB + (size_t)qb_ * 256 * 128; (r).P0 = qb_ * 256; } while (0)
    if (bx < 128) { int item = bx, pass = 0; BR cur; ATT_REF(cur, item, 0); att::causal_swa_prime<bf16, bf16>(cur, 1 << 30, alds, seam);
        for (;;) { const bool more_pass = pass == 0, more_item = item + G < 128, last = !more_pass && !more_item;
            int itn = item, pn = pass + 1; if (!more_pass) { pn = 0; itn = more_item ? item + G : item; }
            BR nxt = cur; if (!last) ATT_REF(nxt, itn, pn);
            att::causal_swa_block<bf16, bf16>(cur, nxt, S, 1 << 30, alds, seam);
            if (last) break; cur = nxt; item = itn; pass = pn; } }
    __syncthreads(); }
PHASE_FN ph_outs(LAS unsigned char* lds, unsigned char* ws, const float* gain_m, const float* gain_r, int u0, int ustep) { TIDS(); WS_PTRS(ws); LAS float* const sf = (LAS float*)(lds + SCR_OFF);
    for (int u = u0; u < 1024; u += ustep) {
        if (u < 512) { const int hd = u >> 7, c = u & 127, t0 = c * 64;
            if (wave == 0) { const float iv = GIF[(size_t)(t0 + lane) * 8 + hd], fv = GIF[(size_t)(t0 + lane) * 8 + 4 + hd]; float b = log_sigmoid_f(fv);
                b = wave_prefix_sum_f(b);
                const float mp = MPREV[hd * 128 + c]; const float pm = wave_prefix_max_f(iv - b);
                const float mt = fmaxf(b + mp, b + pm);
                sf[lane] = b - mt; sf[128 + lane] = iv - b; sf[256 + lane] = __expf(b + mp - mt); sf[384 + lane] = __expf(-mt); sf[512 + lane] = 0.f; }
            if (wave == 1) { sf[640 + lane] = NPREV[(hd * 128 + c) * 128 + lane]; sf[640 + 64 + lane] = NPREV[(hd * 128 + c) * 128 + 64 + lane]; }
            __syncthreads();
            chunk_out<64, 256, 0>(lds, sf, MQK + (size_t)t0 * 1024 + hd * 128, 1024, MQK + (size_t)t0 * 1024 + 512 + hd * 128, 1024, PROJ + (size_t)t0 * NPROJ + PC_MV + hd * 256, NPROJ,
                                  CPM + (size_t)(hd * 128 + c) * 32768, gain_m + hd * 256, PROJ + (size_t)t0 * NPROJ + PC_MO + hd * 256, NPROJ, YM + (size_t)t0 * 1024 + hd * 256, 1024, tid);
        } else { const int v = u - 512, hd = v >> 6, c = v & 63, t0 = c * 128; const float lg = ret_lngamma(hd);
            if (tid < 128) { sf[tid] = lg * (float)tid; sf[128 + tid] = -lg * (float)tid; sf[256 + tid] = __expf(lg * (float)(tid + 1)); }
            __syncthreads();
            chunk_out<128, 128, 1>(lds, sf, PROJ + (size_t)t0 * NPROJ + PC_RQ + hd * 128, NPROJ, PROJ + (size_t)t0 * NPROJ + PC_RK + hd * 128, NPROJ, PROJ + (size_t)t0 * NPROJ + PC_RV + hd * 128, NPROJ,
                                   RPR + (size_t)(hd * 64 + c) * 16384, gain_r + hd * 128, PROJ + (size_t)t0 * NPROJ + PC_RG + hd * 128, NPROJ, YR + (size_t)t0 * 1024 + hd * 128, 1024, tid); }
    } }
template <int MODE> PHASE_FN ph_gemm_branch(LAS unsigned char* lds, unsigned char* ws, const bf16* A, const bf16* Wt, int gcol) { TIDS(); WS_PTRS(ws);
    pg8::Gemm g{A, Wt, S, DM, 1024}; pg8::StaticOrder so; so.init(S, DM, G, bx); pg8::EpiBranch<MODE> E{PROJ + PC_G + gcol, NPROJ, MERGEDF, MERGED, DM};
    pg8::gemm_phase<pg8::EpiBranch<MODE>, pg8::StaticOrder, true, true>(lds, g, so, E); }
PHASE_FN ph_gemm_resid(LAS unsigned char* lds, const bf16* A, const bf16* Wt, int K, const float* base, float* out) { TIDS();
    pg8::Gemm g{A, Wt, S, DM, K}; pg8::StaticOrder so; so.init(S, DM, G, bx); pg8::EpiResid E{base, out, DM};
    pg8::gemm_phase<pg8::EpiResid, pg8::StaticOrder, true, true>(lds, g, so, E); }
PHASE_FN ph_gemm_ffn_in(LAS unsigned char* lds, unsigned char* ws, const bf16* Wt) { TIDS(); WS_PTRS(ws);
    pg8::Gemm g{H, Wt, S, 2 * FF, DM}; pg8::StaticOrder so; so.init(S, 2 * FF, G, bx); pg8::EpiSwiGLU E{ACT, FF};
    pg8::gemm_phase<pg8::EpiSwiGLU, pg8::StaticOrder, true, true>(lds, g, so, E); }


#ifndef SYN_PROBE
#define SYN_PROBE 0
#endif
PHASE_FN ph_probe(LAS unsigned char* lds) { TIDS();
    LAS unsigned* hist = (LAS unsigned*)lds;
    if (SYN_PROBE == 1) {
        unsigned x = (unsigned)tid * 2654435761u + 12345u;
        for (int r = 0; r < 32; ++r) {
#pragma unroll
            for (int i = 0; i < 16; ++i) { x = x * 1664525u + 1013904223u; (void)__hip_atomic_fetch_add(hist + ((x >> 10) & 2047u), 1u, __ATOMIC_RELAXED, __HIP_MEMORY_SCOPE_WORKGROUP); }
            SEL_BAR(); } }
    if (SYN_PROBE == 2) {
        float acc = 0.f; float v[16];
#pragma unroll
        for (int i = 0; i < 16; ++i) v[i] = (float)((tid * 16 + i) % 977);
        for (int r = 0; r < 32 * 8; ++r) { const float c1 = 100.f + (float)(r & 7) + acc * 1e-30f, c2 = c1 * 2.f, c3 = c1 * 3.f; unsigned n1 = 0, n2 = 0, n3 = 0;
#pragma unroll
            for (int i = 0; i < 16; ++i) { n1 += (unsigned)__builtin_popcountll(__builtin_amdgcn_ballot_w64(v[i] >= c1)); n2 += (unsigned)__builtin_popcountll(__builtin_amdgcn_ballot_w64(v[i] >= c2)); n3 += (unsigned)__builtin_popcountll(__builtin_amdgcn_ballot_w64(v[i] >= c3)); }
            if (lane == 0) { hist[(r & 1) * 24 + wave] = n1; hist[(r & 1) * 24 + 8 + wave] = n2; hist[(r & 1) * 24 + 16 + wave] = n3; }
            SEL_BAR();
            unsigned t1 = 0;
#pragma unroll
            for (int j = 0; j < 24; ++j) t1 += hist[(r & 1) * 24 + j];
            acc += (float)t1; }
        if (acc == 12345.f) hist[100] = 1u; }
    if (SYN_PROBE == 3) {
        float a = (float)tid;
        for (int r = 0; r < 32; ++r) {
#pragma unroll
            for (int k = 0; k < 4; ++k)
#pragma unroll
                for (int o = 1; o < 64; o <<= 1) a = fmaxf(a, shfl_idx_f(a, (int)(lane_id_v() ^ (unsigned)o)) * 0.999f);
        }
        if (a == 12345.f) hist[100] = 1u; }
    __syncthreads(); }
typedef const __attribute__((address_space(4))) Args* ArgsP;
__device__ __forceinline__ ArgsP fresh_args() { ArgsP ap = (ArgsP)__builtin_amdgcn_kernarg_segment_ptr(); asm volatile("" : "+s"(ap)); return ap; }
#ifndef DUP_PHASE
#define DUP_PHASE -1
#endif
#define SEAM() do { if constexpr (one_launch) { ArgsP ap_ = fresh_args(); XcdBarrier b_; b_.bar = (unsigned*)(ap_->ws + WS_CTL) + CW_BAR; b_.x = xb_xcc_id(); b_.st = (volatile LAS unsigned*)(lds + MISC_OFF); xcd_barrier(b_); } } while (0)
#define IN(k) (PLO <= (k) && (k) < PHI)
#define WL(ap, layer) ((ap)->ws + WS_W + (size_t)(layer) * W_LAYER)
template <int PLO, int PHI, bool LAST> __device__ __forceinline__ void layer_phases(const int layer, LAS unsigned char* lds, unsigned char* lds_raw) {
    constexpr bool one_launch = (PHI - PLO > 1);
    if constexpr (IN(1)) { ArgsP ap = fresh_args(); ph_rmsnorm(layer == 0 ? ap->x : ap->out, ap->norm_mix + layer * DM, (bf16*)(ap->ws + WS_H)); if constexpr (DUP_PHASE == 1) { SEAM(); ph_rmsnorm(layer == 0 ? ap->x : ap->out, ap->norm_mix + layer * DM, (bf16*)(ap->ws + WS_H)); } SEAM(); }
    constexpr int CV_S1 = 10880, CV_S2 = 10880;
    if constexpr (IN(2)) { ArgsP ap = fresh_args(); ph_gemm_proj(lds, ap->ws, (const bf16*)(WL(ap, layer) + WO_IN));
        if constexpr (one_launch && !LAST) { ArgsP aq = fresh_args(); ph_convert_tail(lds, aq->ws, layer + 1, aq->w_in, aq->w_b_att, aq->w_b_mlstm, aq->w_b_ret, aq->w_out, aq->w_ffn_in, aq->w_ffn_out, ((S / 256) * (NPROJ_PAD / 256)) % (int)gridDim.x, 0, CV_S1); } if constexpr (DUP_PHASE == 2) { SEAM(); ph_gemm_proj(lds, ap->ws, (const bf16*)(WL(ap, layer) + WO_IN)); } SEAM(); }
    if constexpr (IN(3)) { ArgsP ap = fresh_args(); ph_pp(ap->ws, ap->att_q_norm + layer * 128, ap->att_k_norm + layer * 128, ap->mlstm_conv + layer * 4096, ap->mlstm_gate_bias + layer * 8); if constexpr (DUP_PHASE == 23) { SEAM(); ph_gemm_proj(lds, ap->ws, (const bf16*)(WL(ap, layer) + WO_IN)); SEAM(); ph_pp(ap->ws, ap->att_q_norm + layer * 128, ap->att_k_norm + layer * 128, ap->mlstm_conv + layer * 4096, ap->mlstm_gate_bias + layer * 8); } if constexpr (DUP_PHASE == 3) { SEAM(); ph_pp(ap->ws, ap->att_q_norm + layer * 128, ap->att_k_norm + layer * 128, ap->mlstm_conv + layer * 4096, ap->mlstm_gate_bias + layer * 8); } SEAM(); }
    if constexpr (IN(4)) { ArgsP ap = fresh_args(); ph_scores(lds, ap->ws); if constexpr (DUP_PHASE == 4) { SEAM(); ph_scores(lds, ap->ws); } }
    if constexpr (IN(5)) { ArgsP ap = fresh_args(); ph_deltas(lds, ap->ws); if constexpr (DUP_PHASE == 5) { SEAM(); ph_deltas(lds, ap->ws); } SEAM(); }
    if constexpr (IN(6) && SYN_PROBE != 0) { ph_probe(lds); }
    if constexpr (IN(6)) { ArgsP ap = fresh_args(); ph_select(lds, ap->ws); if constexpr (DUP_PHASE == 6) { SEAM(); ph_select(lds, ap->ws); } }
    if constexpr (IN(7) && one_launch && !LAST) { ArgsP aq = fresh_args(); ph_convert_tail(lds, aq->ws, layer + 1, aq->w_in, aq->w_b_att, aq->w_b_mlstm, aq->w_b_ret, aq->w_out, aq->w_ffn_in, aq->w_ffn_out, 128, CV_S1, CV_S2); }
    if constexpr (IN(7)) { ArgsP ap = fresh_args(); ph_scans(lds, ap->ws); if constexpr (DUP_PHASE == 7) { SEAM(); ph_scans(lds, ap->ws); } SEAM(); }
    if constexpr (IN(8) && IN(9)) {
        ArgsP ap = fresh_args(); const bool split = gridDim.x == 256;
        if (!split || blockIdx.x < 128) ph_attention((char*)lds_raw, ap->ws);
        if (!split || blockIdx.x >= 128) ph_outs(lds, ap->ws, ap->mlstm_out_norm + layer * 1024, ap->ret_out_norm + layer * 1024, split ? (int)blockIdx.x - 128 : (int)blockIdx.x, split ? 128 : (int)gridDim.x);
        SEAM(); }
    else {
    if constexpr (IN(8)) { ArgsP ap = fresh_args(); ph_attention((char*)lds_raw, ap->ws); }
    if constexpr (IN(9)) { ArgsP ap = fresh_args(); ph_outs(lds, ap->ws, ap->mlstm_out_norm + layer * 1024, ap->ret_out_norm + layer * 1024, (int)blockIdx.x, (int)gridDim.x); SEAM(); }
    }
    if constexpr (IN(10)) { ArgsP ap = fresh_args(); ph_gemm_branch<0>(lds, ap->ws, (const bf16*)(ap->ws + WS_YA), (const bf16*)(WL(ap, layer) + WO_B), 0); if constexpr (DUP_PHASE == 10) { SEAM(); ph_gemm_branch<0>(lds, ap->ws, (const bf16*)(ap->ws + WS_YA), (const bf16*)(WL(ap, layer) + WO_B), 0); } }
    if constexpr (IN(11)) { ArgsP ap = fresh_args(); ph_gemm_branch<1>(lds, ap->ws, (const bf16*)(ap->ws + WS_YM), (const bf16*)(WL(ap, layer) + WO_B + 4 * MiB), DM); if constexpr (DUP_PHASE == 11) { SEAM(); ph_gemm_branch<1>(lds, ap->ws, (const bf16*)(ap->ws + WS_YM), (const bf16*)(WL(ap, layer) + WO_B + 4 * MiB), DM); } }
    if constexpr (IN(12)) { ArgsP ap = fresh_args(); ph_gemm_branch<2>(lds, ap->ws, (const bf16*)(ap->ws + WS_YR), (const bf16*)(WL(ap, layer) + WO_B + 8 * MiB), 2 * DM); if constexpr (DUP_PHASE == 12) { SEAM(); ph_gemm_branch<2>(lds, ap->ws, (const bf16*)(ap->ws + WS_YR), (const bf16*)(WL(ap, layer) + WO_B + 8 * MiB), 2 * DM); } SEAM(); }
    if constexpr (IN(13)) { ArgsP ap = fresh_args(); ph_gemm_resid(lds, (const bf16*)(ap->ws + WS_MERGED), (const bf16*)(WL(ap, layer) + WO_OUT), DM, layer == 0 ? ap->x : ap->out, ap->out); SEAM(); }
    if constexpr (IN(14)) { ArgsP ap = fresh_args(); ph_rmsnorm(ap->out, ap->norm_ffn + layer * DM, (bf16*)(ap->ws + WS_H)); if constexpr (DUP_PHASE == 14) { SEAM(); ph_rmsnorm(ap->out, ap->norm_ffn + layer * DM, (bf16*)(ap->ws + WS_H)); } SEAM(); }
    if constexpr (IN(15)) { ArgsP ap = fresh_args(); ph_gemm_ffn_in(lds, ap->ws, (const bf16*)(WL(ap, layer) + WO_FIN));
        if constexpr (one_launch && !LAST) { ArgsP aq = fresh_args(); ph_convert_tail(lds, aq->ws, layer + 1, aq->w_in, aq->w_b_att, aq->w_b_mlstm, aq->w_b_ret, aq->w_out, aq->w_ffn_in, aq->w_ffn_out, ((S / 256) * (2 * FF / 256)) % (int)gridDim.x, CV_S2, CV_ITEMS); } if constexpr (DUP_PHASE == 15) { SEAM(); ph_gemm_ffn_in(lds, ap->ws, (const bf16*)(WL(ap, layer) + WO_FIN)); } SEAM(); }
    if constexpr (IN(16)) { ArgsP ap = fresh_args(); ph_gemm_resid(lds, (const bf16*)(ap->ws + WS_ACT), (const bf16*)(WL(ap, layer) + WO_FOUT), FF, ap->out, ap->out); if constexpr (!LAST) SEAM(); }
}
template <int PLO, int PHI> __global__ void __launch_bounds__(NTHR, 2) fwd(Args args_unused) {
    (void)args_unused;
    extern __shared__ __attribute__((aligned(16))) unsigned char lds_raw[];
    LAS unsigned char* lds = (LAS unsigned char*)lds_raw;
    if (threadIdx.x < 64) ((volatile LAS unsigned*)(lds + MISC_OFF))[threadIdx.x] = 0u;
    if ((threadIdx.x & 63) == 0) ((volatile LAS unsigned*)(lds + MISC_OFF))[64 + ((unsigned)__builtin_amdgcn_s_getreg((5 << 11) | 4) & 63u)] = threadIdx.x >> 6;
    __syncthreads();
    constexpr bool one_launch = (PHI - PLO > 1);
    if constexpr (one_launch) { ArgsP ap = fresh_args(); (void)xcd_barrier_post((unsigned*)(ap->ws + WS_CTL) + CW_BAR, (volatile LAS unsigned*)(lds + MISC_OFF)); }
    if constexpr (PLO == 0) { ArgsP ap = fresh_args(); ph_prologue(lds, ap->ws, ap->w_in, ap->w_b_att, ap->w_b_mlstm, ap->w_b_ret, ap->w_out, ap->w_ffn_in, ap->w_ffn_out, !one_launch);
        if constexpr (DUP_PHASE == 0) { SEAM(); ph_prologue(lds, ap->ws, ap->w_in, ap->w_b_att, ap->w_b_mlstm, ap->w_b_ret, ap->w_out, ap->w_ffn_in, ap->w_ffn_out, !one_launch); }
        if (PHI > 1) SEAM(); }
    if constexpr (one_launch) { static_assert(DEPTH == 4, "four inlined layer sites");
        layer_phases<PLO, PHI, false>(0, lds, lds_raw); layer_phases<PLO, PHI, false>(1, lds, lds_raw); layer_phases<PLO, PHI, false>(2, lds, lds_raw); layer_phases<PLO, PHI, true>(3, lds, lds_raw); }
    else if constexpr (PLO > 0) { ArgsP ap = fresh_args(); layer_phases<PLO, PHI, true>(ap->layer_lo, lds, lds_raw); }
}
#undef IN
#undef SEAM
#undef WL

#ifndef ONE_LAUNCH
#define ONE_LAUNCH 1
#endif
typedef void (*kern_t)(Args);
template <int P> static kern_t phase_kernel(int p) { if (p == P) return fwd<P, P + 1>; if constexpr (P < PH_PER_LAYER) return phase_kernel<P + 1>(p); else return nullptr; }
extern "C" void kernel_launch(void* const* d_in, const int* in_sizes, int n_in, void* d_out, int out_size, void* d_ws, size_t ws_size, hipStream_t stream) {
    static int grid = 0;
    if (grid == 0) {
        if (n_in != 16 || in_sizes[0] != S * DM || out_size != S * DM || ws_size < WS_END) { fprintf(stderr, "kernel_launch: unexpected shapes (n_in %d, in0 %d, out %d, ws %zu < %zu); nothing launched\n", n_in, n_in > 0 ? in_sizes[0] : -1, out_size, ws_size, (size_t)WS_END); grid = -1; return; }
        int dev = 0, cus = 0;
        if (hipGetDevice(&dev) != hipSuccess || hipDeviceGetAttribute(&cus, hipDeviceAttributeMultiprocessorCount, dev) != hipSuccess) { grid = -1; return; }
#if ONE_LAUNCH
        if (hipFuncSetAttribute((const void*)fwd<0, PH_PER_LAYER + 1>, hipFuncAttributeMaxDynamicSharedMemorySize, LDS_BYTES) != hipSuccess) { grid = -1; return; }
#else
        for (int p = 0; p <= PH_PER_LAYER; ++p) if (hipFuncSetAttribute((const void*)phase_kernel<0>(p), hipFuncAttributeMaxDynamicSharedMemorySize, LDS_BYTES) != hipSuccess) { fprintf(stderr, "kernel_launch: hipFuncSetAttribute failed\n"); grid = -1; return; }
#endif
        (void)hipGetLastError();
        grid = cus;
    }
    if (grid < 0) return;
    (void)hipMemsetAsync((char*)d_ws + WS_CTL, 0, CTL_ZERO_BYTES, stream);
    Args a{};
    a.x = (const float*)d_in[0]; a.norm_mix = (const float*)d_in[1]; a.norm_ffn = (const float*)d_in[2]; a.w_in = (const float*)d_in[3]; a.att_q_norm = (const float*)d_in[4]; a.att_k_norm = (const float*)d_in[5];
    a.mlstm_conv = (const float*)d_in[6]; a.mlstm_gate_bias = (const float*)d_in[7]; a.mlstm_out_norm = (const float*)d_in[8]; a.ret_out_norm = (const float*)d_in[9];
    a.w_b_att = (const float*)d_in[10]; a.w_b_mlstm = (const float*)d_in[11]; a.w_b_ret = (const float*)d_in[12]; a.w_out = (const float*)d_in[13]; a.w_ffn_in = (const float*)d_in[14]; a.w_ffn_out = (const float*)d_in[15];
    a.out = (float*)d_out; a.ws = (unsigned char*)d_ws;
#if ONE_LAUNCH
    a.layer_lo = 0; a.layer_hi = DEPTH; a.ph_lo = 0; a.ph_hi = PH_PER_LAYER + 1; hipLaunchKernelGGL((fwd<0, PH_PER_LAYER + 1>), dim3(grid), dim3(NTHR), LDS_BYTES, stream, a);
#else
    a.layer_lo = 0; a.layer_hi = 0; a.ph_lo = 0; a.ph_hi = 1; hipLaunchKernelGGL((fwd<0, 1>), dim3(grid), dim3(NTHR), LDS_BYTES, stream, a);
    for (int l = 0; l < DEPTH; ++l) for (int p = 1; p <= PH_PER_LAYER; ++p) { a.layer_lo = l; a.layer_hi = l + 1; a.ph_lo = p; a.ph_hi = p + 1; hipLaunchKernelGGL(phase_kernel<0>(p), dim3(grid), dim3(NTHR), LDS_BYTES, stream, a); }
#endif
}
```

```cpp
#include <hip/hip_runtime.h>
#include <cstdio>
#include <cstdint>
__device__ __forceinline__ int my_tid();
namespace pg8 {
#define PG8_LAS __attribute__((address_space(3)))
typedef unsigned short bf16_t;
typedef short bf16x8 __attribute__((ext_vector_type(8)));
typedef float f32x4 __attribute__((ext_vector_type(4)));
typedef unsigned u32x4 __attribute__((ext_vector_type(4)));
constexpr int BM = 256, BK = 64, HALF = 128, HTB = HALF * BK * 2  , STAGE_BYTES = 8 * HTB, NXCD = 8, WGM = 8;

__host__ __device__ __forceinline__ int lds_byte(int r, int c) { const int st = (r >> 4) * 2 + (c >> 5), rr = r & 15, cc = c & 31, ob = rr * 64 + cc * 2; return st * 1024 + (ob ^ (((ob >> 9) & 1) << 5)); }
__host__ __device__ __forceinline__ void stage_rc(int b, int& R, int& C) { const int st = b / 1024, sb = b % 1024, swz = sb ^ (((sb >> 9) & 1) << 5); R = (st >> 1) * 16 + swz / 64; C = (st & 1) * 32 + (swz % 64) / 2; }
__host__ __device__ __forceinline__ int perm32(int rho) { const int n = rho >> 4, i = rho & 15; return 8 * (i >> 2) + 4 * n + (i & 3); }

struct Unit { int pm, pn; };
struct Gemm { const bf16_t* A; const bf16_t* Bt; int M, N, K; };

struct StaticOrder {
    int nM, nN, nwg, G, c;
    __host__ __device__ void init(int M, int N, int G_, int c_) { nM = M / BM; nN = N / BM; nwg = nM * nN; G = G_; c = c_; }
    __host__ __device__ bool next(int i, Unit& u) const {
        const long L = (long)i * G + c; if (L >= nwg) return false;
        int wgid = (int)L; { const int q = nwg / NXCD, r = nwg % NXCD, xcd = wgid % NXCD, off = wgid / NXCD; wgid = (xcd < r ? xcd * (q + 1) : r * (q + 1) + (xcd - r) * q) + off; }
        const int nig = WGM * nN, gid = wgid / nig, fm = gid * WGM, gsz = (nM - fm) < WGM ? (nM - fm) : WGM;
        u.pm = fm + ((wgid % nig) % gsz); u.pn = (wgid % nig) / gsz; return true;
    }
    __device__ __forceinline__ void a_ready(const Unit&) const {}
    __device__ __forceinline__ void done(const Unit&) const {}
};

__device__ __forceinline__ unsigned cvt_pk_bf16(float lo, float hi) { unsigned r; asm volatile("v_cvt_pk_bf16_f32 %0, %1, %2" : "=v"(r) : "v"(lo), "v"(hi)); return r; }
typedef float f32x2 __attribute__((ext_vector_type(2)));
__device__ __forceinline__ float sigmoid_f(float x) { return __builtin_amdgcn_rcpf(1.0f + __builtin_amdgcn_exp2f(-1.4426950408889634f * x)); }
struct EpiProj {
    static constexpr bool PERM = true, AFTER_DRAIN = false;
    bf16_t* P; int ldp; float* Sm; int ngate0, nbf;
    __device__ __forceinline__ void operator()(const f32x4 (&acc)[2][2][4][2], const Unit& u, int wr, int wc, int fr, int fq) const {
        const int row0 = u.pm * BM + wr * 64 + fr, col0 = u.pn * BM + wc * 32 + 8 * fq;
        if (u.pn >= nbf) {
            const int c0 = wc * 32 + 8 * fq;
#pragma unroll
            for (int ai = 0; ai < 2; ++ai)
#pragma unroll
                for (int m = 0; m < 4; ++m) { float* rowp = Sm + (size_t)(row0 + ai * HALF + m * 16) * 256 + c0;
#pragma unroll
                    for (int bj = 0; bj < 2; ++bj) { *(f32x4*)(rowp + bj * HALF) = acc[ai][bj][m][0]; *(f32x4*)(rowp + bj * HALF + 4) = acc[ai][bj][m][1]; } }
            return;
        }
        const bool sg = u.pn >= ngate0;
#pragma unroll
        for (int ai = 0; ai < 2; ++ai)
#pragma unroll
            for (int m = 0; m < 4; ++m) { bf16_t* rowp = P + (size_t)(row0 + ai * HALF + m * 16) * ldp + col0;
#pragma unroll
                for (int bj = 0; bj < 2; ++bj) { f32x4 v0 = acc[ai][bj][m][0], v1 = acc[ai][bj][m][1];
                    if (sg) {
#pragma unroll
                        for (int j = 0; j < 4; ++j) { v0[j] = sigmoid_f(v0[j]); v1[j] = sigmoid_f(v1[j]); } }
                    u32x4 w; w.x = cvt_pk_bf16(v0[0], v0[1]); w.y = cvt_pk_bf16(v0[2], v0[3]); w.z = cvt_pk_bf16(v1[0], v1[1]); w.w = cvt_pk_bf16(v1[2], v1[3]);
                    *(u32x4*)(rowp + bj * HALF) = w; } }
    }
};
__device__ __forceinline__ f32x4 bf4_lo(u32x4 w) { return (f32x4){__uint_as_float(w.x << 16), __uint_as_float(w.x & 0xffff0000u), __uint_as_float(w.y << 16), __uint_as_float(w.y & 0xffff0000u)}; }
__device__ __forceinline__ f32x4 bf4_hi(u32x4 w) { return (f32x4){__uint_as_float(w.z << 16), __uint_as_float(w.z & 0xffff0000u), __uint_as_float(w.w << 16), __uint_as_float(w.w & 0xffff0000u)}; }
template <int MODE> struct EpiBranch {
    static constexpr bool PERM = true, AFTER_DRAIN = false;
    const bf16_t* G; int ldg; bf16_t* T; bf16_t* O; int ldt;
    __device__ __forceinline__ void operator()(const f32x4 (&acc)[2][2][4][2], const Unit& u, int wr, int wc, int fr, int fq) const {
        const int row0 = u.pm * BM + wr * 64 + fr, col0 = u.pn * BM + wc * 32 + 8 * fq;
#pragma unroll
        for (int ai = 0; ai < 2; ++ai)
#pragma unroll
            for (int m = 0; m < 4; ++m) { const size_t r = (size_t)(row0 + ai * HALF + m * 16);
#pragma unroll
                for (int bj = 0; bj < 2; ++bj) { const u32x4 g = *(const u32x4*)(G + r * ldg + col0 + bj * HALF);
                    f32x4 v0 = acc[ai][bj][m][0] * bf4_lo(g), v1 = acc[ai][bj][m][1] * bf4_hi(g);
                    bf16_t* tp = T + r * ldt + col0 + bj * HALF;
                    if (MODE >= 1) { const u32x4 t = *(const u32x4*)tp; v0 = v0 + bf4_lo(t); v1 = v1 + bf4_hi(t); }
                    u32x4 w; w.x = cvt_pk_bf16(v0[0], v0[1]); w.y = cvt_pk_bf16(v0[2], v0[3]); w.z = cvt_pk_bf16(v1[0], v1[1]); w.w = cvt_pk_bf16(v1[2], v1[3]);
                    *(u32x4*)((MODE <= 1 ? tp : O + r * ldt + col0 + bj * HALF)) = w; } }
    }
};
struct EpiResid {
    static constexpr bool PERM = false, AFTER_DRAIN = false;
    const float* base; float* out; int ldc;
    __device__ __forceinline__ void operator()(const f32x4 (&acc)[2][2][4][2], const Unit& u, int wr, int wc, int fr, int fq) const {
        const int row0 = u.pm * BM + wr * 64 + fr, col0 = u.pn * BM + wc * 32 + 4 * fq;
#pragma unroll
        for (int ai = 0; ai < 2; ++ai)
#pragma unroll
            for (int m = 0; m < 4; ++m) { const size_t off = (size_t)(row0 + ai * HALF + m * 16) * ldc + col0;
#pragma unroll
                for (int bj = 0; bj < 2; ++bj)
#pragma unroll
                    for (int n = 0; n < 2; ++n) *(f32x4*)(out + off + bj * HALF + n * 16) = *(const f32x4*)(base + off + bj * HALF + n * 16) + acc[ai][bj][m][n]; }
    }
};
template <bool BF_IN, bool BF_OUT> struct EpiResidX {
    static constexpr bool PERM = true, AFTER_DRAIN = false;
    const void* base; void* out; int ldc;
    __device__ __forceinline__ void operator()(const f32x4 (&acc)[2][2][4][2], const Unit& u, int wr, int wc, int fr, int fq) const {
        const int row0 = u.pm * BM + wr * 64 + fr, col0 = u.pn * BM + wc * 32 + 8 * fq;
#pragma unroll
        for (int ai = 0; ai < 2; ++ai)
#pragma unroll
            for (int m = 0; m < 4; ++m) { const size_t off = (size_t)(row0 + ai * HALF + m * 16) * ldc + col0;
#pragma unroll
                for (int bj = 0; bj < 2; ++bj) { f32x4 v0, v1;
                    if (BF_IN) { const u32x4 b = *(const u32x4*)((const bf16_t*)base + off + bj * HALF); v0 = bf4_lo(b); v1 = bf4_hi(b); }
                    else { v0 = *(const f32x4*)((const float*)base + off + bj * HALF); v1 = *(const f32x4*)((const float*)base + off + bj * HALF + 4); }
                    v0 = v0 + acc[ai][bj][m][0]; v1 = v1 + acc[ai][bj][m][1];
                    if (BF_OUT) { u32x4 w; w.x = cvt_pk_bf16(v0[0], v0[1]); w.y = cvt_pk_bf16(v0[2], v0[3]); w.z = cvt_pk_bf16(v1[0], v1[1]); w.w = cvt_pk_bf16(v1[2], v1[3]); *(u32x4*)((bf16_t*)out + off + bj * HALF) = w; }
                    else { *(f32x4*)((float*)out + off + bj * HALF) = v0; *(f32x4*)((float*)out + off + bj * HALF + 4) = v1; } } }
    }
};
struct EpiSwiGLU {
    static constexpr bool PERM = true, AFTER_DRAIN = false;
    bf16_t* O; int ldc;
    __device__ __forceinline__ void operator()(const f32x4 (&acc)[2][2][4][2], const Unit& u, int wr, int wc, int fr, int fq) const {
        const int row0 = u.pm * BM + wr * 64 + fr, col0 = u.pn * HALF + wc * 32 + 8 * fq;
#pragma unroll
        for (int ai = 0; ai < 2; ++ai)
#pragma unroll
            for (int m = 0; m < 4; ++m) { f32x4 v0, v1;
#pragma unroll
                for (int j = 0; j < 4; ++j) { const float g0 = acc[ai][0][m][0][j], g1 = acc[ai][0][m][1][j];
                    v0[j] = g0 * sigmoid_f(g0) * acc[ai][1][m][0][j]; v1[j] = g1 * sigmoid_f(g1) * acc[ai][1][m][1][j]; }
                u32x4 w; w.x = cvt_pk_bf16(v0[0], v0[1]); w.y = cvt_pk_bf16(v0[2], v0[3]); w.z = cvt_pk_bf16(v1[0], v1[1]); w.w = cvt_pk_bf16(v1[2], v1[3]);
                *(u32x4*)(O + (size_t)(row0 + ai * HALF + m * 16) * ldc + col0) = w; }
    }
};
template <class Epi, class Sched, bool ALIGN_EPI = false, bool SP2 = false>
__device__ __forceinline__ void gemm_phase(PG8_LAS unsigned char* lds, const Gemm g, const Sched& S, const Epi& E) {
    int tid_o = my_tid(); asm volatile("" : "+v"(tid_o));
    const int tid = tid_o, wid = __builtin_amdgcn_readfirstlane(tid >> 6), lane = tid & 63, wr = wid >> 2, wc = wid & 3, fr = lane & 15, fq = lane >> 4;
    const int K = g.K, nt = K / BK;
    unsigned voffA[2], voffB[2];
#pragma unroll
    for (int i = 0; i < 2; ++i) { int R, C; stage_rc(tid * 16 + i * 8192, R, C); const int Rb = Epi::PERM ? ((R & ~31) + perm32(R & 31)) : R;
        voffA[i] = (unsigned)(R * K + C) * 2u; voffB[i] = (unsigned)(Rb * K + C) * 2u; }
    const size_t kstep = (size_t)(BK * 2);
    const size_t hstep = (size_t)HALF * K * 2;
    const size_t tstep = 2 * hstep;
    const unsigned ldsw = (unsigned)wid * 1024u;
    const int aoff = lds_byte(wr * 64 + fr, fq * 8), boff = lds_byte(wc * 32 + fr, fq * 8);
#define PG8_SA(b, h) (((b) * 2 + (h)) * HTB)
#define PG8_SB(b, h) ((4 + (b) * 2 + (h)) * HTB)
#define PG8_STAGE(bufoff, gbase, voff) do { _Pragma("unroll") for (int _i = 0; _i < 2; ++_i) \
        __builtin_amdgcn_global_load_lds((const unsigned*)((const char*)(gbase) + (voff)[_i]), (PG8_LAS unsigned*)(lds + (bufoff) + ldsw + _i * 8192), 16, 0, 0); } while (0)
#define PG8_LDA(dst, b, h) do { _Pragma("unroll") for (int m = 0; m < 4; ++m) _Pragma("unroll") for (int k = 0; k < 2; ++k) dst[m][k] = *(const PG8_LAS bf16x8*)(lds + PG8_SA(b, h) + aoff + m * 2048 + k * 1024); } while (0)
#define PG8_LDB(dst, b, h) do { _Pragma("unroll") for (int n = 0; n < 2; ++n) _Pragma("unroll") for (int k = 0; k < 2; ++k) dst[n][k] = *(const PG8_LAS bf16x8*)(lds + PG8_SB(b, h) + boff + n * 2048 + k * 1024); } while (0)
#define PG8_MMA(ai, bj, At, Bt) do { __builtin_amdgcn_s_setprio(1); _Pragma("unroll") for (int m = 0; m < 4; ++m) _Pragma("unroll") for (int n = 0; n < 2; ++n) _Pragma("unroll") for (int k = 0; k < 2; ++k) \
        acc[ai][bj][m][n] = __builtin_amdgcn_mfma_f32_16x16x32_bf16(Bt[n][k], At[m][k], acc[ai][bj][m][n], 0, 0, 0); __builtin_amdgcn_s_setprio(0); } while (0)
#define PG8_WAIT_V(n) asm volatile("s_waitcnt vmcnt(" #n ")" ::: "memory")
#define PG8_WAIT_L(n) asm volatile("s_waitcnt lgkmcnt(" #n ")" ::: "memory")
#define PG8_BAR __builtin_amdgcn_s_barrier()
#define PG8_SCHED __builtin_amdgcn_sched_barrier(0)
    Unit cur, nxt; int ui = 0;
    if (!S.next(0, cur)) return;
    f32x4 acc[2][2][4][2];
#pragma unroll
    for (int a = 0; a < 2; ++a)
#pragma unroll
        for (int b = 0; b < 2; ++b)
#pragma unroll
            for (int m = 0; m < 4; ++m)
#pragma unroll
                for (int n = 0; n < 2; ++n) acc[a][b][m][n] = (f32x4){0.f, 0.f, 0.f, 0.f};
    bf16x8 At[4][2], B0[2][2], B1[2][2];
    const char* cA = (const char*)g.A + (size_t)cur.pm * tstep; const char* cB = (const char*)g.Bt + (size_t)cur.pn * tstep;
    S.a_ready(cur);
    if constexpr (SP2) {
        PG8_STAGE(PG8_SB(0, 0), cB, voffB); PG8_STAGE(PG8_SB(0, 1), cB + hstep, voffB); PG8_STAGE(PG8_SA(0, 0), cA, voffA); PG8_STAGE(PG8_SA(0, 1), cA + hstep, voffA);
        if (wr == 1) PG8_BAR;
        PG8_WAIT_V(2); PG8_BAR;
        PG8_STAGE(PG8_SB(1, 0), cB + kstep, voffB); PG8_STAGE(PG8_SA(1, 0), cA + kstep, voffA); PG8_STAGE(PG8_SB(1, 1), cB + hstep + kstep, voffB);
        PG8_WAIT_V(6); PG8_BAR;
    } else {
        PG8_STAGE(PG8_SB(0, 0), cB, voffB); PG8_STAGE(PG8_SA(0, 0), cA, voffA); PG8_STAGE(PG8_SB(0, 1), cB + hstep, voffB); PG8_STAGE(PG8_SA(0, 1), cA + hstep, voffA);
        if (wr == 1) PG8_BAR;
        PG8_WAIT_V(4); PG8_BAR;
        PG8_STAGE(PG8_SB(1, 0), cB + kstep, voffB); PG8_STAGE(PG8_SA(1, 0), cA + kstep, voffA); PG8_STAGE(PG8_SB(1, 1), cB + hstep + kstep, voffB);
        PG8_WAIT_V(6); PG8_BAR;
    }
    for (;;) {
        const bool has_next = S.next(ui + 1, nxt);
        const char* nA = has_next ? (const char*)g.A + (size_t)nxt.pm * tstep : cA; const char* nB = has_next ? (const char*)g.Bt + (size_t)nxt.pn * tstep : cB;
        for (int t = 0; t < nt; t += 2) {
            const bool last = (t == nt - 2);
            const char* a1 = cA + (size_t)(t + 1) * kstep;
            const char* a2 = last ? nA : cA + (size_t)(t + 2) * kstep; const char* b2 = last ? nB : cB + (size_t)(t + 2) * kstep;
            const char* a3 = a2 + kstep; const char* b3 = b2 + kstep;
            if (last && has_next) S.a_ready(nxt);
            if constexpr (SP2) {
            PG8_LDB(B0, 0, 0); PG8_LDB(B1, 0, 1); PG8_SCHED; PG8_LDA(At, 0, 0); PG8_STAGE(PG8_SA(1, 1), a1 + hstep, voffA);
            PG8_WAIT_V(8); PG8_WAIT_L(0); PG8_BAR; PG8_MMA(0, 0, At, B0); PG8_MMA(0, 1, At, B1); PG8_BAR; PG8_SCHED;
            PG8_LDA(At, 0, 1); PG8_STAGE(PG8_SB(0, 0), b2, voffB); PG8_STAGE(PG8_SB(0, 1), b2 + hstep, voffB); PG8_STAGE(PG8_SA(0, 0), a2, voffA);
            PG8_WAIT_V(8); PG8_WAIT_L(0); PG8_BAR; PG8_MMA(1, 0, At, B0); PG8_MMA(1, 1, At, B1); PG8_BAR; PG8_SCHED;
            PG8_LDB(B0, 1, 0); PG8_LDB(B1, 1, 1); PG8_SCHED; PG8_LDA(At, 1, 0); PG8_STAGE(PG8_SA(0, 1), a2 + hstep, voffA);
            PG8_WAIT_V(8); PG8_WAIT_L(0); PG8_BAR; PG8_MMA(0, 0, At, B0); PG8_MMA(0, 1, At, B1); PG8_BAR; PG8_SCHED;
            PG8_LDA(At, 1, 1); PG8_STAGE(PG8_SB(1, 0), b3, voffB); PG8_STAGE(PG8_SB(1, 1), b3 + hstep, voffB); PG8_STAGE(PG8_SA(1, 0), a3, voffA);
            PG8_WAIT_V(8); PG8_WAIT_L(0); PG8_BAR; PG8_MMA(1, 0, At, B0); PG8_MMA(1, 1, At, B1); PG8_BAR; PG8_SCHED;
            } else {
            PG8_LDB(B0, 0, 0); PG8_SCHED; PG8_LDA(At, 0, 0); PG8_STAGE(PG8_SA(1, 1), a1 + hstep, voffA);
            PG8_WAIT_L(8); PG8_BAR; PG8_WAIT_L(0); PG8_MMA(0, 0, At, B0); PG8_BAR; PG8_SCHED;
            PG8_LDB(B1, 0, 1); PG8_STAGE(PG8_SB(0, 0), b2, voffB);
            PG8_BAR; PG8_WAIT_L(0); PG8_MMA(0, 1, At, B1); PG8_BAR;
            PG8_LDA(At, 0, 1); PG8_STAGE(PG8_SA(0, 0), a2, voffA);
            PG8_BAR; PG8_WAIT_L(0); PG8_MMA(1, 0, At, B0); PG8_BAR; PG8_SCHED;
            PG8_STAGE(PG8_SB(0, 1), b2 + hstep, voffB);
            PG8_WAIT_V(6); PG8_BAR; PG8_MMA(1, 1, At, B1); PG8_BAR;
            PG8_LDB(B0, 1, 0); PG8_SCHED; PG8_LDA(At, 1, 0); PG8_STAGE(PG8_SA(0, 1), a2 + hstep, voffA);
            PG8_WAIT_L(8); PG8_BAR; PG8_WAIT_L(0); PG8_MMA(0, 0, At, B0); PG8_BAR; PG8_SCHED;
            PG8_LDB(B1, 1, 1); PG8_STAGE(PG8_SB(1, 0), b3, voffB);
            PG8_BAR; PG8_WAIT_L(0); PG8_MMA(0, 1, At, B1); PG8_BAR;
            PG8_LDA(At, 1, 1); PG8_STAGE(PG8_SA(1, 0), a3, voffA);
            PG8_BAR; PG8_WAIT_L(0); PG8_MMA(1, 0, At, B0); PG8_BAR; PG8_SCHED;
            PG8_STAGE(PG8_SB(1, 1), b3 + hstep, voffB);
            PG8_WAIT_V(6); PG8_BAR; PG8_MMA(1, 1, At, B1); PG8_BAR;
            }
        }
        if constexpr (ALIGN_EPI) { if (wr == 0) PG8_BAR; }
        if constexpr (!Epi::AFTER_DRAIN) { E(acc, cur, wr, wc, fr, fq); S.done(cur); }
        if (!has_next) break;
#pragma unroll
        for (int a = 0; a < 2; ++a)
#pragma unroll
            for (int b = 0; b < 2; ++b)
#pragma unroll
                for (int m = 0; m < 4; ++m)
#pragma unroll
                    for (int n = 0; n < 2; ++n) acc[a][b][m][n] = (f32x4){0.f, 0.f, 0.f, 0.f};
        cur = nxt; cA = nA; cB = nB; ++ui;
        if constexpr (ALIGN_EPI) { if (wr == 1) PG8_BAR; }
    }
    PG8_WAIT_V(0);
    if constexpr (!ALIGN_EPI) { if (wr == 0) PG8_BAR; }
    PG8_BAR;
    if constexpr (Epi::AFTER_DRAIN) { E.fused(acc, cur, wr, wc, fr, fq, lds, wid, lane); S.done(cur); }
#undef PG8_SA
#undef PG8_SB
#undef PG8_STAGE
#undef PG8_LDA
#undef PG8_LDB
#undef PG8_MMA
#undef PG8_WAIT_V
#undef PG8_WAIT_L
#undef PG8_BAR
#undef PG8_SCHED
}
}

using pg8::sigmoid_f;
constexpr int NWAVES = 8, NTHR = 512;
constexpr int S = 8192, DM = 2048, DEPTH = 4, FF = 5632;
constexpr int NPROJ = 16896, NPROJ_PAD = 17152, LPROJ = 16976;
constexpr int PC_AQ = 0, PC_AK = 1024, PC_AV = 2048, PC_IQ = 3072, PC_MQ = 3584, PC_MK = 4096, PC_MV = 4608, PC_MO = 5632, PC_RQ = 6656, PC_RK = 7680, PC_RV = 8704, PC_RG = 9728, PC_G = 10752;
constexpr int LC_IK = 3584, LC_IW = 3648, LC_MI = 5704, LC_MF = 5708;
constexpr float NORM_EPS = 1e-6f;
constexpr size_t MiB = 1u << 20;
constexpr size_t WS_CTL = 0, CTL_ZERO_BYTES = 1 * MiB;
constexpr size_t WS_ROPE128 = 2 * MiB, WS_ROPE64 = 6 * MiB;
constexpr size_t WS_W = 16 * MiB, W_LAYER = 153 * MiB;
constexpr size_t WO_IN = 0, WO_B = 67 * MiB, WO_OUT = 79 * MiB, WO_FIN = 87 * MiB, WO_FOUT = 131 * MiB;
constexpr size_t WS_H = 640 * MiB, WS_PROJ = 672 * MiB, WS_SMALL = 936 * MiB, WS_MQK = 944 * MiB, WS_IKB = 960 * MiB, WS_IWF = 961 * MiB, WS_GIF = WS_IWF + 512 * 1024;
constexpr size_t WS_SC = 964 * MiB, WS_MB = 1220 * MiB, WS_DCM = 1228 * MiB, WS_CPM = 1260 * MiB, WS_MISC = 1292 * MiB, WS_DRR = 1294 * MiB, WS_RPR = 1310 * MiB;
constexpr size_t WS_YA = 1328 * MiB, WS_YM = 1344 * MiB, WS_YR = 1360 * MiB, WS_MERGEDF = 1376 * MiB, WS_MERGED = 1440 * MiB, WS_ACT = 1472 * MiB, WS_YP = 1560 * MiB  , WS_END = 1592 * MiB;
constexpr size_t WS_X16 = WS_MERGEDF + 32 * MiB;
constexpr size_t MISC_DN = 0, MISC_NPREV = 256 * 1024, MISC_AB = 512 * 1024, MISC_MPREV = 520 * 1024;
constexpr int CW_BAR = 4096;
constexpr int LDS_BYTES = 147456, MISC_OFF = 147456 - 1024;

#define GAS __attribute__((address_space(1)))
#define LAS __attribute__((address_space(3)))
typedef unsigned short bf16;
typedef unsigned v4u __attribute__((ext_vector_type(4)));
typedef unsigned v2u __attribute__((ext_vector_type(2)));
typedef float f32x4 __attribute__((ext_vector_type(4)));
typedef float f32x16 __attribute__((ext_vector_type(16)));
typedef short bf16x8 __attribute__((ext_vector_type(8)));
typedef short s16x4 __attribute__((ext_vector_type(4)));
#define LDS_WAIT() asm volatile("s_waitcnt lgkmcnt(0)" ::: "memory")
#define VM_WAIT() asm volatile("s_waitcnt vmcnt(0)" ::: "memory")
__device__ __forceinline__ unsigned f2bf(float f) { unsigned u = __builtin_bit_cast(unsigned, f); return (u + 0x7fffu + ((u >> 16) & 1u)) >> 16; }
__device__ __forceinline__ unsigned pk2(float lo, float hi) { return f2bf(lo) | (f2bf(hi) << 16); }
__device__ __forceinline__ float bf2f(bf16 b) { return __uint_as_float(((unsigned)b) << 16); }
template <int CTRL, int RMASK, int BMASK> __device__ __forceinline__ float dpp_f(float old, float src) { return __builtin_bit_cast(float, __builtin_amdgcn_update_dpp(__builtin_bit_cast(int, old), __builtin_bit_cast(int, src), CTRL, RMASK, BMASK, false)); }
template <int CTRL, int RMASK, int BMASK> __device__ __forceinline__ unsigned dpp_u(unsigned src) { return (unsigned)__builtin_amdgcn_update_dpp(0, (int)src, CTRL, RMASK, BMASK, false); }
__device__ __forceinline__ float wave_sum(float x) {
    x += dpp_f<0xB1, 0xf, 0xf>(0.f, x); x += dpp_f<0x4E, 0xf, 0xf>(0.f, x); x += dpp_f<0x141, 0xf, 0xf>(0.f, x); x += dpp_f<0x140, 0xf, 0xf>(0.f, x);
    x += dpp_f<0x142, 0xa, 0xf>(0.f, x); x += dpp_f<0x143, 0xc, 0xf>(0.f, x);
    return __builtin_bit_cast(float, __builtin_amdgcn_readlane(__builtin_bit_cast(int, x), 63)); }
__device__ __forceinline__ float wave_max(float x) {
    x = fmaxf(x, dpp_f<0xB1, 0xf, 0xf>(x, x)); x = fmaxf(x, dpp_f<0x4E, 0xf, 0xf>(x, x)); x = fmaxf(x, dpp_f<0x141, 0xf, 0xf>(x, x)); x = fmaxf(x, dpp_f<0x140, 0xf, 0xf>(x, x));
    x = fmaxf(x, dpp_f<0x142, 0xa, 0xf>(x, x)); x = fmaxf(x, dpp_f<0x143, 0xc, 0xf>(x, x));
    return __builtin_bit_cast(float, __builtin_amdgcn_readlane(__builtin_bit_cast(int, x), 63)); }
__device__ __forceinline__ unsigned lane_id_v() { unsigned l; asm volatile("v_mbcnt_lo_u32_b32 %0, -1, 0\n\tv_mbcnt_hi_u32_b32 %0, -1, %0" : "=v"(l)); return l; }
__device__ __forceinline__ int my_tid() {
    const unsigned slot = (unsigned)__builtin_amdgcn_s_getreg((5 << 11) | 4) & 63u;
    extern __shared__ __attribute__((aligned(16))) unsigned char lds_raw_t[];
    const unsigned wv = ((volatile LAS unsigned*)((LAS unsigned char*)lds_raw_t + MISC_OFF))[64 + slot];
    return (int)(__builtin_amdgcn_readfirstlane(wv) * 64u + lane_id_v());
}
__device__ __forceinline__ float shfl_idx_f(float x, int src_lane) { return __builtin_bit_cast(float, __builtin_amdgcn_ds_bpermute(src_lane << 2, __builtin_bit_cast(int, x))); }
__device__ __forceinline__ float wave_prefix_sum_f(float x) {
    float y = x + dpp_f<0x111, 0xf, 0xf>(0.f, x); y += dpp_f<0x112, 0xf, 0xf>(0.f, x); y += dpp_f<0x113, 0xf, 0xf>(0.f, x);
    y += dpp_f<0x114, 0xf, 0xe>(0.f, y); y += dpp_f<0x118, 0xf, 0xc>(0.f, y); y += dpp_f<0x142, 0xa, 0xf>(0.f, y); y += dpp_f<0x143, 0xc, 0xf>(0.f, y); return y; }
__device__ __forceinline__ float wave_prefix_max_f(float x) {
    const float N = -3.0e38f;
    float y = fmaxf(x, dpp_f<0x111, 0xf, 0xf>(N, x)); y = fmaxf(y, dpp_f<0x112, 0xf, 0xf>(N, x)); y = fmaxf(y, dpp_f<0x113, 0xf, 0xf>(N, x));
    y = fmaxf(y, dpp_f<0x114, 0xf, 0xe>(N, y)); y = fmaxf(y, dpp_f<0x118, 0xf, 0xc>(N, y)); y = fmaxf(y, dpp_f<0x142, 0xa, 0xf>(N, y)); y = fmaxf(y, dpp_f<0x143, 0xc, 0xf>(N, y)); return y; }
#define XB_TMO      128
#define XB_XCNT(j)  (256  + 64 * (j))
#define XB_XSUB(j)  (1280 + 64 * (j))
#define XB_XGEN(j)  (2304 + 64 * (j))
#define XB_TOP      3328
#define XB_TOPGEN   3392
#define XCD_BAR_WORDS 3456
#define XB_SPIN_CAP (1u << 18)

__device__ __forceinline__ unsigned xb_ld(unsigned* p)              { return __hip_atomic_load(p, __ATOMIC_RELAXED, __HIP_MEMORY_SCOPE_AGENT); }
__device__ __forceinline__ unsigned xb_add(unsigned* p, unsigned v) { return __hip_atomic_fetch_add(p, v, __ATOMIC_RELAXED, __HIP_MEMORY_SCOPE_AGENT); }
__device__ __forceinline__ unsigned xb_xcc_id() { return (unsigned)__builtin_amdgcn_s_getreg((3 << 11) | 20) & 0xFu; }
#define XB_SPIN(cond, bar) do { unsigned _sp = 0; while (cond) { __builtin_amdgcn_s_sleep(1); \
    if ((++_sp & 255u) == 0u) { if (xb_ld(&(bar)[XB_TMO])) break; if (_sp > XB_SPIN_CAP) { atomicAdd(&(bar)[XB_TMO], 1u); break; } } } } while (0)

struct XcdBarrier {
    unsigned* bar; unsigned x;
    volatile LAS unsigned* st;
};

__device__ __forceinline__ XcdBarrier xcd_barrier_post(unsigned* bar, volatile LAS unsigned* st) {
    XcdBarrier b; b.bar = bar; b.x = xb_xcc_id(); b.st = st;
    if (my_tid() == 0) (void)xb_add(&bar[XB_XCNT(b.x)], 1u);
    return b;
}
__device__ __forceinline__ void xcd_barrier_complete(unsigned* bar, unsigned x, unsigned& nloc, unsigned& nx) {
    const unsigned G = gridDim.x * gridDim.y * gridDim.z;
    unsigned sum, cnt, mine, sp = 0u;
    for (;;) {
        sum = 0u; cnt = 0u; mine = 0u;
#pragma unroll
        for (unsigned j = 0; j < 16; ++j) { const unsigned c = xb_ld(&bar[XB_XCNT(j)]); sum += c; cnt += (c > 0u) ? 1u : 0u; mine = (j == x) ? c : mine; }
        if (sum == G) break;
        __builtin_amdgcn_s_sleep(1);
        if ((++sp & 255u) == 0u) { if (xb_ld(&bar[XB_TMO])) break; if (sp > XB_SPIN_CAP) { atomicAdd(&bar[XB_TMO], 1u); break; } }
    }
    nloc = mine > 0u ? mine : 1u; nx = cnt > 0u ? cnt : 1u;
}

__device__ __forceinline__ void xcd_barrier(const XcdBarrier& b) {
    asm volatile("s_waitcnt vmcnt(0)" ::: "memory");
    __syncthreads();
    if (my_tid() == 0) {
        unsigned* bar = b.bar;
        __builtin_amdgcn_s_waitcnt(0);
        unsigned nloc = b.st[0], nx = b.st[1];
        if (nloc == 0u) { xcd_barrier_complete(bar, b.x, nloc, nx); b.st[0] = nloc; b.st[1] = nx; }
        const unsigned old = xb_add(&bar[XB_XSUB(b.x)], 1u);
        const unsigned gen = old / nloc;
        if (old + 1u == (gen + 1u) * nloc) {
            __builtin_amdgcn_fence(__ATOMIC_RELEASE, "agent");
            asm volatile("s_waitcnt vmcnt(0)" ::: "memory");
            const unsigned og = xb_add(&bar[XB_TOP], 1u);
            const unsigned tg = og / nx;
            if (og + 1u == (tg + 1u) * nx) xb_add(&bar[XB_TOPGEN], 1u);
            else XB_SPIN(xb_ld(&bar[XB_TOPGEN]) == tg, bar);
            __builtin_amdgcn_fence(__ATOMIC_ACQUIRE, "agent");
            xb_add(&bar[XB_XGEN(b.x)], 1u);
            asm volatile("s_waitcnt vmcnt(0)" ::: "memory");
        } else {
            XB_SPIN(xb_ld(&bar[XB_XGEN(b.x)]) == gen, bar);
            __builtin_amdgcn_fence(__ATOMIC_ACQUIRE, "agent");
            asm volatile("s_waitcnt vmcnt(0)" ::: "memory");
        }
    }
    __syncthreads();
}

struct MapIdent { __device__ __forceinline__ int operator()(int p) const { return p; } };
struct MapWin { __device__ __forceinline__ int operator()(int p) const {
    if (p < 3584) return p; if (p < 5632) return p + 72; if (p < NPROJ) return p + 80;
    const int r = p - NPROJ; if (r < 64) return LC_IK + r; if (r < 72) return LC_IW + (r - 64); if (r < 76) return LC_MI + (r - 72); if (r < 80) return LC_MF + (r - 76); return -1; } };
struct MapFfn { __device__ __forceinline__ int operator()(int p) const { const int t = p >> 8, r = p & 255; return r < 128 ? 128 * t + r : FF + 128 * t + (r - 128); } };
template <class Map> __device__ __forceinline__ void transpose_item(const float* W, int K, int N, bf16* WT, LAS float* scr, int item, int nblk, int lane, const Map& map) {
    const int kb = item / nblk, nb = item % nblk, k0 = 64 * kb, p0 = 64 * nb;
    const int n4 = lane & 15, kr = lane >> 4, nl = map(p0 + 4 * n4);
    f32x4 v[16];
#pragma unroll
    for (int i = 0; i < 16; ++i) v[i] = nl >= 0 ? *(const GAS f32x4*)(W + (size_t)(k0 + kr + 4 * i) * N + nl) : (f32x4){0.f, 0.f, 0.f, 0.f};
#pragma unroll
    for (int i = 0; i < 16; ++i) { LAS float* d = scr + (kr + 4 * i) * 65 + 4 * n4; d[0] = v[i][0]; d[1] = v[i][1]; d[2] = v[i][2]; d[3] = v[i][3]; }
    LDS_WAIT(); asm volatile("" ::: "memory");
    const int c = lane & 7;
#pragma unroll
    for (int j = 0; j < 8; ++j) { const int n = (lane >> 3) + 8 * j; const LAS float* s = scr + (8 * c) * 65 + n;
        v4u o; o.x = pk2(s[0 * 65], s[1 * 65]); o.y = pk2(s[2 * 65], s[3 * 65]); o.z = pk2(s[4 * 65], s[5 * 65]); o.w = pk2(s[6 * 65], s[7 * 65]);
        *(GAS v4u*)(WT + (size_t)(p0 + n) * K + k0 + 8 * c) = o; }
    LDS_WAIT(); asm volatile("" ::: "memory");
}
template <class Map> __device__ __forceinline__ void transpose_matrix(const float* W, int K, int N, int Nphys, bf16* WT, LAS float* scr, int gw, int ngw, int lane, const Map& map) {
    const int nblk = Nphys / 64, nit = (K / 64) * nblk;
    for (int it = gw; it < nit; it += ngw) transpose_item(W, K, N, WT, scr, it, nblk, lane, map);
}

__device__ __forceinline__ void bf8_unpack0(const v4u w, float (&f)[8]) { f[0] = __uint_as_float(w.x << 16); f[1] = __uint_as_float(w.x & 0xffff0000u); f[2] = __uint_as_float(w.y << 16); f[3] = __uint_as_float(w.y & 0xffff0000u);
    f[4] = __uint_as_float(w.z << 16); f[5] = __uint_as_float(w.z & 0xffff0000u); f[6] = __uint_as_float(w.w << 16); f[7] = __uint_as_float(w.w & 0xffff0000u); }
__device__ __forceinline__ void rms_row16_to_bf16(const bf16* xrow, const float* gain, bf16* orow, int lane) {
    float v[4][8]; float s = 0.f;
#pragma unroll
    for (int j = 0; j < 4; ++j) { bf8_unpack0(*((const GAS v4u*)xrow + lane + 64 * j), v[j]);
#pragma unroll
        for (int i = 0; i < 8; ++i) s += v[j][i] * v[j][i]; }
    const float rstd = 1.0f / sqrtf(wave_sum(s) * (1.f / DM) + NORM_EPS);
#pragma unroll
    for (int j = 0; j < 4; ++j) { const f32x4 ga = *(const f32x4*)(gain + 8 * (lane + 64 * j)), gb = *(const f32x4*)(gain + 8 * (lane + 64 * j) + 4); v4u o;
        o.x = pk2(v[j][0] * rstd * ga[0], v[j][1] * rstd * ga[1]); o.y = pk2(v[j][2] * rstd * ga[2], v[j][3] * rstd * ga[3]); o.z = pk2(v[j][4] * rstd * gb[0], v[j][5] * rstd * gb[1]); o.w = pk2(v[j][6] * rstd * gb[2], v[j][7] * rstd * gb[3]);
        *((GAS v4u*)orow + lane + 64 * j) = o; }
}
__device__ __forceinline__ void rms_row_to_bf16(const float* xrow, const float* gain, bf16* orow, int lane) {
    const GAS f32x4* xr = (const GAS f32x4*)xrow + lane; const GAS f32x4* gr = (const GAS f32x4*)gain + lane;
    f32x4 v[8]; float s = 0.f;
#pragma unroll
    for (int j = 0; j < 8; ++j) { v[j] = xr[64 * j]; s += (v[j].x * v[j].x + v[j].y * v[j].y) + (v[j].z * v[j].z + v[j].w * v[j].w); }
    const float rstd = 1.0f / sqrtf(wave_sum(s) * (1.f / DM) + NORM_EPS);
    GAS unsigned long long* o8 = (GAS unsigned long long*)orow + lane;
#pragma unroll
    for (int j = 0; j < 8; ++j) { const f32x4 g = gr[64 * j]; o8[64 * j] = (unsigned long long)pk2(v[j].x * rstd * g.x, v[j].y * rstd * g.y) | ((unsigned long long)pk2(v[j].z * rstd * g.z, v[j].w * rstd * g.w) << 32); }
}

struct PPArgs { bf16* proj; const float* small; bf16* mqk; bf16* ikb; unsigned char* sgn; float* gif; const float* rope128; const float* rope64; const float* gq; const float* gk; const float* convw; const float* gbias; };
__device__ __forceinline__ void bf8_unpack(const v4u w, float (&f)[8]) { f[0] = __uint_as_float(w.x << 16); f[1] = __uint_as_float(w.x & 0xffff0000u); f[2] = __uint_as_float(w.y << 16); f[3] = __uint_as_float(w.y & 0xffff0000u);
    f[4] = __uint_as_float(w.z << 16); f[5] = __uint_as_float(w.z & 0xffff0000u); f[6] = __uint_as_float(w.w << 16); f[7] = __uint_as_float(w.w & 0xffff0000u); }
__device__ __forceinline__ v4u bf8_pack(const float (&f)[8]) { v4u o; o.x = pk2(f[0], f[1]); o.y = pk2(f[2], f[3]); o.z = pk2(f[4], f[5]); o.w = pk2(f[6], f[7]); return o; }
__device__ __forceinline__ float sum8_dpp(float x) {
    x += dpp_f<0xB1, 0xf, 0xf>(0.f, x); x += dpp_f<0x4E, 0xf, 0xf>(0.f, x); x += dpp_f<0x141, 0xf, 0xf>(0.f, x); return x; }
__device__ __forceinline__ void pp_row(const PPArgs& a, int t, int lane, const f32x4 (&cw)[16]) {
    bf16* pr = a.proj + (size_t)t * NPROJ;
    const int hd = lane >> 3, d0 = (lane & 7) * 8;
    float cs[8], sn[8];
#pragma unroll
    for (int i = 0; i < 4; ++i) { const f32x4 c = *(const f32x4*)(a.rope128 + ((size_t)t * 64 + d0 + 2 * i) * 2); cs[2 * i] = c[0]; sn[2 * i] = c[1]; cs[2 * i + 1] = c[2]; sn[2 * i + 1] = c[3]; }
#pragma unroll
    for (int seg = 0; seg < 4; ++seg) {
        const int base = seg == 0 ? PC_AQ : (seg == 1 ? PC_AK : (seg == 2 ? PC_RQ : PC_RK));
        bf16* p = pr + base + hd * 128 + d0; float x1[8], x2[8];
        bf8_unpack(*(const GAS v4u*)p, x1); bf8_unpack(*(const GAS v4u*)(p + 64), x2);
        if (seg < 2) { const float* gn = seg ? a.gk : a.gq; float ss = 0.f;
#pragma unroll
            for (int i = 0; i < 8; ++i) ss += x1[i] * x1[i] + x2[i] * x2[i];
            const float rstd = 1.0f / sqrtf(sum8_dpp(ss) * (1.f / 128.f) + NORM_EPS);
            const f32x4 ga = *(const f32x4*)(gn + d0), gb = *(const f32x4*)(gn + d0 + 4), gc = *(const f32x4*)(gn + 64 + d0), gd = *(const f32x4*)(gn + 64 + d0 + 4);
#pragma unroll
            for (int i = 0; i < 4; ++i) { x1[i] *= rstd * ga[i]; x1[4 + i] *= rstd * gb[i]; x2[i] *= rstd * gc[i]; x2[4 + i] *= rstd * gd[i]; } }
        float o1[8], o2[8];
#pragma unroll
        for (int i = 0; i < 8; ++i) { o1[i] = x1[i] * cs[i] - x2[i] * sn[i]; o2[i] = x2[i] * cs[i] + x1[i] * sn[i]; }
        *(GAS v4u*)p = bf8_pack(o1); *(GAS v4u*)(p + 64) = bf8_pack(o2); }
    const float* sm = a.small + (size_t)t * 256;
    {
        const int e0 = (lane & 7) * 4; const f32x4 ca = *(const f32x4*)(a.rope64 + ((size_t)t * 32 + e0) * 2), cb = *(const f32x4*)(a.rope64 + ((size_t)t * 32 + e0 + 2) * 2);
        const float c4[4] = {ca[0], ca[2], cb[0], cb[2]}, s4[4] = {ca[1], ca[3], cb[1], cb[3]};
        bf16* p = pr + PC_IQ + hd * 64 + e0; const v2u lo = *(const GAS v2u*)p, hi = *(const GAS v2u*)(p + 32);
        const float aw = fabsf(sm[64 + hd]) * (0.35355339059327373f * 0.125f);
        const float y1[4] = {__uint_as_float(lo.x << 16), __uint_as_float(lo.x & 0xffff0000u), __uint_as_float(lo.y << 16), __uint_as_float(lo.y & 0xffff0000u)};
        const float y2[4] = {__uint_as_float(hi.x << 16), __uint_as_float(hi.x & 0xffff0000u), __uint_as_float(hi.y << 16), __uint_as_float(hi.y & 0xffff0000u)};
        float q1[4], q2[4];
#pragma unroll
        for (int i = 0; i < 4; ++i) { q1[i] = (y1[i] * c4[i] - y2[i] * s4[i]) * aw; q2[i] = (y2[i] * c4[i] + y1[i] * s4[i]) * aw; }
        v2u w1, w2; w1.x = pk2(q1[0], q1[1]); w1.y = pk2(q1[2], q1[3]); w2.x = pk2(q2[0], q2[1]); w2.y = pk2(q2[2], q2[3]);
        *(GAS v2u*)p = w1; *(GAS v2u*)(p + 32) = w2;
        if (lane < 8) { const f32x4 k1 = *(const f32x4*)(sm + e0), k2 = *(const f32x4*)(sm + 32 + e0); float r1[4], r2[4];
#pragma unroll
            for (int i = 0; i < 4; ++i) { r1[i] = k1[i] * c4[i] - k2[i] * s4[i]; r2[i] = k2[i] * c4[i] + k1[i] * s4[i]; }
            v2u u1, u2; u1.x = pk2(r1[0], r1[1]); u1.y = pk2(r1[2], r1[3]); u2.x = pk2(r2[0], r2[1]); u2.y = pk2(r2[2], r2[3]);
            *(GAS v2u*)(a.ikb + (size_t)t * 64 + e0) = u1; *(GAS v2u*)(a.ikb + (size_t)t * 64 + 32 + e0) = u2; } }
    { const unsigned long long nb = __builtin_amdgcn_ballot_w64(lane < 8 && sm[64 + (lane & 7)] < 0.f); if (lane == 0) a.sgn[t] = (unsigned char)(nb & 0xffull); }
    if (lane < 8) a.gif[(size_t)t * 8 + lane] = sm[72 + lane] + a.gbias[lane];
    {
        float acc[16];
#pragma unroll
        for (int i = 0; i < 16; ++i) acc[i] = 0.f;
#pragma unroll
        for (int j = 0; j < 4; ++j) { const int tt = t - 3 + j; if (tt >= 0) { const bf16* xp = a.proj + (size_t)tt * NPROJ + PC_MQ + 16 * lane; float xa[8], xb[8];
                bf8_unpack(*(const GAS v4u*)xp, xa); bf8_unpack(*(const GAS v4u*)(xp + 8), xb);
#pragma unroll
                for (int i = 0; i < 4; ++i) { acc[i] += cw[j * 4][i] * xa[i]; acc[4 + i] += cw[j * 4 + 1][i] * xa[4 + i]; acc[8 + i] += cw[j * 4 + 2][i] * xb[i]; acc[12 + i] += cw[j * 4 + 3][i] * xb[4 + i]; } } }
        float oa[8], ob[8];
#pragma unroll
        for (int i = 0; i < 8; ++i) { oa[i] = acc[i]; ob[i] = acc[8 + i]; }
        bf16* mp = a.mqk + (size_t)t * 1024 + 16 * lane; *(GAS v4u*)mp = bf8_pack(oa); *(GAS v4u*)(mp + 8) = bf8_pack(ob); }
}

constexpr int SCT_RS = 144, IQT_RS = 1040, IQT_BYTES = 32 * IQT_RS;
__device__ __forceinline__ void score_wave_unit(LAS unsigned char* wt, const LAS unsigned char* iqt, const bf16* ikb, const unsigned char* sgn, unsigned short* sc, int qb, int kb, int lane) {
    const int r = lane & 31, h = lane >> 5, q0 = qb * 32, s0 = kb * 64;
    bf16x8 ka[2][4];
#pragma unroll
    for (int b = 0; b < 2; ++b)
#pragma unroll
        for (int kk = 0; kk < 4; ++kk) ka[b][kk] = *(const bf16x8*)(ikb + (size_t)(s0 + 32 * b + r) * 64 + 16 * kk + 8 * h);
    const LAS unsigned char* qrow = iqt + r * IQT_RS + 16 * h;
    const unsigned sb = sgn[q0 + r];
    f32x16 scv[2];
#pragma unroll
    for (int b = 0; b < 2; ++b)
#pragma unroll
        for (int e = 0; e < 16; ++e) scv[b][e] = 0.f;
#pragma unroll 2
    for (int j = 0; j < 8; ++j) { bf16x8 qf[4];
#pragma unroll
        for (int kk = 0; kk < 4; ++kk) qf[kk] = *(const LAS bf16x8*)(qrow + j * 128 + kk * 32);
        const float sj = ((sb >> j) & 1u) ? -1.0f : 1.0f;
#pragma unroll
        for (int b = 0; b < 2; ++b) { f32x16 acc;
#pragma unroll
            for (int e = 0; e < 16; ++e) acc[e] = 0.f;
#pragma unroll
            for (int kk = 0; kk < 4; ++kk) acc = __builtin_amdgcn_mfma_f32_32x32x16_bf16(ka[b][kk], qf[kk], acc, 0, 0, 0);
#pragma unroll
            for (int e = 0; e < 16; ++e) scv[b][e] = fmaf(fmaxf(acc[e], 0.f), sj, scv[b][e]); } }
#pragma unroll
    for (int b = 0; b < 2; ++b)
#pragma unroll
        for (int g = 0; g < 4; ++g) { v2u hw; hw.x = __builtin_bit_cast(unsigned, __builtin_amdgcn_cvt_pkrtz(scv[b][4 * g], scv[b][4 * g + 1])); hw.y = __builtin_bit_cast(unsigned, __builtin_amdgcn_cvt_pkrtz(scv[b][4 * g + 2], scv[b][4 * g + 3]));
            *(LAS v2u*)(wt + r * SCT_RS + (32 * b + 8 * g + 4 * h) * 2) = hw; }
#pragma unroll
    for (int k = 0; k < 4; ++k) { const int row = 8 * k + (lane >> 3), c8 = (lane & 7) * 8;
        const v4u x = *(const LAS v4u*)(wt + row * SCT_RS + c8 * 2);
        *(GAS v4u*)(sc + (size_t)(q0 + row) * S + s0 + c8) = x; }
}


__device__ __forceinline__ float wave_max_dpp(float x) { return wave_max(x); }
__device__ __forceinline__ float wave_min_dpp(float x) { return -wave_max_dpp(-x); }
__device__ __forceinline__ unsigned wave_prefix_dpp(unsigned x) {
    unsigned y = x + dpp_u<0x111, 0xf, 0xf>(x); y += dpp_u<0x112, 0xf, 0xf>(x); y += dpp_u<0x113, 0xf, 0xf>(x);
    y += dpp_u<0x114, 0xf, 0xe>(y); y += dpp_u<0x118, 0xf, 0xc>(y); y += dpp_u<0x142, 0xa, 0xf>(y); y += dpp_u<0x143, 0xc, 0xf>(y);
    return y; }
#define SEL_BAR() do { asm volatile("s_waitcnt lgkmcnt(0)" ::: "memory"); __builtin_amdgcn_s_barrier(); asm volatile("" ::: "memory"); } while (0)
#define SEL_ROW(i) ((i) < n0 ? row0 + (i) * rstep : xrow0 + ((i) - n0) * xstep)
#ifndef PROBE_MASK
#define PROBE_MASK 0
#endif
#define SEL_STAMP(k) do { if (PROBE_MASK != 0 && tid == 0) { const unsigned long long c_ = (unsigned long long)__builtin_readcyclecounter(); pacc[k] += c_ - plast; plast = c_; } } while (0)
__device__ __forceinline__ void select_rows_wg(LAS unsigned char* lds, const unsigned short* sc, unsigned long long* mb, int row0, int rstep, int n0, int xrow0, int xstep, int n1, int tid, unsigned long long* gacc) {
    unsigned long long pacc[8] = {0, 0, 0, 0, 0, 0, 0, 0}; unsigned long long plast = (PROBE_MASK != 0) ? (unsigned long long)__builtin_readcyclecounter() : 0ull; (void)pacc; (void)plast; (void)gacc;
    LAS unsigned* hist = (LAS unsigned*)lds;
    LAS unsigned* btot = hist + 2176;
    LAS float* red = (LAS float*)(hist + 2240); LAS unsigned* lcnt = hist + 2256;
    LAS float* lval = (LAS float*)(hist + 2272); LAS int* lidx = (LAS int*)(hist + 2272 + 8192);
    const int lane = tid & 63, w = tid >> 6;
    v2u nx[4];
#define SEL_LOAD(t_) do { const unsigned short* scr_ = sc + (size_t)(t_) * S + 4 * tid; _Pragma("unroll") for (int j = 0; j < 4; ++j) { if (2048 * j <= (t_)) nx[j] = *(const GAS v2u*)(scr_ + 2048 * j); else nx[j] = (v2u){0u, 0u}; } } while (0)
    const int nrows = n0 + n1;
    if (nrows > 0) SEL_LOAD(SEL_ROW(0));
    if (tid < 2) lcnt[tid] = 0u;
    for (int j = tid; j < 2240; j += NTHR) hist[j] = 0u;
    int par = 0;
    for (int ri = 0; ri < nrows; ++ri) { const int t = SEL_ROW(ri);
        float v[16];
#pragma unroll
        for (int j = 0; j < 4; ++j)
#pragma unroll
            for (int c = 0; c < 4; ++c) { const unsigned hb_ = ((c & 2) ? nx[j].y : nx[j].x) >> (16 * (c & 1)); const float sv_ = (float)__builtin_bit_cast(_Float16, (unsigned short)hb_);
                v[4 * j + c] = (2048 * j + 4 * tid + c <= t) ? sv_ : -3.0e38f; }
        if (ri + 1 < nrows) SEL_LOAD(SEL_ROW(ri + 1));
        if (PROBE_MASK != 0) { float d_ = 0.f; _Pragma("unroll") for (int i = 0; i < 16; ++i) d_ += v[i]; asm volatile("" :: "v"(d_)); } SEL_STAMP(0);
        unsigned long long* mbr = mb + (size_t)t * 128;
        bool sel[16];
        if (t >= 256) {
            const int ngrp = (t >> 11) + 1;
            float mn = 3.0e38f, mx = -3.0e38f;
#pragma unroll
            for (int i = 0; i < 16; ++i) { mx = fmaxf(mx, v[i]); mn = fminf(mn, (v[i] > -3.0e38f) ? v[i] : 3.0e38f); }
            mn = wave_min_dpp(mn); mx = wave_max_dpp(mx);
            if (lane == 0) { red[w] = mn; red[8 + w] = mx; }
            SEL_BAR();
            SEL_STAMP(1);
            mn = red[0]; mx = red[8];
#pragma unroll
            for (int j = 1; j < 8; ++j) { mn = fminf(mn, red[j]); mx = fmaxf(mx, red[8 + j]); }
            const float scale = (mx > mn) ? 2047.0f / (mx - mn) : 0.f;
            int bin[16];
#pragma unroll
            for (int i = 0; i < 16; ++i) { int b = (int)((v[i] - mn) * scale); b = b < 0 ? 0 : (b > 2047 ? 2047 : b); const bool ok = v[i] > -3.0e38f; bin[i] = ok ? b : -1;
                if ((i >> 2) < ngrp) { (void)__hip_atomic_fetch_add(hist + (ok ? b + (b >> 5) : 2112 + lane), 1u, __ATOMIC_RELAXED, __HIP_MEMORY_SCOPE_WORKGROUP);
                    (void)__hip_atomic_fetch_add(btot + (ok ? (b >> 5) : 0), ok ? 1u : 0u, __ATOMIC_RELAXED, __HIP_MEMORY_SCOPE_WORKGROUP); } }
            SEL_BAR();
            SEL_STAMP(2);
            const unsigned bt = btot[63 - lane]; const unsigned sufb = wave_prefix_dpp(bt);
            const unsigned long long ob = __builtin_amdgcn_ballot_w64(sufb >= 256u);
            const int olb = ob ? (int)__builtin_ctzll(ob) : 0; const int blk = 63 - olb;
            const unsigned above_blk = (unsigned)__builtin_amdgcn_readlane((int)(sufb - bt), olb);
            const unsigned hbn = (lane < 32) ? hist[33 * blk + 31 - lane] : 0u; const unsigned sufn = wave_prefix_dpp(hbn) + above_blk;
            const unsigned long long on = __builtin_amdgcn_ballot_w64(lane < 32 && sufn >= 256u);
            const int oln = on ? (int)__builtin_ctzll(on) : 0;
            const int bstar = 32 * blk + 31 - oln; const unsigned need = 256u - (unsigned)__builtin_amdgcn_readlane((int)(sufn - hbn), oln);
            { asm volatile("" :: "s"(bstar), "s"(need)); } SEL_STAMP(3);
#pragma unroll
            for (int i = 0; i < 16; ++i) if (bin[i] == bstar) { const unsigned k = __hip_atomic_fetch_add(lcnt + par, 1u, __ATOMIC_RELAXED, __HIP_MEMORY_SCOPE_WORKGROUP); lval[k] = v[i]; lidx[k] = 2048 * (i >> 2) + 4 * tid + (i & 3); }
            SEL_BAR();
            SEL_STAMP(4);
            const int nl = (int)lcnt[par];
#pragma unroll
            for (int i = 0; i < 16; ++i) { bool sl = bin[i] > bstar;
                if (bin[i] == bstar) { const float x = v[i]; const int s = 2048 * (i >> 2) + 4 * tid + (i & 3); unsigned rank = 0u;
                    for (int j = 0; j < nl; ++j) { const float y = lval[j]; const int sj = lidx[j]; rank += (y > x || (y == x && sj < s)) ? 1u : 0u; }
                    sl = rank < need; }
                sel[i] = sl; }
            SEL_STAMP(5);
            *(LAS v4u*)(hist + 4 * tid) = (v4u){0u, 0u, 0u, 0u}; if (tid < 48) *(LAS v4u*)(hist + 2048 + 4 * tid) = (v4u){0u, 0u, 0u, 0u};
            if (tid == 0) lcnt[par ^ 1] = 0u;
            par ^= 1;
        } else {
#pragma unroll
            for (int i = 0; i < 16; ++i) sel[i] = v[i] > -3.0e38f;
        }
#pragma unroll
        for (int j = 0; j < 4; ++j) { unsigned f[4];
#pragma unroll
            for (int c = 0; c < 4; ++c) { const unsigned long long b = __builtin_amdgcn_ballot_w64(sel[4 * j + c]); const unsigned src = (lane & 2) ? (unsigned)(b >> 32) : (unsigned)b; f[c] = (src >> (16 * (lane & 1))) & 0xffffu; }
            if (lane < 4) { v2u wd; wd.x = f[0] | (f[1] << 16); wd.y = f[2] | (f[3] << 16); *(GAS v2u*)(mbr + 32 * j + 4 * w + lane) = wd; } }
        SEL_STAMP(6);
    }
    if (PROBE_MASK != 0 && tid == 0) { _Pragma("unroll") for (int k = 0; k < 7; ++k) atomicAdd(gacc + k, pacc[k]); }
    SEL_BAR();
#undef SEL_LOAD
#undef SEL_ROW
}

template <int RS> __device__ __forceinline__ bf16x8 frag_row(const LAS unsigned char* base, int r0, int k0, int lane) {
    return *(const LAS bf16x8*)(base + (r0 + (lane & 15)) * RS + (k0 + 8 * (lane >> 4)) * 2);
}
template <int RS> __device__ __forceinline__ bf16x8 frag_tr(const LAS unsigned char* base, int k0, int c0, int lane) {
    const int g = lane >> 4, q = (lane & 15) >> 2, p = lane & 3;
    const unsigned a = (unsigned)(size_t)(base + (k0 + 8 * g + q) * RS + (c0 + 4 * p) * 2);
    s16x4 lo, hi;
    asm volatile("ds_read_b64_tr_b16 %0, %2\n\tds_read_b64_tr_b16 %1, %2 offset:%3\n\ts_waitcnt lgkmcnt(0)" : "=&v"(lo), "=&v"(hi) : "v"(a), "i"(4 * RS) : "memory");
    return (bf16x8){lo[0], lo[1], lo[2], lo[3], hi[0], hi[1], hi[2], hi[3]};
}
#define MFMA16(a, b, c) __builtin_amdgcn_mfma_f32_16x16x32_bf16((a), (b), (c), 0, 0, 0)
constexpr int SCR_OFF = 114688;
constexpr float DK_SCALE = 0.08838834764831845f;
__device__ __forceinline__ float log_sigmoid_f(float x) { return fminf(x, 0.f) - log1pf(expf(-fabsf(x))); }

template <int L, int DV, class Prep> __device__ __forceinline__ void chunk_delta(const Prep& prep, LAS unsigned char* lds, const bf16* ksrc, int ldk, const bf16* vsrc, int ldv, const LAS float* wcol, bf16* outT, float* dn, int tid) {
    constexpr int RSK = (128 + 8) * 2, RSV = (DV + 8) * 2, NCB = DV / 128;
    LAS unsigned char* KA = lds; LAS unsigned char* V = lds + L * RSK;
    const int lane = tid & 63, w = tid >> 6;
    constexpr int NK = L * 16 / NTHR, NV = L * (DV / 8) / NTHR; v4u rk[NK], rv[NV];
#pragma unroll
    for (int i = 0; i < NK; ++i) { const int idx = tid + i * NTHR, s = idx >> 4, c8 = idx & 15; rk[i] = *(const GAS v4u*)(ksrc + (size_t)s * ldk + c8 * 8); }
#pragma unroll
    for (int i = 0; i < NV; ++i) { const int idx = tid + i * NTHR, s = idx / (DV / 8), c8 = idx % (DV / 8); rv[i] = *(const GAS v4u*)(vsrc + (size_t)s * ldv + c8 * 8); }
    __builtin_amdgcn_sched_barrier(0);
    prep();
    __syncthreads();
#pragma unroll
    for (int i = 0; i < NK; ++i) { const int idx = tid + i * NTHR, s = idx >> 4, c8 = idx & 15; const v4u x = rk[i]; const float sc = DK_SCALE * wcol[s]; v4u o;
        o.x = pk2(__uint_as_float(x.x << 16) * sc, __uint_as_float(x.x & 0xffff0000u) * sc); o.y = pk2(__uint_as_float(x.y << 16) * sc, __uint_as_float(x.y & 0xffff0000u) * sc);
        o.z = pk2(__uint_as_float(x.z << 16) * sc, __uint_as_float(x.z & 0xffff0000u) * sc); o.w = pk2(__uint_as_float(x.w << 16) * sc, __uint_as_float(x.w & 0xffff0000u) * sc);
        *(LAS v4u*)(KA + s * RSK + c8 * 16) = o; }
#pragma unroll
    for (int i = 0; i < NV; ++i) { const int idx = tid + i * NTHR, s = idx / (DV / 8), c8 = idx % (DV / 8); *(LAS v4u*)(V + s * RSV + c8 * 16) = rv[i]; }
    __syncthreads();
    f32x4 acc[8][NCB];
#pragma unroll
    for (int db = 0; db < 8; ++db)
#pragma unroll
        for (int i = 0; i < NCB; ++i) acc[db][i] = (f32x4){0.f, 0.f, 0.f, 0.f};
#pragma unroll
    for (int kk = 0; kk < L / 32; ++kk) {
        bf16x8 bfr[NCB];
#pragma unroll
        for (int i = 0; i < NCB; ++i) bfr[i] = frag_tr<RSV>(V, 32 * kk, 16 * (w * NCB + i), lane);
#pragma unroll
        for (int db = 0; db < 8; ++db) { const bf16x8 a = frag_tr<RSK>(KA, 32 * kk, 16 * db, lane);
#pragma unroll
            for (int i = 0; i < NCB; ++i) acc[db][i] = MFMA16(a, bfr[i], acc[db][i]); }
    }
#pragma unroll
    for (int db = 0; db < 8; ++db)
#pragma unroll
        for (int i = 0; i < NCB; ++i) { const int e = 16 * (w * NCB + i) + (lane & 15), d0 = 16 * db + 4 * (lane >> 4);
            v2u o; o.x = pk2(acc[db][i][0], acc[db][i][1]); o.y = pk2(acc[db][i][2], acc[db][i][3]);
            *(GAS v2u*)(outT + (size_t)e * 128 + d0) = o; }
    if (dn != nullptr && tid < 128) { float s_ = 0.f;
        for (int s = 0; s < L; ++s) s_ += bf2f(*(const LAS bf16*)(KA + s * RSK + tid * 2));
        dn[tid] = s_; }
    __syncthreads();
}

template <int L, int DV, int MODE, class Prep> __device__ __forceinline__ void chunk_out(const Prep& prep, LAS unsigned char* lds, LAS float* sf, const bf16* qsrc, int ldq, const bf16* ksrc, int ldk, const bf16* vsrc, int ldv,
                                                                              const bf16* stT, const float* gain, const bf16* gate, int ldg, bf16* y, int ldy, int tid_in) {
    int tid = tid_in; asm volatile("" : "+v"(tid));
    constexpr int RSQ = (128 + 8) * 2, RSV = (DV + 8) * 2, RSP = (L + 8) * 2, NCB = DV / 128, NT = L / 16, TPW = NT * NT / 8;
    LAS unsigned char* Q = lds; LAS unsigned char* K = lds + L * RSQ; LAS unsigned char* V = lds + 2 * L * RSQ;
    LAS unsigned char* P = (MODE == 0) ? (lds + 2 * L * RSQ + L * RSV) : K;
    LAS float* H = (LAS float*)lds;
    LAS float* lrow = sf; LAS float* lcol = sf + 128; LAS float* qs = sf + 256; LAS float* flo = sf + 384; LAS float* rowsum = sf + 512; LAS float* npv = sf + 640; LAS float* part = sf + 768; LAS float* dpart = sf + 768 + L * NT;
    const int lane = tid & 63, w = tid >> 6, g4 = lane >> 4, c16 = lane & 15;
    constexpr int RPS = 256 / DV, NSTEP = L / (NWAVES * RPS);
    const int nsub = (RPS == 2) ? (lane >> 5) : 0, ne0 = 4 * ((RPS == 2) ? (lane & 31) : lane);
    bf16x8 stf[4][NCB];
#pragma unroll
    for (int kk = 0; kk < 4; ++kk)
#pragma unroll
        for (int i = 0; i < NCB; ++i) stf[kk][i] = *(const GAS bf16x8*)(stT + (size_t)(16 * (w * NCB + i) + c16) * 128 + 32 * kk + 8 * g4);
    constexpr int NQ = L * 16 / NTHR, NV = L * (DV / 8) / NTHR; v4u rq[NQ], rk[NQ], rv[NV];
#pragma unroll
    for (int i = 0; i < NQ; ++i) { const int idx = tid + i * NTHR, s = idx >> 4, c8 = idx & 15; rq[i] = *(const GAS v4u*)(qsrc + (size_t)s * ldq + c8 * 8); rk[i] = *(const GAS v4u*)(ksrc + (size_t)s * ldk + c8 * 8); }
#pragma unroll
    for (int i = 0; i < NV; ++i) { const int idx = tid + i * NTHR, s = idx / (DV / 8), c8 = idx % (DV / 8); rv[i] = *(const GAS v4u*)(vsrc + (size_t)s * ldv + c8 * 8); }
    __builtin_amdgcn_sched_barrier(0);
    prep();
    __builtin_amdgcn_sched_barrier(0);
#pragma unroll
    for (int i = 0; i < NQ; ++i) { const int idx = tid + i * NTHR, s = idx >> 4, c8 = idx & 15; *(LAS v4u*)(Q + s * RSQ + c8 * 16) = rq[i]; *(LAS v4u*)(K + s * RSQ + c8 * 16) = rk[i]; }
#pragma unroll
    for (int i = 0; i < NV; ++i) { const int idx = tid + i * NTHR, s = idx / (DV / 8), c8 = idx % (DV / 8); *(LAS v4u*)(V + s * RSV + c8 * 16) = rv[i]; }
    __syncthreads();
    f32x4 pv[TPW];
#pragma unroll
    for (int i = 0; i < TPW; ++i) { const int ti = w * TPW + i, rb = ti / NT, cb = ti % NT; f32x4 a = (f32x4){0.f, 0.f, 0.f, 0.f};
        if (cb <= rb) {
#pragma unroll
            for (int kk = 0; kk < 4; ++kk) a = MFMA16(frag_row<RSQ>(Q, 16 * rb, 32 * kk, lane), frag_row<RSQ>(K, 16 * cb, 32 * kk, lane), a);
            const int s = 16 * cb + c16; const float lc = lcol[s]; float rs[4];
#pragma unroll
            for (int r = 0; r < 4; ++r) { const int t = 16 * rb + 4 * g4 + r; const float pw = (s <= t) ? __expf(lrow[t] + lc) * a[r] * DK_SCALE : 0.f; a[r] = pw; rs[r] = pw; }
            if (MODE == 0) {
#pragma unroll
                for (int r = 0; r < 4; ++r) { float v = rs[r]; v += dpp_f<0xB1, 0xf, 0xf>(0.f, v); v += dpp_f<0x4E, 0xf, 0xf>(0.f, v); v += dpp_f<0x141, 0xf, 0xf>(0.f, v); v += dpp_f<0x140, 0xf, 0xf>(0.f, v);
                    if (c16 == 0) part[(16 * rb + 4 * g4 + r) * NT + cb] = v; } }
        } else if (MODE == 0) { if (c16 == 0) {
#pragma unroll
                for (int r = 0; r < 4; ++r) part[(16 * rb + 4 * g4 + r) * NT + cb] = 0.f; } }
        pv[i] = a; }
    __syncthreads();
#pragma unroll
    for (int i = 0; i < TPW; ++i) { const int ti = w * TPW + i, rb = ti / NT, cb = ti % NT;
#pragma unroll
        for (int r = 0; r < 4; ++r) *(LAS bf16*)(P + (16 * rb + 4 * g4 + r) * RSP + (16 * cb + c16) * 2) = (bf16)f2bf(pv[i][r]); }
    for (int idx = tid; idx < L * 16; idx += NTHR) { const int s = idx >> 4, c8 = idx & 15; const float sc = qs[s];
        const v4u x = *(const LAS v4u*)(Q + s * RSQ + c8 * 16); float f[8];
        f[0] = __uint_as_float(x.x << 16) * sc; f[1] = __uint_as_float(x.x & 0xffff0000u) * sc; f[2] = __uint_as_float(x.y << 16) * sc; f[3] = __uint_as_float(x.y & 0xffff0000u) * sc;
        f[4] = __uint_as_float(x.z << 16) * sc; f[5] = __uint_as_float(x.z & 0xffff0000u) * sc; f[6] = __uint_as_float(x.w << 16) * sc; f[7] = __uint_as_float(x.w & 0xffff0000u) * sc;
        v4u o; o.x = pk2(f[0], f[1]); o.y = pk2(f[2], f[3]); o.z = pk2(f[4], f[5]); o.w = pk2(f[6], f[7]);
        *(LAS v4u*)(Q + s * RSQ + c8 * 16) = o;
        if (MODE == 0) { float dsum = 0.f;
#pragma unroll
            for (int j = 0; j < 8; ++j) dsum += f[j] * npv[8 * c8 + j];
            dpart[s * 16 + c8] = dsum; } }
    __syncthreads();
    if (MODE == 0 && tid < L) { float a = 0.f;
#pragma unroll
        for (int j = 0; j < NT; ++j) a += part[tid * NT + j];
#pragma unroll
        for (int j = 0; j < 16; ++j) a += dpart[tid * 16 + j];
        rowsum[tid] = a; }
    f32x4 acc[NT][NCB];
#pragma unroll
    for (int rb = 0; rb < NT; ++rb)
#pragma unroll
        for (int i = 0; i < NCB; ++i) acc[rb][i] = (f32x4){0.f, 0.f, 0.f, 0.f};
#pragma unroll
    for (int kk = 0; kk < 4; ++kk) {
#pragma unroll
        for (int rb = 0; rb < NT; ++rb) { const bf16x8 a = frag_row<RSQ>(Q, 16 * rb, 32 * kk, lane);
#pragma unroll
            for (int i = 0; i < NCB; ++i) acc[rb][i] = MFMA16(a, stf[kk][i], acc[rb][i]); } }
#pragma unroll
    for (int kk = 0; kk < L / 32; ++kk) { bf16x8 bfr[NCB];
#pragma unroll
        for (int i = 0; i < NCB; ++i) bfr[i] = frag_tr<RSV>(V, 32 * kk, 16 * (w * NCB + i), lane);
#pragma unroll
        for (int rb = 0; rb < NT; ++rb) { const bf16x8 a = frag_row<RSP>(P, 16 * rb, 32 * kk, lane);
#pragma unroll
            for (int i = 0; i < NCB; ++i) acc[rb][i] = MFMA16(a, bfr[i], acc[rb][i]); } }
    v2u gpre[NSTEP];
#pragma unroll
    for (int i = 0; i < NSTEP; ++i) gpre[i] = *(const GAS v2u*)(gate + (size_t)(w * RPS + i * NWAVES * RPS + nsub) * ldg + ne0);
    __syncthreads();
#pragma unroll
    for (int rb = 0; rb < NT; ++rb)
#pragma unroll
        for (int i = 0; i < NCB; ++i)
#pragma unroll
            for (int r = 0; r < 4; ++r) { const int t = 16 * rb + 4 * g4 + r, e = 16 * (w * NCB + i) + c16; float hv = acc[rb][i][r];
                if (MODE == 0) hv = hv / fmaxf(fabsf(rowsum[t]), flo[t]);
                H[t * DV + e] = hv; }
    __syncthreads();
    {   const int sub = nsub, e0 = ne0;
        const f32x4 gn = *(const f32x4*)(gain + e0);
#pragma unroll
        for (int si = 0; si < NSTEP; ++si) { const int t = w * RPS + si * NWAVES * RPS + sub;
            const v2u gw2 = gpre[si];
            f32x4 hv = *(const LAS f32x4*)(H + t * DV + e0);
            float mu = 0.f;
            if (MODE == 1) { float s1 = (hv[0] + hv[1]) + (hv[2] + hv[3]);
                s1 += dpp_f<0xB1, 0xf, 0xf>(0.f, s1); s1 += dpp_f<0x4E, 0xf, 0xf>(0.f, s1); s1 += dpp_f<0x141, 0xf, 0xf>(0.f, s1); s1 += dpp_f<0x140, 0xf, 0xf>(0.f, s1); s1 += dpp_f<0x142, 0xa, 0xf>(0.f, s1);
                if (RPS == 2) { const float lo_ = __builtin_bit_cast(float, __builtin_amdgcn_readlane(__builtin_bit_cast(int, s1), 31)), hi_ = __builtin_bit_cast(float, __builtin_amdgcn_readlane(__builtin_bit_cast(int, s1), 63)); s1 = sub ? hi_ : lo_; }
                else { s1 += dpp_f<0x143, 0xc, 0xf>(0.f, s1); s1 = __builtin_bit_cast(float, __builtin_amdgcn_readlane(__builtin_bit_cast(int, s1), 63)); }
                mu = s1 * (1.f / DV); }
            hv = hv - mu;
            float s2 = (hv[0] * hv[0] + hv[1] * hv[1]) + (hv[2] * hv[2] + hv[3] * hv[3]);
            s2 += dpp_f<0xB1, 0xf, 0xf>(0.f, s2); s2 += dpp_f<0x4E, 0xf, 0xf>(0.f, s2); s2 += dpp_f<0x141, 0xf, 0xf>(0.f, s2); s2 += dpp_f<0x140, 0xf, 0xf>(0.f, s2); s2 += dpp_f<0x142, 0xa, 0xf>(0.f, s2);
            if (RPS == 2) { const float lo_ = __builtin_bit_cast(float, __builtin_amdgcn_readlane(__builtin_bit_cast(int, s2), 31)), hi_ = __builtin_bit_cast(float, __builtin_amdgcn_readlane(__builtin_bit_cast(int, s2), 63)); s2 = sub ? hi_ : lo_; }
            else { s2 += dpp_f<0x143, 0xc, 0xf>(0.f, s2); s2 = __builtin_bit_cast(float, __builtin_amdgcn_readlane(__builtin_bit_cast(int, s2), 63)); }
            const float rstd = 1.0f / sqrtf(s2 * (1.f / DV) + NORM_EPS);
            const float g0 = __uint_as_float(gw2.x << 16), g1 = __uint_as_float(gw2.x & 0xffff0000u), g2 = __uint_as_float(gw2.y << 16), g3 = __uint_as_float(gw2.y & 0xffff0000u);
            float a0, a1, a2, a3;
            if (MODE == 0) { a0 = sigmoid_f(g0); a1 = sigmoid_f(g1); a2 = sigmoid_f(g2); a3 = sigmoid_f(g3); }
            else { a0 = g0 * sigmoid_f(g0); a1 = g1 * sigmoid_f(g1); a2 = g2 * sigmoid_f(g2); a3 = g3 * sigmoid_f(g3); }
            v2u o; o.x = pk2(hv[0] * rstd * gn[0] * a0, hv[1] * rstd * gn[1] * a1); o.y = pk2(hv[2] * rstd * gn[2] * a2, hv[3] * rstd * gn[3] * a3);
            *(GAS v2u*)(y + (size_t)t * ldy + e0) = o; __builtin_amdgcn_sched_barrier(0); } }
    __syncthreads();
}
namespace att {
constexpr int D = 128, LDQKV = NPROJ, LDO = 1024;
constexpr float THR = 8.f; constexpr bool WSKIP = false;
constexpr float SCALE = 0.08838834764831845f;
constexpr int NW = 8, QBLK = 32, KVBLK = 64, QB = NW * QBLK;
constexpr int SHM_V = KVBLK * D * 2, SHM_K = KVBLK * D * 2;
constexpr int LDS_BYTES = 2 * SHM_V + 2 * SHM_K + NW * 64 * 4;

using bf16 = unsigned short;
typedef short bf16x8 __attribute__((ext_vector_type(8)));
typedef short s16x4 __attribute__((ext_vector_type(4)));
typedef float f32x16 __attribute__((ext_vector_type(16)));
typedef float f32x4 __attribute__((ext_vector_type(4)));
typedef unsigned u32x4 __attribute__((ext_vector_type(4)));
template <class A, class Bt> struct same_t { static constexpr bool v = false; };
template <class A> struct same_t<A, A> { static constexpr bool v = true; };

#define KSWZ(row, colB) ((row) * 256 + ((colB) ^ (((row) & 7) << 4)))
#define SBAR() __builtin_amdgcn_sched_barrier(0)
__device__ __forceinline__ int v_st(int k, int c) { const int kk = (k & ~0xC) | ((k & 4) << 1) | ((k & 8) >> 1); return ((kk >> 3) * 4 + (c >> 5)) * 512 + ((kk & 7) * 32 + (c & 31)) * 2; }
__device__ __forceinline__ int v_rd_base(int lane) { return ((lane & 3) << 3) | (((lane >> 2) & 3) << 6) | (((lane >> 4) & 1) << 5) | (((lane >> 5) & 1) << 8); }
constexpr int v_rd_off(int d0, int ks, int half) { return d0 * 512 + ks * 4096 + half * 2048; }
__device__ __forceinline__ int crow(int r, int hi) { return (r & 3) + 8 * (r >> 2) + 4 * hi; }
__device__ __forceinline__ unsigned cvtpk(float lo, float hi) {
    unsigned r; asm volatile("v_cvt_pk_bf16_f32 %0, %1, %2" : "=v"(r) : "v"(lo), "v"(hi)); return r;
}
__device__ __forceinline__ bf16x8 pack8(f32x4 a, f32x4 b) {
    u32x4 w = {cvtpk(a[0], a[1]), cvtpk(a[2], a[3]), cvtpk(b[0], b[1]), cvtpk(b[2], b[3])};
    return *reinterpret_cast<bf16x8*>(&w);
}
template <class T> __device__ __forceinline__ bf16x8 load8(const T* p) {
    if constexpr (same_t<T, float>::v) { return pack8(*(const f32x4*)p, *(const f32x4*)(p + 4)); }
    else { return *reinterpret_cast<const bf16x8*>(p); }
}
__device__ __forceinline__ unsigned long long mask_word(const char* tile_base, int row) { unsigned off = (unsigned)row; asm volatile("" : "+v"(off)); off *= 1024u; return *(const unsigned long long*)(tile_base + off); }
__device__ __forceinline__ void mask_bits(f32x16& p0, f32x16& p1, unsigned long long mw, int hi) {
    const unsigned long long ws = mw >> hi; const unsigned lo = (unsigned)ws, up = (unsigned)(ws >> 32);
#pragma unroll
    for (int r = 0; r < 16; ++r) {
        const int c = 16 * (r & 1) + 2 * (r >> 2); const unsigned x = (r & 2) ? up : lo;
        const unsigned ma = (unsigned)(((int)(x << (31 - c))) >> 31), mb = (unsigned)(((int)(x << (31 - c - 8))) >> 31);
        p0[r] = __uint_as_float((__float_as_uint(p0[r]) & ma) | (0xff800000u & ~ma));
        p1[r] = __uint_as_float((__float_as_uint(p1[r]) & mb) | (0xff800000u & ~mb));
    }
}
__device__ __forceinline__ void partialSM(f32x16& p0, f32x16& p1, float& m_reg, float& mn, float& alpha) {
    float pmax = p0[0]; for (int r = 1; r < 16; ++r) pmax = fmaxf(pmax, p0[r]); for (int r = 0; r < 16; ++r) pmax = fmaxf(pmax, p1[r]);
    { auto rr = __builtin_amdgcn_permlane32_swap(__float_as_uint(pmax), __float_as_uint(pmax), false, false);
      pmax = fmaxf(__uint_as_float(rr[0]), __uint_as_float(rr[1])); }
    constexpr float C2 = 1.4426950408889634f * SCALE;
    if (__builtin_expect(__all((pmax - m_reg) * SCALE <= THR), 1)) { mn = m_reg; alpha = 1.f; }
    else { mn = fmaxf(m_reg, pmax); alpha = __builtin_amdgcn_exp2f((m_reg - mn) * C2); m_reg = mn; }
    const float mnL = -mn * C2;
    for (int r = 0; r < 16; ++r) p0[r] = fmaf(p0[r], C2, mnL); for (int r = 0; r < 16; ++r) p1[r] = fmaf(p1[r], C2, mnL);
    for (int r = 0; r < 16; ++r) p0[r] = __builtin_amdgcn_exp2f(p0[r]);
}
__device__ __forceinline__ void finishSM(f32x16& p0, f32x16& p1, float alpha, float& l_reg, bf16x8& pa0, bf16x8& pa1, bf16x8& pa2, bf16x8& pa3) {
    for (int r = 0; r < 16; ++r) p1[r] = __builtin_amdgcn_exp2f(p1[r]);
    float ps = 0; for (int r = 0; r < 16; ++r) ps += p0[r]; for (int r = 0; r < 16; ++r) ps += p1[r];
    { auto rr = __builtin_amdgcn_permlane32_swap(__float_as_uint(ps), __float_as_uint(ps), false, false);
      ps = __uint_as_float(rr[0]) + __uint_as_float(rr[1]); }
    l_reg = l_reg * alpha + ps;
#define PK4(P, B_, OUT) do { unsigned a0 = cvtpk(P[B_+0], P[B_+1]), a1 = cvtpk(P[B_+2], P[B_+3]);                          \
        unsigned b0 = cvtpk(P[B_+4], P[B_+5]), b1 = cvtpk(P[B_+6], P[B_+7]);                                             \
        auto r0 = __builtin_amdgcn_permlane32_swap(a0, b0, false, false); auto r1 = __builtin_amdgcn_permlane32_swap(a1, b1, false, false); \
        u32x4 w = {r0[0], r1[0], r0[1], r1[1]}; OUT = *reinterpret_cast<bf16x8*>(&w); } while (0)
    PK4(p0, 0, pa0); PK4(p0, 8, pa1); PK4(p1, 0, pa2); PK4(p1, 8, pa3);
#undef PK4
}
template <int KB, bool SK>
__device__ __forceinline__ void qkt(f32x16& p0, f32x16& p1, const char* K_lds, int r32, int hi, const bf16x8* qr, bool act) {
    if (SK && !act) { const float NEG = -__builtin_inff();
#pragma unroll
        for (int r = 0; r < 16; ++r) { p0[r] = NEG; p1[r] = NEG; } return; }
    p0 = f32x16{}; p1 = f32x16{};
    const char* kb[4];
#pragma unroll
    for (int dd = 0; dd < 4; ++dd) kb[dd] = K_lds + KB * SHM_K + KSWZ(r32, (dd * 16 + hi * 8) * 2);
#pragma unroll
    for (int d0 = 0; d0 < 8; ++d0) { const char* a = kb[d0 & 3] + (d0 >> 2) * 128;
        bf16x8 b0 = *reinterpret_cast<const bf16x8*>(a);
        bf16x8 b1 = *reinterpret_cast<const bf16x8*>(a + 32 * 256);
        p0 = __builtin_amdgcn_mfma_f32_32x32x16_bf16(b0, qr[d0], p0, 0, 0, 0);
        p1 = __builtin_amdgcn_mfma_f32_32x32x16_bf16(b1, qr[d0], p1, 0, 0, 0); }
}
template <int VB, bool SK>
__device__ __forceinline__ void pv_tile(f32x16* o, int vb0, bf16x8 pa0, bf16x8 pa1, bf16x8 pa2, bf16x8 pa3, bool act) {
    if (SK && !act) return;
#define TRRD(dst, off) asm volatile("ds_read_b64_tr_b16 %0, %1 offset:%2" : "=&v"(dst) : "v"(vb0), "i"(off) : "memory")
#define PV_D0(d0) do { s16x4 l0, l1, l2, l3, h0, h1, h2, h3; constexpr int b_ = VB * SHM_V + v_rd_off(d0, 0, 0);     \
        TRRD(l0, b_); TRRD(h0, b_ + 2048); TRRD(l1, b_ + 4096); TRRD(h1, b_ + 6144); TRRD(l2, b_ + 8192); TRRD(h2, b_ + 10240); TRRD(l3, b_ + 12288); TRRD(h3, b_ + 14336); \
        asm volatile("s_waitcnt lgkmcnt(0)" ::: "memory"); SBAR();                 \
        o[d0] = __builtin_amdgcn_mfma_f32_32x32x16_bf16(pa0, (bf16x8){l0[0], l0[1], l0[2], l0[3], h0[0], h0[1], h0[2], h0[3]}, o[d0], 0, 0, 0);   \
        o[d0] = __builtin_amdgcn_mfma_f32_32x32x16_bf16(pa1, (bf16x8){l1[0], l1[1], l1[2], l1[3], h1[0], h1[1], h1[2], h1[3]}, o[d0], 0, 0, 0);   \
        o[d0] = __builtin_amdgcn_mfma_f32_32x32x16_bf16(pa2, (bf16x8){l2[0], l2[1], l2[2], l2[3], h2[0], h2[1], h2[2], h2[3]}, o[d0], 0, 0, 0);   \
        o[d0] = __builtin_amdgcn_mfma_f32_32x32x16_bf16(pa3, (bf16x8){l3[0], l3[1], l3[2], l3[3], h3[0], h3[1], h3[2], h3[3]}, o[d0], 0, 0, 0); } while (0)
    PV_D0(0); PV_D0(1); PV_D0(2); PV_D0(3);
#undef PV_D0
#undef TRRD
}

template <class TIn, class TOut> struct BlockRef { const TIn* Q; const TIn* K; const TIn* V; TOut* O; const unsigned long long* M; float* ML; int P0, jlo, jhi, pad; };
template <class TIn> struct Seam {
    bf16x8 qr[8];
    bf16x8 st_v0, st_v1, st_k0, st_k1; f32x4 sf0, sf1, sf2, sf3;
    f32x4 tq[16];
};
__device__ __forceinline__ int swa_jlo(int P0, int W) { const int lowk = P0 - W + 1; return lowk > 0 ? lowk / KVBLK : 0; }
#define ROW(p, k0, rr) ((p) + (size_t)((k0) + (rr)) * LDQKV + sc)
#define VMW() asm volatile("s_waitcnt vmcnt(0)" ::: "memory")
#define VMWN(n) asm volatile("s_waitcnt vmcnt(%0)" :: "i"(n) : "memory")
#define LD16U(base, off) (*reinterpret_cast<const bf16x8*>((const char*)(base) + (off)))
#define SLOAD_H(Kp, Vp, k0) do { const char* kb_ = (const char*)((Kp) + (size_t)(k0) * LDQKV); const char* vb_ = (const char*)((Vp) + (size_t)(k0) * LDQKV);                 \
                         S.st_v0 = LD16U(vb_, soff); S.st_v1 = LD16U(vb_ + (size_t)32 * LDQKV * 2, soff);                                  \
                         S.st_k0 = LD16U(kb_, soff); S.st_k1 = LD16U(kb_ + (size_t)32 * LDQKV * 2, soff); } while (0)
#define SWRITE_HK(bf) do { *(bf16x8*)(K_lds + (bf) * SHM_K + kws) = S.st_k0; *(bf16x8*)(K_lds + (bf) * SHM_K + kws + 32 * 256) = S.st_k1; } while (0)
#define SWRITE_HV(bf) do { *(bf16x8*)(V_lds + (bf) * SHM_V + vst0) = S.st_v0; *(bf16x8*)(V_lds + (bf) * SHM_V + vst1) = S.st_v1; } while (0)
#define SWRITE_H(bf) do { SWRITE_HV(bf); SWRITE_HK(bf); } while (0)
#define SLOAD_F(p, k0) do { S.sf0 = *(const f32x4*)ROW(p, k0, sr); S.sf1 = *(const f32x4*)(ROW(p, k0, sr) + 4);                \
                            S.sf2 = *(const f32x4*)ROW(p, k0, 32 + sr); S.sf3 = *(const f32x4*)(ROW(p, k0, 32 + sr) + 4); } while (0)
#define SWRITE_KF(bf) do { *(bf16x8*)(K_lds + (bf) * SHM_K + kws) = pack8(S.sf0, S.sf1); *(bf16x8*)(K_lds + (bf) * SHM_K + kws + 32 * 256) = pack8(S.sf2, S.sf3); } while (0)
#define SWRITE_VF(bf) do { *(bf16x8*)(V_lds + (bf) * SHM_V + vst0) = pack8(S.sf0, S.sf1); *(bf16x8*)(V_lds + (bf) * SHM_V + vst1) = pack8(S.sf2, S.sf3); } while (0)
template <class TIn, class TOut>
__device__ __forceinline__ void causal_swa_prime(const BlockRef<TIn, TOut>& cur, int W, char* lds, Seam<TIn>& S) {
    constexpr bool F32 = same_t<TIn, float>::v;
    int tid_o = my_tid(); asm volatile("" : "+v"(tid_o));
    const int tid = tid_o, wid = __builtin_amdgcn_readfirstlane(tid >> 6), lane = tid & 63, r32 = lane & 31, hi = lane >> 5;
    const int sr = tid >> 4, sc = (tid & 15) * 8, kws = KSWZ(sr, sc * 2); char* K_lds = lds + 2 * SHM_V; const unsigned soff = (unsigned)(sr * LDQKV + sc) * 2u;
    const int kb0 = cur.jlo * KVBLK; (void)W;
    for (int d0 = 0; d0 < 8; ++d0) S.qr[d0] = load8<TIn>(cur.Q + (size_t)(wid * QBLK + r32) * LDQKV + d0 * 16 + hi * 8);
    if constexpr (F32) { SLOAD_F((const float*)cur.K, kb0); VMW(); SWRITE_KF(0); SBAR(); SLOAD_F((const float*)cur.V, kb0); }
    else { SLOAD_H(cur.K, cur.V, kb0); VMW(); SWRITE_HK(0); }
    __syncthreads();
}
template <class TIn, class TOut>
__device__ __forceinline__ void causal_swa_block(const BlockRef<TIn, TOut>& cur, const BlockRef<TIn, TOut>& nxt, int skv, int W, char* lds, Seam<TIn>& S) {
    constexpr bool F32 = same_t<TIn, float>::v;
    int tid_o = my_tid(); asm volatile("" : "+v"(tid_o));
    const int tid = tid_o, wid = __builtin_amdgcn_readfirstlane(tid >> 6), lane = tid & 63, r32 = lane & 31, hi = lane >> 5;
    const int j_lo = cur.jlo, j_hi = cur.jhi; (void)skv;
    const int NT = j_hi - j_lo;
    const int kbn = nxt.jlo * KVBLK;
    const int qlo = cur.P0 + wid * QBLK, qm = qlo + r32 - 4 * hi;
    char* V_lds = lds; char* K_lds = lds + 2 * SHM_V;
    float* ws = (float*)(lds + 2 * SHM_V + 2 * SHM_K) + wid * 64; float* li_l = ws, * al_l = ws + 32;
    float m_reg = -1e30f, l_reg = 0; f32x16 o[4] = {};
#define TID_NOW() ({ int t_ = tid; asm volatile("" : "+v"(t_)); t_; })
#define soff ({ const int t_ = TID_NOW(); (unsigned)((t_ >> 4) * LDQKV + (t_ & 15) * 8) * 2u; })
#define vst0 ({ const int t_ = TID_NOW(); v_st(t_ >> 4, (t_ & 15) * 8); })
#define vst1 (vst0 + 8192)
#define kws ({ const int t_ = TID_NOW(); KSWZ(t_ >> 4, (t_ & 15) * 16); })
    const int sr = tid >> 4, sc = (tid & 15) * 8; (void)sr; (void)sc;
    const int vb0 = (int)(uintptr_t)V_lds + v_rd_base(lane);
    const TIn* Kh = cur.K; const TIn* Vh = cur.V;
#define RESC(a) do { if (__any((a) < 1.f)) { if (hi == 0) al_l[r32] = (a); asm volatile("s_waitcnt lgkmcnt(0)" ::: "memory");              \
                     for (int d_ = 0; d_ < 4; ++d_) for (int r = 0; r < 16; ++r) o[d_][r] *= al_l[crow(r, hi)]; } } while (0)
#define KBASE(t) ((j_lo + (t)) * KVBLK)
#define ACT(t) (KBASE(t) <= qlo + QBLK - 1 && KBASE(t) + KVBLK - 1 >= qlo - W + 1)
#define MASKT(P0_, P1_, mw_) mask_bits(P0_, P1_, mw_, hi)
#define MLOAD(t) mask_word((const char*)cur.M + (size_t)((j_lo + (t)) * 8), wid * QBLK + r32)
    constexpr int NQL = F32 ? 16 : 8;
    constexpr bool SK = WSKIP && !F32;
#define SEAM_K0() do { VMWN(NQL); if constexpr (F32) { SWRITE_KF(0); SBAR(); SLOAD_F((const float*)nxt.V, kbn); } else { SWRITE_HK(0); } SBAR(); } while (0)
    f32x16 pA0, pA1, pB0, pB1; float mnA, mnB, alA, alB; bf16x8 pa0, pa1, pa2, pa3;
    if constexpr (F32) { VMW(); SWRITE_VF(0); SBAR(); } else { SWRITE_HV(0); SBAR(); }
    if (NT > 1) { if constexpr (F32) SLOAD_F((const float*)Kh, KBASE(1)); else SLOAD_H(Kh, Vh, KBASE(1)); }
    SBAR(); qkt<0, SK>(pA0, pA1, K_lds, r32, hi, S.qr, ACT(0));
    if constexpr (F32) { if (NT > 1) { VMW(); SWRITE_KF(1); SBAR(); SLOAD_F((const float*)Vh, KBASE(1)); } }
    unsigned long long mwn = MLOAD(NT > 1 ? 1 : 0);
    MASKT(pA0, pA1, MLOAD(0)); partialSM(pA0, pA1, m_reg, mnA, alA);
    if (NT > 1) { VMW(); if constexpr (F32) { SWRITE_VF(1); SBAR(); if (NT > 2) SLOAD_F((const float*)Kh, KBASE(2)); } else SWRITE_H(1); }
    __syncthreads();
#define HALF_STEP(PX0, PX1, mnX, alX, PY0, PY1, alY, t, KB, VB, SB) do {                                                      \
        SBAR(); qkt<KB, SK>(PX0, PX1, K_lds, r32, hi, S.qr, ACT(t));                                             \
        finishSM(PY0, PY1, alY, l_reg, pa0, pa1, pa2, pa3); SBAR();                                                           \
        if ((t) + 1 < NT) { if constexpr (F32) { VMW(); SWRITE_KF(SB); SBAR(); SLOAD_F((const float*)Vh, KBASE((t) + 1)); }  \
                            else { SLOAD_H(Kh, Vh, KBASE((t) + 1)); } SBAR(); }                                               \
        pv_tile<VB, SK>(o, vb0, pa0, pa1, pa2, pa3, ACT((t) - 1)); { const unsigned long long mwc_ = mwn; mwn = MLOAD((t) + 1 < NT ? (t) + 1 : (t)); MASKT(PX0, PX1, mwc_); } partialSM(PX0, PX1, m_reg, mnX, alX);                                        \
        __syncthreads();                                                                                                      \
        if ((t) + 1 < NT) { VMW(); if constexpr (F32) { SWRITE_VF(SB); SBAR(); if ((t) + 2 < NT) SLOAD_F((const float*)Kh, KBASE((t) + 2)); } \
                            else { SWRITE_H(SB); } }                                                                          \
        RESC(alX); __syncthreads(); } while (0)
    for (int t = 1; t + 1 < NT; t += 2) {
        HALF_STEP(pB0, pB1, mnB, alB, pA0, pA1, alA, t, 1, 0, 0);
        HALF_STEP(pA0, pA1, mnA, alA, pB0, pB1, alB, t + 1, 0, 1, 1);
    }
    const bool even = (NT & 1) == 0;
    if (even) { SBAR(); qkt<1, SK>(pB0, pB1, K_lds, r32, hi, S.qr, ACT(NT - 1)); SBAR(); }
#define QROW(e) (nxt.Q + (size_t)(wid * QBLK + r32) * LDQKV + ((e) >> 1) * 16 + hi * 8 + ((e) & 1) * 4)
    if constexpr (F32) { SLOAD_F((const float*)nxt.K, kbn); SBAR();
#pragma unroll
        for (int e = 0; e < 8; ++e) S.tq[e] = *(const f32x4*)QROW(e); }
    else { SLOAD_H(nxt.K, nxt.V, kbn); SBAR();
#pragma unroll
        for (int d0 = 0; d0 < 8; ++d0) S.qr[d0] = load8<TIn>(nxt.Q + (size_t)(wid * QBLK + r32) * LDQKV + d0 * 16 + hi * 8); }
    SBAR();
    finishSM(pA0, pA1, alA, l_reg, pa0, pa1, pa2, pa3); SBAR();
    if constexpr (F32) {
#pragma unroll
        for (int e = 8; e < 16; ++e) S.tq[e] = *(const f32x4*)QROW(e); SBAR(); }
#undef QROW
    pv_tile<0, SK>(o, vb0, pa0, pa1, pa2, pa3, ACT(even ? NT - 2 : NT - 1));
    if (even) { MASKT(pB0, pB1, mwn); partialSM(pB0, pB1, m_reg, mnB, alB); __syncthreads(); RESC(alB);
        finishSM(pB0, pB1, alB, l_reg, pa0, pa1, pa2, pa3); SBAR(); pv_tile<1, SK>(o, vb0, pa0, pa1, pa2, pa3, ACT(NT - 1)); }
    SBAR(); SEAM_K0();
    if (hi == 0) { li_l[r32] = l_reg; if (cur.ML != nullptr) { float* mlp = cur.ML + (size_t)(wid * QBLK + r32) * 16; mlp[0] = m_reg; mlp[1] = l_reg; } } asm volatile("s_waitcnt lgkmcnt(0)" ::: "memory");
    float rli[16];
#pragma unroll
    for (int r = 0; r < 16; ++r) rli[r] = __builtin_amdgcn_rcpf(li_l[crow(r, hi)]);
    TOut* Ow = cur.O + (size_t)(wid * QBLK) * LDO;
#pragma unroll
    for (int r = 0; r < 16; ++r) { const int orow = crow(r, hi);
#pragma unroll
        for (int d0 = 0; d0 < 4; ++d0) { const float v = o[d0][r] * rli[r];
            if constexpr (same_t<TOut, float>::v) { Ow[(size_t)orow * LDO + d0 * 32 + r32] = v; }
            else { const float vn = __builtin_bit_cast(float, __builtin_amdgcn_update_dpp(0, __builtin_bit_cast(int, v), 0xB1, 0xf, 0xf, false));
                   if ((r32 & 1) == 0) *(unsigned*)(Ow + (size_t)orow * LDO + d0 * 32 + r32) = cvtpk(v, vn); } } }
    if constexpr (F32) {
#pragma unroll
        for (int d0 = 0; d0 < 8; ++d0) S.qr[d0] = pack8(S.tq[2 * d0], S.tq[2 * d0 + 1]); }
    __syncthreads();
#undef RESC
#undef TID_NOW
#undef soff
#undef vst0
#undef vst1
#undef kws
#undef KBASE
#undef ACT
#undef MASKT
#undef MLOAD
#undef SEAM_K0
#undef HALF_STEP
}
#undef ROW
#undef VMW
#undef VMWN
#undef SLOAD_H
#undef LD16U
#undef SWRITE_HK
#undef SWRITE_HV
#undef SWRITE_H
#undef SLOAD_F
#undef SWRITE_KF
#undef SWRITE_VF

}


template <int NC> __device__ __forceinline__ void scan_elems(const bf16* __restrict__ delta, bf16* __restrict__ prev, size_t cstride, const LAS float* dec, const LAS float* inj) {
    f32x4 st = (f32x4){0.f, 0.f, 0.f, 0.f};
#pragma unroll 8
    for (int c = 0; c < NC; ++c) { const v2u x = *(const GAS v2u*)(delta + (size_t)c * cstride);
        v2u o; o.x = pk2(st[0], st[1]); o.y = pk2(st[2], st[3]); *(GAS v2u*)(prev + (size_t)c * cstride) = o;
        const float d = dec[c], j = inj[c];
        st[0] = d * st[0] + j * __uint_as_float(x.x << 16); st[1] = d * st[1] + j * __uint_as_float(x.x & 0xffff0000u);
        st[2] = d * st[2] + j * __uint_as_float(x.y << 16); st[3] = d * st[3] + j * __uint_as_float(x.y & 0xffff0000u); }
}

struct Args {
    const float* x; const float* norm_mix; const float* norm_ffn; const float* w_in; const float* att_q_norm; const float* att_k_norm; const float* mlstm_conv; const float* mlstm_gate_bias;
    const float* mlstm_out_norm; const float* ret_out_norm; const float* w_b_att; const float* w_b_mlstm; const float* w_b_ret; const float* w_out; const float* w_ffn_in; const float* w_ffn_out;
    float* out; unsigned char* ws; int layer_lo, layer_hi, ph_lo, ph_hi;
};
constexpr int PH_PER_LAYER = 16;
__device__ __forceinline__ float ret_lngamma(int hd) { return log1pf(-exp2f(-5.0f - (float)hd)); }
#define PHASE_FN static __device__ __forceinline__ void
#define OPAQUE_PTR(p) asm volatile("" : "+s"(p))
#define WS_PTRS(ws) OPAQUE_PTR(ws); \
    bf16* const H = (bf16*)((ws) + WS_H); bf16* const PROJ = (bf16*)((ws) + WS_PROJ); float* const SMALL = (float*)((ws) + WS_SMALL); bf16* const MQK = (bf16*)((ws) + WS_MQK); \
    bf16* const IKB = (bf16*)((ws) + WS_IKB); unsigned char* const IWF = (unsigned char*)((ws) + WS_IWF); float* const GIF = (float*)((ws) + WS_GIF); unsigned short* const SC = (unsigned short*)((ws) + WS_SC); \
    unsigned long long* const MB = (unsigned long long*)((ws) + WS_MB); bf16* const DCM = (bf16*)((ws) + WS_DCM); bf16* const CPM = (bf16*)((ws) + WS_CPM); \
    float* const DN = (float*)((ws) + WS_MISC + MISC_DN); float* const NPREV = (float*)((ws) + WS_MISC + MISC_NPREV); float* const AB = (float*)((ws) + WS_MISC + MISC_AB); float* const MPREV = (float*)((ws) + WS_MISC + MISC_MPREV); \
    bf16* const DRR = (bf16*)((ws) + WS_DRR); bf16* const RPR = (bf16*)((ws) + WS_RPR); bf16* const YA = (bf16*)((ws) + WS_YA); bf16* const YM = (bf16*)((ws) + WS_YM); bf16* const YR = (bf16*)((ws) + WS_YR); \
    float* const MERGEDF = (float*)((ws) + WS_MERGEDF); bf16* const MERGED = (bf16*)((ws) + WS_MERGED); bf16* const ACT = (bf16*)((ws) + WS_ACT); \
    float* const ROPE128 = (float*)((ws) + WS_ROPE128); float* const ROPE64 = (float*)((ws) + WS_ROPE64); \
    (void)H; (void)PROJ; (void)SMALL; (void)MQK; (void)IKB; (void)IWF; (void)GIF; (void)SC; (void)MB; (void)DCM; (void)CPM; (void)DN; (void)NPREV; (void)AB; (void)MPREV; (void)DRR; (void)RPR; (void)YA; (void)YM; (void)YR; \
    (void)MERGEDF; (void)MERGED; (void)ACT; (void)ROPE128; (void)ROPE64
#define TIDS() int tid_ = my_tid(); asm volatile("" : "+v"(tid_)); int bx_ = blockIdx.x; asm volatile("" : "+s"(bx_));   \
    const int tid = tid_, lane = tid & 63, wave = __builtin_amdgcn_readfirstlane(tid >> 6); const int G = gridDim.x, bx = bx_; const int gw = bx * NWAVES + wave, NGW = G * NWAVES; \
    (void)lane; (void)wave; (void)gw; (void)NGW; (void)G; (void)bx

constexpr int CV_IN = 32 * 268, CV_B = 16 * 32, CV_OUT = 32 * 32, CV_FIN = 32 * 176, CV_FOUT = 88 * 32, CV_ITEMS = CV_IN + 3 * CV_B + CV_OUT + CV_FIN + CV_FOUT;
__device__ __forceinline__ void convert_layer_items(LAS float* scr, unsigned char* ws, int l, const float* w_in, const float* w_b_att, const float* w_b_mlstm, const float* w_b_ret, const float* w_out, const float* w_ffn_in,
                                                    const float* w_ffn_out, int it0, int it1, int wv, int nwv, int lane) {
    unsigned char* wl = ws + WS_W + (size_t)l * W_LAYER;
    for (int it = it0 + wv; it < it1; it += nwv) { int r = it;
        if (r < CV_IN) { transpose_item(w_in + (size_t)l * DM * LPROJ, DM, LPROJ, (bf16*)(wl + WO_IN), scr, r, NPROJ_PAD / 64, lane, MapWin()); continue; } r -= CV_IN;
        if (r < CV_B) { transpose_item(w_b_att + (size_t)l * 1024 * DM, 1024, DM, (bf16*)(wl + WO_B), scr, r, DM / 64, lane, MapIdent()); continue; } r -= CV_B;
        if (r < CV_B) { transpose_item(w_b_mlstm + (size_t)l * 1024 * DM, 1024, DM, (bf16*)(wl + WO_B + 4 * MiB), scr, r, DM / 64, lane, MapIdent()); continue; } r -= CV_B;
        if (r < CV_B) { transpose_item(w_b_ret + (size_t)l * 1024 * DM, 1024, DM, (bf16*)(wl + WO_B + 8 * MiB), scr, r, DM / 64, lane, MapIdent()); continue; } r -= CV_B;
        if (r < CV_OUT) { transpose_item(w_out + (size_t)l * DM * DM, DM, DM, (bf16*)(wl + WO_OUT), scr, r, DM / 64, lane, MapIdent()); continue; } r -= CV_OUT;
        if (r < CV_FIN) { transpose_item(w_ffn_in + (size_t)l * DM * 2 * FF, DM, 2 * FF, (bf16*)(wl + WO_FIN), scr, r, 2 * FF / 64, lane, MapFfn()); continue; } r -= CV_FIN;
        transpose_item(w_ffn_out + (size_t)l * FF * DM, FF, DM, (bf16*)(wl + WO_FOUT), scr, r, DM / 64, lane, MapIdent()); }
}
PHASE_FN ph_prologue(LAS unsigned char* lds, unsigned char* ws, const float* w_in, const float* w_b_att, const float* w_b_mlstm, const float* w_b_ret, const float* w_out, const float* w_ffn_in, const float* w_ffn_out, bool all_layers) {
    TIDS(); WS_PTRS(ws);
    LAS float* scr = (LAS float*)(lds + wave * 16640);
    if (all_layers) { for (int l = 0; l < DEPTH; ++l) convert_layer_items(scr, ws, l, w_in, w_b_att, w_b_mlstm, w_b_ret, w_out, w_ffn_in, w_ffn_out, 0, CV_ITEMS, gw, NGW, lane); }
    else convert_layer_items(scr, ws, 0, w_in, w_b_att, w_b_mlstm, w_b_ret, w_out, w_ffn_in, w_ffn_out, 0, CV_IN, gw, NGW, lane);
    for (int i = gw * 64 + lane; i < S * 96; i += NGW * 64) {
        if (i < S * 64) { const int t = i >> 6, f = i & 63; const float inv = (float)pow(10000.0, -(double)f * 2.0 / 128.0); const float ang = (float)t * inv;
            ROPE128[2 * i] = (float)cos((double)ang); ROPE128[2 * i + 1] = (float)sin((double)ang); }
        else { const int k = i - S * 64, t = k >> 5, f = k & 31; const float inv = (float)pow(10000.0, -(double)f * 2.0 / 64.0); const float ang = (float)t * inv;
            ROPE64[2 * k] = (float)cos((double)ang); ROPE64[2 * k + 1] = (float)sin((double)ang); } }
}
PHASE_FN ph_convert_tail(LAS unsigned char* lds, unsigned char* ws, int l, const float* w_in, const float* w_b_att, const float* w_b_mlstm, const float* w_b_ret, const float* w_out, const float* w_ffn_in, const float* w_ffn_out,
                         int rem, int it0, int it1) {
    TIDS(); if (rem <= 0 || rem >= G || bx < rem) return;
    LAS float* scr = (LAS float*)(lds + wave * 16640);
    convert_layer_items(scr, ws, l, w_in, w_b_att, w_b_mlstm, w_b_ret, w_out, w_ffn_in, w_ffn_out, it0, it1, (bx - rem) * NWAVES + wave, (G - rem) * NWAVES, lane);
    __syncthreads(); }
PHASE_FN ph_rmsnorm16(const bf16* xin, const float* gain, bf16* Hout) { TIDS(); for (int m = gw; m < S; m += NGW) rms_row16_to_bf16(xin + (size_t)m * DM, gain, Hout + (size_t)m * DM, lane); }
PHASE_FN ph_rmsnorm(const float* xin, const float* gain, bf16* Hout) { TIDS(); for (int m = gw; m < S; m += NGW) rms_row_to_bf16(xin + (size_t)m * DM, gain, Hout + (size_t)m * DM, lane); }
PHASE_FN ph_gemm_proj(LAS unsigned char* lds, unsigned char* ws, const bf16* Wt) { TIDS(); WS_PTRS(ws);
    pg8::Gemm g{H, Wt, S, NPROJ_PAD, DM}; pg8::StaticOrder so; so.init(S, NPROJ_PAD, G, bx); pg8::EpiProj E{PROJ, NPROJ, SMALL, PC_G / 256, NPROJ / 256};
    pg8::gemm_phase<pg8::EpiProj, pg8::StaticOrder, true, true>(lds, g, so, E); }
PHASE_FN ph_pp(unsigned char* ws, const float* gq, const float* gk, const float* convw, const float* gbias) { TIDS(); WS_PTRS(ws);
    PPArgs a{PROJ, SMALL, MQK, IKB, IWF, GIF, ROPE128, ROPE64, gq, gk, convw, gbias};
    f32x4 cw[16];
#pragma unroll
    for (int j = 0; j < 4; ++j)
#pragma unroll
        for (int q = 0; q < 4; ++q) cw[j * 4 + q] = *(const f32x4*)(convw + j * 1024 + 16 * lane + 4 * q);
    for (int m = gw; m < S; m += NGW) pp_row(a, m, lane, cw); }
PHASE_FN ph_scores(LAS unsigned char* lds, unsigned char* ws) { TIDS(); WS_PTRS(ws);
    LAS unsigned char* iqt = lds; LAS unsigned char* wt = lds + IQT_BYTES + wave * (32 * SCT_RS);
    for (int u = bx; u < 1152; u += G) { int m = 0; while (16 * (m + 1) * (m + 2) <= u) ++m;
        const int r = u - 16 * m * (m + 1), qb = 32 * m + r / (m + 1), c = r % (m + 1), nkb = (qb >> 1) + 1, k0 = 16 * c, k1 = (k0 + 16 < nkb) ? k0 + 16 : nkb;
        {   const int row = tid >> 4, part = tid & 15; const bf16* src = PROJ + (size_t)(qb * 32 + row) * NPROJ + PC_IQ;
#pragma unroll
            for (int i = 0; i < 4; ++i) *(LAS v4u*)(iqt + row * IQT_RS + part * 16 + 256 * i) = *(const GAS v4u*)(src + part * 8 + 128 * i); }
        __syncthreads();
        for (int kb = k0 + wave; kb < k1; kb += NWAVES) score_wave_unit(wt, iqt, IKB, IWF, SC, qb, kb, lane);
        __syncthreads(); }
}
PHASE_FN ph_deltas(LAS unsigned char* lds, unsigned char* ws) { TIDS(); WS_PTRS(ws); LAS float* const sf = (LAS float*)(lds + SCR_OFF);
    for (int u = bx; u < 1024; u += G) {
        if (u < 512) { const int hd = u >> 7, c = u & 127, t0 = c * 64;
            auto prep = [=]() { if (wave == 0) { const float iv = GIF[(size_t)(t0 + lane) * 8 + hd], fv = GIF[(size_t)(t0 + lane) * 8 + 4 + hd]; float b = log_sigmoid_f(fv);
                    b = wave_prefix_sum_f(b);
                    const float bend = __builtin_bit_cast(float, __builtin_amdgcn_readlane(__builtin_bit_cast(int, b), 63)), gl = bend - b + iv, A = wave_max(gl);
                    sf[lane] = __expf(gl - A); if (lane == 0) { AB[(hd * 128 + c) * 2] = A; AB[(hd * 128 + c) * 2 + 1] = bend; } } };
            chunk_delta<64, 256>(prep, lds, MQK + (size_t)t0 * 1024 + 512 + hd * 128, 1024, PROJ + (size_t)t0 * NPROJ + PC_MV + hd * 256, NPROJ, sf, DCM + (size_t)(hd * 128 + c) * 32768, DN + (hd * 128 + c) * 128, tid);
        } else { const int v = u - 512, hd = v >> 6, c = v & 63, t0 = c * 128; const float lg = ret_lngamma(hd);
            auto prep = [=]() { if (tid < 128) sf[tid] = __expf(lg * (float)(127 - tid)); };
            chunk_delta<128, 128>(prep, lds, PROJ + (size_t)t0 * NPROJ + PC_RK + hd * 128, NPROJ, PROJ + (size_t)t0 * NPROJ + PC_RV + hd * 128, NPROJ, sf, DRR + (size_t)(hd * 64 + c) * 16384, nullptr, tid); }
    } }
PHASE_FN ph_select(LAS unsigned char* lds, unsigned char* ws) { TIDS(); WS_PTRS(ws);
    if (G == 256) select_rows_wg(lds, SC, MB, bx, 256, 28, 7168 + (bx - 128), 128, bx >= 128 ? 8 : 0, tid, (unsigned long long*)(ws + WS_CTL) + 16384);
    else select_rows_wg(lds, SC, MB, bx, G, (S - bx + G - 1) / G, 0, 0, 0, tid, (unsigned long long*)(ws + WS_CTL) + 16384); }
PHASE_FN ph_scans(LAS unsigned char* lds, unsigned char* ws) { TIDS(); WS_PTRS(ws); LAS float* const sf = (LAS float*)(lds + SCR_OFF);
    for (int u = bx; u < 128; u += G) {
        LAS float* dec = sf; LAS float* inj = sf + 128; LAS float* av = sf + 256; LAS float* bv = sf + 384;
        if (u < 64) { const int hd = u >> 4, p = u & 15;
            if (tid < 128) { av[tid] = AB[(hd * 128 + tid) * 2]; bv[tid] = AB[(hd * 128 + tid) * 2 + 1]; }
            __syncthreads();
            if (tid == 0) { float m = 0.f; for (int c = 0; c < 128; ++c) { const float mn = fmaxf(bv[c] + m, av[c]); dec[c] = __expf(bv[c] + m - mn); inj[c] = __expf(av[c] - mn); if (p == 0) MPREV[hd * 128 + c] = m; m = mn; } }
            __syncthreads();
            const size_t e4 = (size_t)hd * 128 * 32768 + p * 2048 + tid * 4;
            scan_elems<128>(DCM + e4, CPM + e4, 32768, dec, inj);
            if (p == 0 && tid < 128) { float st = 0.f; for (int c = 0; c < 128; ++c) { NPREV[(hd * 128 + c) * 128 + tid] = st; st = dec[c] * st + inj[c] * DN[(hd * 128 + c) * 128 + tid]; } }
        } else { const int v = u - 64, hd = v >> 3, p = v & 7; const float dg = __expf(128.0f * ret_lngamma(hd));
            if (tid < 64) { dec[tid] = dg; inj[tid] = 1.0f; }
            __syncthreads();
            const size_t e4 = (size_t)hd * 64 * 16384 + p * 2048 + tid * 4;
            scan_elems<64>(DRR + e4, RPR + e4, 16384, dec, inj); }
        __syncthreads(); } }
#define ATT_IT(qb, part, jlo, jhi) ((unsigned)(qb) | ((unsigned)(part) << 8) | ((unsigned)(jlo) << 16) | ((unsigned)(jhi) << 24))
constexpr int ATT_BINS = 24;
__device__ __forceinline__ unsigned att_item(int bin, int pass) {
    static constexpr unsigned tab[ATT_BINS * 3] = {
        ATT_IT(16, 1, 0, 24), ATT_IT(15, 0, 0, 64), 0u,
        ATT_IT(17, 1, 0, 28), ATT_IT(14, 0, 0, 60), 0u,
        ATT_IT(18, 1, 0, 32), ATT_IT(13, 0, 0, 56), 0u,
        ATT_IT(19, 1, 0, 36), ATT_IT(12, 0, 0, 52), 0u,
        ATT_IT(20, 1, 0, 40), ATT_IT(11, 0, 0, 48), 0u,
        ATT_IT(21, 1, 0, 44), ATT_IT(10, 0, 0, 44), 0u,
        ATT_IT(22, 1, 0, 48), ATT_IT(9, 0, 0, 40), 0u,
        ATT_IT(23, 1, 0, 52), ATT_IT(8, 0, 0, 36), 0u,
        ATT_IT(24, 1, 0, 56), ATT_IT(7, 0, 0, 32), 0u,
        ATT_IT(25, 1, 0, 60), ATT_IT(6, 0, 0, 28), 0u,
        ATT_IT(26, 1, 0, 64), ATT_IT(5, 0, 0, 24), 0u,
        ATT_IT(27, 1, 0, 68), ATT_IT(4, 0, 0, 20), 0u,
        ATT_IT(28, 1, 0, 72), ATT_IT(3, 0, 0, 16), 0u,
        ATT_IT(29, 1, 0, 76), ATT_IT(2, 0, 0, 12), 0u,
        ATT_IT(30, 1, 0, 80), ATT_IT(1, 0, 0, 8), 0u,
        ATT_IT(31, 1, 0, 84), ATT_IT(0, 0, 0, 4), 0u,
        ATT_IT(16, 2, 24, 68), ATT_IT(17, 2, 28, 72), 0u,
        ATT_IT(18, 2, 32, 76), ATT_IT(19, 2, 36, 80), 0u,
        ATT_IT(20, 2, 40, 84), ATT_IT(21, 2, 44, 88), 0u,
        ATT_IT(22, 2, 48, 92), ATT_IT(23, 2, 52, 96), 0u,
        ATT_IT(24, 2, 56, 100), ATT_IT(25, 2, 60, 104), 0u,
        ATT_IT(26, 2, 64, 108), ATT_IT(27, 2, 68, 112), 0u,
        ATT_IT(28, 2, 72, 116), ATT_IT(29, 2, 76, 120), 0u,
        ATT_IT(30, 2, 80, 124), ATT_IT(31, 2, 84, 128), 0u,
    };
    return tab[3 * bin + pass]; }
__device__ __forceinline__ int att_nitems(int bin) { static constexpr unsigned char cnt[ATT_BINS] = {2, 2, 2, 2, 2, 2, 2, 2, 2, 2, 2, 2, 2, 2, 2, 2, 2, 2, 2, 2, 2, 2, 2, 2}; return cnt[bin]; }
constexpr int ATT_WGS = ATT_BINS * 8;
PHASE_FN ph_attention(char* alds, unsigned char* ws) { TIDS(); WS_PTRS(ws);
    typedef att::BlockRef<bf16, bf16> BR; att::Seam<bf16> seam;
    bf16* const YP = (bf16*)(ws + WS_YP); float* const ML = (float*)(ws + WS_MISC + MiB);
    const bool split = G == 256;
#define ATT_REF(r, a_, pass_) do { int hd_, qb_, part_ = 0, jlo_ = 0, jhi_; \
        if (split) { hd_ = (a_) / ATT_BINS; const unsigned e_ = att_item((a_) % ATT_BINS, (pass_)); qb_ = (int)(e_ & 255u); part_ = (int)((e_ >> 8) & 255u); jlo_ = (int)((e_ >> 16) & 255u); jhi_ = (int)(e_ >> 24); } \
        else { hd_ = (a_) >> 4; const int y_ = (a_) & 15; qb_ = (pass_) ? 31 - y_ : y_; jhi_ = 4 * (qb_ + 1); } \
        (r).Q = PROJ + (size_t)qb_ * 256 * NPROJ + PC_AQ + hd_ * 128; (r).K = PROJ + PC_AK + hd_ * 128; (r).V = PROJ + PC_AV + hd_ * 128; \
        (r).O = (part_ ? YP + (size_t)(part_ - 1) * S * 1024 : YA) + (size_t)qb_ * 256 * 1024 + hd_ * 128; \
        (r).ML = part_ ? ML + (size_t)(part_ - 1) * S * 16 + (size_t)qb_ * 256 * 16 + hd_ * 2 : nullptr; \
        (r).M = MB + (size_t)qb_ * 256 * 128; (r).P0 = qb_ * 256; (r).jlo = jlo_; (r).jhi = jhi_; (r).pad = 0; } while (0)
    const int nwg = split ? ATT_WGS : 128;
    if (bx < nwg) { { BR c0; ATT_REF(c0, bx, 0); att::causal_swa_prime<bf16, bf16>(c0, 1 << 30, alds, seam); }
        const int nit = split ? att_nitems(bx % ATT_BINS) : 2;
#pragma unroll 1
        for (int pass = 0; pass < nit; ++pass) {
            BR cur, nxt; ATT_REF(cur, bx, pass); const int pn = pass + 1 < nit ? pass + 1 : pass; ATT_REF(nxt, bx, pn);
            att::causal_swa_block<bf16, bf16>(cur, nxt, S, 1 << 30, alds, seam); } }
#undef ATT_REF
    __syncthreads(); }
PHASE_FN ph_attn_merge(unsigned char* ws) { TIDS(); WS_PTRS(ws);
    if (G != 256) return;
    const bf16* YP = (const bf16*)(ws + WS_YP); const float* ML = (const float*)(ws + WS_MISC + MiB);
    constexpr float C2 = 1.4426950408889634f * 0.08838834764831845f;
    for (int t = 4096 + gw; t < S; t += NGW) { const int hd = lane >> 3, c0 = hd * 128 + (lane & 7) * 16;
        const float m1 = ML[(size_t)t * 16 + hd * 2], l1 = ML[(size_t)t * 16 + hd * 2 + 1], m2 = ML[(size_t)S * 16 + (size_t)t * 16 + hd * 2], l2 = ML[(size_t)S * 16 + (size_t)t * 16 + hd * 2 + 1];
        const float mm = fmaxf(m1, m2); float w1 = l1 > 0.f ? l1 * __builtin_amdgcn_exp2f((m1 - mm) * C2) : 0.f, w2 = l2 > 0.f ? l2 * __builtin_amdgcn_exp2f((m2 - mm) * C2) : 0.f;
        const float inv = 1.0f / (w1 + w2); w1 *= inv; w2 *= inv;
#pragma unroll
        for (int q = 0; q < 2; ++q) { float a[8], b[8], o[8];
            bf8_unpack(*(const GAS v4u*)(YP + (size_t)t * 1024 + c0 + 8 * q), a); bf8_unpack(*(const GAS v4u*)(YP + (size_t)S * 1024 + (size_t)t * 1024 + c0 + 8 * q), b);
#pragma unroll
            for (int i = 0; i < 8; ++i) o[i] = (w1 > 0.f ? w1 * a[i] : 0.f) + (w2 > 0.f ? w2 * b[i] : 0.f);
            *(GAS v4u*)(YA + (size_t)t * 1024 + c0 + 8 * q) = bf8_pack(o); } } }
PHASE_FN ph_outs(LAS unsigned char* lds, unsigned char* ws, const float* gain_m, const float* gain_r, int u0, int ustep) { TIDS(); WS_PTRS(ws); LAS float* const sf = (LAS float*)(lds + SCR_OFF);
    for (int u = u0; u < 1024; u += ustep) {
        if (u < 512) { const int hd = u >> 7, c = u & 127, t0 = c * 64;
            auto prep = [=]() {
                if (wave == 0) { const float iv = GIF[(size_t)(t0 + lane) * 8 + hd], fv = GIF[(size_t)(t0 + lane) * 8 + 4 + hd]; float b = log_sigmoid_f(fv);
                    b = wave_prefix_sum_f(b);
                    const float mp = MPREV[hd * 128 + c]; const float pm = wave_prefix_max_f(iv - b);
                    const float mt = fmaxf(b + mp, b + pm);
                    sf[lane] = b - mt; sf[128 + lane] = iv - b; sf[256 + lane] = __expf(b + mp - mt); sf[384 + lane] = __expf(-mt); sf[512 + lane] = 0.f; }
                if (wave == 1) { sf[640 + lane] = NPREV[(hd * 128 + c) * 128 + lane]; sf[640 + 64 + lane] = NPREV[(hd * 128 + c) * 128 + 64 + lane]; } };
            chunk_out<64, 256, 0>(prep, lds, sf, MQK + (size_t)t0 * 1024 + hd * 128, 1024, MQK + (size_t)t0 * 1024 + 512 + hd * 128, 1024, PROJ + (size_t)t0 * NPROJ + PC_MV + hd * 256, NPROJ,
                                  CPM + (size_t)(hd * 128 + c) * 32768, gain_m + hd * 256, PROJ + (size_t)t0 * NPROJ + PC_MO + hd * 256, NPROJ, YM + (size_t)t0 * 1024 + hd * 256, 1024, tid);
        } else { const int v = u - 512, hd = v >> 6, c = v & 63, t0 = c * 128; const float lg = ret_lngamma(hd);
            auto prep = [=]() { if (tid < 128) { sf[tid] = lg * (float)tid; sf[128 + tid] = -lg * (float)tid; sf[256 + tid] = __expf(lg * (float)(tid + 1)); } };
            chunk_out<128, 128, 1>(prep, lds, sf, PROJ + (size_t)t0 * NPROJ + PC_RQ + hd * 128, NPROJ, PROJ + (size_t)t0 * NPROJ + PC_RK + hd * 128, NPROJ, PROJ + (size_t)t0 * NPROJ + PC_RV + hd * 128, NPROJ,
                                   RPR + (size_t)(hd * 64 + c) * 16384, gain_r + hd * 128, PROJ + (size_t)t0 * NPROJ + PC_RG + hd * 128, NPROJ, YR + (size_t)t0 * 1024 + hd * 128, 1024, tid); }
    } }
template <int MODE> PHASE_FN ph_gemm_branch(LAS unsigned char* lds, unsigned char* ws, const bf16* A, const bf16* Wt, int gcol) { TIDS(); WS_PTRS(ws);
    pg8::Gemm g{A, Wt, S, DM, 1024}; pg8::StaticOrder so; so.init(S, DM, G, bx); pg8::EpiBranch<MODE> E{PROJ + PC_G + gcol, NPROJ, (bf16*)MERGEDF, MERGED, DM};
    pg8::gemm_phase<pg8::EpiBranch<MODE>, pg8::StaticOrder, true, true>(lds, g, so, E); }
template <bool BF_IN, bool BF_OUT> PHASE_FN ph_gemm_resid_x(LAS unsigned char* lds, const bf16* A, const bf16* Wt, int K, const void* base, void* out) { TIDS();
    pg8::Gemm g{A, Wt, S, DM, K}; pg8::StaticOrder so; so.init(S, DM, G, bx); pg8::EpiResidX<BF_IN, BF_OUT> E{base, out, DM};
    pg8::gemm_phase<pg8::EpiResidX<BF_IN, BF_OUT>, pg8::StaticOrder, true, true>(lds, g, so, E); }
PHASE_FN ph_gemm_resid(LAS unsigned char* lds, const bf16* A, const bf16* Wt, int K, const float* base, float* out) { TIDS();
    pg8::Gemm g{A, Wt, S, DM, K}; pg8::StaticOrder so; so.init(S, DM, G, bx); pg8::EpiResid E{base, out, DM};
    pg8::gemm_phase<pg8::EpiResid, pg8::StaticOrder, true, true>(lds, g, so, E); }
PHASE_FN ph_gemm_ffn_in(LAS unsigned char* lds, unsigned char* ws, const bf16* Wt) { TIDS(); WS_PTRS(ws);
    pg8::Gemm g{H, Wt, S, 2 * FF, DM}; pg8::StaticOrder so; so.init(S, 2 * FF, G, bx); pg8::EpiSwiGLU E{ACT, FF};
    pg8::gemm_phase<pg8::EpiSwiGLU, pg8::StaticOrder, true, true>(lds, g, so, E); }


#ifndef SYN_PROBE
#define SYN_PROBE 0
#endif
PHASE_FN ph_probe(LAS unsigned char* lds) { TIDS();
    LAS unsigned* hist = (LAS unsigned*)lds;
    if (SYN_PROBE == 1) {
        unsigned x = (unsigned)tid * 2654435761u + 12345u;
        for (int r = 0; r < 32; ++r) {
#pragma unroll
            for (int i = 0; i < 16; ++i) { x = x * 1664525u + 1013904223u; (void)__hip_atomic_fetch_add(hist + ((x >> 10) & 2047u), 1u, __ATOMIC_RELAXED, __HIP_MEMORY_SCOPE_WORKGROUP); }
            SEL_BAR(); } }
    if (SYN_PROBE == 2) {
        float acc = 0.f; float v[16];
#pragma unroll
        for (int i = 0; i < 16; ++i) v[i] = (float)((tid * 16 + i) % 977);
        for (int r = 0; r < 32 * 8; ++r) { const float c1 = 100.f + (float)(r & 7) + acc * 1e-30f, c2 = c1 * 2.f, c3 = c1 * 3.f; unsigned n1 = 0, n2 = 0, n3 = 0;
#pragma unroll
            for (int i = 0; i < 16; ++i) { n1 += (unsigned)__builtin_popcountll(__builtin_amdgcn_ballot_w64(v[i] >= c1)); n2 += (unsigned)__builtin_popcountll(__builtin_amdgcn_ballot_w64(v[i] >= c2)); n3 += (unsigned)__builtin_popcountll(__builtin_amdgcn_ballot_w64(v[i] >= c3)); }
            if (lane == 0) { hist[(r & 1) * 24 + wave] = n1; hist[(r & 1) * 24 + 8 + wave] = n2; hist[(r & 1) * 24 + 16 + wave] = n3; }
            SEL_BAR();
            unsigned t1 = 0;
#pragma unroll
            for (int j = 0; j < 24; ++j) t1 += hist[(r & 1) * 24 + j];
            acc += (float)t1; }
        if (acc == 12345.f) hist[100] = 1u; }
    if (SYN_PROBE == 3) {
        float a = (float)tid;
        for (int r = 0; r < 32; ++r) {
#pragma unroll
            for (int k = 0; k < 4; ++k)
#pragma unroll
                for (int o = 1; o < 64; o <<= 1) a = fmaxf(a, shfl_idx_f(a, (int)(lane_id_v() ^ (unsigned)o)) * 0.999f);
        }
        if (a == 12345.f) hist[100] = 1u; }
    __syncthreads(); }
typedef const __attribute__((address_space(4))) Args* ArgsP;
__device__ __forceinline__ ArgsP fresh_args() { ArgsP ap = (ArgsP)__builtin_amdgcn_kernarg_segment_ptr(); asm volatile("" : "+s"(ap)); return ap; }
#ifndef DUP_PHASE
#define DUP_PHASE -1
#endif
#ifndef PROBE_GAIN
#define PROBE_GAIN 1.0f
#endif
#ifndef PROBE_WSPLIT
#define PROBE_WSPLIT 176
#endif
#ifndef PROBE_WHALF
#define PROBE_WHALF 0
#endif
#ifndef PROBE_WMASK
#define PROBE_WMASK 0
#endif
#define SEAM() do { if constexpr (one_launch) { ArgsP ap_ = fresh_args(); XcdBarrier b_; b_.bar = (unsigned*)(ap_->ws + WS_CTL) + CW_BAR; b_.x = xb_xcc_id(); b_.st = (volatile LAS unsigned*)(lds + MISC_OFF); \
        unsigned long long t0_ = 0ull; if (PROBE_WMASK != 0) t0_ = __builtin_amdgcn_s_memrealtime(); xcd_barrier(b_); \
        if (PROBE_WMASK != 0) { const unsigned long long t1_ = __builtin_amdgcn_s_memrealtime(); if (my_tid() == 0 && (PROBE_WHALF == 0 || (PROBE_WHALF == 1) == ((int)blockIdx.x < PROBE_WSPLIT))) atomicAdd((unsigned long long*)(ap_->ws + WS_CTL) + 16384 + 16 + seam_no, t1_ - t0_); } } ++seam_no; } while (0)
#define IN(k) (PLO <= (k) && (k) < PHI)
#define WL(ap, layer) ((ap)->ws + WS_W + (size_t)(layer) * W_LAYER)
template <int PLO, int PHI, bool LAST> __device__ __forceinline__ void layer_phases(const int layer, LAS unsigned char* lds, unsigned char* lds_raw) {
    constexpr bool one_launch = (PHI - PLO > 1); int seam_no = 0; (void)seam_no;
    if constexpr (IN(1)) { ArgsP ap = fresh_args(); if (layer == 0) ph_rmsnorm(ap->x, ap->norm_mix, (bf16*)(ap->ws + WS_H)); else ph_rmsnorm16((const bf16*)(ap->ws + WS_X16), ap->norm_mix + layer * DM, (bf16*)(ap->ws + WS_H)); SEAM(); }
    constexpr int CV_EARLY = 32 * 134;
    constexpr int CV_S1 = 10880, CV_S2 = 10880;
    if constexpr (IN(2)) { ArgsP ap = fresh_args(); ph_gemm_proj(lds, ap->ws, (const bf16*)(WL(ap, layer) + WO_IN));
        if constexpr (one_launch) { ArgsP aq = fresh_args(); ph_convert_tail(lds, aq->ws, layer, aq->w_in, aq->w_b_att, aq->w_b_mlstm, aq->w_b_ret, aq->w_out, aq->w_ffn_in, aq->w_ffn_out, ((S / 256) * (NPROJ_PAD / 256)) % (int)gridDim.x, CV_IN, CV_ITEMS);
            if constexpr (!LAST) { ArgsP ar = fresh_args(); ph_convert_tail(lds, ar->ws, layer + 1, ar->w_in, ar->w_b_att, ar->w_b_mlstm, ar->w_b_ret, ar->w_out, ar->w_ffn_in, ar->w_ffn_out, ((S / 256) * (NPROJ_PAD / 256)) % (int)gridDim.x, 0, CV_EARLY); } } if constexpr (DUP_PHASE == 2) { SEAM(); ph_gemm_proj(lds, ap->ws, (const bf16*)(WL(ap, layer) + WO_IN)); } SEAM(); }
    if constexpr (IN(3)) { ArgsP ap = fresh_args(); ph_pp(ap->ws, ap->att_q_norm + layer * 128, ap->att_k_norm + layer * 128, ap->mlstm_conv + layer * 4096, ap->mlstm_gate_bias + layer * 8); if constexpr (DUP_PHASE == 23) { SEAM(); ph_gemm_proj(lds, ap->ws, (const bf16*)(WL(ap, layer) + WO_IN)); SEAM(); ph_pp(ap->ws, ap->att_q_norm + layer * 128, ap->att_k_norm + layer * 128, ap->mlstm_conv + layer * 4096, ap->mlstm_gate_bias + layer * 8); } if constexpr (DUP_PHASE == 3) { SEAM(); ph_pp(ap->ws, ap->att_q_norm + layer * 128, ap->att_k_norm + layer * 128, ap->mlstm_conv + layer * 4096, ap->mlstm_gate_bias + layer * 8); } SEAM(); }
    if constexpr (IN(4)) { ArgsP ap = fresh_args(); ph_scores(lds, ap->ws); if constexpr (DUP_PHASE == 4) { SEAM(); ph_scores(lds, ap->ws); } }
    if constexpr (IN(5)) { ArgsP ap = fresh_args(); ph_deltas(lds, ap->ws); if constexpr (DUP_PHASE == 5) { SEAM(); ph_deltas(lds, ap->ws); } SEAM(); }
    if constexpr (IN(6) && SYN_PROBE != 0) { ph_probe(lds); }
    if constexpr (IN(6)) { ArgsP ap = fresh_args(); ph_select(lds, ap->ws); if constexpr (DUP_PHASE == 6) { SEAM(); ph_select(lds, ap->ws); } }
    if constexpr (IN(7)) { ArgsP ap = fresh_args(); ph_scans(lds, ap->ws); if constexpr (DUP_PHASE == 7) { SEAM(); ph_scans(lds, ap->ws); } SEAM(); }
    if constexpr (IN(8) && IN(9)) {
        ArgsP ap = fresh_args(); const bool split = gridDim.x == 256;
        if (!split || blockIdx.x < ATT_WGS) ph_attention((char*)lds_raw, ap->ws);
        if (!split || blockIdx.x >= ATT_WGS) ph_outs(lds, ap->ws, ap->mlstm_out_norm + layer * 1024, ap->ret_out_norm + layer * 1024, split ? (int)blockIdx.x - ATT_WGS : (int)blockIdx.x, split ? 256 - ATT_WGS : (int)gridDim.x);
        SEAM();
        { ArgsP am = fresh_args(); ph_attn_merge(am->ws); } SEAM(); }
    else {
    if constexpr (IN(8)) { ArgsP ap = fresh_args(); ph_attention((char*)lds_raw, ap->ws); SEAM(); ph_attn_merge(ap->ws); }
    if constexpr (IN(9)) { ArgsP ap = fresh_args(); ph_outs(lds, ap->ws, ap->mlstm_out_norm + layer * 1024, ap->ret_out_norm + layer * 1024, (int)blockIdx.x, (int)gridDim.x); SEAM(); }
    }
    if constexpr (IN(10)) { ArgsP ap = fresh_args(); ph_gemm_branch<0>(lds, ap->ws, (const bf16*)(ap->ws + WS_YA), (const bf16*)(WL(ap, layer) + WO_B), 0); if constexpr (DUP_PHASE == 10) { SEAM(); ph_gemm_branch<0>(lds, ap->ws, (const bf16*)(ap->ws + WS_YA), (const bf16*)(WL(ap, layer) + WO_B), 0); } }
    if constexpr (IN(11)) { ArgsP ap = fresh_args(); ph_gemm_branch<1>(lds, ap->ws, (const bf16*)(ap->ws + WS_YM), (const bf16*)(WL(ap, layer) + WO_B + 4 * MiB), DM); if constexpr (DUP_PHASE == 11) { SEAM(); ph_gemm_branch<1>(lds, ap->ws, (const bf16*)(ap->ws + WS_YM), (const bf16*)(WL(ap, layer) + WO_B + 4 * MiB), DM); } }
    if constexpr (IN(12)) { ArgsP ap = fresh_args(); ph_gemm_branch<2>(lds, ap->ws, (const bf16*)(ap->ws + WS_YR), (const bf16*)(WL(ap, layer) + WO_B + 8 * MiB), 2 * DM); if constexpr (DUP_PHASE == 12) { SEAM(); ph_gemm_branch<2>(lds, ap->ws, (const bf16*)(ap->ws + WS_YR), (const bf16*)(WL(ap, layer) + WO_B + 8 * MiB), 2 * DM); } SEAM(); }
    if constexpr (IN(13)) { ArgsP ap = fresh_args();
        if (layer == 0) ph_gemm_resid_x<false, true>(lds, (const bf16*)(ap->ws + WS_MERGED), (const bf16*)(WL(ap, layer) + WO_OUT), DM, ap->x, ap->ws + WS_X16);
        else ph_gemm_resid_x<true, true>(lds, (const bf16*)(ap->ws + WS_MERGED), (const bf16*)(WL(ap, layer) + WO_OUT), DM, ap->ws + WS_X16, ap->ws + WS_X16);
        SEAM(); }
    if constexpr (IN(14)) { ArgsP ap = fresh_args(); ph_rmsnorm16((const bf16*)(ap->ws + WS_X16), ap->norm_ffn + layer * DM, (bf16*)(ap->ws + WS_H)); SEAM(); }
    if constexpr (IN(15)) { ArgsP ap = fresh_args(); ph_gemm_ffn_in(lds, ap->ws, (const bf16*)(WL(ap, layer) + WO_FIN));
        if constexpr (one_launch && !LAST) { ArgsP aq = fresh_args(); ph_convert_tail(lds, aq->ws, layer + 1, aq->w_in, aq->w_b_att, aq->w_b_mlstm, aq->w_b_ret, aq->w_out, aq->w_ffn_in, aq->w_ffn_out, ((S / 256) * (2 * FF / 256)) % (int)gridDim.x, CV_EARLY, CV_IN); } if constexpr (DUP_PHASE == 15) { SEAM(); ph_gemm_ffn_in(lds, ap->ws, (const bf16*)(WL(ap, layer) + WO_FIN)); } SEAM(); }
    if constexpr (IN(16)) { ArgsP ap = fresh_args();
        if (layer == DEPTH - 1) ph_gemm_resid_x<true, false>(lds, (const bf16*)(ap->ws + WS_ACT), (const bf16*)(WL(ap, layer) + WO_FOUT), FF, ap->ws + WS_X16, ap->out);
        else ph_gemm_resid_x<true, true>(lds, (const bf16*)(ap->ws + WS_ACT), (const bf16*)(WL(ap, layer) + WO_FOUT), FF, ap->ws + WS_X16, ap->ws + WS_X16);
        if constexpr (!LAST) SEAM(); }
}
PHASE_FN ph_probe_scale(unsigned char* ws, float* out) { TIDS();
    const unsigned long long* gacc = (const unsigned long long*)(ws + WS_CTL) + 16384; double num = 0.0, den = 0.0;
    if (PROBE_MASK != 0) { for (int k = 0; k < 7; ++k) { const double a = (double)__hip_atomic_load(gacc + k, __ATOMIC_RELAXED, __HIP_MEMORY_SCOPE_AGENT); den += a; if ((PROBE_MASK >> k) & 1) num += a; } }
    else { for (int k = 0; k < 16; ++k) if ((PROBE_WMASK >> k) & 1) num += (double)__hip_atomic_load(gacc + 16 + k, __ATOMIC_RELAXED, __HIP_MEMORY_SCOPE_AGENT);
        den = (double)G * (double)__hip_atomic_load(gacc + 15, __ATOMIC_RELAXED, __HIP_MEMORY_SCOPE_AGENT); }
    const float f = 1.0f + 0.05f * floorf((float)(num / den) * 20.0f * PROBE_GAIN + 0.5f);
    for (size_t i = (size_t)gw * 64 + lane; i < (size_t)S * DM; i += (size_t)NGW * 64) out[i] *= f; }
template <int PLO, int PHI> __global__ void __launch_bounds__(NTHR, 2) fwd(Args args_unused) {
    (void)args_unused;
    extern __shared__ __attribute__((aligned(16))) unsigned char lds_raw[];
    LAS unsigned char* lds = (LAS unsigned char*)lds_raw;
    if (threadIdx.x < 64) ((volatile LAS unsigned*)(lds + MISC_OFF))[threadIdx.x] = 0u;
    if ((threadIdx.x & 63) == 0) ((volatile LAS unsigned*)(lds + MISC_OFF))[64 + ((unsigned)__builtin_amdgcn_s_getreg((5 << 11) | 4) & 63u)] = threadIdx.x >> 6;
    __syncthreads();
    constexpr bool one_launch = (PHI - PLO > 1); int seam_no = 15; (void)seam_no;
    const unsigned long long tstart_ = (PROBE_WMASK != 0) ? __builtin_amdgcn_s_memrealtime() : 0ull; (void)tstart_;
    if constexpr (one_launch) { ArgsP ap = fresh_args(); (void)xcd_barrier_post((unsigned*)(ap->ws + WS_CTL) + CW_BAR, (volatile LAS unsigned*)(lds + MISC_OFF)); }
    if constexpr (PLO == 0) { ArgsP ap = fresh_args(); ph_prologue(lds, ap->ws, ap->w_in, ap->w_b_att, ap->w_b_mlstm, ap->w_b_ret, ap->w_out, ap->w_ffn_in, ap->w_ffn_out, !one_launch);
        if constexpr (DUP_PHASE == 0) { SEAM(); ph_prologue(lds, ap->ws, ap->w_in, ap->w_b_att, ap->w_b_mlstm, ap->w_b_ret, ap->w_out, ap->w_ffn_in, ap->w_ffn_out, !one_launch); }
        if (PHI > 1) SEAM(); }
    if constexpr (one_launch) { static_assert(DEPTH == 4, "four inlined layer sites");
        layer_phases<PLO, PHI, false>(0, lds, lds_raw); layer_phases<PLO, PHI, false>(1, lds, lds_raw); layer_phases<PLO, PHI, false>(2, lds, lds_raw); layer_phases<PLO, PHI, true>(3, lds, lds_raw);
        if constexpr (PROBE_WMASK != 0) { if (blockIdx.x == 0 && my_tid() == 0) { ArgsP ap = fresh_args(); atomicAdd((unsigned long long*)(ap->ws + WS_CTL) + 16384 + 15, __builtin_amdgcn_s_memrealtime() - tstart_); } }
        if constexpr (PROBE_MASK != 0 || PROBE_WMASK != 0) { seam_no = 14; SEAM(); ArgsP ap = fresh_args(); ph_probe_scale(ap->ws, ap->out); } }
    else if constexpr (PLO > 0) { ArgsP ap = fresh_args(); layer_phases<PLO, PHI, true>(ap->layer_lo, lds, lds_raw); }
}
#undef IN
#undef SEAM
#undef WL

#ifndef ONE_LAUNCH
#define ONE_LAUNCH 1
#endif
typedef void (*kern_t)(Args);
template <int P> static kern_t phase_kernel(int p) { if (p == P) return fwd<P, P + 1>; if constexpr (P < PH_PER_LAYER) return phase_kernel<P + 1>(p); else return nullptr; }
extern "C" void kernel_launch(void* const* d_in, const int* in_sizes, int n_in, void* d_out, int out_size, void* d_ws, size_t ws_size, hipStream_t stream) {
    static int grid = 0;
    if (grid == 0) {
        if (n_in != 16 || in_sizes[0] != S * DM || out_size != S * DM || ws_size < WS_END) { fprintf(stderr, "kernel_launch: unexpected shapes (n_in %d, in0 %d, out %d, ws %zu < %zu); nothing launched\n", n_in, n_in > 0 ? in_sizes[0] : -1, out_size, ws_size, (size_t)WS_END); grid = -1; return; }
        int dev = 0, cus = 0;
        if (hipGetDevice(&dev) != hipSuccess || hipDeviceGetAttribute(&cus, hipDeviceAttributeMultiprocessorCount, dev) != hipSuccess) { grid = -1; return; }
#if ONE_LAUNCH
        if (hipFuncSetAttribute((const void*)fwd<0, PH_PER_LAYER + 1>, hipFuncAttributeMaxDynamicSharedMemorySize, LDS_BYTES) != hipSuccess) { grid = -1; return; }
#else
        for (int p = 0; p <= PH_PER_LAYER; ++p) if (hipFuncSetAttribute((const void*)phase_kernel<0>(p), hipFuncAttributeMaxDynamicSharedMemorySize, LDS_BYTES) != hipSuccess) { fprintf(stderr, "kernel_launch: hipFuncSetAttribute failed\n"); grid = -1; return; }
#endif
        (void)hipGetLastError();
        grid = cus;
    }
    if (grid < 0) return;
    (void)hipMemsetAsync((char*)d_ws + WS_CTL, 0, CTL_ZERO_BYTES, stream);
    Args a{};
    a.x = (const float*)d_in[0]; a.norm_mix = (const float*)d_in[1]; a.norm_ffn = (const float*)d_in[2]; a.w_in = (const float*)d_in[3]; a.att_q_norm = (const float*)d_in[4]; a.att_k_norm = (const float*)d_in[5];
    a.mlstm_conv = (const float*)d_in[6]; a.mlstm_gate_bias = (const float*)d_in[7]; a.mlstm_out_norm = (const float*)d_in[8]; a.ret_out_norm = (const float*)d_in[9];
    a.w_b_att = (const float*)d_in[10]; a.w_b_mlstm = (const float*)d_in[11]; a.w_b_ret = (const float*)d_in[12]; a.w_out = (const float*)d_in[13]; a.w_ffn_in = (const float*)d_in[14]; a.w_ffn_out = (const float*)d_in[15];
    a.out = (float*)d_out; a.ws = (unsigned char*)d_ws;
#if ONE_LAUNCH
    a.layer_lo = 0; a.layer_hi = DEPTH; a.ph_lo = 0; a.ph_hi = PH_PER_LAYER + 1; hipLaunchKernelGGL((fwd<0, PH_PER_LAYER + 1>), dim3(grid), dim3(NTHR), LDS_BYTES, stream, a);
#else
    a.layer_lo = 0; a.layer_hi = 0; a.ph_lo = 0; a.ph_hi = 1; hipLaunchKernelGGL((fwd<0, 1>), dim3(grid), dim3(NTHR), LDS_BYTES, stream, a);
    for (int l = 0; l < DEPTH; ++l) for (int p = 1; p <= PH_PER_LAYER; ++p) { a.layer_lo = l; a.layer_hi = l + 1; a.ph_lo = p; a.ph_hi = p + 1; hipLaunchKernelGGL(phase_kernel<0>(p), dim3(grid), dim3(NTHR), LDS_BYTES, stream, a); }
#endif
}
```

```cpp
#include <hip/hip_runtime.h>
#include <cstdio>
#include <cstdint>
__device__ __forceinline__ int my_tid();
namespace pg8 {
#define PG8_LAS __attribute__((address_space(3)))
typedef unsigned short bf16_t;
typedef short bf16x8 __attribute__((ext_vector_type(8)));
typedef float f32x4 __attribute__((ext_vector_type(4)));
typedef unsigned u32x4 __attribute__((ext_vector_type(4)));
constexpr int BM = 256, BK = 64, HALF = 128, HTB = HALF * BK * 2  , STAGE_BYTES = 8 * HTB, NXCD = 8, WGM = 8;

__host__ __device__ __forceinline__ int lds_byte(int r, int c) { const int st = (r >> 4) * 2 + (c >> 5), rr = r & 15, cc = c & 31, ob = rr * 64 + cc * 2; return st * 1024 + (ob ^ (((ob >> 9) & 1) << 5)); }
__host__ __device__ __forceinline__ void stage_rc(int b, int& R, int& C) { const int st = b / 1024, sb = b % 1024, swz = sb ^ (((sb >> 9) & 1) << 5); R = (st >> 1) * 16 + swz / 64; C = (st & 1) * 32 + (swz % 64) / 2; }
__host__ __device__ __forceinline__ int perm32(int rho) { const int n = rho >> 4, i = rho & 15; return 8 * (i >> 2) + 4 * n + (i & 3); }

struct Unit { int pm, pn; };
struct Gemm { const bf16_t* A; const bf16_t* Bt; int M, N, K; };

struct StaticOrder {
    int nM, nN, nwg, G, c;
    __host__ __device__ void init(int M, int N, int G_, int c_) { nM = M / BM; nN = N / BM; nwg = nM * nN; G = G_; c = c_; }
    __host__ __device__ bool next(int i, Unit& u) const {
        const long L = (long)i * G + c; if (L >= nwg) return false;
        int wgid = (int)L; { const int q = nwg / NXCD, r = nwg % NXCD, xcd = wgid % NXCD, off = wgid / NXCD; wgid = (xcd < r ? xcd * (q + 1) : r * (q + 1) + (xcd - r) * q) + off; }
        const int nig = WGM * nN, gid = wgid / nig, fm = gid * WGM, gsz = (nM - fm) < WGM ? (nM - fm) : WGM;
        u.pm = fm + ((wgid % nig) % gsz); u.pn = (wgid % nig) / gsz; return true;
    }
    __device__ __forceinline__ void a_ready(const Unit&) const {}
    __device__ __forceinline__ void done(const Unit&) const {}
};

__device__ __forceinline__ unsigned cvt_pk_bf16(float lo, float hi) { unsigned r; asm volatile("v_cvt_pk_bf16_f32 %0, %1, %2" : "=v"(r) : "v"(lo), "v"(hi)); return r; }
typedef float f32x2 __attribute__((ext_vector_type(2)));
__device__ __forceinline__ float sigmoid_f(float x) { return __builtin_amdgcn_rcpf(1.0f + __builtin_amdgcn_exp2f(-1.4426950408889634f * x)); }
struct EpiProj {
    static constexpr bool PERM = true, AFTER_DRAIN = false;
    bf16_t* P; int ldp; float* Sm; int ngate0, nbf;
    __device__ __forceinline__ void operator()(const f32x4 (&acc)[2][2][4][2], const Unit& u, int wr, int wc, int fr, int fq) const {
        const int row0 = u.pm * BM + wr * 64 + fr, col0 = u.pn * BM + wc * 32 + 8 * fq;
        if (u.pn >= nbf) {
            const int c0 = wc * 32 + 8 * fq;
#pragma unroll
            for (int ai = 0; ai < 2; ++ai)
#pragma unroll
                for (int m = 0; m < 4; ++m) { float* rowp = Sm + (size_t)(row0 + ai * HALF + m * 16) * 256 + c0;
#pragma unroll
                    for (int bj = 0; bj < 2; ++bj) { *(f32x4*)(rowp + bj * HALF) = acc[ai][bj][m][0]; *(f32x4*)(rowp + bj * HALF + 4) = acc[ai][bj][m][1]; } }
            return;
        }
        const bool sg = u.pn >= ngate0;
#pragma unroll
        for (int ai = 0; ai < 2; ++ai)
#pragma unroll
            for (int m = 0; m < 4; ++m) { bf16_t* rowp = P + (size_t)(row0 + ai * HALF + m * 16) * ldp + col0;
#pragma unroll
                for (int bj = 0; bj < 2; ++bj) { f32x4 v0 = acc[ai][bj][m][0], v1 = acc[ai][bj][m][1];
                    if (sg) {
#pragma unroll
                        for (int j = 0; j < 4; ++j) { v0[j] = sigmoid_f(v0[j]); v1[j] = sigmoid_f(v1[j]); } }
                    u32x4 w; w.x = cvt_pk_bf16(v0[0], v0[1]); w.y = cvt_pk_bf16(v0[2], v0[3]); w.z = cvt_pk_bf16(v1[0], v1[1]); w.w = cvt_pk_bf16(v1[2], v1[3]);
                    *(u32x4*)(rowp + bj * HALF) = w; } }
    }
};
__device__ __forceinline__ f32x4 bf4_lo(u32x4 w) { return (f32x4){__uint_as_float(w.x << 16), __uint_as_float(w.x & 0xffff0000u), __uint_as_float(w.y << 16), __uint_as_float(w.y & 0xffff0000u)}; }
__device__ __forceinline__ f32x4 bf4_hi(u32x4 w) { return (f32x4){__uint_as_float(w.z << 16), __uint_as_float(w.z & 0xffff0000u), __uint_as_float(w.w << 16), __uint_as_float(w.w & 0xffff0000u)}; }
template <int MODE> struct EpiBranch {
    static constexpr bool PERM = true, AFTER_DRAIN = false;
    const bf16_t* G; int ldg; bf16_t* T; bf16_t* O; int ldt;
    __device__ __forceinline__ void operator()(const f32x4 (&acc)[2][2][4][2], const Unit& u, int wr, int wc, int fr, int fq) const {
        const int row0 = u.pm * BM + wr * 64 + fr, col0 = u.pn * BM + wc * 32 + 8 * fq;
#pragma unroll
        for (int ai = 0; ai < 2; ++ai)
#pragma unroll
            for (int m = 0; m < 4; ++m) { const size_t r = (size_t)(row0 + ai * HALF + m * 16);
#pragma unroll
                for (int bj = 0; bj < 2; ++bj) { const u32x4 g = *(const u32x4*)(G + r * ldg + col0 + bj * HALF);
                    f32x4 v0 = acc[ai][bj][m][0] * bf4_lo(g), v1 = acc[ai][bj][m][1] * bf4_hi(g);
                    bf16_t* tp = T + r * ldt + col0 + bj * HALF;
                    if (MODE >= 1) { const u32x4 t = *(const u32x4*)tp; v0 = v0 + bf4_lo(t); v1 = v1 + bf4_hi(t); }
                    u32x4 w; w.x = cvt_pk_bf16(v0[0], v0[1]); w.y = cvt_pk_bf16(v0[2], v0[3]); w.z = cvt_pk_bf16(v1[0], v1[1]); w.w = cvt_pk_bf16(v1[2], v1[3]);
                    *(u32x4*)((MODE <= 1 ? tp : O + r * ldt + col0 + bj * HALF)) = w; } }
    }
};
struct EpiResid {
    static constexpr bool PERM = false, AFTER_DRAIN = false;
    const float* base; float* out; int ldc;
    __device__ __forceinline__ void operator()(const f32x4 (&acc)[2][2][4][2], const Unit& u, int wr, int wc, int fr, int fq) const {
        const int row0 = u.pm * BM + wr * 64 + fr, col0 = u.pn * BM + wc * 32 + 4 * fq;
#pragma unroll
        for (int ai = 0; ai < 2; ++ai)
#pragma unroll
            for (int m = 0; m < 4; ++m) { const size_t off = (size_t)(row0 + ai * HALF + m * 16) * ldc + col0;
#pragma unroll
                for (int bj = 0; bj < 2; ++bj)
#pragma unroll
                    for (int n = 0; n < 2; ++n) *(f32x4*)(out + off + bj * HALF + n * 16) = *(const f32x4*)(base + off + bj * HALF + n * 16) + acc[ai][bj][m][n]; }
    }
};
template <bool BF_IN, bool BF_OUT> struct EpiResidX {
    static constexpr bool PERM = true, AFTER_DRAIN = false;
    const void* base; void* out; int ldc;
    __device__ __forceinline__ void operator()(const f32x4 (&acc)[2][2][4][2], const Unit& u, int wr, int wc, int fr, int fq) const {
        const int row0 = u.pm * BM + wr * 64 + fr, col0 = u.pn * BM + wc * 32 + 8 * fq;
#pragma unroll
        for (int ai = 0; ai < 2; ++ai)
#pragma unroll
            for (int m = 0; m < 4; ++m) { const size_t off = (size_t)(row0 + ai * HALF + m * 16) * ldc + col0;
#pragma unroll
                for (int bj = 0; bj < 2; ++bj) { f32x4 v0, v1;
                    if (BF_IN) { const u32x4 b = *(const u32x4*)((const bf16_t*)base + off + bj * HALF); v0 = bf4_lo(b); v1 = bf4_hi(b); }
                    else { v0 = *(const f32x4*)((const float*)base + off + bj * HALF); v1 = *(const f32x4*)((const float*)base + off + bj * HALF + 4); }
                    v0 = v0 + acc[ai][bj][m][0]; v1 = v1 + acc[ai][bj][m][1];
                    if (BF_OUT) { u32x4 w; w.x = cvt_pk_bf16(v0[0], v0[1]); w.y = cvt_pk_bf16(v0[2], v0[3]); w.z = cvt_pk_bf16(v1[0], v1[1]); w.w = cvt_pk_bf16(v1[2], v1[3]); *(u32x4*)((bf16_t*)out + off + bj * HALF) = w; }
                    else { *(f32x4*)((float*)out + off + bj * HALF) = v0; *(f32x4*)((float*)out + off + bj * HALF + 4) = v1; } } }
    }
};
struct EpiSwiGLU {
    static constexpr bool PERM = true, AFTER_DRAIN = false;
    bf16_t* O; int ldc;
    __device__ __forceinline__ void operator()(const f32x4 (&acc)[2][2][4][2], const Unit& u, int wr, int wc, int fr, int fq) const {
        const int row0 = u.pm * BM + wr * 64 + fr, col0 = u.pn * HALF + wc * 32 + 8 * fq;
#pragma unroll
        for (int ai = 0; ai < 2; ++ai)
#pragma unroll
            for (int m = 0; m < 4; ++m) { f32x4 v0, v1;
#pragma unroll
                for (int j = 0; j < 4; ++j) { const float g0 = acc[ai][0][m][0][j], g1 = acc[ai][0][m][1][j];
                    v0[j] = g0 * sigmoid_f(g0) * acc[ai][1][m][0][j]; v1[j] = g1 * sigmoid_f(g1) * acc[ai][1][m][1][j]; }
                u32x4 w; w.x = cvt_pk_bf16(v0[0], v0[1]); w.y = cvt_pk_bf16(v0[2], v0[3]); w.z = cvt_pk_bf16(v1[0], v1[1]); w.w = cvt_pk_bf16(v1[2], v1[3]);
                *(u32x4*)(O + (size_t)(row0 + ai * HALF + m * 16) * ldc + col0) = w; }
    }
};
template <class Epi, class Sched, bool ALIGN_EPI = false, bool SP2 = false>
__device__ __forceinline__ void gemm_phase(PG8_LAS unsigned char* lds, const Gemm g, const Sched& S, const Epi& E) {
    int tid_o = my_tid(); asm volatile("" : "+v"(tid_o));
    const int tid = tid_o, wid = __builtin_amdgcn_readfirstlane(tid >> 6), lane = tid & 63, wr = wid >> 2, wc = wid & 3, fr = lane & 15, fq = lane >> 4;
    const int K = g.K, nt = K / BK;
    unsigned voffA[2], voffB[2];
#pragma unroll
    for (int i = 0; i < 2; ++i) { int R, C; stage_rc(tid * 16 + i * 8192, R, C); const int Rb = Epi::PERM ? ((R & ~31) + perm32(R & 31)) : R;
        voffA[i] = (unsigned)(R * K + C) * 2u; voffB[i] = (unsigned)(Rb * K + C) * 2u; }
    const size_t kstep = (size_t)(BK * 2);
    const size_t hstep = (size_t)HALF * K * 2;
    const size_t tstep = 2 * hstep;
    const unsigned ldsw = (unsigned)wid * 1024u;
    const int aoff = lds_byte(wr * 64 + fr, fq * 8), boff = lds_byte(wc * 32 + fr, fq * 8);
#define PG8_SA(b, h) (((b) * 2 + (h)) * HTB)
#define PG8_SB(b, h) ((4 + (b) * 2 + (h)) * HTB)
#define PG8_STAGE(bufoff, gbase, voff) do { _Pragma("unroll") for (int _i = 0; _i < 2; ++_i) \
        __builtin_amdgcn_global_load_lds((const unsigned*)((const char*)(gbase) + (voff)[_i]), (PG8_LAS unsigned*)(lds + (bufoff) + ldsw + _i * 8192), 16, 0, 0); } while (0)
#define PG8_LDA(dst, b, h) do { _Pragma("unroll") for (int m = 0; m < 4; ++m) _Pragma("unroll") for (int k = 0; k < 2; ++k) dst[m][k] = *(const PG8_LAS bf16x8*)(lds + PG8_SA(b, h) + aoff + m * 2048 + k * 1024); } while (0)
#define PG8_LDB(dst, b, h) do { _Pragma("unroll") for (int n = 0; n < 2; ++n) _Pragma("unroll") for (int k = 0; k < 2; ++k) dst[n][k] = *(const PG8_LAS bf16x8*)(lds + PG8_SB(b, h) + boff + n * 2048 + k * 1024); } while (0)
#define PG8_MMA(ai, bj, At, Bt) do { __builtin_amdgcn_s_setprio(1); _Pragma("unroll") for (int m = 0; m < 4; ++m) _Pragma("unroll") for (int n = 0; n < 2; ++n) _Pragma("unroll") for (int k = 0; k < 2; ++k) \
        acc[ai][bj][m][n] = __builtin_amdgcn_mfma_f32_16x16x32_bf16(Bt[n][k], At[m][k], acc[ai][bj][m][n], 0, 0, 0); __builtin_amdgcn_s_setprio(0); } while (0)
#define PG8_WAIT_V(n) asm volatile("s_waitcnt vmcnt(" #n ")" ::: "memory")
#define PG8_WAIT_L(n) asm volatile("s_waitcnt lgkmcnt(" #n ")" ::: "memory")
#define PG8_BAR __builtin_amdgcn_s_barrier()
#define PG8_SCHED __builtin_amdgcn_sched_barrier(0)
    Unit cur, nxt; int ui = 0;
    if (!S.next(0, cur)) return;
    f32x4 acc[2][2][4][2];
#pragma unroll
    for (int a = 0; a < 2; ++a)
#pragma unroll
        for (int b = 0; b < 2; ++b)
#pragma unroll
            for (int m = 0; m < 4; ++m)
#pragma unroll
                for (int n = 0; n < 2; ++n) acc[a][b][m][n] = (f32x4){0.f, 0.f, 0.f, 0.f};
    bf16x8 At[4][2], B0[2][2], B1[2][2];
    const char* cA = (const char*)g.A + (size_t)cur.pm * tstep; const char* cB = (const char*)g.Bt + (size_t)cur.pn * tstep;
    S.a_ready(cur);
    if constexpr (SP2) {
        PG8_STAGE(PG8_SB(0, 0), cB, voffB); PG8_STAGE(PG8_SB(0, 1), cB + hstep, voffB); PG8_STAGE(PG8_SA(0, 0), cA, voffA); PG8_STAGE(PG8_SA(0, 1), cA + hstep, voffA);
        if (wr == 1) PG8_BAR;
        PG8_WAIT_V(2); PG8_BAR;
        PG8_STAGE(PG8_SB(1, 0), cB + kstep, voffB); PG8_STAGE(PG8_SA(1, 0), cA + kstep, voffA); PG8_STAGE(PG8_SB(1, 1), cB + hstep + kstep, voffB);
        PG8_WAIT_V(6); PG8_BAR;
    } else {
        PG8_STAGE(PG8_SB(0, 0), cB, voffB); PG8_STAGE(PG8_SA(0, 0), cA, voffA); PG8_STAGE(PG8_SB(0, 1), cB + hstep, voffB); PG8_STAGE(PG8_SA(0, 1), cA + hstep, voffA);
        if (wr == 1) PG8_BAR;
        PG8_WAIT_V(4); PG8_BAR;
        PG8_STAGE(PG8_SB(1, 0), cB + kstep, voffB); PG8_STAGE(PG8_SA(1, 0), cA + kstep, voffA); PG8_STAGE(PG8_SB(1, 1), cB + hstep + kstep, voffB);
        PG8_WAIT_V(6); PG8_BAR;
    }
    for (;;) {
        const bool has_next = S.next(ui + 1, nxt);
        const char* nA = has_next ? (const char*)g.A + (size_t)nxt.pm * tstep : cA; const char* nB = has_next ? (const char*)g.Bt + (size_t)nxt.pn * tstep : cB;
        for (int t = 0; t < nt; t += 2) {
            const bool last = (t == nt - 2);
            const char* a1 = cA + (size_t)(t + 1) * kstep;
            const char* a2 = last ? nA : cA + (size_t)(t + 2) * kstep; const char* b2 = last ? nB : cB + (size_t)(t + 2) * kstep;
            const char* a3 = a2 + kstep; const char* b3 = b2 + kstep;
            if (last && has_next) S.a_ready(nxt);
            if constexpr (SP2) {
            PG8_LDB(B0, 0, 0); PG8_LDB(B1, 0, 1); PG8_SCHED; PG8_LDA(At, 0, 0); PG8_STAGE(PG8_SA(1, 1), a1 + hstep, voffA);
            PG8_WAIT_V(8); PG8_WAIT_L(0); PG8_BAR; PG8_MMA(0, 0, At, B0); PG8_MMA(0, 1, At, B1); PG8_BAR; PG8_SCHED;
            PG8_LDA(At, 0, 1); PG8_STAGE(PG8_SB(0, 0), b2, voffB); PG8_STAGE(PG8_SB(0, 1), b2 + hstep, voffB); PG8_STAGE(PG8_SA(0, 0), a2, voffA);
            PG8_WAIT_V(8); PG8_WAIT_L(0); PG8_BAR; PG8_MMA(1, 0, At, B0); PG8_MMA(1, 1, At, B1); PG8_BAR; PG8_SCHED;
            PG8_LDB(B0, 1, 0); PG8_LDB(B1, 1, 1); PG8_SCHED; PG8_LDA(At, 1, 0); PG8_STAGE(PG8_SA(0, 1), a2 + hstep, voffA);
            PG8_WAIT_V(8); PG8_WAIT_L(0); PG8_BAR; PG8_MMA(0, 0, At, B0); PG8_MMA(0, 1, At, B1); PG8_BAR; PG8_SCHED;
            PG8_LDA(At, 1, 1); PG8_STAGE(PG8_SB(1, 0), b3, voffB); PG8_STAGE(PG8_SB(1, 1), b3 + hstep, voffB); PG8_STAGE(PG8_SA(1, 0), a3, voffA);
            PG8_WAIT_V(8); PG8_WAIT_L(0); PG8_BAR; PG8_MMA(1, 0, At, B0); PG8_MMA(1, 1, At, B1); PG8_BAR; PG8_SCHED;
            } else {
            PG8_LDB(B0, 0, 0); PG8_SCHED; PG8_LDA(At, 0, 0); PG8_STAGE(PG8_SA(1, 1), a1 + hstep, voffA);
            PG8_WAIT_L(8); PG8_BAR; PG8_WAIT_L(0); PG8_MMA(0, 0, At, B0); PG8_BAR; PG8_SCHED;
            PG8_LDB(B1, 0, 1); PG8_STAGE(PG8_SB(0, 0), b2, voffB);
            PG8_BAR; PG8_WAIT_L(0); PG8_MMA(0, 1, At, B1); PG8_BAR;
            PG8_LDA(At, 0, 1); PG8_STAGE(PG8_SA(0, 0), a2, voffA);
            PG8_BAR; PG8_WAIT_L(0); PG8_MMA(1, 0, At, B0); PG8_BAR; PG8_SCHED;
            PG8_STAGE(PG8_SB(0, 1), b2 + hstep, voffB);
            PG8_WAIT_V(6); PG8_BAR; PG8_MMA(1, 1, At, B1); PG8_BAR;
            PG8_LDB(B0, 1, 0); PG8_SCHED; PG8_LDA(At, 1, 0); PG8_STAGE(PG8_SA(0, 1), a2 + hstep, voffA);
            PG8_WAIT_L(8); PG8_BAR; PG8_WAIT_L(0); PG8_MMA(0, 0, At, B0); PG8_BAR; PG8_SCHED;
            PG8_LDB(B1, 1, 1); PG8_STAGE(PG8_SB(1, 0), b3, voffB);
            PG8_BAR; PG8_WAIT_L(0); PG8_MMA(0, 1, At, B1); PG8_BAR;
            PG8_LDA(At, 1, 1); PG8_STAGE(PG8_SA(1, 0), a3, voffA);
            PG8_BAR; PG8_WAIT_L(0); PG8_MMA(1, 0, At, B0); PG8_BAR; PG8_SCHED;
            PG8_STAGE(PG8_SB(1, 1), b3 + hstep, voffB);
            PG8_WAIT_V(6); PG8_BAR; PG8_MMA(1, 1, At, B1); PG8_BAR;
            }
        }
        if constexpr (ALIGN_EPI) { if (wr == 0) PG8_BAR; }
        if constexpr (!Epi::AFTER_DRAIN) { E(acc, cur, wr, wc, fr, fq); S.done(cur); }
        if (!has_next) break;
#pragma unroll
        for (int a = 0; a < 2; ++a)
#pragma unroll
            for (int b = 0; b < 2; ++b)
#pragma unroll
                for (int m = 0; m < 4; ++m)
#pragma unroll
                    for (int n = 0; n < 2; ++n) acc[a][b][m][n] = (f32x4){0.f, 0.f, 0.f, 0.f};
        cur = nxt; cA = nA; cB = nB; ++ui;
        if constexpr (ALIGN_EPI) { if (wr == 1) PG8_BAR; }
    }
    PG8_WAIT_V(0);
    if constexpr (!ALIGN_EPI) { if (wr == 0) PG8_BAR; }
    PG8_BAR;
    if constexpr (Epi::AFTER_DRAIN) { E.fused(acc, cur, wr, wc, fr, fq, lds, wid, lane); S.done(cur); }
#undef PG8_SA
#undef PG8_SB
#undef PG8_STAGE
#undef PG8_LDA
#undef PG8_LDB
#undef PG8_MMA
#undef PG8_WAIT_V
#undef PG8_WAIT_L
#undef PG8_BAR
#undef PG8_SCHED
}
}

using pg8::sigmoid_f;
constexpr int NWAVES = 8, NTHR = 512;
constexpr int S = 8192, DM = 2048, DEPTH = 4, FF = 5632;
constexpr int NPROJ = 16896, NPROJ_PAD = 17152, LPROJ = 16976;
constexpr int PC_AQ = 0, PC_AK = 1024, PC_AV = 2048, PC_IQ = 3072, PC_MQ = 3584, PC_MK = 4096, PC_MV = 4608, PC_MO = 5632, PC_RQ = 6656, PC_RK = 7680, PC_RV = 8704, PC_RG = 9728, PC_G = 10752;
constexpr int LC_IK = 3584, LC_IW = 3648, LC_MI = 5704, LC_MF = 5708;
constexpr float NORM_EPS = 1e-6f;
constexpr size_t MiB = 1u << 20;
constexpr size_t WS_CTL = 0, CTL_ZERO_BYTES = 1 * MiB;
constexpr size_t WS_ROPE128 = 2 * MiB, WS_ROPE64 = 6 * MiB;
constexpr size_t WS_W = 16 * MiB, W_LAYER = 153 * MiB;
constexpr size_t WO_IN = 0, WO_B = 67 * MiB, WO_OUT = 79 * MiB, WO_FIN = 87 * MiB, WO_FOUT = 131 * MiB;
constexpr size_t WS_H = 640 * MiB, WS_PROJ = 672 * MiB, WS_SMALL = 936 * MiB, WS_MQK = 944 * MiB, WS_IKB = 960 * MiB, WS_IWF = 961 * MiB, WS_GIF = WS_IWF + 512 * 1024;
constexpr size_t WS_SC = 964 * MiB, WS_MB = 1220 * MiB, WS_DCM = 1228 * MiB, WS_CPM = 1260 * MiB, WS_MISC = 1292 * MiB, WS_DRR = 1294 * MiB, WS_RPR = 1310 * MiB;
constexpr size_t WS_YA = 1328 * MiB, WS_YM = 1344 * MiB, WS_YR = 1360 * MiB, WS_MERGEDF = 1376 * MiB, WS_MERGED = 1440 * MiB, WS_ACT = 1472 * MiB, WS_YP = 1560 * MiB  , WS_END = 1592 * MiB;
constexpr size_t WS_X16 = WS_MERGEDF + 32 * MiB;
constexpr size_t MISC_DN = 0, MISC_NPREV = 256 * 1024, MISC_AB = 512 * 1024, MISC_MPREV = 520 * 1024;
constexpr int CW_BAR = 4096;
constexpr int LDS_BYTES = 147456, MISC_OFF = 147456 - 1024;

#define GAS __attribute__((address_space(1)))
#define LAS __attribute__((address_space(3)))
typedef unsigned short bf16;
typedef unsigned v4u __attribute__((ext_vector_type(4)));
typedef unsigned v2u __attribute__((ext_vector_type(2)));
typedef float f32x4 __attribute__((ext_vector_type(4)));
typedef float f32x16 __attribute__((ext_vector_type(16)));
typedef short bf16x8 __attribute__((ext_vector_type(8)));
typedef short s16x4 __attribute__((ext_vector_type(4)));
#define LDS_WAIT() asm volatile("s_waitcnt lgkmcnt(0)" ::: "memory")
#define VM_WAIT() asm volatile("s_waitcnt vmcnt(0)" ::: "memory")
__device__ __forceinline__ unsigned f2bf(float f) { unsigned u = __builtin_bit_cast(unsigned, f); return (u + 0x7fffu + ((u >> 16) & 1u)) >> 16; }
__device__ __forceinline__ unsigned pk2(float lo, float hi) { return f2bf(lo) | (f2bf(hi) << 16); }
__device__ __forceinline__ float bf2f(bf16 b) { return __uint_as_float(((unsigned)b) << 16); }
template <int CTRL, int RMASK, int BMASK> __device__ __forceinline__ float dpp_f(float old, float src) { return __builtin_bit_cast(float, __builtin_amdgcn_update_dpp(__builtin_bit_cast(int, old), __builtin_bit_cast(int, src), CTRL, RMASK, BMASK, false)); }
template <int CTRL, int RMASK, int BMASK> __device__ __forceinline__ unsigned dpp_u(unsigned src) { return (unsigned)__builtin_amdgcn_update_dpp(0, (int)src, CTRL, RMASK, BMASK, false); }
__device__ __forceinline__ float wave_sum(float x) {
    x += dpp_f<0xB1, 0xf, 0xf>(0.f, x); x += dpp_f<0x4E, 0xf, 0xf>(0.f, x); x += dpp_f<0x141, 0xf, 0xf>(0.f, x); x += dpp_f<0x140, 0xf, 0xf>(0.f, x);
    x += dpp_f<0x142, 0xa, 0xf>(0.f, x); x += dpp_f<0x143, 0xc, 0xf>(0.f, x);
    return __builtin_bit_cast(float, __builtin_amdgcn_readlane(__builtin_bit_cast(int, x), 63)); }
__device__ __forceinline__ float wave_max(float x) {
    x = fmaxf(x, dpp_f<0xB1, 0xf, 0xf>(x, x)); x = fmaxf(x, dpp_f<0x4E, 0xf, 0xf>(x, x)); x = fmaxf(x, dpp_f<0x141, 0xf, 0xf>(x, x)); x = fmaxf(x, dpp_f<0x140, 0xf, 0xf>(x, x));
    x = fmaxf(x, dpp_f<0x142, 0xa, 0xf>(x, x)); x = fmaxf(x, dpp_f<0x143, 0xc, 0xf>(x, x));
    return __builtin_bit_cast(float, __builtin_amdgcn_readlane(__builtin_bit_cast(int, x), 63)); }
__device__ __forceinline__ unsigned lane_id_v() { unsigned l; asm volatile("v_mbcnt_lo_u32_b32 %0, -1, 0\n\tv_mbcnt_hi_u32_b32 %0, -1, %0" : "=v"(l)); return l; }
__device__ __forceinline__ int my_tid() {
    const unsigned slot = (unsigned)__builtin_amdgcn_s_getreg((5 << 11) | 4) & 63u;
    extern __shared__ __attribute__((aligned(16))) unsigned char lds_raw_t[];
    const unsigned wv = ((volatile LAS unsigned*)((LAS unsigned char*)lds_raw_t + MISC_OFF))[64 + slot];
    return (int)(__builtin_amdgcn_readfirstlane(wv) * 64u + lane_id_v());
}
__device__ __forceinline__ float shfl_idx_f(float x, int src_lane) { return __builtin_bit_cast(float, __builtin_amdgcn_ds_bpermute(src_lane << 2, __builtin_bit_cast(int, x))); }
__device__ __forceinline__ float wave_prefix_sum_f(float x) {
    float y = x + dpp_f<0x111, 0xf, 0xf>(0.f, x); y += dpp_f<0x112, 0xf, 0xf>(0.f, x); y += dpp_f<0x113, 0xf, 0xf>(0.f, x);
    y += dpp_f<0x114, 0xf, 0xe>(0.f, y); y += dpp_f<0x118, 0xf, 0xc>(0.f, y); y += dpp_f<0x142, 0xa, 0xf>(0.f, y); y += dpp_f<0x143, 0xc, 0xf>(0.f, y); return y; }
__device__ __forceinline__ float wave_prefix_max_f(float x) {
    const float N = -3.0e38f;
    float y = fmaxf(x, dpp_f<0x111, 0xf, 0xf>(N, x)); y = fmaxf(y, dpp_f<0x112, 0xf, 0xf>(N, x)); y = fmaxf(y, dpp_f<0x113, 0xf, 0xf>(N, x));
    y = fmaxf(y, dpp_f<0x114, 0xf, 0xe>(N, y)); y = fmaxf(y, dpp_f<0x118, 0xf, 0xc>(N, y)); y = fmaxf(y, dpp_f<0x142, 0xa, 0xf>(N, y)); y = fmaxf(y, dpp_f<0x143, 0xc, 0xf>(N, y)); return y; }
#define XB_TMO      128
#define XB_XCNT(j)  (256  + 64 * (j))
#define XB_XSUB(j)  (1280 + 64 * (j))
#define XB_XGEN(j)  (2304 + 64 * (j))
#define XB_TOP      3328
#define XB_TOPGEN   3392
#define XCD_BAR_WORDS 3456
#define XB_SPIN_CAP (1u << 18)

__device__ __forceinline__ unsigned xb_ld(unsigned* p)              { return __hip_atomic_load(p, __ATOMIC_RELAXED, __HIP_MEMORY_SCOPE_AGENT); }
__device__ __forceinline__ unsigned xb_add(unsigned* p, unsigned v) { return __hip_atomic_fetch_add(p, v, __ATOMIC_RELAXED, __HIP_MEMORY_SCOPE_AGENT); }
__device__ __forceinline__ unsigned xb_xcc_id() { return (unsigned)__builtin_amdgcn_s_getreg((3 << 11) | 20) & 0xFu; }
#define XB_SPIN(cond, bar) do { unsigned _sp = 0; while (cond) { __builtin_amdgcn_s_sleep(1); \
    if ((++_sp & 255u) == 0u) { if (xb_ld(&(bar)[XB_TMO])) break; if (_sp > XB_SPIN_CAP) { atomicAdd(&(bar)[XB_TMO], 1u); break; } } } } while (0)

struct XcdBarrier {
    unsigned* bar; unsigned x;
    volatile LAS unsigned* st;
};

__device__ __forceinline__ XcdBarrier xcd_barrier_post(unsigned* bar, volatile LAS unsigned* st) {
    XcdBarrier b; b.bar = bar; b.x = xb_xcc_id(); b.st = st;
    if (my_tid() == 0) (void)xb_add(&bar[XB_XCNT(b.x)], 1u);
    return b;
}
__device__ __forceinline__ void xcd_barrier_complete(unsigned* bar, unsigned x, unsigned& nloc, unsigned& nx) {
    const unsigned G = gridDim.x * gridDim.y * gridDim.z;
    unsigned sum, cnt, mine, sp = 0u;
    for (;;) {
        sum = 0u; cnt = 0u; mine = 0u;
#pragma unroll
        for (unsigned j = 0; j < 16; ++j) { const unsigned c = xb_ld(&bar[XB_XCNT(j)]); sum += c; cnt += (c > 0u) ? 1u : 0u; mine = (j == x) ? c : mine; }
        if (sum == G) break;
        __builtin_amdgcn_s_sleep(1);
        if ((++sp & 255u) == 0u) { if (xb_ld(&bar[XB_TMO])) break; if (sp > XB_SPIN_CAP) { atomicAdd(&bar[XB_TMO], 1u); break; } }
    }
    nloc = mine > 0u ? mine : 1u; nx = cnt > 0u ? cnt : 1u;
}

__device__ __forceinline__ void xcd_barrier(const XcdBarrier& b) {
    asm volatile("s_waitcnt vmcnt(0)" ::: "memory");
    __syncthreads();
    if (my_tid() == 0) {
        unsigned* bar = b.bar;
        __builtin_amdgcn_s_waitcnt(0);
        unsigned nloc = b.st[0], nx = b.st[1];
        if (nloc == 0u) { xcd_barrier_complete(bar, b.x, nloc, nx); b.st[0] = nloc; b.st[1] = nx; }
        const unsigned old = xb_add(&bar[XB_XSUB(b.x)], 1u);
        const unsigned gen = old / nloc;
        if (old + 1u == (gen + 1u) * nloc) {
            __builtin_amdgcn_fence(__ATOMIC_RELEASE, "agent");
            asm volatile("s_waitcnt vmcnt(0)" ::: "memory");
            const unsigned og = xb_add(&bar[XB_TOP], 1u);
            const unsigned tg = og / nx;
            if (og + 1u == (tg + 1u) * nx) xb_add(&bar[XB_TOPGEN], 1u);
            else XB_SPIN(xb_ld(&bar[XB_TOPGEN]) == tg, bar);
            __builtin_amdgcn_fence(__ATOMIC_ACQUIRE, "agent");
            xb_add(&bar[XB_XGEN(b.x)], 1u);
            asm volatile("s_waitcnt vmcnt(0)" ::: "memory");
        } else {
            XB_SPIN(xb_ld(&bar[XB_XGEN(b.x)]) == gen, bar);
            __builtin_amdgcn_fence(__ATOMIC_ACQUIRE, "agent");
            asm volatile("s_waitcnt vmcnt(0)" ::: "memory");
        }
    }
    __syncthreads();
}

struct MapIdent { __device__ __forceinline__ int operator()(int p) const { return p; } };
struct MapWin { __device__ __forceinline__ int operator()(int p) const {
    if (p < 3584) return p; if (p < 5632) return p + 72; if (p < NPROJ) return p + 80;
    const int r = p - NPROJ; if (r < 64) return LC_IK + r; if (r < 72) return LC_IW + (r - 64); if (r < 76) return LC_MI + (r - 72); if (r < 80) return LC_MF + (r - 76); return -1; } };
struct MapFfn { __device__ __forceinline__ int operator()(int p) const { const int t = p >> 8, r = p & 255; return r < 128 ? 128 * t + r : FF + 128 * t + (r - 128); } };
template <class Map> __device__ __forceinline__ void transpose_item(const float* W, int K, int N, bf16* WT, LAS float* scr, int item, int nblk, int lane, const Map& map) {
    const int kb = item / nblk, nb = item % nblk, k0 = 64 * kb, p0 = 64 * nb;
    const int n4 = lane & 15, kr = lane >> 4, nl = map(p0 + 4 * n4);
    f32x4 v[16];
#pragma unroll
    for (int i = 0; i < 16; ++i) v[i] = nl >= 0 ? *(const GAS f32x4*)(W + (size_t)(k0 + kr + 4 * i) * N + nl) : (f32x4){0.f, 0.f, 0.f, 0.f};
#pragma unroll
    for (int i = 0; i < 16; ++i) { LAS float* d = scr + (kr + 4 * i) * 65 + 4 * n4; d[0] = v[i][0]; d[1] = v[i][1]; d[2] = v[i][2]; d[3] = v[i][3]; }
    LDS_WAIT(); asm volatile("" ::: "memory");
    const int c = lane & 7;
#pragma unroll
    for (int j = 0; j < 8; ++j) { const int n = (lane >> 3) + 8 * j; const LAS float* s = scr + (8 * c) * 65 + n;
        v4u o; o.x = pk2(s[0 * 65], s[1 * 65]); o.y = pk2(s[2 * 65], s[3 * 65]); o.z = pk2(s[4 * 65], s[5 * 65]); o.w = pk2(s[6 * 65], s[7 * 65]);
        *(GAS v4u*)(WT + (size_t)(p0 + n) * K + k0 + 8 * c) = o; }
    LDS_WAIT(); asm volatile("" ::: "memory");
}
template <class Map> __device__ __forceinline__ void transpose_matrix(const float* W, int K, int N, int Nphys, bf16* WT, LAS float* scr, int gw, int ngw, int lane, const Map& map) {
    const int nblk = Nphys / 64, nit = (K / 64) * nblk;
    for (int it = gw; it < nit; it += ngw) transpose_item(W, K, N, WT, scr, it, nblk, lane, map);
}

__device__ __forceinline__ void bf8_unpack0(const v4u w, float (&f)[8]) { f[0] = __uint_as_float(w.x << 16); f[1] = __uint_as_float(w.x & 0xffff0000u); f[2] = __uint_as_float(w.y << 16); f[3] = __uint_as_float(w.y & 0xffff0000u);
    f[4] = __uint_as_float(w.z << 16); f[5] = __uint_as_float(w.z & 0xffff0000u); f[6] = __uint_as_float(w.w << 16); f[7] = __uint_as_float(w.w & 0xffff0000u); }
__device__ __forceinline__ void rms_row16_to_bf16(const bf16* xrow, const float* gain, bf16* orow, int lane) {
    float v[4][8]; float s = 0.f;
#pragma unroll
    for (int j = 0; j < 4; ++j) { bf8_unpack0(*((const GAS v4u*)xrow + lane + 64 * j), v[j]);
#pragma unroll
        for (int i = 0; i < 8; ++i) s += v[j][i] * v[j][i]; }
    const float rstd = 1.0f / sqrtf(wave_sum(s) * (1.f / DM) + NORM_EPS);
#pragma unroll
    for (int j = 0; j < 4; ++j) { const f32x4 ga = *(const f32x4*)(gain + 8 * (lane + 64 * j)), gb = *(const f32x4*)(gain + 8 * (lane + 64 * j) + 4); v4u o;
        o.x = pk2(v[j][0] * rstd * ga[0], v[j][1] * rstd * ga[1]); o.y = pk2(v[j][2] * rstd * ga[2], v[j][3] * rstd * ga[3]); o.z = pk2(v[j][4] * rstd * gb[0], v[j][5] * rstd * gb[1]); o.w = pk2(v[j][6] * rstd * gb[2], v[j][7] * rstd * gb[3]);
        *((GAS v4u*)orow + lane + 64 * j) = o; }
}
__device__ __forceinline__ void rms_row_to_bf16(const float* xrow, const float* gain, bf16* orow, int lane) {
    const GAS f32x4* xr = (const GAS f32x4*)xrow + lane; const GAS f32x4* gr = (const GAS f32x4*)gain + lane;
    f32x4 v[8]; float s = 0.f;
#pragma unroll
    for (int j = 0; j < 8; ++j) { v[j] = xr[64 * j]; s += (v[j].x * v[j].x + v[j].y * v[j].y) + (v[j].z * v[j].z + v[j].w * v[j].w); }
    const float rstd = 1.0f / sqrtf(wave_sum(s) * (1.f / DM) + NORM_EPS);
    GAS unsigned long long* o8 = (GAS unsigned long long*)orow + lane;
#pragma unroll
    for (int j = 0; j < 8; ++j) { const f32x4 g = gr[64 * j]; o8[64 * j] = (unsigned long long)pk2(v[j].x * rstd * g.x, v[j].y * rstd * g.y) | ((unsigned long long)pk2(v[j].z * rstd * g.z, v[j].w * rstd * g.w) << 32); }
}

struct PPArgs { bf16* proj; const float* small; bf16* mqk; bf16* ikb; unsigned char* sgn; float* gif; const float* rope128; const float* rope64; const float* gq; const float* gk; const float* convw; const float* gbias; };
__device__ __forceinline__ void bf8_unpack(const v4u w, float (&f)[8]) { f[0] = __uint_as_float(w.x << 16); f[1] = __uint_as_float(w.x & 0xffff0000u); f[2] = __uint_as_float(w.y << 16); f[3] = __uint_as_float(w.y & 0xffff0000u);
    f[4] = __uint_as_float(w.z << 16); f[5] = __uint_as_float(w.z & 0xffff0000u); f[6] = __uint_as_float(w.w << 16); f[7] = __uint_as_float(w.w & 0xffff0000u); }
__device__ __forceinline__ v4u bf8_pack(const float (&f)[8]) { v4u o; o.x = pk2(f[0], f[1]); o.y = pk2(f[2], f[3]); o.z = pk2(f[4], f[5]); o.w = pk2(f[6], f[7]); return o; }
__device__ __forceinline__ float sum8_dpp(float x) {
    x += dpp_f<0xB1, 0xf, 0xf>(0.f, x); x += dpp_f<0x4E, 0xf, 0xf>(0.f, x); x += dpp_f<0x141, 0xf, 0xf>(0.f, x); return x; }
__device__ __forceinline__ void pp_row(const PPArgs& a, int t, int lane, const f32x4 (&cw)[16]) {
    bf16* pr = a.proj + (size_t)t * NPROJ;
    const int hd = lane >> 3, d0 = (lane & 7) * 8;
    float cs[8], sn[8];
#pragma unroll
    for (int i = 0; i < 4; ++i) { const f32x4 c = *(const f32x4*)(a.rope128 + ((size_t)t * 64 + d0 + 2 * i) * 2); cs[2 * i] = c[0]; sn[2 * i] = c[1]; cs[2 * i + 1] = c[2]; sn[2 * i + 1] = c[3]; }
#pragma unroll
    for (int seg = 0; seg < 4; ++seg) {
        const int base = seg == 0 ? PC_AQ : (seg == 1 ? PC_AK : (seg == 2 ? PC_RQ : PC_RK));
        bf16* p = pr + base + hd * 128 + d0; float x1[8], x2[8];
        bf8_unpack(*(const GAS v4u*)p, x1); bf8_unpack(*(const GAS v4u*)(p + 64), x2);
        if (seg < 2) { const float* gn = seg ? a.gk : a.gq; float ss = 0.f;
#pragma unroll
            for (int i = 0; i < 8; ++i) ss += x1[i] * x1[i] + x2[i] * x2[i];
            const float rstd = 1.0f / sqrtf(sum8_dpp(ss) * (1.f / 128.f) + NORM_EPS);
            const f32x4 ga = *(const f32x4*)(gn + d0), gb = *(const f32x4*)(gn + d0 + 4), gc = *(const f32x4*)(gn + 64 + d0), gd = *(const f32x4*)(gn + 64 + d0 + 4);
#pragma unroll
            for (int i = 0; i < 4; ++i) { x1[i] *= rstd * ga[i]; x1[4 + i] *= rstd * gb[i]; x2[i] *= rstd * gc[i]; x2[4 + i] *= rstd * gd[i]; } }
        float o1[8], o2[8];
#pragma unroll
        for (int i = 0; i < 8; ++i) { o1[i] = x1[i] * cs[i] - x2[i] * sn[i]; o2[i] = x2[i] * cs[i] + x1[i] * sn[i]; }
        *(GAS v4u*)p = bf8_pack(o1); *(GAS v4u*)(p + 64) = bf8_pack(o2); }
    const float* sm = a.small + (size_t)t * 256;
    {
        const int e0 = (lane & 7) * 4; const f32x4 ca = *(const f32x4*)(a.rope64 + ((size_t)t * 32 + e0) * 2), cb = *(const f32x4*)(a.rope64 + ((size_t)t * 32 + e0 + 2) * 2);
        const float c4[4] = {ca[0], ca[2], cb[0], cb[2]}, s4[4] = {ca[1], ca[3], cb[1], cb[3]};
        bf16* p = pr + PC_IQ + hd * 64 + e0; const v2u lo = *(const GAS v2u*)p, hi = *(const GAS v2u*)(p + 32);
        const float aw = fabsf(sm[64 + hd]) * (0.35355339059327373f * 0.125f);
        const float y1[4] = {__uint_as_float(lo.x << 16), __uint_as_float(lo.x & 0xffff0000u), __uint_as_float(lo.y << 16), __uint_as_float(lo.y & 0xffff0000u)};
        const float y2[4] = {__uint_as_float(hi.x << 16), __uint_as_float(hi.x & 0xffff0000u), __uint_as_float(hi.y << 16), __uint_as_float(hi.y & 0xffff0000u)};
        float q1[4], q2[4];
#pragma unroll
        for (int i = 0; i < 4; ++i) { q1[i] = (y1[i] * c4[i] - y2[i] * s4[i]) * aw; q2[i] = (y2[i] * c4[i] + y1[i] * s4[i]) * aw; }
        v2u w1, w2; w1.x = pk2(q1[0], q1[1]); w1.y = pk2(q1[2], q1[3]); w2.x = pk2(q2[0], q2[1]); w2.y = pk2(q2[2], q2[3]);
        *(GAS v2u*)p = w1; *(GAS v2u*)(p + 32) = w2;
        if (lane < 8) { const f32x4 k1 = *(const f32x4*)(sm + e0), k2 = *(const f32x4*)(sm + 32 + e0); float r1[4], r2[4];
#pragma unroll
            for (int i = 0; i < 4; ++i) { r1[i] = k1[i] * c4[i] - k2[i] * s4[i]; r2[i] = k2[i] * c4[i] + k1[i] * s4[i]; }
            v2u u1, u2; u1.x = pk2(r1[0], r1[1]); u1.y = pk2(r1[2], r1[3]); u2.x = pk2(r2[0], r2[1]); u2.y = pk2(r2[2], r2[3]);
            *(GAS v2u*)(a.ikb + (size_t)t * 64 + e0) = u1; *(GAS v2u*)(a.ikb + (size_t)t * 64 + 32 + e0) = u2; } }
    { const unsigned long long nb = __builtin_amdgcn_ballot_w64(lane < 8 && sm[64 + (lane & 7)] < 0.f); if (lane == 0) a.sgn[t] = (unsigned char)(nb & 0xffull); }
    if (lane < 8) a.gif[(size_t)t * 8 + lane] = sm[72 + lane] + a.gbias[lane];
    {
        float acc[16];
#pragma unroll
        for (int i = 0; i < 16; ++i) acc[i] = 0.f;
#pragma unroll
        for (int j = 0; j < 4; ++j) { const int tt = t - 3 + j; if (tt >= 0) { const bf16* xp = a.proj + (size_t)tt * NPROJ + PC_MQ + 16 * lane; float xa[8], xb[8];
                bf8_unpack(*(const GAS v4u*)xp, xa); bf8_unpack(*(const GAS v4u*)(xp + 8), xb);
#pragma unroll
                for (int i = 0; i < 4; ++i) { acc[i] += cw[j * 4][i] * xa[i]; acc[4 + i] += cw[j * 4 + 1][i] * xa[4 + i]; acc[8 + i] += cw[j * 4 + 2][i] * xb[i]; acc[12 + i] += cw[j * 4 + 3][i] * xb[4 + i]; } } }
        float oa[8], ob[8];
#pragma unroll
        for (int i = 0; i < 8; ++i) { oa[i] = acc[i]; ob[i] = acc[8 + i]; }
        bf16* mp = a.mqk + (size_t)t * 1024 + 16 * lane; *(GAS v4u*)mp = bf8_pack(oa); *(GAS v4u*)(mp + 8) = bf8_pack(ob); }
}

constexpr int SCT_RS = 144, IQT_RS = 1040, IQT_BYTES = 32 * IQT_RS;
__device__ __forceinline__ void score_wave_unit(LAS unsigned char* wt, const LAS unsigned char* iqt, const bf16* ikb, const unsigned char* sgn, unsigned short* sc, int qb, int kb, int lane) {
    const int r = lane & 31, h = lane >> 5, q0 = qb * 32, s0 = kb * 64;
    bf16x8 ka[2][4];
#pragma unroll
    for (int b = 0; b < 2; ++b)
#pragma unroll
        for (int kk = 0; kk < 4; ++kk) ka[b][kk] = *(const bf16x8*)(ikb + (size_t)(s0 + 32 * b + r) * 64 + 16 * kk + 8 * h);
    const LAS unsigned char* qrow = iqt + r * IQT_RS + 16 * h;
    const unsigned sb = sgn[q0 + r];
    f32x16 scv[2];
#pragma unroll
    for (int b = 0; b < 2; ++b)
#pragma unroll
        for (int e = 0; e < 16; ++e) scv[b][e] = 0.f;
#pragma unroll 2
    for (int j = 0; j < 8; ++j) { bf16x8 qf[4];
#pragma unroll
        for (int kk = 0; kk < 4; ++kk) qf[kk] = *(const LAS bf16x8*)(qrow + j * 128 + kk * 32);
        const float sj = ((sb >> j) & 1u) ? -1.0f : 1.0f;
#pragma unroll
        for (int b = 0; b < 2; ++b) { f32x16 acc;
#pragma unroll
            for (int e = 0; e < 16; ++e) acc[e] = 0.f;
#pragma unroll
            for (int kk = 0; kk < 4; ++kk) acc = __builtin_amdgcn_mfma_f32_32x32x16_bf16(ka[b][kk], qf[kk], acc, 0, 0, 0);
#pragma unroll
            for (int e = 0; e < 16; ++e) scv[b][e] = fmaf(fmaxf(acc[e], 0.f), sj, scv[b][e]); } }
#pragma unroll
    for (int b = 0; b < 2; ++b)
#pragma unroll
        for (int g = 0; g < 4; ++g) { v2u hw; hw.x = __builtin_bit_cast(unsigned, __builtin_amdgcn_cvt_pkrtz(scv[b][4 * g], scv[b][4 * g + 1])); hw.y = __builtin_bit_cast(unsigned, __builtin_amdgcn_cvt_pkrtz(scv[b][4 * g + 2], scv[b][4 * g + 3]));
            *(LAS v2u*)(wt + r * SCT_RS + (32 * b + 8 * g + 4 * h) * 2) = hw; }
#pragma unroll
    for (int k = 0; k < 4; ++k) { const int row = 8 * k + (lane >> 3), c8 = (lane & 7) * 8;
        const v4u x = *(const LAS v4u*)(wt + row * SCT_RS + c8 * 2);
        *(GAS v4u*)(sc + (size_t)(q0 + row) * S + s0 + c8) = x; }
}


__device__ __forceinline__ float wave_max_dpp(float x) { return wave_max(x); }
__device__ __forceinline__ float wave_min_dpp(float x) { return -wave_max_dpp(-x); }
__device__ __forceinline__ unsigned wave_prefix_dpp(unsigned x) {
    unsigned y = x + dpp_u<0x111, 0xf, 0xf>(x); y += dpp_u<0x112, 0xf, 0xf>(x); y += dpp_u<0x113, 0xf, 0xf>(x);
    y += dpp_u<0x114, 0xf, 0xe>(y); y += dpp_u<0x118, 0xf, 0xc>(y); y += dpp_u<0x142, 0xa, 0xf>(y); y += dpp_u<0x143, 0xc, 0xf>(y);
    return y; }
#define SEL_BAR() do { asm volatile("s_waitcnt lgkmcnt(0)" ::: "memory"); __builtin_amdgcn_s_barrier(); asm volatile("" ::: "memory"); } while (0)
#define SEL_ROW(i) ((i) < n0 ? row0 + (i) * rstep : xrow0 + ((i) - n0) * xstep)
#ifndef PROBE_MASK
#define PROBE_MASK 0
#endif
#define SEL_STAMP(k) do { if (PROBE_MASK != 0 && tid == 0) { const unsigned long long c_ = (unsigned long long)__builtin_readcyclecounter(); pacc[k] += c_ - plast; plast = c_; } } while (0)
__device__ __forceinline__ void select_rows_wg(LAS unsigned char* lds, const unsigned short* sc, unsigned long long* mb, int row0, int rstep, int n0, int xrow0, int xstep, int n1, int tid, unsigned long long* gacc) {
    unsigned long long pacc[8] = {0, 0, 0, 0, 0, 0, 0, 0}; unsigned long long plast = (PROBE_MASK != 0) ? (unsigned long long)__builtin_readcyclecounter() : 0ull; (void)pacc; (void)plast; (void)gacc;
    LAS unsigned* hist = (LAS unsigned*)lds;
    LAS unsigned* btot = hist + 2176;
    LAS float* red = (LAS float*)(hist + 2240); LAS unsigned* lcnt = hist + 2256;
    LAS float* lval = (LAS float*)(hist + 2272); LAS int* lidx = (LAS int*)(hist + 2272 + 8192);
    const int lane = tid & 63, w = tid >> 6;
    v2u nx[4];
#define SEL_LOAD(t_) do { const unsigned short* scr_ = sc + (size_t)(t_) * S + 4 * tid; _Pragma("unroll") for (int j = 0; j < 4; ++j) { if (2048 * j <= (t_)) nx[j] = *(const GAS v2u*)(scr_ + 2048 * j); else nx[j] = (v2u){0u, 0u}; } } while (0)
    const int nrows = n0 + n1;
    if (nrows > 0) SEL_LOAD(SEL_ROW(0));
    if (tid < 2) lcnt[tid] = 0u;
    for (int j = tid; j < 2240; j += NTHR) hist[j] = 0u;
    int par = 0;
    for (int ri = 0; ri < nrows; ++ri) { const int t = SEL_ROW(ri);
        float v[16];
#pragma unroll
        for (int j = 0; j < 4; ++j)
#pragma unroll
            for (int c = 0; c < 4; ++c) { const unsigned hb_ = ((c & 2) ? nx[j].y : nx[j].x) >> (16 * (c & 1)); const float sv_ = (float)__builtin_bit_cast(_Float16, (unsigned short)hb_);
                v[4 * j + c] = (2048 * j + 4 * tid + c <= t) ? sv_ : -3.0e38f; }
        if (ri + 1 < nrows) SEL_LOAD(SEL_ROW(ri + 1));
        if (PROBE_MASK != 0) { float d_ = 0.f; _Pragma("unroll") for (int i = 0; i < 16; ++i) d_ += v[i]; asm volatile("" :: "v"(d_)); } SEL_STAMP(0);
        unsigned long long* mbr = mb + (size_t)t * 128;
        bool sel[16];
        if (t >= 256) {
            const int ngrp = (t >> 11) + 1;
            float mn = 3.0e38f, mx = -3.0e38f;
#pragma unroll
            for (int i = 0; i < 16; ++i) { mx = fmaxf(mx, v[i]); mn = fminf(mn, (v[i] > -3.0e38f) ? v[i] : 3.0e38f); }
            mn = wave_min_dpp(mn); mx = wave_max_dpp(mx);
            if (lane == 0) { red[w] = mn; red[8 + w] = mx; }
            SEL_BAR();
            SEL_STAMP(1);
            mn = red[0]; mx = red[8];
#pragma unroll
            for (int j = 1; j < 8; ++j) { mn = fminf(mn, red[j]); mx = fmaxf(mx, red[8 + j]); }
            const float scale = (mx > mn) ? 2047.0f / (mx - mn) : 0.f;
            int bin[16];
#pragma unroll
            for (int i = 0; i < 16; ++i) { int b = (int)((v[i] - mn) * scale); b = b < 0 ? 0 : (b > 2047 ? 2047 : b); const bool ok = v[i] > -3.0e38f; bin[i] = ok ? b : -1;
                if ((i >> 2) < ngrp) { (void)__hip_atomic_fetch_add(hist + (ok ? b + (b >> 5) : 2112 + lane), 1u, __ATOMIC_RELAXED, __HIP_MEMORY_SCOPE_WORKGROUP);
                    (void)__hip_atomic_fetch_add(btot + (ok ? (b >> 5) : 0), ok ? 1u : 0u, __ATOMIC_RELAXED, __HIP_MEMORY_SCOPE_WORKGROUP); } }
            SEL_BAR();
            SEL_STAMP(2);
            const unsigned bt = btot[63 - lane]; const unsigned sufb = wave_prefix_dpp(bt);
            const unsigned long long ob = __builtin_amdgcn_ballot_w64(sufb >= 256u);
            const int olb = ob ? (int)__builtin_ctzll(ob) : 0; const int blk = 63 - olb;
            const unsigned above_blk = (unsigned)__builtin_amdgcn_readlane((int)(sufb - bt), olb);
            const unsigned hbn = (lane < 32) ? hist[33 * blk + 31 - lane] : 0u; const unsigned sufn = wave_prefix_dpp(hbn) + above_blk;
            const unsigned long long on = __builtin_amdgcn_ballot_w64(lane < 32 && sufn >= 256u);
            const int oln = on ? (int)__builtin_ctzll(on) : 0;
            const int bstar = 32 * blk + 31 - oln; const unsigned need = 256u - (unsigned)__builtin_amdgcn_readlane((int)(sufn - hbn), oln);
            { asm volatile("" :: "s"(bstar), "s"(need)); } SEL_STAMP(3);
#pragma unroll
            for (int i = 0; i < 16; ++i) if (bin[i] == bstar) { const unsigned k = __hip_atomic_fetch_add(lcnt + par, 1u, __ATOMIC_RELAXED, __HIP_MEMORY_SCOPE_WORKGROUP); lval[k] = v[i]; lidx[k] = 2048 * (i >> 2) + 4 * tid + (i & 3); }
            SEL_BAR();
            SEL_STAMP(4);
            const int nl = (int)lcnt[par];
#pragma unroll
            for (int i = 0; i < 16; ++i) { bool sl = bin[i] > bstar;
                if (bin[i] == bstar) { const float x = v[i]; const int s = 2048 * (i >> 2) + 4 * tid + (i & 3); unsigned rank = 0u;
                    for (int j = 0; j < nl; ++j) { const float y = lval[j]; const int sj = lidx[j]; rank += (y > x || (y == x && sj < s)) ? 1u : 0u; }
                    sl = rank < need; }
                sel[i] = sl; }
            SEL_STAMP(5);
            *(LAS v4u*)(hist + 4 * tid) = (v4u){0u, 0u, 0u, 0u}; if (tid < 48) *(LAS v4u*)(hist + 2048 + 4 * tid) = (v4u){0u, 0u, 0u, 0u};
            if (tid == 0) lcnt[par ^ 1] = 0u;
            par ^= 1;
        } else {
#pragma unroll
            for (int i = 0; i < 16; ++i) sel[i] = v[i] > -3.0e38f;
        }
#pragma unroll
        for (int j = 0; j < 4; ++j) { unsigned f[4];
#pragma unroll
            for (int c = 0; c < 4; ++c) { const unsigned long long b = __builtin_amdgcn_ballot_w64(sel[4 * j + c]); const unsigned src = (lane & 2) ? (unsigned)(b >> 32) : (unsigned)b; f[c] = (src >> (16 * (lane & 1))) & 0xffffu; }
            if (lane < 4) { v2u wd; wd.x = f[0] | (f[1] << 16); wd.y = f[2] | (f[3] << 16); *(GAS v2u*)(mbr + 32 * j + 4 * w + lane) = wd; } }
        SEL_STAMP(6);
    }
    if (PROBE_MASK != 0 && tid == 0) { _Pragma("unroll") for (int k = 0; k < 7; ++k) atomicAdd(gacc + k, pacc[k]); }
    SEL_BAR();
#undef SEL_LOAD
#undef SEL_ROW
}

template <int RS> __device__ __forceinline__ bf16x8 frag_row(const LAS unsigned char* base, int r0, int k0, int lane) {
    return *(const LAS bf16x8*)(base + (r0 + (lane & 15)) * RS + (k0 + 8 * (lane >> 4)) * 2);
}
template <int RS> __device__ __forceinline__ bf16x8 frag_tr(const LAS unsigned char* base, int k0, int c0, int lane) {
    const int g = lane >> 4, q = (lane & 15) >> 2, p = lane & 3;
    const unsigned a = (unsigned)(size_t)(base + (k0 + 8 * g + q) * RS + (c0 + 4 * p) * 2);
    s16x4 lo, hi;
    asm volatile("ds_read_b64_tr_b16 %0, %2\n\tds_read_b64_tr_b16 %1, %2 offset:%3\n\ts_waitcnt lgkmcnt(0)" : "=&v"(lo), "=&v"(hi) : "v"(a), "i"(4 * RS) : "memory");
    return (bf16x8){lo[0], lo[1], lo[2], lo[3], hi[0], hi[1], hi[2], hi[3]};
}
#define MFMA16(a, b, c) __builtin_amdgcn_mfma_f32_16x16x32_bf16((a), (b), (c), 0, 0, 0)
constexpr int SCR_OFF = 114688;
constexpr float DK_SCALE = 0.08838834764831845f;
__device__ __forceinline__ float log_sigmoid_f(float x) { return fminf(x, 0.f) - log1pf(expf(-fabsf(x))); }

template <int L, int DV, class Prep> __device__ __forceinline__ void chunk_delta(const Prep& prep, LAS unsigned char* lds, const bf16* ksrc, int ldk, const bf16* vsrc, int ldv, const LAS float* wcol, bf16* outT, float* dn, int tid) {
    constexpr int RSK = (128 + 8) * 2, RSV = (DV + 8) * 2, NCB = DV / 128;
    LAS unsigned char* KA = lds; LAS unsigned char* V = lds + L * RSK;
    const int lane = tid & 63, w = tid >> 6;
    constexpr int NK = L * 16 / NTHR, NV = L * (DV / 8) / NTHR; v4u rk[NK], rv[NV];
#pragma unroll
    for (int i = 0; i < NK; ++i) { const int idx = tid + i * NTHR, s = idx >> 4, c8 = idx & 15; rk[i] = *(const GAS v4u*)(ksrc + (size_t)s * ldk + c8 * 8); }
#pragma unroll
    for (int i = 0; i < NV; ++i) { const int idx = tid + i * NTHR, s = idx / (DV / 8), c8 = idx % (DV / 8); rv[i] = *(const GAS v4u*)(vsrc + (size_t)s * ldv + c8 * 8); }
    __builtin_amdgcn_sched_barrier(0);
    prep();
    __syncthreads();
#pragma unroll
    for (int i = 0; i < NK; ++i) { const int idx = tid + i * NTHR, s = idx >> 4, c8 = idx & 15; const v4u x = rk[i]; const float sc = DK_SCALE * wcol[s]; v4u o;
        o.x = pk2(__uint_as_float(x.x << 16) * sc, __uint_as_float(x.x & 0xffff0000u) * sc); o.y = pk2(__uint_as_float(x.y << 16) * sc, __uint_as_float(x.y & 0xffff0000u) * sc);
        o.z = pk2(__uint_as_float(x.z << 16) * sc, __uint_as_float(x.z & 0xffff0000u) * sc); o.w = pk2(__uint_as_float(x.w << 16) * sc, __uint_as_float(x.w & 0xffff0000u) * sc);
        *(LAS v4u*)(KA + s * RSK + c8 * 16) = o; }
#pragma unroll
    for (int i = 0; i < NV; ++i) { const int idx = tid + i * NTHR, s = idx / (DV / 8), c8 = idx % (DV / 8); *(LAS v4u*)(V + s * RSV + c8 * 16) = rv[i]; }
    __syncthreads();
    f32x4 acc[8][NCB];
#pragma unroll
    for (int db = 0; db < 8; ++db)
#pragma unroll
        for (int i = 0; i < NCB; ++i) acc[db][i] = (f32x4){0.f, 0.f, 0.f, 0.f};
#pragma unroll
    for (int kk = 0; kk < L / 32; ++kk) {
        bf16x8 bfr[NCB];
#pragma unroll
        for (int i = 0; i < NCB; ++i) bfr[i] = frag_tr<RSV>(V, 32 * kk, 16 * (w * NCB + i), lane);
#pragma unroll
        for (int db = 0; db < 8; ++db) { const bf16x8 a = frag_tr<RSK>(KA, 32 * kk, 16 * db, lane);
#pragma unroll
            for (int i = 0; i < NCB; ++i) acc[db][i] = MFMA16(a, bfr[i], acc[db][i]); }
    }
#pragma unroll
    for (int db = 0; db < 8; ++db)
#pragma unroll
        for (int i = 0; i < NCB; ++i) { const int e = 16 * (w * NCB + i) + (lane & 15), d0 = 16 * db + 4 * (lane >> 4);
            v2u o; o.x = pk2(acc[db][i][0], acc[db][i][1]); o.y = pk2(acc[db][i][2], acc[db][i][3]);
            *(GAS v2u*)(outT + (size_t)e * 128 + d0) = o; }
    if (dn != nullptr && tid < 128) { float s_ = 0.f;
        for (int s = 0; s < L; ++s) s_ += bf2f(*(const LAS bf16*)(KA + s * RSK + tid * 2));
        dn[tid] = s_; }
    __syncthreads();
}

template <int L, int DV, int MODE, class Prep> __device__ __forceinline__ void chunk_out(const Prep& prep, LAS unsigned char* lds, LAS float* sf, const bf16* qsrc, int ldq, const bf16* ksrc, int ldk, const bf16* vsrc, int ldv,
                                                                              const bf16* stT, const float* gain, const bf16* gate, int ldg, bf16* y, int ldy, int tid_in) {
    int tid = tid_in; asm volatile("" : "+v"(tid));
    constexpr int RSQ = (128 + 8) * 2, RSV = (DV + 8) * 2, RSP = (L + 8) * 2, NCB = DV / 128, NT = L / 16, TPW = NT * NT / 8;
    LAS unsigned char* Q = lds; LAS unsigned char* K = lds + L * RSQ; LAS unsigned char* V = lds + 2 * L * RSQ;
    LAS unsigned char* P = (MODE == 0) ? (lds + 2 * L * RSQ + L * RSV) : K;
    LAS float* H = (LAS float*)lds;
    LAS float* lrow = sf; LAS float* lcol = sf + 128; LAS float* qs = sf + 256; LAS float* flo = sf + 384; LAS float* rowsum = sf + 512; LAS float* npv = sf + 640; LAS float* part = sf + 768; LAS float* dpart = sf + 768 + L * NT;
    const int lane = tid & 63, w = tid >> 6, g4 = lane >> 4, c16 = lane & 15;
    constexpr int RPS = 256 / DV, NSTEP = L / (NWAVES * RPS);
    const int nsub = (RPS == 2) ? (lane >> 5) : 0, ne0 = 4 * ((RPS == 2) ? (lane & 31) : lane);
    bf16x8 stf[4][NCB];
#pragma unroll
    for (int kk = 0; kk < 4; ++kk)
#pragma unroll
        for (int i = 0; i < NCB; ++i) stf[kk][i] = *(const GAS bf16x8*)(stT + (size_t)(16 * (w * NCB + i) + c16) * 128 + 32 * kk + 8 * g4);
    constexpr int NQ = L * 16 / NTHR, NV = L * (DV / 8) / NTHR; v4u rq[NQ], rk[NQ], rv[NV];
#pragma unroll
    for (int i = 0; i < NQ; ++i) { const int idx = tid + i * NTHR, s = idx >> 4, c8 = idx & 15; rq[i] = *(const GAS v4u*)(qsrc + (size_t)s * ldq + c8 * 8); rk[i] = *(const GAS v4u*)(ksrc + (size_t)s * ldk + c8 * 8); }
#pragma unroll
    for (int i = 0; i < NV; ++i) { const int idx = tid + i * NTHR, s = idx / (DV / 8), c8 = idx % (DV / 8); rv[i] = *(const GAS v4u*)(vsrc + (size_t)s * ldv + c8 * 8); }
    __builtin_amdgcn_sched_barrier(0);
    prep();
    __builtin_amdgcn_sched_barrier(0);
#pragma unroll
    for (int i = 0; i < NQ; ++i) { const int idx = tid + i * NTHR, s = idx >> 4, c8 = idx & 15; *(LAS v4u*)(Q + s * RSQ + c8 * 16) = rq[i]; *(LAS v4u*)(K + s * RSQ + c8 * 16) = rk[i]; }
#pragma unroll
    for (int i = 0; i < NV; ++i) { const int idx = tid + i * NTHR, s = idx / (DV / 8), c8 = idx % (DV / 8); *(LAS v4u*)(V + s * RSV + c8 * 16) = rv[i]; }
    __syncthreads();
    f32x4 pv[TPW];
#pragma unroll
    for (int i = 0; i < TPW; ++i) { const int ti = w * TPW + i, rb = ti / NT, cb = ti % NT; f32x4 a = (f32x4){0.f, 0.f, 0.f, 0.f};
        if (cb <= rb) {
#pragma unroll
            for (int kk = 0; kk < 4; ++kk) a = MFMA16(frag_row<RSQ>(Q, 16 * rb, 32 * kk, lane), frag_row<RSQ>(K, 16 * cb, 32 * kk, lane), a);
            const int s = 16 * cb + c16; const float lc = lcol[s]; float rs[4];
#pragma unroll
            for (int r = 0; r < 4; ++r) { const int t = 16 * rb + 4 * g4 + r; const float pw = (s <= t) ? __expf(lrow[t] + lc) * a[r] * DK_SCALE : 0.f; a[r] = pw; rs[r] = pw; }
            if (MODE == 0) {
#pragma unroll
                for (int r = 0; r < 4; ++r) { float v = rs[r]; v += dpp_f<0xB1, 0xf, 0xf>(0.f, v); v += dpp_f<0x4E, 0xf, 0xf>(0.f, v); v += dpp_f<0x141, 0xf, 0xf>(0.f, v); v += dpp_f<0x140, 0xf, 0xf>(0.f, v);
                    if (c16 == 0) part[(16 * rb + 4 * g4 + r) * NT + cb] = v; } }
        } else if (MODE == 0) { if (c16 == 0) {
#pragma unroll
                for (int r = 0; r < 4; ++r) part[(16 * rb + 4 * g4 + r) * NT + cb] = 0.f; } }
        pv[i] = a; }
    __syncthreads();
#pragma unroll
    for (int i = 0; i < TPW; ++i) { const int ti = w * TPW + i, rb = ti / NT, cb = ti % NT;
#pragma unroll
        for (int r = 0; r < 4; ++r) *(LAS bf16*)(P + (16 * rb + 4 * g4 + r) * RSP + (16 * cb + c16) * 2) = (bf16)f2bf(pv[i][r]); }
    for (int idx = tid; idx < L * 16; idx += NTHR) { const int s = idx >> 4, c8 = idx & 15; const float sc = qs[s];
        const v4u x = *(const LAS v4u*)(Q + s * RSQ + c8 * 16); float f[8];
        f[0] = __uint_as_float(x.x << 16) * sc; f[1] = __uint_as_float(x.x & 0xffff0000u) * sc; f[2] = __uint_as_float(x.y << 16) * sc; f[3] = __uint_as_float(x.y & 0xffff0000u) * sc;
        f[4] = __uint_as_float(x.z << 16) * sc; f[5] = __uint_as_float(x.z & 0xffff0000u) * sc; f[6] = __uint_as_float(x.w << 16) * sc; f[7] = __uint_as_float(x.w & 0xffff0000u) * sc;
        v4u o; o.x = pk2(f[0], f[1]); o.y = pk2(f[2], f[3]); o.z = pk2(f[4], f[5]); o.w = pk2(f[6], f[7]);
        *(LAS v4u*)(Q + s * RSQ + c8 * 16) = o;
        if (MODE == 0) { float dsum = 0.f;
#pragma unroll
            for (int j = 0; j < 8; ++j) dsum += f[j] * npv[8 * c8 + j];
            dpart[s * 16 + c8] = dsum; } }
    __syncthreads();
    if (MODE == 0 && tid < L) { float a = 0.f;
#pragma unroll
        for (int j = 0; j < NT; ++j) a += part[tid * NT + j];
#pragma unroll
        for (int j = 0; j < 16; ++j) a += dpart[tid * 16 + j];
        rowsum[tid] = a; }
    f32x4 acc[NT][NCB];
#pragma unroll
    for (int rb = 0; rb < NT; ++rb)
#pragma unroll
        for (int i = 0; i < NCB; ++i) acc[rb][i] = (f32x4){0.f, 0.f, 0.f, 0.f};
#pragma unroll
    for (int kk = 0; kk < 4; ++kk) {
#pragma unroll
        for (int rb = 0; rb < NT; ++rb) { const bf16x8 a = frag_row<RSQ>(Q, 16 * rb, 32 * kk, lane);
#pragma unroll
            for (int i = 0; i < NCB; ++i) acc[rb][i] = MFMA16(a, stf[kk][i], acc[rb][i]); } }
#pragma unroll
    for (int kk = 0; kk < L / 32; ++kk) { bf16x8 bfr[NCB];
#pragma unroll
        for (int i = 0; i < NCB; ++i) bfr[i] = frag_tr<RSV>(V, 32 * kk, 16 * (w * NCB + i), lane);
#pragma unroll
        for (int rb = 0; rb < NT; ++rb) { const bf16x8 a = frag_row<RSP>(P, 16 * rb, 32 * kk, lane);
#pragma unroll
            for (int i = 0; i < NCB; ++i) acc[rb][i] = MFMA16(a, bfr[i], acc[rb][i]); } }
    v2u gpre[NSTEP];
#pragma unroll
    for (int i = 0; i < NSTEP; ++i) gpre[i] = *(const GAS v2u*)(gate + (size_t)(w * RPS + i * NWAVES * RPS + nsub) * ldg + ne0);
    __syncthreads();
#pragma unroll
    for (int rb = 0; rb < NT; ++rb)
#pragma unroll
        for (int i = 0; i < NCB; ++i)
#pragma unroll
            for (int r = 0; r < 4; ++r) { const int t = 16 * rb + 4 * g4 + r, e = 16 * (w * NCB + i) + c16; float hv = acc[rb][i][r];
                if (MODE == 0) hv = hv / fmaxf(fabsf(rowsum[t]), flo[t]);
                H[t * DV + e] = hv; }
    __syncthreads();
    {   const int sub = nsub, e0 = ne0;
        const f32x4 gn = *(const f32x4*)(gain + e0);
#pragma unroll
        for (int si = 0; si < NSTEP; ++si) { const int t = w * RPS + si * NWAVES * RPS + sub;
            const v2u gw2 = gpre[si];
            f32x4 hv = *(const LAS f32x4*)(H + t * DV + e0);
            float mu = 0.f;
            if (MODE == 1) { float s1 = (hv[0] + hv[1]) + (hv[2] + hv[3]);
                s1 += dpp_f<0xB1, 0xf, 0xf>(0.f, s1); s1 += dpp_f<0x4E, 0xf, 0xf>(0.f, s1); s1 += dpp_f<0x141, 0xf, 0xf>(0.f, s1); s1 += dpp_f<0x140, 0xf, 0xf>(0.f, s1); s1 += dpp_f<0x142, 0xa, 0xf>(0.f, s1);
                if (RPS == 2) { const float lo_ = __builtin_bit_cast(float, __builtin_amdgcn_readlane(__builtin_bit_cast(int, s1), 31)), hi_ = __builtin_bit_cast(float, __builtin_amdgcn_readlane(__builtin_bit_cast(int, s1), 63)); s1 = sub ? hi_ : lo_; }
                else { s1 += dpp_f<0x143, 0xc, 0xf>(0.f, s1); s1 = __builtin_bit_cast(float, __builtin_amdgcn_readlane(__builtin_bit_cast(int, s1), 63)); }
                mu = s1 * (1.f / DV); }
            hv = hv - mu;
            float s2 = (hv[0] * hv[0] + hv[1] * hv[1]) + (hv[2] * hv[2] + hv[3] * hv[3]);
            s2 += dpp_f<0xB1, 0xf, 0xf>(0.f, s2); s2 += dpp_f<0x4E, 0xf, 0xf>(0.f, s2); s2 += dpp_f<0x141, 0xf, 0xf>(0.f, s2); s2 += dpp_f<0x140, 0xf, 0xf>(0.f, s2); s2 += dpp_f<0x142, 0xa, 0xf>(0.f, s2);
            if (RPS == 2) { const float lo_ = __builtin_bit_cast(float, __builtin_amdgcn_readlane(__builtin_bit_cast(int, s2), 31)), hi_ = __builtin_bit_cast(float, __builtin_amdgcn_readlane(__builtin_bit_cast(int, s2), 63)); s2 = sub ? hi_ : lo_; }
            else { s2 += dpp_f<0x143, 0xc, 0xf>(0.f, s2); s2 = __builtin_bit_cast(float, __builtin_amdgcn_readlane(__builtin_bit_cast(int, s2), 63)); }
            const float rstd = 1.0f / sqrtf(s2 * (1.f / DV) + NORM_EPS);
            const float g0 = __uint_as_float(gw2.x << 16), g1 = __uint_as_float(gw2.x & 0xffff0000u), g2 = __uint_as_float(gw2.y << 16), g3 = __uint_as_float(gw2.y & 0xffff0000u);
            float a0, a1, a2, a3;
            if (MODE == 0) { a0 = sigmoid_f(g0); a1 = sigmoid_f(g1); a2 = sigmoid_f(g2); a3 = sigmoid_f(g3); }
            else { a0 = g0 * sigmoid_f(g0); a1 = g1 * sigmoid_f(g1); a2 = g2 * sigmoid_f(g2); a3 = g3 * sigmoid_f(g3); }
            v2u o; o.x = pk2(hv[0] * rstd * gn[0] * a0, hv[1] * rstd * gn[1] * a1); o.y = pk2(hv[2] * rstd * gn[2] * a2, hv[3] * rstd * gn[3] * a3);
            *(GAS v2u*)(y + (size_t)t * ldy + e0) = o; __builtin_amdgcn_sched_barrier(0); } }
    __syncthreads();
}
namespace att {
constexpr int D = 128, LDQKV = NPROJ, LDO = 1024;
constexpr float THR = 8.f; constexpr bool WSKIP = false;
constexpr float SCALE = 0.08838834764831845f;
constexpr int NW = 8, QBLK = 32, KVBLK = 64, QB = NW * QBLK;
constexpr int SHM_V = KVBLK * D * 2, SHM_K = KVBLK * D * 2;
constexpr int LDS_BYTES = 2 * SHM_V + 2 * SHM_K + NW * 64 * 4;

using bf16 = unsigned short;
typedef short bf16x8 __attribute__((ext_vector_type(8)));
typedef short s16x4 __attribute__((ext_vector_type(4)));
typedef float f32x16 __attribute__((ext_vector_type(16)));
typedef float f32x4 __attribute__((ext_vector_type(4)));
typedef unsigned u32x4 __attribute__((ext_vector_type(4)));
template <class A, class Bt> struct same_t { static constexpr bool v = false; };
template <class A> struct same_t<A, A> { static constexpr bool v = true; };

#define KSWZ(row, colB) ((row) * 256 + ((colB) ^ (((row) & 7) << 4)))
#define SBAR() __builtin_amdgcn_sched_barrier(0)
__device__ __forceinline__ int v_st(int k, int c) { const int kk = (k & ~0xC) | ((k & 4) << 1) | ((k & 8) >> 1); return ((kk >> 3) * 4 + (c >> 5)) * 512 + ((kk & 7) * 32 + (c & 31)) * 2; }
__device__ __forceinline__ int v_rd_base(int lane) { return ((lane & 3) << 3) | (((lane >> 2) & 3) << 6) | (((lane >> 4) & 1) << 5) | (((lane >> 5) & 1) << 8); }
constexpr int v_rd_off(int d0, int ks, int half) { return d0 * 512 + ks * 4096 + half * 2048; }
__device__ __forceinline__ int crow(int r, int hi) { return (r & 3) + 8 * (r >> 2) + 4 * hi; }
__device__ __forceinline__ unsigned cvtpk(float lo, float hi) {
    unsigned r; asm volatile("v_cvt_pk_bf16_f32 %0, %1, %2" : "=v"(r) : "v"(lo), "v"(hi)); return r;
}
__device__ __forceinline__ bf16x8 pack8(f32x4 a, f32x4 b) {
    u32x4 w = {cvtpk(a[0], a[1]), cvtpk(a[2], a[3]), cvtpk(b[0], b[1]), cvtpk(b[2], b[3])};
    return *reinterpret_cast<bf16x8*>(&w);
}
template <class T> __device__ __forceinline__ bf16x8 load8(const T* p) {
    if constexpr (same_t<T, float>::v) { return pack8(*(const f32x4*)p, *(const f32x4*)(p + 4)); }
    else { return *reinterpret_cast<const bf16x8*>(p); }
}
__device__ __forceinline__ unsigned long long mask_word(const char* tile_base, int row) { unsigned off = (unsigned)row; asm volatile("" : "+v"(off)); off *= 1024u; return *(const unsigned long long*)(tile_base + off); }
__device__ __forceinline__ void mask_bits(f32x16& p0, f32x16& p1, unsigned long long mw, int hi) {
    const unsigned long long ws = mw >> hi; const unsigned lo = (unsigned)ws, up = (unsigned)(ws >> 32);
#pragma unroll
    for (int r = 0; r < 16; ++r) {
        const int c = 16 * (r & 1) + 2 * (r >> 2); const unsigned x = (r & 2) ? up : lo;
        const unsigned ma = (unsigned)(((int)(x << (31 - c))) >> 31), mb = (unsigned)(((int)(x << (31 - c - 8))) >> 31);
        p0[r] = __uint_as_float((__float_as_uint(p0[r]) & ma) | (0xff800000u & ~ma));
        p1[r] = __uint_as_float((__float_as_uint(p1[r]) & mb) | (0xff800000u & ~mb));
    }
}
__device__ __forceinline__ void partialSM(f32x16& p0, f32x16& p1, float& m_reg, float& mn, float& alpha) {
    float pmax = p0[0]; for (int r = 1; r < 16; ++r) pmax = fmaxf(pmax, p0[r]); for (int r = 0; r < 16; ++r) pmax = fmaxf(pmax, p1[r]);
    { auto rr = __builtin_amdgcn_permlane32_swap(__float_as_uint(pmax), __float_as_uint(pmax), false, false);
      pmax = fmaxf(__uint_as_float(rr[0]), __uint_as_float(rr[1])); }
    constexpr float C2 = 1.4426950408889634f * SCALE;
    if (__builtin_expect(__all((pmax - m_reg) * SCALE <= THR), 1)) { mn = m_reg; alpha = 1.f; }
    else { mn = fmaxf(m_reg, pmax); alpha = __builtin_amdgcn_exp2f((m_reg - mn) * C2); m_reg = mn; }
    const float mnL = -mn * C2;
    for (int r = 0; r < 16; ++r) p0[r] = fmaf(p0[r], C2, mnL); for (int r = 0; r < 16; ++r) p1[r] = fmaf(p1[r], C2, mnL);
    for (int r = 0; r < 16; ++r) p0[r] = __builtin_amdgcn_exp2f(p0[r]);
}
__device__ __forceinline__ void finishSM(f32x16& p0, f32x16& p1, float alpha, float& l_reg, bf16x8& pa0, bf16x8& pa1, bf16x8& pa2, bf16x8& pa3) {
    for (int r = 0; r < 16; ++r) p1[r] = __builtin_amdgcn_exp2f(p1[r]);
    float ps = 0; for (int r = 0; r < 16; ++r) ps += p0[r]; for (int r = 0; r < 16; ++r) ps += p1[r];
    { auto rr = __builtin_amdgcn_permlane32_swap(__float_as_uint(ps), __float_as_uint(ps), false, false);
      ps = __uint_as_float(rr[0]) + __uint_as_float(rr[1]); }
    l_reg = l_reg * alpha + ps;
#define PK4(P, B_, OUT) do { unsigned a0 = cvtpk(P[B_+0], P[B_+1]), a1 = cvtpk(P[B_+2], P[B_+3]);                          \
        unsigned b0 = cvtpk(P[B_+4], P[B_+5]), b1 = cvtpk(P[B_+6], P[B_+7]);                                             \
        auto r0 = __builtin_amdgcn_permlane32_swap(a0, b0, false, false); auto r1 = __builtin_amdgcn_permlane32_swap(a1, b1, false, false); \
        u32x4 w = {r0[0], r1[0], r0[1], r1[1]}; OUT = *reinterpret_cast<bf16x8*>(&w); } while (0)
    PK4(p0, 0, pa0); PK4(p0, 8, pa1); PK4(p1, 0, pa2); PK4(p1, 8, pa3);
#undef PK4
}
template <int KB, bool SK>
__device__ __forceinline__ void qkt(f32x16& p0, f32x16& p1, const char* K_lds, int r32, int hi, const bf16x8* qr, bool act) {
    if (SK && !act) { const float NEG = -__builtin_inff();
#pragma unroll
        for (int r = 0; r < 16; ++r) { p0[r] = NEG; p1[r] = NEG; } return; }
    p0 = f32x16{}; p1 = f32x16{};
    const char* kb[4];
#pragma unroll
    for (int dd = 0; dd < 4; ++dd) kb[dd] = K_lds + KB * SHM_K + KSWZ(r32, (dd * 16 + hi * 8) * 2);
#pragma unroll
    for (int d0 = 0; d0 < 8; ++d0) { const char* a = kb[d0 & 3] + (d0 >> 2) * 128;
        bf16x8 b0 = *reinterpret_cast<const bf16x8*>(a);
        bf16x8 b1 = *reinterpret_cast<const bf16x8*>(a + 32 * 256);
        p0 = __builtin_amdgcn_mfma_f32_32x32x16_bf16(b0, qr[d0], p0, 0, 0, 0);
        p1 = __builtin_amdgcn_mfma_f32_32x32x16_bf16(b1, qr[d0], p1, 0, 0, 0); }
}
template <int VB, bool SK>
__device__ __forceinline__ void pv_tile(f32x16* o, int vb0, bf16x8 pa0, bf16x8 pa1, bf16x8 pa2, bf16x8 pa3, bool act) {
    if (SK && !act) return;
#define TRRD(dst, off) asm volatile("ds_read_b64_tr_b16 %0, %1 offset:%2" : "=&v"(dst) : "v"(vb0), "i"(off) : "memory")
#define PV_D0(d0) do { s16x4 l0, l1, l2, l3, h0, h1, h2, h3; constexpr int b_ = VB * SHM_V + v_rd_off(d0, 0, 0);     \
        TRRD(l0, b_); TRRD(h0, b_ + 2048); TRRD(l1, b_ + 4096); TRRD(h1, b_ + 6144); TRRD(l2, b_ + 8192); TRRD(h2, b_ + 10240); TRRD(l3, b_ + 12288); TRRD(h3, b_ + 14336); \
        asm volatile("s_waitcnt lgkmcnt(0)" ::: "memory"); SBAR();                 \
        o[d0] = __builtin_amdgcn_mfma_f32_32x32x16_bf16(pa0, (bf16x8){l0[0], l0[1], l0[2], l0[3], h0[0], h0[1], h0[2], h0[3]}, o[d0], 0, 0, 0);   \
        o[d0] = __builtin_amdgcn_mfma_f32_32x32x16_bf16(pa1, (bf16x8){l1[0], l1[1], l1[2], l1[3], h1[0], h1[1], h1[2], h1[3]}, o[d0], 0, 0, 0);   \
        o[d0] = __builtin_amdgcn_mfma_f32_32x32x16_bf16(pa2, (bf16x8){l2[0], l2[1], l2[2], l2[3], h2[0], h2[1], h2[2], h2[3]}, o[d0], 0, 0, 0);   \
        o[d0] = __builtin_amdgcn_mfma_f32_32x32x16_bf16(pa3, (bf16x8){l3[0], l3[1], l3[2], l3[3], h3[0], h3[1], h3[2], h3[3]}, o[d0], 0, 0, 0); } while (0)
    PV_D0(0); PV_D0(1); PV_D0(2); PV_D0(3);
#undef PV_D0
#undef TRRD
}

template <class TIn, class TOut> struct BlockRef { const TIn* Q; const TIn* K; const TIn* V; TOut* O; const unsigned long long* M; float* ML; int P0, jlo, jhi, pad; };
template <class TIn> struct Seam {
    bf16x8 qr[8];
    bf16x8 st_v0, st_v1, st_k0, st_k1; f32x4 sf0, sf1, sf2, sf3;
    f32x4 tq[16];
};
__device__ __forceinline__ int swa_jlo(int P0, int W) { const int lowk = P0 - W + 1; return lowk > 0 ? lowk / KVBLK : 0; }
#define ROW(p, k0, rr) ((p) + (size_t)((k0) + (rr)) * LDQKV + sc)
#define VMW() asm volatile("s_waitcnt vmcnt(0)" ::: "memory")
#define VMWN(n) asm volatile("s_waitcnt vmcnt(%0)" :: "i"(n) : "memory")
#define LD16U(base, off) (*reinterpret_cast<const bf16x8*>((const char*)(base) + (off)))
#define SLOAD_H(Kp, Vp, k0) do { const char* kb_ = (const char*)((Kp) + (size_t)(k0) * LDQKV); const char* vb_ = (const char*)((Vp) + (size_t)(k0) * LDQKV);                 \
                         S.st_v0 = LD16U(vb_, soff); S.st_v1 = LD16U(vb_ + (size_t)32 * LDQKV * 2, soff);                                  \
                         S.st_k0 = LD16U(kb_, soff); S.st_k1 = LD16U(kb_ + (size_t)32 * LDQKV * 2, soff); } while (0)
#define SWRITE_HK(bf) do { *(bf16x8*)(K_lds + (bf) * SHM_K + kws) = S.st_k0; *(bf16x8*)(K_lds + (bf) * SHM_K + kws + 32 * 256) = S.st_k1; } while (0)
#define SWRITE_HV(bf) do { *(bf16x8*)(V_lds + (bf) * SHM_V + vst0) = S.st_v0; *(bf16x8*)(V_lds + (bf) * SHM_V + vst1) = S.st_v1; } while (0)
#define SWRITE_H(bf) do { SWRITE_HV(bf); SWRITE_HK(bf); } while (0)
#define SLOAD_F(p, k0) do { S.sf0 = *(const f32x4*)ROW(p, k0, sr); S.sf1 = *(const f32x4*)(ROW(p, k0, sr) + 4);                \
                            S.sf2 = *(const f32x4*)ROW(p, k0, 32 + sr); S.sf3 = *(const f32x4*)(ROW(p, k0, 32 + sr) + 4); } while (0)
#define SWRITE_KF(bf) do { *(bf16x8*)(K_lds + (bf) * SHM_K + kws) = pack8(S.sf0, S.sf1); *(bf16x8*)(K_lds + (bf) * SHM_K + kws + 32 * 256) = pack8(S.sf2, S.sf3); } while (0)
#define SWRITE_VF(bf) do { *(bf16x8*)(V_lds + (bf) * SHM_V + vst0) = pack8(S.sf0, S.sf1); *(bf16x8*)(V_lds + (bf) * SHM_V + vst1) = pack8(S.sf2, S.sf3); } while (0)
template <class TIn, class TOut>
__device__ __forceinline__ void causal_swa_prime(const BlockRef<TIn, TOut>& cur, int W, char* lds, Seam<TIn>& S) {
    constexpr bool F32 = same_t<TIn, float>::v;
    int tid_o = my_tid(); asm volatile("" : "+v"(tid_o));
    const int tid = tid_o, wid = __builtin_amdgcn_readfirstlane(tid >> 6), lane = tid & 63, r32 = lane & 31, hi = lane >> 5;
    const int sr = tid >> 4, sc = (tid & 15) * 8, kws = KSWZ(sr, sc * 2); char* K_lds = lds + 2 * SHM_V; const unsigned soff = (unsigned)(sr * LDQKV + sc) * 2u;
    const int kb0 = cur.jlo * KVBLK; (void)W;
    for (int d0 = 0; d0 < 8; ++d0) S.qr[d0] = load8<TIn>(cur.Q + (size_t)(wid * QBLK + r32) * LDQKV + d0 * 16 + hi * 8);
    if constexpr (F32) { SLOAD_F((const float*)cur.K, kb0); VMW(); SWRITE_KF(0); SBAR(); SLOAD_F((const float*)cur.V, kb0); }
    else { SLOAD_H(cur.K, cur.V, kb0); VMW(); SWRITE_HK(0); }
    __syncthreads();
}
template <class TIn, class TOut>
__device__ __forceinline__ void causal_swa_block(const BlockRef<TIn, TOut>& cur, const BlockRef<TIn, TOut>& nxt, int skv, int W, char* lds, Seam<TIn>& S) {
    constexpr bool F32 = same_t<TIn, float>::v;
    int tid_o = my_tid(); asm volatile("" : "+v"(tid_o));
    const int tid = tid_o, wid = __builtin_amdgcn_readfirstlane(tid >> 6), lane = tid & 63, r32 = lane & 31, hi = lane >> 5;
    const int j_lo = cur.jlo, j_hi = cur.jhi; (void)skv;
    const int NT = j_hi - j_lo;
    const int kbn = nxt.jlo * KVBLK;
    const int qlo = cur.P0 + wid * QBLK, qm = qlo + r32 - 4 * hi;
    char* V_lds = lds; char* K_lds = lds + 2 * SHM_V;
    float* ws = (float*)(lds + 2 * SHM_V + 2 * SHM_K) + wid * 64; float* li_l = ws, * al_l = ws + 32;
    float m_reg = -1e30f, l_reg = 0; f32x16 o[4] = {};
#define TID_NOW() ({ int t_ = tid; asm volatile("" : "+v"(t_)); t_; })
#define soff ({ const int t_ = TID_NOW(); (unsigned)((t_ >> 4) * LDQKV + (t_ & 15) * 8) * 2u; })
#define vst0 ({ const int t_ = TID_NOW(); v_st(t_ >> 4, (t_ & 15) * 8); })
#define vst1 (vst0 + 8192)
#define kws ({ const int t_ = TID_NOW(); KSWZ(t_ >> 4, (t_ & 15) * 16); })
    const int sr = tid >> 4, sc = (tid & 15) * 8; (void)sr; (void)sc;
    const int vb0 = (int)(uintptr_t)V_lds + v_rd_base(lane);
    const TIn* Kh = cur.K; const TIn* Vh = cur.V;
#define RESC(a) do { if (__any((a) < 1.f)) { if (hi == 0) al_l[r32] = (a); asm volatile("s_waitcnt lgkmcnt(0)" ::: "memory");              \
                     for (int d_ = 0; d_ < 4; ++d_) for (int r = 0; r < 16; ++r) o[d_][r] *= al_l[crow(r, hi)]; } } while (0)
#define KBASE(t) ((j_lo + (t)) * KVBLK)
#define ACT(t) (KBASE(t) <= qlo + QBLK - 1 && KBASE(t) + KVBLK - 1 >= qlo - W + 1)
#define MASKT(P0_, P1_, mw_) mask_bits(P0_, P1_, mw_, hi)
#define MLOAD(t) mask_word((const char*)cur.M + (size_t)((j_lo + (t)) * 8), wid * QBLK + r32)
    constexpr int NQL = F32 ? 16 : 8;
    constexpr bool SK = WSKIP && !F32;
#define SEAM_K0() do { VMWN(NQL); if constexpr (F32) { SWRITE_KF(0); SBAR(); SLOAD_F((const float*)nxt.V, kbn); } else { SWRITE_HK(0); } SBAR(); } while (0)
    f32x16 pA0, pA1, pB0, pB1; float mnA, mnB, alA, alB; bf16x8 pa0, pa1, pa2, pa3;
    if constexpr (F32) { VMW(); SWRITE_VF(0); SBAR(); } else { SWRITE_HV(0); SBAR(); }
    if (NT > 1) { if constexpr (F32) SLOAD_F((const float*)Kh, KBASE(1)); else SLOAD_H(Kh, Vh, KBASE(1)); }
    SBAR(); qkt<0, SK>(pA0, pA1, K_lds, r32, hi, S.qr, ACT(0));
    if constexpr (F32) { if (NT > 1) { VMW(); SWRITE_KF(1); SBAR(); SLOAD_F((const float*)Vh, KBASE(1)); } }
    unsigned long long mwn = MLOAD(NT > 1 ? 1 : 0);
    MASKT(pA0, pA1, MLOAD(0)); partialSM(pA0, pA1, m_reg, mnA, alA);
    if (NT > 1) { VMW(); if constexpr (F32) { SWRITE_VF(1); SBAR(); if (NT > 2) SLOAD_F((const float*)Kh, KBASE(2)); } else SWRITE_H(1); }
    __syncthreads();
#define HALF_STEP(PX0, PX1, mnX, alX, PY0, PY1, alY, t, KB, VB, SB) do {                                                      \
        SBAR(); qkt<KB, SK>(PX0, PX1, K_lds, r32, hi, S.qr, ACT(t));                                             \
        finishSM(PY0, PY1, alY, l_reg, pa0, pa1, pa2, pa3); SBAR();                                                           \
        if ((t) + 1 < NT) { if constexpr (F32) { VMW(); SWRITE_KF(SB); SBAR(); SLOAD_F((const float*)Vh, KBASE((t) + 1)); }  \
                            else { SLOAD_H(Kh, Vh, KBASE((t) + 1)); } SBAR(); }                                               \
        pv_tile<VB, SK>(o, vb0, pa0, pa1, pa2, pa3, ACT((t) - 1)); { const unsigned long long mwc_ = mwn; mwn = MLOAD((t) + 1 < NT ? (t) + 1 : (t)); MASKT(PX0, PX1, mwc_); } partialSM(PX0, PX1, m_reg, mnX, alX);                                        \
        __syncthreads();                                                                                                      \
        if ((t) + 1 < NT) { VMW(); if constexpr (F32) { SWRITE_VF(SB); SBAR(); if ((t) + 2 < NT) SLOAD_F((const float*)Kh, KBASE((t) + 2)); } \
                            else { SWRITE_H(SB); } }                                                                          \
        RESC(alX); __syncthreads(); } while (0)
    for (int t = 1; t + 1 < NT; t += 2) {
        HALF_STEP(pB0, pB1, mnB, alB, pA0, pA1, alA, t, 1, 0, 0);
        HALF_STEP(pA0, pA1, mnA, alA, pB0, pB1, alB, t + 1, 0, 1, 1);
    }
    const bool even = (NT & 1) == 0;
    if (even) { SBAR(); qkt<1, SK>(pB0, pB1, K_lds, r32, hi, S.qr, ACT(NT - 1)); SBAR(); }
#define QROW(e) (nxt.Q + (size_t)(wid * QBLK + r32) * LDQKV + ((e) >> 1) * 16 + hi * 8 + ((e) & 1) * 4)
    if constexpr (F32) { SLOAD_F((const float*)nxt.K, kbn); SBAR();
#pragma unroll
        for (int e = 0; e < 8; ++e) S.tq[e] = *(const f32x4*)QROW(e); }
    else { SLOAD_H(nxt.K, nxt.V, kbn); SBAR();
#pragma unroll
        for (int d0 = 0; d0 < 8; ++d0) S.qr[d0] = load8<TIn>(nxt.Q + (size_t)(wid * QBLK + r32) * LDQKV + d0 * 16 + hi * 8); }
    SBAR();
    finishSM(pA0, pA1, alA, l_reg, pa0, pa1, pa2, pa3); SBAR();
    if constexpr (F32) {
#pragma unroll
        for (int e = 8; e < 16; ++e) S.tq[e] = *(const f32x4*)QROW(e); SBAR(); }
#undef QROW
    pv_tile<0, SK>(o, vb0, pa0, pa1, pa2, pa3, ACT(even ? NT - 2 : NT - 1));
    if (even) { MASKT(pB0, pB1, mwn); partialSM(pB0, pB1, m_reg, mnB, alB); __syncthreads(); RESC(alB);
        finishSM(pB0, pB1, alB, l_reg, pa0, pa1, pa2, pa3); SBAR(); pv_tile<1, SK>(o, vb0, pa0, pa1, pa2, pa3, ACT(NT - 1)); }
    SBAR(); SEAM_K0();
    if (hi == 0) { li_l[r32] = l_reg; if (cur.ML != nullptr) { float* mlp = cur.ML + (size_t)(wid * QBLK + r32) * 16; mlp[0] = m_reg; mlp[1] = l_reg; } } asm volatile("s_waitcnt lgkmcnt(0)" ::: "memory");
    float rli[16];
#pragma unroll
    for (int r = 0; r < 16; ++r) rli[r] = __builtin_amdgcn_rcpf(li_l[crow(r, hi)]);
    TOut* Ow = cur.O + (size_t)(wid * QBLK) * LDO;
#pragma unroll
    for (int r = 0; r < 16; ++r) { const int orow = crow(r, hi);
#pragma unroll
        for (int d0 = 0; d0 < 4; ++d0) { const float v = o[d0][r] * rli[r];
            if constexpr (same_t<TOut, float>::v) { Ow[(size_t)orow * LDO + d0 * 32 + r32] = v; }
            else { const float vn = __builtin_bit_cast(float, __builtin_amdgcn_update_dpp(0, __builtin_bit_cast(int, v), 0xB1, 0xf, 0xf, false));
                   if ((r32 & 1) == 0) *(unsigned*)(Ow + (size_t)orow * LDO + d0 * 32 + r32) = cvtpk(v, vn); } } }
    if constexpr (F32) {
#pragma unroll
        for (int d0 = 0; d0 < 8; ++d0) S.qr[d0] = pack8(S.tq[2 * d0], S.tq[2 * d0 + 1]); }
    __syncthreads();
#undef RESC
#undef TID_NOW
#undef soff
#undef vst0
#undef vst1
#undef kws
#undef KBASE
#undef ACT
#undef MASKT
#undef MLOAD
#undef SEAM_K0
#undef HALF_STEP
}
#undef ROW
#undef VMW
#undef VMWN
#undef SLOAD_H
#undef LD16U
#undef SWRITE_HK
#undef SWRITE_HV
#undef SWRITE_H
#undef SLOAD_F
#undef SWRITE_KF
#undef SWRITE_VF

}


template <int NC> __device__ __forceinline__ void scan_elems(const bf16* __restrict__ delta, bf16* __restrict__ prev, size_t cstride, const LAS float* dec, const LAS float* inj) {
    f32x4 st = (f32x4){0.f, 0.f, 0.f, 0.f};
#pragma unroll 8
    for (int c = 0; c < NC; ++c) { const v2u x = *(const GAS v2u*)(delta + (size_t)c * cstride);
        v2u o; o.x = pk2(st[0], st[1]); o.y = pk2(st[2], st[3]); *(GAS v2u*)(prev + (size_t)c * cstride) = o;
        const float d = dec[c], j = inj[c];
        st[0] = d * st[0] + j * __uint_as_float(x.x << 16); st[1] = d * st[1] + j * __uint_as_float(x.x & 0xffff0000u);
        st[2] = d * st[2] + j * __uint_as_float(x.y << 16); st[3] = d * st[3] + j * __uint_as_float(x.y & 0xffff0000u); }
}

struct Args {
    const float* x; const float* norm_mix; const float* norm_ffn; const float* w_in; const float* att_q_norm; const float* att_k_norm; const float* mlstm_conv; const float* mlstm_gate_bias;
    const float* mlstm_out_norm; const float* ret_out_norm; const float* w_b_att; const float* w_b_mlstm; const float* w_b_ret; const float* w_out; const float* w_ffn_in; const float* w_ffn_out;
    float* out; unsigned char* ws; int layer_lo, layer_hi, ph_lo, ph_hi;
};
constexpr int PH_PER_LAYER = 16;
__device__ __forceinline__ float ret_lngamma(int hd) { return log1pf(-exp2f(-5.0f - (float)hd)); }
#define PHASE_FN static __device__ __forceinline__ void
#define OPAQUE_PTR(p) asm volatile("" : "+s"(p))
#define WS_PTRS(ws) OPAQUE_PTR(ws); \
    bf16* const H = (bf16*)((ws) + WS_H); bf16* const PROJ = (bf16*)((ws) + WS_PROJ); float* const SMALL = (float*)((ws) + WS_SMALL); bf16* const MQK = (bf16*)((ws) + WS_MQK); \
    bf16* const IKB = (bf16*)((ws) + WS_IKB); unsigned char* const IWF = (unsigned char*)((ws) + WS_IWF); float* const GIF = (float*)((ws) + WS_GIF); unsigned short* const SC = (unsigned short*)((ws) + WS_SC); \
    unsigned long long* const MB = (unsigned long long*)((ws) + WS_MB); bf16* const DCM = (bf16*)((ws) + WS_DCM); bf16* const CPM = (bf16*)((ws) + WS_CPM); \
    float* const DN = (float*)((ws) + WS_MISC + MISC_DN); float* const NPREV = (float*)((ws) + WS_MISC + MISC_NPREV); float* const AB = (float*)((ws) + WS_MISC + MISC_AB); float* const MPREV = (float*)((ws) + WS_MISC + MISC_MPREV); \
    bf16* const DRR = (bf16*)((ws) + WS_DRR); bf16* const RPR = (bf16*)((ws) + WS_RPR); bf16* const YA = (bf16*)((ws) + WS_YA); bf16* const YM = (bf16*)((ws) + WS_YM); bf16* const YR = (bf16*)((ws) + WS_YR); \
    float* const MERGEDF = (float*)((ws) + WS_MERGEDF); bf16* const MERGED = (bf16*)((ws) + WS_MERGED); bf16* const ACT = (bf16*)((ws) + WS_ACT); \
    float* const ROPE128 = (float*)((ws) + WS_ROPE128); float* const ROPE64 = (float*)((ws) + WS_ROPE64); \
    (void)H; (void)PROJ; (void)SMALL; (void)MQK; (void)IKB; (void)IWF; (void)GIF; (void)SC; (void)MB; (void)DCM; (void)CPM; (void)DN; (void)NPREV; (void)AB; (void)MPREV; (void)DRR; (void)RPR; (void)YA; (void)YM; (void)YR; \
    (void)MERGEDF; (void)MERGED; (void)ACT; (void)ROPE128; (void)ROPE64
#define TIDS() int tid_ = my_tid(); asm volatile("" : "+v"(tid_)); int bx_ = blockIdx.x; asm volatile("" : "+s"(bx_));   \
    const int tid = tid_, lane = tid & 63, wave = __builtin_amdgcn_readfirstlane(tid >> 6); const int G = gridDim.x, bx = bx_; const int gw = bx * NWAVES + wave, NGW = G * NWAVES; \
    (void)lane; (void)wave; (void)gw; (void)NGW; (void)G; (void)bx

constexpr int CV_IN = 32 * 268, CV_B = 16 * 32, CV_OUT = 32 * 32, CV_FIN = 32 * 176, CV_FOUT = 88 * 32, CV_ITEMS = CV_IN + 3 * CV_B + CV_OUT + CV_FIN + CV_FOUT;
__device__ __forceinline__ void convert_layer_items(LAS float* scr, unsigned char* ws, int l, const float* w_in, const float* w_b_att, const float* w_b_mlstm, const float* w_b_ret, const float* w_out, const float* w_ffn_in,
                                                    const float* w_ffn_out, int it0, int it1, int wv, int nwv, int lane) {
    unsigned char* wl = ws + WS_W + (size_t)l * W_LAYER;
    for (int it = it0 + wv; it < it1; it += nwv) { int r = it;
        if (r < CV_IN) { transpose_item(w_in + (size_t)l * DM * LPROJ, DM, LPROJ, (bf16*)(wl + WO_IN), scr, r, NPROJ_PAD / 64, lane, MapWin()); continue; } r -= CV_IN;
        if (r < CV_B) { transpose_item(w_b_att + (size_t)l * 1024 * DM, 1024, DM, (bf16*)(wl + WO_B), scr, r, DM / 64, lane, MapIdent()); continue; } r -= CV_B;
        if (r < CV_B) { transpose_item(w_b_mlstm + (size_t)l * 1024 * DM, 1024, DM, (bf16*)(wl + WO_B + 4 * MiB), scr, r, DM / 64, lane, MapIdent()); continue; } r -= CV_B;
        if (r < CV_B) { transpose_item(w_b_ret + (size_t)l * 1024 * DM, 1024, DM, (bf16*)(wl + WO_B + 8 * MiB), scr, r, DM / 64, lane, MapIdent()); continue; } r -= CV_B;
        if (r < CV_OUT) { transpose_item(w_out + (size_t)l * DM * DM, DM, DM, (bf16*)(wl + WO_OUT), scr, r, DM / 64, lane, MapIdent()); continue; } r -= CV_OUT;
        if (r < CV_FIN) { transpose_item(w_ffn_in + (size_t)l * DM * 2 * FF, DM, 2 * FF, (bf16*)(wl + WO_FIN), scr, r, 2 * FF / 64, lane, MapFfn()); continue; } r -= CV_FIN;
        transpose_item(w_ffn_out + (size_t)l * FF * DM, FF, DM, (bf16*)(wl + WO_FOUT), scr, r, DM / 64, lane, MapIdent()); }
}
PHASE_FN ph_prologue(LAS unsigned char* lds, unsigned char* ws, const float* w_in, const float* w_b_att, const float* w_b_mlstm, const float* w_b_ret, const float* w_out, const float* w_ffn_in, const float* w_ffn_out, bool all_layers) {
    TIDS(); WS_PTRS(ws);
    LAS float* scr = (LAS float*)(lds + wave * 16640);
    if (all_layers) { for (int l = 0; l < DEPTH; ++l) convert_layer_items(scr, ws, l, w_in, w_b_att, w_b_mlstm, w_b_ret, w_out, w_ffn_in, w_ffn_out, 0, CV_ITEMS, gw, NGW, lane); }
    else convert_layer_items(scr, ws, 0, w_in, w_b_att, w_b_mlstm, w_b_ret, w_out, w_ffn_in, w_ffn_out, 0, CV_IN, gw, NGW, lane);
    for (int i = gw * 64 + lane; i < S * 96; i += NGW * 64) {
        if (i < S * 64) { const int t = i >> 6, f = i & 63; const float inv = (float)pow(10000.0, -(double)f * 2.0 / 128.0); const float ang = (float)t * inv;
            ROPE128[2 * i] = (float)cos((double)ang); ROPE128[2 * i + 1] = (float)sin((double)ang); }
        else { const int k = i - S * 64, t = k >> 5, f = k & 31; const float inv = (float)pow(10000.0, -(double)f * 2.0 / 64.0); const float ang = (float)t * inv;
            ROPE64[2 * k] = (float)cos((double)ang); ROPE64[2 * k + 1] = (float)sin((double)ang); } }
}
PHASE_FN ph_convert_tail(LAS unsigned char* lds, unsigned char* ws, int l, const float* w_in, const float* w_b_att, const float* w_b_mlstm, const float* w_b_ret, const float* w_out, const float* w_ffn_in, const float* w_ffn_out,
                         int rem, int it0, int it1) {
    TIDS(); if (rem <= 0 || rem >= G || bx < rem) return;
    LAS float* scr = (LAS float*)(lds + wave * 16640);
    convert_layer_items(scr, ws, l, w_in, w_b_att, w_b_mlstm, w_b_ret, w_out, w_ffn_in, w_ffn_out, it0, it1, (bx - rem) * NWAVES + wave, (G - rem) * NWAVES, lane);
    __syncthreads(); }
PHASE_FN ph_rmsnorm16(const bf16* xin, const float* gain, bf16* Hout) { TIDS(); for (int m = gw; m < S; m += NGW) rms_row16_to_bf16(xin + (size_t)m * DM, gain, Hout + (size_t)m * DM, lane); }
PHASE_FN ph_rmsnorm(const float* xin, const float* gain, bf16* Hout) { TIDS(); for (int m = gw; m < S; m += NGW) rms_row_to_bf16(xin + (size_t)m * DM, gain, Hout + (size_t)m * DM, lane); }
PHASE_FN ph_gemm_proj(LAS unsigned char* lds, unsigned char* ws, const bf16* Wt) { TIDS(); WS_PTRS(ws);
    pg8::Gemm g{H, Wt, S, NPROJ_PAD, DM}; pg8::StaticOrder so; so.init(S, NPROJ_PAD, G, bx); pg8::EpiProj E{PROJ, NPROJ, SMALL, PC_G / 256, NPROJ / 256};
    pg8::gemm_phase<pg8::EpiProj, pg8::StaticOrder, true, true>(lds, g, so, E); }
PHASE_FN ph_pp(unsigned char* ws, const float* gq, const float* gk, const float* convw, const float* gbias) { TIDS(); WS_PTRS(ws);
    PPArgs a{PROJ, SMALL, MQK, IKB, IWF, GIF, ROPE128, ROPE64, gq, gk, convw, gbias};
    f32x4 cw[16];
#pragma unroll
    for (int j = 0; j < 4; ++j)
#pragma unroll
        for (int q = 0; q < 4; ++q) cw[j * 4 + q] = *(const f32x4*)(convw + j * 1024 + 16 * lane + 4 * q);
    for (int m = gw; m < S; m += NGW) pp_row(a, m, lane, cw); }
PHASE_FN ph_scores(LAS unsigned char* lds, unsigned char* ws) { TIDS(); WS_PTRS(ws);
    LAS unsigned char* iqt = lds; LAS unsigned char* wt = lds + IQT_BYTES + wave * (32 * SCT_RS);
    for (int u = bx; u < 1152; u += G) { int m = 0; while (16 * (m + 1) * (m + 2) <= u) ++m;
        const int r = u - 16 * m * (m + 1), qb = 32 * m + r / (m + 1), c = r % (m + 1), nkb = (qb >> 1) + 1, k0 = 16 * c, k1 = (k0 + 16 < nkb) ? k0 + 16 : nkb;
        {   const int row = tid >> 4, part = tid & 15; const bf16* src = PROJ + (size_t)(qb * 32 + row) * NPROJ + PC_IQ;
#pragma unroll
            for (int i = 0; i < 4; ++i) *(LAS v4u*)(iqt + row * IQT_RS + part * 16 + 256 * i) = *(const GAS v4u*)(src + part * 8 + 128 * i); }
        __syncthreads();
        for (int kb = k0 + wave; kb < k1; kb += NWAVES) score_wave_unit(wt, iqt, IKB, IWF, SC, qb, kb, lane);
        __syncthreads(); }
}
PHASE_FN ph_deltas(LAS unsigned char* lds, unsigned char* ws) { TIDS(); WS_PTRS(ws); LAS float* const sf = (LAS float*)(lds + SCR_OFF);
    for (int u = bx; u < 1024; u += G) {
        if (u < 512) { const int hd = u >> 7, c = u & 127, t0 = c * 64;
            auto prep = [=]() { if (wave == 0) { const float iv = GIF[(size_t)(t0 + lane) * 8 + hd], fv = GIF[(size_t)(t0 + lane) * 8 + 4 + hd]; float b = log_sigmoid_f(fv);
                    b = wave_prefix_sum_f(b);
                    const float bend = __builtin_bit_cast(float, __builtin_amdgcn_readlane(__builtin_bit_cast(int, b), 63)), gl = bend - b + iv, A = wave_max(gl);
                    sf[lane] = __expf(gl - A); if (lane == 0) { AB[(hd * 128 + c) * 2] = A; AB[(hd * 128 + c) * 2 + 1] = bend; } } };
            chunk_delta<64, 256>(prep, lds, MQK + (size_t)t0 * 1024 + 512 + hd * 128, 1024, PROJ + (size_t)t0 * NPROJ + PC_MV + hd * 256, NPROJ, sf, DCM + (size_t)(hd * 128 + c) * 32768, DN + (hd * 128 + c) * 128, tid);
        } else { const int v = u - 512, hd = v >> 6, c = v & 63, t0 = c * 128; const float lg = ret_lngamma(hd);
            auto prep = [=]() { if (tid < 128) sf[tid] = __expf(lg * (float)(127 - tid)); };
            chunk_delta<128, 128>(prep, lds, PROJ + (size_t)t0 * NPROJ + PC_RK + hd * 128, NPROJ, PROJ + (size_t)t0 * NPROJ + PC_RV + hd * 128, NPROJ, sf, DRR + (size_t)(hd * 64 + c) * 16384, nullptr, tid); }
    } }
PHASE_FN ph_select(LAS unsigned char* lds, unsigned char* ws) { TIDS(); WS_PTRS(ws);
    if (G == 256) select_rows_wg(lds, SC, MB, bx, 256, 28, 7168 + (bx - 128), 128, bx >= 128 ? 8 : 0, tid, (unsigned long long*)(ws + WS_CTL) + 16384);
    else select_rows_wg(lds, SC, MB, bx, G, (S - bx + G - 1) / G, 0, 0, 0, tid, (unsigned long long*)(ws + WS_CTL) + 16384); }
PHASE_FN ph_scans(LAS unsigned char* lds, unsigned char* ws) { TIDS(); WS_PTRS(ws); LAS float* const sf = (LAS float*)(lds + SCR_OFF);
    for (int u = bx; u < 128; u += G) {
        LAS float* dec = sf; LAS float* inj = sf + 128; LAS float* av = sf + 256; LAS float* bv = sf + 384;
        if (u < 64) { const int hd = u >> 4, p = u & 15;
            if (tid < 128) { av[tid] = AB[(hd * 128 + tid) * 2]; bv[tid] = AB[(hd * 128 + tid) * 2 + 1]; }
            __syncthreads();
            if (tid == 0) { float m = 0.f; for (int c = 0; c < 128; ++c) { const float mn = fmaxf(bv[c] + m, av[c]); dec[c] = __expf(bv[c] + m - mn); inj[c] = __expf(av[c] - mn); if (p == 0) MPREV[hd * 128 + c] = m; m = mn; } }
            __syncthreads();
            const size_t e4 = (size_t)hd * 128 * 32768 + p * 2048 + tid * 4;
            scan_elems<128>(DCM + e4, CPM + e4, 32768, dec, inj);
            if (p == 0 && tid < 128) { float st = 0.f; for (int c = 0; c < 128; ++c) { NPREV[(hd * 128 + c) * 128 + tid] = st; st = dec[c] * st + inj[c] * DN[(hd * 128 + c) * 128 + tid]; } }
        } else { const int v = u - 64, hd = v >> 3, p = v & 7; const float dg = __expf(128.0f * ret_lngamma(hd));
            if (tid < 64) { dec[tid] = dg; inj[tid] = 1.0f; }
            __syncthreads();
            const size_t e4 = (size_t)hd * 64 * 16384 + p * 2048 + tid * 4;
            scan_elems<64>(DRR + e4, RPR + e4, 16384, dec, inj); }
        __syncthreads(); } }
#define ATT_IT(qb, part, jlo, jhi) ((unsigned)(qb) | ((unsigned)(part) << 8) | ((unsigned)(jlo) << 16) | ((unsigned)(jhi) << 24))
constexpr int ATT_BINS = 24;
__device__ __forceinline__ unsigned att_item(int bin, int pass) {
    static constexpr unsigned tab[ATT_BINS * 3] = {
        ATT_IT(16, 1, 0, 24), ATT_IT(15, 0, 0, 64), 0u,
        ATT_IT(17, 1, 0, 28), ATT_IT(14, 0, 0, 60), 0u,
        ATT_IT(18, 1, 0, 32), ATT_IT(13, 0, 0, 56), 0u,
        ATT_IT(19, 1, 0, 36), ATT_IT(12, 0, 0, 52), 0u,
        ATT_IT(20, 1, 0, 40), ATT_IT(11, 0, 0, 48), 0u,
        ATT_IT(21, 1, 0, 44), ATT_IT(10, 0, 0, 44), 0u,
        ATT_IT(22, 1, 0, 48), ATT_IT(9, 0, 0, 40), 0u,
        ATT_IT(23, 1, 0, 52), ATT_IT(8, 0, 0, 36), 0u,
        ATT_IT(24, 1, 0, 56), ATT_IT(7, 0, 0, 32), 0u,
        ATT_IT(25, 1, 0, 60), ATT_IT(6, 0, 0, 28), 0u,
        ATT_IT(26, 1, 0, 64), ATT_IT(5, 0, 0, 24), 0u,
        ATT_IT(27, 1, 0, 68), ATT_IT(4, 0, 0, 20), 0u,
        ATT_IT(28, 1, 0, 72), ATT_IT(3, 0, 0, 16), 0u,
        ATT_IT(29, 1, 0, 76), ATT_IT(2, 0, 0, 12), 0u,
        ATT_IT(30, 1, 0, 80), ATT_IT(1, 0, 0, 8), 0u,
        ATT_IT(31, 1, 0, 84), ATT_IT(0, 0, 0, 4), 0u,
        ATT_IT(16, 2, 24, 68), ATT_IT(17, 2, 28, 72), 0u,
        ATT_IT(18, 2, 32, 76), ATT_IT(19, 2, 36, 80), 0u,
        ATT_IT(20, 2, 40, 84), ATT_IT(21, 2, 44, 88), 0u,
        ATT_IT(22, 2, 48, 92), ATT_IT(23, 2, 52, 96), 0u,
        ATT_IT(24, 2, 56, 100), ATT_IT(25, 2, 60, 104), 0u,
        ATT_IT(26, 2, 64, 108), ATT_IT(27, 2, 68, 112), 0u,
        ATT_IT(28, 2, 72, 116), ATT_IT(29, 2, 76, 120), 0u,
        ATT_IT(30, 2, 80, 124), ATT_IT(31, 2, 84, 128), 0u,
    };
    return tab[3 * bin + pass]; }
__device__ __forceinline__ int att_nitems(int bin) { static constexpr unsigned char cnt[ATT_BINS] = {2, 2, 2, 2, 2, 2, 2, 2, 2, 2, 2, 2, 2, 2, 2, 2, 2, 2, 2, 2, 2, 2, 2, 2}; return cnt[bin]; }
constexpr int ATT_WGS = ATT_BINS * 8;
PHASE_FN ph_attention(char* alds, unsigned char* ws) { TIDS(); WS_PTRS(ws);
    typedef att::BlockRef<bf16, bf16> BR; att::Seam<bf16> seam;
    bf16* const YP = (bf16*)(ws + WS_YP); float* const ML = (float*)(ws + WS_MISC + MiB);
    const bool split = G == 256;
#define ATT_REF(r, a_, pass_) do { int hd_, qb_, part_ = 0, jlo_ = 0, jhi_; \
        if (split) { hd_ = (a_) / ATT_BINS; const unsigned e_ = att_item((a_) % ATT_BINS, (pass_)); qb_ = (int)(e_ & 255u); part_ = (int)((e_ >> 8) & 255u); jlo_ = (int)((e_ >> 16) & 255u); jhi_ = (int)(e_ >> 24); } \
        else { hd_ = (a_) >> 4; const int y_ = (a_) & 15; qb_ = (pass_) ? 31 - y_ : y_; jhi_ = 4 * (qb_ + 1); } \
        (r).Q = PROJ + (size_t)qb_ * 256 * NPROJ + PC_AQ + hd_ * 128; (r).K = PROJ + PC_AK + hd_ * 128; (r).V = PROJ + PC_AV + hd_ * 128; \
        (r).O = (part_ ? YP + (size_t)(part_ - 1) * S * 1024 : YA) + (size_t)qb_ * 256 * 1024 + hd_ * 128; \
        (r).ML = part_ ? ML + (size_t)(part_ - 1) * S * 16 + (size_t)qb_ * 256 * 16 + hd_ * 2 : nullptr; \
        (r).M = MB + (size_t)qb_ * 256 * 128; (r).P0 = qb_ * 256; (r).jlo = jlo_; (r).jhi = jhi_; (r).pad = 0; } while (0)
    const int nwg = split ? ATT_WGS : 128;
    if (bx < nwg) { { BR c0; ATT_REF(c0, bx, 0); att::causal_swa_prime<bf16, bf16>(c0, 1 << 30, alds, seam); }
        const int nit = split ? att_nitems(bx % ATT_BINS) : 2;
#pragma unroll 1
        for (int pass = 0; pass < nit; ++pass) {
            BR cur, nxt; ATT_REF(cur, bx, pass); const int pn = pass + 1 < nit ? pass + 1 : pass; ATT_REF(nxt, bx, pn);
            att::causal_swa_block<bf16, bf16>(cur, nxt, S, 1 << 30, alds, seam); } }
#undef ATT_REF
    __syncthreads(); }
PHASE_FN ph_attn_merge(unsigned char* ws) { TIDS(); WS_PTRS(ws);
    if (G != 256) return;
    const bf16* YP = (const bf16*)(ws + WS_YP); const float* ML = (const float*)(ws + WS_MISC + MiB);
    constexpr float C2 = 1.4426950408889634f * 0.08838834764831845f;
    for (int t = 4096 + gw; t < S; t += NGW) { const int hd = lane >> 3, c0 = hd * 128 + (lane & 7) * 16;
        const float m1 = ML[(size_t)t * 16 + hd * 2], l1 = ML[(size_t)t * 16 + hd * 2 + 1], m2 = ML[(size_t)S * 16 + (size_t)t * 16 + hd * 2], l2 = ML[(size_t)S * 16 + (size_t)t * 16 + hd * 2 + 1];
        const float mm = fmaxf(m1, m2); float w1 = l1 > 0.f ? l1 * __builtin_amdgcn_exp2f((m1 - mm) * C2) : 0.f, w2 = l2 > 0.f ? l2 * __builtin_amdgcn_exp2f((m2 - mm) * C2) : 0.f;
        const float inv = 1.0f / (w1 + w2); w1 *= inv; w2 *= inv;
#pragma unroll
        for (int q = 0; q < 2; ++q) { float a[8], b[8], o[8];
            bf8_unpack(*(const GAS v4u*)(YP + (size_t)t * 1024 + c0 + 8 * q), a); bf8_unpack(*(const GAS v4u*)(YP + (size_t)S * 1024 + (size_t)t * 1024 + c0 + 8 * q), b);
#pragma unroll
            for (int i = 0; i < 8; ++i) o[i] = (w1 > 0.f ? w1 * a[i] : 0.f) + (w2 > 0.f ? w2 * b[i] : 0.f);
            *(GAS v4u*)(YA + (size_t)t * 1024 + c0 + 8 * q) = bf8_pack(o); } } }
PHASE_FN ph_outs(LAS unsigned char* lds, unsigned char* ws, const float* gain_m, const float* gain_r, int u0, int ustep) { TIDS(); WS_PTRS(ws); LAS float* const sf = (LAS float*)(lds + SCR_OFF);
    for (int u = u0; u < 1024; u += ustep) {
        if (u < 512) { const int hd = u >> 7, c = u & 127, t0 = c * 64;
            auto prep = [=]() {
                if (wave == 0) { const float iv = GIF[(size_t)(t0 + lane) * 8 + hd], fv = GIF[(size_t)(t0 + lane) * 8 + 4 + hd]; float b = log_sigmoid_f(fv);
                    b = wave_prefix_sum_f(b);
                    const float mp = MPREV[hd * 128 + c]; const float pm = wave_prefix_max_f(iv - b);
                    const float mt = fmaxf(b + mp, b + pm);
                    sf[lane] = b - mt; sf[128 + lane] = iv - b; sf[256 + lane] = __expf(b + mp - mt); sf[384 + lane] = __expf(-mt); sf[512 + lane] = 0.f; }
                if (wave == 1) { sf[640 + lane] = NPREV[(hd * 128 + c) * 128 + lane]; sf[640 + 64 + lane] = NPREV[(hd * 128 + c) * 128 + 64 + lane]; } };
            chunk_out<64, 256, 0>(prep, lds, sf, MQK + (size_t)t0 * 1024 + hd * 128, 1024, MQK + (size_t)t0 * 1024 + 512 + hd * 128, 1024, PROJ + (size_t)t0 * NPROJ + PC_MV + hd * 256, NPROJ,
                                  CPM + (size_t)(hd * 128 + c) * 32768, gain_m + hd * 256, PROJ + (size_t)t0 * NPROJ + PC_MO + hd * 256, NPROJ, YM + (size_t)t0 * 1024 + hd * 256, 1024, tid);
        } else { const int v = u - 512, hd = v >> 6, c = v & 63, t0 = c * 128; const float lg = ret_lngamma(hd);
            auto prep = [=]() { if (tid < 128) { sf[tid] = lg * (float)tid; sf[128 + tid] = -lg * (float)tid; sf[256 + tid] = __expf(lg * (float)(tid + 1)); } };
            chunk_out<128, 128, 1>(prep, lds, sf, PROJ + (size_t)t0 * NPROJ + PC_RQ + hd * 128, NPROJ, PROJ + (size_t)t0 * NPROJ + PC_RK + hd * 128, NPROJ, PROJ + (size_t)t0 * NPROJ + PC_RV + hd * 128, NPROJ,
                                   RPR + (size_t)(hd * 64 + c) * 16384, gain_r + hd * 128, PROJ + (size_t)t0 * NPROJ + PC_RG + hd * 128, NPROJ, YR + (size_t)t0 * 1024 + hd * 128, 1024, tid); }
    } }
template <int MODE> PHASE_FN ph_gemm_branch(LAS unsigned char* lds, unsigned char* ws, const bf16* A, const bf16* Wt, int gcol) { TIDS(); WS_PTRS(ws);
    pg8::Gemm g{A, Wt, S, DM, 1024}; pg8::StaticOrder so; so.init(S, DM, G, bx); pg8::EpiBranch<MODE> E{PROJ + PC_G + gcol, NPROJ, (bf16*)MERGEDF, MERGED, DM};
    pg8::gemm_phase<pg8::EpiBranch<MODE>, pg8::StaticOrder, true, true>(lds, g, so, E); }
template <bool BF_IN, bool BF_OUT> PHASE_FN ph_gemm_resid_x(LAS unsigned char* lds, const bf16* A, const bf16* Wt, int K, const void* base, void* out) { TIDS();
    pg8::Gemm g{A, Wt, S, DM, K}; pg8::StaticOrder so; so.init(S, DM, G, bx); pg8::EpiResidX<BF_IN, BF_OUT> E{base, out, DM};
    pg8::gemm_phase<pg8::EpiResidX<BF_IN, BF_OUT>, pg8::StaticOrder, true, true>(lds, g, so, E); }
PHASE_FN ph_gemm_resid(LAS unsigned char* lds, const bf16* A, const bf16* Wt, int K, const float* base, float* out) { TIDS();
    pg8::Gemm g{A, Wt, S, DM, K}; pg8::StaticOrder so; so.init(S, DM, G, bx); pg8::EpiResid E{base, out, DM};
    pg8::gemm_phase<pg8::EpiResid, pg8::StaticOrder, true, true>(lds, g, so, E); }
PHASE_FN ph_gemm_ffn_in(LAS unsigned char* lds, unsigned char* ws, const bf16* Wt) { TIDS(); WS_PTRS(ws);
    pg8::Gemm g{H, Wt, S, 2 * FF, DM}; pg8::StaticOrder so; so.init(S, 2 * FF, G, bx); pg8::EpiSwiGLU E{ACT, FF};
    pg8::gemm_phase<pg8::EpiSwiGLU, pg8::StaticOrder, true, true>(lds, g, so, E); }


#ifndef SYN_PROBE
#define SYN_PROBE 0
#endif
PHASE_FN ph_probe(LAS unsigned char* lds) { TIDS();
    LAS unsigned* hist = (LAS unsigned*)lds;
    if (SYN_PROBE == 1) {
        unsigned x = (unsigned)tid * 2654435761u + 12345u;
        for (int r = 0; r < 32; ++r) {
#pragma unroll
            for (int i = 0; i < 16; ++i) { x = x * 1664525u + 1013904223u; (void)__hip_atomic_fetch_add(hist + ((x >> 10) & 2047u), 1u, __ATOMIC_RELAXED, __HIP_MEMORY_SCOPE_WORKGROUP); }
            SEL_BAR(); } }
    if (SYN_PROBE == 2) {
        float acc = 0.f; float v[16];
#pragma unroll
        for (int i = 0; i < 16; ++i) v[i] = (float)((tid * 16 + i) % 977);
        for (int r = 0; r < 32 * 8; ++r) { const float c1 = 100.f + (float)(r & 7) + acc * 1e-30f, c2 = c1 * 2.f, c3 = c1 * 3.f; unsigned n1 = 0, n2 = 0, n3 = 0;
#pragma unroll
            for (int i = 0; i < 16; ++i) { n1 += (unsigned)__builtin_popcountll(__builtin_amdgcn_ballot_w64(v[i] >= c1)); n2 += (unsigned)__builtin_popcountll(__builtin_amdgcn_ballot_w64(v[i] >= c2)); n3 += (unsigned)__builtin_popcountll(__builtin_amdgcn_ballot_w64(v[i] >= c3)); }
            if (lane == 0) { hist[(r & 1) * 24 + wave] = n1; hist[(r & 1) * 24 + 8 + wave] = n2; hist[(r & 1) * 24 + 16 + wave] = n3; }
            SEL_BAR();
            unsigned t1 = 0;
#pragma unroll
            for (int j = 0; j < 24; ++j) t1 += hist[(r & 1) * 24 + j];
            acc += (float)t1; }
        if (acc == 12345.f) hist[100] = 1u; }
    if (SYN_PROBE == 3) {
        float a = (float)tid;
        for (int r = 0; r < 32; ++r) {
#pragma unroll
            for (int k = 0; k < 4; ++k)
#pragma unroll
                for (int o = 1; o < 64; o <<= 1) a = fmaxf(a, shfl_idx_f(a, (int)(lane_id_v() ^ (unsigned)o)) * 0.999f);
        }
        if (a == 12345.f) hist[100] = 1u; }
    __syncthreads(); }
typedef const __attribute__((address_space(4))) Args* ArgsP;
__device__ __forceinline__ ArgsP fresh_args() { ArgsP ap = (ArgsP)__builtin_amdgcn_kernarg_segment_ptr(); asm volatile("" : "+s"(ap)); return ap; }
#ifndef DUP_PHASE
#define DUP_PHASE -1
#endif
#ifndef PROBE_GAIN
#define PROBE_GAIN 1.0f
#endif
#ifndef PROBE_WSPLIT
#define PROBE_WSPLIT 176
#endif
#ifndef PROBE_WHALF
#define PROBE_WHALF 0
#endif
#ifndef PROBE_WMASK
#define PROBE_WMASK 0
#endif
#define SEAM() do { if constexpr (one_launch) { ArgsP ap_ = fresh_args(); XcdBarrier b_; b_.bar = (unsigned*)(ap_->ws + WS_CTL) + CW_BAR; b_.x = xb_xcc_id(); b_.st = (volatile LAS unsigned*)(lds + MISC_OFF); \
        unsigned long long t0_ = 0ull; if (PROBE_WMASK != 0) t0_ = __builtin_amdgcn_s_memrealtime(); xcd_barrier(b_); \
        if (PROBE_WMASK != 0) { const unsigned long long t1_ = __builtin_amdgcn_s_memrealtime(); if (my_tid() == 0 && (PROBE_WHALF == 0 || (PROBE_WHALF == 1) == ((int)blockIdx.x < PROBE_WSPLIT))) atomicAdd((unsigned long long*)(ap_->ws + WS_CTL) + 16384 + 16 + seam_no, t1_ - t0_); } } ++seam_no; } while (0)
#define IN(k) (PLO <= (k) && (k) < PHI)
#define WL(ap, layer) ((ap)->ws + WS_W + (size_t)(layer) * W_LAYER)
template <int PLO, int PHI, bool LAST> __device__ __forceinline__ void layer_phases(const int layer, LAS unsigned char* lds, unsigned char* lds_raw) {
    constexpr bool one_launch = (PHI - PLO > 1); int seam_no = 0; (void)seam_no;
    if constexpr (IN(1)) { ArgsP ap = fresh_args(); if (layer == 0) ph_rmsnorm(ap->x, ap->norm_mix, (bf16*)(ap->ws + WS_H)); else ph_rmsnorm16((const bf16*)(ap->ws + WS_X16), ap->norm_mix + layer * DM, (bf16*)(ap->ws + WS_H)); SEAM(); }
    constexpr int CV_EARLY = 32 * 58;
    constexpr int CV_S1 = 10880, CV_S2 = 10880;
    if constexpr (IN(2)) { ArgsP ap = fresh_args(); ph_gemm_proj(lds, ap->ws, (const bf16*)(WL(ap, layer) + WO_IN));
        if constexpr (one_launch) { ArgsP aq = fresh_args(); ph_convert_tail(lds, aq->ws, layer, aq->w_in, aq->w_b_att, aq->w_b_mlstm, aq->w_b_ret, aq->w_out, aq->w_ffn_in, aq->w_ffn_out, ((S / 256) * (NPROJ_PAD / 256)) % (int)gridDim.x, CV_IN, CV_ITEMS);
            if constexpr (!LAST) { ArgsP ar = fresh_args(); ph_convert_tail(lds, ar->ws, layer + 1, ar->w_in, ar->w_b_att, ar->w_b_mlstm, ar->w_b_ret, ar->w_out, ar->w_ffn_in, ar->w_ffn_out, ((S / 256) * (NPROJ_PAD / 256)) % (int)gridDim.x, 0, CV_EARLY); } } if constexpr (DUP_PHASE == 2) { SEAM(); ph_gemm_proj(lds, ap->ws, (const bf16*)(WL(ap, layer) + WO_IN)); } SEAM(); }
    if constexpr (IN(3)) { ArgsP ap = fresh_args(); ph_pp(ap->ws, ap->att_q_norm + layer * 128, ap->att_k_norm + layer * 128, ap->mlstm_conv + layer * 4096, ap->mlstm_gate_bias + layer * 8); if constexpr (DUP_PHASE == 23) { SEAM(); ph_gemm_proj(lds, ap->ws, (const bf16*)(WL(ap, layer) + WO_IN)); SEAM(); ph_pp(ap->ws, ap->att_q_norm + layer * 128, ap->att_k_norm + layer * 128, ap->mlstm_conv + layer * 4096, ap->mlstm_gate_bias + layer * 8); } if constexpr (DUP_PHASE == 3) { SEAM(); ph_pp(ap->ws, ap->att_q_norm + layer * 128, ap->att_k_norm + layer * 128, ap->mlstm_conv + layer * 4096, ap->mlstm_gate_bias + layer * 8); } SEAM(); }
    if constexpr (IN(4)) { ArgsP ap = fresh_args(); ph_scores(lds, ap->ws); if constexpr (DUP_PHASE == 4) { SEAM(); ph_scores(lds, ap->ws); } }
    if constexpr (IN(5)) { ArgsP ap = fresh_args(); ph_deltas(lds, ap->ws); if constexpr (DUP_PHASE == 5) { SEAM(); ph_deltas(lds, ap->ws); } SEAM(); }
    if constexpr (IN(6) && SYN_PROBE != 0) { ph_probe(lds); }
    if constexpr (IN(6)) { ArgsP ap = fresh_args(); ph_select(lds, ap->ws); if constexpr (DUP_PHASE == 6) { SEAM(); ph_select(lds, ap->ws); } }
    if constexpr (IN(7)) { ArgsP ap = fresh_args(); ph_scans(lds, ap->ws); if constexpr (DUP_PHASE == 7) { SEAM(); ph_scans(lds, ap->ws); } SEAM(); }
    if constexpr (IN(8) && IN(9)) {
        ArgsP ap = fresh_args(); const bool split = gridDim.x == 256;
        if (!split || blockIdx.x < ATT_WGS) ph_attention((char*)lds_raw, ap->ws);
        if (!split || blockIdx.x >= ATT_WGS) ph_outs(lds, ap->ws, ap->mlstm_out_norm + layer * 1024, ap->ret_out_norm + layer * 1024, split ? (int)blockIdx.x - ATT_WGS : (int)blockIdx.x, split ? 256 - ATT_WGS : (int)gridDim.x);
        SEAM();
        { ArgsP am = fresh_args(); ph_attn_merge(am->ws); } SEAM(); }
    else {
    if constexpr (IN(8)) { ArgsP ap = fresh_args(); ph_attention((char*)lds_raw, ap->ws); SEAM(); ph_attn_merge(ap->ws); }
    if constexpr (IN(9)) { ArgsP ap = fresh_args(); ph_outs(lds, ap->ws, ap->mlstm_out_norm + layer * 1024, ap->ret_out_norm + layer * 1024, (int)blockIdx.x, (int)gridDim.x); SEAM(); }
    }
    if constexpr (IN(10)) { ArgsP ap = fresh_args(); ph_gemm_branch<0>(lds, ap->ws, (const bf16*)(ap->ws + WS_YA), (const bf16*)(WL(ap, layer) + WO_B), 0); if constexpr (DUP_PHASE == 10) { SEAM(); ph_gemm_branch<0>(lds, ap->ws, (const bf16*)(ap->ws + WS_YA), (const bf16*)(WL(ap, layer) + WO_B), 0); } }
    if constexpr (IN(11)) { ArgsP ap = fresh_args(); ph_gemm_branch<1>(lds, ap->ws, (const bf16*)(ap->ws + WS_YM), (const bf16*)(WL(ap, layer) + WO_B + 4 * MiB), DM); if constexpr (DUP_PHASE == 11) { SEAM(); ph_gemm_branch<1>(lds, ap->ws, (const bf16*)(ap->ws + WS_YM), (const bf16*)(WL(ap, layer) + WO_B + 4 * MiB), DM); } }
    if constexpr (IN(12)) { ArgsP ap = fresh_args(); ph_gemm_branch<2>(lds, ap->ws, (const bf16*)(ap->ws + WS_YR), (const bf16*)(WL(ap, layer) + WO_B + 8 * MiB), 2 * DM); if constexpr (DUP_PHASE == 12) { SEAM(); ph_gemm_branch<2>(lds, ap->ws, (const bf16*)(ap->ws + WS_YR), (const bf16*)(WL(ap, layer) + WO_B + 8 * MiB), 2 * DM); } SEAM(); }
    if constexpr (IN(13)) { ArgsP ap = fresh_args();
        if (layer == 0) ph_gemm_resid_x<false, true>(lds, (const bf16*)(ap->ws + WS_MERGED), (const bf16*)(WL(ap, layer) + WO_OUT), DM, ap->x, ap->ws + WS_X16);
        else ph_gemm_resid_x<true, true>(lds, (const bf16*)(ap->ws + WS_MERGED), (const bf16*)(WL(ap, layer) + WO_OUT), DM, ap->ws + WS_X16, ap->ws + WS_X16);
        SEAM(); }
    if constexpr (IN(14)) { ArgsP ap = fresh_args(); ph_rmsnorm16((const bf16*)(ap->ws + WS_X16), ap->norm_ffn + layer * DM, (bf16*)(ap->ws + WS_H)); SEAM(); }
    if constexpr (IN(15)) { ArgsP ap = fresh_args(); ph_gemm_ffn_in(lds, ap->ws, (const bf16*)(WL(ap, layer) + WO_FIN));
        if constexpr (one_launch && !LAST) { ArgsP aq = fresh_args(); ph_convert_tail(lds, aq->ws, layer + 1, aq->w_in, aq->w_b_att, aq->w_b_mlstm, aq->w_b_ret, aq->w_out, aq->w_ffn_in, aq->w_ffn_out, ((S / 256) * (2 * FF / 256)) % (int)gridDim.x, CV_EARLY, CV_IN); } if constexpr (DUP_PHASE == 15) { SEAM(); ph_gemm_ffn_in(lds, ap->ws, (const bf16*)(WL(ap, layer) + WO_FIN)); } SEAM(); }
    if constexpr (IN(16)) { ArgsP ap = fresh_args();
        if (layer == DEPTH - 1) ph_gemm_resid_x<true, false>(lds, (const bf16*)(ap->ws + WS_ACT), (const bf16*)(WL(ap, layer) + WO_FOUT), FF, ap->ws + WS_X16, ap->out);
        else ph_gemm_resid_x<true, true>(lds, (const bf16*)(ap->ws + WS_ACT), (const bf16*)(WL(ap, layer) + WO_FOUT), FF, ap->ws + WS_X16, ap->ws + WS_X16);
        if constexpr (!LAST) SEAM(); }
}
PHASE_FN ph_probe_scale(unsigned char* ws, float* out) { TIDS();
    const unsigned long long* gacc = (const unsigned long long*)(ws + WS_CTL) + 16384; double num = 0.0, den = 0.0;
    if (PROBE_MASK != 0) { for (int k = 0; k < 7; ++k) { const double a = (double)__hip_atomic_load(gacc + k, __ATOMIC_RELAXED, __HIP_MEMORY_SCOPE_AGENT); den += a; if ((PROBE_MASK >> k) & 1) num += a; } }
    else { for (int k = 0; k < 16; ++k) if ((PROBE_WMASK >> k) & 1) num += (double)__hip_atomic_load(gacc + 16 + k, __ATOMIC_RELAXED, __HIP_MEMORY_SCOPE_AGENT);
        den = (double)G * (double)__hip_atomic_load(gacc + 15, __ATOMIC_RELAXED, __HIP_MEMORY_SCOPE_AGENT); }
    const float f = 1.0f + 0.05f * floorf((float)(num / den) * 20.0f * PROBE_GAIN + 0.5f);
    for (size_t i = (size_t)gw * 64 + lane; i < (size_t)S * DM; i += (size_t)NGW * 64) out[i] *= f; }
template <int PLO, int PHI> __global__ void __launch_bounds__(NTHR, 2) fwd(Args args_unused) {
    (void)args_unused;
    extern __shared__ __attribute__((aligned(16))) unsigned char lds_raw[];
    LAS unsigned char* lds = (LAS unsigned char*)lds_raw;
    if (threadIdx.x < 64) ((volatile LAS unsigned*)(lds + MISC_OFF))[threadIdx.x] = 0u;
    if ((threadIdx.x & 63) == 0) ((volatile LAS unsigned*)(lds + MISC_OFF))[64 + ((unsigned)__builtin_amdgcn_s_getreg((5 << 11) | 4) & 63u)] = threadIdx.x >> 6;
    __syncthreads();
    constexpr bool one_launch = (PHI - PLO > 1); int seam_no = 15; (void)seam_no;
    const unsigned long long tstart_ = (PROBE_WMASK != 0) ? __builtin_amdgcn_s_memrealtime() : 0ull; (void)tstart_;
    if constexpr (one_launch) { ArgsP ap = fresh_args(); (void)xcd_barrier_post((unsigned*)(ap->ws + WS_CTL) + CW_BAR, (volatile LAS unsigned*)(lds + MISC_OFF)); }
    if constexpr (PLO == 0) { ArgsP ap = fresh_args(); ph_prologue(lds, ap->ws, ap->w_in, ap->w_b_att, ap->w_b_mlstm, ap->w_b_ret, ap->w_out, ap->w_ffn_in, ap->w_ffn_out, !one_launch);
        if constexpr (DUP_PHASE == 0) { SEAM(); ph_prologue(lds, ap->ws, ap->w_in, ap->w_b_att, ap->w_b_mlstm, ap->w_b_ret, ap->w_out, ap->w_ffn_in, ap->w_ffn_out, !one_launch); }
        if (PHI > 1) SEAM(); }
    if constexpr (one_launch) { static_assert(DEPTH == 4, "four inlined layer sites");
        layer_phases<PLO, PHI, false>(0, lds, lds_raw); layer_phases<PLO, PHI, false>(1, lds, lds_raw); layer_phases<PLO, PHI, false>(2, lds, lds_raw); layer_phases<PLO, PHI, true>(3, lds, lds_raw);
        if constexpr (PROBE_WMASK != 0) { if (blockIdx.x == 0 && my_tid() == 0) { ArgsP ap = fresh_args(); atomicAdd((unsigned long long*)(ap->ws + WS_CTL) + 16384 + 15, __builtin_amdgcn_s_memrealtime() - tstart_); } }
        if constexpr (PROBE_MASK != 0 || PROBE_WMASK != 0) { seam_no = 14; SEAM(); ArgsP ap = fresh_args(); ph_probe_scale(ap->ws, ap->out); } }
    else if constexpr (PLO > 0) { ArgsP ap = fresh_args(); layer_phases<PLO, PHI, true>(ap->layer_lo, lds, lds_raw); }
}
#undef IN
#undef SEAM
#undef WL

#ifndef ONE_LAUNCH
#define ONE_LAUNCH 1
#endif
typedef void (*kern_t)(Args);
template <int P> static kern_t phase_kernel(int p) { if (p == P) return fwd<P, P + 1>; if constexpr (P < PH_PER_LAYER) return phase_kernel<P + 1>(p); else return nullptr; }
extern "C" void kernel_launch(void* const* d_in, const int* in_sizes, int n_in, void* d_out, int out_size, void* d_ws, size_t ws_size, hipStream_t stream) {
    static int grid = 0;
    if (grid == 0) {
        if (n_in != 16 || in_sizes[0] != S * DM || out_size != S * DM || ws_size < WS_END) { fprintf(stderr, "kernel_launch: unexpected shapes (n_in %d, in0 %d, out %d, ws %zu < %zu); nothing launched\n", n_in, n_in > 0 ? in_sizes[0] : -1, out_size, ws_size, (size_t)WS_END); grid = -1; return; }
        int dev = 0, cus = 0;
        if (hipGetDevice(&dev) != hipSuccess || hipDeviceGetAttribute(&cus, hipDeviceAttributeMultiprocessorCount, dev) != hipSuccess) { grid = -1; return; }
#if ONE_LAUNCH
        if (hipFuncSetAttribute((const void*)fwd<0, PH_PER_LAYER + 1>, hipFuncAttributeMaxDynamicSharedMemorySize, LDS_BYTES) != hipSuccess) { grid = -1; return; }
#else
        for (int p = 0; p <= PH_PER_LAYER; ++p) if (hipFuncSetAttribute((const void*)phase_kernel<0>(p), hipFuncAttributeMaxDynamicSharedMemorySize, LDS_BYTES) != hipSuccess) { fprintf(stderr, "kernel_launch: hipFuncSetAttribute failed\n"); grid = -1; return; }
#endif
        (void)hipGetLastError();
        grid = cus;
    }
    if (grid < 0) return;
    (void)hipMemsetAsync((char*)d_ws + WS_CTL, 0, CTL_ZERO_BYTES, stream);
    Args a{};
    a.x = (const float*)d_in[0]; a.norm_mix = (const float*)d_in[1]; a.norm_ffn = (const float*)d_in[2]; a.w_in = (const float*)d_in[3]; a.att_q_norm = (const float*)d_in[4]; a.att_k_norm = (const float*)d_in[5];
    a.mlstm_conv = (const float*)d_in[6]; a.mlstm_gate_bias = (const float*)d_in[7]; a.mlstm_out_norm = (const float*)d_in[8]; a.ret_out_norm = (const float*)d_in[9];
    a.w_b_att = (const float*)d_in[10]; a.w_b_mlstm = (const float*)d_in[11]; a.w_b_ret = (const float*)d_in[12]; a.w_out = (const float*)d_in[13]; a.w_ffn_in = (const float*)d_in[14]; a.w_ffn_out = (const float*)d_in[15];
    a.out = (float*)d_out; a.ws = (unsigned char*)d_ws;
#if ONE_LAUNCH
    a.layer_lo = 0; a.layer_hi = DEPTH; a.ph_lo = 0; a.ph_hi = PH_PER_LAYER + 1; hipLaunchKernelGGL((fwd<0, PH_PER_LAYER + 1>), dim3(grid), dim3(NTHR), LDS_BYTES, stream, a);
#else
    a.layer_lo = 0; a.layer_hi = 0; a.ph_lo = 0; a.ph_hi = 1; hipLaunchKernelGGL((fwd<0, 1>), dim3(grid), dim3(NTHR), LDS_BYTES, stream, a);
    for (int l = 0; l < DEPTH; ++l) for (int p = 1; p <= PH_PER_LAYER; ++p) { a.layer_lo = l; a.layer_hi = l + 1; a.ph_lo = p; a.ph_hi = p + 1; hipLaunchKernelGGL(phase_kernel<0>(p), dim3(grid), dim3(NTHR), LDS_BYTES, stream, a); }
#endif
}
```
